# Optimizing an MI355X kernel written in HIP

```python
import jax, jax.numpy as jnp
from jax import lax
import numpy as np

D_MODEL = 1024
BATCH = 4
SEQ = 4096
DEPTH = 2

RET_HEADS = 4
RET_DK = 64
RET_DV = 64
RET_CHUNK = 128
ROPE_BASE = 10000.0
RWKV_HEADS = 6
RWKV_HEAD = 64
RWKV_W = RWKV_HEADS * RWKV_HEAD
DECAY_LORA = 64
AAA_LORA = 64
GATE_LORA = 128
RWKV_GN_EPS = 64e-5
GLA_HEADS = 4
GLA_DK = 48
GLA_DV = 96
GLA_GATE_LORA = 16
GLA_GATE_NORMALIZER = 16.0
GLA_CHUNK = 64
D_MIX = RET_HEADS * RET_DV + RWKV_W + GLA_HEADS * GLA_DV
PEER_HEADS = 8
PEER_NKEYS = 128
PEER_NEXPERTS = PEER_NKEYS * PEER_NKEYS
PEER_QDIM = 256
PEER_QHALF = PEER_QDIM // 2
PEER_TOPK = 16
PEER_BLOCK = 128
NORM_EPS = 1e-6
HEAD_NORM_EPS = 1e-5

RET_SIZES = (RET_HEADS * RET_DK, RET_HEADS * RET_DK, RET_HEADS * RET_DV, RET_HEADS * RET_DV)
RWKV_SIZES = (RWKV_W, RWKV_W, RWKV_W, DECAY_LORA, AAA_LORA, GATE_LORA)
GLA_SIZES = (GLA_HEADS * GLA_DK, GLA_HEADS * GLA_DK, GLA_HEADS * GLA_DV, GLA_GATE_LORA, GLA_HEADS * GLA_DV)
GROUP_SIZES = (sum(RET_SIZES), sum(RWKV_SIZES), sum(GLA_SIZES))
D_IN = sum(GROUP_SIZES)

kernel_name = "hymba_ret_rwkv7_gla_peer"


def _split(z, sizes):
    offs = np.cumsum(np.array(sizes))[:-1].tolist()
    return jnp.split(z, offs, axis=-1)


def rms_norm(x, g):
    xf = x.astype(jnp.float32)
    y = xf * lax.rsqrt(jnp.mean(xf * xf, axis=-1, keepdims=True) + NORM_EPS)
    return (y * g.astype(jnp.float32)).astype(x.dtype)


def _head_rms(o, eps):
    return o * lax.rsqrt(jnp.mean(o * o, axis=-1, keepdims=True) + eps)


def _to_bhsd(t, h):
    b, s, _ = t.shape
    return t.reshape(b, s, h, -1).transpose(0, 2, 1, 3)


def _to_chunks(t, n, c):
    b, h, _, d = t.shape
    return t.reshape(b, h, n, c, d).transpose(2, 0, 1, 3, 4)


def _from_chunks(o):
    n, b, h, c, d = o.shape
    return o.transpose(1, 2, 0, 3, 4).reshape(b, h, n * c, d)


def _rotary(t, pos):
    half = t.shape[-1] // 2
    inv = ROPE_BASE ** (-jnp.arange(half, dtype=jnp.float32) / half)
    ang = pos[:, None] * inv[None, :]
    cos, sin = jnp.cos(ang), jnp.sin(ang)
    t1, t2 = t[..., :half], t[..., half:]
    return jnp.concatenate([t1 * cos - t2 * sin, t1 * sin + t2 * cos], axis=-1)


def retention_mixer(q, k, v, g):
    f32 = jnp.float32
    b, s, _ = q.shape
    h, c = RET_HEADS, RET_CHUNK
    n = s // c
    pos = jnp.arange(s, dtype=f32)
    q = _rotary(_to_bhsd(q, h).astype(f32), pos)
    k = _rotary(_to_bhsd(k, h).astype(f32), pos) * (RET_DK ** -0.5)
    v = _to_bhsd(v, h).astype(f32)
    log_gamma = jnp.log1p(-jnp.exp(jnp.linspace(np.log(1.0 / 32.0), np.log(1.0 / 512.0), h).astype(f32)))
    idx = jnp.arange(c, dtype=f32)
    diff = idx[:, None] - idx[None, :]
    causal = diff >= 0
    dmat = jnp.where(causal, jnp.exp(log_gamma[:, None, None] * jnp.where(causal, diff, 0.0)), 0.0)
    q_decay = jnp.exp(log_gamma[:, None] * (idx + 1.0))[..., None]
    k_decay = jnp.exp(log_gamma[:, None] * (c - 1.0 - idx))[..., None]
    chunk_decay = jnp.exp(log_gamma * c)[:, None, None]

    def step(state, inp):
        qc, kc, vc = inp
        scores = jnp.einsum('bhid,bhjd->bhij', qc, kc) * dmat
        o = jnp.einsum('bhij,bhjv->bhiv', scores, vc) + jnp.einsum('bhid,bhdv->bhiv', qc * q_decay, state)
        state = state * chunk_decay + jnp.einsum('bhjd,bhjv->bhdv', kc * k_decay, vc)
        return state, o

    s0 = jnp.zeros((b, h, RET_DK, RET_DV), f32)
    _, o = lax.scan(step, s0, (_to_chunks(q, n, c), _to_chunks(k, n, c), _to_chunks(v, n, c)))
    o = _head_rms(_from_chunks(o), HEAD_NORM_EPS)
    o = o.transpose(0, 2, 1, 3).reshape(b, s, h * RET_DV)
    return o * jax.nn.silu(g.astype(f32))


def rwkv7_mixer(f, mu, w_up, w_bias, a_up, a_bias, g_up, k_k, k_a, r_k, ln_w, ln_b):
    f32 = jnp.float32
    b, s, _ = f.shape
    h, nh = RWKV_HEADS, RWKV_HEAD
    f = f.astype(f32)
    f_prev = jnp.pad(f, ((0, 0), (1, 0), (0, 0)))[:, :-1]
    f = f + (f_prev - f) * mu.astype(f32)
    r, k, v, wd, ad, gd = _split(f, RWKV_SIZES)
    w = -jax.nn.softplus(-(w_bias + jnp.tanh(wd) @ w_up)) - 0.5
    decay = jnp.exp(-jnp.exp(w.astype(f32)))
    a = jax.nn.sigmoid(a_bias + ad @ a_up).astype(f32)
    g = (jax.nn.sigmoid(gd) @ g_up).astype(f32)
    hs = lambda t: t.astype(f32).reshape(b, s, h, nh)
    kk = hs(k * k_k)
    kk = kk * lax.rsqrt(jnp.maximum(jnp.sum(kk * kk, axis=-1, keepdims=True), 1e-24))
    k = k * (1.0 + (a - 1.0) * k_a)
    r_h, k_h, v_h, a_h, w_h = hs(r), hs(k), hs(v), hs(a), hs(decay)
    tm = lambda t: t.transpose(1, 0, 2, 3)

    def step(state, inp):
        r_t, w_t, k_t, v_t, kk_t, a_t = inp
        sa = jnp.einsum('bhvk,bhk->bhv', state, -kk_t)
        state = (state * w_t[:, :, None, :] + sa[..., None] * (kk_t * a_t)[:, :, None, :]
                 + v_t[..., None] * k_t[:, :, None, :])
        return state, jnp.einsum('bhvk,bhk->bhv', state, r_t)

    s0 = jnp.zeros((b, h, nh, nh), f32)
    _, o = lax.scan(step, s0, (tm(r_h), tm(w_h), tm(k_h), tm(v_h), tm(kk), tm(a_h)))
    o = tm(o)
    mean = jnp.mean(o, axis=-1, keepdims=True)
    var = jnp.mean(jnp.square(o - mean), axis=-1, keepdims=True)
    o = (o - mean) * lax.rsqrt(var + RWKV_GN_EPS) * ln_w.astype(f32).reshape(h, nh) + ln_b.astype(f32).reshape(h, nh)
    o = o + jnp.sum(r_h * k_h * r_k.astype(f32), axis=-1, keepdims=True) * v_h
    return o.reshape(b, s, h * nh) * g


def gla_mixer(q, k, v, gk_d, g, gk_up, gk_bias, norm_w):
    f32 = jnp.float32
    b, s, _ = q.shape
    h, c = GLA_HEADS, GLA_CHUNK
    n = s // c
    gk = jax.nn.log_sigmoid((gk_d @ gk_up + gk_bias).astype(f32)) / GLA_GATE_NORMALIZER
    q = _to_bhsd(q.astype(f32), h) * (GLA_DK ** -0.5)
    k = _to_bhsd(k.astype(f32), h)
    v = _to_bhsd(v.astype(f32), h)
    gk = _to_bhsd(gk, h)
    mask = (jnp.arange(c)[:, None] >= jnp.arange(c)[None, :])[:, :, None]

    def step(state, inp):
        qc, kc, vc, gc = inp
        bcum = jnp.cumsum(gc, axis=-2)
        b_last = bcum[..., -1, :]
        o_inter = jnp.einsum('bhid,bhdv->bhiv', qc * jnp.exp(bcum), state)
        diff = bcum[..., :, None, :] - bcum[..., None, :, :]
        dec = jnp.where(mask, jnp.exp(jnp.where(mask, diff, 0.0)), 0.0)
        attn = jnp.sum(qc[..., :, None, :] * kc[..., None, :, :] * dec, axis=-1)
        o = o_inter + jnp.einsum('bhij,bhjv->bhiv', attn, vc)
        state = (state * jnp.exp(b_last)[..., None]
                 + jnp.einsum('bhjd,bhjv->bhdv', kc * jnp.exp(b_last[..., None, :] - bcum), vc))
        return state, o

    s0 = jnp.zeros((b, h, GLA_DK, GLA_DV), f32)
    _, o = lax.scan(step, s0, (_to_chunks(q, n, c), _to_chunks(k, n, c), _to_chunks(v, n, c), _to_chunks(gk, n, c)))
    o = _from_chunks(o).transpose(0, 2, 1, 3)
    o = _head_rms(o, HEAD_NORM_EPS) * norm_w.astype(f32).reshape(h, GLA_DV)
    return o.reshape(b, s, h * GLA_DV) * jax.nn.silu(g.astype(f32))


def peer_ffn(hn, w_q, sub_keys, u, v):
    b, s, d = hn.shape
    hb = hn.reshape((b * s) // PEER_BLOCK, PEER_BLOCK, d)

    def block(xb):
        p = xb.shape[0]
        q = (xb @ w_q).reshape(p, PEER_HEADS, 2, PEER_QHALF)
        sc = jnp.einsum('thpc,hpnc->thpn', q, sub_keys).astype(jnp.float32)
        s1, i1 = lax.top_k(sc[:, :, 0], PEER_TOPK)
        s2, i2 = lax.top_k(sc[:, :, 1], PEER_TOPK)
        cand = (s1[..., :, None] + s2[..., None, :]).reshape(p, PEER_HEADS, PEER_TOPK * PEER_TOPK)
        cand_idx = (i1[..., :, None] * PEER_NKEYS + i2[..., None, :]).reshape(p, PEER_HEADS, PEER_TOPK * PEER_TOPK)
        top_s, sel = lax.top_k(cand, PEER_TOPK)
        eidx = jnp.take_along_axis(cand_idx, sel, axis=-1).reshape(p, PEER_HEADS * PEER_TOPK)
        gate = jax.nn.softmax(top_s, axis=-1).reshape(p, PEER_HEADS * PEER_TOPK)
        act = jax.nn.gelu(jnp.einsum('td,ted->te', xb, u[eidx]).astype(jnp.float32), approximate=False) * gate
        return jnp.einsum('te,ted->td', act, v[eidx]).astype(xb.dtype)

    return lax.map(block, hb).reshape(b, s, d)


def setup_inputs(seed: int = 0) -> dict:
    key = jax.random.key(seed)
    ks = iter(jax.random.split(key, 32))
    nrm = lambda shape, scale: jax.random.normal(next(ks), shape, jnp.float32) * scale
    L = DEPTH
    return {
        "x": nrm((BATCH, SEQ, D_MODEL), 1.0),
        "norm_mix": 1.0 + nrm((L, D_MODEL), 0.02),
        "norm_ffn": 1.0 + nrm((L, D_MODEL), 0.02),
        "norm_final": 1.0 + nrm((D_MODEL,), 0.02),
        "w_in": nrm((L, D_MODEL, D_IN), D_MODEL ** -0.5),
        "w_out": nrm((L, D_MIX, D_MODEL), D_MIX ** -0.5),
        "rwkv_mu": jax.random.uniform(next(ks), (L, sum(RWKV_SIZES)), jnp.float32),
        "rwkv_w_up": nrm((L, DECAY_LORA, RWKV_W), 0.5 * DECAY_LORA ** -0.5),
        "rwkv_w_bias": jax.random.uniform(next(ks), (L, RWKV_W), jnp.float32, -6.0, 1.0),
        "rwkv_a_up": nrm((L, AAA_LORA, RWKV_W), AAA_LORA ** -0.5),
        "rwkv_a_bias": nrm((L, RWKV_W), 0.5),
        "rwkv_g_up": nrm((L, GATE_LORA, RWKV_W), GATE_LORA ** -0.5),
        "rwkv_k_k": 0.85 + nrm((L, RWKV_W), 0.1),
        "rwkv_k_a": 1.0 + nrm((L, RWKV_W), 0.1),
        "rwkv_r_k": nrm((L, RWKV_HEADS, RWKV_HEAD), 0.1),
        "rwkv_ln_w": 1.0 + nrm((L, RWKV_W), 0.02),
        "rwkv_ln_b": nrm((L, RWKV_W), 0.02),
        "gla_gk_up": nrm((L, GLA_GATE_LORA, GLA_HEADS * GLA_DK), GLA_GATE_LORA ** -0.5),
        "gla_gk_bias": nrm((L, GLA_HEADS * GLA_DK), 0.5),
        "gla_norm_w": 1.0 + nrm((L, GLA_HEADS * GLA_DV), 0.02),
        "peer_w_q": nrm((L, D_MODEL, PEER_HEADS * PEER_QDIM), D_MODEL ** -0.5),
        "peer_sub_keys": nrm((L, PEER_HEADS, 2, PEER_NKEYS, PEER_QHALF), PEER_QHALF ** -0.5),
        "peer_u": nrm((L, PEER_NEXPERTS, D_MODEL), D_MODEL ** -0.5),
        "peer_v": nrm((L, PEER_NEXPERTS, D_MODEL), PEER_TOPK ** -0.5),
    }


def reference(x, norm_mix, norm_ffn, norm_final, w_in, w_out, rwkv_mu, rwkv_w_up, rwkv_w_bias,
              rwkv_a_up, rwkv_a_bias, rwkv_g_up, rwkv_k_k, rwkv_k_a, rwkv_r_k, rwkv_ln_w, rwkv_ln_b,
              gla_gk_up, gla_gk_bias, gla_norm_w, peer_w_q, peer_sub_keys, peer_u, peer_v):
    for l in range(DEPTH):
        h = rms_norm(x, norm_mix[l])
        z = h @ w_in[l]
        z_ret, z_rwkv, z_gla = _split(z, GROUP_SIZES)
        o_ret = retention_mixer(*_split(z_ret, RET_SIZES))
        o_rwkv = rwkv7_mixer(z_rwkv, rwkv_mu[l], rwkv_w_up[l], rwkv_w_bias[l], rwkv_a_up[l], rwkv_a_bias[l],
                             rwkv_g_up[l], rwkv_k_k[l], rwkv_k_a[l], rwkv_r_k[l], rwkv_ln_w[l], rwkv_ln_b[l])
        o_gla = gla_mixer(*_split(z_gla, GLA_SIZES), gla_gk_up[l], gla_gk_bias[l], gla_norm_w[l])
        o = jnp.concatenate([o_ret, o_rwkv, o_gla], axis=-1).astype(x.dtype)
        x = x + o @ w_out[l]
        h = rms_norm(x, norm_ffn[l])
        x = x + peer_ffn(h, peer_w_q[l], peer_sub_keys[l], peer_u[l], peer_v[l])
    return rms_norm(x, norm_final)
```

```cpp
#include <hip/hip_runtime.h>
#include <stdint.h>
#include <stdio.h>

typedef unsigned short bf16_t;
typedef short bf16x8 __attribute__((ext_vector_type(8)));
typedef float f32x4 __attribute__((ext_vector_type(4)));
typedef unsigned u32x4 __attribute__((ext_vector_type(4)));
typedef unsigned u32x2 __attribute__((ext_vector_type(2)));

constexpr int NB = 4, NS = 4096, NT = NB * NS, D = 1024, DIN = 3600, DINP = 3712;
constexpr int ZC_RET = 0, ZC_RW = 1024, ZC_GLA = 2432;
constexpr int RW_F = 1408;
constexpr int NEXP = 16384;
constexpr int NTHREADS = 256;

constexpr size_t MiB = 1024ull * 1024ull;
constexpr size_t WS_CTL   = 0;
constexpr size_t WS_WTIN  = 1 * MiB;
constexpr size_t WS_WTOUT = WS_WTIN + 2ull * DINP * D * 2;
constexpr size_t WS_WTQ   = WS_WTOUT + 2ull * D * D * 2;
constexpr size_t WS_SK    = WS_WTQ + 2ull * 2048 * D * 2;
constexpr size_t WS_UB    = WS_SK + 2ull * 16 * 128 * 128 * 2;
constexpr size_t WS_VB    = WS_UB + 2ull * NEXP * D * 2;
constexpr size_t WS_H     = WS_VB + 2ull * NEXP * D * 2;
constexpr size_t WS_Z     = WS_H + (size_t)NT * D * 2;
constexpr size_t WS_O     = WS_Z + (size_t)NT * DINP * 2;
constexpr size_t WS_MIX   = WS_O + (size_t)NT * D * 2;
constexpr size_t WS_EIDX  = WS_MIX + 128 * MiB;
constexpr size_t WS_GATE  = WS_EIDX + (size_t)NT * 128 * 4;
constexpr size_t WS_END   = WS_GATE + (size_t)NT * 128 * 4;
constexpr size_t RWA = (size_t)NT * 384;
constexpr size_t MX_W   = 0;
constexpr size_t MX_KK  = MX_W + RWA * 4;
constexpr size_t MX_KKA = MX_KK + RWA * 4;
constexpr size_t MX_R   = MX_KKA + RWA * 4;
constexpr size_t MX_K   = MX_R + RWA * 2;
constexpr size_t MX_V   = MX_K + RWA * 2;
constexpr size_t MX_G   = MX_V + RWA * 2;
constexpr size_t MX_END = MX_G + RWA * 2;
static_assert(MX_END <= 128 * MiB, "mix region");

__device__ __forceinline__ float bf2f(bf16_t v) { return __uint_as_float(((unsigned)v) << 16); }
__device__ __forceinline__ bf16_t f2bf(float f) { unsigned u = __float_as_uint(f); u += 0x7FFFu + ((u >> 16) & 1u); return (bf16_t)(u >> 16); }
__device__ __forceinline__ unsigned pk2(float lo, float hi) { return (unsigned)f2bf(lo) | ((unsigned)f2bf(hi) << 16); }
__device__ __forceinline__ float lo_bf(unsigned u) { return __uint_as_float(u << 16); }
__device__ __forceinline__ float hi_bf(unsigned u) { return __uint_as_float(u & 0xFFFF0000u); }
__device__ __forceinline__ float wave_sum(float v) {
#pragma unroll
    for (int o = 32; o >= 1; o >>= 1) v += __shfl_xor(v, o);
    return v;
}
__device__ __forceinline__ unsigned wave_max_u32(unsigned v) {
#pragma unroll
    for (int o = 32; o >= 1; o >>= 1) { unsigned t = (unsigned)__shfl_xor((int)v, o); v = t > v ? t : v; }
    return v;
}
__device__ __forceinline__ float sigmoidf_(float x) { return 1.f / (1.f + __expf(-x)); }
__device__ __forceinline__ float softplusf_(float x) { return fmaxf(x, 0.f) + log1pf(__expf(-fabsf(x))); }

__device__ void transpose_tile(const float* __restrict__ W, int K, int N, bf16_t* __restrict__ Wt, int kt, int nt, float* tile  ) {
    const int tid = threadIdx.x;
    const int k0 = kt * 64, n0 = nt * 64;
#pragma unroll
    for (int i = 0; i < 16; ++i) {
        const int k = i * 4 + (tid >> 6), n = tid & 63;
        tile[k * 65 + n] = (n0 + n < N) ? W[(size_t)(k0 + k) * N + n0 + n] : 0.f;
    }
    __syncthreads();
#pragma unroll
    for (int i = 0; i < 16; ++i) {
        const int n = i * 4 + (tid >> 6), k = tid & 63;
        Wt[(size_t)(n0 + n) * K + k0 + k] = f2bf(tile[k * 65 + n]);
    }
    __syncthreads();
}

struct ConvP {
    const float* w_in; const float* w_out; const float* w_q; const float* sk; const float* u; const float* v;
    unsigned char* ws;
};

__device__ void phase_convert_weights(const ConvP& p, char* smem, int bid, int nblk) {
    float* tile = (float*)smem;
    constexpr int T_IN = 16 * 58, T_OUT = 16 * 16, T_Q = 16 * 32, T_L = T_IN + T_OUT + T_Q;
    for (int it = bid; it < 2 * T_L; it += nblk) {
        const int l = it / T_L; int r = it % T_L;
        if (r < T_IN) { transpose_tile(p.w_in + (size_t)l * D * DIN, D, DIN, (bf16_t*)(p.ws + WS_WTIN) + (size_t)l * DINP * D, r / 58, r % 58, tile); continue; }
        r -= T_IN;
        if (r < T_OUT) { transpose_tile(p.w_out + (size_t)l * D * D, D, D, (bf16_t*)(p.ws + WS_WTOUT) + (size_t)l * D * D, r / 16, r % 16, tile); continue; }
        r -= T_OUT;
        transpose_tile(p.w_q + (size_t)l * D * 2048, D, 2048, (bf16_t*)(p.ws + WS_WTQ) + (size_t)l * 2048 * D, r / 32, r % 32, tile);
    }
    const size_t gtid = (size_t)bid * NTHREADS + threadIdx.x, gn = (size_t)nblk * NTHREADS;
    {
        const size_t n8 = (2ull * 16 * 128 * 128) / 8;
        const f32x4* s = (const f32x4*)p.sk; u32x4* d = (u32x4*)(p.ws + WS_SK);
        for (size_t i = gtid; i < n8; i += gn) { f32x4 a = s[2 * i], b = s[2 * i + 1]; u32x4 o; o.x = pk2(a.x, a.y); o.y = pk2(a.z, a.w); o.z = pk2(b.x, b.y); o.w = pk2(b.z, b.w); d[i] = o; }
    }
    {
        const size_t n8 = (2ull * NEXP * D) / 8;
        const f32x4* s = (const f32x4*)p.u; u32x4* d = (u32x4*)(p.ws + WS_UB);
        for (size_t i = gtid; i < n8; i += gn) { f32x4 a = s[2 * i], b = s[2 * i + 1]; u32x4 o; o.x = pk2(a.x, a.y); o.y = pk2(a.z, a.w); o.z = pk2(b.x, b.y); o.w = pk2(b.z, b.w); d[i] = o; }
        s = (const f32x4*)p.v; d = (u32x4*)(p.ws + WS_VB);
        for (size_t i = gtid; i < n8; i += gn) { f32x4 a = s[2 * i], b = s[2 * i + 1]; u32x4 o; o.x = pk2(a.x, a.y); o.y = pk2(a.z, a.w); o.z = pk2(b.x, b.y); o.w = pk2(b.z, b.w); d[i] = o; }
    }
}

template <bool OUT_F32>
__device__ void phase_rmsnorm(const float* x, const float* __restrict__ g, void* out, int bid, int nblk) {
    const int lane = threadIdx.x & 63, wave = threadIdx.x >> 6;
    const int gw = bid * 4 + wave, ngw = nblk * 4;
    f32x4 gv[4];
#pragma unroll
    for (int j = 0; j < 4; ++j) gv[j] = ((const f32x4*)g)[lane + 64 * j];
    for (int row = gw; row < NT; row += ngw) {
        const f32x4* xr = (const f32x4*)(x + (size_t)row * D) + lane;
        f32x4 v[4]; float s = 0.f;
#pragma unroll
        for (int j = 0; j < 4; ++j) { v[j] = xr[64 * j]; s += v[j].x * v[j].x + v[j].y * v[j].y + v[j].z * v[j].z + v[j].w * v[j].w; }
        s = wave_sum(s);
        const float rs = rsqrtf(s * (1.f / D) + 1e-6f);
        if (OUT_F32) {
            f32x4* o = (f32x4*)((float*)out + (size_t)row * D) + lane;
#pragma unroll
            for (int j = 0; j < 4; ++j) o[64 * j] = v[j] * rs * gv[j];
        } else {
            u32x2* o = (u32x2*)((bf16_t*)out + (size_t)row * D) + lane;
#pragma unroll
            for (int j = 0; j < 4; ++j) { f32x4 y = v[j] * rs * gv[j]; u32x2 w; w.x = pk2(y.x, y.y); w.y = pk2(y.z, y.w); o[64 * j] = w; }
        }
    }
}

struct GemmP {
    const bf16_t* A; int lda; int a_koff;
    const bf16_t* Bt; int ldb; int K;
    int MT, NTl;
    void* C; int ldc; const float* R;
};
constexpr int GS = 72;
template <int MODE>
__device__ void phase_gemm(const GemmP& p, char* smem, int bid, int nblk) {
    bf16_t* As = (bf16_t*)smem;
    bf16_t* Bs = As + 128 * GS;
    const int tid = threadIdx.x, lane = tid & 63, wave = tid >> 6;
    const int wr = wave >> 1, wc = wave & 1;
    const int lr = tid >> 3, lc = (tid & 7) * 8;
    const int fl = lane & 15, fq = lane >> 4;
    const int ntiles = p.MT * p.NTl;
    for (int tile = bid; tile < ntiles; tile += nblk) {
        const int mt = tile / p.NTl, nt = tile % p.NTl;
        const bf16_t* Ag = p.A + (size_t)mt * 128 * p.lda + (size_t)nt * p.a_koff + (size_t)lr * p.lda + lc;
        const bf16_t* Bg = p.Bt + (size_t)nt * 128 * p.ldb + (size_t)lr * p.ldb + lc;
        f32x4 acc[4][4];
#pragma unroll
        for (int m = 0; m < 4; ++m)
#pragma unroll
            for (int n = 0; n < 4; ++n) acc[m][n] = (f32x4){0.f, 0.f, 0.f, 0.f};
        u32x4 ra[4], rb[4];
#pragma unroll
        for (int i = 0; i < 4; ++i) { ra[i] = *(const u32x4*)(Ag + (size_t)(32 * i) * p.lda); rb[i] = *(const u32x4*)(Bg + (size_t)(32 * i) * p.ldb); }
        for (int k0 = 0; k0 < p.K; k0 += 64) {
            __syncthreads();
#pragma unroll
            for (int i = 0; i < 4; ++i) { *(u32x4*)(As + (lr + 32 * i) * GS + lc) = ra[i]; *(u32x4*)(Bs + (lr + 32 * i) * GS + lc) = rb[i]; }
            __syncthreads();
            if (k0 + 64 < p.K) {
#pragma unroll
                for (int i = 0; i < 4; ++i) { ra[i] = *(const u32x4*)(Ag + (size_t)(32 * i) * p.lda + k0 + 64); rb[i] = *(const u32x4*)(Bg + (size_t)(32 * i) * p.ldb + k0 + 64); }
            }
#pragma unroll
            for (int ks = 0; ks < 2; ++ks) {
                bf16x8 xa[4], wb[4];
#pragma unroll
                for (int m = 0; m < 4; ++m) xa[m] = *(const bf16x8*)(As + (wr * 64 + m * 16 + fl) * GS + ks * 32 + fq * 8);
#pragma unroll
                for (int n = 0; n < 4; ++n) wb[n] = *(const bf16x8*)(Bs + (wc * 64 + n * 16 + fl) * GS + ks * 32 + fq * 8);
#pragma unroll
                for (int m = 0; m < 4; ++m)
#pragma unroll
                    for (int n = 0; n < 4; ++n) acc[m][n] = __builtin_amdgcn_mfma_f32_16x16x32_bf16(wb[n], xa[m], acc[m][n], 0, 0, 0);
            }
        }
#pragma unroll
        for (int m = 0; m < 4; ++m) {
            const size_t row = (size_t)mt * 128 + wr * 64 + m * 16 + fl;
#pragma unroll
            for (int n = 0; n < 4; ++n) {
                const int col = nt * 128 + wc * 64 + n * 16 + fq * 4;
                const f32x4 a = acc[m][n];
                if (MODE == 0) { u32x2 w; w.x = pk2(a.x, a.y); w.y = pk2(a.z, a.w); *(u32x2*)((bf16_t*)p.C + row * p.ldc + col) = w; }
                else if (MODE == 1) { *(f32x4*)((float*)p.C + row * p.ldc + col) = a; }
                else { const f32x4 r = *(const f32x4*)(p.R + row * p.ldc + col); *(f32x4*)((float*)p.C + row * p.ldc + col) = r + a; }
            }
        }
    }
}

constexpr int LS = 72;
struct LinP {
    const bf16_t* Z; bf16_t* O;
    const float* gk_up;
    const float* gk_bias;
    const float* norm_w;
};
__device__ __forceinline__ bf16x8 ldfrag(const bf16_t* base, int row, int kofs) { return *(const bf16x8*)(base + row * LS + kofs); }

template <bool IS_GLA>
__device__ void linattn_task(const LinP& p, char* smem, int b, int h) {
    constexpr int DK = IS_GLA ? 48 : 64, DV = IS_GLA ? 96 : 64, NVB = DV / 16;
    const int qoff = IS_GLA ? (ZC_GLA + 0 + h * 48) : (ZC_RET + 0 + h * 64);
    const int koff = IS_GLA ? (ZC_GLA + 192 + h * 48) : (ZC_RET + 256 + h * 64);
    const int voff = IS_GLA ? (ZC_GLA + 384 + h * 96) : (ZC_RET + 512 + h * 64);
    const int goff = IS_GLA ? (ZC_GLA + 784 + h * 96) : (ZC_RET + 768 + h * 64);
    const int gkdoff = ZC_GLA + 768;
    const int ooff = IS_GLA ? (640 + h * 96) : (h * 64);
    bf16_t* Qs = (bf16_t*)smem;
    bf16_t* Ks = Qs + 64 * LS;
    bf16_t* Kts = Ks + 64 * LS;
    bf16_t* Ps = Kts + 64 * LS;
    bf16_t* Vts = Ps + 64 * LS;
    bf16_t* Sts = Vts + 96 * LS;
    float* decs = (float*)(Sts + 96 * LS);
    const int tid = threadIdx.x, lane = tid & 63, wave = tid >> 6;
    const int fl = lane & 15, fq = lane >> 4;
    for (int i = tid; i < (64 * 4 + 96 * 2) * LS / 2; i += NTHREADS) ((unsigned*)smem)[i] = 0u;
    if (tid < 64) decs[tid] = 1.f;
    __syncthreads();
    f32x4 accS[NVB];
#pragma unroll
    for (int vb = 0; vb < NVB; ++vb) accS[vb] = (f32x4){0.f, 0.f, 0.f, 0.f};
    float lg = 0.f;
    if (!IS_GLA) { const float e = exp2f(-5.f - (float)h * (4.f / 3.f)); lg = log1pf(-e); }

    for (int c = 0; c < NS / 64; ++c) {
        const size_t t0 = (size_t)b * NS + (size_t)c * 64;
        if (IS_GLA) {
            for (int x = tid; x < 64 * 6; x += NTHREADS) {
                const int tok = x / 6, ch = x % 6;
                const bf16_t* zr = p.Z + (t0 + tok) * DINP;
                *(u32x4*)(Qs + tok * LS + ch * 8) = *(const u32x4*)(zr + qoff + ch * 8);
                *(u32x4*)(Ks + tok * LS + ch * 8) = *(const u32x4*)(zr + koff + ch * 8);
            }
            for (int x = tid; x < 64 * 12; x += NTHREADS) {
                const int tok = x / 12, ch = x % 12;
                const u32x4 vv = *(const u32x4*)(p.Z + (t0 + tok) * DINP + voff + ch * 8);
                const unsigned w[4] = {vv.x, vv.y, vv.z, vv.w};
#pragma unroll
                for (int e = 0; e < 4; ++e) { Vts[(ch * 8 + 2 * e) * LS + tok] = (bf16_t)(w[e] & 0xFFFFu); Vts[(ch * 8 + 2 * e + 1) * LS + tok] = (bf16_t)(w[e] >> 16); }
            }
        } else {
            const int tok = tid >> 2, cq = tid & 3;
            const bf16_t* zr = p.Z + (t0 + tok) * DINP;
            const float pos = (float)(c * 64 + tok);
            const u32x4 q1 = *(const u32x4*)(zr + qoff + cq * 8), q2 = *(const u32x4*)(zr + qoff + 32 + cq * 8);
            const u32x4 k1 = *(const u32x4*)(zr + koff + cq * 8), k2 = *(const u32x4*)(zr + koff + 32 + cq * 8);
            const unsigned q1w[4] = {q1.x, q1.y, q1.z, q1.w}, q2w[4] = {q2.x, q2.y, q2.z, q2.w};
            const unsigned k1w[4] = {k1.x, k1.y, k1.z, k1.w}, k2w[4] = {k2.x, k2.y, k2.z, k2.w};
            unsigned oq1[4], oq2[4], ok1[4], ok2[4];
#pragma unroll
            for (int e = 0; e < 4; ++e) {
                float cs[2], sn[2];
#pragma unroll
                for (int u = 0; u < 2; ++u) {
                    const int i = cq * 8 + 2 * e + u;
                    const float inv = exp2f(-(float)i * (13.287712379549449f / 32.f));
                    const float ang = pos * inv;
                    sincosf(ang, &sn[u], &cs[u]);
                }
                const float a1l = lo_bf(q1w[e]), a1h = hi_bf(q1w[e]), a2l = lo_bf(q2w[e]), a2h = hi_bf(q2w[e]);
                oq1[e] = pk2(a1l * cs[0] - a2l * sn[0], a1h * cs[1] - a2h * sn[1]);
                oq2[e] = pk2(a1l * sn[0] + a2l * cs[0], a1h * sn[1] + a2h * cs[1]);
                const float b1l = lo_bf(k1w[e]), b1h = hi_bf(k1w[e]), b2l = lo_bf(k2w[e]), b2h = hi_bf(k2w[e]);
                ok1[e] = pk2(b1l * cs[0] - b2l * sn[0], b1h * cs[1] - b2h * sn[1]);
                ok2[e] = pk2(b1l * sn[0] + b2l * cs[0], b1h * sn[1] + b2h * cs[1]);
            }
            *(u32x4*)(Qs + tok * LS + cq * 8) = (u32x4){oq1[0], oq1[1], oq1[2], oq1[3]};
            *(u32x4*)(Qs + tok * LS + 32 + cq * 8) = (u32x4){oq2[0], oq2[1], oq2[2], oq2[3]};
            *(u32x4*)(Ks + tok * LS + cq * 8) = (u32x4){ok1[0], ok1[1], ok1[2], ok1[3]};
            *(u32x4*)(Ks + tok * LS + 32 + cq * 8) = (u32x4){ok2[0], ok2[1], ok2[2], ok2[3]};
            for (int x = tid; x < 64 * 8; x += NTHREADS) {
                const int tk = x >> 3, ch = x & 7;
                const u32x4 vv = *(const u32x4*)(p.Z + (t0 + tk) * DINP + voff + ch * 8);
                const unsigned w[4] = {vv.x, vv.y, vv.z, vv.w};
#pragma unroll
                for (int e = 0; e < 4; ++e) { Vts[(ch * 8 + 2 * e) * LS + tk] = (bf16_t)(w[e] & 0xFFFFu); Vts[(ch * 8 + 2 * e + 1) * LS + tk] = (bf16_t)(w[e] >> 16); }
            }
        }
        __syncthreads();
        if (IS_GLA) {
            float gd[16];
            {
                const bf16_t* zr = p.Z + (t0 + lane) * DINP + gkdoff;
                const u32x4 g0 = *(const u32x4*)zr, g1 = *(const u32x4*)(zr + 8);
                gd[0] = lo_bf(g0.x); gd[1] = hi_bf(g0.x); gd[2] = lo_bf(g0.y); gd[3] = hi_bf(g0.y); gd[4] = lo_bf(g0.z); gd[5] = hi_bf(g0.z); gd[6] = lo_bf(g0.w); gd[7] = hi_bf(g0.w);
                gd[8] = lo_bf(g1.x); gd[9] = hi_bf(g1.x); gd[10] = lo_bf(g1.y); gd[11] = hi_bf(g1.y); gd[12] = lo_bf(g1.z); gd[13] = hi_bf(g1.z); gd[14] = lo_bf(g1.w); gd[15] = hi_bf(g1.w);
            }
            for (int dd = 0; dd < 12; ++dd) {
                const int d = wave * 12 + dd;
                float x = p.gk_bias[h * 48 + d];
#pragma unroll
                for (int i = 0; i < 16; ++i) x += gd[i] * p.gk_up[i * 192 + h * 48 + d];
                float gk = (fminf(x, 0.f) - log1pf(__expf(-fabsf(x)))) * (1.f / 16.f);
                float bc = gk;
#pragma unroll
                for (int o = 1; o < 64; o <<= 1) { const float t = __shfl_up(bc, o); if (lane >= o) bc += t; }
                const float bl = __shfl(bc, 63);
                const float eq = __expf(bc) * 0.14433756729740643f  , ek = __expf(-bc), ek2 = __expf(bl - bc);
                const float qv = bf2f(Qs[lane * LS + d]), kv = bf2f(Ks[lane * LS + d]);
                Qs[lane * LS + d] = f2bf(qv * eq);
                Ks[lane * LS + d] = f2bf(kv * ek);
                Kts[d * LS + lane] = f2bf(kv * ek2);
                if (lane == 0) decs[d] = __expf(bl);
            }
        } else {
            const float fqd = __expf(lg * (float)(lane + 1)), fk = 0.125f * __expf(-lg * (float)(lane + 1)), fk2 = 0.125f * __expf(lg * (float)(63 - lane));
            for (int dd = 0; dd < 16; ++dd) {
                const int d = wave * 16 + dd;
                const float qv = bf2f(Qs[lane * LS + d]), kv = bf2f(Ks[lane * LS + d]);
                Qs[lane * LS + d] = f2bf(qv * fqd);
                Ks[lane * LS + d] = f2bf(kv * fk);
                Kts[d * LS + lane] = f2bf(kv * fk2);
            }
            if (tid < 64) decs[tid] = __expf(lg * 64.f);
        }
        __syncthreads();
#pragma unroll
        for (int jb = 0; jb < 4; ++jb) {
            f32x4 ap = (f32x4){0.f, 0.f, 0.f, 0.f};
#pragma unroll
            for (int ks = 0; ks < 2; ++ks) {
                const bf16x8 a = ldfrag(Ks, 16 * jb + fl, ks * 32 + fq * 8);
                const bf16x8 bq = ldfrag(Qs, 16 * wave + fl, ks * 32 + fq * 8);
                ap = __builtin_amdgcn_mfma_f32_16x16x32_bf16(a, bq, ap, 0, 0, 0);
            }
            const int i = 16 * wave + fl, j0 = 16 * jb + 4 * fq;
            u32x2 w;
            w.x = pk2(j0 + 0 <= i ? ap.x : 0.f, j0 + 1 <= i ? ap.y : 0.f);
            w.y = pk2(j0 + 2 <= i ? ap.z : 0.f, j0 + 3 <= i ? ap.w : 0.f);
            *(u32x2*)(Ps + i * LS + j0) = w;
        }
        __syncthreads();
        {
            f32x4 ao[NVB];
            float ss = 0.f;
#pragma unroll
            for (int vb = 0; vb < NVB; ++vb) {
                f32x4 a4 = (f32x4){0.f, 0.f, 0.f, 0.f};
#pragma unroll
                for (int ks = 0; ks < 2; ++ks) {
                    const bf16x8 a = ldfrag(Vts, 16 * vb + fl, ks * 32 + fq * 8);
                    const bf16x8 bp = ldfrag(Ps, 16 * wave + fl, ks * 32 + fq * 8);
                    a4 = __builtin_amdgcn_mfma_f32_16x16x32_bf16(a, bp, a4, 0, 0, 0);
                }
#pragma unroll
                for (int ks = 0; ks < 2; ++ks) {
                    const bf16x8 a = ldfrag(Sts, 16 * vb + fl, ks * 32 + fq * 8);
                    const bf16x8 bq = ldfrag(Qs, 16 * wave + fl, ks * 32 + fq * 8);
                    a4 = __builtin_amdgcn_mfma_f32_16x16x32_bf16(a, bq, a4, 0, 0, 0);
                }
                ao[vb] = a4;
                ss += a4.x * a4.x + a4.y * a4.y + a4.z * a4.z + a4.w * a4.w;
            }
            ss += __shfl_xor(ss, 16);
            ss += __shfl_xor(ss, 32);
            const float inv = rsqrtf(ss * (1.f / DV) + 1e-5f);
            const size_t t = t0 + 16 * wave + fl;
#pragma unroll
            for (int vb = 0; vb < NVB; ++vb) {
                const int v0 = 16 * vb + 4 * fq;
                const u32x2 gg = *(const u32x2*)(p.Z + t * DINP + goff + v0);
                float g4[4] = {lo_bf(gg.x), hi_bf(gg.x), lo_bf(gg.y), hi_bf(gg.y)};
                float o4[4] = {ao[vb].x, ao[vb].y, ao[vb].z, ao[vb].w};
#pragma unroll
                for (int e = 0; e < 4; ++e) {
                    float y = o4[e] * inv;
                    if (IS_GLA) y *= p.norm_w[h * 96 + v0 + e];
                    const float g = g4[e];
                    o4[e] = y * (g / (1.f + __expf(-g)));
                }
                u32x2 w; w.x = pk2(o4[0], o4[1]); w.y = pk2(o4[2], o4[3]);
                *(u32x2*)(p.O + t * D + ooff + v0) = w;
            }
        }
        {
            f32x4 dc = *(const f32x4*)(decs + 16 * wave + 4 * fq);
#pragma unroll
            for (int vb = 0; vb < NVB; ++vb) {
                f32x4 a4 = accS[vb] * dc;
#pragma unroll
                for (int ks = 0; ks < 2; ++ks) {
                    const bf16x8 a = ldfrag(Kts, 16 * wave + fl, ks * 32 + fq * 8);
                    const bf16x8 bv = ldfrag(Vts, 16 * vb + fl, ks * 32 + fq * 8);
                    a4 = __builtin_amdgcn_mfma_f32_16x16x32_bf16(a, bv, a4, 0, 0, 0);
                }
                accS[vb] = a4;
            }
        }
        __syncthreads();
#pragma unroll
        for (int vb = 0; vb < NVB; ++vb) {
            u32x2 w; w.x = pk2(accS[vb].x, accS[vb].y); w.y = pk2(accS[vb].z, accS[vb].w);
            *(u32x2*)(Sts + (16 * vb + fl) * LS + 16 * wave + 4 * fq) = w;
        }
    }
    __syncthreads();
}

struct RwP {
    const bf16_t* Z; unsigned char* mix;
    const float* mu; const float* w_up; const float* w_bias; const float* a_up; const float* a_bias; const float* g_up;
    const float* k_k; const float* k_a; const float* r_k; const float* ln_w; const float* ln_b;
    float* oraw; bf16_t* O;
};
__device__ void phase_rwkv_prep(const RwP& p, char* smem, int bid, int nblk) {
    float* fs = (float*)smem;
    const int tid = threadIdx.x, lane = tid & 63;
    float* Wd = (float*)(p.mix + MX_W); float* KKd = (float*)(p.mix + MX_KK); float* KKAd = (float*)(p.mix + MX_KKA);
    bf16_t* Rd = (bf16_t*)(p.mix + MX_R); bf16_t* Kd = (bf16_t*)(p.mix + MX_K); bf16_t* Vd = (bf16_t*)(p.mix + MX_V); bf16_t* Gd = (bf16_t*)(p.mix + MX_G);
    for (int it = bid; it < NT / 8; it += nblk) {
        const int t0 = it * 8;
        for (int x = tid; x < 8 * RW_F; x += NTHREADS) {
            const int tok = x / RW_F, c = x % RW_F;
            const int t = t0 + tok;
            const float f = bf2f(p.Z[(size_t)t * DINP + ZC_RW + c]);
            const float fp = ((t & (NS - 1)) == 0) ? 0.f : bf2f(p.Z[(size_t)(t - 1) * DINP + ZC_RW + c]);
            float v = f + (fp - f) * p.mu[c];
            if (c >= 1152 && c < 1216) v = tanhf(v);
            else if (c >= 1280) v = sigmoidf_(v);
            fs[tok * RW_F + c] = v;
        }
        __syncthreads();
        for (int cc = tid; cc < 384; cc += NTHREADS) {
            float aw[8], aa[8], ag[8];
#pragma unroll
            for (int k = 0; k < 8; ++k) { aw[k] = 0.f; aa[k] = 0.f; ag[k] = 0.f; }
            for (int i = 0; i < 64; i += 4) {
                float w1[4], a1[4];
#pragma unroll
                for (int e = 0; e < 4; ++e) { w1[e] = p.w_up[(i + e) * 384 + cc]; a1[e] = p.a_up[(i + e) * 384 + cc]; }
#pragma unroll
                for (int k = 0; k < 8; ++k) {
                    const f32x4 xw = *(const f32x4*)(fs + k * RW_F + 1152 + i), xa = *(const f32x4*)(fs + k * RW_F + 1216 + i);
                    aw[k] += xw.x * w1[0] + xw.y * w1[1] + xw.z * w1[2] + xw.w * w1[3];
                    aa[k] += xa.x * a1[0] + xa.y * a1[1] + xa.z * a1[2] + xa.w * a1[3];
                }
            }
            for (int i = 0; i < 128; i += 4) {
                float g1[4];
#pragma unroll
                for (int e = 0; e < 4; ++e) g1[e] = p.g_up[(i + e) * 384 + cc];
#pragma unroll
                for (int k = 0; k < 8; ++k) {
                    const f32x4 xg = *(const f32x4*)(fs + k * RW_F + 1280 + i);
                    ag[k] += xg.x * g1[0] + xg.y * g1[1] + xg.z * g1[2] + xg.w * g1[3];
                }
            }
            const float wb = p.w_bias[cc], ab = p.a_bias[cc], kkc = p.k_k[cc], kac = p.k_a[cc];
            const int hd = cc >> 6, cl = cc & 63;
#pragma unroll
            for (int k = 0; k < 8; ++k) {
                const int t = t0 + k, b = t >> 12, s = t & (NS - 1);
                const size_t hi = ((size_t)(b * 6 + hd) * NS + s) * 64 + cl;
                const float wl = -softplusf_(-(wb + aw[k])) - 0.5f;
                const float dec = __expf(-__expf(wl));
                const float a = sigmoidf_(ab + aa[k]);
                const float r = fs[k * RW_F + cc], kx = fs[k * RW_F + 384 + cc], vx = fs[k * RW_F + 768 + cc];
                float kk = kx * kkc;
                const float ss = wave_sum(kk * kk);
                kk *= rsqrtf(fmaxf(ss, 1e-24f));
                const float kmod = kx * (1.f + (a - 1.f) * kac);
                Wd[hi] = dec; KKd[hi] = kk; KKAd[hi] = kk * a;
                Rd[hi] = f2bf(r); Kd[hi] = f2bf(kmod); Vd[hi] = f2bf(vx);
                Gd[(size_t)t * 384 + cc] = f2bf(ag[k]);
            }
        }
        __syncthreads();
    }
}

__device__ __forceinline__ float row16_sum(float v) {
    v += __shfl_xor(v, 8); v += __shfl_xor(v, 4); v += __shfl_xor(v, 2); v += __shfl_xor(v, 1);
    return v;
}
constexpr int SC_STEPS = 16;
__device__ void rwkv_scan_task(const RwP& p, char* smem, int bh, int qd) {
    float* buf = (float*)smem;
    float* obuf = buf + 2 * 6 * SC_STEPS * 64;
    const int tid = threadIdx.x, lane = tid & 63, wave = tid >> 6;
    const int rloc = wave * 4 + (lane >> 4);
    const int row = qd * 16 + rloc;
    const int c4 = (lane & 15) * 4;
    const float* Wd = (const float*)(p.mix + MX_W) + (size_t)bh * NS * 64;
    const float* KKd = (const float*)(p.mix + MX_KK) + (size_t)bh * NS * 64;
    const float* KKAd = (const float*)(p.mix + MX_KKA) + (size_t)bh * NS * 64;
    const bf16_t* Rd = (const bf16_t*)(p.mix + MX_R) + (size_t)bh * NS * 64;
    const bf16_t* Kd = (const bf16_t*)(p.mix + MX_K) + (size_t)bh * NS * 64;
    const bf16_t* Vd = (const bf16_t*)(p.mix + MX_V) + (size_t)bh * NS * 64;
    float* orow = p.oraw + (size_t)bh * NS * 64;
    f32x4 S = (f32x4){0.f, 0.f, 0.f, 0.f};
    f32x4 lw, lkk, lka; u32x2 lr, lk, lv;
    auto gload = [&](int ch) {
        const size_t e = (size_t)ch * SC_STEPS * 64 + tid * 4;
        lw = *(const f32x4*)(Wd + e); lkk = *(const f32x4*)(KKd + e); lka = *(const f32x4*)(KKAd + e);
        lr = *(const u32x2*)(Rd + e); lk = *(const u32x2*)(Kd + e); lv = *(const u32x2*)(Vd + e);
    };
    auto lstore = [&](int bsel) {
        float* bb = buf + bsel * 6 * SC_STEPS * 64 + tid * 4;
        *(f32x4*)(bb + 0 * SC_STEPS * 64) = lw; *(f32x4*)(bb + 1 * SC_STEPS * 64) = lkk; *(f32x4*)(bb + 2 * SC_STEPS * 64) = lka;
        *(f32x4*)(bb + 3 * SC_STEPS * 64) = (f32x4){lo_bf(lr.x), hi_bf(lr.x), lo_bf(lr.y), hi_bf(lr.y)};
        *(f32x4*)(bb + 4 * SC_STEPS * 64) = (f32x4){lo_bf(lk.x), hi_bf(lk.x), lo_bf(lk.y), hi_bf(lk.y)};
        *(f32x4*)(bb + 5 * SC_STEPS * 64) = (f32x4){lo_bf(lv.x), hi_bf(lv.x), lo_bf(lv.y), hi_bf(lv.y)};
    };
    __syncthreads();
    gload(0); lstore(0);
    __syncthreads();
    constexpr int NCH = NS / SC_STEPS;
    for (int ch = 0; ch < NCH; ++ch) {
        if (ch + 1 < NCH) gload(ch + 1);
        const float* bb = buf + (ch & 1) * 6 * SC_STEPS * 64;
#pragma unroll 4
        for (int st = 0; st < SC_STEPS; ++st) {
            const f32x4 w4 = *(const f32x4*)(bb + 0 * SC_STEPS * 64 + st * 64 + c4);
            const f32x4 kk4 = *(const f32x4*)(bb + 1 * SC_STEPS * 64 + st * 64 + c4);
            const f32x4 ka4 = *(const f32x4*)(bb + 2 * SC_STEPS * 64 + st * 64 + c4);
            const f32x4 r4 = *(const f32x4*)(bb + 3 * SC_STEPS * 64 + st * 64 + c4);
            const f32x4 k4 = *(const f32x4*)(bb + 4 * SC_STEPS * 64 + st * 64 + c4);
            const float vv = bb[5 * SC_STEPS * 64 + st * 64 + row];
            float pd = S.x * kk4.x + S.y * kk4.y + S.z * kk4.z + S.w * kk4.w;
            const float sa = -row16_sum(pd);
            S.x = S.x * w4.x + vv * k4.x + sa * ka4.x;
            S.y = S.y * w4.y + vv * k4.y + sa * ka4.y;
            S.z = S.z * w4.z + vv * k4.z + sa * ka4.z;
            S.w = S.w * w4.w + vv * k4.w + sa * ka4.w;
            float od = S.x * r4.x + S.y * r4.y + S.z * r4.z + S.w * r4.w;
            od = row16_sum(od);
            if ((lane & 15) == 0) obuf[st * 16 + rloc] = od;
        }
        __syncthreads();
        {
            const int st = tid >> 4, rr = tid & 15;
            orow[((size_t)ch * SC_STEPS + st) * 64 + qd * 16 + rr] = obuf[tid];
        }
        if (ch + 1 < NCH) lstore((ch + 1) & 1);
        __syncthreads();
    }
}

__device__ void phase_rwkv_post(const RwP& p, int bid, int nblk) {
    const int lane = threadIdx.x & 63, wave = threadIdx.x >> 6;
    const bf16_t* Rd = (const bf16_t*)(p.mix + MX_R); const bf16_t* Kd = (const bf16_t*)(p.mix + MX_K); const bf16_t* Vd = (const bf16_t*)(p.mix + MX_V);
    const bf16_t* Gd = (const bf16_t*)(p.mix + MX_G);
    for (int x = bid * 4 + wave; x < NT * 6; x += nblk * 4) {
        const int t = x / 6, hd = x % 6, b = t >> 12, s = t & (NS - 1);
        const size_t hi = ((size_t)(b * 6 + hd) * NS + s) * 64 + lane;
        const float o = p.oraw[hi];
        const float mean = wave_sum(o) * (1.f / 64.f);
        const float dv = o - mean;
        const float var = wave_sum(dv * dv) * (1.f / 64.f);
        float on = dv * rsqrtf(var + 64e-5f) * p.ln_w[hd * 64 + lane] + p.ln_b[hd * 64 + lane];
        const float r = bf2f(Rd[hi]), k = bf2f(Kd[hi]), v = bf2f(Vd[hi]);
        const float rk = wave_sum(r * k * p.r_k[hd * 64 + lane]);
        on += rk * v;
        const float g = bf2f(Gd[(size_t)t * 384 + hd * 64 + lane]);
        p.O[(size_t)t * D + 256 + hd * 64 + lane] = f2bf(on * g);
    }
}

__device__ __forceinline__ unsigned ordkey(float f) { const unsigned u = __float_as_uint(f); return (u & 0x80000000u) ? ~u : (u | 0x80000000u); }
__device__ __forceinline__ void top16_128(float a0, float a1, int lane, float& outv, int& outi) {
    unsigned k0 = (ordkey(a0) & 0xFFFFFF80u) | (unsigned)(127 - lane);
    unsigned k1 = (ordkey(a1) & 0xFFFFFF80u) | (unsigned)(63 - lane);
    outv = 0.f; outi = 0;
    for (int it = 0; it < 16; ++it) {
        const unsigned m = k0 > k1 ? k0 : k1;
        const unsigned wm = wave_max_u32(m);
        const int idx = 127 - (int)(wm & 127u);
        const float cand = (idx >> 6) ? a1 : a0;
        const float val = __shfl(cand, idx & 63);
        if (lane == it) { outv = val; outi = idx; }
        if (k0 == wm) k0 = 0u;
        if (k1 == wm) k1 = 0u;
    }
}
__device__ void phase_topk(const float* SC, int* EIDX, float* GATE, int bid, int nblk) {
    const int lane = threadIdx.x & 63, wave = threadIdx.x >> 6;
    int ci, cj;
    {
        const int c = lane;
        if (c < 16) { ci = 0; cj = c; } else if (c < 24) { ci = 1; cj = c - 16; } else if (c < 29) { ci = 2; cj = c - 24; } else if (c < 33) { ci = 3; cj = c - 29; }
        else if (c < 36) { ci = 4; cj = c - 33; } else if (c < 38) { ci = 5; cj = c - 36; } else if (c < 40) { ci = 6; cj = c - 38; } else if (c < 42) { ci = 7; cj = c - 40; }
        else if (c < 50) { ci = c - 34; cj = 0; } else { ci = 0; cj = 0; }
    }
    for (int x = bid * 4 + wave; x < NT * 8; x += nblk * 4) {
        const int t = x >> 3, hd = x & 7;
        const float* sc = SC + (size_t)t * 2048 + hd * 256;
        float s1, s2; int i1, i2;
        top16_128(sc[lane], sc[64 + lane], lane, s1, i1);
        top16_128(sc[128 + lane], sc[192 + lane], lane, s2, i2);
        const float cv = __shfl(s1, ci) + __shfl(s2, cj);
        const int ce = __shfl(i1, ci) * 128 + __shfl(i2, cj);
        unsigned key = (lane < 50) ? ((ordkey(cv) & 0xFFFFFFC0u) | (unsigned)(63 - lane)) : 0u;
        float tv = 0.f; int te = 0;
        for (int it = 0; it < 16; ++it) {
            const unsigned wm = wave_max_u32(key);
            const int wl = 63 - (int)(wm & 63u);
            const float v = __shfl(cv, wl); const int e = __shfl(ce, wl);
            if (lane == it) { tv = v; te = e; }
            if (key == wm) key = 0u;
        }
        const float mx = __shfl(tv, 0);
        const float ex = (lane < 16) ? __expf(tv - mx) : 0.f;
        const float sum = wave_sum(ex);
        if (lane < 16) { EIDX[(size_t)t * 128 + hd * 16 + lane] = te; GATE[(size_t)t * 128 + hd * 16 + lane] = ex / sum; }
    }
}

__device__ void phase_expert(const bf16_t* H, const bf16_t* Ub, const bf16_t* Vb, const int* EIDX, const float* GATE, float* X, int bid, int nblk) {
    const int lane = threadIdx.x & 63, wave = threadIdx.x >> 6;
    for (int t = bid * 4 + wave; t < NT; t += nblk * 4) {
        float xf[16], acc[16];
        {
            const u32x4 a = *(const u32x4*)(H + (size_t)t * D + lane * 8), b = *(const u32x4*)(H + (size_t)t * D + 512 + lane * 8);
            xf[0] = lo_bf(a.x); xf[1] = hi_bf(a.x); xf[2] = lo_bf(a.y); xf[3] = hi_bf(a.y); xf[4] = lo_bf(a.z); xf[5] = hi_bf(a.z); xf[6] = lo_bf(a.w); xf[7] = hi_bf(a.w);
            xf[8] = lo_bf(b.x); xf[9] = hi_bf(b.x); xf[10] = lo_bf(b.y); xf[11] = hi_bf(b.y); xf[12] = lo_bf(b.z); xf[13] = hi_bf(b.z); xf[14] = lo_bf(b.w); xf[15] = hi_bf(b.w);
        }
#pragma unroll
        for (int i = 0; i < 16; ++i) acc[i] = 0.f;
        for (int e0 = 0; e0 < 128; e0 += 4) {
            float act[4];
#pragma unroll
            for (int j = 0; j < 4; ++j) {
                const int e = EIDX[(size_t)t * 128 + e0 + j];
                const bf16_t* ur = Ub + (size_t)e * D;
                const u32x4 a = *(const u32x4*)(ur + lane * 8), b = *(const u32x4*)(ur + 512 + lane * 8);
                float d = xf[0] * lo_bf(a.x) + xf[1] * hi_bf(a.x) + xf[2] * lo_bf(a.y) + xf[3] * hi_bf(a.y) + xf[4] * lo_bf(a.z) + xf[5] * hi_bf(a.z) + xf[6] * lo_bf(a.w) + xf[7] * hi_bf(a.w)
                        + xf[8] * lo_bf(b.x) + xf[9] * hi_bf(b.x) + xf[10] * lo_bf(b.y) + xf[11] * hi_bf(b.y) + xf[12] * lo_bf(b.z) + xf[13] * hi_bf(b.z) + xf[14] * lo_bf(b.w) + xf[15] * hi_bf(b.w);
                d = wave_sum(d);
                act[j] = 0.5f * d * (1.f + erff(d * 0.7071067811865476f)) * GATE[(size_t)t * 128 + e0 + j];
            }
#pragma unroll
            for (int j = 0; j < 4; ++j) {
                const int e = EIDX[(size_t)t * 128 + e0 + j];
                const bf16_t* vr = Vb + (size_t)e * D;
                const u32x4 a = *(const u32x4*)(vr + lane * 8), b = *(const u32x4*)(vr + 512 + lane * 8);
                const float s = act[j];
                acc[0] += s * lo_bf(a.x); acc[1] += s * hi_bf(a.x); acc[2] += s * lo_bf(a.y); acc[3] += s * hi_bf(a.y);
                acc[4] += s * lo_bf(a.z); acc[5] += s * hi_bf(a.z); acc[6] += s * lo_bf(a.w); acc[7] += s * hi_bf(a.w);
                acc[8] += s * lo_bf(b.x); acc[9] += s * hi_bf(b.x); acc[10] += s * lo_bf(b.y); acc[11] += s * hi_bf(b.y);
                acc[12] += s * lo_bf(b.z); acc[13] += s * hi_bf(b.z); acc[14] += s * lo_bf(b.w); acc[15] += s * hi_bf(b.w);
            }
        }
        f32x4* xr = (f32x4*)(X + (size_t)t * D);
        f32x4 o0 = xr[lane * 2], o1 = xr[lane * 2 + 1], o2 = xr[128 + lane * 2], o3 = xr[128 + lane * 2 + 1];
        o0 += (f32x4){acc[0], acc[1], acc[2], acc[3]}; o1 += (f32x4){acc[4], acc[5], acc[6], acc[7]};
        o2 += (f32x4){acc[8], acc[9], acc[10], acc[11]}; o3 += (f32x4){acc[12], acc[13], acc[14], acc[15]};
        xr[lane * 2] = o0; xr[lane * 2 + 1] = o1; xr[128 + lane * 2] = o2; xr[128 + lane * 2 + 1] = o3;
    }
}

struct Params {
    const float* in[24];
    float* out; unsigned char* ws;
    int layer; int pad;
};
constexpr int LDS_BYTES = 65536;

__global__ void __launch_bounds__(NTHREADS) k_convert(Params P) {
    __shared__ __attribute__((aligned(16))) char smem[LDS_BYTES];
    ConvP c{P.in[4], P.in[5], P.in[20], P.in[21], P.in[22], P.in[23], P.ws};
    phase_convert_weights(c, smem, blockIdx.x, gridDim.x);
}
__global__ void __launch_bounds__(NTHREADS) k_rmsnorm(Params P, int which) {
    const int l = P.layer;
    if (which == 0) phase_rmsnorm<false>(l == 0 ? P.in[0] : P.out, P.in[1] + l * D, P.ws + WS_H, blockIdx.x, gridDim.x);
    else if (which == 1) phase_rmsnorm<false>(P.out, P.in[2] + l * D, P.ws + WS_H, blockIdx.x, gridDim.x);
    else phase_rmsnorm<true>(P.out, P.in[3], P.out, blockIdx.x, gridDim.x);
}
__global__ void __launch_bounds__(NTHREADS) k_gemm(Params P, int which) {
    __shared__ __attribute__((aligned(16))) char smem[LDS_BYTES];
    const int l = P.layer;
    GemmP g;
    if (which == 0) {
        g = GemmP{(const bf16_t*)(P.ws + WS_H), D, 0, (const bf16_t*)(P.ws + WS_WTIN) + (size_t)l * DINP * D, D, D, NT / 128, DINP / 128, P.ws + WS_Z, DINP, nullptr};
        phase_gemm<0>(g, smem, blockIdx.x, gridDim.x);
    } else if (which == 1) {
        g = GemmP{(const bf16_t*)(P.ws + WS_O), D, 0, (const bf16_t*)(P.ws + WS_WTOUT) + (size_t)l * D * D, D, D, NT / 128, D / 128, P.out, D, l == 0 ? P.in[0] : P.out};
        phase_gemm<2>(g, smem, blockIdx.x, gridDim.x);
    } else if (which == 2) {
        g = GemmP{(const bf16_t*)(P.ws + WS_H), D, 0, (const bf16_t*)(P.ws + WS_WTQ) + (size_t)l * 2048 * D, D, D, NT / 128, 2048 / 128, P.ws + WS_Z, 2048, nullptr};
        phase_gemm<0>(g, smem, blockIdx.x, gridDim.x);
    } else {
        g = GemmP{(const bf16_t*)(P.ws + WS_Z), 2048, 128, (const bf16_t*)(P.ws + WS_SK) + (size_t)l * 16 * 128 * 128, 128, 128, NT / 128, 16, P.ws + WS_MIX, 2048, nullptr};
        phase_gemm<1>(g, smem, blockIdx.x, gridDim.x);
    }
}
__device__ __forceinline__ RwP make_rwp(const Params& P) {
    const int l = P.layer;
    RwP r;
    r.Z = (const bf16_t*)(P.ws + WS_Z); r.mix = P.ws + WS_MIX;
    r.mu = P.in[6] + l * RW_F; r.w_up = P.in[7] + (size_t)l * 64 * 384; r.w_bias = P.in[8] + l * 384; r.a_up = P.in[9] + (size_t)l * 64 * 384; r.a_bias = P.in[10] + l * 384;
    r.g_up = P.in[11] + (size_t)l * 128 * 384; r.k_k = P.in[12] + l * 384; r.k_a = P.in[13] + l * 384; r.r_k = P.in[14] + l * 384; r.ln_w = P.in[15] + l * 384; r.ln_b = P.in[16] + l * 384;
    r.oraw = (float*)(P.ws + WS_H); r.O = (bf16_t*)(P.ws + WS_O);
    return r;
}
__global__ void __launch_bounds__(NTHREADS) k_linattn(Params P) {
    __shared__ __attribute__((aligned(16))) char smem[LDS_BYTES];
    const int l = P.layer;
    LinP lp{(const bf16_t*)(P.ws + WS_Z), (bf16_t*)(P.ws + WS_O), P.in[17] + (size_t)l * 16 * 192, P.in[18] + l * 192, P.in[19] + l * 384};
    const int task = blockIdx.x;
    if (task < 16) linattn_task<false>(lp, smem, task >> 2, task & 3);
    else linattn_task<true>(lp, smem, (task - 16) >> 2, (task - 16) & 3);
}
__global__ void __launch_bounds__(NTHREADS) k_rwkv_prep(Params P) {
    __shared__ __attribute__((aligned(16))) char smem[LDS_BYTES];
    RwP r = make_rwp(P);
    phase_rwkv_prep(r, smem, blockIdx.x, gridDim.x);
}
__global__ void __launch_bounds__(NTHREADS) k_rwkv_scan(Params P) {
    __shared__ __attribute__((aligned(16))) char smem[LDS_BYTES];
    RwP r = make_rwp(P);
    rwkv_scan_task(r, smem, blockIdx.x >> 2, blockIdx.x & 3);
}
__global__ void __launch_bounds__(NTHREADS) k_rwkv_post(Params P) {
    RwP r = make_rwp(P);
    phase_rwkv_post(r, blockIdx.x, gridDim.x);
}
__global__ void __launch_bounds__(NTHREADS) k_topk(Params P) {
    phase_topk((const float*)(P.ws + WS_MIX), (int*)(P.ws + WS_EIDX), (float*)(P.ws + WS_GATE), blockIdx.x, gridDim.x);
}
__global__ void __launch_bounds__(NTHREADS) k_expert(Params P) {
    const int l = P.layer;
    phase_expert((const bf16_t*)(P.ws + WS_H), (const bf16_t*)(P.ws + WS_UB) + (size_t)l * NEXP * D, (const bf16_t*)(P.ws + WS_VB) + (size_t)l * NEXP * D,
                 (const int*)(P.ws + WS_EIDX), (const float*)(P.ws + WS_GATE), P.out, blockIdx.x, gridDim.x);
}

extern "C" void kernel_launch(void* const* d_in, const int* in_sizes, int n_in, void* d_out, int out_size, void* d_ws, size_t ws_size, hipStream_t stream) {
    if (n_in != 24 || ws_size < WS_END) { fprintf(stderr, "kernel_launch: bad args n_in=%d ws=%zu need=%zu\n", n_in, ws_size, (size_t)WS_END); return; }
    Params P{};
    for (int i = 0; i < 24; ++i) P.in[i] = (const float*)d_in[i];
    P.out = (float*)d_out; P.ws = (unsigned char*)d_ws; P.layer = 0; P.pad = 0;
    const int G = 1024;
    hipLaunchKernelGGL(k_convert, dim3(G), dim3(NTHREADS), 0, stream, P);
    for (int l = 0; l < 2; ++l) {
        P.layer = l;
        hipLaunchKernelGGL(k_rmsnorm, dim3(G), dim3(NTHREADS), 0, stream, P, 0);
        hipLaunchKernelGGL(k_gemm, dim3(G), dim3(NTHREADS), 0, stream, P, 0);
        hipLaunchKernelGGL(k_linattn, dim3(32), dim3(NTHREADS), 0, stream, P);
        hipLaunchKernelGGL(k_rwkv_prep, dim3(G), dim3(NTHREADS), 0, stream, P);
        hipLaunchKernelGGL(k_rwkv_scan, dim3(96), dim3(NTHREADS), 0, stream, P);
        hipLaunchKernelGGL(k_rwkv_post, dim3(G), dim3(NTHREADS), 0, stream, P);
        hipLaunchKernelGGL(k_gemm, dim3(G), dim3(NTHREADS), 0, stream, P, 1);
        hipLaunchKernelGGL(k_rmsnorm, dim3(G), dim3(NTHREADS), 0, stream, P, 1);
        hipLaunchKernelGGL(k_gemm, dim3(G), dim3(NTHREADS), 0, stream, P, 2);
        hipLaunchKernelGGL(k_gemm, dim3(G), dim3(NTHREADS), 0, stream, P, 3);
        hipLaunchKernelGGL(k_topk, dim3(G), dim3(NTHREADS), 0, stream, P);
        hipLaunchKernelGGL(k_expert, dim3(G), dim3(NTHREADS), 0, stream, P);
    }
    hipLaunchKernelGGL(k_rmsnorm, dim3(G), dim3(NTHREADS), 0, stream, P, 2);
}
```

```cpp
#include <hip/hip_runtime.h>
#include <stdint.h>
#include <stdio.h>

typedef unsigned short bf16_t;
typedef short bf16x8 __attribute__((ext_vector_type(8)));
typedef float f32x4 __attribute__((ext_vector_type(4)));
typedef unsigned u32x4 __attribute__((ext_vector_type(4)));
typedef unsigned u32x2 __attribute__((ext_vector_type(2)));

constexpr int NB = 4, NS = 4096, NT = NB * NS, D = 1024, DIN = 3600, DINP = 3712;
constexpr int ZC_RET = 0, ZC_RW = 1024, ZC_GLA = 2432;
constexpr int RW_F = 1408;
constexpr int NEXP = 16384;
constexpr int NTHREADS = 256;

constexpr size_t MiB = 1024ull * 1024ull;
constexpr size_t WS_CTL   = 0;
constexpr size_t WS_WTIN  = 1 * MiB;
constexpr size_t WS_WTOUT = WS_WTIN + 2ull * DINP * D * 2;
constexpr size_t WS_WTQ   = WS_WTOUT + 2ull * D * D * 2;
constexpr size_t WS_SK    = WS_WTQ + 2ull * 2048 * D * 2;
constexpr size_t WS_UB    = WS_SK + 2ull * 16 * 128 * 128 * 2;
constexpr size_t WS_VB    = WS_UB + 2ull * NEXP * D * 2;
constexpr size_t WS_H     = WS_VB + 2ull * NEXP * D * 2;
constexpr size_t WS_Z     = WS_H + (size_t)NT * D * 2;
constexpr size_t WS_O     = WS_Z + (size_t)NT * DINP * 2;
constexpr size_t WS_MIX   = WS_O + (size_t)NT * D * 2;
constexpr size_t WS_EIDX  = WS_MIX + 128 * MiB;
constexpr size_t WS_GATE  = WS_EIDX + (size_t)NT * 128 * 4;
constexpr size_t WS_ROPE  = WS_GATE + (size_t)NT * 128 * 4;
constexpr size_t WS_END   = WS_ROPE + 1 * MiB;
constexpr size_t RWA = (size_t)NT * 384;
constexpr size_t MX_W   = 0;
constexpr size_t MX_KK  = MX_W + RWA * 4;
constexpr size_t MX_KKA = MX_KK + RWA * 4;
constexpr size_t MX_R   = MX_KKA + RWA * 4;
constexpr size_t MX_K   = MX_R + RWA * 2;
constexpr size_t MX_V   = MX_K + RWA * 2;
constexpr size_t MX_G   = MX_V + RWA * 2;
constexpr size_t MX_END = MX_G + RWA * 2;
static_assert(MX_END <= 128 * MiB, "mix region");

__device__ __forceinline__ float bf2f(bf16_t v) { return __uint_as_float(((unsigned)v) << 16); }
__device__ __forceinline__ bf16_t f2bf(float f) { unsigned u = __float_as_uint(f); u += 0x7FFFu + ((u >> 16) & 1u); return (bf16_t)(u >> 16); }
__device__ __forceinline__ unsigned pk2(float lo, float hi) { return (unsigned)f2bf(lo) | ((unsigned)f2bf(hi) << 16); }
__device__ __forceinline__ float lo_bf(unsigned u) { return __uint_as_float(u << 16); }
__device__ __forceinline__ float hi_bf(unsigned u) { return __uint_as_float(u & 0xFFFF0000u); }
__device__ __forceinline__ float wave_sum(float v) {
#pragma unroll
    for (int o = 32; o >= 1; o >>= 1) v += __shfl_xor(v, o);
    return v;
}
__device__ __forceinline__ unsigned wave_max_u32(unsigned v) {
#pragma unroll
    for (int o = 32; o >= 1; o >>= 1) { unsigned t = (unsigned)__shfl_xor((int)v, o); v = t > v ? t : v; }
    return v;
}
__device__ __forceinline__ float sigmoidf_(float x) { return 1.f / (1.f + __expf(-x)); }
__device__ __forceinline__ float softplusf_(float x) { return fmaxf(x, 0.f) + log1pf(__expf(-fabsf(x))); }

__device__ __forceinline__ int otid() { int t = threadIdx.x; asm volatile("" : "+v"(t)); return t; }

__device__ void transpose_tile(const float* __restrict__ W, int K, int N, bf16_t* __restrict__ Wt, int kt, int nt, float* tile  ) {
    const int tid = otid();
    const int k0 = kt * 64, n0 = nt * 64;
#pragma unroll
    for (int i = 0; i < 16; ++i) {
        const int k = i * 4 + (tid >> 6), n = tid & 63;
        tile[k * 65 + n] = (n0 + n < N) ? W[(size_t)(k0 + k) * N + n0 + n] : 0.f;
    }
    __syncthreads();
#pragma unroll
    for (int i = 0; i < 16; ++i) {
        const int n = i * 4 + (tid >> 6), k = tid & 63;
        Wt[(size_t)(n0 + n) * K + k0 + k] = f2bf(tile[k * 65 + n]);
    }
    __syncthreads();
}

struct ConvP {
    const float* w_in; const float* w_out; const float* w_q; const float* sk; const float* u; const float* v;
    unsigned char* ws;
};

__device__ void phase_convert_weights(const ConvP& p, char* smem, int bid, int nblk) {
    float* tile = (float*)smem;
    constexpr int T_IN = 16 * 58, T_OUT = 16 * 16, T_Q = 16 * 32, T_L = T_IN + T_OUT + T_Q;
    for (int it = bid; it < 2 * T_L; it += nblk) {
        const int l = it / T_L; int r = it % T_L;
        if (r < T_IN) { transpose_tile(p.w_in + (size_t)l * D * DIN, D, DIN, (bf16_t*)(p.ws + WS_WTIN) + (size_t)l * DINP * D, r / 58, r % 58, tile); continue; }
        r -= T_IN;
        if (r < T_OUT) { transpose_tile(p.w_out + (size_t)l * D * D, D, D, (bf16_t*)(p.ws + WS_WTOUT) + (size_t)l * D * D, r / 16, r % 16, tile); continue; }
        r -= T_OUT;
        transpose_tile(p.w_q + (size_t)l * D * 2048, D, 2048, (bf16_t*)(p.ws + WS_WTQ) + (size_t)l * 2048 * D, r / 32, r % 32, tile);
    }
    const size_t gtid = (size_t)bid * NTHREADS + otid(), gn = (size_t)nblk * NTHREADS;
    {
        float* ct = (float*)(p.ws + WS_ROPE); float* stb = ct + NS * 32;
        for (size_t i = gtid; i < (size_t)NS * 32; i += gn) {
            const int pos = (int)(i >> 5), fi = (int)(i & 31);
            const float inv = exp2f(-(float)fi * (13.287712379549449f / 32.f));
            float sn, cs; sincosf((float)pos * inv, &sn, &cs);
            ct[i] = cs; stb[i] = sn;
        }
    }
    {
        const size_t n8 = (2ull * 16 * 128 * 128) / 8;
        const f32x4* s = (const f32x4*)p.sk; u32x4* d = (u32x4*)(p.ws + WS_SK);
        for (size_t i = gtid; i < n8; i += gn) { f32x4 a = s[2 * i], b = s[2 * i + 1]; u32x4 o; o.x = pk2(a.x, a.y); o.y = pk2(a.z, a.w); o.z = pk2(b.x, b.y); o.w = pk2(b.z, b.w); d[i] = o; }
    }
    {
        const size_t n8 = (2ull * NEXP * D) / 8;
        const f32x4* s = (const f32x4*)p.u; u32x4* d = (u32x4*)(p.ws + WS_UB);
        for (size_t i = gtid; i < n8; i += gn) { f32x4 a = s[2 * i], b = s[2 * i + 1]; u32x4 o; o.x = pk2(a.x, a.y); o.y = pk2(a.z, a.w); o.z = pk2(b.x, b.y); o.w = pk2(b.z, b.w); d[i] = o; }
        s = (const f32x4*)p.v; d = (u32x4*)(p.ws + WS_VB);
        for (size_t i = gtid; i < n8; i += gn) { f32x4 a = s[2 * i], b = s[2 * i + 1]; u32x4 o; o.x = pk2(a.x, a.y); o.y = pk2(a.z, a.w); o.z = pk2(b.x, b.y); o.w = pk2(b.z, b.w); d[i] = o; }
    }
}

template <bool OUT_F32>
__device__ void phase_rmsnorm(const float* x, const float* __restrict__ g, void* out, int bid, int nblk) {
    const int lane = otid() & 63, wave = otid() >> 6;
    const int gw = bid * 4 + wave, ngw = nblk * 4;
    f32x4 gv[4];
#pragma unroll
    for (int j = 0; j < 4; ++j) gv[j] = ((const f32x4*)g)[lane + 64 * j];
    for (int row = gw; row < NT; row += ngw) {
        const f32x4* xr = (const f32x4*)(x + (size_t)row * D) + lane;
        f32x4 v[4]; float s = 0.f;
#pragma unroll
        for (int j = 0; j < 4; ++j) { v[j] = xr[64 * j]; s += v[j].x * v[j].x + v[j].y * v[j].y + v[j].z * v[j].z + v[j].w * v[j].w; }
        s = wave_sum(s);
        const float rs = rsqrtf(s * (1.f / D) + 1e-6f);
        if (OUT_F32) {
            f32x4* o = (f32x4*)((float*)out + (size_t)row * D) + lane;
#pragma unroll
            for (int j = 0; j < 4; ++j) o[64 * j] = v[j] * rs * gv[j];
        } else {
            u32x2* o = (u32x2*)((bf16_t*)out + (size_t)row * D) + lane;
#pragma unroll
            for (int j = 0; j < 4; ++j) { f32x4 y = v[j] * rs * gv[j]; u32x2 w; w.x = pk2(y.x, y.y); w.y = pk2(y.z, y.w); o[64 * j] = w; }
        }
    }
}

struct GemmP {
    const bf16_t* A; int lda; int a_koff;
    const bf16_t* Bt; int ldb; int K;
    int MT, NTl;
    void* C; int ldc; const float* R;
};
constexpr int GS = 72;
template <int MODE>
__device__ void phase_gemm(const GemmP& p, char* smem, int bid, int nblk) {
    bf16_t* As = (bf16_t*)smem;
    bf16_t* Bs = As + 128 * GS;
    const int tid = otid(), lane = tid & 63, wave = tid >> 6;
    const int wr = wave >> 1, wc = wave & 1;
    const int lr = tid >> 3, lc = (tid & 7) * 8;
    const int fl = lane & 15, fq = lane >> 4;
    const int ntiles = p.MT * p.NTl;
    for (int tile = bid; tile < ntiles; tile += nblk) {
        const int mt = tile / p.NTl, nt = tile % p.NTl;
        const bf16_t* Ag = p.A + (size_t)mt * 128 * p.lda + (size_t)nt * p.a_koff + (size_t)lr * p.lda + lc;
        const bf16_t* Bg = p.Bt + (size_t)nt * 128 * p.ldb + (size_t)lr * p.ldb + lc;
        f32x4 acc[4][4];
#pragma unroll
        for (int m = 0; m < 4; ++m)
#pragma unroll
            for (int n = 0; n < 4; ++n) acc[m][n] = (f32x4){0.f, 0.f, 0.f, 0.f};
        u32x4 ra[4], rb[4];
#pragma unroll
        for (int i = 0; i < 4; ++i) { ra[i] = *(const u32x4*)(Ag + (size_t)(32 * i) * p.lda); rb[i] = *(const u32x4*)(Bg + (size_t)(32 * i) * p.ldb); }
        for (int k0 = 0; k0 < p.K; k0 += 64) {
            __syncthreads();
#pragma unroll
            for (int i = 0; i < 4; ++i) { *(u32x4*)(As + (lr + 32 * i) * GS + lc) = ra[i]; *(u32x4*)(Bs + (lr + 32 * i) * GS + lc) = rb[i]; }
            __syncthreads();
            if (k0 + 64 < p.K) {
#pragma unroll
                for (int i = 0; i < 4; ++i) { ra[i] = *(const u32x4*)(Ag + (size_t)(32 * i) * p.lda + k0 + 64); rb[i] = *(const u32x4*)(Bg + (size_t)(32 * i) * p.ldb + k0 + 64); }
            }
#pragma unroll
            for (int ks = 0; ks < 2; ++ks) {
                bf16x8 xa[4], wb[4];
#pragma unroll
                for (int m = 0; m < 4; ++m) xa[m] = *(const bf16x8*)(As + (wr * 64 + m * 16 + fl) * GS + ks * 32 + fq * 8);
#pragma unroll
                for (int n = 0; n < 4; ++n) wb[n] = *(const bf16x8*)(Bs + (wc * 64 + n * 16 + fl) * GS + ks * 32 + fq * 8);
#pragma unroll
                for (int m = 0; m < 4; ++m)
#pragma unroll
                    for (int n = 0; n < 4; ++n) acc[m][n] = __builtin_amdgcn_mfma_f32_16x16x32_bf16(wb[n], xa[m], acc[m][n], 0, 0, 0);
            }
        }
#pragma unroll
        for (int m = 0; m < 4; ++m) {
            const size_t row = (size_t)mt * 128 + wr * 64 + m * 16 + fl;
#pragma unroll
            for (int n = 0; n < 4; ++n) {
                const int col = nt * 128 + wc * 64 + n * 16 + fq * 4;
                const f32x4 a = acc[m][n];
                if (MODE == 0) { u32x2 w; w.x = pk2(a.x, a.y); w.y = pk2(a.z, a.w); *(u32x2*)((bf16_t*)p.C + row * p.ldc + col) = w; }
                else if (MODE == 1) { *(f32x4*)((float*)p.C + row * p.ldc + col) = a; }
                else { const f32x4 r = *(const f32x4*)(p.R + row * p.ldc + col); *(f32x4*)((float*)p.C + row * p.ldc + col) = r + a; }
            }
        }
    }
}

constexpr int LS = 72;
struct LinP {
    const bf16_t* Z; bf16_t* O;
    const float* gk_up;
    const float* gk_bias;
    const float* norm_w;
    const float* rope;
};
__device__ __forceinline__ bf16x8 ldfrag(const bf16_t* base, int row, int kofs) { return *(const bf16x8*)(base + row * LS + kofs); }

template <bool IS_GLA>
__device__ void linattn_task(const LinP& p, char* smem, int b, int h) {
    constexpr int DK = IS_GLA ? 48 : 64, DV = IS_GLA ? 96 : 64, NVB = DV / 16;
    const int qoff = IS_GLA ? (ZC_GLA + 0 + h * 48) : (ZC_RET + 0 + h * 64);
    const int koff = IS_GLA ? (ZC_GLA + 192 + h * 48) : (ZC_RET + 256 + h * 64);
    const int voff = IS_GLA ? (ZC_GLA + 384 + h * 96) : (ZC_RET + 512 + h * 64);
    const int goff = IS_GLA ? (ZC_GLA + 784 + h * 96) : (ZC_RET + 768 + h * 64);
    const int gkdoff = ZC_GLA + 768;
    const int ooff = IS_GLA ? (640 + h * 96) : (h * 64);
    bf16_t* Qs = (bf16_t*)smem;
    bf16_t* Ks = Qs + 64 * LS;
    bf16_t* Kts = Ks + 64 * LS;
    bf16_t* Ps = Kts + 64 * LS;
    bf16_t* Vts = Ps + 64 * LS;
    bf16_t* Sts = Vts + 96 * LS;
    float* decs = (float*)(Sts + 96 * LS);
    const int tid = otid(), lane = tid & 63, wave = tid >> 6;
    const int fl = lane & 15, fq = lane >> 4;
    for (int i = tid; i < (64 * 4 + 96 * 2) * LS / 2; i += NTHREADS) ((unsigned*)smem)[i] = 0u;
    if (tid < 64) decs[tid] = 1.f;
    __syncthreads();
    f32x4 accS[NVB];
#pragma unroll
    for (int vb = 0; vb < NVB; ++vb) accS[vb] = (f32x4){0.f, 0.f, 0.f, 0.f};
    float lg = 0.f;
    if (!IS_GLA) { const float e = exp2f(-5.f - (float)h * (4.f / 3.f)); lg = log1pf(-e); }

    for (int c = 0; c < NS / 64; ++c) {
        const size_t t0 = (size_t)b * NS + (size_t)c * 64;
        if (IS_GLA) {
            for (int x = tid; x < 64 * 6; x += NTHREADS) {
                const int tok = x / 6, ch = x % 6;
                const bf16_t* zr = p.Z + (t0 + tok) * DINP;
                *(u32x4*)(Qs + tok * LS + ch * 8) = *(const u32x4*)(zr + qoff + ch * 8);
                *(u32x4*)(Ks + tok * LS + ch * 8) = *(const u32x4*)(zr + koff + ch * 8);
            }
            for (int x = tid; x < 64 * 12; x += NTHREADS) {
                const int tok = x / 12, ch = x % 12;
                const u32x4 vv = *(const u32x4*)(p.Z + (t0 + tok) * DINP + voff + ch * 8);
                const unsigned w[4] = {vv.x, vv.y, vv.z, vv.w};
#pragma unroll
                for (int e = 0; e < 4; ++e) { Vts[(ch * 8 + 2 * e) * LS + tok] = (bf16_t)(w[e] & 0xFFFFu); Vts[(ch * 8 + 2 * e + 1) * LS + tok] = (bf16_t)(w[e] >> 16); }
            }
        } else {
            const int tok = tid >> 2, cq = tid & 3;
            const bf16_t* zr = p.Z + (t0 + tok) * DINP;
            const u32x4 q1 = *(const u32x4*)(zr + qoff + cq * 8), q2 = *(const u32x4*)(zr + qoff + 32 + cq * 8);
            const u32x4 k1 = *(const u32x4*)(zr + koff + cq * 8), k2 = *(const u32x4*)(zr + koff + 32 + cq * 8);
            const unsigned q1w[4] = {q1.x, q1.y, q1.z, q1.w}, q2w[4] = {q2.x, q2.y, q2.z, q2.w};
            const unsigned k1w[4] = {k1.x, k1.y, k1.z, k1.w}, k2w[4] = {k2.x, k2.y, k2.z, k2.w};
            unsigned oq1[4], oq2[4], ok1[4], ok2[4];
            const int spos = c * 64 + tok;
            const f32x4 c0 = *(const f32x4*)(p.rope + spos * 32 + cq * 8), c1 = *(const f32x4*)(p.rope + spos * 32 + cq * 8 + 4);
            const f32x4 s0 = *(const f32x4*)(p.rope + NS * 32 + spos * 32 + cq * 8), s1 = *(const f32x4*)(p.rope + NS * 32 + spos * 32 + cq * 8 + 4);
            const float csv[8] = {c0.x, c0.y, c0.z, c0.w, c1.x, c1.y, c1.z, c1.w}, snv[8] = {s0.x, s0.y, s0.z, s0.w, s1.x, s1.y, s1.z, s1.w};
#pragma unroll
            for (int e = 0; e < 4; ++e) {
                const float cs[2] = {csv[2 * e], csv[2 * e + 1]}, sn[2] = {snv[2 * e], snv[2 * e + 1]};
                const float a1l = lo_bf(q1w[e]), a1h = hi_bf(q1w[e]), a2l = lo_bf(q2w[e]), a2h = hi_bf(q2w[e]);
                oq1[e] = pk2(a1l * cs[0] - a2l * sn[0], a1h * cs[1] - a2h * sn[1]);
                oq2[e] = pk2(a1l * sn[0] + a2l * cs[0], a1h * sn[1] + a2h * cs[1]);
                const float b1l = lo_bf(k1w[e]), b1h = hi_bf(k1w[e]), b2l = lo_bf(k2w[e]), b2h = hi_bf(k2w[e]);
                ok1[e] = pk2(b1l * cs[0] - b2l * sn[0], b1h * cs[1] - b2h * sn[1]);
                ok2[e] = pk2(b1l * sn[0] + b2l * cs[0], b1h * sn[1] + b2h * cs[1]);
            }
            *(u32x4*)(Qs + tok * LS + cq * 8) = (u32x4){oq1[0], oq1[1], oq1[2], oq1[3]};
            *(u32x4*)(Qs + tok * LS + 32 + cq * 8) = (u32x4){oq2[0], oq2[1], oq2[2], oq2[3]};
            *(u32x4*)(Ks + tok * LS + cq * 8) = (u32x4){ok1[0], ok1[1], ok1[2], ok1[3]};
            *(u32x4*)(Ks + tok * LS + 32 + cq * 8) = (u32x4){ok2[0], ok2[1], ok2[2], ok2[3]};
            for (int x = tid; x < 64 * 8; x += NTHREADS) {
                const int tk = x >> 3, ch = x & 7;
                const u32x4 vv = *(const u32x4*)(p.Z + (t0 + tk) * DINP + voff + ch * 8);
                const unsigned w[4] = {vv.x, vv.y, vv.z, vv.w};
#pragma unroll
                for (int e = 0; e < 4; ++e) { Vts[(ch * 8 + 2 * e) * LS + tk] = (bf16_t)(w[e] & 0xFFFFu); Vts[(ch * 8 + 2 * e + 1) * LS + tk] = (bf16_t)(w[e] >> 16); }
            }
        }
        __syncthreads();
        if (IS_GLA) {
            float gd[16];
            {
                const bf16_t* zr = p.Z + (t0 + lane) * DINP + gkdoff;
                const u32x4 g0 = *(const u32x4*)zr, g1 = *(const u32x4*)(zr + 8);
                gd[0] = lo_bf(g0.x); gd[1] = hi_bf(g0.x); gd[2] = lo_bf(g0.y); gd[3] = hi_bf(g0.y); gd[4] = lo_bf(g0.z); gd[5] = hi_bf(g0.z); gd[6] = lo_bf(g0.w); gd[7] = hi_bf(g0.w);
                gd[8] = lo_bf(g1.x); gd[9] = hi_bf(g1.x); gd[10] = lo_bf(g1.y); gd[11] = hi_bf(g1.y); gd[12] = lo_bf(g1.z); gd[13] = hi_bf(g1.z); gd[14] = lo_bf(g1.w); gd[15] = hi_bf(g1.w);
            }
#pragma unroll 1
            for (int dd = 0; dd < 12; ++dd) {
                const int d = wave * 12 + dd;
                float x = p.gk_bias[h * 48 + d];
#pragma unroll
                for (int i = 0; i < 16; ++i) x += gd[i] * p.gk_up[i * 192 + h * 48 + d];
                float gk = (fminf(x, 0.f) - log1pf(__expf(-fabsf(x)))) * (1.f / 16.f);
                float bc = gk;
#pragma unroll
                for (int o = 1; o < 64; o <<= 1) { const float t = __shfl_up(bc, o); if (lane >= o) bc += t; }
                const float bl = __shfl(bc, 63);
                const float eq = __expf(bc) * 0.14433756729740643f  , ek = __expf(-bc), ek2 = __expf(bl - bc);
                const float qv = bf2f(Qs[lane * LS + d]), kv = bf2f(Ks[lane * LS + d]);
                Qs[lane * LS + d] = f2bf(qv * eq);
                Ks[lane * LS + d] = f2bf(kv * ek);
                Kts[d * LS + lane] = f2bf(kv * ek2);
                if (lane == 0) decs[d] = __expf(bl);
            }
        } else {
            const float fqd = __expf(lg * (float)(lane + 1)), fk = 0.125f * __expf(-lg * (float)(lane + 1)), fk2 = 0.125f * __expf(lg * (float)(63 - lane));
#pragma unroll 1
            for (int dd = 0; dd < 16; ++dd) {
                const int d = wave * 16 + dd;
                const float qv = bf2f(Qs[lane * LS + d]), kv = bf2f(Ks[lane * LS + d]);
                Qs[lane * LS + d] = f2bf(qv * fqd);
                Ks[lane * LS + d] = f2bf(kv * fk);
                Kts[d * LS + lane] = f2bf(kv * fk2);
            }
            if (tid < 64) decs[tid] = __expf(lg * 64.f);
        }
        __syncthreads();
#pragma unroll
        for (int jb = 0; jb < 4; ++jb) {
            f32x4 ap = (f32x4){0.f, 0.f, 0.f, 0.f};
#pragma unroll
            for (int ks = 0; ks < 2; ++ks) {
                const bf16x8 a = ldfrag(Ks, 16 * jb + fl, ks * 32 + fq * 8);
                const bf16x8 bq = ldfrag(Qs, 16 * wave + fl, ks * 32 + fq * 8);
                ap = __builtin_amdgcn_mfma_f32_16x16x32_bf16(a, bq, ap, 0, 0, 0);
            }
            const int i = 16 * wave + fl, j0 = 16 * jb + 4 * fq;
            u32x2 w;
            w.x = pk2(j0 + 0 <= i ? ap.x : 0.f, j0 + 1 <= i ? ap.y : 0.f);
            w.y = pk2(j0 + 2 <= i ? ap.z : 0.f, j0 + 3 <= i ? ap.w : 0.f);
            *(u32x2*)(Ps + i * LS + j0) = w;
        }
        __syncthreads();
        {
            f32x4 ao[NVB];
            float ss = 0.f;
#pragma unroll
            for (int vb = 0; vb < NVB; ++vb) {
                f32x4 a4 = (f32x4){0.f, 0.f, 0.f, 0.f};
#pragma unroll
                for (int ks = 0; ks < 2; ++ks) {
                    const bf16x8 a = ldfrag(Vts, 16 * vb + fl, ks * 32 + fq * 8);
                    const bf16x8 bp = ldfrag(Ps, 16 * wave + fl, ks * 32 + fq * 8);
                    a4 = __builtin_amdgcn_mfma_f32_16x16x32_bf16(a, bp, a4, 0, 0, 0);
                }
#pragma unroll
                for (int ks = 0; ks < 2; ++ks) {
                    const bf16x8 a = ldfrag(Sts, 16 * vb + fl, ks * 32 + fq * 8);
                    const bf16x8 bq = ldfrag(Qs, 16 * wave + fl, ks * 32 + fq * 8);
                    a4 = __builtin_amdgcn_mfma_f32_16x16x32_bf16(a, bq, a4, 0, 0, 0);
                }
                ao[vb] = a4;
                ss += a4.x * a4.x + a4.y * a4.y + a4.z * a4.z + a4.w * a4.w;
            }
            ss += __shfl_xor(ss, 16);
            ss += __shfl_xor(ss, 32);
            const float inv = rsqrtf(ss * (1.f / DV) + 1e-5f);
            const size_t t = t0 + 16 * wave + fl;
#pragma unroll
            for (int vb = 0; vb < NVB; ++vb) {
                const int v0 = 16 * vb + 4 * fq;
                const u32x2 gg = *(const u32x2*)(p.Z + t * DINP + goff + v0);
                float g4[4] = {lo_bf(gg.x), hi_bf(gg.x), lo_bf(gg.y), hi_bf(gg.y)};
                float o4[4] = {ao[vb].x, ao[vb].y, ao[vb].z, ao[vb].w};
#pragma unroll
                for (int e = 0; e < 4; ++e) {
                    float y = o4[e] * inv;
                    if (IS_GLA) y *= p.norm_w[h * 96 + v0 + e];
                    const float g = g4[e];
                    o4[e] = y * (g / (1.f + __expf(-g)));
                }
                u32x2 w; w.x = pk2(o4[0], o4[1]); w.y = pk2(o4[2], o4[3]);
                *(u32x2*)(p.O + t * D + ooff + v0) = w;
            }
        }
        {
            f32x4 dc = *(const f32x4*)(decs + 16 * wave + 4 * fq);
#pragma unroll
            for (int vb = 0; vb < NVB; ++vb) {
                f32x4 a4 = accS[vb] * dc;
#pragma unroll
                for (int ks = 0; ks < 2; ++ks) {
                    const bf16x8 a = ldfrag(Kts, 16 * wave + fl, ks * 32 + fq * 8);
                    const bf16x8 bv = ldfrag(Vts, 16 * vb + fl, ks * 32 + fq * 8);
                    a4 = __builtin_amdgcn_mfma_f32_16x16x32_bf16(a, bv, a4, 0, 0, 0);
                }
                accS[vb] = a4;
            }
        }
        __syncthreads();
#pragma unroll
        for (int vb = 0; vb < NVB; ++vb) {
            u32x2 w; w.x = pk2(accS[vb].x, accS[vb].y); w.y = pk2(accS[vb].z, accS[vb].w);
            *(u32x2*)(Sts + (16 * vb + fl) * LS + 16 * wave + 4 * fq) = w;
        }
    }
    __syncthreads();
}

struct RwP {
    const bf16_t* Z; unsigned char* mix;
    const float* mu; const float* w_up; const float* w_bias; const float* a_up; const float* a_bias; const float* g_up;
    const float* k_k; const float* k_a; const float* r_k; const float* ln_w; const float* ln_b;
    float* oraw; bf16_t* O;
};
__device__ void phase_rwkv_prep(const RwP& p, char* smem, int bid, int nblk) {
    float* fs = (float*)smem;
    const int tid = otid(), lane = tid & 63;
    float* Wd = (float*)(p.mix + MX_W); float* KKd = (float*)(p.mix + MX_KK); float* KKAd = (float*)(p.mix + MX_KKA);
    bf16_t* Rd = (bf16_t*)(p.mix + MX_R); bf16_t* Kd = (bf16_t*)(p.mix + MX_K); bf16_t* Vd = (bf16_t*)(p.mix + MX_V); bf16_t* Gd = (bf16_t*)(p.mix + MX_G);
    for (int it = bid; it < NT / 8; it += nblk) {
        const int t0 = it * 8;
        for (int x = tid; x < 8 * RW_F; x += NTHREADS) {
            const int tok = x / RW_F, c = x % RW_F;
            const int t = t0 + tok;
            const float f = bf2f(p.Z[(size_t)t * DINP + ZC_RW + c]);
            const float fp = ((t & (NS - 1)) == 0) ? 0.f : bf2f(p.Z[(size_t)(t - 1) * DINP + ZC_RW + c]);
            float v = f + (fp - f) * p.mu[c];
            if (c >= 1152 && c < 1216) v = tanhf(v);
            else if (c >= 1280) v = sigmoidf_(v);
            fs[tok * RW_F + c] = v;
        }
        __syncthreads();
        for (int cc = tid; cc < 384; cc += NTHREADS) {
            float aw[8], aa[8], ag[8];
#pragma unroll
            for (int k = 0; k < 8; ++k) { aw[k] = 0.f; aa[k] = 0.f; ag[k] = 0.f; }
            for (int i = 0; i < 64; i += 4) {
                float w1[4], a1[4];
#pragma unroll
                for (int e = 0; e < 4; ++e) { w1[e] = p.w_up[(i + e) * 384 + cc]; a1[e] = p.a_up[(i + e) * 384 + cc]; }
#pragma unroll
                for (int k = 0; k < 8; ++k) {
                    const f32x4 xw = *(const f32x4*)(fs + k * RW_F + 1152 + i), xa = *(const f32x4*)(fs + k * RW_F + 1216 + i);
                    aw[k] += xw.x * w1[0] + xw.y * w1[1] + xw.z * w1[2] + xw.w * w1[3];
                    aa[k] += xa.x * a1[0] + xa.y * a1[1] + xa.z * a1[2] + xa.w * a1[3];
                }
            }
            for (int i = 0; i < 128; i += 4) {
                float g1[4];
#pragma unroll
                for (int e = 0; e < 4; ++e) g1[e] = p.g_up[(i + e) * 384 + cc];
#pragma unroll
                for (int k = 0; k < 8; ++k) {
                    const f32x4 xg = *(const f32x4*)(fs + k * RW_F + 1280 + i);
                    ag[k] += xg.x * g1[0] + xg.y * g1[1] + xg.z * g1[2] + xg.w * g1[3];
                }
            }
            const float wb = p.w_bias[cc], ab = p.a_bias[cc], kkc = p.k_k[cc], kac = p.k_a[cc];
            const int hd = cc >> 6, cl = cc & 63;
#pragma unroll
            for (int k = 0; k < 8; ++k) {
                const int t = t0 + k, b = t >> 12, s = t & (NS - 1);
                const size_t hi = ((size_t)(b * 6 + hd) * NS + s) * 64 + cl;
                const float wl = -softplusf_(-(wb + aw[k])) - 0.5f;
                const float dec = __expf(-__expf(wl));
                const float a = sigmoidf_(ab + aa[k]);
                const float r = fs[k * RW_F + cc], kx = fs[k * RW_F + 384 + cc], vx = fs[k * RW_F + 768 + cc];
                float kk = kx * kkc;
                const float ss = wave_sum(kk * kk);
                kk *= rsqrtf(fmaxf(ss, 1e-24f));
                const float kmod = kx * (1.f + (a - 1.f) * kac);
                Wd[hi] = dec; KKd[hi] = kk; KKAd[hi] = kk * a;
                Rd[hi] = f2bf(r); Kd[hi] = f2bf(kmod); Vd[hi] = f2bf(vx);
                Gd[(size_t)t * 384 + cc] = f2bf(ag[k]);
            }
        }
        __syncthreads();
    }
}

__device__ __forceinline__ float row16_sum(float v) {
    v += __shfl_xor(v, 8); v += __shfl_xor(v, 4); v += __shfl_xor(v, 2); v += __shfl_xor(v, 1);
    return v;
}
constexpr int SC_STEPS = 16;
__device__ void rwkv_scan_task(const RwP& p, char* smem, int bh, int qd) {
    float* buf = (float*)smem;
    float* obuf = buf + 2 * 6 * SC_STEPS * 64;
    const int tid = otid(), lane = tid & 63, wave = tid >> 6;
    const int rloc = wave * 4 + (lane >> 4);
    const int row = qd * 16 + rloc;
    const int c4 = (lane & 15) * 4;
    const float* Wd = (const float*)(p.mix + MX_W) + (size_t)bh * NS * 64;
    const float* KKd = (const float*)(p.mix + MX_KK) + (size_t)bh * NS * 64;
    const float* KKAd = (const float*)(p.mix + MX_KKA) + (size_t)bh * NS * 64;
    const bf16_t* Rd = (const bf16_t*)(p.mix + MX_R) + (size_t)bh * NS * 64;
    const bf16_t* Kd = (const bf16_t*)(p.mix + MX_K) + (size_t)bh * NS * 64;
    const bf16_t* Vd = (const bf16_t*)(p.mix + MX_V) + (size_t)bh * NS * 64;
    float* orow = p.oraw + (size_t)bh * NS * 64;
    f32x4 S = (f32x4){0.f, 0.f, 0.f, 0.f};
    f32x4 lw, lkk, lka; u32x2 lr, lk, lv;
    auto gload = [&](int ch) {
        const size_t e = (size_t)ch * SC_STEPS * 64 + tid * 4;
        lw = *(const f32x4*)(Wd + e); lkk = *(const f32x4*)(KKd + e); lka = *(const f32x4*)(KKAd + e);
        lr = *(const u32x2*)(Rd + e); lk = *(const u32x2*)(Kd + e); lv = *(const u32x2*)(Vd + e);
    };
    auto lstore = [&](int bsel) {
        float* bb = buf + bsel * 6 * SC_STEPS * 64 + tid * 4;
        *(f32x4*)(bb + 0 * SC_STEPS * 64) = lw; *(f32x4*)(bb + 1 * SC_STEPS * 64) = lkk; *(f32x4*)(bb + 2 * SC_STEPS * 64) = lka;
        *(f32x4*)(bb + 3 * SC_STEPS * 64) = (f32x4){lo_bf(lr.x), hi_bf(lr.x), lo_bf(lr.y), hi_bf(lr.y)};
        *(f32x4*)(bb + 4 * SC_STEPS * 64) = (f32x4){lo_bf(lk.x), hi_bf(lk.x), lo_bf(lk.y), hi_bf(lk.y)};
        *(f32x4*)(bb + 5 * SC_STEPS * 64) = (f32x4){lo_bf(lv.x), hi_bf(lv.x), lo_bf(lv.y), hi_bf(lv.y)};
    };
    __syncthreads();
    gload(0); lstore(0);
    __syncthreads();
    constexpr int NCH = NS / SC_STEPS;
    for (int ch = 0; ch < NCH; ++ch) {
        if (ch + 1 < NCH) gload(ch + 1);
        const float* bb = buf + (ch & 1) * 6 * SC_STEPS * 64;
#pragma unroll 4
        for (int st = 0; st < SC_STEPS; ++st) {
            const f32x4 w4 = *(const f32x4*)(bb + 0 * SC_STEPS * 64 + st * 64 + c4);
            const f32x4 kk4 = *(const f32x4*)(bb + 1 * SC_STEPS * 64 + st * 64 + c4);
            const f32x4 ka4 = *(const f32x4*)(bb + 2 * SC_STEPS * 64 + st * 64 + c4);
            const f32x4 r4 = *(const f32x4*)(bb + 3 * SC_STEPS * 64 + st * 64 + c4);
            const f32x4 k4 = *(const f32x4*)(bb + 4 * SC_STEPS * 64 + st * 64 + c4);
            const float vv = bb[5 * SC_STEPS * 64 + st * 64 + row];
            float pd = S.x * kk4.x + S.y * kk4.y + S.z * kk4.z + S.w * kk4.w;
            const float sa = -row16_sum(pd);
            S.x = S.x * w4.x + vv * k4.x + sa * ka4.x;
            S.y = S.y * w4.y + vv * k4.y + sa * ka4.y;
            S.z = S.z * w4.z + vv * k4.z + sa * ka4.z;
            S.w = S.w * w4.w + vv * k4.w + sa * ka4.w;
            float od = S.x * r4.x + S.y * r4.y + S.z * r4.z + S.w * r4.w;
            od = row16_sum(od);
            if ((lane & 15) == 0) obuf[st * 16 + rloc] = od;
        }
        __syncthreads();
        {
            const int st = tid >> 4, rr = tid & 15;
            orow[((size_t)ch * SC_STEPS + st) * 64 + qd * 16 + rr] = obuf[tid];
        }
        if (ch + 1 < NCH) lstore((ch + 1) & 1);
        __syncthreads();
    }
}

__device__ void phase_rwkv_post(const RwP& p, int bid, int nblk) {
    const int lane = otid() & 63, wave = otid() >> 6;
    const bf16_t* Rd = (const bf16_t*)(p.mix + MX_R); const bf16_t* Kd = (const bf16_t*)(p.mix + MX_K); const bf16_t* Vd = (const bf16_t*)(p.mix + MX_V);
    const bf16_t* Gd = (const bf16_t*)(p.mix + MX_G);
    for (int x = bid * 4 + wave; x < NT * 6; x += nblk * 4) {
        const int t = x / 6, hd = x % 6, b = t >> 12, s = t & (NS - 1);
        const size_t hi = ((size_t)(b * 6 + hd) * NS + s) * 64 + lane;
        const float o = p.oraw[hi];
        const float mean = wave_sum(o) * (1.f / 64.f);
        const float dv = o - mean;
        const float var = wave_sum(dv * dv) * (1.f / 64.f);
        float on = dv * rsqrtf(var + 64e-5f) * p.ln_w[hd * 64 + lane] + p.ln_b[hd * 64 + lane];
        const float r = bf2f(Rd[hi]), k = bf2f(Kd[hi]), v = bf2f(Vd[hi]);
        const float rk = wave_sum(r * k * p.r_k[hd * 64 + lane]);
        on += rk * v;
        const float g = bf2f(Gd[(size_t)t * 384 + hd * 64 + lane]);
        p.O[(size_t)t * D + 256 + hd * 64 + lane] = f2bf(on * g);
    }
}

__device__ __forceinline__ unsigned ordkey(float f) { const unsigned u = __float_as_uint(f); return (u & 0x80000000u) ? ~u : (u | 0x80000000u); }
__device__ __forceinline__ void top16_128(float a0, float a1, int lane, float& outv, int& outi) {
    unsigned k0 = (ordkey(a0) & 0xFFFFFF80u) | (unsigned)(127 - lane);
    unsigned k1 = (ordkey(a1) & 0xFFFFFF80u) | (unsigned)(63 - lane);
    outv = 0.f; outi = 0;
    for (int it = 0; it < 16; ++it) {
        const unsigned m = k0 > k1 ? k0 : k1;
        const unsigned wm = wave_max_u32(m);
        const int idx = 127 - (int)(wm & 127u);
        const float cand = (idx >> 6) ? a1 : a0;
        const float val = __shfl(cand, idx & 63);
        if (lane == it) { outv = val; outi = idx; }
        if (k0 == wm) k0 = 0u;
        if (k1 == wm) k1 = 0u;
    }
}
__device__ void phase_topk(const float* SC, int* EIDX, float* GATE, int bid, int nblk) {
    const int lane = otid() & 63, wave = otid() >> 6;
    int ci, cj;
    {
        const int c = lane;
        if (c < 16) { ci = 0; cj = c; } else if (c < 24) { ci = 1; cj = c - 16; } else if (c < 29) { ci = 2; cj = c - 24; } else if (c < 33) { ci = 3; cj = c - 29; }
        else if (c < 36) { ci = 4; cj = c - 33; } else if (c < 38) { ci = 5; cj = c - 36; } else if (c < 40) { ci = 6; cj = c - 38; } else if (c < 42) { ci = 7; cj = c - 40; }
        else if (c < 50) { ci = c - 34; cj = 0; } else { ci = 0; cj = 0; }
    }
    for (int x = bid * 4 + wave; x < NT * 8; x += nblk * 4) {
        const int t = x >> 3, hd = x & 7;
        const float* sc = SC + (size_t)t * 2048 + hd * 256;
        float s1, s2; int i1, i2;
        top16_128(sc[lane], sc[64 + lane], lane, s1, i1);
        top16_128(sc[128 + lane], sc[192 + lane], lane, s2, i2);
        const float cv = __shfl(s1, ci) + __shfl(s2, cj);
        const int ce = __shfl(i1, ci) * 128 + __shfl(i2, cj);
        unsigned key = (lane < 50) ? ((ordkey(cv) & 0xFFFFFFC0u) | (unsigned)(63 - lane)) : 0u;
        float tv = 0.f; int te = 0;
        for (int it = 0; it < 16; ++it) {
            const unsigned wm = wave_max_u32(key);
            const int wl = 63 - (int)(wm & 63u);
            const float v = __shfl(cv, wl); const int e = __shfl(ce, wl);
            if (lane == it) { tv = v; te = e; }
            if (key == wm) key = 0u;
        }
        const float mx = __shfl(tv, 0);
        const float ex = (lane < 16) ? __expf(tv - mx) : 0.f;
        const float sum = wave_sum(ex);
        if (lane < 16) { EIDX[(size_t)t * 128 + hd * 16 + lane] = te; GATE[(size_t)t * 128 + hd * 16 + lane] = ex / sum; }
    }
}

__device__ void phase_expert(const bf16_t* H, const bf16_t* Ub, const bf16_t* Vb, const int* EIDX, const float* GATE, float* X, int bid, int nblk) {
    const int lane = otid() & 63, wave = otid() >> 6;
    for (int t = bid * 4 + wave; t < NT; t += nblk * 4) {
        float xf[16], acc[16];
        {
            const u32x4 a = *(const u32x4*)(H + (size_t)t * D + lane * 8), b = *(const u32x4*)(H + (size_t)t * D + 512 + lane * 8);
            xf[0] = lo_bf(a.x); xf[1] = hi_bf(a.x); xf[2] = lo_bf(a.y); xf[3] = hi_bf(a.y); xf[4] = lo_bf(a.z); xf[5] = hi_bf(a.z); xf[6] = lo_bf(a.w); xf[7] = hi_bf(a.w);
            xf[8] = lo_bf(b.x); xf[9] = hi_bf(b.x); xf[10] = lo_bf(b.y); xf[11] = hi_bf(b.y); xf[12] = lo_bf(b.z); xf[13] = hi_bf(b.z); xf[14] = lo_bf(b.w); xf[15] = hi_bf(b.w);
        }
#pragma unroll
        for (int i = 0; i < 16; ++i) acc[i] = 0.f;
        for (int e0 = 0; e0 < 128; e0 += 4) {
            float act[4];
#pragma unroll
            for (int j = 0; j < 4; ++j) {
                const int e = EIDX[(size_t)t * 128 + e0 + j];
                const bf16_t* ur = Ub + (size_t)e * D;
                const u32x4 a = *(const u32x4*)(ur + lane * 8), b = *(const u32x4*)(ur + 512 + lane * 8);
                float d = xf[0] * lo_bf(a.x) + xf[1] * hi_bf(a.x) + xf[2] * lo_bf(a.y) + xf[3] * hi_bf(a.y) + xf[4] * lo_bf(a.z) + xf[5] * hi_bf(a.z) + xf[6] * lo_bf(a.w) + xf[7] * hi_bf(a.w)
                        + xf[8] * lo_bf(b.x) + xf[9] * hi_bf(b.x) + xf[10] * lo_bf(b.y) + xf[11] * hi_bf(b.y) + xf[12] * lo_bf(b.z) + xf[13] * hi_bf(b.z) + xf[14] * lo_bf(b.w) + xf[15] * hi_bf(b.w);
                d = wave_sum(d);
                act[j] = 0.5f * d * (1.f + erff(d * 0.7071067811865476f)) * GATE[(size_t)t * 128 + e0 + j];
            }
#pragma unroll
            for (int j = 0; j < 4; ++j) {
                const int e = EIDX[(size_t)t * 128 + e0 + j];
                const bf16_t* vr = Vb + (size_t)e * D;
                const u32x4 a = *(const u32x4*)(vr + lane * 8), b = *(const u32x4*)(vr + 512 + lane * 8);
                const float s = act[j];
                acc[0] += s * lo_bf(a.x); acc[1] += s * hi_bf(a.x); acc[2] += s * lo_bf(a.y); acc[3] += s * hi_bf(a.y);
                acc[4] += s * lo_bf(a.z); acc[5] += s * hi_bf(a.z); acc[6] += s * lo_bf(a.w); acc[7] += s * hi_bf(a.w);
                acc[8] += s * lo_bf(b.x); acc[9] += s * hi_bf(b.x); acc[10] += s * lo_bf(b.y); acc[11] += s * hi_bf(b.y);
                acc[12] += s * lo_bf(b.z); acc[13] += s * hi_bf(b.z); acc[14] += s * lo_bf(b.w); acc[15] += s * hi_bf(b.w);
            }
        }
        f32x4* xr = (f32x4*)(X + (size_t)t * D);
        f32x4 o0 = xr[lane * 2], o1 = xr[lane * 2 + 1], o2 = xr[128 + lane * 2], o3 = xr[128 + lane * 2 + 1];
        o0 += (f32x4){acc[0], acc[1], acc[2], acc[3]}; o1 += (f32x4){acc[4], acc[5], acc[6], acc[7]};
        o2 += (f32x4){acc[8], acc[9], acc[10], acc[11]}; o3 += (f32x4){acc[12], acc[13], acc[14], acc[15]};
        xr[lane * 2] = o0; xr[lane * 2 + 1] = o1; xr[128 + lane * 2] = o2; xr[128 + lane * 2 + 1] = o3;
    }
}

#define XB_TMO      128
#define XB_XCNT(j)  (256  + 64 * (j))
#define XB_XSUB(j)  (1280 + 64 * (j))
#define XB_XGEN(j)  (2304 + 64 * (j))
#define XB_TOP      3328
#define XB_TOPGEN   3392
#define XCD_BAR_WORDS 3456
#define XB_SPIN_CAP (1u << 22)
#define LAS __attribute__((address_space(3)))
__device__ __forceinline__ unsigned xb_ld(unsigned* p)              { return __hip_atomic_load(p, __ATOMIC_RELAXED, __HIP_MEMORY_SCOPE_AGENT); }
__device__ __forceinline__ unsigned xb_add(unsigned* p, unsigned v) { return __hip_atomic_fetch_add(p, v, __ATOMIC_RELAXED, __HIP_MEMORY_SCOPE_AGENT); }
__device__ __forceinline__ unsigned xb_xcc_id() { return (unsigned)__builtin_amdgcn_s_getreg((3 << 11) | 20) & 0xFu; }
#define XB_SPIN(cond, bar) do { unsigned _sp = 0; while (cond) { __builtin_amdgcn_s_sleep(1); \
    if ((++_sp & 255u) == 0u) { if (xb_ld(&(bar)[XB_TMO])) break; if (_sp > XB_SPIN_CAP) { atomicAdd(&(bar)[XB_TMO], 1u); break; } } } } while (0)
struct XcdBarrier { unsigned* bar; unsigned x; volatile LAS unsigned* st; };
__device__ __forceinline__ XcdBarrier xcd_barrier_post(unsigned* bar, volatile LAS unsigned* st) {
    XcdBarrier b; b.bar = bar; b.x = xb_xcc_id(); b.st = st;
    if (threadIdx.x == 0) (void)xb_add(&bar[XB_XCNT(b.x)], 1u);
    return b;
}
__device__ __forceinline__ void xcd_barrier_complete(unsigned* bar, unsigned x, unsigned& nloc, unsigned& nx) {
    const unsigned G = gridDim.x * gridDim.y * gridDim.z;
    unsigned sum, cnt, mine, sp = 0u;
    for (;;) {
        sum = 0u; cnt = 0u; mine = 0u;
#pragma unroll
        for (unsigned j = 0; j < 16; ++j) { const unsigned c = xb_ld(&bar[XB_XCNT(j)]); sum += c; cnt += (c > 0u) ? 1u : 0u; mine = (j == x) ? c : mine; }
        if (sum == G) break;
        __builtin_amdgcn_s_sleep(1);
        if ((++sp & 255u) == 0u) { if (xb_ld(&bar[XB_TMO])) break; if (sp > XB_SPIN_CAP) { atomicAdd(&bar[XB_TMO], 1u); break; } }
    }
    nloc = mine > 0u ? mine : 1u; nx = cnt > 0u ? cnt : 1u;
}
__device__ __forceinline__ void xcd_barrier(const XcdBarrier& b) {
    asm volatile("s_waitcnt vmcnt(0)" ::: "memory");
    __syncthreads();
    if (threadIdx.x == 0) {
        unsigned* bar = b.bar;
        __builtin_amdgcn_s_waitcnt(0);
        unsigned nloc = b.st[0], nx = b.st[1];
        if (nloc == 0u) { xcd_barrier_complete(bar, b.x, nloc, nx); b.st[0] = nloc; b.st[1] = nx; }
        const unsigned old = xb_add(&bar[XB_XSUB(b.x)], 1u);
        const unsigned gen = old / nloc;
        if (old + 1u == (gen + 1u) * nloc) {
            __builtin_amdgcn_fence(__ATOMIC_RELEASE, "agent");
            asm volatile("s_waitcnt vmcnt(0)" ::: "memory");
            const unsigned og = xb_add(&bar[XB_TOP], 1u);
            const unsigned tg = og / nx;
            if (og + 1u == (tg + 1u) * nx) xb_add(&bar[XB_TOPGEN], 1u);
            else XB_SPIN(xb_ld(&bar[XB_TOPGEN]) == tg, bar);
            __builtin_amdgcn_fence(__ATOMIC_ACQUIRE, "agent");
            xb_add(&bar[XB_XGEN(b.x)], 1u);
            asm volatile("s_waitcnt vmcnt(0)" ::: "memory");
        } else {
            XB_SPIN(xb_ld(&bar[XB_XGEN(b.x)]) == gen, bar);
            __builtin_amdgcn_fence(__ATOMIC_ACQUIRE, "agent");
            asm volatile("s_waitcnt vmcnt(0)" ::: "memory");
        }
    }
    __syncthreads();
}

struct Params {
    const float* in[24];
    float* out; unsigned char* ws;
};
constexpr int LDS_BYTES = 65536;

__device__ __forceinline__ RwP make_rwp(const Params& P, int l) {
    RwP r;
    r.Z = (const bf16_t*)(P.ws + WS_Z); r.mix = P.ws + WS_MIX;
    r.mu = P.in[6] + l * RW_F; r.w_up = P.in[7] + (size_t)l * 64 * 384; r.w_bias = P.in[8] + l * 384; r.a_up = P.in[9] + (size_t)l * 64 * 384; r.a_bias = P.in[10] + l * 384;
    r.g_up = P.in[11] + (size_t)l * 128 * 384; r.k_k = P.in[12] + l * 384; r.k_a = P.in[13] + l * 384; r.r_k = P.in[14] + l * 384; r.ln_w = P.in[15] + l * 384; r.ln_b = P.in[16] + l * 384;
    r.oraw = (float*)(P.ws + WS_H); r.O = (bf16_t*)(P.ws + WS_O);
    return r;
}

__global__ void __launch_bounds__(NTHREADS, 2) mega_fwd(Params P) {
    __shared__ __attribute__((aligned(16))) char smem[LDS_BYTES];
    const int bid = blockIdx.x, nblk = gridDim.x;
    volatile LAS unsigned* st = (volatile LAS unsigned*)(smem + LDS_BYTES - 16);
    if (threadIdx.x == 0) { st[0] = 0u; st[1] = 0u; st[2] = 0u; st[3] = 0u; }
    __syncthreads();
    XcdBarrier bar = xcd_barrier_post((unsigned*)(P.ws + WS_CTL), st);
#define GSYNC() xcd_barrier(bar)

    {
        ConvP c{P.in[4], P.in[5], P.in[20], P.in[21], P.in[22], P.in[23], P.ws};
        phase_convert_weights(c, smem, bid, nblk);
        phase_rmsnorm<false>(P.in[0], P.in[1], P.ws + WS_H, bid, nblk);
    }
    GSYNC();
#pragma unroll 1
    for (int l = 0; l < 2; ++l) {
        const float* xin = (l == 0) ? P.in[0] : P.out;
        {
            GemmP g{(const bf16_t*)(P.ws + WS_H), D, 0, (const bf16_t*)(P.ws + WS_WTIN) + (size_t)l * DINP * D, D, D, NT / 128, DINP / 128, P.ws + WS_Z, DINP, nullptr};
            phase_gemm<0>(g, smem, bid, nblk);
        }
        GSYNC();
        RwP rw = make_rwp(P, l);
        phase_rwkv_prep(rw, smem, bid, nblk);
        GSYNC();
        {
            LinP lp{(const bf16_t*)(P.ws + WS_Z), (bf16_t*)(P.ws + WS_O), P.in[17] + (size_t)l * 16 * 192, P.in[18] + l * 192, P.in[19] + l * 384, (const float*)(P.ws + WS_ROPE)};
            for (int task = bid; task < 128; task += nblk) {
                if (task < 96) rwkv_scan_task(rw, smem, task >> 2, task & 3);
                else if (task < 112) linattn_task<false>(lp, smem, (task - 96) >> 2, (task - 96) & 3);
                else linattn_task<true>(lp, smem, (task - 112) >> 2, (task - 112) & 3);
            }
        }
        GSYNC();
        phase_rwkv_post(rw, bid, nblk);
        GSYNC();
        {
            GemmP g{(const bf16_t*)(P.ws + WS_O), D, 0, (const bf16_t*)(P.ws + WS_WTOUT) + (size_t)l * D * D, D, D, NT / 128, D / 128, P.out, D, xin};
            phase_gemm<2>(g, smem, bid, nblk);
        }
        GSYNC();
        phase_rmsnorm<false>(P.out, P.in[2] + l * D, P.ws + WS_H, bid, nblk);
        GSYNC();
        {
            GemmP g{(const bf16_t*)(P.ws + WS_H), D, 0, (const bf16_t*)(P.ws + WS_WTQ) + (size_t)l * 2048 * D, D, D, NT / 128, 2048 / 128, P.ws + WS_Z, 2048, nullptr};
            phase_gemm<0>(g, smem, bid, nblk);
        }
        GSYNC();
        {
            GemmP g{(const bf16_t*)(P.ws + WS_Z), 2048, 128, (const bf16_t*)(P.ws + WS_SK) + (size_t)l * 16 * 128 * 128, 128, 128, NT / 128, 16, P.ws + WS_MIX, 2048, nullptr};
            phase_gemm<1>(g, smem, bid, nblk);
        }
        GSYNC();
        phase_topk((const float*)(P.ws + WS_MIX), (int*)(P.ws + WS_EIDX), (float*)(P.ws + WS_GATE), bid, nblk);
        GSYNC();
        phase_expert((const bf16_t*)(P.ws + WS_H), (const bf16_t*)(P.ws + WS_UB) + (size_t)l * NEXP * D, (const bf16_t*)(P.ws + WS_VB) + (size_t)l * NEXP * D,
                     (const int*)(P.ws + WS_EIDX), (const float*)(P.ws + WS_GATE), P.out, bid, nblk);
        GSYNC();
        if (l == 0) { phase_rmsnorm<false>(P.out, P.in[1] + D, P.ws + WS_H, bid, nblk); GSYNC(); }
    }
    phase_rmsnorm<true>(P.out, P.in[3], P.out, bid, nblk);
}

extern "C" void kernel_launch(void* const* d_in, const int* in_sizes, int n_in, void* d_out, int out_size, void* d_ws, size_t ws_size, hipStream_t stream) {
    static int grid = 0;
    if (grid == 0) {
        if (n_in != 24 || ws_size < WS_END) { fprintf(stderr, "kernel_launch: bad args n_in=%d ws=%zu need=%zu\n", n_in, ws_size, (size_t)WS_END); grid = -1; return; }
        int dev = 0, cus = 0, per_cu = 0;
        hipGetDevice(&dev);
        hipDeviceGetAttribute(&cus, hipDeviceAttributeMultiprocessorCount, dev);
        hipOccupancyMaxActiveBlocksPerMultiprocessor(&per_cu, (const void*)mega_fwd, NTHREADS, 0);
        if (per_cu < 1) { fprintf(stderr, "kernel_launch: occupancy query says %d\n", per_cu); grid = -1; return; }
        if (per_cu > 2) per_cu = 2;
        grid = cus * per_cu;
        fprintf(stderr, "kernel_launch: grid %d (%d CUs x %d)\n", grid, cus, per_cu);
    }
    if (grid < 0) return;
    hipMemsetAsync((char*)d_ws + WS_CTL, 0, XCD_BAR_WORDS * 4, stream);
    Params P{};
    for (int i = 0; i < 24; ++i) P.in[i] = (const float*)d_in[i];
    P.out = (float*)d_out; P.ws = (unsigned char*)d_ws;
    void* args[] = {&P};
    hipError_t e = hipLaunchCooperativeKernel((const void*)mega_fwd, dim3(grid), dim3(NTHREADS), args, 0, stream);
    if (e != hipSuccess) fprintf(stderr, "cooperative launch failed: %s (grid %d)\n", hipGetErrorString(e), grid);
}
```

```cpp
#include <hip/hip_runtime.h>
#include <stdint.h>
#include <stdio.h>

typedef unsigned short bf16_t;
typedef short bf16x8 __attribute__((ext_vector_type(8)));
typedef float f32x4 __attribute__((ext_vector_type(4)));
typedef unsigned u32x4 __attribute__((ext_vector_type(4)));
typedef unsigned u32x2 __attribute__((ext_vector_type(2)));

#define REP_CONV 1
#define REP_GIN 1
#define REP_PREP 1
#define REP_SCAN 1
#define REP_LIN 1
#define REP_POST 1
#define REP_GOUT 1
#define REP_NORM 1
#define REP_GQ 1
#define REP_GSK 1
#define REP_TOPK 1
#define REP_EXP 1
constexpr int NB = 4, NS = 4096, NT = NB * NS, D = 1024, DIN = 3600, DINP = 3712;
constexpr int ZC_RET = 0, ZC_RW = 1024, ZC_GLA = 2432;
constexpr int RW_F = 1408;
constexpr int NEXP = 16384;
constexpr int NTHREADS = 256;

constexpr size_t MiB = 1024ull * 1024ull;
constexpr size_t WS_CTL   = 0;
constexpr size_t WS_WTIN  = 1 * MiB;
constexpr size_t WS_WTOUT = WS_WTIN + 2ull * DINP * D * 2;
constexpr size_t WS_WTQ   = WS_WTOUT + 2ull * D * D * 2;
constexpr size_t WS_SK    = WS_WTQ + 2ull * 2048 * D * 2;
constexpr size_t WS_UB    = WS_SK + 2ull * 16 * 128 * 128 * 2;
constexpr size_t WS_VB    = WS_UB + 2ull * NEXP * D;
constexpr size_t WS_LIN   = WS_VB + 2ull * NEXP * D;
constexpr size_t WS_H     = WS_LIN + 64 * MiB;
constexpr size_t WS_Z     = WS_H + (size_t)NT * D * 2;
constexpr size_t WS_O     = WS_Z + (size_t)NT * DINP * 2;
constexpr size_t WS_MIX   = WS_O + (size_t)NT * D * 2;
constexpr size_t WS_EIDX  = WS_MIX + 128 * MiB;
constexpr size_t WS_GATE  = WS_EIDX + (size_t)NT * 128 * 4;
constexpr size_t WS_ROPE  = WS_GATE + (size_t)NT * 128 * 4;
constexpr size_t WS_END   = WS_ROPE + 1 * MiB;
constexpr size_t RWA = (size_t)NT * 384;
constexpr size_t MX_W   = 0;
constexpr size_t MX_KK  = MX_W + RWA * 4;
constexpr size_t MX_KKA = MX_KK + RWA * 4;
constexpr size_t MX_R   = MX_KKA + RWA * 4;
constexpr size_t MX_K   = MX_R + RWA * 2;
constexpr size_t MX_V   = MX_K + RWA * 2;
constexpr size_t MX_G   = MX_V + RWA * 2;
constexpr size_t MX_END = MX_G + RWA * 2;
static_assert(MX_END <= 128 * MiB, "mix region");

__device__ __forceinline__ float bf2f(bf16_t v) { return __uint_as_float(((unsigned)v) << 16); }
__device__ __forceinline__ bf16_t f2bf(float f) { unsigned u = __float_as_uint(f); u += 0x7FFFu + ((u >> 16) & 1u); return (bf16_t)(u >> 16); }
__device__ __forceinline__ unsigned pk2(float lo, float hi) { return (unsigned)f2bf(lo) | ((unsigned)f2bf(hi) << 16); }
__device__ __forceinline__ float lo_bf(unsigned u) { return __uint_as_float(u << 16); }
__device__ __forceinline__ float hi_bf(unsigned u) { return __uint_as_float(u & 0xFFFF0000u); }
template <int CTRL> __device__ __forceinline__ float dpp_f(float v) { return __int_as_float(__builtin_amdgcn_update_dpp(0, __float_as_int(v), CTRL, 0xF, 0xF, true)); }
template <int CTRL> __device__ __forceinline__ unsigned dpp_u(unsigned v) { return (unsigned)__builtin_amdgcn_update_dpp(0, (int)v, CTRL, 0xF, 0xF, true); }
__device__ __forceinline__ float row16_sum(float v) { v += dpp_f<0x128>(v); v += dpp_f<0x124>(v); v += dpp_f<0x122>(v); v += dpp_f<0x121>(v); return v; }
__device__ __forceinline__ float xor16_sum(float v) { auto r = __builtin_amdgcn_permlane16_swap(__float_as_uint(v), __float_as_uint(v), false, false); return __uint_as_float(r[0]) + __uint_as_float(r[1]); }
__device__ __forceinline__ float xor32_sum(float v) { auto r = __builtin_amdgcn_permlane32_swap(__float_as_uint(v), __float_as_uint(v), false, false); return __uint_as_float(r[0]) + __uint_as_float(r[1]); }
__device__ __forceinline__ float wave_sum(float v) { return xor32_sum(xor16_sum(row16_sum(v))); }
__device__ __forceinline__ unsigned umax_(unsigned a, unsigned b) { return a > b ? a : b; }
__device__ __forceinline__ unsigned wave_max_u32(unsigned v) {
    v = umax_(v, dpp_u<0x128>(v)); v = umax_(v, dpp_u<0x124>(v)); v = umax_(v, dpp_u<0x122>(v)); v = umax_(v, dpp_u<0x121>(v));
    { auto r = __builtin_amdgcn_permlane16_swap(v, v, false, false); v = umax_(r[0], r[1]); }
    { auto r = __builtin_amdgcn_permlane32_swap(v, v, false, false); v = umax_(r[0], r[1]); }
    return v;
}
__device__ __forceinline__ float sigmoidf_(float x) { return 1.f / (1.f + __expf(-x)); }
__device__ __forceinline__ float softplusf_(float x) { return fmaxf(x, 0.f) + log1pf(__expf(-fabsf(x))); }

__device__ __forceinline__ int otid() { int t = threadIdx.x; asm volatile("" : "+v"(t)); return t; }

__device__ void transpose_tile(const float* __restrict__ W, int K, int N, bf16_t* __restrict__ Wt, int kt, int nt, float* tile  ) {
    const int tid = otid();
    const int k0 = kt * 64, n0 = nt * 64;
#pragma unroll
    for (int i = 0; i < 16; ++i) {
        const int k = i * 4 + (tid >> 6), n = tid & 63;
        tile[k * 65 + n] = (n0 + n < N) ? W[(size_t)(k0 + k) * N + n0 + n] : 0.f;
    }
    __syncthreads();
#pragma unroll
    for (int i = 0; i < 16; ++i) {
        const int n = i * 4 + (tid >> 6), k = tid & 63;
        Wt[(size_t)(n0 + n) * K + k0 + k] = f2bf(tile[k * 65 + n]);
    }
    __syncthreads();
}

struct ConvP {
    const float* w_in; const float* w_out; const float* w_q; const float* sk; const float* u; const float* v;
    unsigned char* ws;
};

__device__ void phase_convert_weights(const ConvP& p, char* smem, int bid, int nblk) {
    float* tile = (float*)smem;
    constexpr int T_IN = 16 * 58, T_OUT = 16 * 16, T_Q = 16 * 32, T_L = T_IN + T_OUT + T_Q;
    for (int it = bid; it < 2 * T_L; it += nblk) {
        const int l = it / T_L; int r = it % T_L;
        if (r < T_IN) { transpose_tile(p.w_in + (size_t)l * D * DIN, D, DIN, (bf16_t*)(p.ws + WS_WTIN) + (size_t)l * DINP * D, r / 58, r % 58, tile); continue; }
        r -= T_IN;
        if (r < T_OUT) { transpose_tile(p.w_out + (size_t)l * D * D, D, D, (bf16_t*)(p.ws + WS_WTOUT) + (size_t)l * D * D, r / 16, r % 16, tile); continue; }
        r -= T_OUT;
        transpose_tile(p.w_q + (size_t)l * D * 2048, D, 2048, (bf16_t*)(p.ws + WS_WTQ) + (size_t)l * 2048 * D, r / 32, r % 32, tile);
    }
    const size_t gtid = (size_t)bid * NTHREADS + otid(), gn = (size_t)nblk * NTHREADS;
    {
        float* ct = (float*)(p.ws + WS_ROPE); float* stb = ct + NS * 32;
        for (size_t i = gtid; i < (size_t)NS * 32; i += gn) {
            const int pos = (int)(i >> 5), fi = (int)(i & 31);
            const float inv = exp2f(-(float)fi * (13.287712379549449f / 32.f));
            float sn, cs; sincosf((float)pos * inv, &sn, &cs);
            ct[i] = cs; stb[i] = sn;
        }
    }
    {
        const size_t n8 = (2ull * 16 * 128 * 128) / 8;
        const f32x4* s = (const f32x4*)p.sk; u32x4* d = (u32x4*)(p.ws + WS_SK);
        for (size_t i = gtid; i < n8; i += gn) { f32x4 a = s[2 * i], b = s[2 * i + 1]; u32x4 o; o.x = pk2(a.x, a.y); o.y = pk2(a.z, a.w); o.z = pk2(b.x, b.y); o.w = pk2(b.z, b.w); d[i] = o; }
    }
    {
        const size_t n16 = (2ull * NEXP * D) / 16;
        const f32x4* su = (const f32x4*)p.u; u32x4* du = (u32x4*)(p.ws + WS_UB);
        const f32x4* sv = (const f32x4*)p.v; u32x4* dv = (u32x4*)(p.ws + WS_VB);
        for (size_t i = gtid; i < n16; i += gn) {
            f32x4 a = su[4 * i] * 512.f, b = su[4 * i + 1] * 512.f, c = su[4 * i + 2] * 512.f, d = su[4 * i + 3] * 512.f;
            u32x4 o;
            o.x = (unsigned)__builtin_amdgcn_cvt_pk_fp8_f32(a.z, a.w, __builtin_amdgcn_cvt_pk_fp8_f32(a.x, a.y, 0, false), true);
            o.y = (unsigned)__builtin_amdgcn_cvt_pk_fp8_f32(b.z, b.w, __builtin_amdgcn_cvt_pk_fp8_f32(b.x, b.y, 0, false), true);
            o.z = (unsigned)__builtin_amdgcn_cvt_pk_fp8_f32(c.z, c.w, __builtin_amdgcn_cvt_pk_fp8_f32(c.x, c.y, 0, false), true);
            o.w = (unsigned)__builtin_amdgcn_cvt_pk_fp8_f32(d.z, d.w, __builtin_amdgcn_cvt_pk_fp8_f32(d.x, d.y, 0, false), true);
            du[i] = o;
            a = sv[4 * i] * 64.f; b = sv[4 * i + 1] * 64.f; c = sv[4 * i + 2] * 64.f; d = sv[4 * i + 3] * 64.f;
            o.x = (unsigned)__builtin_amdgcn_cvt_pk_fp8_f32(a.z, a.w, __builtin_amdgcn_cvt_pk_fp8_f32(a.x, a.y, 0, false), true);
            o.y = (unsigned)__builtin_amdgcn_cvt_pk_fp8_f32(b.z, b.w, __builtin_amdgcn_cvt_pk_fp8_f32(b.x, b.y, 0, false), true);
            o.z = (unsigned)__builtin_amdgcn_cvt_pk_fp8_f32(c.z, c.w, __builtin_amdgcn_cvt_pk_fp8_f32(c.x, c.y, 0, false), true);
            o.w = (unsigned)__builtin_amdgcn_cvt_pk_fp8_f32(d.z, d.w, __builtin_amdgcn_cvt_pk_fp8_f32(d.x, d.y, 0, false), true);
            dv[i] = o;
        }
    }
}

template <bool OUT_F32>
__device__ void phase_rmsnorm(const float* x, const float* __restrict__ g, void* out, int bid, int nblk) {
    const int lane = otid() & 63, wave = otid() >> 6;
    const int gw = bid * 4 + wave, ngw = nblk * 4;
    f32x4 gv[4];
#pragma unroll
    for (int j = 0; j < 4; ++j) gv[j] = ((const f32x4*)g)[lane + 64 * j];
    for (int row = gw; row < NT; row += ngw) {
        const f32x4* xr = (const f32x4*)(x + (size_t)row * D) + lane;
        f32x4 v[4]; float s = 0.f;
#pragma unroll
        for (int j = 0; j < 4; ++j) { v[j] = xr[64 * j]; s += v[j].x * v[j].x + v[j].y * v[j].y + v[j].z * v[j].z + v[j].w * v[j].w; }
        s = wave_sum(s);
        const float rs = rsqrtf(s * (1.f / D) + 1e-6f);
        if (OUT_F32) {
            f32x4* o = (f32x4*)((float*)out + (size_t)row * D) + lane;
#pragma unroll
            for (int j = 0; j < 4; ++j) o[64 * j] = v[j] * rs * gv[j];
        } else {
            u32x2* o = (u32x2*)((bf16_t*)out + (size_t)row * D) + lane;
#pragma unroll
            for (int j = 0; j < 4; ++j) { f32x4 y = v[j] * rs * gv[j]; u32x2 w; w.x = pk2(y.x, y.y); w.y = pk2(y.z, y.w); o[64 * j] = w; }
        }
    }
}

struct GemmP {
    const bf16_t* A; int lda; int a_koff;
    const bf16_t* Bt; int ldb; int K;
    int MT, NTl;
    void* C; int ldc; const float* R;
};
constexpr int GS = 72;
template <int MODE>
__device__ void phase_gemm(const GemmP& p, char* smem, int bid, int nblk) {
    bf16_t* As = (bf16_t*)smem;
    bf16_t* Bs = As + 128 * GS;
    const int tid = otid(), lane = tid & 63, wave = tid >> 6;
    const int wr = wave >> 1, wc = wave & 1;
    const int lr = tid >> 3, lc = (tid & 7) * 8;
    const int fl = lane & 15, fq = lane >> 4;
    const int ntiles = p.MT * p.NTl;
    for (int tile = bid; tile < ntiles; tile += nblk) {
        const int mt = tile / p.NTl, nt = tile % p.NTl;
        const bf16_t* Ag = p.A + (size_t)mt * 128 * p.lda + (size_t)nt * p.a_koff + (size_t)lr * p.lda + lc;
        const bf16_t* Bg = p.Bt + (size_t)nt * 128 * p.ldb + (size_t)lr * p.ldb + lc;
        f32x4 acc[4][4];
#pragma unroll
        for (int m = 0; m < 4; ++m)
#pragma unroll
            for (int n = 0; n < 4; ++n) acc[m][n] = (f32x4){0.f, 0.f, 0.f, 0.f};
        u32x4 ra[4], rb[4];
#pragma unroll
        for (int i = 0; i < 4; ++i) { ra[i] = *(const u32x4*)(Ag + (size_t)(32 * i) * p.lda); rb[i] = *(const u32x4*)(Bg + (size_t)(32 * i) * p.ldb); }
        for (int k0 = 0; k0 < p.K; k0 += 64) {
            __syncthreads();
#pragma unroll
            for (int i = 0; i < 4; ++i) { *(u32x4*)(As + (lr + 32 * i) * GS + lc) = ra[i]; *(u32x4*)(Bs + (lr + 32 * i) * GS + lc) = rb[i]; }
            __syncthreads();
            if (k0 + 64 < p.K) {
#pragma unroll
                for (int i = 0; i < 4; ++i) { ra[i] = *(const u32x4*)(Ag + (size_t)(32 * i) * p.lda + k0 + 64); rb[i] = *(const u32x4*)(Bg + (size_t)(32 * i) * p.ldb + k0 + 64); }
            }
#pragma unroll
            for (int ks = 0; ks < 2; ++ks) {
                bf16x8 xa[4], wb[4];
#pragma unroll
                for (int m = 0; m < 4; ++m) xa[m] = *(const bf16x8*)(As + (wr * 64 + m * 16 + fl) * GS + ks * 32 + fq * 8);
#pragma unroll
                for (int n = 0; n < 4; ++n) wb[n] = *(const bf16x8*)(Bs + (wc * 64 + n * 16 + fl) * GS + ks * 32 + fq * 8);
#pragma unroll
                for (int m = 0; m < 4; ++m)
#pragma unroll
                    for (int n = 0; n < 4; ++n) acc[m][n] = __builtin_amdgcn_mfma_f32_16x16x32_bf16(wb[n], xa[m], acc[m][n], 0, 0, 0);
            }
        }
#pragma unroll
        for (int m = 0; m < 4; ++m) {
            const size_t row = (size_t)mt * 128 + wr * 64 + m * 16 + fl;
#pragma unroll
            for (int n = 0; n < 4; ++n) {
                const int col = nt * 128 + wc * 64 + n * 16 + fq * 4;
                const f32x4 a = acc[m][n];
                if (MODE == 0) { u32x2 w; w.x = pk2(a.x, a.y); w.y = pk2(a.z, a.w); *(u32x2*)((bf16_t*)p.C + row * p.ldc + col) = w; }
                else if (MODE == 1) { *(f32x4*)((float*)p.C + row * p.ldc + col) = a; }
                else { const f32x4 r = *(const f32x4*)(p.R + row * p.ldc + col); *(f32x4*)((float*)p.C + row * p.ldc + col) = r + a; }
            }
        }
    }
}

constexpr int LS = 72;
struct LinP {
    const bf16_t* Z; bf16_t* O;
    const float* gk_up;
    const float* gk_bias;
    const float* norm_w;
    const float* rope;
};
__device__ __forceinline__ bf16x8 ldfrag(const bf16_t* base, int row, int kofs) { return *(const bf16x8*)(base + row * LS + kofs); }

template <bool IS_GLA>
__device__ void linattn_task(const LinP& p, char* smem, int b, int h) {
    constexpr int DK = IS_GLA ? 48 : 64, DV = IS_GLA ? 96 : 64, NVB = DV / 16;
    const int qoff = IS_GLA ? (ZC_GLA + 0 + h * 48) : (ZC_RET + 0 + h * 64);
    const int koff = IS_GLA ? (ZC_GLA + 192 + h * 48) : (ZC_RET + 256 + h * 64);
    const int voff = IS_GLA ? (ZC_GLA + 384 + h * 96) : (ZC_RET + 512 + h * 64);
    const int goff = IS_GLA ? (ZC_GLA + 784 + h * 96) : (ZC_RET + 768 + h * 64);
    const int gkdoff = ZC_GLA + 768;
    const int ooff = IS_GLA ? (640 + h * 96) : (h * 64);
    bf16_t* Qs = (bf16_t*)smem;
    bf16_t* Ks = Qs + 64 * LS;
    bf16_t* Kts = Ks + 64 * LS;
    bf16_t* Ps = Kts + 64 * LS;
    bf16_t* Vts = Ps + 64 * LS;
    bf16_t* Sts = Vts + 96 * LS;
    float* decs = (float*)(Sts + 96 * LS);
    const int tid = otid(), lane = tid & 63, wave = tid >> 6;
    const int fl = lane & 15, fq = lane >> 4;
    for (int i = tid; i < (64 * 4 + 96 * 2) * LS / 2; i += NTHREADS) ((unsigned*)smem)[i] = 0u;
    if (tid < 64) decs[tid] = 1.f;
    __syncthreads();
    f32x4 accS[NVB];
#pragma unroll
    for (int vb = 0; vb < NVB; ++vb) accS[vb] = (f32x4){0.f, 0.f, 0.f, 0.f};
    float lg = 0.f;
    if (!IS_GLA) { const float e = exp2f(-5.f - (float)h * (4.f / 3.f)); lg = log1pf(-e); }

    for (int c = 0; c < NS / 64; ++c) {
        const size_t t0 = (size_t)b * NS + (size_t)c * 64;
        if (IS_GLA) {
            for (int x = tid; x < 64 * 6; x += NTHREADS) {
                const int tok = x / 6, ch = x % 6;
                const bf16_t* zr = p.Z + (t0 + tok) * DINP;
                *(u32x4*)(Qs + tok * LS + ch * 8) = *(const u32x4*)(zr + qoff + ch * 8);
                *(u32x4*)(Ks + tok * LS + ch * 8) = *(const u32x4*)(zr + koff + ch * 8);
            }
            for (int x = tid; x < 64 * 12; x += NTHREADS) {
                const int tok = x / 12, ch = x % 12;
                const u32x4 vv = *(const u32x4*)(p.Z + (t0 + tok) * DINP + voff + ch * 8);
                const unsigned w[4] = {vv.x, vv.y, vv.z, vv.w};
#pragma unroll
                for (int e = 0; e < 4; ++e) { Vts[(ch * 8 + 2 * e) * LS + tok] = (bf16_t)(w[e] & 0xFFFFu); Vts[(ch * 8 + 2 * e + 1) * LS + tok] = (bf16_t)(w[e] >> 16); }
            }
        } else {
            const int tok = tid >> 2, cq = tid & 3;
            const bf16_t* zr = p.Z + (t0 + tok) * DINP;
            const u32x4 q1 = *(const u32x4*)(zr + qoff + cq * 8), q2 = *(const u32x4*)(zr + qoff + 32 + cq * 8);
            const u32x4 k1 = *(const u32x4*)(zr + koff + cq * 8), k2 = *(const u32x4*)(zr + koff + 32 + cq * 8);
            const unsigned q1w[4] = {q1.x, q1.y, q1.z, q1.w}, q2w[4] = {q2.x, q2.y, q2.z, q2.w};
            const unsigned k1w[4] = {k1.x, k1.y, k1.z, k1.w}, k2w[4] = {k2.x, k2.y, k2.z, k2.w};
            unsigned oq1[4], oq2[4], ok1[4], ok2[4];
            const int spos = c * 64 + tok;
            const f32x4 c0 = *(const f32x4*)(p.rope + spos * 32 + cq * 8), c1 = *(const f32x4*)(p.rope + spos * 32 + cq * 8 + 4);
            const f32x4 s0 = *(const f32x4*)(p.rope + NS * 32 + spos * 32 + cq * 8), s1 = *(const f32x4*)(p.rope + NS * 32 + spos * 32 + cq * 8 + 4);
            const float csv[8] = {c0.x, c0.y, c0.z, c0.w, c1.x, c1.y, c1.z, c1.w}, snv[8] = {s0.x, s0.y, s0.z, s0.w, s1.x, s1.y, s1.z, s1.w};
#pragma unroll
            for (int e = 0; e < 4; ++e) {
                const float cs[2] = {csv[2 * e], csv[2 * e + 1]}, sn[2] = {snv[2 * e], snv[2 * e + 1]};
                const float a1l = lo_bf(q1w[e]), a1h = hi_bf(q1w[e]), a2l = lo_bf(q2w[e]), a2h = hi_bf(q2w[e]);
                oq1[e] = pk2(a1l * cs[0] - a2l * sn[0], a1h * cs[1] - a2h * sn[1]);
                oq2[e] = pk2(a1l * sn[0] + a2l * cs[0], a1h * sn[1] + a2h * cs[1]);
                const float b1l = lo_bf(k1w[e]), b1h = hi_bf(k1w[e]), b2l = lo_bf(k2w[e]), b2h = hi_bf(k2w[e]);
                ok1[e] = pk2(b1l * cs[0] - b2l * sn[0], b1h * cs[1] - b2h * sn[1]);
                ok2[e] = pk2(b1l * sn[0] + b2l * cs[0], b1h * sn[1] + b2h * cs[1]);
            }
            *(u32x4*)(Qs + tok * LS + cq * 8) = (u32x4){oq1[0], oq1[1], oq1[2], oq1[3]};
            *(u32x4*)(Qs + tok * LS + 32 + cq * 8) = (u32x4){oq2[0], oq2[1], oq2[2], oq2[3]};
            *(u32x4*)(Ks + tok * LS + cq * 8) = (u32x4){ok1[0], ok1[1], ok1[2], ok1[3]};
            *(u32x4*)(Ks + tok * LS + 32 + cq * 8) = (u32x4){ok2[0], ok2[1], ok2[2], ok2[3]};
            for (int x = tid; x < 64 * 8; x += NTHREADS) {
                const int tk = x >> 3, ch = x & 7;
                const u32x4 vv = *(const u32x4*)(p.Z + (t0 + tk) * DINP + voff + ch * 8);
                const unsigned w[4] = {vv.x, vv.y, vv.z, vv.w};
#pragma unroll
                for (int e = 0; e < 4; ++e) { Vts[(ch * 8 + 2 * e) * LS + tk] = (bf16_t)(w[e] & 0xFFFFu); Vts[(ch * 8 + 2 * e + 1) * LS + tk] = (bf16_t)(w[e] >> 16); }
            }
        }
        __syncthreads();
        if (IS_GLA) {
            float gd[16];
            {
                const bf16_t* zr = p.Z + (t0 + lane) * DINP + gkdoff;
                const u32x4 g0 = *(const u32x4*)zr, g1 = *(const u32x4*)(zr + 8);
                gd[0] = lo_bf(g0.x); gd[1] = hi_bf(g0.x); gd[2] = lo_bf(g0.y); gd[3] = hi_bf(g0.y); gd[4] = lo_bf(g0.z); gd[5] = hi_bf(g0.z); gd[6] = lo_bf(g0.w); gd[7] = hi_bf(g0.w);
                gd[8] = lo_bf(g1.x); gd[9] = hi_bf(g1.x); gd[10] = lo_bf(g1.y); gd[11] = hi_bf(g1.y); gd[12] = lo_bf(g1.z); gd[13] = hi_bf(g1.z); gd[14] = lo_bf(g1.w); gd[15] = hi_bf(g1.w);
            }
#pragma unroll 1
            for (int dd = 0; dd < 12; ++dd) {
                const int d = wave * 12 + dd;
                float x = p.gk_bias[h * 48 + d];
#pragma unroll
                for (int i = 0; i < 16; ++i) x += gd[i] * p.gk_up[i * 192 + h * 48 + d];
                float gk = (fminf(x, 0.f) - log1pf(__expf(-fabsf(x)))) * (1.f / 16.f);
                float bc = gk;
#pragma unroll
                for (int o = 1; o < 64; o <<= 1) { const float t = __shfl_up(bc, o); if (lane >= o) bc += t; }
                const float bl = __shfl(bc, 63);
                const float eq = __expf(bc) * 0.14433756729740643f  , ek = __expf(-bc), ek2 = __expf(bl - bc);
                const float qv = bf2f(Qs[lane * LS + d]), kv = bf2f(Ks[lane * LS + d]);
                Qs[lane * LS + d] = f2bf(qv * eq);
                Ks[lane * LS + d] = f2bf(kv * ek);
                Kts[d * LS + lane] = f2bf(kv * ek2);
                if (lane == 0) decs[d] = __expf(bl);
            }
        } else {
            const float fqd = __expf(lg * (float)(lane + 1)), fk = 0.125f * __expf(-lg * (float)(lane + 1)), fk2 = 0.125f * __expf(lg * (float)(63 - lane));
#pragma unroll 1
            for (int dd = 0; dd < 16; ++dd) {
                const int d = wave * 16 + dd;
                const float qv = bf2f(Qs[lane * LS + d]), kv = bf2f(Ks[lane * LS + d]);
                Qs[lane * LS + d] = f2bf(qv * fqd);
                Ks[lane * LS + d] = f2bf(kv * fk);
                Kts[d * LS + lane] = f2bf(kv * fk2);
            }
            if (tid < 64) decs[tid] = __expf(lg * 64.f);
        }
        __syncthreads();
#pragma unroll
        for (int jb = 0; jb < 4; ++jb) {
            f32x4 ap = (f32x4){0.f, 0.f, 0.f, 0.f};
#pragma unroll
            for (int ks = 0; ks < 2; ++ks) {
                const bf16x8 a = ldfrag(Ks, 16 * jb + fl, ks * 32 + fq * 8);
                const bf16x8 bq = ldfrag(Qs, 16 * wave + fl, ks * 32 + fq * 8);
                ap = __builtin_amdgcn_mfma_f32_16x16x32_bf16(a, bq, ap, 0, 0, 0);
            }
            const int i = 16 * wave + fl, j0 = 16 * jb + 4 * fq;
            u32x2 w;
            w.x = pk2(j0 + 0 <= i ? ap.x : 0.f, j0 + 1 <= i ? ap.y : 0.f);
            w.y = pk2(j0 + 2 <= i ? ap.z : 0.f, j0 + 3 <= i ? ap.w : 0.f);
            *(u32x2*)(Ps + i * LS + j0) = w;
        }
        __syncthreads();
        {
            f32x4 ao[NVB];
            float ss = 0.f;
#pragma unroll
            for (int vb = 0; vb < NVB; ++vb) {
                f32x4 a4 = (f32x4){0.f, 0.f, 0.f, 0.f};
#pragma unroll
                for (int ks = 0; ks < 2; ++ks) {
                    const bf16x8 a = ldfrag(Vts, 16 * vb + fl, ks * 32 + fq * 8);
                    const bf16x8 bp = ldfrag(Ps, 16 * wave + fl, ks * 32 + fq * 8);
                    a4 = __builtin_amdgcn_mfma_f32_16x16x32_bf16(a, bp, a4, 0, 0, 0);
                }
#pragma unroll
                for (int ks = 0; ks < 2; ++ks) {
                    const bf16x8 a = ldfrag(Sts, 16 * vb + fl, ks * 32 + fq * 8);
                    const bf16x8 bq = ldfrag(Qs, 16 * wave + fl, ks * 32 + fq * 8);
                    a4 = __builtin_amdgcn_mfma_f32_16x16x32_bf16(a, bq, a4, 0, 0, 0);
                }
                ao[vb] = a4;
                ss += a4.x * a4.x + a4.y * a4.y + a4.z * a4.z + a4.w * a4.w;
            }
            ss = xor32_sum(xor16_sum(ss));
            const float inv = rsqrtf(ss * (1.f / DV) + 1e-5f);
            const size_t t = t0 + 16 * wave + fl;
#pragma unroll
            for (int vb = 0; vb < NVB; ++vb) {
                const int v0 = 16 * vb + 4 * fq;
                const u32x2 gg = *(const u32x2*)(p.Z + t * DINP + goff + v0);
                float g4[4] = {lo_bf(gg.x), hi_bf(gg.x), lo_bf(gg.y), hi_bf(gg.y)};
                float o4[4] = {ao[vb].x, ao[vb].y, ao[vb].z, ao[vb].w};
#pragma unroll
                for (int e = 0; e < 4; ++e) {
                    float y = o4[e] * inv;
                    if (IS_GLA) y *= p.norm_w[h * 96 + v0 + e];
                    const float g = g4[e];
                    o4[e] = y * (g / (1.f + __expf(-g)));
                }
                u32x2 w; w.x = pk2(o4[0], o4[1]); w.y = pk2(o4[2], o4[3]);
                *(u32x2*)(p.O + t * D + ooff + v0) = w;
            }
        }
        {
            f32x4 dc = *(const f32x4*)(decs + 16 * wave + 4 * fq);
#pragma unroll
            for (int vb = 0; vb < NVB; ++vb) {
                f32x4 a4 = accS[vb] * dc;
#pragma unroll
                for (int ks = 0; ks < 2; ++ks) {
                    const bf16x8 a = ldfrag(Kts, 16 * wave + fl, ks * 32 + fq * 8);
                    const bf16x8 bv = ldfrag(Vts, 16 * vb + fl, ks * 32 + fq * 8);
                    a4 = __builtin_amdgcn_mfma_f32_16x16x32_bf16(a, bv, a4, 0, 0, 0);
                }
                accS[vb] = a4;
            }
        }
        __syncthreads();
#pragma unroll
        for (int vb = 0; vb < NVB; ++vb) {
            u32x2 w; w.x = pk2(accS[vb].x, accS[vb].y); w.y = pk2(accS[vb].z, accS[vb].w);
            *(u32x2*)(Sts + (16 * vb + fl) * LS + 16 * wave + 4 * fq) = w;
        }
    }
    __syncthreads();
}

struct RwP {
    const bf16_t* Z; unsigned char* mix;
    const float* mu; const float* w_up; const float* w_bias; const float* a_up; const float* a_bias; const float* g_up;
    const float* k_k; const float* k_a; const float* r_k; const float* ln_w; const float* ln_b;
    float* oraw; bf16_t* O;
};
__device__ void phase_rwkv_prep(const RwP& p, char* smem, int bid, int nblk) {
    float* fs = (float*)smem;
    const int tid = otid(), lane = tid & 63;
    float* Wd = (float*)(p.mix + MX_W); float* KKd = (float*)(p.mix + MX_KK); float* KKAd = (float*)(p.mix + MX_KKA);
    bf16_t* Rd = (bf16_t*)(p.mix + MX_R); bf16_t* Kd = (bf16_t*)(p.mix + MX_K); bf16_t* Vd = (bf16_t*)(p.mix + MX_V); bf16_t* Gd = (bf16_t*)(p.mix + MX_G);
    for (int it = bid; it < NT / 8; it += nblk) {
        const int t0 = it * 8;
        for (int x = tid; x < 8 * RW_F; x += NTHREADS) {
            const int tok = x / RW_F, c = x % RW_F;
            const int t = t0 + tok;
            const float f = bf2f(p.Z[(size_t)t * DINP + ZC_RW + c]);
            const float fp = ((t & (NS - 1)) == 0) ? 0.f : bf2f(p.Z[(size_t)(t - 1) * DINP + ZC_RW + c]);
            float v = f + (fp - f) * p.mu[c];
            if (c >= 1152 && c < 1216) v = tanhf(v);
            else if (c >= 1280) v = sigmoidf_(v);
            fs[tok * RW_F + c] = v;
        }
        __syncthreads();
        for (int cc = tid; cc < 384; cc += NTHREADS) {
            float aw[8], aa[8], ag[8];
#pragma unroll
            for (int k = 0; k < 8; ++k) { aw[k] = 0.f; aa[k] = 0.f; ag[k] = 0.f; }
            for (int i = 0; i < 64; i += 4) {
                float w1[4], a1[4];
#pragma unroll
                for (int e = 0; e < 4; ++e) { w1[e] = p.w_up[(i + e) * 384 + cc]; a1[e] = p.a_up[(i + e) * 384 + cc]; }
#pragma unroll
                for (int k = 0; k < 8; ++k) {
                    const f32x4 xw = *(const f32x4*)(fs + k * RW_F + 1152 + i), xa = *(const f32x4*)(fs + k * RW_F + 1216 + i);
                    aw[k] += xw.x * w1[0] + xw.y * w1[1] + xw.z * w1[2] + xw.w * w1[3];
                    aa[k] += xa.x * a1[0] + xa.y * a1[1] + xa.z * a1[2] + xa.w * a1[3];
                }
            }
            for (int i = 0; i < 128; i += 4) {
                float g1[4];
#pragma unroll
                for (int e = 0; e < 4; ++e) g1[e] = p.g_up[(i + e) * 384 + cc];
#pragma unroll
                for (int k = 0; k < 8; ++k) {
                    const f32x4 xg = *(const f32x4*)(fs + k * RW_F + 1280 + i);
                    ag[k] += xg.x * g1[0] + xg.y * g1[1] + xg.z * g1[2] + xg.w * g1[3];
                }
            }
            const float wb = p.w_bias[cc], ab = p.a_bias[cc], kkc = p.k_k[cc], kac = p.k_a[cc];
            const int hd = cc >> 6, cl = cc & 63;
#pragma unroll
            for (int k = 0; k < 8; ++k) {
                const int t = t0 + k, b = t >> 12, s = t & (NS - 1);
                const size_t hi = ((size_t)(b * 6 + hd) * NS + s) * 64 + cl;
                const float wl = -softplusf_(-(wb + aw[k])) - 0.5f;
                const float dec = __expf(-__expf(wl));
                const float a = sigmoidf_(ab + aa[k]);
                const float r = fs[k * RW_F + cc], kx = fs[k * RW_F + 384 + cc], vx = fs[k * RW_F + 768 + cc];
                float kk = kx * kkc;
                const float ss = wave_sum(kk * kk);
                kk *= rsqrtf(fmaxf(ss, 1e-24f));
                const float kmod = kx * (1.f + (a - 1.f) * kac);
                Wd[hi] = dec; KKd[hi] = kk; KKAd[hi] = kk * a;
                Rd[hi] = f2bf(r); Kd[hi] = f2bf(kmod); Vd[hi] = f2bf(vx);
                Gd[(size_t)t * 384 + cc] = f2bf(ag[k]);
            }
        }
        __syncthreads();
    }
}

constexpr int SC_STEPS = 16;
__device__ void rwkv_scan_task(const RwP& p, char* smem, int bh, int qd) {
    float* buf = (float*)smem;
    float* obuf = buf + 2 * 6 * SC_STEPS * 64;
    const int tid = otid(), lane = tid & 63, wave = tid >> 6;
    const int rloc = wave * 4 + (lane >> 4);
    const int row = qd * 16 + rloc;
    const int c4 = (lane & 15) * 4;
    const float* Wd = (const float*)(p.mix + MX_W) + (size_t)bh * NS * 64;
    const float* KKd = (const float*)(p.mix + MX_KK) + (size_t)bh * NS * 64;
    const float* KKAd = (const float*)(p.mix + MX_KKA) + (size_t)bh * NS * 64;
    const bf16_t* Rd = (const bf16_t*)(p.mix + MX_R) + (size_t)bh * NS * 64;
    const bf16_t* Kd = (const bf16_t*)(p.mix + MX_K) + (size_t)bh * NS * 64;
    const bf16_t* Vd = (const bf16_t*)(p.mix + MX_V) + (size_t)bh * NS * 64;
    float* orow = p.oraw + (size_t)bh * NS * 64;
    f32x4 S = (f32x4){0.f, 0.f, 0.f, 0.f};
    f32x4 lw, lkk, lka; u32x2 lr, lk, lv;
    auto gload = [&](int ch) {
        const size_t e = (size_t)ch * SC_STEPS * 64 + tid * 4;
        lw = *(const f32x4*)(Wd + e); lkk = *(const f32x4*)(KKd + e); lka = *(const f32x4*)(KKAd + e);
        lr = *(const u32x2*)(Rd + e); lk = *(const u32x2*)(Kd + e); lv = *(const u32x2*)(Vd + e);
    };
    auto lstore = [&](int bsel) {
        float* bb = buf + bsel * 6 * SC_STEPS * 64 + tid * 4;
        *(f32x4*)(bb + 0 * SC_STEPS * 64) = lw; *(f32x4*)(bb + 1 * SC_STEPS * 64) = lkk; *(f32x4*)(bb + 2 * SC_STEPS * 64) = lka;
        *(f32x4*)(bb + 3 * SC_STEPS * 64) = (f32x4){lo_bf(lr.x), hi_bf(lr.x), lo_bf(lr.y), hi_bf(lr.y)};
        *(f32x4*)(bb + 4 * SC_STEPS * 64) = (f32x4){lo_bf(lk.x), hi_bf(lk.x), lo_bf(lk.y), hi_bf(lk.y)};
        *(f32x4*)(bb + 5 * SC_STEPS * 64) = (f32x4){lo_bf(lv.x), hi_bf(lv.x), lo_bf(lv.y), hi_bf(lv.y)};
    };
    __syncthreads();
    gload(0); lstore(0);
    __syncthreads();
    constexpr int NCH = NS / SC_STEPS;
    for (int ch = 0; ch < NCH; ++ch) {
        if (ch + 1 < NCH) gload(ch + 1);
        const float* bb = buf + (ch & 1) * 6 * SC_STEPS * 64;
#pragma unroll 4
        for (int st = 0; st < SC_STEPS; ++st) {
            const f32x4 w4 = *(const f32x4*)(bb + 0 * SC_STEPS * 64 + st * 64 + c4);
            const f32x4 kk4 = *(const f32x4*)(bb + 1 * SC_STEPS * 64 + st * 64 + c4);
            const f32x4 ka4 = *(const f32x4*)(bb + 2 * SC_STEPS * 64 + st * 64 + c4);
            const f32x4 r4 = *(const f32x4*)(bb + 3 * SC_STEPS * 64 + st * 64 + c4);
            const f32x4 k4 = *(const f32x4*)(bb + 4 * SC_STEPS * 64 + st * 64 + c4);
            const float vv = bb[5 * SC_STEPS * 64 + st * 64 + row];
            float pd = S.x * kk4.x + S.y * kk4.y + S.z * kk4.z + S.w * kk4.w;
            const float sa = -row16_sum(pd);
            S.x = S.x * w4.x + vv * k4.x + sa * ka4.x;
            S.y = S.y * w4.y + vv * k4.y + sa * ka4.y;
            S.z = S.z * w4.z + vv * k4.z + sa * ka4.z;
            S.w = S.w * w4.w + vv * k4.w + sa * ka4.w;
            float od = S.x * r4.x + S.y * r4.y + S.z * r4.z + S.w * r4.w;
            od = row16_sum(od);
            if ((lane & 15) == 0) obuf[st * 16 + rloc] = od;
        }
        __syncthreads();
        {
            const int st = tid >> 4, rr = tid & 15;
            orow[((size_t)ch * SC_STEPS + st) * 64 + qd * 16 + rr] = obuf[tid];
        }
        if (ch + 1 < NCH) lstore((ch + 1) & 1);
        __syncthreads();
    }
}

__device__ void phase_rwkv_post(const RwP& p, int bid, int nblk) {
    const int lane = otid() & 63, wave = otid() >> 6;
    const bf16_t* Rd = (const bf16_t*)(p.mix + MX_R); const bf16_t* Kd = (const bf16_t*)(p.mix + MX_K); const bf16_t* Vd = (const bf16_t*)(p.mix + MX_V);
    const bf16_t* Gd = (const bf16_t*)(p.mix + MX_G);
    for (int x = bid * 4 + wave; x < NT * 6; x += nblk * 4) {
        const int t = x / 6, hd = x % 6, b = t >> 12, s = t & (NS - 1);
        const size_t hi = ((size_t)(b * 6 + hd) * NS + s) * 64 + lane;
        const float o = p.oraw[hi];
        const float mean = wave_sum(o) * (1.f / 64.f);
        const float dv = o - mean;
        const float var = wave_sum(dv * dv) * (1.f / 64.f);
        float on = dv * rsqrtf(var + 64e-5f) * p.ln_w[hd * 64 + lane] + p.ln_b[hd * 64 + lane];
        const float r = bf2f(Rd[hi]), k = bf2f(Kd[hi]), v = bf2f(Vd[hi]);
        const float rk = wave_sum(r * k * p.r_k[hd * 64 + lane]);
        on += rk * v;
        const float g = bf2f(Gd[(size_t)t * 384 + hd * 64 + lane]);
        p.O[(size_t)t * D + 256 + hd * 64 + lane] = f2bf(on * g);
    }
}

__device__ __forceinline__ unsigned ordkey(float f) { const unsigned u = __float_as_uint(f); return (u & 0x80000000u) ? ~u : (u | 0x80000000u); }
__device__ __forceinline__ void top16_128(float a0, float a1, int lane, float& outv, int& outi) {
    unsigned k0 = (ordkey(a0) & 0xFFFFFF80u) | (unsigned)(127 - lane);
    unsigned k1 = (ordkey(a1) & 0xFFFFFF80u) | (unsigned)(63 - lane);
    outv = 0.f; outi = 0;
    for (int it = 0; it < 16; ++it) {
        const unsigned m = k0 > k1 ? k0 : k1;
        const unsigned wm = wave_max_u32(m);
        const int idx = 127 - (int)(wm & 127u);
        const float cand = (idx >> 6) ? a1 : a0;
        const float val = __shfl(cand, idx & 63);
        if (lane == it) { outv = val; outi = idx; }
        if (k0 == wm) k0 = 0u;
        if (k1 == wm) k1 = 0u;
    }
}
__device__ void phase_topk(const float* SC, int* EIDX, float* GATE, int bid, int nblk) {
    const int lane = otid() & 63, wave = otid() >> 6;
    int ci, cj;
    {
        const int c = lane;
        if (c < 16) { ci = 0; cj = c; } else if (c < 24) { ci = 1; cj = c - 16; } else if (c < 29) { ci = 2; cj = c - 24; } else if (c < 33) { ci = 3; cj = c - 29; }
        else if (c < 36) { ci = 4; cj = c - 33; } else if (c < 38) { ci = 5; cj = c - 36; } else if (c < 40) { ci = 6; cj = c - 38; } else if (c < 42) { ci = 7; cj = c - 40; }
        else if (c < 50) { ci = c - 34; cj = 0; } else { ci = 0; cj = 0; }
    }
    for (int x = bid * 4 + wave; x < NT * 8; x += nblk * 4) {
        const int t = x >> 3, hd = x & 7;
        const float* sc = SC + (size_t)t * 2048 + hd * 256;
        float s1, s2; int i1, i2;
        top16_128(sc[lane], sc[64 + lane], lane, s1, i1);
        top16_128(sc[128 + lane], sc[192 + lane], lane, s2, i2);
        const float cv = __shfl(s1, ci) + __shfl(s2, cj);
        const int ce = __shfl(i1, ci) * 128 + __shfl(i2, cj);
        unsigned key = (lane < 50) ? ((ordkey(cv) & 0xFFFFFFC0u) | (unsigned)(63 - lane)) : 0u;
        float tv = 0.f; int te = 0;
        for (int it = 0; it < 16; ++it) {
            const unsigned wm = wave_max_u32(key);
            const int wl = 63 - (int)(wm & 63u);
            const float v = __shfl(cv, wl); const int e = __shfl(ce, wl);
            if (lane == it) { tv = v; te = e; }
            if (key == wm) key = 0u;
        }
        const float mx = __shfl(tv, 0);
        const float ex = (lane < 16) ? __expf(tv - mx) : 0.f;
        const float sum = wave_sum(ex);
        if (lane < 16) { EIDX[(size_t)t * 128 + hd * 16 + lane] = te; GATE[(size_t)t * 128 + hd * 16 + lane] = ex / sum; }
    }
}

typedef float f32x2 __attribute__((ext_vector_type(2)));
__device__ __forceinline__ void dec16(const u32x4 w, float (&f)[16]) {
    const unsigned ww[4] = {w.x, w.y, w.z, w.w};
#pragma unroll
    for (int i = 0; i < 4; ++i) {
        const f32x2 a = __builtin_amdgcn_cvt_pk_f32_fp8((int)ww[i], false), b = __builtin_amdgcn_cvt_pk_f32_fp8((int)ww[i], true);
        f[4 * i] = a.x; f[4 * i + 1] = a.y; f[4 * i + 2] = b.x; f[4 * i + 3] = b.y;
    }
}
__device__ void phase_expert(const bf16_t* H, const unsigned char* U8, const unsigned char* V8, const int* EIDX, const float* GATE, const float* X, float* Xo, int bid, int nblk) {
    const int lane = otid() & 63, wave = otid() >> 6;
    for (int t = bid * 4 + wave; t < NT; t += nblk * 4) {
        float xf[16], acc[16];
        {
            const u32x4 a = *(const u32x4*)(H + (size_t)t * D + lane * 16), b = *(const u32x4*)(H + (size_t)t * D + lane * 16 + 8);
            xf[0] = lo_bf(a.x); xf[1] = hi_bf(a.x); xf[2] = lo_bf(a.y); xf[3] = hi_bf(a.y); xf[4] = lo_bf(a.z); xf[5] = hi_bf(a.z); xf[6] = lo_bf(a.w); xf[7] = hi_bf(a.w);
            xf[8] = lo_bf(b.x); xf[9] = hi_bf(b.x); xf[10] = lo_bf(b.y); xf[11] = hi_bf(b.y); xf[12] = lo_bf(b.z); xf[13] = hi_bf(b.z); xf[14] = lo_bf(b.w); xf[15] = hi_bf(b.w);
        }
#pragma unroll
        for (int i = 0; i < 16; ++i) acc[i] = 0.f;
        for (int e0 = 0; e0 < 128; e0 += 8) {
            int ei[8]; float act[8]; u32x4 ur[8];
#pragma unroll
            for (int j = 0; j < 8; ++j) { ei[j] = EIDX[(size_t)t * 128 + e0 + j]; ur[j] = *(const u32x4*)(U8 + (size_t)ei[j] * D + lane * 16); }
#pragma unroll
            for (int j = 0; j < 8; ++j) {
                float uf[16]; dec16(ur[j], uf);
                float d = 0.f;
#pragma unroll
                for (int i = 0; i < 16; ++i) d += xf[i] * uf[i];
                d = wave_sum(d) * (1.f / 512.f);
                act[j] = 0.5f * d * (1.f + erff(d * 0.7071067811865476f)) * GATE[(size_t)t * 128 + e0 + j] * (1.f / 64.f);
            }
#pragma unroll
            for (int j = 0; j < 8; ++j) ur[j] = *(const u32x4*)(V8 + (size_t)ei[j] * D + lane * 16);
#pragma unroll
            for (int j = 0; j < 8; ++j) {
                float vf[16]; dec16(ur[j], vf);
#pragma unroll
                for (int i = 0; i < 16; ++i) acc[i] += act[j] * vf[i];
            }
        }
        const f32x4* xr = (const f32x4*)(X + (size_t)t * D) + lane * 4;
        f32x4* xo = (f32x4*)(Xo + (size_t)t * D) + lane * 4;
#pragma unroll
        for (int i = 0; i < 4; ++i) { f32x4 o = xr[i]; o += (f32x4){acc[4 * i], acc[4 * i + 1], acc[4 * i + 2], acc[4 * i + 3]}; xo[i] = o; }
    }
}

#define XB_TMO      128
#define XB_XCNT(j)  (256  + 64 * (j))
#define XB_XSUB(j)  (1280 + 64 * (j))
#define XB_XGEN(j)  (2304 + 64 * (j))
#define XB_TOP      3328
#define XB_TOPGEN   3392
#define XCD_BAR_WORDS 3456
#define XB_SPIN_CAP (1u << 22)
#define LAS __attribute__((address_space(3)))
__device__ __forceinline__ unsigned xb_ld(unsigned* p)              { return __hip_atomic_load(p, __ATOMIC_RELAXED, __HIP_MEMORY_SCOPE_AGENT); }
__device__ __forceinline__ unsigned xb_add(unsigned* p, unsigned v) { return __hip_atomic_fetch_add(p, v, __ATOMIC_RELAXED, __HIP_MEMORY_SCOPE_AGENT); }
__device__ __forceinline__ unsigned xb_xcc_id() { return (unsigned)__builtin_amdgcn_s_getreg((3 << 11) | 20) & 0xFu; }
#define XB_SPIN(cond, bar) do { unsigned _sp = 0; while (cond) { __builtin_amdgcn_s_sleep(1); \
    if ((++_sp & 255u) == 0u) { if (xb_ld(&(bar)[XB_TMO])) break; if (_sp > XB_SPIN_CAP) { atomicAdd(&(bar)[XB_TMO], 1u); break; } } } } while (0)
struct XcdBarrier { unsigned* bar; unsigned x; volatile LAS unsigned* st; };
__device__ __forceinline__ XcdBarrier xcd_barrier_post(unsigned* bar, volatile LAS unsigned* st) {
    XcdBarrier b; b.bar = bar; b.x = xb_xcc_id(); b.st = st;
    if (threadIdx.x == 0) (void)xb_add(&bar[XB_XCNT(b.x)], 1u);
    return b;
}
__device__ __forceinline__ void xcd_barrier_complete(unsigned* bar, unsigned x, unsigned& nloc, unsigned& nx) {
    const unsigned G = gridDim.x * gridDim.y * gridDim.z;
    unsigned sum, cnt, mine, sp = 0u;
    for (;;) {
        sum = 0u; cnt = 0u; mine = 0u;
#pragma unroll
        for (unsigned j = 0; j < 16; ++j) { const unsigned c = xb_ld(&bar[XB_XCNT(j)]); sum += c; cnt += (c > 0u) ? 1u : 0u; mine = (j == x) ? c : mine; }
        if (sum == G) break;
        __builtin_amdgcn_s_sleep(1);
        if ((++sp & 255u) == 0u) { if (xb_ld(&bar[XB_TMO])) break; if (sp > XB_SPIN_CAP) { atomicAdd(&bar[XB_TMO], 1u); break; } }
    }
    nloc = mine > 0u ? mine : 1u; nx = cnt > 0u ? cnt : 1u;
}
__device__ __forceinline__ void xcd_barrier(const XcdBarrier& b) {
    asm volatile("s_waitcnt vmcnt(0)" ::: "memory");
    __syncthreads();
    if (threadIdx.x == 0) {
        unsigned* bar = b.bar;
        __builtin_amdgcn_s_waitcnt(0);
        unsigned nloc = b.st[0], nx = b.st[1];
        if (nloc == 0u) { xcd_barrier_complete(bar, b.x, nloc, nx); b.st[0] = nloc; b.st[1] = nx; }
        const unsigned old = xb_add(&bar[XB_XSUB(b.x)], 1u);
        const unsigned gen = old / nloc;
        if (old + 1u == (gen + 1u) * nloc) {
            __builtin_amdgcn_fence(__ATOMIC_RELEASE, "agent");
            asm volatile("s_waitcnt vmcnt(0)" ::: "memory");
            const unsigned og = xb_add(&bar[XB_TOP], 1u);
            const unsigned tg = og / nx;
            if (og + 1u == (tg + 1u) * nx) xb_add(&bar[XB_TOPGEN], 1u);
            else XB_SPIN(xb_ld(&bar[XB_TOPGEN]) == tg, bar);
            __builtin_amdgcn_fence(__ATOMIC_ACQUIRE, "agent");
            xb_add(&bar[XB_XGEN(b.x)], 1u);
            asm volatile("s_waitcnt vmcnt(0)" ::: "memory");
        } else {
            XB_SPIN(xb_ld(&bar[XB_XGEN(b.x)]) == gen, bar);
            __builtin_amdgcn_fence(__ATOMIC_ACQUIRE, "agent");
            asm volatile("s_waitcnt vmcnt(0)" ::: "memory");
        }
    }
    __syncthreads();
}

struct Params {
    const float* in[24];
    float* out; unsigned char* ws;
};
constexpr int LDS_BYTES = 65536;

__device__ __forceinline__ RwP make_rwp(const Params& P, int l) {
    RwP r;
    r.Z = (const bf16_t*)(P.ws + WS_Z); r.mix = P.ws + WS_MIX;
    r.mu = P.in[6] + l * RW_F; r.w_up = P.in[7] + (size_t)l * 64 * 384; r.w_bias = P.in[8] + l * 384; r.a_up = P.in[9] + (size_t)l * 64 * 384; r.a_bias = P.in[10] + l * 384;
    r.g_up = P.in[11] + (size_t)l * 128 * 384; r.k_k = P.in[12] + l * 384; r.k_a = P.in[13] + l * 384; r.r_k = P.in[14] + l * 384; r.ln_w = P.in[15] + l * 384; r.ln_b = P.in[16] + l * 384;
    r.oraw = (float*)(P.ws + WS_H); r.O = (bf16_t*)(P.ws + WS_O);
    return r;
}

__global__ void __launch_bounds__(NTHREADS, 2) mega_fwd(Params P) {
    __shared__ __attribute__((aligned(16))) char smem[LDS_BYTES];
    const int bid = blockIdx.x, nblk = gridDim.x;
    volatile LAS unsigned* st = (volatile LAS unsigned*)(smem + LDS_BYTES - 16);
    if (threadIdx.x == 0) { st[0] = 0u; st[1] = 0u; st[2] = 0u; st[3] = 0u; }
    __syncthreads();
    XcdBarrier bar = xcd_barrier_post((unsigned*)(P.ws + WS_CTL), st);
#define GSYNC() xcd_barrier(bar)

    {
        ConvP c{P.in[4], P.in[5], P.in[20], P.in[21], P.in[22], P.in[23], P.ws};
        for (int rep = 0; rep < REP_CONV; ++rep) phase_convert_weights(c, smem, bid, nblk);
        phase_rmsnorm<false>(P.in[0], P.in[1], P.ws + WS_H, bid, nblk);
    }
    GSYNC();
#pragma unroll 1
    for (int l = 0; l < 2; ++l) {
        const float* xin = (l == 0) ? P.in[0] : P.out;
        {
            GemmP g{(const bf16_t*)(P.ws + WS_H), D, 0, (const bf16_t*)(P.ws + WS_WTIN) + (size_t)l * DINP * D, D, D, NT / 128, DINP / 128, P.ws + WS_Z, DINP, nullptr};
            for (int rep = 0; rep < REP_GIN; ++rep) phase_gemm<0>(g, smem, bid, nblk);
        }
        GSYNC();
        RwP rw = make_rwp(P, l);
        for (int rep = 0; rep < REP_PREP; ++rep) phase_rwkv_prep(rw, smem, bid, nblk);
        GSYNC();
        {
            LinP lp{(const bf16_t*)(P.ws + WS_Z), (bf16_t*)(P.ws + WS_O), P.in[17] + (size_t)l * 16 * 192, P.in[18] + l * 192, P.in[19] + l * 384, (const float*)(P.ws + WS_ROPE)};
            for (int task = bid; task < 128; task += nblk) {
                if (task < 96) { for (int rep = 0; rep < REP_SCAN; ++rep) rwkv_scan_task(rw, smem, task >> 2, task & 3); }
                else if (task < 112) { for (int rep = 0; rep < REP_LIN; ++rep) linattn_task<false>(lp, smem, (task - 96) >> 2, (task - 96) & 3); }
                else { for (int rep = 0; rep < REP_LIN; ++rep) linattn_task<true>(lp, smem, (task - 112) >> 2, (task - 112) & 3); }
            }
        }
        GSYNC();
        for (int rep = 0; rep < REP_POST; ++rep) phase_rwkv_post(rw, bid, nblk);
        GSYNC();
        {
            GemmP g{(const bf16_t*)(P.ws + WS_O), D, 0, (const bf16_t*)(P.ws + WS_WTOUT) + (size_t)l * D * D, D, D, NT / 128, D / 128, P.out, D, xin};
            phase_gemm<2>(g, smem, bid, nblk);
            for (int rep = 1; rep < REP_GOUT; ++rep) { GemmP g2 = g; g2.C = P.ws + WS_MIX; phase_gemm<2>(g2, smem, bid, nblk); }
        }
        GSYNC();
        for (int rep = 0; rep < REP_NORM; ++rep) phase_rmsnorm<false>(P.out, P.in[2] + l * D, P.ws + WS_H, bid, nblk);
        GSYNC();
        {
            GemmP g{(const bf16_t*)(P.ws + WS_H), D, 0, (const bf16_t*)(P.ws + WS_WTQ) + (size_t)l * 2048 * D, D, D, NT / 128, 2048 / 128, P.ws + WS_Z, 2048, nullptr};
            for (int rep = 0; rep < REP_GQ; ++rep) phase_gemm<0>(g, smem, bid, nblk);
        }
        GSYNC();
        {
            GemmP g{(const bf16_t*)(P.ws + WS_Z), 2048, 128, (const bf16_t*)(P.ws + WS_SK) + (size_t)l * 16 * 128 * 128, 128, 128, NT / 128, 16, P.ws + WS_MIX, 2048, nullptr};
            for (int rep = 0; rep < REP_GSK; ++rep) phase_gemm<1>(g, smem, bid, nblk);
        }
        GSYNC();
        for (int rep = 0; rep < REP_TOPK; ++rep) phase_topk((const float*)(P.ws + WS_MIX), (int*)(P.ws + WS_EIDX), (float*)(P.ws + WS_GATE), bid, nblk);
        GSYNC();
        phase_expert((const bf16_t*)(P.ws + WS_H), P.ws + WS_UB + (size_t)l * NEXP * D, P.ws + WS_VB + (size_t)l * NEXP * D,
                     (const int*)(P.ws + WS_EIDX), (const float*)(P.ws + WS_GATE), P.out, P.out, bid, nblk);
        for (int rep = 1; rep < REP_EXP; ++rep) phase_expert((const bf16_t*)(P.ws + WS_H), P.ws + WS_UB + (size_t)l * NEXP * D, P.ws + WS_VB + (size_t)l * NEXP * D,
                     (const int*)(P.ws + WS_EIDX), (const float*)(P.ws + WS_GATE), P.out, (float*)(P.ws + WS_Z), bid, nblk);
        GSYNC();
        if (l == 0) { phase_rmsnorm<false>(P.out, P.in[1] + D, P.ws + WS_H, bid, nblk); GSYNC(); }
    }
    phase_rmsnorm<true>(P.out, P.in[3], P.out, bid, nblk);
}

extern "C" void kernel_launch(void* const* d_in, const int* in_sizes, int n_in, void* d_out, int out_size, void* d_ws, size_t ws_size, hipStream_t stream) {
    static int grid = 0;
    if (grid == 0) {
        if (n_in != 24 || ws_size < WS_END) { fprintf(stderr, "kernel_launch: bad args n_in=%d ws=%zu need=%zu\n", n_in, ws_size, (size_t)WS_END); grid = -1; return; }
        int dev = 0, cus = 0, per_cu = 0;
        hipGetDevice(&dev);
        hipDeviceGetAttribute(&cus, hipDeviceAttributeMultiprocessorCount, dev);
        hipOccupancyMaxActiveBlocksPerMultiprocessor(&per_cu, (const void*)mega_fwd, NTHREADS, 0);
        if (per_cu < 1) { fprintf(stderr, "kernel_launch: occupancy query says %d\n", per_cu); grid = -1; return; }
        if (per_cu > 2) per_cu = 2;
        grid = cus * per_cu;
        fprintf(stderr, "kernel_launch: grid %d (%d CUs x %d)\n", grid, cus, per_cu);
    }
    if (grid < 0) return;
    hipMemsetAsync((char*)d_ws + WS_CTL, 0, XCD_BAR_WORDS * 4, stream);
    Params P{};
    for (int i = 0; i < 24; ++i) P.in[i] = (const float*)d_in[i];
    P.out = (float*)d_out; P.ws = (unsigned char*)d_ws;
    void* args[] = {&P};
    hipError_t e = hipLaunchCooperativeKernel((const void*)mega_fwd, dim3(grid), dim3(NTHREADS), args, 0, stream);
    if (e != hipSuccess) fprintf(stderr, "cooperative launch failed: %s (grid %d)\n", hipGetErrorString(e), grid);
}
```

```cpp
#include <hip/hip_runtime.h>
#include <stdint.h>
#include <stdio.h>

typedef unsigned short bf16_t;
typedef short bf16x8 __attribute__((ext_vector_type(8)));
typedef float f32x4 __attribute__((ext_vector_type(4)));
typedef unsigned u32x4 __attribute__((ext_vector_type(4)));
typedef unsigned u32x2 __attribute__((ext_vector_type(2)));

#define REP_CONV 1
#define REP_GIN 1
#define REP_PREP 1
#define REP_SCAN 1
#define REP_LIN 1
#define REP_POST 1
#define REP_GOUT 1
#define REP_NORM 1
#define REP_GQ 1
#define REP_GSK 1
#define REP_TOPK 1
#define REP_EXP 1
constexpr int NB = 4, NS = 4096, NT = NB * NS, D = 1024, DIN = 3600, DINP = 3712;
constexpr int ZC_RET = 0, ZC_RW = 1024, ZC_GLA = 2432;
constexpr int RW_F = 1408;
constexpr int NEXP = 16384;
constexpr int NTHREADS = 256;

constexpr size_t MiB = 1024ull * 1024ull;
constexpr size_t WS_CTL   = 0;
constexpr size_t WS_WTIN  = 1 * MiB;
constexpr size_t WS_WTOUT = WS_WTIN + 2ull * DINP * D * 2;
constexpr size_t WS_WTQ   = WS_WTOUT + 2ull * D * D * 2;
constexpr size_t WS_SK    = WS_WTQ + 2ull * 2048 * D * 2;
constexpr size_t WS_UB    = WS_SK + 2ull * 16 * 128 * 128 * 2;
constexpr size_t WS_VB    = WS_UB + 2ull * NEXP * D;
constexpr size_t WS_LIN   = WS_VB + 2ull * NEXP * D;
constexpr size_t WS_H     = WS_LIN + 64 * MiB;
constexpr size_t WS_Z     = WS_H + (size_t)NT * D * 2;
constexpr size_t WS_O     = WS_Z + (size_t)NT * DINP * 2;
constexpr size_t WS_MIX   = WS_O + (size_t)NT * D * 2;
constexpr size_t WS_EIDX  = WS_MIX + 128 * MiB;
constexpr size_t WS_GATE  = WS_EIDX + (size_t)NT * 128 * 4;
constexpr size_t WS_ROPE  = WS_GATE + (size_t)NT * 128 * 4;
constexpr size_t WS_END   = WS_ROPE + 1 * MiB;
constexpr size_t RWA = (size_t)NT * 384;
constexpr size_t MX_W   = 0;
constexpr size_t MX_KK  = MX_W + RWA * 4;
constexpr size_t MX_KKA = MX_KK + RWA * 4;
constexpr size_t MX_R   = MX_KKA + RWA * 4;
constexpr size_t MX_K   = MX_R + RWA * 2;
constexpr size_t MX_V   = MX_K + RWA * 2;
constexpr size_t MX_G   = MX_V + RWA * 2;
constexpr size_t MX_END = MX_G + RWA * 2;
static_assert(MX_END <= 128 * MiB, "mix region");

__device__ __forceinline__ float bf2f(bf16_t v) { return __uint_as_float(((unsigned)v) << 16); }
__device__ __forceinline__ bf16_t f2bf(float f) { unsigned u = __float_as_uint(f); u += 0x7FFFu + ((u >> 16) & 1u); return (bf16_t)(u >> 16); }
__device__ __forceinline__ unsigned pk2(float lo, float hi) { return (unsigned)f2bf(lo) | ((unsigned)f2bf(hi) << 16); }
__device__ __forceinline__ float lo_bf(unsigned u) { return __uint_as_float(u << 16); }
__device__ __forceinline__ float hi_bf(unsigned u) { return __uint_as_float(u & 0xFFFF0000u); }
template <int CTRL> __device__ __forceinline__ float dpp_f(float v) { return __int_as_float(__builtin_amdgcn_update_dpp(0, __float_as_int(v), CTRL, 0xF, 0xF, true)); }
template <int CTRL> __device__ __forceinline__ unsigned dpp_u(unsigned v) { return (unsigned)__builtin_amdgcn_update_dpp(0, (int)v, CTRL, 0xF, 0xF, true); }
__device__ __forceinline__ float row16_sum(float v) { v += dpp_f<0x128>(v); v += dpp_f<0x124>(v); v += dpp_f<0x122>(v); v += dpp_f<0x121>(v); return v; }
__device__ __forceinline__ float xor16_sum(float v) { auto r = __builtin_amdgcn_permlane16_swap(__float_as_uint(v), __float_as_uint(v), false, false); return __uint_as_float(r[0]) + __uint_as_float(r[1]); }
__device__ __forceinline__ float xor32_sum(float v) { auto r = __builtin_amdgcn_permlane32_swap(__float_as_uint(v), __float_as_uint(v), false, false); return __uint_as_float(r[0]) + __uint_as_float(r[1]); }
__device__ __forceinline__ float wave_sum(float v) { return xor32_sum(xor16_sum(row16_sum(v))); }
__device__ __forceinline__ unsigned umax_(unsigned a, unsigned b) { return a > b ? a : b; }
__device__ __forceinline__ unsigned wave_max_u32(unsigned v) {
    v = umax_(v, dpp_u<0x128>(v)); v = umax_(v, dpp_u<0x124>(v)); v = umax_(v, dpp_u<0x122>(v)); v = umax_(v, dpp_u<0x121>(v));
    { auto r = __builtin_amdgcn_permlane16_swap(v, v, false, false); v = umax_(r[0], r[1]); }
    { auto r = __builtin_amdgcn_permlane32_swap(v, v, false, false); v = umax_(r[0], r[1]); }
    return v;
}
__device__ __forceinline__ float sigmoidf_(float x) { return 1.f / (1.f + __expf(-x)); }
__device__ __forceinline__ float softplusf_(float x) { return fmaxf(x, 0.f) + log1pf(__expf(-fabsf(x))); }

__device__ __forceinline__ int otid() { int t = threadIdx.x; asm volatile("" : "+v"(t)); return t; }

__device__ void transpose_tile(const float* __restrict__ W, int K, int N, bf16_t* __restrict__ Wt, int kt, int nt, float* tile  ) {
    const int tid = otid();
    const int k0 = kt * 64, n0 = nt * 64;
#pragma unroll
    for (int i = 0; i < 16; ++i) {
        const int k = i * 4 + (tid >> 6), n = tid & 63;
        tile[k * 65 + n] = (n0 + n < N) ? W[(size_t)(k0 + k) * N + n0 + n] : 0.f;
    }
    __syncthreads();
#pragma unroll
    for (int i = 0; i < 16; ++i) {
        const int n = i * 4 + (tid >> 6), k = tid & 63;
        Wt[(size_t)(n0 + n) * K + k0 + k] = f2bf(tile[k * 65 + n]);
    }
    __syncthreads();
}

struct ConvP {
    const float* w_in; const float* w_out; const float* w_q; const float* sk; const float* u; const float* v;
    unsigned char* ws;
};

__device__ void phase_convert_weights(const ConvP& p, char* smem, int bid, int nblk) {
    float* tile = (float*)smem;
    constexpr int T_IN = 16 * 58, T_OUT = 16 * 16, T_Q = 16 * 32, T_L = T_IN + T_OUT + T_Q;
    for (int it = bid; it < 2 * T_L; it += nblk) {
        const int l = it / T_L; int r = it % T_L;
        if (r < T_IN) { transpose_tile(p.w_in + (size_t)l * D * DIN, D, DIN, (bf16_t*)(p.ws + WS_WTIN) + (size_t)l * DINP * D, r / 58, r % 58, tile); continue; }
        r -= T_IN;
        if (r < T_OUT) { transpose_tile(p.w_out + (size_t)l * D * D, D, D, (bf16_t*)(p.ws + WS_WTOUT) + (size_t)l * D * D, r / 16, r % 16, tile); continue; }
        r -= T_OUT;
        transpose_tile(p.w_q + (size_t)l * D * 2048, D, 2048, (bf16_t*)(p.ws + WS_WTQ) + (size_t)l * 2048 * D, r / 32, r % 32, tile);
    }
    const size_t gtid = (size_t)bid * NTHREADS + otid(), gn = (size_t)nblk * NTHREADS;
    {
        float* ct = (float*)(p.ws + WS_ROPE); float* stb = ct + NS * 32;
        for (size_t i = gtid; i < (size_t)NS * 32; i += gn) {
            const int pos = (int)(i >> 5), fi = (int)(i & 31);
            const float inv = exp2f(-(float)fi * (13.287712379549449f / 32.f));
            float sn, cs; sincosf((float)pos * inv, &sn, &cs);
            ct[i] = cs; stb[i] = sn;
        }
    }
    {
        const size_t n8 = (2ull * 16 * 128 * 128) / 8;
        const f32x4* s = (const f32x4*)p.sk; u32x4* d = (u32x4*)(p.ws + WS_SK);
        for (size_t i = gtid; i < n8; i += gn) { f32x4 a = s[2 * i], b = s[2 * i + 1]; u32x4 o; o.x = pk2(a.x, a.y); o.y = pk2(a.z, a.w); o.z = pk2(b.x, b.y); o.w = pk2(b.z, b.w); d[i] = o; }
    }
    {
        const size_t n16 = (2ull * NEXP * D) / 16;
        const f32x4* su = (const f32x4*)p.u; u32x4* du = (u32x4*)(p.ws + WS_UB);
        const f32x4* sv = (const f32x4*)p.v; u32x4* dv = (u32x4*)(p.ws + WS_VB);
        for (size_t i = gtid; i < n16; i += gn) {
            f32x4 a = su[4 * i] * 512.f, b = su[4 * i + 1] * 512.f, c = su[4 * i + 2] * 512.f, d = su[4 * i + 3] * 512.f;
            u32x4 o;
            o.x = (unsigned)__builtin_amdgcn_cvt_pk_fp8_f32(a.z, a.w, __builtin_amdgcn_cvt_pk_fp8_f32(a.x, a.y, 0, false), true);
            o.y = (unsigned)__builtin_amdgcn_cvt_pk_fp8_f32(b.z, b.w, __builtin_amdgcn_cvt_pk_fp8_f32(b.x, b.y, 0, false), true);
            o.z = (unsigned)__builtin_amdgcn_cvt_pk_fp8_f32(c.z, c.w, __builtin_amdgcn_cvt_pk_fp8_f32(c.x, c.y, 0, false), true);
            o.w = (unsigned)__builtin_amdgcn_cvt_pk_fp8_f32(d.z, d.w, __builtin_amdgcn_cvt_pk_fp8_f32(d.x, d.y, 0, false), true);
            du[i] = o;
            a = sv[4 * i] * 64.f; b = sv[4 * i + 1] * 64.f; c = sv[4 * i + 2] * 64.f; d = sv[4 * i + 3] * 64.f;
            o.x = (unsigned)__builtin_amdgcn_cvt_pk_fp8_f32(a.z, a.w, __builtin_amdgcn_cvt_pk_fp8_f32(a.x, a.y, 0, false), true);
            o.y = (unsigned)__builtin_amdgcn_cvt_pk_fp8_f32(b.z, b.w, __builtin_amdgcn_cvt_pk_fp8_f32(b.x, b.y, 0, false), true);
            o.z = (unsigned)__builtin_amdgcn_cvt_pk_fp8_f32(c.z, c.w, __builtin_amdgcn_cvt_pk_fp8_f32(c.x, c.y, 0, false), true);
            o.w = (unsigned)__builtin_amdgcn_cvt_pk_fp8_f32(d.z, d.w, __builtin_amdgcn_cvt_pk_fp8_f32(d.x, d.y, 0, false), true);
            dv[i] = o;
        }
    }
}

template <bool OUT_F32>
__device__ void phase_rmsnorm(const float* x, const float* __restrict__ g, void* out, int bid, int nblk) {
    const int lane = otid() & 63, wave = otid() >> 6;
    const int gw = bid * 4 + wave, ngw = nblk * 4;
    f32x4 gv[4];
#pragma unroll
    for (int j = 0; j < 4; ++j) gv[j] = ((const f32x4*)g)[lane + 64 * j];
    for (int row = gw; row < NT; row += ngw) {
        const f32x4* xr = (const f32x4*)(x + (size_t)row * D) + lane;
        f32x4 v[4]; float s = 0.f;
#pragma unroll
        for (int j = 0; j < 4; ++j) { v[j] = xr[64 * j]; s += v[j].x * v[j].x + v[j].y * v[j].y + v[j].z * v[j].z + v[j].w * v[j].w; }
        s = wave_sum(s);
        const float rs = rsqrtf(s * (1.f / D) + 1e-6f);
        if (OUT_F32) {
            f32x4* o = (f32x4*)((float*)out + (size_t)row * D) + lane;
#pragma unroll
            for (int j = 0; j < 4; ++j) o[64 * j] = v[j] * rs * gv[j];
        } else {
            u32x2* o = (u32x2*)((bf16_t*)out + (size_t)row * D) + lane;
#pragma unroll
            for (int j = 0; j < 4; ++j) { f32x4 y = v[j] * rs * gv[j]; u32x2 w; w.x = pk2(y.x, y.y); w.y = pk2(y.z, y.w); o[64 * j] = w; }
        }
    }
}

struct GemmP {
    const bf16_t* A; int lda; int a_koff;
    const bf16_t* Bt; int ldb; int K;
    int MT, NTl;
    void* C; int ldc; const float* R;
};
constexpr int GS = 72;
template <int MODE>
__device__ void phase_gemm(const GemmP& p, char* smem, int bid, int nblk) {
    bf16_t* As = (bf16_t*)smem;
    bf16_t* Bs = As + 128 * GS;
    const int tid = otid(), lane = tid & 63, wave = tid >> 6;
    const int wr = wave >> 1, wc = wave & 1;
    const int lr = tid >> 3, lc = (tid & 7) * 8;
    const int fl = lane & 15, fq = lane >> 4;
    const int ntiles = p.MT * p.NTl;
    for (int tile = bid; tile < ntiles; tile += nblk) {
        const int mt = tile / p.NTl, nt = tile % p.NTl;
        const bf16_t* Ag = p.A + (size_t)mt * 128 * p.lda + (size_t)nt * p.a_koff + (size_t)lr * p.lda + lc;
        const bf16_t* Bg = p.Bt + (size_t)nt * 128 * p.ldb + (size_t)lr * p.ldb + lc;
        f32x4 acc[4][4];
#pragma unroll
        for (int m = 0; m < 4; ++m)
#pragma unroll
            for (int n = 0; n < 4; ++n) acc[m][n] = (f32x4){0.f, 0.f, 0.f, 0.f};
        u32x4 ra[4], rb[4];
#pragma unroll
        for (int i = 0; i < 4; ++i) { ra[i] = *(const u32x4*)(Ag + (size_t)(32 * i) * p.lda); rb[i] = *(const u32x4*)(Bg + (size_t)(32 * i) * p.ldb); }
        for (int k0 = 0; k0 < p.K; k0 += 64) {
            __syncthreads();
#pragma unroll
            for (int i = 0; i < 4; ++i) { *(u32x4*)(As + (lr + 32 * i) * GS + lc) = ra[i]; *(u32x4*)(Bs + (lr + 32 * i) * GS + lc) = rb[i]; }
            __syncthreads();
            if (k0 + 64 < p.K) {
#pragma unroll
                for (int i = 0; i < 4; ++i) { ra[i] = *(const u32x4*)(Ag + (size_t)(32 * i) * p.lda + k0 + 64); rb[i] = *(const u32x4*)(Bg + (size_t)(32 * i) * p.ldb + k0 + 64); }
            }
#pragma unroll
            for (int ks = 0; ks < 2; ++ks) {
                bf16x8 xa[4], wb[4];
#pragma unroll
                for (int m = 0; m < 4; ++m) xa[m] = *(const bf16x8*)(As + (wr * 64 + m * 16 + fl) * GS + ks * 32 + fq * 8);
#pragma unroll
                for (int n = 0; n < 4; ++n) wb[n] = *(const bf16x8*)(Bs + (wc * 64 + n * 16 + fl) * GS + ks * 32 + fq * 8);
#pragma unroll
                for (int m = 0; m < 4; ++m)
#pragma unroll
                    for (int n = 0; n < 4; ++n) acc[m][n] = (MODE == 3) ? __builtin_amdgcn_mfma_f32_16x16x32_bf16(xa[m], wb[n], acc[m][n], 0, 0, 0)
                                                                     : __builtin_amdgcn_mfma_f32_16x16x32_bf16(wb[n], xa[m], acc[m][n], 0, 0, 0);
            }
        }
#pragma unroll
        for (int m = 0; m < 4; ++m) {
#pragma unroll
            for (int n = 0; n < 4; ++n) {
                const f32x4 a = acc[m][n];
                if (MODE == 3) {
                    const size_t row = (size_t)mt * 128 + wr * 64 + m * 16 + fq * 4;
                    const size_t col = (size_t)nt * 128 + wc * 64 + n * 16 + fl;
                    *(f32x4*)((float*)p.C + col * p.ldc + row) = a;
                } else {
                    const size_t row = (size_t)mt * 128 + wr * 64 + m * 16 + fl;
                    const int col = nt * 128 + wc * 64 + n * 16 + fq * 4;
                    if (MODE == 0) { u32x2 w; w.x = pk2(a.x, a.y); w.y = pk2(a.z, a.w); *(u32x2*)((bf16_t*)p.C + row * p.ldc + col) = w; }
                    else if (MODE == 1) { *(f32x4*)((float*)p.C + row * p.ldc + col) = a; }
                    else { const f32x4 r = *(const f32x4*)(p.R + row * p.ldc + col); *(f32x4*)((float*)p.C + row * p.ldc + col) = r + a; }
                }
            }
        }
    }
}

constexpr int LS = 72;
struct LinP {
    const bf16_t* Z; bf16_t* O;
    const float* gk_up;
    const float* gk_bias;
    const float* norm_w;
    const float* rope;
    unsigned char* lin;
};
__device__ __forceinline__ bf16x8 ldfrag(const bf16_t* base, int row, int kofs) { return *(const bf16x8*)(base + row * LS + kofs); }

constexpr size_t LN_KV_RET = 0;
constexpr size_t LN_KV_GLA = LN_KV_RET + 1024ull * 64 * 64 * 4;
constexpr size_t LN_S_RET  = LN_KV_GLA + 1024ull * 96 * 64 * 4;
constexpr size_t LN_S_GLA  = LN_S_RET + 1024ull * 64 * 64 * 2;
constexpr size_t LN_DEC    = LN_S_GLA + 1024ull * 96 * 64 * 2;
static_assert(LN_DEC + 2048ull * 64 * 4 <= 64 * MiB, "lin region");

__device__ __forceinline__ float wave_incl_scan(float v) {
    v += dpp_f<0x111>(v); v += dpp_f<0x112>(v); v += dpp_f<0x114>(v); v += dpp_f<0x118>(v);
    v += __int_as_float(__builtin_amdgcn_update_dpp(0, __float_as_int(v), 0x142, 0xA, 0xF, false));
    v += __int_as_float(__builtin_amdgcn_update_dpp(0, __float_as_int(v), 0x143, 0xC, 0xF, false));
    return v;
}
__device__ __forceinline__ float readlane_f(float v, int l) { return __int_as_float(__builtin_amdgcn_readlane(__float_as_int(v), l)); }

__device__ __forceinline__ void rot8(const bf16_t* src, const float* rope, int spos, int cq, unsigned (&o1)[4], unsigned (&o2)[4]) {
    const u32x4 q1 = *(const u32x4*)(src + cq * 8), q2 = *(const u32x4*)(src + 32 + cq * 8);
    const unsigned q1w[4] = {q1.x, q1.y, q1.z, q1.w}, q2w[4] = {q2.x, q2.y, q2.z, q2.w};
    const f32x4 c0 = *(const f32x4*)(rope + spos * 32 + cq * 8), c1 = *(const f32x4*)(rope + spos * 32 + cq * 8 + 4);
    const f32x4 s0 = *(const f32x4*)(rope + NS * 32 + spos * 32 + cq * 8), s1 = *(const f32x4*)(rope + NS * 32 + spos * 32 + cq * 8 + 4);
    const float csv[8] = {c0.x, c0.y, c0.z, c0.w, c1.x, c1.y, c1.z, c1.w}, snv[8] = {s0.x, s0.y, s0.z, s0.w, s1.x, s1.y, s1.z, s1.w};
#pragma unroll
    for (int e = 0; e < 4; ++e) {
        const float a1l = lo_bf(q1w[e]), a1h = hi_bf(q1w[e]), a2l = lo_bf(q2w[e]), a2h = hi_bf(q2w[e]);
        o1[e] = pk2(a1l * csv[2 * e] - a2l * snv[2 * e], a1h * csv[2 * e + 1] - a2h * snv[2 * e + 1]);
        o2[e] = pk2(a1l * snv[2 * e] + a2l * csv[2 * e], a1h * snv[2 * e + 1] + a2h * csv[2 * e + 1]);
    }
}
__device__ __forceinline__ void load_vts(const bf16_t* Z, size_t t0, int voff, int nch, bf16_t* Vts, int tid) {
    for (int x = tid; x < 64 * nch; x += NTHREADS) {
        const int tok = x / nch, ch = x % nch;
        const u32x4 vv = *(const u32x4*)(Z + (t0 + tok) * DINP + voff + ch * 8);
        const unsigned w[4] = {vv.x, vv.y, vv.z, vv.w};
#pragma unroll
        for (int e = 0; e < 4; ++e) { Vts[(ch * 8 + 2 * e) * LS + tok] = (bf16_t)(w[e] & 0xFFFFu); Vts[(ch * 8 + 2 * e + 1) * LS + tok] = (bf16_t)(w[e] >> 16); }
    }
}
__device__ __forceinline__ void load_gd(const bf16_t* zr, float (&gd)[16]) {
    const u32x4 g0 = *(const u32x4*)zr, g1 = *(const u32x4*)(zr + 8);
    gd[0] = lo_bf(g0.x); gd[1] = hi_bf(g0.x); gd[2] = lo_bf(g0.y); gd[3] = hi_bf(g0.y); gd[4] = lo_bf(g0.z); gd[5] = hi_bf(g0.z); gd[6] = lo_bf(g0.w); gd[7] = hi_bf(g0.w);
    gd[8] = lo_bf(g1.x); gd[9] = hi_bf(g1.x); gd[10] = lo_bf(g1.y); gd[11] = hi_bf(g1.y); gd[12] = lo_bf(g1.z); gd[13] = hi_bf(g1.z); gd[14] = lo_bf(g1.w); gd[15] = hi_bf(g1.w);
}
__device__ __forceinline__ float gla_gk(const LinP& p, const float (&gd)[16], int h, int d) {
    float x = p.gk_bias[h * 48 + d];
#pragma unroll
    for (int i = 0; i < 16; ++i) x += gd[i] * p.gk_up[i * 192 + h * 48 + d];
    return (fminf(x, 0.f) - log1pf(__expf(-fabsf(x)))) * (1.f / 16.f);
}
__device__ __forceinline__ float ret_lg(int h) { const float e = exp2f(-5.f - (float)h * (4.f / 3.f)); return log1pf(-e); }

template <bool IS_GLA>
__device__ void lin_kv_task(const LinP& p, char* smem, int b, int h, int c) {
    constexpr int DV = IS_GLA ? 96 : 64, NVB = DV / 16;
    const int koff = IS_GLA ? (ZC_GLA + 192 + h * 48) : (ZC_RET + 256 + h * 64);
    const int voff = IS_GLA ? (ZC_GLA + 384 + h * 96) : (ZC_RET + 512 + h * 64);
    const int gkdoff = ZC_GLA + 768;
    bf16_t* Ks = (bf16_t*)smem;
    bf16_t* Kts = Ks + 64 * LS;
    bf16_t* Vts = Kts + 64 * LS;
    float* decs = (float*)(Vts + 96 * LS);
    const int tid = otid(), lane = tid & 63, wave = tid >> 6;
    const int fl = lane & 15, fq = lane >> 4;
    const size_t t0 = (size_t)b * NS + (size_t)c * 64;
    const int task = (b * 4 + h) * 64 + c;
    __syncthreads();
    if (IS_GLA) {
        for (int x = tid; x < 64 * 6; x += NTHREADS) {
            const int tok = x / 6, ch = x % 6;
            *(u32x4*)(Ks + tok * LS + ch * 8) = *(const u32x4*)(p.Z + (t0 + tok) * DINP + koff + ch * 8);
        }
        for (int x = tid; x < 16 * LS / 2; x += NTHREADS) ((unsigned*)(Kts + 48 * LS))[x] = 0u;
        if (tid < 16) decs[48 + tid] = 1.f;
        load_vts(p.Z, t0, voff, 12, Vts, tid);
    } else {
        const int tok = tid >> 2, cq = tid & 3;
        unsigned k1[4], k2[4];
        rot8(p.Z + (t0 + tok) * DINP + koff, p.rope, c * 64 + tok, cq, k1, k2);
        const float fk2 = 0.125f * __expf(ret_lg(h) * (float)(63 - tok));
#pragma unroll
        for (int e = 0; e < 4; ++e) {
            Kts[(cq * 8 + 2 * e) * LS + tok] = f2bf(lo_bf(k1[e]) * fk2); Kts[(cq * 8 + 2 * e + 1) * LS + tok] = f2bf(hi_bf(k1[e]) * fk2);
            Kts[(32 + cq * 8 + 2 * e) * LS + tok] = f2bf(lo_bf(k2[e]) * fk2); Kts[(32 + cq * 8 + 2 * e + 1) * LS + tok] = f2bf(hi_bf(k2[e]) * fk2);
        }
        if (tid < 64) decs[tid] = __expf(ret_lg(h) * 64.f);
        load_vts(p.Z, t0, voff, 8, Vts, tid);
    }
    __syncthreads();
    if (IS_GLA) {
        float gd[16];
        load_gd(p.Z + (t0 + lane) * DINP + gkdoff, gd);
#pragma unroll 1
        for (int dd = 0; dd < 12; ++dd) {
            const int d = wave * 12 + dd;
            const float bc = wave_incl_scan(gla_gk(p, gd, h, d));
            const float bl = readlane_f(bc, 63);
            Kts[d * LS + lane] = f2bf(bf2f(Ks[lane * LS + d]) * __expf(bl - bc));
            if (lane == 0) decs[d] = __expf(bl);
        }
        __syncthreads();
    }
    float* KV = (float*)(p.lin + (IS_GLA ? LN_KV_GLA : LN_KV_RET)) + (size_t)task * DV * 64;
#pragma unroll
    for (int vb = 0; vb < NVB; ++vb) {
        f32x4 a4 = (f32x4){0.f, 0.f, 0.f, 0.f};
#pragma unroll
        for (int ks = 0; ks < 2; ++ks) {
            const bf16x8 a = ldfrag(Kts, 16 * wave + fl, ks * 32 + fq * 8);
            const bf16x8 bv = ldfrag(Vts, 16 * vb + fl, ks * 32 + fq * 8);
            a4 = __builtin_amdgcn_mfma_f32_16x16x32_bf16(a, bv, a4, 0, 0, 0);
        }
        *(f32x4*)(KV + (size_t)(16 * vb + fl) * 64 + 16 * wave + 4 * fq) = a4;
    }
    if (tid < 64) ((float*)(p.lin + LN_DEC))[(size_t)((IS_GLA ? 1024 : 0) + task) * 64 + tid] = decs[tid];
}

__device__ void lin_scan_phase(const LinP& p, int vbid, int nvblk) {
    const int tid = otid();
    for (int it = vbid; it < 640; it += nvblk) {
        const bool gla = it >= 256;
        const int r = gla ? it - 256 : it;
        const int per = gla ? 24 : 16, DVx = gla ? 96 : 64;
        const int bh = r / per, e = (r % per) * 256 + tid;
        const float* KV = (const float*)(p.lin + (gla ? LN_KV_GLA : LN_KV_RET)) + (size_t)bh * 64 * DVx * 64 + e;
        bf16_t* Sb = (bf16_t*)(p.lin + (gla ? LN_S_GLA : LN_S_RET)) + (size_t)bh * 64 * DVx * 64 + e;
        const float* DEC = (const float*)(p.lin + LN_DEC) + (size_t)((gla ? 1024 : 0) + bh * 64) * 64 + (e & 63);
        float S = 0.f;
#pragma unroll 8
        for (int c = 0; c < 64; ++c) {
            const float kv = KV[(size_t)c * DVx * 64], dc = DEC[c * 64];
            Sb[(size_t)c * DVx * 64] = f2bf(S);
            S = S * dc + kv;
        }
    }
}

template <bool IS_GLA>
__device__ void lin_out_task(const LinP& p, char* smem, int b, int h, int c) {
    constexpr int DV = IS_GLA ? 96 : 64, NVB = DV / 16;
    const int qoff = IS_GLA ? (ZC_GLA + 0 + h * 48) : (ZC_RET + 0 + h * 64);
    const int koff = IS_GLA ? (ZC_GLA + 192 + h * 48) : (ZC_RET + 256 + h * 64);
    const int voff = IS_GLA ? (ZC_GLA + 384 + h * 96) : (ZC_RET + 512 + h * 64);
    const int goff = IS_GLA ? (ZC_GLA + 784 + h * 96) : (ZC_RET + 768 + h * 64);
    const int gkdoff = ZC_GLA + 768;
    const int ooff = IS_GLA ? (640 + h * 96) : (h * 64);
    bf16_t* Qs = (bf16_t*)smem;
    bf16_t* Ks = Qs + 64 * LS;
    bf16_t* Ps = Ks + 64 * LS;
    bf16_t* Vts = Ps + 64 * LS;
    bf16_t* Sts = Vts + 96 * LS;
    const int tid = otid(), lane = tid & 63, wave = tid >> 6;
    const int fl = lane & 15, fq = lane >> 4;
    const size_t t0 = (size_t)b * NS + (size_t)c * 64;
    const int task = (b * 4 + h) * 64 + c;
    __syncthreads();
    {
        const bf16_t* Sb = (const bf16_t*)(p.lin + (IS_GLA ? LN_S_GLA : LN_S_RET)) + (size_t)task * DV * 64;
        for (int x = tid; x < DV * 8; x += NTHREADS) { const int v = x >> 3, ch = x & 7; *(u32x4*)(Sts + v * LS + ch * 8) = *(const u32x4*)(Sb + v * 64 + ch * 8); }
    }
    if (IS_GLA) {
        for (int x = tid; x < 64 * 6; x += NTHREADS) {
            const int tok = x / 6, ch = x % 6;
            const bf16_t* zr = p.Z + (t0 + tok) * DINP;
            *(u32x4*)(Qs + tok * LS + ch * 8) = *(const u32x4*)(zr + qoff + ch * 8);
            *(u32x4*)(Ks + tok * LS + ch * 8) = *(const u32x4*)(zr + koff + ch * 8);
        }
        for (int x = tid; x < 64 * 2; x += NTHREADS) {
            const int tok = x >> 1, ch = 6 + (x & 1);
            *(u32x4*)(Qs + tok * LS + ch * 8) = (u32x4){0u, 0u, 0u, 0u};
            *(u32x4*)(Ks + tok * LS + ch * 8) = (u32x4){0u, 0u, 0u, 0u};
        }
        load_vts(p.Z, t0, voff, 12, Vts, tid);
    } else {
        const int tok = tid >> 2, cq = tid & 3;
        const bf16_t* zr = p.Z + (t0 + tok) * DINP;
        unsigned q1[4], q2[4], k1[4], k2[4];
        rot8(zr + qoff, p.rope, c * 64 + tok, cq, q1, q2);
        rot8(zr + koff, p.rope, c * 64 + tok, cq, k1, k2);
        const float lg = ret_lg(h);
        const float fqd = __expf(lg * (float)(tok + 1)), fk = 0.125f * __expf(-lg * (float)(tok + 1));
#pragma unroll
        for (int e = 0; e < 4; ++e) {
            q1[e] = pk2(lo_bf(q1[e]) * fqd, hi_bf(q1[e]) * fqd); q2[e] = pk2(lo_bf(q2[e]) * fqd, hi_bf(q2[e]) * fqd);
            k1[e] = pk2(lo_bf(k1[e]) * fk, hi_bf(k1[e]) * fk); k2[e] = pk2(lo_bf(k2[e]) * fk, hi_bf(k2[e]) * fk);
        }
        *(u32x4*)(Qs + tok * LS + cq * 8) = (u32x4){q1[0], q1[1], q1[2], q1[3]};
        *(u32x4*)(Qs + tok * LS + 32 + cq * 8) = (u32x4){q2[0], q2[1], q2[2], q2[3]};
        *(u32x4*)(Ks + tok * LS + cq * 8) = (u32x4){k1[0], k1[1], k1[2], k1[3]};
        *(u32x4*)(Ks + tok * LS + 32 + cq * 8) = (u32x4){k2[0], k2[1], k2[2], k2[3]};
        load_vts(p.Z, t0, voff, 8, Vts, tid);
    }
    __syncthreads();
    if (IS_GLA) {
        float gd[16];
        load_gd(p.Z + (t0 + lane) * DINP + gkdoff, gd);
#pragma unroll 1
        for (int dd = 0; dd < 12; ++dd) {
            const int d = wave * 12 + dd;
            const float bc = wave_incl_scan(gla_gk(p, gd, h, d));
            const float eq = __expf(bc) * 0.14433756729740643f  , ek = __expf(-bc);
            Qs[lane * LS + d] = f2bf(bf2f(Qs[lane * LS + d]) * eq);
            Ks[lane * LS + d] = f2bf(bf2f(Ks[lane * LS + d]) * ek);
        }
        __syncthreads();
    }
#pragma unroll
    for (int jb = 0; jb < 4; ++jb) {
        f32x4 ap = (f32x4){0.f, 0.f, 0.f, 0.f};
#pragma unroll
        for (int ks = 0; ks < 2; ++ks) {
            const bf16x8 a = ldfrag(Ks, 16 * jb + fl, ks * 32 + fq * 8);
            const bf16x8 bq = ldfrag(Qs, 16 * wave + fl, ks * 32 + fq * 8);
            ap = __builtin_amdgcn_mfma_f32_16x16x32_bf16(a, bq, ap, 0, 0, 0);
        }
        const int i = 16 * wave + fl, j0 = 16 * jb + 4 * fq;
        u32x2 w;
        w.x = pk2(j0 + 0 <= i ? ap.x : 0.f, j0 + 1 <= i ? ap.y : 0.f);
        w.y = pk2(j0 + 2 <= i ? ap.z : 0.f, j0 + 3 <= i ? ap.w : 0.f);
        *(u32x2*)(Ps + i * LS + j0) = w;
    }
    __syncthreads();
    {
        f32x4 ao[NVB];
        float ss = 0.f;
#pragma unroll
        for (int vb = 0; vb < NVB; ++vb) {
            f32x4 a4 = (f32x4){0.f, 0.f, 0.f, 0.f};
#pragma unroll
            for (int ks = 0; ks < 2; ++ks) {
                const bf16x8 a = ldfrag(Vts, 16 * vb + fl, ks * 32 + fq * 8);
                const bf16x8 bp = ldfrag(Ps, 16 * wave + fl, ks * 32 + fq * 8);
                a4 = __builtin_amdgcn_mfma_f32_16x16x32_bf16(a, bp, a4, 0, 0, 0);
            }
#pragma unroll
            for (int ks = 0; ks < 2; ++ks) {
                const bf16x8 a = ldfrag(Sts, 16 * vb + fl, ks * 32 + fq * 8);
                const bf16x8 bq = ldfrag(Qs, 16 * wave + fl, ks * 32 + fq * 8);
                a4 = __builtin_amdgcn_mfma_f32_16x16x32_bf16(a, bq, a4, 0, 0, 0);
            }
            ao[vb] = a4;
            ss += a4.x * a4.x + a4.y * a4.y + a4.z * a4.z + a4.w * a4.w;
        }
        ss = xor32_sum(xor16_sum(ss));
        const float inv = rsqrtf(ss * (1.f / DV) + 1e-5f);
        const size_t t = t0 + 16 * wave + fl;
#pragma unroll
        for (int vb = 0; vb < NVB; ++vb) {
            const int v0 = 16 * vb + 4 * fq;
            const u32x2 gg = *(const u32x2*)(p.Z + t * DINP + goff + v0);
            float g4[4] = {lo_bf(gg.x), hi_bf(gg.x), lo_bf(gg.y), hi_bf(gg.y)};
            float o4[4] = {ao[vb].x, ao[vb].y, ao[vb].z, ao[vb].w};
#pragma unroll
            for (int e = 0; e < 4; ++e) {
                float y = o4[e] * inv;
                if (IS_GLA) y *= p.norm_w[h * 96 + v0 + e];
                const float g = g4[e];
                o4[e] = y * (g / (1.f + __expf(-g)));
            }
            u32x2 w; w.x = pk2(o4[0], o4[1]); w.y = pk2(o4[2], o4[3]);
            *(u32x2*)(p.O + t * D + ooff + v0) = w;
        }
    }
}
__device__ __forceinline__ void lin_kv_dispatch(const LinP& p, char* smem, int task) {
    const int r = task & 1023, bh = r >> 6, c = r & 63;
    if (task < 1024) lin_kv_task<false>(p, smem, bh >> 2, bh & 3, c); else lin_kv_task<true>(p, smem, bh >> 2, bh & 3, c);
}
__device__ __forceinline__ void lin_out_dispatch(const LinP& p, char* smem, int task) {
    const int r = task & 1023, bh = r >> 6, c = r & 63;
    if (task < 1024) lin_out_task<false>(p, smem, bh >> 2, bh & 3, c); else lin_out_task<true>(p, smem, bh >> 2, bh & 3, c);
}

struct RwP {
    const bf16_t* Z; unsigned char* mix;
    const float* mu; const float* w_up; const float* w_bias; const float* a_up; const float* a_bias; const float* g_up;
    const float* k_k; const float* k_a; const float* r_k; const float* ln_w; const float* ln_b;
    float* oraw; bf16_t* O;
};
__device__ void phase_rwkv_prep(const RwP& p, char* smem, int bid, int nblk) {
    float* fs = (float*)smem;
    const int tid = otid(), lane = tid & 63;
    float* Wd = (float*)(p.mix + MX_W); float* KKd = (float*)(p.mix + MX_KK); float* KKAd = (float*)(p.mix + MX_KKA);
    bf16_t* Rd = (bf16_t*)(p.mix + MX_R); bf16_t* Kd = (bf16_t*)(p.mix + MX_K); bf16_t* Vd = (bf16_t*)(p.mix + MX_V); bf16_t* Gd = (bf16_t*)(p.mix + MX_G);
    for (int it = bid; it < NT / 8; it += nblk) {
        const int t0 = it * 8;
        for (int x = tid; x < 8 * RW_F; x += NTHREADS) {
            const int tok = x / RW_F, c = x % RW_F;
            const int t = t0 + tok;
            const float f = bf2f(p.Z[(size_t)t * DINP + ZC_RW + c]);
            const float fp = ((t & (NS - 1)) == 0) ? 0.f : bf2f(p.Z[(size_t)(t - 1) * DINP + ZC_RW + c]);
            float v = f + (fp - f) * p.mu[c];
            if (c >= 1152 && c < 1216) v = tanhf(v);
            else if (c >= 1280) v = sigmoidf_(v);
            fs[tok * RW_F + c] = v;
        }
        __syncthreads();
        for (int cc = tid; cc < 384; cc += NTHREADS) {
            float aw[8], aa[8], ag[8];
#pragma unroll
            for (int k = 0; k < 8; ++k) { aw[k] = 0.f; aa[k] = 0.f; ag[k] = 0.f; }
            for (int i = 0; i < 64; i += 4) {
                float w1[4], a1[4];
#pragma unroll
                for (int e = 0; e < 4; ++e) { w1[e] = p.w_up[(i + e) * 384 + cc]; a1[e] = p.a_up[(i + e) * 384 + cc]; }
#pragma unroll
                for (int k = 0; k < 8; ++k) {
                    const f32x4 xw = *(const f32x4*)(fs + k * RW_F + 1152 + i), xa = *(const f32x4*)(fs + k * RW_F + 1216 + i);
                    aw[k] += xw.x * w1[0] + xw.y * w1[1] + xw.z * w1[2] + xw.w * w1[3];
                    aa[k] += xa.x * a1[0] + xa.y * a1[1] + xa.z * a1[2] + xa.w * a1[3];
                }
            }
            for (int i = 0; i < 128; i += 4) {
                float g1[4];
#pragma unroll
                for (int e = 0; e < 4; ++e) g1[e] = p.g_up[(i + e) * 384 + cc];
#pragma unroll
                for (int k = 0; k < 8; ++k) {
                    const f32x4 xg = *(const f32x4*)(fs + k * RW_F + 1280 + i);
                    ag[k] += xg.x * g1[0] + xg.y * g1[1] + xg.z * g1[2] + xg.w * g1[3];
                }
            }
            const float wb = p.w_bias[cc], ab = p.a_bias[cc], kkc = p.k_k[cc], kac = p.k_a[cc];
            const int hd = cc >> 6, cl = cc & 63;
#pragma unroll
            for (int k = 0; k < 8; ++k) {
                const int t = t0 + k, b = t >> 12, s = t & (NS - 1);
                const size_t hi = ((size_t)(b * 6 + hd) * NS + s) * 64 + cl;
                const float wl = -softplusf_(-(wb + aw[k])) - 0.5f;
                const float dec = __expf(-__expf(wl));
                const float a = sigmoidf_(ab + aa[k]);
                const float r = fs[k * RW_F + cc], kx = fs[k * RW_F + 384 + cc], vx = fs[k * RW_F + 768 + cc];
                float kk = kx * kkc;
                const float ss = wave_sum(kk * kk);
                kk *= rsqrtf(fmaxf(ss, 1e-24f));
                const float kmod = kx * (1.f + (a - 1.f) * kac);
                Wd[hi] = dec; KKd[hi] = kk; KKAd[hi] = kk * a;
                Rd[hi] = f2bf(r); Kd[hi] = f2bf(kmod); Vd[hi] = f2bf(vx);
                Gd[(size_t)t * 384 + cc] = f2bf(ag[k]);
            }
        }
        __syncthreads();
    }
}

constexpr int SC_STEPS = 16;
__device__ void rwkv_scan_task(const RwP& p, char* smem, int bh, int qd) {
    float* buf = (float*)smem;
    float* obuf = buf + 2 * 6 * SC_STEPS * 64;
    const int tid = otid(), lane = tid & 63, wave = tid >> 6;
    const int rloc = wave * 4 + (lane >> 4);
    const int row = qd * 16 + rloc;
    const int c4 = (lane & 15) * 4;
    const float* Wd = (const float*)(p.mix + MX_W) + (size_t)bh * NS * 64;
    const float* KKd = (const float*)(p.mix + MX_KK) + (size_t)bh * NS * 64;
    const float* KKAd = (const float*)(p.mix + MX_KKA) + (size_t)bh * NS * 64;
    const bf16_t* Rd = (const bf16_t*)(p.mix + MX_R) + (size_t)bh * NS * 64;
    const bf16_t* Kd = (const bf16_t*)(p.mix + MX_K) + (size_t)bh * NS * 64;
    const bf16_t* Vd = (const bf16_t*)(p.mix + MX_V) + (size_t)bh * NS * 64;
    float* orow = p.oraw + (size_t)bh * NS * 64;
    f32x4 S = (f32x4){0.f, 0.f, 0.f, 0.f};
    f32x4 lw, lkk, lka; u32x2 lr, lk, lv;
    auto gload = [&](int ch) {
        const size_t e = (size_t)ch * SC_STEPS * 64 + tid * 4;
        lw = *(const f32x4*)(Wd + e); lkk = *(const f32x4*)(KKd + e); lka = *(const f32x4*)(KKAd + e);
        lr = *(const u32x2*)(Rd + e); lk = *(const u32x2*)(Kd + e); lv = *(const u32x2*)(Vd + e);
    };
    auto lstore = [&](int bsel) {
        float* bb = buf + bsel * 6 * SC_STEPS * 64 + tid * 4;
        *(f32x4*)(bb + 0 * SC_STEPS * 64) = lw; *(f32x4*)(bb + 1 * SC_STEPS * 64) = lkk; *(f32x4*)(bb + 2 * SC_STEPS * 64) = lka;
        *(f32x4*)(bb + 3 * SC_STEPS * 64) = (f32x4){lo_bf(lr.x), hi_bf(lr.x), lo_bf(lr.y), hi_bf(lr.y)};
        *(f32x4*)(bb + 4 * SC_STEPS * 64) = (f32x4){lo_bf(lk.x), hi_bf(lk.x), lo_bf(lk.y), hi_bf(lk.y)};
        *(f32x4*)(bb + 5 * SC_STEPS * 64) = (f32x4){lo_bf(lv.x), hi_bf(lv.x), lo_bf(lv.y), hi_bf(lv.y)};
    };
    __syncthreads();
    gload(0); lstore(0);
    __syncthreads();
    constexpr int NCH = NS / SC_STEPS;
    for (int ch = 0; ch < NCH; ++ch) {
        if (ch + 1 < NCH) gload(ch + 1);
        const float* bb = buf + (ch & 1) * 6 * SC_STEPS * 64;
#pragma unroll 4
        for (int st = 0; st < SC_STEPS; ++st) {
            const f32x4 w4 = *(const f32x4*)(bb + 0 * SC_STEPS * 64 + st * 64 + c4);
            const f32x4 kk4 = *(const f32x4*)(bb + 1 * SC_STEPS * 64 + st * 64 + c4);
            const f32x4 ka4 = *(const f32x4*)(bb + 2 * SC_STEPS * 64 + st * 64 + c4);
            const f32x4 r4 = *(const f32x4*)(bb + 3 * SC_STEPS * 64 + st * 64 + c4);
            const f32x4 k4 = *(const f32x4*)(bb + 4 * SC_STEPS * 64 + st * 64 + c4);
            const float vv = bb[5 * SC_STEPS * 64 + st * 64 + row];
            float pd = S.x * kk4.x + S.y * kk4.y + S.z * kk4.z + S.w * kk4.w;
            const float sa = -row16_sum(pd);
            S.x = S.x * w4.x + vv * k4.x + sa * ka4.x;
            S.y = S.y * w4.y + vv * k4.y + sa * ka4.y;
            S.z = S.z * w4.z + vv * k4.z + sa * ka4.z;
            S.w = S.w * w4.w + vv * k4.w + sa * ka4.w;
            float od = S.x * r4.x + S.y * r4.y + S.z * r4.z + S.w * r4.w;
            od = row16_sum(od);
            if ((lane & 15) == 0) obuf[st * 16 + rloc] = od;
        }
        __syncthreads();
        {
            const int st = tid >> 4, rr = tid & 15;
            orow[((size_t)ch * SC_STEPS + st) * 64 + qd * 16 + rr] = obuf[tid];
        }
        if (ch + 1 < NCH) lstore((ch + 1) & 1);
        __syncthreads();
    }
}

__device__ void phase_rwkv_post(const RwP& p, int bid, int nblk) {
    const int lane = otid() & 63, wave = otid() >> 6;
    const bf16_t* Rd = (const bf16_t*)(p.mix + MX_R); const bf16_t* Kd = (const bf16_t*)(p.mix + MX_K); const bf16_t* Vd = (const bf16_t*)(p.mix + MX_V);
    const bf16_t* Gd = (const bf16_t*)(p.mix + MX_G);
    for (int x = bid * 4 + wave; x < NT * 6; x += nblk * 4) {
        const int t = x / 6, hd = x % 6, b = t >> 12, s = t & (NS - 1);
        const size_t hi = ((size_t)(b * 6 + hd) * NS + s) * 64 + lane;
        const float o = p.oraw[hi];
        const float mean = wave_sum(o) * (1.f / 64.f);
        const float dv = o - mean;
        const float var = wave_sum(dv * dv) * (1.f / 64.f);
        float on = dv * rsqrtf(var + 64e-5f) * p.ln_w[hd * 64 + lane] + p.ln_b[hd * 64 + lane];
        const float r = bf2f(Rd[hi]), k = bf2f(Kd[hi]), v = bf2f(Vd[hi]);
        const float rk = wave_sum(r * k * p.r_k[hd * 64 + lane]);
        on += rk * v;
        const float g = bf2f(Gd[(size_t)t * 384 + hd * 64 + lane]);
        p.O[(size_t)t * D + 256 + hd * 64 + lane] = f2bf(on * g);
    }
}

__device__ __forceinline__ unsigned ordkey(float f) { const unsigned u = __float_as_uint(f); return (u & 0x80000000u) ? ~u : (u | 0x80000000u); }
__device__ __forceinline__ float unordkey(unsigned k) { return __uint_as_float((k & 0x80000000u) ? (k & 0x7FFFFFFFu) : ~k); }
__device__ __forceinline__ void ins16(unsigned (&L)[16], unsigned x) {
#pragma unroll
    for (int i = 0; i < 16; ++i) { const unsigned hi = L[i] > x ? L[i] : x; x = L[i] > x ? x : L[i]; L[i] = hi; }
}
__device__ __forceinline__ void top16_col(const float* col  , unsigned (&L)[16]) {
#pragma unroll
    for (int i = 0; i < 16; ++i) L[i] = 0u;
#pragma unroll 1
    for (int n0 = 0; n0 < 128; n0 += 16) {
        float x[16];
#pragma unroll
        for (int j = 0; j < 16; ++j) x[j] = col[(size_t)(n0 + j) * NT];
#pragma unroll
        for (int j = 0; j < 16; ++j) ins16(L, (ordkey(x[j]) & 0xFFFFFF80u) | (unsigned)(127 - (n0 + j)));
    }
}
__device__ void phase_topk(const float* SCT, int* EIDX, float* GATE, char* smem, int bid, int nblk) {
    const int tid = otid(), lane = tid & 63, wave = tid >> 6;
    unsigned char* itab = (unsigned char*)smem + tid * 32;
    unsigned char* ctab = (unsigned char*)smem + NTHREADS * 32;
    __syncthreads();
    if (tid < 64) {
        const int c = tid; int ci, cj;
        if (c < 16) { ci = 0; cj = c; } else if (c < 24) { ci = 1; cj = c - 16; } else if (c < 29) { ci = 2; cj = c - 24; } else if (c < 33) { ci = 3; cj = c - 29; }
        else if (c < 36) { ci = 4; cj = c - 33; } else if (c < 38) { ci = 5; cj = c - 36; } else if (c < 40) { ci = 6; cj = c - 38; } else if (c < 42) { ci = 7; cj = c - 40; }
        else if (c < 50) { ci = c - 34; cj = 0; } else { ci = 0; cj = 0; }
        ctab[c] = (unsigned char)(ci | (cj << 4));
    }
    __syncthreads();
    for (int x = bid * 4 + wave; x < (NT / 64) * 8; x += nblk * 4) {
        const int tb = x >> 3, hd = x & 7;
        const int t = tb * 64 + lane;
        unsigned L1[16], L2[16];
        top16_col(SCT + (size_t)(hd * 256) * NT + t, L1);
        top16_col(SCT + (size_t)(hd * 256 + 128) * NT + t, L2);
        float s1[16], s2[16];
#pragma unroll
        for (int i = 0; i < 16; ++i) {
            s1[i] = unordkey(L1[i] & 0xFFFFFF80u); s2[i] = unordkey(L2[i] & 0xFFFFFF80u);
            itab[i] = (unsigned char)(127u - (L1[i] & 127u)); itab[16 + i] = (unsigned char)(127u - (L2[i] & 127u));
        }
        unsigned M[16];
#pragma unroll
        for (int i = 0; i < 16; ++i) M[i] = 0u;
        int c = 0;
#pragma unroll
        for (int ci = 0; ci < 16; ++ci) {
#pragma unroll
            for (int cj = 0; cj < 16; ++cj) {
                if ((ci + 1) * (cj + 1) <= 16) {
                    const int cid = (ci == 0) ? cj : (ci == 1) ? 16 + cj : (ci == 2) ? 24 + cj : (ci == 3) ? 29 + cj : (ci == 4) ? 33 + cj : (ci == 5) ? 36 + cj : (ci == 6) ? 38 + cj : (ci == 7) ? 40 + cj : 34 + ci;
                    ins16(M, (ordkey(s1[ci] + s2[cj]) & 0xFFFFFFC0u) | (unsigned)(63 - cid));
                    ++c;
                }
            }
        }
        float ev[16]; int ee[16];
        const float mx = unordkey(M[0] & 0xFFFFFFC0u);
        float sum = 0.f;
#pragma unroll
        for (int i = 0; i < 16; ++i) {
            const int cid = 63 - (int)(M[i] & 63u);
            const unsigned cc = ctab[cid];
            ee[i] = (int)itab[cc & 15u] * 128 + (int)itab[16 + (cc >> 4)];
            ev[i] = __expf(unordkey(M[i] & 0xFFFFFFC0u) - mx);
            sum += ev[i];
        }
        const float inv = 1.f / sum;
        int* eo = EIDX + (size_t)t * 128 + hd * 16; float* go = GATE + (size_t)t * 128 + hd * 16;
#pragma unroll
        for (int i = 0; i < 4; ++i) {
            *(int4*)(eo + 4 * i) = make_int4(ee[4 * i], ee[4 * i + 1], ee[4 * i + 2], ee[4 * i + 3]);
            *(f32x4*)(go + 4 * i) = (f32x4){ev[4 * i] * inv, ev[4 * i + 1] * inv, ev[4 * i + 2] * inv, ev[4 * i + 3] * inv};
        }
    }
    __syncthreads();
}

typedef float f32x2 __attribute__((ext_vector_type(2)));
__device__ __forceinline__ void dec16(const u32x4 w, float (&f)[16]) {
    const unsigned ww[4] = {w.x, w.y, w.z, w.w};
#pragma unroll
    for (int i = 0; i < 4; ++i) {
        const f32x2 a = __builtin_amdgcn_cvt_pk_f32_fp8((int)ww[i], false), b = __builtin_amdgcn_cvt_pk_f32_fp8((int)ww[i], true);
        f[4 * i] = a.x; f[4 * i + 1] = a.y; f[4 * i + 2] = b.x; f[4 * i + 3] = b.y;
    }
}
__device__ void phase_expert(const bf16_t* H, const unsigned char* U8, const unsigned char* V8, const int* EIDX, const float* GATE, const float* X, float* Xo, int bid, int nblk) {
    const int lane = otid() & 63, wave = otid() >> 6;
    for (int t = bid * 4 + wave; t < NT; t += nblk * 4) {
        float xf[16], acc[16];
        {
            const u32x4 a = *(const u32x4*)(H + (size_t)t * D + lane * 16), b = *(const u32x4*)(H + (size_t)t * D + lane * 16 + 8);
            xf[0] = lo_bf(a.x); xf[1] = hi_bf(a.x); xf[2] = lo_bf(a.y); xf[3] = hi_bf(a.y); xf[4] = lo_bf(a.z); xf[5] = hi_bf(a.z); xf[6] = lo_bf(a.w); xf[7] = hi_bf(a.w);
            xf[8] = lo_bf(b.x); xf[9] = hi_bf(b.x); xf[10] = lo_bf(b.y); xf[11] = hi_bf(b.y); xf[12] = lo_bf(b.z); xf[13] = hi_bf(b.z); xf[14] = lo_bf(b.w); xf[15] = hi_bf(b.w);
        }
#pragma unroll
        for (int i = 0; i < 16; ++i) acc[i] = 0.f;
        for (int e0 = 0; e0 < 128; e0 += 8) {
            int ei[8]; float act[8]; u32x4 ur[8];
#pragma unroll
            for (int j = 0; j < 8; ++j) { ei[j] = EIDX[(size_t)t * 128 + e0 + j]; ur[j] = *(const u32x4*)(U8 + (size_t)ei[j] * D + lane * 16); }
#pragma unroll
            for (int j = 0; j < 8; ++j) {
                float uf[16]; dec16(ur[j], uf);
                float d = 0.f;
#pragma unroll
                for (int i = 0; i < 16; ++i) d += xf[i] * uf[i];
                d = wave_sum(d) * (1.f / 512.f);
                act[j] = 0.5f * d * (1.f + erff(d * 0.7071067811865476f)) * GATE[(size_t)t * 128 + e0 + j] * (1.f / 64.f);
            }
#pragma unroll
            for (int j = 0; j < 8; ++j) ur[j] = *(const u32x4*)(V8 + (size_t)ei[j] * D + lane * 16);
#pragma unroll
            for (int j = 0; j < 8; ++j) {
                float vf[16]; dec16(ur[j], vf);
#pragma unroll
                for (int i = 0; i < 16; ++i) acc[i] += act[j] * vf[i];
            }
        }
        const f32x4* xr = (const f32x4*)(X + (size_t)t * D) + lane * 4;
        f32x4* xo = (f32x4*)(Xo + (size_t)t * D) + lane * 4;
#pragma unroll
        for (int i = 0; i < 4; ++i) { f32x4 o = xr[i]; o += (f32x4){acc[4 * i], acc[4 * i + 1], acc[4 * i + 2], acc[4 * i + 3]}; xo[i] = o; }
    }
}

#define XB_TMO      128
#define XB_XCNT(j)  (256  + 64 * (j))
#define XB_XSUB(j)  (1280 + 64 * (j))
#define XB_XGEN(j)  (2304 + 64 * (j))
#define XB_TOP      3328
#define XB_TOPGEN   3392
#define XCD_BAR_WORDS 3456
#define XB_SPIN_CAP (1u << 22)
#define LAS __attribute__((address_space(3)))
__device__ __forceinline__ unsigned xb_ld(unsigned* p)              { return __hip_atomic_load(p, __ATOMIC_RELAXED, __HIP_MEMORY_SCOPE_AGENT); }
__device__ __forceinline__ unsigned xb_add(unsigned* p, unsigned v) { return __hip_atomic_fetch_add(p, v, __ATOMIC_RELAXED, __HIP_MEMORY_SCOPE_AGENT); }
__device__ __forceinline__ unsigned xb_xcc_id() { return (unsigned)__builtin_amdgcn_s_getreg((3 << 11) | 20) & 0xFu; }
#define XB_SPIN(cond, bar) do { unsigned _sp = 0; while (cond) { __builtin_amdgcn_s_sleep(1); \
    if ((++_sp & 255u) == 0u) { if (xb_ld(&(bar)[XB_TMO])) break; if (_sp > XB_SPIN_CAP) { atomicAdd(&(bar)[XB_TMO], 1u); break; } } } } while (0)
struct XcdBarrier { unsigned* bar; unsigned x; volatile LAS unsigned* st; };
__device__ __forceinline__ XcdBarrier xcd_barrier_post(unsigned* bar, volatile LAS unsigned* st) {
    XcdBarrier b; b.bar = bar; b.x = xb_xcc_id(); b.st = st;
    if (threadIdx.x == 0) (void)xb_add(&bar[XB_XCNT(b.x)], 1u);
    return b;
}
__device__ __forceinline__ void xcd_barrier_complete(unsigned* bar, unsigned x, unsigned& nloc, unsigned& nx) {
    const unsigned G = gridDim.x * gridDim.y * gridDim.z;
    unsigned sum, cnt, mine, sp = 0u;
    for (;;) {
        sum = 0u; cnt = 0u; mine = 0u;
#pragma unroll
        for (unsigned j = 0; j < 16; ++j) { const unsigned c = xb_ld(&bar[XB_XCNT(j)]); sum += c; cnt += (c > 0u) ? 1u : 0u; mine = (j == x) ? c : mine; }
        if (sum == G) break;
        __builtin_amdgcn_s_sleep(1);
        if ((++sp & 255u) == 0u) { if (xb_ld(&bar[XB_TMO])) break; if (sp > XB_SPIN_CAP) { atomicAdd(&bar[XB_TMO], 1u); break; } }
    }
    nloc = mine > 0u ? mine : 1u; nx = cnt > 0u ? cnt : 1u;
}
__device__ __forceinline__ void xcd_barrier(const XcdBarrier& b) {
    asm volatile("s_waitcnt vmcnt(0)" ::: "memory");
    __syncthreads();
    if (threadIdx.x == 0) {
        unsigned* bar = b.bar;
        __builtin_amdgcn_s_waitcnt(0);
        unsigned nloc = b.st[0], nx = b.st[1];
        if (nloc == 0u) { xcd_barrier_complete(bar, b.x, nloc, nx); b.st[0] = nloc; b.st[1] = nx; }
        const unsigned old = xb_add(&bar[XB_XSUB(b.x)], 1u);
        const unsigned gen = old / nloc;
        if (old + 1u == (gen + 1u) * nloc) {
            __builtin_amdgcn_fence(__ATOMIC_RELEASE, "agent");
            asm volatile("s_waitcnt vmcnt(0)" ::: "memory");
            const unsigned og = xb_add(&bar[XB_TOP], 1u);
            const unsigned tg = og / nx;
            if (og + 1u == (tg + 1u) * nx) xb_add(&bar[XB_TOPGEN], 1u);
            else XB_SPIN(xb_ld(&bar[XB_TOPGEN]) == tg, bar);
            __builtin_amdgcn_fence(__ATOMIC_ACQUIRE, "agent");
            xb_add(&bar[XB_XGEN(b.x)], 1u);
            asm volatile("s_waitcnt vmcnt(0)" ::: "memory");
        } else {
            XB_SPIN(xb_ld(&bar[XB_XGEN(b.x)]) == gen, bar);
            __builtin_amdgcn_fence(__ATOMIC_ACQUIRE, "agent");
            asm volatile("s_waitcnt vmcnt(0)" ::: "memory");
        }
    }
    __syncthreads();
}

struct Params {
    const float* in[24];
    float* out; unsigned char* ws;
};
constexpr int LDS_BYTES = 65536;

__device__ __forceinline__ RwP make_rwp(const Params& P, int l) {
    RwP r;
    r.Z = (const bf16_t*)(P.ws + WS_Z); r.mix = P.ws + WS_MIX;
    r.mu = P.in[6] + l * RW_F; r.w_up = P.in[7] + (size_t)l * 64 * 384; r.w_bias = P.in[8] + l * 384; r.a_up = P.in[9] + (size_t)l * 64 * 384; r.a_bias = P.in[10] + l * 384;
    r.g_up = P.in[11] + (size_t)l * 128 * 384; r.k_k = P.in[12] + l * 384; r.k_a = P.in[13] + l * 384; r.r_k = P.in[14] + l * 384; r.ln_w = P.in[15] + l * 384; r.ln_b = P.in[16] + l * 384;
    r.oraw = (float*)(P.ws + WS_H); r.O = (bf16_t*)(P.ws + WS_O);
    return r;
}

__global__ void __launch_bounds__(NTHREADS, 2) mega_fwd(Params P) {
    __shared__ __attribute__((aligned(16))) char smem[LDS_BYTES];
    const int bid = blockIdx.x, nblk = gridDim.x;
    volatile LAS unsigned* st = (volatile LAS unsigned*)(smem + LDS_BYTES - 16);
    if (threadIdx.x == 0) { st[0] = 0u; st[1] = 0u; st[2] = 0u; st[3] = 0u; }
    __syncthreads();
    XcdBarrier bar = xcd_barrier_post((unsigned*)(P.ws + WS_CTL), st);
#define GSYNC() xcd_barrier(bar)

    {
        ConvP c{P.in[4], P.in[5], P.in[20], P.in[21], P.in[22], P.in[23], P.ws};
        for (int rep = 0; rep < REP_CONV; ++rep) phase_convert_weights(c, smem, bid, nblk);
        phase_rmsnorm<false>(P.in[0], P.in[1], P.ws + WS_H, bid, nblk);
    }
    GSYNC();
#pragma unroll 1
    for (int l = 0; l < 2; ++l) {
        const float* xin = (l == 0) ? P.in[0] : P.out;
        {
            GemmP g{(const bf16_t*)(P.ws + WS_H), D, 0, (const bf16_t*)(P.ws + WS_WTIN) + (size_t)l * DINP * D, D, D, NT / 128, DINP / 128, P.ws + WS_Z, DINP, nullptr};
            for (int rep = 0; rep < REP_GIN; ++rep) phase_gemm<0>(g, smem, bid, nblk);
        }
        GSYNC();
        RwP rw = make_rwp(P, l);
        LinP lp{(const bf16_t*)(P.ws + WS_Z), (bf16_t*)(P.ws + WS_O), P.in[17] + (size_t)l * 16 * 192, P.in[18] + l * 192, P.in[19] + l * 384, (const float*)(P.ws + WS_ROPE), P.ws + WS_LIN};
        for (int rep = 0; rep < REP_PREP; ++rep) phase_rwkv_prep(rw, smem, bid, nblk);
        for (int rep = 0; rep < REP_LIN; ++rep) for (int task = bid; task < 2048; task += nblk) lin_kv_dispatch(lp, smem, task);
        GSYNC();
        {
            if (bid < 96) { for (int rep = 0; rep < REP_SCAN; ++rep) rwkv_scan_task(rw, smem, bid >> 2, bid & 3); }
            else { for (int rep = 0; rep < REP_LIN; ++rep) lin_scan_phase(lp, bid - 96, nblk - 96); }
        }
        GSYNC();
        for (int rep = 0; rep < REP_POST; ++rep) phase_rwkv_post(rw, bid, nblk);
        for (int rep = 0; rep < REP_LIN; ++rep) for (int task = bid; task < 2048; task += nblk) lin_out_dispatch(lp, smem, task);
        GSYNC();
        {
            GemmP g{(const bf16_t*)(P.ws + WS_O), D, 0, (const bf16_t*)(P.ws + WS_WTOUT) + (size_t)l * D * D, D, D, NT / 128, D / 128, P.out, D, xin};
            phase_gemm<2>(g, smem, bid, nblk);
            for (int rep = 1; rep < REP_GOUT; ++rep) { GemmP g2 = g; g2.C = P.ws + WS_MIX; phase_gemm<2>(g2, smem, bid, nblk); }
        }
        GSYNC();
        for (int rep = 0; rep < REP_NORM; ++rep) phase_rmsnorm<false>(P.out, P.in[2] + l * D, P.ws + WS_H, bid, nblk);
        GSYNC();
        {
            GemmP g{(const bf16_t*)(P.ws + WS_H), D, 0, (const bf16_t*)(P.ws + WS_WTQ) + (size_t)l * 2048 * D, D, D, NT / 128, 2048 / 128, P.ws + WS_Z, 2048, nullptr};
            for (int rep = 0; rep < REP_GQ; ++rep) phase_gemm<0>(g, smem, bid, nblk);
        }
        GSYNC();
        {
            GemmP g{(const bf16_t*)(P.ws + WS_Z), 2048, 128, (const bf16_t*)(P.ws + WS_SK) + (size_t)l * 16 * 128 * 128, 128, 128, NT / 128, 16, P.ws + WS_MIX, NT, nullptr};
            for (int rep = 0; rep < REP_GSK; ++rep) phase_gemm<3>(g, smem, bid, nblk);
        }
        GSYNC();
        for (int rep = 0; rep < REP_TOPK; ++rep) phase_topk((const float*)(P.ws + WS_MIX), (int*)(P.ws + WS_EIDX), (float*)(P.ws + WS_GATE), smem, bid, nblk);
        GSYNC();
        phase_expert((const bf16_t*)(P.ws + WS_H), P.ws + WS_UB + (size_t)l * NEXP * D, P.ws + WS_VB + (size_t)l * NEXP * D,
                     (const int*)(P.ws + WS_EIDX), (const float*)(P.ws + WS_GATE), P.out, P.out, bid, nblk);
        for (int rep = 1; rep < REP_EXP; ++rep) phase_expert((const bf16_t*)(P.ws + WS_H), P.ws + WS_UB + (size_t)l * NEXP * D, P.ws + WS_VB + (size_t)l * NEXP * D,
                     (const int*)(P.ws + WS_EIDX), (const float*)(P.ws + WS_GATE), P.out, (float*)(P.ws + WS_Z), bid, nblk);
        GSYNC();
        if (l == 0) { phase_rmsnorm<false>(P.out, P.in[1] + D, P.ws + WS_H, bid, nblk); GSYNC(); }
    }
    phase_rmsnorm<true>(P.out, P.in[3], P.out, bid, nblk);
}

extern "C" void kernel_launch(void* const* d_in, const int* in_sizes, int n_in, void* d_out, int out_size, void* d_ws, size_t ws_size, hipStream_t stream) {
    static int grid = 0;
    if (grid == 0) {
        if (n_in != 24 || ws_size < WS_END) { fprintf(stderr, "kernel_launch: bad args n_in=%d ws=%zu need=%zu\n", n_in, ws_size, (size_t)WS_END); grid = -1; return; }
        int dev = 0, cus = 0, per_cu = 0;
        hipGetDevice(&dev);
        hipDeviceGetAttribute(&cus, hipDeviceAttributeMultiprocessorCount, dev);
        hipOccupancyMaxActiveBlocksPerMultiprocessor(&per_cu, (const void*)mega_fwd, NTHREADS, 0);
        if (per_cu < 1) { fprintf(stderr, "kernel_launch: occupancy query says %d\n", per_cu); grid = -1; return; }
        if (per_cu > 2) per_cu = 2;
        grid = cus * per_cu;
        fprintf(stderr, "kernel_launch: grid %d (%d CUs x %d)\n", grid, cus, per_cu);
    }
    if (grid < 0) return;
    hipMemsetAsync((char*)d_ws + WS_CTL, 0, XCD_BAR_WORDS * 4, stream);
    Params P{};
    for (int i = 0; i < 24; ++i) P.in[i] = (const float*)d_in[i];
    P.out = (float*)d_out; P.ws = (unsigned char*)d_ws;
    void* args[] = {&P};
    hipError_t e = hipLaunchCooperativeKernel((const void*)mega_fwd, dim3(grid), dim3(NTHREADS), args, 0, stream);
    if (e != hipSuccess) fprintf(stderr, "cooperative launch failed: %s (grid %d)\n", hipGetErrorString(e), grid);
}
```

```cpp
#include <hip/hip_runtime.h>
#include <stdint.h>
#include <stdio.h>

typedef unsigned short bf16_t;
typedef short bf16x8 __attribute__((ext_vector_type(8)));
typedef float f32x4 __attribute__((ext_vector_type(4)));
typedef unsigned u32x4 __attribute__((ext_vector_type(4)));
typedef unsigned u32x2 __attribute__((ext_vector_type(2)));

#define REP_CONV 1
#define REP_GIN 1
#define REP_PREP 1
#define REP_SCAN 1
#define REP_LIN 1
#define REP_POST 1
#define REP_GOUT 1
#define REP_NORM 1
#define REP_GQ 1
#define REP_GSK 1
#define REP_TOPK 1
#define REP_EXP 1
constexpr int NB = 4, NS = 4096, NT = NB * NS, D = 1024, DIN = 3600, DINP = 3712;
constexpr int ZC_RET = 0, ZC_RW = 1024, ZC_GLA = 2432;
constexpr int RW_F = 1408;
constexpr int NEXP = 16384;
constexpr int NTHREADS = 256;

constexpr size_t MiB = 1024ull * 1024ull;
constexpr size_t WS_CTL   = 0;
constexpr size_t WS_WTIN  = 1 * MiB;
constexpr size_t WS_WTOUT = WS_WTIN + 2ull * DINP * D * 2;
constexpr size_t WS_WTQ   = WS_WTOUT + 2ull * D * D * 2;
constexpr size_t WS_SK    = WS_WTQ + 2ull * 2048 * D * 2;
constexpr size_t WS_UB    = WS_SK + 2ull * 16 * 128 * 128 * 2;
constexpr size_t WS_VB    = WS_UB + 2ull * NEXP * D;
constexpr size_t WS_LIN   = WS_VB + 2ull * NEXP * D;
constexpr size_t WS_H     = WS_LIN + 64 * MiB;
constexpr size_t WS_Z     = WS_H + (size_t)NT * D * 2;
constexpr size_t WS_O     = WS_Z + (size_t)NT * DINP * 2;
constexpr size_t WS_MIX   = WS_O + (size_t)NT * D * 2;
constexpr size_t WS_EIDX  = WS_MIX + 128 * MiB;
constexpr size_t WS_GATE  = WS_EIDX + (size_t)NT * 128 * 4;
constexpr size_t WS_ROPE  = WS_GATE + (size_t)NT * 128 * 4;
constexpr size_t WS_END   = WS_ROPE + 1 * MiB;
constexpr size_t RWA = (size_t)NT * 384;
constexpr size_t MX_W   = 0;
constexpr size_t MX_KK  = MX_W + RWA * 4;
constexpr size_t MX_KKA = MX_KK + RWA * 4;
constexpr size_t MX_R   = MX_KKA + RWA * 4;
constexpr size_t MX_K   = MX_R + RWA * 2;
constexpr size_t MX_V   = MX_K + RWA * 2;
constexpr size_t MX_G   = MX_V + RWA * 2;
constexpr size_t MX_END = MX_G + RWA * 2;
static_assert(MX_END <= 128 * MiB, "mix region");

__device__ __forceinline__ float bf2f(bf16_t v) { return __uint_as_float(((unsigned)v) << 16); }
__device__ __forceinline__ bf16_t f2bf(float f) { unsigned u = __float_as_uint(f); u += 0x7FFFu + ((u >> 16) & 1u); return (bf16_t)(u >> 16); }
__device__ __forceinline__ unsigned pk2(float lo, float hi) { return (unsigned)f2bf(lo) | ((unsigned)f2bf(hi) << 16); }
__device__ __forceinline__ float lo_bf(unsigned u) { return __uint_as_float(u << 16); }
__device__ __forceinline__ float hi_bf(unsigned u) { return __uint_as_float(u & 0xFFFF0000u); }
template <int CTRL> __device__ __forceinline__ float dpp_f(float v) { return __int_as_float(__builtin_amdgcn_update_dpp(0, __float_as_int(v), CTRL, 0xF, 0xF, true)); }
template <int CTRL> __device__ __forceinline__ unsigned dpp_u(unsigned v) { return (unsigned)__builtin_amdgcn_update_dpp(0, (int)v, CTRL, 0xF, 0xF, true); }
__device__ __forceinline__ float row16_sum(float v) { v += dpp_f<0x128>(v); v += dpp_f<0x124>(v); v += dpp_f<0x122>(v); v += dpp_f<0x121>(v); return v; }
__device__ __forceinline__ float xor16_sum(float v) { auto r = __builtin_amdgcn_permlane16_swap(__float_as_uint(v), __float_as_uint(v), false, false); return __uint_as_float(r[0]) + __uint_as_float(r[1]); }
__device__ __forceinline__ float xor32_sum(float v) { auto r = __builtin_amdgcn_permlane32_swap(__float_as_uint(v), __float_as_uint(v), false, false); return __uint_as_float(r[0]) + __uint_as_float(r[1]); }
__device__ __forceinline__ float wave_sum(float v) { return xor32_sum(xor16_sum(row16_sum(v))); }
__device__ __forceinline__ unsigned umax_(unsigned a, unsigned b) { return a > b ? a : b; }
__device__ __forceinline__ unsigned wave_max_u32(unsigned v) {
    v = umax_(v, dpp_u<0x128>(v)); v = umax_(v, dpp_u<0x124>(v)); v = umax_(v, dpp_u<0x122>(v)); v = umax_(v, dpp_u<0x121>(v));
    { auto r = __builtin_amdgcn_permlane16_swap(v, v, false, false); v = umax_(r[0], r[1]); }
    { auto r = __builtin_amdgcn_permlane32_swap(v, v, false, false); v = umax_(r[0], r[1]); }
    return v;
}
__device__ __forceinline__ float sigmoidf_(float x) { return 1.f / (1.f + __expf(-x)); }
__device__ __forceinline__ float softplusf_(float x) { return fmaxf(x, 0.f) + log1pf(__expf(-fabsf(x))); }

__device__ __forceinline__ int otid() { int t = threadIdx.x; asm volatile("" : "+v"(t)); return t; }

__device__ void transpose_tile(const float* __restrict__ W, int K, int N, bf16_t* __restrict__ Wt, int kt, int nt, float* tile  ) {
    const int tid = otid();
    const int k0 = kt * 64, n0 = nt * 64;
#pragma unroll
    for (int i = 0; i < 16; ++i) {
        const int k = i * 4 + (tid >> 6), n = tid & 63;
        tile[k * 65 + n] = (n0 + n < N) ? W[(size_t)(k0 + k) * N + n0 + n] : 0.f;
    }
    __syncthreads();
#pragma unroll
    for (int i = 0; i < 16; ++i) {
        const int n = i * 4 + (tid >> 6), k = tid & 63;
        Wt[(size_t)(n0 + n) * K + k0 + k] = f2bf(tile[k * 65 + n]);
    }
    __syncthreads();
}

struct ConvP {
    const float* w_in; const float* w_out; const float* w_q; const float* sk; const float* u; const float* v;
    unsigned char* ws;
};

__device__ void phase_convert_weights(const ConvP& p, char* smem, int bid, int nblk) {
    float* tile = (float*)smem;
    constexpr int T_IN = 16 * 58, T_OUT = 16 * 16, T_Q = 16 * 32, T_L = T_IN + T_OUT + T_Q;
    for (int it = bid; it < 2 * T_L; it += nblk) {
        const int l = it / T_L; int r = it % T_L;
        if (r < T_IN) { transpose_tile(p.w_in + (size_t)l * D * DIN, D, DIN, (bf16_t*)(p.ws + WS_WTIN) + (size_t)l * DINP * D, r / 58, r % 58, tile); continue; }
        r -= T_IN;
        if (r < T_OUT) { transpose_tile(p.w_out + (size_t)l * D * D, D, D, (bf16_t*)(p.ws + WS_WTOUT) + (size_t)l * D * D, r / 16, r % 16, tile); continue; }
        r -= T_OUT;
        transpose_tile(p.w_q + (size_t)l * D * 2048, D, 2048, (bf16_t*)(p.ws + WS_WTQ) + (size_t)l * 2048 * D, r / 32, r % 32, tile);
    }
    const size_t gtid = (size_t)bid * NTHREADS + otid(), gn = (size_t)nblk * NTHREADS;
    {
        float* ct = (float*)(p.ws + WS_ROPE); float* stb = ct + NS * 32;
        for (size_t i = gtid; i < (size_t)NS * 32; i += gn) {
            const int pos = (int)(i >> 5), fi = (int)(i & 31);
            const float inv = exp2f(-(float)fi * (13.287712379549449f / 32.f));
            float sn, cs; sincosf((float)pos * inv, &sn, &cs);
            ct[i] = cs; stb[i] = sn;
        }
    }
    {
        const size_t n8 = (2ull * 16 * 128 * 128) / 8;
        const f32x4* s = (const f32x4*)p.sk; u32x4* d = (u32x4*)(p.ws + WS_SK);
        for (size_t i = gtid; i < n8; i += gn) { f32x4 a = s[2 * i], b = s[2 * i + 1]; u32x4 o; o.x = pk2(a.x, a.y); o.y = pk2(a.z, a.w); o.z = pk2(b.x, b.y); o.w = pk2(b.z, b.w); d[i] = o; }
    }
    {
        const size_t n16 = (2ull * NEXP * D) / 16;
        const f32x4* su = (const f32x4*)p.u; u32x4* du = (u32x4*)(p.ws + WS_UB);
        const f32x4* sv = (const f32x4*)p.v; u32x4* dv = (u32x4*)(p.ws + WS_VB);
        for (size_t i = gtid; i < n16; i += gn) {
            f32x4 a = su[4 * i] * 512.f, b = su[4 * i + 1] * 512.f, c = su[4 * i + 2] * 512.f, d = su[4 * i + 3] * 512.f;
            u32x4 o;
            o.x = (unsigned)__builtin_amdgcn_cvt_pk_fp8_f32(a.z, a.w, __builtin_amdgcn_cvt_pk_fp8_f32(a.x, a.y, 0, false), true);
            o.y = (unsigned)__builtin_amdgcn_cvt_pk_fp8_f32(b.z, b.w, __builtin_amdgcn_cvt_pk_fp8_f32(b.x, b.y, 0, false), true);
            o.z = (unsigned)__builtin_amdgcn_cvt_pk_fp8_f32(c.z, c.w, __builtin_amdgcn_cvt_pk_fp8_f32(c.x, c.y, 0, false), true);
            o.w = (unsigned)__builtin_amdgcn_cvt_pk_fp8_f32(d.z, d.w, __builtin_amdgcn_cvt_pk_fp8_f32(d.x, d.y, 0, false), true);
            du[i] = o;
            a = sv[4 * i] * 64.f; b = sv[4 * i + 1] * 64.f; c = sv[4 * i + 2] * 64.f; d = sv[4 * i + 3] * 64.f;
            o.x = (unsigned)__builtin_amdgcn_cvt_pk_fp8_f32(a.z, a.w, __builtin_amdgcn_cvt_pk_fp8_f32(a.x, a.y, 0, false), true);
            o.y = (unsigned)__builtin_amdgcn_cvt_pk_fp8_f32(b.z, b.w, __builtin_amdgcn_cvt_pk_fp8_f32(b.x, b.y, 0, false), true);
            o.z = (unsigned)__builtin_amdgcn_cvt_pk_fp8_f32(c.z, c.w, __builtin_amdgcn_cvt_pk_fp8_f32(c.x, c.y, 0, false), true);
            o.w = (unsigned)__builtin_amdgcn_cvt_pk_fp8_f32(d.z, d.w, __builtin_amdgcn_cvt_pk_fp8_f32(d.x, d.y, 0, false), true);
            dv[i] = o;
        }
    }
}

template <bool OUT_F32>
__device__ void phase_rmsnorm(const float* x, const float* __restrict__ g, void* out, int bid, int nblk) {
    const int lane = otid() & 63, wave = otid() >> 6;
    const int gw = bid * 4 + wave, ngw = nblk * 4;
    f32x4 gv[4];
#pragma unroll
    for (int j = 0; j < 4; ++j) gv[j] = ((const f32x4*)g)[lane + 64 * j];
    for (int row = gw; row < NT; row += ngw) {
        const f32x4* xr = (const f32x4*)(x + (size_t)row * D) + lane;
        f32x4 v[4]; float s = 0.f;
#pragma unroll
        for (int j = 0; j < 4; ++j) { v[j] = xr[64 * j]; s += v[j].x * v[j].x + v[j].y * v[j].y + v[j].z * v[j].z + v[j].w * v[j].w; }
        s = wave_sum(s);
        const float rs = rsqrtf(s * (1.f / D) + 1e-6f);
        if (OUT_F32) {
            f32x4* o = (f32x4*)((float*)out + (size_t)row * D) + lane;
#pragma unroll
            for (int j = 0; j < 4; ++j) o[64 * j] = v[j] * rs * gv[j];
        } else {
            u32x2* o = (u32x2*)((bf16_t*)out + (size_t)row * D) + lane;
#pragma unroll
            for (int j = 0; j < 4; ++j) { f32x4 y = v[j] * rs * gv[j]; u32x2 w; w.x = pk2(y.x, y.y); w.y = pk2(y.z, y.w); o[64 * j] = w; }
        }
    }
}

struct GemmP {
    const bf16_t* A; int lda; int a_koff;
    const bf16_t* Bt; int ldb; int K;
    int MT, NTl;
    void* C; int ldc; const float* R;
};
constexpr int GS = 72;
template <int MODE>
__device__ void phase_gemm(const GemmP& p, char* smem, int bid, int nblk) {
    bf16_t* As = (bf16_t*)smem;
    bf16_t* Bs = As + 128 * GS;
    const int tid = otid(), lane = tid & 63, wave = tid >> 6;
    const int wr = wave >> 1, wc = wave & 1;
    const int lr = tid >> 3, lc = (tid & 7) * 8;
    const int fl = lane & 15, fq = lane >> 4;
    const int ntiles = p.MT * p.NTl;
    for (int tile = bid; tile < ntiles; tile += nblk) {
        const int mt = tile / p.NTl, nt = tile % p.NTl;
        const bf16_t* Ag = p.A + (size_t)mt * 128 * p.lda + (size_t)nt * p.a_koff + (size_t)lr * p.lda + lc;
        const bf16_t* Bg = p.Bt + (size_t)nt * 128 * p.ldb + (size_t)lr * p.ldb + lc;
        f32x4 acc[4][4];
#pragma unroll
        for (int m = 0; m < 4; ++m)
#pragma unroll
            for (int n = 0; n < 4; ++n) acc[m][n] = (f32x4){0.f, 0.f, 0.f, 0.f};
        u32x4 ra[4], rb[4];
#pragma unroll
        for (int i = 0; i < 4; ++i) { ra[i] = *(const u32x4*)(Ag + (size_t)(32 * i) * p.lda); rb[i] = *(const u32x4*)(Bg + (size_t)(32 * i) * p.ldb); }
        for (int k0 = 0; k0 < p.K; k0 += 64) {
            __syncthreads();
#pragma unroll
            for (int i = 0; i < 4; ++i) { *(u32x4*)(As + (lr + 32 * i) * GS + lc) = ra[i]; *(u32x4*)(Bs + (lr + 32 * i) * GS + lc) = rb[i]; }
            __syncthreads();
            if (k0 + 64 < p.K) {
#pragma unroll
                for (int i = 0; i < 4; ++i) { ra[i] = *(const u32x4*)(Ag + (size_t)(32 * i) * p.lda + k0 + 64); rb[i] = *(const u32x4*)(Bg + (size_t)(32 * i) * p.ldb + k0 + 64); }
            }
#pragma unroll
            for (int ks = 0; ks < 2; ++ks) {
                bf16x8 xa[4], wb[4];
#pragma unroll
                for (int m = 0; m < 4; ++m) xa[m] = *(const bf16x8*)(As + (wr * 64 + m * 16 + fl) * GS + ks * 32 + fq * 8);
#pragma unroll
                for (int n = 0; n < 4; ++n) wb[n] = *(const bf16x8*)(Bs + (wc * 64 + n * 16 + fl) * GS + ks * 32 + fq * 8);
#pragma unroll
                for (int m = 0; m < 4; ++m)
#pragma unroll
                    for (int n = 0; n < 4; ++n) acc[m][n] = (MODE == 3) ? __builtin_amdgcn_mfma_f32_16x16x32_bf16(xa[m], wb[n], acc[m][n], 0, 0, 0)
                                                                     : __builtin_amdgcn_mfma_f32_16x16x32_bf16(wb[n], xa[m], acc[m][n], 0, 0, 0);
            }
        }
#pragma unroll
        for (int m = 0; m < 4; ++m) {
#pragma unroll
            for (int n = 0; n < 4; ++n) {
                const f32x4 a = acc[m][n];
                if (MODE == 3) {
                    const size_t row = (size_t)mt * 128 + wr * 64 + m * 16 + fq * 4;
                    const size_t col = (size_t)nt * 128 + wc * 64 + n * 16 + fl;
                    *(f32x4*)((float*)p.C + col * p.ldc + row) = a;
                } else {
                    const size_t row = (size_t)mt * 128 + wr * 64 + m * 16 + fl;
                    const int col = nt * 128 + wc * 64 + n * 16 + fq * 4;
                    if (MODE == 0) { u32x2 w; w.x = pk2(a.x, a.y); w.y = pk2(a.z, a.w); *(u32x2*)((bf16_t*)p.C + row * p.ldc + col) = w; }
                    else if (MODE == 1) { *(f32x4*)((float*)p.C + row * p.ldc + col) = a; }
                    else { const f32x4 r = *(const f32x4*)(p.R + row * p.ldc + col); *(f32x4*)((float*)p.C + row * p.ldc + col) = r + a; }
                }
            }
        }
    }
}

constexpr int LS = 72;
struct LinP {
    const bf16_t* Z; bf16_t* O;
    const float* gk_up;
    const float* gk_bias;
    const float* norm_w;
    const float* rope;
    unsigned char* lin;
};
__device__ __forceinline__ bf16x8 ldfrag(const bf16_t* base, int row, int kofs) { return *(const bf16x8*)(base + row * LS + kofs); }

constexpr size_t LN_KV_RET = 0;
constexpr size_t LN_KV_GLA = LN_KV_RET + 1024ull * 64 * 64 * 4;
constexpr size_t LN_S_RET  = LN_KV_GLA + 1024ull * 96 * 64 * 4;
constexpr size_t LN_S_GLA  = LN_S_RET + 1024ull * 64 * 64 * 2;
constexpr size_t LN_DEC    = LN_S_GLA + 1024ull * 96 * 64 * 2;
static_assert(LN_DEC + 2048ull * 64 * 4 <= 64 * MiB, "lin region");

__device__ __forceinline__ float wave_incl_scan(float v) {
    v += dpp_f<0x111>(v); v += dpp_f<0x112>(v); v += dpp_f<0x114>(v); v += dpp_f<0x118>(v);
    v += __int_as_float(__builtin_amdgcn_update_dpp(0, __float_as_int(v), 0x142, 0xA, 0xF, false));
    v += __int_as_float(__builtin_amdgcn_update_dpp(0, __float_as_int(v), 0x143, 0xC, 0xF, false));
    return v;
}
__device__ __forceinline__ float readlane_f(float v, int l) { return __int_as_float(__builtin_amdgcn_readlane(__float_as_int(v), l)); }

__device__ __forceinline__ void rot8(const bf16_t* src, const float* rope, int spos, int cq, unsigned (&o1)[4], unsigned (&o2)[4]) {
    const u32x4 q1 = *(const u32x4*)(src + cq * 8), q2 = *(const u32x4*)(src + 32 + cq * 8);
    const unsigned q1w[4] = {q1.x, q1.y, q1.z, q1.w}, q2w[4] = {q2.x, q2.y, q2.z, q2.w};
    const f32x4 c0 = *(const f32x4*)(rope + spos * 32 + cq * 8), c1 = *(const f32x4*)(rope + spos * 32 + cq * 8 + 4);
    const f32x4 s0 = *(const f32x4*)(rope + NS * 32 + spos * 32 + cq * 8), s1 = *(const f32x4*)(rope + NS * 32 + spos * 32 + cq * 8 + 4);
    const float csv[8] = {c0.x, c0.y, c0.z, c0.w, c1.x, c1.y, c1.z, c1.w}, snv[8] = {s0.x, s0.y, s0.z, s0.w, s1.x, s1.y, s1.z, s1.w};
#pragma unroll
    for (int e = 0; e < 4; ++e) {
        const float a1l = lo_bf(q1w[e]), a1h = hi_bf(q1w[e]), a2l = lo_bf(q2w[e]), a2h = hi_bf(q2w[e]);
        o1[e] = pk2(a1l * csv[2 * e] - a2l * snv[2 * e], a1h * csv[2 * e + 1] - a2h * snv[2 * e + 1]);
        o2[e] = pk2(a1l * snv[2 * e] + a2l * csv[2 * e], a1h * snv[2 * e + 1] + a2h * csv[2 * e + 1]);
    }
}
__device__ __forceinline__ void load_vts(const bf16_t* Z, size_t t0, int voff, int nch, bf16_t* Vts, int tid) {
    for (int x = tid; x < 64 * nch; x += NTHREADS) {
        const int tok = x / nch, ch = x % nch;
        const u32x4 vv = *(const u32x4*)(Z + (t0 + tok) * DINP + voff + ch * 8);
        const unsigned w[4] = {vv.x, vv.y, vv.z, vv.w};
#pragma unroll
        for (int e = 0; e < 4; ++e) { Vts[(ch * 8 + 2 * e) * LS + tok] = (bf16_t)(w[e] & 0xFFFFu); Vts[(ch * 8 + 2 * e + 1) * LS + tok] = (bf16_t)(w[e] >> 16); }
    }
}
__device__ __forceinline__ void load_gd(const bf16_t* zr, float (&gd)[16]) {
    const u32x4 g0 = *(const u32x4*)zr, g1 = *(const u32x4*)(zr + 8);
    gd[0] = lo_bf(g0.x); gd[1] = hi_bf(g0.x); gd[2] = lo_bf(g0.y); gd[3] = hi_bf(g0.y); gd[4] = lo_bf(g0.z); gd[5] = hi_bf(g0.z); gd[6] = lo_bf(g0.w); gd[7] = hi_bf(g0.w);
    gd[8] = lo_bf(g1.x); gd[9] = hi_bf(g1.x); gd[10] = lo_bf(g1.y); gd[11] = hi_bf(g1.y); gd[12] = lo_bf(g1.z); gd[13] = hi_bf(g1.z); gd[14] = lo_bf(g1.w); gd[15] = hi_bf(g1.w);
}
__device__ __forceinline__ float gla_gk(const LinP& p, const float (&gd)[16], int h, int d) {
    float x = p.gk_bias[h * 48 + d];
#pragma unroll
    for (int i = 0; i < 16; ++i) x += gd[i] * p.gk_up[i * 192 + h * 48 + d];
    return (fminf(x, 0.f) - log1pf(__expf(-fabsf(x)))) * (1.f / 16.f);
}
__device__ __forceinline__ float ret_lg(int h) { const float e = exp2f(-5.f - (float)h * (4.f / 3.f)); return log1pf(-e); }

template <bool IS_GLA>
__device__ void lin_kv_task(const LinP& p, char* smem, int b, int h, int c) {
    constexpr int DV = IS_GLA ? 96 : 64, NVB = DV / 16;
    const int koff = IS_GLA ? (ZC_GLA + 192 + h * 48) : (ZC_RET + 256 + h * 64);
    const int voff = IS_GLA ? (ZC_GLA + 384 + h * 96) : (ZC_RET + 512 + h * 64);
    const int gkdoff = ZC_GLA + 768;
    bf16_t* Ks = (bf16_t*)smem;
    bf16_t* Kts = Ks + 64 * LS;
    bf16_t* Vts = Kts + 64 * LS;
    float* decs = (float*)(Vts + 96 * LS);
    const int tid = otid(), lane = tid & 63, wave = tid >> 6;
    const int fl = lane & 15, fq = lane >> 4;
    const size_t t0 = (size_t)b * NS + (size_t)c * 64;
    const int task = (b * 4 + h) * 64 + c;
    __syncthreads();
    if (IS_GLA) {
        for (int x = tid; x < 64 * 6; x += NTHREADS) {
            const int tok = x / 6, ch = x % 6;
            *(u32x4*)(Ks + tok * LS + ch * 8) = *(const u32x4*)(p.Z + (t0 + tok) * DINP + koff + ch * 8);
        }
        for (int x = tid; x < 16 * LS / 2; x += NTHREADS) ((unsigned*)(Kts + 48 * LS))[x] = 0u;
        if (tid < 16) decs[48 + tid] = 1.f;
        load_vts(p.Z, t0, voff, 12, Vts, tid);
    } else {
        const int tok = tid >> 2, cq = tid & 3;
        unsigned k1[4], k2[4];
        rot8(p.Z + (t0 + tok) * DINP + koff, p.rope, c * 64 + tok, cq, k1, k2);
        const float fk2 = 0.125f * __expf(ret_lg(h) * (float)(63 - tok));
#pragma unroll
        for (int e = 0; e < 4; ++e) {
            Kts[(cq * 8 + 2 * e) * LS + tok] = f2bf(lo_bf(k1[e]) * fk2); Kts[(cq * 8 + 2 * e + 1) * LS + tok] = f2bf(hi_bf(k1[e]) * fk2);
            Kts[(32 + cq * 8 + 2 * e) * LS + tok] = f2bf(lo_bf(k2[e]) * fk2); Kts[(32 + cq * 8 + 2 * e + 1) * LS + tok] = f2bf(hi_bf(k2[e]) * fk2);
        }
        if (tid < 64) decs[tid] = __expf(ret_lg(h) * 64.f);
        load_vts(p.Z, t0, voff, 8, Vts, tid);
    }
    __syncthreads();
    if (IS_GLA) {
        float gd[16];
        load_gd(p.Z + (t0 + lane) * DINP + gkdoff, gd);
#pragma unroll 1
        for (int dd = 0; dd < 12; ++dd) {
            const int d = wave * 12 + dd;
            const float bc = wave_incl_scan(gla_gk(p, gd, h, d));
            const float bl = readlane_f(bc, 63);
            Kts[d * LS + lane] = f2bf(bf2f(Ks[lane * LS + d]) * __expf(bl - bc));
            if (lane == 0) decs[d] = __expf(bl);
        }
        __syncthreads();
    }
    float* KV = (float*)(p.lin + (IS_GLA ? LN_KV_GLA : LN_KV_RET)) + (size_t)task * DV * 64;
#pragma unroll
    for (int vb = 0; vb < NVB; ++vb) {
        f32x4 a4 = (f32x4){0.f, 0.f, 0.f, 0.f};
#pragma unroll
        for (int ks = 0; ks < 2; ++ks) {
            const bf16x8 a = ldfrag(Kts, 16 * wave + fl, ks * 32 + fq * 8);
            const bf16x8 bv = ldfrag(Vts, 16 * vb + fl, ks * 32 + fq * 8);
            a4 = __builtin_amdgcn_mfma_f32_16x16x32_bf16(a, bv, a4, 0, 0, 0);
        }
        *(f32x4*)(KV + (size_t)(16 * vb + fl) * 64 + 16 * wave + 4 * fq) = a4;
    }
    if (tid < 64) ((float*)(p.lin + LN_DEC))[(size_t)((IS_GLA ? 1024 : 0) + task) * 64 + tid] = decs[tid];
}

__device__ void lin_scan_phase(const LinP& p, int vbid, int nvblk) {
    const int tid = otid();
    for (int it = vbid; it < 160; it += nvblk) {
        const bool gla = it >= 64;
        const int r = gla ? it - 64 : it;
        const int per = gla ? 6 : 4, DVx = gla ? 96 : 64;
        const int bh = r / per, e = (r % per) * 1024 + tid;
        const float* KV = (const float*)(p.lin + (gla ? LN_KV_GLA : LN_KV_RET)) + (size_t)bh * 64 * DVx * 64 + e;
        bf16_t* Sb = (bf16_t*)(p.lin + (gla ? LN_S_GLA : LN_S_RET)) + (size_t)bh * 64 * DVx * 64 + e;
        const float* DEC = (const float*)(p.lin + LN_DEC) + (size_t)((gla ? 1024 : 0) + bh * 64) * 64 + (e & 63);
        float S0 = 0.f, S1 = 0.f, S2 = 0.f, S3 = 0.f;
#pragma unroll 8
        for (int c = 0; c < 64; ++c) {
            const size_t o = (size_t)c * DVx * 64;
            const float k0 = KV[o], k1 = KV[o + 256], k2 = KV[o + 512], k3 = KV[o + 768], dc = DEC[c * 64];
            Sb[o] = f2bf(S0); Sb[o + 256] = f2bf(S1); Sb[o + 512] = f2bf(S2); Sb[o + 768] = f2bf(S3);
            S0 = S0 * dc + k0; S1 = S1 * dc + k1; S2 = S2 * dc + k2; S3 = S3 * dc + k3;
        }
    }
}

template <bool IS_GLA>
__device__ void lin_out_task(const LinP& p, char* smem, int b, int h, int c) {
    constexpr int DV = IS_GLA ? 96 : 64, NVB = DV / 16;
    const int qoff = IS_GLA ? (ZC_GLA + 0 + h * 48) : (ZC_RET + 0 + h * 64);
    const int koff = IS_GLA ? (ZC_GLA + 192 + h * 48) : (ZC_RET + 256 + h * 64);
    const int voff = IS_GLA ? (ZC_GLA + 384 + h * 96) : (ZC_RET + 512 + h * 64);
    const int goff = IS_GLA ? (ZC_GLA + 784 + h * 96) : (ZC_RET + 768 + h * 64);
    const int gkdoff = ZC_GLA + 768;
    const int ooff = IS_GLA ? (640 + h * 96) : (h * 64);
    bf16_t* Qs = (bf16_t*)smem;
    bf16_t* Ks = Qs + 64 * LS;
    bf16_t* Ps = Ks + 64 * LS;
    bf16_t* Vts = Ps + 64 * LS;
    bf16_t* Sts = Vts + 96 * LS;
    const int tid = otid(), lane = tid & 63, wave = tid >> 6;
    const int fl = lane & 15, fq = lane >> 4;
    const size_t t0 = (size_t)b * NS + (size_t)c * 64;
    const int task = (b * 4 + h) * 64 + c;
    __syncthreads();
    {
        const bf16_t* Sb = (const bf16_t*)(p.lin + (IS_GLA ? LN_S_GLA : LN_S_RET)) + (size_t)task * DV * 64;
        for (int x = tid; x < DV * 8; x += NTHREADS) { const int v = x >> 3, ch = x & 7; *(u32x4*)(Sts + v * LS + ch * 8) = *(const u32x4*)(Sb + v * 64 + ch * 8); }
    }
    if (IS_GLA) {
        for (int x = tid; x < 64 * 6; x += NTHREADS) {
            const int tok = x / 6, ch = x % 6;
            const bf16_t* zr = p.Z + (t0 + tok) * DINP;
            *(u32x4*)(Qs + tok * LS + ch * 8) = *(const u32x4*)(zr + qoff + ch * 8);
            *(u32x4*)(Ks + tok * LS + ch * 8) = *(const u32x4*)(zr + koff + ch * 8);
        }
        for (int x = tid; x < 64 * 2; x += NTHREADS) {
            const int tok = x >> 1, ch = 6 + (x & 1);
            *(u32x4*)(Qs + tok * LS + ch * 8) = (u32x4){0u, 0u, 0u, 0u};
            *(u32x4*)(Ks + tok * LS + ch * 8) = (u32x4){0u, 0u, 0u, 0u};
        }
        load_vts(p.Z, t0, voff, 12, Vts, tid);
    } else {
        const int tok = tid >> 2, cq = tid & 3;
        const bf16_t* zr = p.Z + (t0 + tok) * DINP;
        unsigned q1[4], q2[4], k1[4], k2[4];
        rot8(zr + qoff, p.rope, c * 64 + tok, cq, q1, q2);
        rot8(zr + koff, p.rope, c * 64 + tok, cq, k1, k2);
        const float lg = ret_lg(h);
        const float fqd = __expf(lg * (float)(tok + 1)), fk = 0.125f * __expf(-lg * (float)(tok + 1));
#pragma unroll
        for (int e = 0; e < 4; ++e) {
            q1[e] = pk2(lo_bf(q1[e]) * fqd, hi_bf(q1[e]) * fqd); q2[e] = pk2(lo_bf(q2[e]) * fqd, hi_bf(q2[e]) * fqd);
            k1[e] = pk2(lo_bf(k1[e]) * fk, hi_bf(k1[e]) * fk); k2[e] = pk2(lo_bf(k2[e]) * fk, hi_bf(k2[e]) * fk);
        }
        *(u32x4*)(Qs + tok * LS + cq * 8) = (u32x4){q1[0], q1[1], q1[2], q1[3]};
        *(u32x4*)(Qs + tok * LS + 32 + cq * 8) = (u32x4){q2[0], q2[1], q2[2], q2[3]};
        *(u32x4*)(Ks + tok * LS + cq * 8) = (u32x4){k1[0], k1[1], k1[2], k1[3]};
        *(u32x4*)(Ks + tok * LS + 32 + cq * 8) = (u32x4){k2[0], k2[1], k2[2], k2[3]};
        load_vts(p.Z, t0, voff, 8, Vts, tid);
    }
    __syncthreads();
    if (IS_GLA) {
        float gd[16];
        load_gd(p.Z + (t0 + lane) * DINP + gkdoff, gd);
#pragma unroll 1
        for (int dd = 0; dd < 12; ++dd) {
            const int d = wave * 12 + dd;
            const float bc = wave_incl_scan(gla_gk(p, gd, h, d));
            const float eq = __expf(bc) * 0.14433756729740643f  , ek = __expf(-bc);
            Qs[lane * LS + d] = f2bf(bf2f(Qs[lane * LS + d]) * eq);
            Ks[lane * LS + d] = f2bf(bf2f(Ks[lane * LS + d]) * ek);
        }
        __syncthreads();
    }
#pragma unroll
    for (int jb = 0; jb < 4; ++jb) {
        f32x4 ap = (f32x4){0.f, 0.f, 0.f, 0.f};
#pragma unroll
        for (int ks = 0; ks < 2; ++ks) {
            const bf16x8 a = ldfrag(Ks, 16 * jb + fl, ks * 32 + fq * 8);
            const bf16x8 bq = ldfrag(Qs, 16 * wave + fl, ks * 32 + fq * 8);
            ap = __builtin_amdgcn_mfma_f32_16x16x32_bf16(a, bq, ap, 0, 0, 0);
        }
        const int i = 16 * wave + fl, j0 = 16 * jb + 4 * fq;
        u32x2 w;
        w.x = pk2(j0 + 0 <= i ? ap.x : 0.f, j0 + 1 <= i ? ap.y : 0.f);
        w.y = pk2(j0 + 2 <= i ? ap.z : 0.f, j0 + 3 <= i ? ap.w : 0.f);
        *(u32x2*)(Ps + i * LS + j0) = w;
    }
    __syncthreads();
    {
        f32x4 ao[NVB];
        float ss = 0.f;
#pragma unroll
        for (int vb = 0; vb < NVB; ++vb) {
            f32x4 a4 = (f32x4){0.f, 0.f, 0.f, 0.f};
#pragma unroll
            for (int ks = 0; ks < 2; ++ks) {
                const bf16x8 a = ldfrag(Vts, 16 * vb + fl, ks * 32 + fq * 8);
                const bf16x8 bp = ldfrag(Ps, 16 * wave + fl, ks * 32 + fq * 8);
                a4 = __builtin_amdgcn_mfma_f32_16x16x32_bf16(a, bp, a4, 0, 0, 0);
            }
#pragma unroll
            for (int ks = 0; ks < 2; ++ks) {
                const bf16x8 a = ldfrag(Sts, 16 * vb + fl, ks * 32 + fq * 8);
                const bf16x8 bq = ldfrag(Qs, 16 * wave + fl, ks * 32 + fq * 8);
                a4 = __builtin_amdgcn_mfma_f32_16x16x32_bf16(a, bq, a4, 0, 0, 0);
            }
            ao[vb] = a4;
            ss += a4.x * a4.x + a4.y * a4.y + a4.z * a4.z + a4.w * a4.w;
        }
        ss = xor32_sum(xor16_sum(ss));
        const float inv = rsqrtf(ss * (1.f / DV) + 1e-5f);
        const size_t t = t0 + 16 * wave + fl;
#pragma unroll
        for (int vb = 0; vb < NVB; ++vb) {
            const int v0 = 16 * vb + 4 * fq;
            const u32x2 gg = *(const u32x2*)(p.Z + t * DINP + goff + v0);
            float g4[4] = {lo_bf(gg.x), hi_bf(gg.x), lo_bf(gg.y), hi_bf(gg.y)};
            float o4[4] = {ao[vb].x, ao[vb].y, ao[vb].z, ao[vb].w};
#pragma unroll
            for (int e = 0; e < 4; ++e) {
                float y = o4[e] * inv;
                if (IS_GLA) y *= p.norm_w[h * 96 + v0 + e];
                const float g = g4[e];
                o4[e] = y * (g / (1.f + __expf(-g)));
            }
            u32x2 w; w.x = pk2(o4[0], o4[1]); w.y = pk2(o4[2], o4[3]);
            *(u32x2*)(p.O + t * D + ooff + v0) = w;
        }
    }
}
__device__ __forceinline__ void lin_kv_dispatch(const LinP& p, char* smem, int task) {
    const int r = task & 1023, bh = r >> 6, c = r & 63;
    if (task < 1024) lin_kv_task<false>(p, smem, bh >> 2, bh & 3, c); else lin_kv_task<true>(p, smem, bh >> 2, bh & 3, c);
}
__device__ __forceinline__ void lin_out_dispatch(const LinP& p, char* smem, int task) {
    const int r = task & 1023, bh = r >> 6, c = r & 63;
    if (task < 1024) lin_out_task<false>(p, smem, bh >> 2, bh & 3, c); else lin_out_task<true>(p, smem, bh >> 2, bh & 3, c);
}

struct RwP {
    const bf16_t* Z; unsigned char* mix;
    const float* mu; const float* w_up; const float* w_bias; const float* a_up; const float* a_bias; const float* g_up;
    const float* k_k; const float* k_a; const float* r_k; const float* ln_w; const float* ln_b;
    float* oraw; bf16_t* O; bf16_t* Y;
};
__device__ void phase_rwkv_prep(const RwP& p, char* smem, int bid, int nblk) {
    float* fs = (float*)smem;
    const int tid = otid(), lane = tid & 63;
    float* Wd = (float*)(p.mix + MX_W); float* KKd = (float*)(p.mix + MX_KK); float* KKAd = (float*)(p.mix + MX_KKA);
    bf16_t* Rd = (bf16_t*)(p.mix + MX_R); bf16_t* Kd = (bf16_t*)(p.mix + MX_K); bf16_t* Vd = (bf16_t*)(p.mix + MX_V); bf16_t* Gd = (bf16_t*)(p.mix + MX_G);
    for (int it = bid; it < NT / 8; it += nblk) {
        const int t0 = it * 8;
        for (int x = tid; x < 8 * RW_F; x += NTHREADS) {
            const int tok = x / RW_F, c = x % RW_F;
            const int t = t0 + tok;
            const float f = bf2f(p.Z[(size_t)t * DINP + ZC_RW + c]);
            const float fp = ((t & (NS - 1)) == 0) ? 0.f : bf2f(p.Z[(size_t)(t - 1) * DINP + ZC_RW + c]);
            float v = f + (fp - f) * p.mu[c];
            if (c >= 1152 && c < 1216) v = tanhf(v);
            else if (c >= 1280) v = sigmoidf_(v);
            fs[tok * RW_F + c] = v;
        }
        __syncthreads();
        for (int cc = tid; cc < 384; cc += NTHREADS) {
            float aw[8], aa[8], ag[8];
#pragma unroll
            for (int k = 0; k < 8; ++k) { aw[k] = 0.f; aa[k] = 0.f; ag[k] = 0.f; }
            for (int i = 0; i < 64; i += 4) {
                float w1[4], a1[4];
#pragma unroll
                for (int e = 0; e < 4; ++e) { w1[e] = p.w_up[(i + e) * 384 + cc]; a1[e] = p.a_up[(i + e) * 384 + cc]; }
#pragma unroll
                for (int k = 0; k < 8; ++k) {
                    const f32x4 xw = *(const f32x4*)(fs + k * RW_F + 1152 + i), xa = *(const f32x4*)(fs + k * RW_F + 1216 + i);
                    aw[k] += xw.x * w1[0] + xw.y * w1[1] + xw.z * w1[2] + xw.w * w1[3];
                    aa[k] += xa.x * a1[0] + xa.y * a1[1] + xa.z * a1[2] + xa.w * a1[3];
                }
            }
            for (int i = 0; i < 128; i += 4) {
                float g1[4];
#pragma unroll
                for (int e = 0; e < 4; ++e) g1[e] = p.g_up[(i + e) * 384 + cc];
#pragma unroll
                for (int k = 0; k < 8; ++k) {
                    const f32x4 xg = *(const f32x4*)(fs + k * RW_F + 1280 + i);
                    ag[k] += xg.x * g1[0] + xg.y * g1[1] + xg.z * g1[2] + xg.w * g1[3];
                }
            }
            const float wb = p.w_bias[cc], ab = p.a_bias[cc], kkc = p.k_k[cc], kac = p.k_a[cc];
            const int hd = cc >> 6, cl = cc & 63;
#pragma unroll
            for (int k = 0; k < 8; ++k) {
                const int t = t0 + k, b = t >> 12, s = t & (NS - 1);
                const size_t hi = ((size_t)(b * 6 + hd) * NS + s) * 64 + cl;
                const float wl = -softplusf_(-(wb + aw[k])) - 0.5f;
                const float dec = __expf(-__expf(wl));
                const float a = sigmoidf_(ab + aa[k]);
                const float r = fs[k * RW_F + cc], kx = fs[k * RW_F + 384 + cc], vx = fs[k * RW_F + 768 + cc];
                float kk = kx * kkc;
                const float ss = wave_sum(kk * kk);
                kk *= rsqrtf(fmaxf(ss, 1e-24f));
                const float kmod = kx * (1.f + (a - 1.f) * kac);
                Wd[hi] = dec; KKd[hi] = kk; KKAd[hi] = kk * a;
                Rd[hi] = f2bf(r); Kd[hi] = f2bf(kmod); Vd[hi] = f2bf(vx);
                Gd[(size_t)t * 384 + cc] = f2bf(ag[k]);
            }
        }
        __syncthreads();
    }
}

constexpr int SC_STEPS = 16;
constexpr int SEG_BEG[4] = {0, 1376, 2736, 4096};
constexpr size_t MX_SE0 = MX_END;
constexpr size_t MX_XE  = MX_SE0 + 24ull * 3 * 4096 * 4;
constexpr size_t MX_SST = MX_XE + 24ull * 3 * 4096 * 4;
static_assert(MX_SST + 24ull * 3 * 4096 * 2 <= 128 * MiB, "mix region");
__device__ void rwkv_scan_task(const RwP& p, char* smem, int bh, int seg, int grp) {
    float* buf = (float*)smem;
    float* obuf = buf + 2 * 6 * SC_STEPS * 64;
    const int tid = otid(), lane = tid & 63, wave = tid >> 6;
    const int rloc = wave * 4 + (lane >> 4);
    const bool ident = grp >= 4;
    const int row = (grp & 3) * 16 + rloc;
    const int c4 = (lane & 15) * 4;
    const int s_beg = seg == 0 ? SEG_BEG[0] : (seg == 1 ? SEG_BEG[1] : SEG_BEG[2]);
    const int s_end = seg == 0 ? SEG_BEG[1] : (seg == 1 ? SEG_BEG[2] : SEG_BEG[3]);
    const int NCH = (s_end - s_beg) / SC_STEPS;
    const size_t hb = ((size_t)bh * NS + s_beg) * 64;
    const float* Wd = (const float*)(p.mix + MX_W) + hb;
    const float* KKd = (const float*)(p.mix + MX_KK) + hb;
    const float* KKAd = (const float*)(p.mix + MX_KKA) + hb;
    const bf16_t* Rd = (const bf16_t*)(p.mix + MX_R) + hb;
    const bf16_t* Kd = (const bf16_t*)(p.mix + MX_K) + hb;
    const bf16_t* Vd = (const bf16_t*)(p.mix + MX_V) + hb;
    float* orow = p.oraw + hb;
    bf16_t* yrow = p.Y + hb;
    f32x4 S;
    S.x = (ident && c4 + 0 == row) ? 1.f : 0.f; S.y = (ident && c4 + 1 == row) ? 1.f : 0.f; S.z = (ident && c4 + 2 == row) ? 1.f : 0.f; S.w = (ident && c4 + 3 == row) ? 1.f : 0.f;
    f32x4 lw, lkk, lka; u32x2 lr, lk, lv;
    auto gload = [&](int ch) {
        const size_t e = (size_t)ch * SC_STEPS * 64 + tid * 4;
        lw = *(const f32x4*)(Wd + e); lkk = *(const f32x4*)(KKd + e); lka = *(const f32x4*)(KKAd + e);
        lr = *(const u32x2*)(Rd + e); lk = *(const u32x2*)(Kd + e); lv = *(const u32x2*)(Vd + e);
    };
    auto lstore = [&](int bsel) {
        float* bb = buf + bsel * 6 * SC_STEPS * 64 + tid * 4;
        *(f32x4*)(bb + 0 * SC_STEPS * 64) = lw; *(f32x4*)(bb + 1 * SC_STEPS * 64) = lkk; *(f32x4*)(bb + 2 * SC_STEPS * 64) = lka;
        *(f32x4*)(bb + 3 * SC_STEPS * 64) = (f32x4){lo_bf(lr.x), hi_bf(lr.x), lo_bf(lr.y), hi_bf(lr.y)};
        *(f32x4*)(bb + 4 * SC_STEPS * 64) = (f32x4){lo_bf(lk.x), hi_bf(lk.x), lo_bf(lk.y), hi_bf(lk.y)};
        *(f32x4*)(bb + 5 * SC_STEPS * 64) = (f32x4){lo_bf(lv.x), hi_bf(lv.x), lo_bf(lv.y), hi_bf(lv.y)};
    };
    __syncthreads();
    gload(0); lstore(0);
    __syncthreads();
    const float vmask = ident ? 0.f : 1.f;
    for (int ch = 0; ch < NCH; ++ch) {
        if (ch + 1 < NCH) gload(ch + 1);
        const float* bb = buf + (ch & 1) * 6 * SC_STEPS * 64;
        f32x4 w4 = *(const f32x4*)(bb + 0 * SC_STEPS * 64 + c4), kk4 = *(const f32x4*)(bb + 1 * SC_STEPS * 64 + c4), ka4 = *(const f32x4*)(bb + 2 * SC_STEPS * 64 + c4);
        f32x4 r4 = *(const f32x4*)(bb + 3 * SC_STEPS * 64 + c4), k4 = *(const f32x4*)(bb + 4 * SC_STEPS * 64 + c4);
        float vv = bb[5 * SC_STEPS * 64 + row];
#pragma unroll
        for (int st = 0; st < SC_STEPS; ++st) {
            const int sn = (st + 1 < SC_STEPS) ? st + 1 : st;
            const f32x4 nw4 = *(const f32x4*)(bb + 0 * SC_STEPS * 64 + sn * 64 + c4), nkk4 = *(const f32x4*)(bb + 1 * SC_STEPS * 64 + sn * 64 + c4);
            const f32x4 nka4 = *(const f32x4*)(bb + 2 * SC_STEPS * 64 + sn * 64 + c4), nr4 = *(const f32x4*)(bb + 3 * SC_STEPS * 64 + sn * 64 + c4);
            const f32x4 nk4 = *(const f32x4*)(bb + 4 * SC_STEPS * 64 + sn * 64 + c4);
            const float nvv = bb[5 * SC_STEPS * 64 + sn * 64 + row];
            const float vx = vv * vmask;
            float pd = S.x * kk4.x + S.y * kk4.y + S.z * kk4.z + S.w * kk4.w;
            const float sa = -row16_sum(pd);
            S.x = S.x * w4.x + vx * k4.x + sa * ka4.x;
            S.y = S.y * w4.y + vx * k4.y + sa * ka4.y;
            S.z = S.z * w4.z + vx * k4.z + sa * ka4.z;
            S.w = S.w * w4.w + vx * k4.w + sa * ka4.w;
            float od = S.x * r4.x + S.y * r4.y + S.z * r4.z + S.w * r4.w;
            od = row16_sum(od);
            obuf[st * 16 + rloc] = od;
            w4 = nw4; kk4 = nkk4; ka4 = nka4; r4 = nr4; k4 = nk4; vv = nvv;
        }
        __syncthreads();
        {
            const int st = tid >> 4, rr = tid & 15;
            const size_t oi = ((size_t)ch * SC_STEPS + st) * 64 + (grp & 3) * 16 + rr;
            if (ident) yrow[oi] = f2bf(obuf[tid]); else orow[oi] = obuf[tid];
        }
        if (ch + 1 < NCH) lstore((ch + 1) & 1);
        __syncthreads();
    }
    float* fin = (float*)(p.mix + (ident ? MX_XE : MX_SE0)) + ((size_t)(bh * 3 + seg) * 64 + row) * 64 + c4;
    *(f32x4*)fin = S;
}

__device__ void phase_rwkv_chain(const RwP& p, int bid, int nblk) {
    const int lane = otid() & 63, wave = otid() >> 6;
    const float* SE0 = (const float*)(p.mix + MX_SE0); const float* XE = (const float*)(p.mix + MX_XE);
    bf16_t* SST = (bf16_t*)(p.mix + MX_SST);
    for (int x = bid * 4 + wave; x < 24 * 4; x += nblk * 4) {
        const int bh = x >> 2, cg = (x & 3) * 16;
        const float* s1 = SE0 + ((size_t)(bh * 3 + 0) * 64 + lane) * 64;
        const float* e1 = SE0 + ((size_t)(bh * 3 + 1) * 64 + lane) * 64 + cg;
        const float* X1 = XE + (size_t)(bh * 3 + 1) * 4096 + cg;
        float o[16];
#pragma unroll
        for (int k = 0; k < 16; ++k) o[k] = e1[k];
        for (int i = 0; i < 64; ++i) {
            const float si = s1[i];
#pragma unroll
            for (int k = 0; k < 16; ++k) o[k] += si * X1[i * 64 + k];
        }
        bf16_t* d1 = SST + ((size_t)(bh * 3 + 1) * 64 + lane) * 64 + cg;
        bf16_t* d2 = SST + ((size_t)(bh * 3 + 2) * 64 + lane) * 64 + cg;
#pragma unroll
        for (int k = 0; k < 16; ++k) { d1[k] = f2bf(s1[cg + k]); d2[k] = f2bf(o[k]); }
    }
}

__device__ void phase_rwkv_post(const RwP& p, int bid, int nblk) {
    const int lane = otid() & 63, wave = otid() >> 6;
    const int fl = lane & 15, fq = lane >> 4;
    const bf16_t* Rd = (const bf16_t*)(p.mix + MX_R); const bf16_t* Kd = (const bf16_t*)(p.mix + MX_K); const bf16_t* Vd = (const bf16_t*)(p.mix + MX_V);
    const bf16_t* Gd = (const bf16_t*)(p.mix + MX_G); const bf16_t* SST = (const bf16_t*)(p.mix + MX_SST);
    for (int x = bid * 4 + wave; x < 24 * (NS / 16); x += nblk * 4) {
        const int bh = x / (NS / 16), s0 = (x % (NS / 16)) * 16;
        const int b = bh / 6, hd = bh % 6;
        const int seg = s0 < SEG_BEG[1] ? 0 : (s0 < SEG_BEG[2] ? 1 : 2);
        const size_t hrow = ((size_t)bh * NS + s0 + fl) * 64;
        f32x4 acc[4];
#pragma unroll
        for (int n = 0; n < 4; ++n) acc[n] = *(const f32x4*)(p.oraw + hrow + 16 * n + 4 * fq);
        if (seg > 0) {
            const bf16_t* ss = SST + (size_t)(bh * 3 + seg) * 4096;
#pragma unroll
            for (int ks = 0; ks < 2; ++ks) {
                const bf16x8 yb = *(const bf16x8*)(p.Y + hrow + ks * 32 + fq * 8);
#pragma unroll
                for (int n = 0; n < 4; ++n) {
                    const bf16x8 sa = *(const bf16x8*)(ss + (size_t)(16 * n + fl) * 64 + ks * 32 + fq * 8);
                    acc[n] = __builtin_amdgcn_mfma_f32_16x16x32_bf16(sa, yb, acc[n], 0, 0, 0);
                }
            }
        }
        float sm = 0.f;
#pragma unroll
        for (int n = 0; n < 4; ++n) sm += acc[n].x + acc[n].y + acc[n].z + acc[n].w;
        const float mean = xor32_sum(xor16_sum(sm)) * (1.f / 64.f);
        float sv = 0.f;
#pragma unroll
        for (int n = 0; n < 4; ++n) { acc[n] = acc[n] - mean; sv += acc[n].x * acc[n].x + acc[n].y * acc[n].y + acc[n].z * acc[n].z + acc[n].w * acc[n].w; }
        const float rstd = rsqrtf(xor32_sum(xor16_sum(sv)) * (1.f / 64.f) + 64e-5f);
        float rk = 0.f; f32x4 vv[4];
#pragma unroll
        for (int n = 0; n < 4; ++n) {
            const int c = 16 * n + 4 * fq;
            const u32x2 r2 = *(const u32x2*)(Rd + hrow + c), k2 = *(const u32x2*)(Kd + hrow + c), v2 = *(const u32x2*)(Vd + hrow + c);
            const f32x4 rkw = *(const f32x4*)(p.r_k + hd * 64 + c);
            rk += lo_bf(r2.x) * lo_bf(k2.x) * rkw.x + hi_bf(r2.x) * hi_bf(k2.x) * rkw.y + lo_bf(r2.y) * lo_bf(k2.y) * rkw.z + hi_bf(r2.y) * hi_bf(k2.y) * rkw.w;
            vv[n] = (f32x4){lo_bf(v2.x), hi_bf(v2.x), lo_bf(v2.y), hi_bf(v2.y)};
        }
        rk = xor32_sum(xor16_sum(rk));
        const size_t t = (size_t)b * NS + s0 + fl;
#pragma unroll
        for (int n = 0; n < 4; ++n) {
            const int c = 16 * n + 4 * fq;
            const f32x4 lw = *(const f32x4*)(p.ln_w + hd * 64 + c), lb = *(const f32x4*)(p.ln_b + hd * 64 + c);
            const u32x2 g2 = *(const u32x2*)(Gd + t * 384 + hd * 64 + c);
            const f32x4 gg = (f32x4){lo_bf(g2.x), hi_bf(g2.x), lo_bf(g2.y), hi_bf(g2.y)};
            const f32x4 o = (acc[n] * rstd * lw + lb + vv[n] * rk) * gg;
            u32x2 w; w.x = pk2(o.x, o.y); w.y = pk2(o.z, o.w);
            *(u32x2*)(p.O + t * D + 256 + hd * 64 + c) = w;
        }
    }
}

__device__ __forceinline__ unsigned ordkey(float f) { const unsigned u = __float_as_uint(f); return (u & 0x80000000u) ? ~u : (u | 0x80000000u); }
__device__ __forceinline__ float unordkey(unsigned k) { return __uint_as_float((k & 0x80000000u) ? (k & 0x7FFFFFFFu) : ~k); }
__device__ __forceinline__ void ins16(unsigned (&L)[16], unsigned x) {
#pragma unroll
    for (int i = 0; i < 16; ++i) { const unsigned hi = L[i] > x ? L[i] : x; x = L[i] > x ? x : L[i]; L[i] = hi; }
}
__device__ __forceinline__ void top16_col(const float* col  , unsigned (&L)[16]) {
#pragma unroll
    for (int i = 0; i < 16; ++i) L[i] = 0u;
#pragma unroll 1
    for (int n0 = 0; n0 < 128; n0 += 16) {
        float x[16];
#pragma unroll
        for (int j = 0; j < 16; ++j) x[j] = col[(size_t)(n0 + j) * NT];
#pragma unroll
        for (int j = 0; j < 16; ++j) ins16(L, (ordkey(x[j]) & 0xFFFFFF80u) | (unsigned)(127 - (n0 + j)));
    }
}
__device__ void phase_topk(const float* SCT, int* EIDX, float* GATE, char* smem, int bid, int nblk) {
    const int tid = otid(), lane = tid & 63, wave = tid >> 6;
    unsigned char* itab = (unsigned char*)smem + tid * 32;
    unsigned char* ctab = (unsigned char*)smem + NTHREADS * 32;
    __syncthreads();
    if (tid < 64) {
        const int c = tid; int ci, cj;
        if (c < 16) { ci = 0; cj = c; } else if (c < 24) { ci = 1; cj = c - 16; } else if (c < 29) { ci = 2; cj = c - 24; } else if (c < 33) { ci = 3; cj = c - 29; }
        else if (c < 36) { ci = 4; cj = c - 33; } else if (c < 38) { ci = 5; cj = c - 36; } else if (c < 40) { ci = 6; cj = c - 38; } else if (c < 42) { ci = 7; cj = c - 40; }
        else if (c < 50) { ci = c - 34; cj = 0; } else { ci = 0; cj = 0; }
        ctab[c] = (unsigned char)(ci | (cj << 4));
    }
    __syncthreads();
    for (int x = bid * 4 + wave; x < (NT / 64) * 8; x += nblk * 4) {
        const int tb = x >> 3, hd = x & 7;
        const int t = tb * 64 + lane;
        unsigned L1[16], L2[16];
        top16_col(SCT + (size_t)(hd * 256) * NT + t, L1);
        top16_col(SCT + (size_t)(hd * 256 + 128) * NT + t, L2);
        float s1[16], s2[16];
#pragma unroll
        for (int i = 0; i < 16; ++i) {
            s1[i] = unordkey(L1[i] & 0xFFFFFF80u); s2[i] = unordkey(L2[i] & 0xFFFFFF80u);
            itab[i] = (unsigned char)(127u - (L1[i] & 127u)); itab[16 + i] = (unsigned char)(127u - (L2[i] & 127u));
        }
        unsigned M[16];
#pragma unroll
        for (int i = 0; i < 16; ++i) M[i] = 0u;
        int c = 0;
#pragma unroll
        for (int ci = 0; ci < 16; ++ci) {
#pragma unroll
            for (int cj = 0; cj < 16; ++cj) {
                if ((ci + 1) * (cj + 1) <= 16) {
                    const int cid = (ci == 0) ? cj : (ci == 1) ? 16 + cj : (ci == 2) ? 24 + cj : (ci == 3) ? 29 + cj : (ci == 4) ? 33 + cj : (ci == 5) ? 36 + cj : (ci == 6) ? 38 + cj : (ci == 7) ? 40 + cj : 34 + ci;
                    ins16(M, (ordkey(s1[ci] + s2[cj]) & 0xFFFFFFC0u) | (unsigned)(63 - cid));
                    ++c;
                }
            }
        }
        float ev[16]; int ee[16];
        const float mx = unordkey(M[0] & 0xFFFFFFC0u);
        float sum = 0.f;
#pragma unroll
        for (int i = 0; i < 16; ++i) {
            const int cid = 63 - (int)(M[i] & 63u);
            const unsigned cc = ctab[cid];
            ee[i] = (int)itab[cc & 15u] * 128 + (int)itab[16 + (cc >> 4)];
            ev[i] = __expf(unordkey(M[i] & 0xFFFFFFC0u) - mx);
            sum += ev[i];
        }
        const float inv = 1.f / sum;
        int* eo = EIDX + (size_t)t * 128 + hd * 16; float* go = GATE + (size_t)t * 128 + hd * 16;
#pragma unroll
        for (int i = 0; i < 4; ++i) {
            *(int4*)(eo + 4 * i) = make_int4(ee[4 * i], ee[4 * i + 1], ee[4 * i + 2], ee[4 * i + 3]);
            *(f32x4*)(go + 4 * i) = (f32x4){ev[4 * i] * inv, ev[4 * i + 1] * inv, ev[4 * i + 2] * inv, ev[4 * i + 3] * inv};
        }
    }
    __syncthreads();
}

typedef float f32x2 __attribute__((ext_vector_type(2)));
__device__ __forceinline__ void dec16(const u32x4 w, float (&f)[16]) {
    const unsigned ww[4] = {w.x, w.y, w.z, w.w};
#pragma unroll
    for (int i = 0; i < 4; ++i) {
        const f32x2 a = __builtin_amdgcn_cvt_pk_f32_fp8((int)ww[i], false), b = __builtin_amdgcn_cvt_pk_f32_fp8((int)ww[i], true);
        f[4 * i] = a.x; f[4 * i + 1] = a.y; f[4 * i + 2] = b.x; f[4 * i + 3] = b.y;
    }
}
__device__ void phase_expert(const bf16_t* H, const unsigned char* U8, const unsigned char* V8, const int* EIDX, const float* GATE, const float* X, float* Xo, int bid, int nblk) {
    const int lane = otid() & 63, wave = otid() >> 6;
    for (int t = bid * 4 + wave; t < NT; t += nblk * 4) {
        float xf[16], acc[16];
        {
            const u32x4 a = *(const u32x4*)(H + (size_t)t * D + lane * 16), b = *(const u32x4*)(H + (size_t)t * D + lane * 16 + 8);
            xf[0] = lo_bf(a.x); xf[1] = hi_bf(a.x); xf[2] = lo_bf(a.y); xf[3] = hi_bf(a.y); xf[4] = lo_bf(a.z); xf[5] = hi_bf(a.z); xf[6] = lo_bf(a.w); xf[7] = hi_bf(a.w);
            xf[8] = lo_bf(b.x); xf[9] = hi_bf(b.x); xf[10] = lo_bf(b.y); xf[11] = hi_bf(b.y); xf[12] = lo_bf(b.z); xf[13] = hi_bf(b.z); xf[14] = lo_bf(b.w); xf[15] = hi_bf(b.w);
        }
#pragma unroll
        for (int i = 0; i < 16; ++i) acc[i] = 0.f;
        for (int e0 = 0; e0 < 128; e0 += 8) {
            int ei[8]; float act[8]; u32x4 ur[8];
#pragma unroll
            for (int j = 0; j < 8; ++j) { ei[j] = EIDX[(size_t)t * 128 + e0 + j]; ur[j] = *(const u32x4*)(U8 + (size_t)ei[j] * D + lane * 16); }
#pragma unroll
            for (int j = 0; j < 8; ++j) {
                float uf[16]; dec16(ur[j], uf);
                float d = 0.f;
#pragma unroll
                for (int i = 0; i < 16; ++i) d += xf[i] * uf[i];
                d = wave_sum(d) * (1.f / 512.f);
                act[j] = 0.5f * d * (1.f + erff(d * 0.7071067811865476f)) * GATE[(size_t)t * 128 + e0 + j] * (1.f / 64.f);
            }
#pragma unroll
            for (int j = 0; j < 8; ++j) ur[j] = *(const u32x4*)(V8 + (size_t)ei[j] * D + lane * 16);
#pragma unroll
            for (int j = 0; j < 8; ++j) {
                float vf[16]; dec16(ur[j], vf);
#pragma unroll
                for (int i = 0; i < 16; ++i) acc[i] += act[j] * vf[i];
            }
        }
        const f32x4* xr = (const f32x4*)(X + (size_t)t * D) + lane * 4;
        f32x4* xo = (f32x4*)(Xo + (size_t)t * D) + lane * 4;
#pragma unroll
        for (int i = 0; i < 4; ++i) { f32x4 o = xr[i]; o += (f32x4){acc[4 * i], acc[4 * i + 1], acc[4 * i + 2], acc[4 * i + 3]}; xo[i] = o; }
    }
}

#define XB_TMO      128
#define XB_XCNT(j)  (256  + 64 * (j))
#define XB_XSUB(j)  (1280 + 64 * (j))
#define XB_XGEN(j)  (2304 + 64 * (j))
#define XB_TOP      3328
#define XB_TOPGEN   3392
#define XCD_BAR_WORDS 3456
#define XB_SPIN_CAP (1u << 22)
#define LAS __attribute__((address_space(3)))
__device__ __forceinline__ unsigned xb_ld(unsigned* p)              { return __hip_atomic_load(p, __ATOMIC_RELAXED, __HIP_MEMORY_SCOPE_AGENT); }
__device__ __forceinline__ unsigned xb_add(unsigned* p, unsigned v) { return __hip_atomic_fetch_add(p, v, __ATOMIC_RELAXED, __HIP_MEMORY_SCOPE_AGENT); }
__device__ __forceinline__ unsigned xb_xcc_id() { return (unsigned)__builtin_amdgcn_s_getreg((3 << 11) | 20) & 0xFu; }
#define XB_SPIN(cond, bar) do { unsigned _sp = 0; while (cond) { __builtin_amdgcn_s_sleep(1); \
    if ((++_sp & 255u) == 0u) { if (xb_ld(&(bar)[XB_TMO])) break; if (_sp > XB_SPIN_CAP) { atomicAdd(&(bar)[XB_TMO], 1u); break; } } } } while (0)
struct XcdBarrier { unsigned* bar; unsigned x; volatile LAS unsigned* st; };
__device__ __forceinline__ XcdBarrier xcd_barrier_post(unsigned* bar, volatile LAS unsigned* st) {
    XcdBarrier b; b.bar = bar; b.x = xb_xcc_id(); b.st = st;
    if (threadIdx.x == 0) (void)xb_add(&bar[XB_XCNT(b.x)], 1u);
    return b;
}
__device__ __forceinline__ void xcd_barrier_complete(unsigned* bar, unsigned x, unsigned& nloc, unsigned& nx) {
    const unsigned G = gridDim.x * gridDim.y * gridDim.z;
    unsigned sum, cnt, mine, sp = 0u;
    for (;;) {
        sum = 0u; cnt = 0u; mine = 0u;
#pragma unroll
        for (unsigned j = 0; j < 16; ++j) { const unsigned c = xb_ld(&bar[XB_XCNT(j)]); sum += c; cnt += (c > 0u) ? 1u : 0u; mine = (j == x) ? c : mine; }
        if (sum == G) break;
        __builtin_amdgcn_s_sleep(1);
        if ((++sp & 255u) == 0u) { if (xb_ld(&bar[XB_TMO])) break; if (sp > XB_SPIN_CAP) { atomicAdd(&bar[XB_TMO], 1u); break; } }
    }
    nloc = mine > 0u ? mine : 1u; nx = cnt > 0u ? cnt : 1u;
}
__device__ __forceinline__ void xcd_barrier(const XcdBarrier& b) {
    asm volatile("s_waitcnt vmcnt(0)" ::: "memory");
    __syncthreads();
    if (threadIdx.x == 0) {
        unsigned* bar = b.bar;
        __builtin_amdgcn_s_waitcnt(0);
        unsigned nloc = b.st[0], nx = b.st[1];
        if (nloc == 0u) { xcd_barrier_complete(bar, b.x, nloc, nx); b.st[0] = nloc; b.st[1] = nx; }
        const unsigned old = xb_add(&bar[XB_XSUB(b.x)], 1u);
        const unsigned gen = old / nloc;
        if (old + 1u == (gen + 1u) * nloc) {
            __builtin_amdgcn_fence(__ATOMIC_RELEASE, "agent");
            asm volatile("s_waitcnt vmcnt(0)" ::: "memory");
            const unsigned og = xb_add(&bar[XB_TOP], 1u);
            const unsigned tg = og / nx;
            if (og + 1u == (tg + 1u) * nx) xb_add(&bar[XB_TOPGEN], 1u);
            else XB_SPIN(xb_ld(&bar[XB_TOPGEN]) == tg, bar);
            __builtin_amdgcn_fence(__ATOMIC_ACQUIRE, "agent");
            xb_add(&bar[XB_XGEN(b.x)], 1u);
            asm volatile("s_waitcnt vmcnt(0)" ::: "memory");
        } else {
            XB_SPIN(xb_ld(&bar[XB_XGEN(b.x)]) == gen, bar);
            __builtin_amdgcn_fence(__ATOMIC_ACQUIRE, "agent");
            asm volatile("s_waitcnt vmcnt(0)" ::: "memory");
        }
    }
    __syncthreads();
}

struct Params {
    const float* in[24];
    float* out; unsigned char* ws;
};
constexpr int LDS_BYTES = 65536;

__device__ __forceinline__ RwP make_rwp(const Params& P, int l) {
    RwP r;
    r.Z = (const bf16_t*)(P.ws + WS_Z); r.mix = P.ws + WS_MIX;
    r.mu = P.in[6] + l * RW_F; r.w_up = P.in[7] + (size_t)l * 64 * 384; r.w_bias = P.in[8] + l * 384; r.a_up = P.in[9] + (size_t)l * 64 * 384; r.a_bias = P.in[10] + l * 384;
    r.g_up = P.in[11] + (size_t)l * 128 * 384; r.k_k = P.in[12] + l * 384; r.k_a = P.in[13] + l * 384; r.r_k = P.in[14] + l * 384; r.ln_w = P.in[15] + l * 384; r.ln_b = P.in[16] + l * 384;
    r.oraw = (float*)(P.ws + WS_H); r.O = (bf16_t*)(P.ws + WS_O); r.Y = (bf16_t*)(P.ws + WS_EIDX);
    return r;
}

__global__ void __launch_bounds__(NTHREADS, 2) mega_fwd(Params P) {
    __shared__ __attribute__((aligned(16))) char smem[LDS_BYTES];
    const int bid = blockIdx.x, nblk = gridDim.x;
    volatile LAS unsigned* st = (volatile LAS unsigned*)(smem + LDS_BYTES - 16);
    if (threadIdx.x == 0) { st[0] = 0u; st[1] = 0u; st[2] = 0u; st[3] = 0u; }
    __syncthreads();
    XcdBarrier bar = xcd_barrier_post((unsigned*)(P.ws + WS_CTL), st);
#define GSYNC() xcd_barrier(bar)

    {
        ConvP c{P.in[4], P.in[5], P.in[20], P.in[21], P.in[22], P.in[23], P.ws};
        for (int rep = 0; rep < REP_CONV; ++rep) phase_convert_weights(c, smem, bid, nblk);
        phase_rmsnorm<false>(P.in[0], P.in[1], P.ws + WS_H, bid, nblk);
    }
    GSYNC();
#pragma unroll 1
    for (int l = 0; l < 2; ++l) {
        const float* xin = (l == 0) ? P.in[0] : P.out;
        {
            GemmP g{(const bf16_t*)(P.ws + WS_H), D, 0, (const bf16_t*)(P.ws + WS_WTIN) + (size_t)l * DINP * D, D, D, NT / 128, DINP / 128, P.ws + WS_Z, DINP, nullptr};
            for (int rep = 0; rep < REP_GIN; ++rep) phase_gemm<0>(g, smem, bid, nblk);
        }
        GSYNC();
        RwP rw = make_rwp(P, l);
        LinP lp{(const bf16_t*)(P.ws + WS_Z), (bf16_t*)(P.ws + WS_O), P.in[17] + (size_t)l * 16 * 192, P.in[18] + l * 192, P.in[19] + l * 384, (const float*)(P.ws + WS_ROPE), P.ws + WS_LIN};
        for (int rep = 0; rep < REP_PREP; ++rep) phase_rwkv_prep(rw, smem, bid, nblk);
        for (int rep = 0; rep < REP_LIN; ++rep) for (int task = bid; task < 2048; task += nblk) lin_kv_dispatch(lp, smem, task);
        GSYNC();
        {
            for (int rep = 0; rep < REP_SCAN; ++rep)
            for (int task = bid; task < 480; task += nblk) {
                const int bh = task / 20, r = task % 20;
                const int seg = r < 4 ? 0 : (r < 12 ? 1 : 2), grp = r < 4 ? r : (r < 12 ? r - 4 : r - 12);
                rwkv_scan_task(rw, smem, bh, seg, grp);
            }
            if (nblk >= 512) { if (bid >= 480) for (int rep = 0; rep < REP_LIN; ++rep) lin_scan_phase(lp, bid - 480, nblk - 480); }
            else { for (int rep = 0; rep < REP_LIN; ++rep) lin_scan_phase(lp, bid, nblk); }
        }
        GSYNC();
        phase_rwkv_chain(rw, bid, nblk);
        GSYNC();
        for (int rep = 0; rep < REP_POST; ++rep) phase_rwkv_post(rw, bid, nblk);
        for (int rep = 0; rep < REP_LIN; ++rep) for (int task = bid; task < 2048; task += nblk) lin_out_dispatch(lp, smem, task);
        GSYNC();
        {
            GemmP g{(const bf16_t*)(P.ws + WS_O), D, 0, (const bf16_t*)(P.ws + WS_WTOUT) + (size_t)l * D * D, D, D, NT / 128, D / 128, P.out, D, xin};
            phase_gemm<2>(g, smem, bid, nblk);
            for (int rep = 1; rep < REP_GOUT; ++rep) { GemmP g2 = g; g2.C = P.ws + WS_MIX; phase_gemm<2>(g2, smem, bid, nblk); }
        }
        GSYNC();
        for (int rep = 0; rep < REP_NORM; ++rep) phase_rmsnorm<false>(P.out, P.in[2] + l * D, P.ws + WS_H, bid, nblk);
        GSYNC();
        {
            GemmP g{(const bf16_t*)(P.ws + WS_H), D, 0, (const bf16_t*)(P.ws + WS_WTQ) + (size_t)l * 2048 * D, D, D, NT / 128, 2048 / 128, P.ws + WS_Z, 2048, nullptr};
            for (int rep = 0; rep < REP_GQ; ++rep) phase_gemm<0>(g, smem, bid, nblk);
        }
        GSYNC();
        {
            GemmP g{(const bf16_t*)(P.ws + WS_Z), 2048, 128, (const bf16_t*)(P.ws + WS_SK) + (size_t)l * 16 * 128 * 128, 128, 128, NT / 128, 16, P.ws + WS_MIX, NT, nullptr};
            for (int rep = 0; rep < REP_GSK; ++rep) phase_gemm<3>(g, smem, bid, nblk);
        }
        GSYNC();
        for (int rep = 0; rep < REP_TOPK; ++rep) phase_topk((const float*)(P.ws + WS_MIX), (int*)(P.ws + WS_EIDX), (float*)(P.ws + WS_GATE), smem, bid, nblk);
        GSYNC();
        phase_expert((const bf16_t*)(P.ws + WS_H), P.ws + WS_UB + (size_t)l * NEXP * D, P.ws + WS_VB + (size_t)l * NEXP * D,
                     (const int*)(P.ws + WS_EIDX), (const float*)(P.ws + WS_GATE), P.out, P.out, bid, nblk);
        for (int rep = 1; rep < REP_EXP; ++rep) phase_expert((const bf16_t*)(P.ws + WS_H), P.ws + WS_UB + (size_t)l * NEXP * D, P.ws + WS_VB + (size_t)l * NEXP * D,
                     (const int*)(P.ws + WS_EIDX), (const float*)(P.ws + WS_GATE), P.out, (float*)(P.ws + WS_Z), bid, nblk);
        GSYNC();
        if (l == 0) { phase_rmsnorm<false>(P.out, P.in[1] + D, P.ws + WS_H, bid, nblk); GSYNC(); }
    }
    phase_rmsnorm<true>(P.out, P.in[3], P.out, bid, nblk);
}

extern "C" void kernel_launch(void* const* d_in, const int* in_sizes, int n_in, void* d_out, int out_size, void* d_ws, size_t ws_size, hipStream_t stream) {
    static int grid = 0;
    if (grid == 0) {
        if (n_in != 24 || ws_size < WS_END) { fprintf(stderr, "kernel_launch: bad args n_in=%d ws=%zu need=%zu\n", n_in, ws_size, (size_t)WS_END); grid = -1; return; }
        int dev = 0, cus = 0, per_cu = 0;
        hipGetDevice(&dev);
        hipDeviceGetAttribute(&cus, hipDeviceAttributeMultiprocessorCount, dev);
        hipOccupancyMaxActiveBlocksPerMultiprocessor(&per_cu, (const void*)mega_fwd, NTHREADS, 0);
        if (per_cu < 1) { fprintf(stderr, "kernel_launch: occupancy query says %d\n", per_cu); grid = -1; return; }
        if (per_cu > 2) per_cu = 2;
        grid = cus * per_cu;
        fprintf(stderr, "kernel_launch: grid %d (%d CUs x %d)\n", grid, cus, per_cu);
    }
    if (grid < 0) return;
    hipMemsetAsync((char*)d_ws + WS_CTL, 0, XCD_BAR_WORDS * 4, stream);
    Params P{};
    for (int i = 0; i < 24; ++i) P.in[i] = (const float*)d_in[i];
    P.out = (float*)d_out; P.ws = (unsigned char*)d_ws;
    void* args[] = {&P};
    hipError_t e = hipLaunchCooperativeKernel((const void*)mega_fwd, dim3(grid), dim3(NTHREADS), args, 0, stream);
    if (e != hipSuccess) fprintf(stderr, "cooperative launch failed: %s (grid %d)\n", hipGetErrorString(e), grid);
}
```

```cpp
#include <hip/hip_runtime.h>
#include <stdint.h>
#include <stdio.h>

typedef unsigned short bf16_t;
typedef short bf16x8 __attribute__((ext_vector_type(8)));
typedef float f32x4 __attribute__((ext_vector_type(4)));
typedef unsigned u32x4 __attribute__((ext_vector_type(4)));
typedef unsigned u32x2 __attribute__((ext_vector_type(2)));

#define REP_CONV 1
#define REP_GIN 1
#define REP_PREP 1
#define REP_SCAN 1
#define REP_LIN 1
#define REP_POST 1
#define REP_GOUT 1
#define REP_NORM 1
#define REP_GQ 1
#define REP_GSK 1
#define REP_TOPK 1
#define REP_EXP 1
constexpr int NB = 4, NS = 4096, NT = NB * NS, D = 1024, DIN = 3600, DINP = 3712;
constexpr int ZC_RET = 0, ZC_RW = 1024, ZC_GLA = 2432;
constexpr int RW_F = 1408;
constexpr int NEXP = 16384;
constexpr int NTHREADS = 256;

constexpr size_t MiB = 1024ull * 1024ull;
constexpr size_t WS_CTL   = 0;
constexpr size_t WS_LORA  = 65536;
constexpr size_t LORA_L   = 384ull * 256 * 2;
constexpr size_t WS_WTIN  = 1 * MiB;
constexpr size_t WS_WTOUT = WS_WTIN + 2ull * DINP * D * 2;
constexpr size_t WS_WTQ   = WS_WTOUT + 2ull * D * D * 2;
constexpr size_t WS_SK    = WS_WTQ + 2ull * 2048 * D * 2;
constexpr size_t WS_UB    = WS_SK + 2ull * 16 * 128 * 128 * 2;
constexpr size_t WS_VB    = WS_UB + 2ull * NEXP * D;
constexpr size_t WS_LIN   = WS_VB + 2ull * NEXP * D;
constexpr size_t WS_H     = WS_LIN + 64 * MiB;
constexpr size_t WS_Z     = WS_H + (size_t)NT * D * 2;
constexpr size_t WS_O     = WS_Z + (size_t)NT * DINP * 2;
constexpr size_t WS_MIX   = WS_O + (size_t)NT * D * 2;
constexpr size_t WS_EIDX  = WS_MIX + 128 * MiB;
constexpr size_t WS_GATE  = WS_EIDX + (size_t)NT * 128 * 4;
constexpr size_t WS_ROPE  = WS_GATE + (size_t)NT * 128 * 4;
constexpr size_t WS_END   = WS_ROPE + 1 * MiB;
constexpr size_t RWA = (size_t)NT * 384;
constexpr size_t MX_W   = 0;
constexpr size_t MX_KK  = MX_W + RWA * 4;
constexpr size_t MX_KKA = MX_KK + RWA * 4;
constexpr size_t MX_R   = MX_KKA + RWA * 4;
constexpr size_t MX_K   = MX_R + RWA * 2;
constexpr size_t MX_V   = MX_K + RWA * 2;
constexpr size_t MX_G   = MX_V + RWA * 2;
constexpr size_t MX_END = MX_G + RWA * 2;
static_assert(MX_END <= 128 * MiB, "mix region");

__device__ __forceinline__ float bf2f(bf16_t v) { return __uint_as_float(((unsigned)v) << 16); }
__device__ __forceinline__ bf16_t f2bf(float f) { unsigned u = __float_as_uint(f); u += 0x7FFFu + ((u >> 16) & 1u); return (bf16_t)(u >> 16); }
__device__ __forceinline__ unsigned pk2(float lo, float hi) { return (unsigned)f2bf(lo) | ((unsigned)f2bf(hi) << 16); }
__device__ __forceinline__ float lo_bf(unsigned u) { return __uint_as_float(u << 16); }
__device__ __forceinline__ float hi_bf(unsigned u) { return __uint_as_float(u & 0xFFFF0000u); }
template <int CTRL> __device__ __forceinline__ float dpp_f(float v) { return __int_as_float(__builtin_amdgcn_update_dpp(0, __float_as_int(v), CTRL, 0xF, 0xF, true)); }
template <int CTRL> __device__ __forceinline__ unsigned dpp_u(unsigned v) { return (unsigned)__builtin_amdgcn_update_dpp(0, (int)v, CTRL, 0xF, 0xF, true); }
__device__ __forceinline__ float row16_sum(float v) { v += dpp_f<0x128>(v); v += dpp_f<0x124>(v); v += dpp_f<0x122>(v); v += dpp_f<0x121>(v); return v; }
__device__ __forceinline__ float xor16_sum(float v) { auto r = __builtin_amdgcn_permlane16_swap(__float_as_uint(v), __float_as_uint(v), false, false); return __uint_as_float(r[0]) + __uint_as_float(r[1]); }
__device__ __forceinline__ float xor32_sum(float v) { auto r = __builtin_amdgcn_permlane32_swap(__float_as_uint(v), __float_as_uint(v), false, false); return __uint_as_float(r[0]) + __uint_as_float(r[1]); }
__device__ __forceinline__ float wave_sum(float v) { return xor32_sum(xor16_sum(row16_sum(v))); }
__device__ __forceinline__ unsigned umax_(unsigned a, unsigned b) { return a > b ? a : b; }
__device__ __forceinline__ unsigned wave_max_u32(unsigned v) {
    v = umax_(v, dpp_u<0x128>(v)); v = umax_(v, dpp_u<0x124>(v)); v = umax_(v, dpp_u<0x122>(v)); v = umax_(v, dpp_u<0x121>(v));
    { auto r = __builtin_amdgcn_permlane16_swap(v, v, false, false); v = umax_(r[0], r[1]); }
    { auto r = __builtin_amdgcn_permlane32_swap(v, v, false, false); v = umax_(r[0], r[1]); }
    return v;
}
__device__ __forceinline__ float sigmoidf_(float x) { return 1.f / (1.f + __expf(-x)); }
__device__ __forceinline__ float softplusf_(float x) { return fmaxf(x, 0.f) + log1pf(__expf(-fabsf(x))); }

__device__ __forceinline__ int otid() { int t = threadIdx.x; asm volatile("" : "+v"(t)); return t; }

__device__ void transpose_tile(const float* __restrict__ W, int K, int N, bf16_t* __restrict__ Wt, int kt, int nt, float* tile  ) {
    const int tid = otid();
    const int k0 = kt * 64, n0 = nt * 64;
#pragma unroll
    for (int i = 0; i < 16; ++i) {
        const int k = i * 4 + (tid >> 6), n = tid & 63;
        tile[k * 65 + n] = (n0 + n < N) ? W[(size_t)(k0 + k) * N + n0 + n] : 0.f;
    }
    __syncthreads();
#pragma unroll
    for (int i = 0; i < 16; ++i) {
        const int n = i * 4 + (tid >> 6), k = tid & 63;
        Wt[(size_t)(n0 + n) * K + k0 + k] = f2bf(tile[k * 65 + n]);
    }
    __syncthreads();
}

struct ConvP {
    const float* w_in; const float* w_out; const float* w_q; const float* sk; const float* u; const float* v;
    const float* w_up; const float* a_up; const float* g_up;
    unsigned char* ws;
};

__device__ void phase_convert_weights(const ConvP& p, char* smem, int bid, int nblk) {
    float* tile = (float*)smem;
    constexpr int T_IN = 16 * 58, T_OUT = 16 * 16, T_Q = 16 * 32, T_L = T_IN + T_OUT + T_Q;
    for (int it = bid; it < 2 * T_L; it += nblk) {
        const int l = it / T_L; int r = it % T_L;
        if (r < T_IN) { transpose_tile(p.w_in + (size_t)l * D * DIN, D, DIN, (bf16_t*)(p.ws + WS_WTIN) + (size_t)l * DINP * D, r / 58, r % 58, tile); continue; }
        r -= T_IN;
        if (r < T_OUT) { transpose_tile(p.w_out + (size_t)l * D * D, D, D, (bf16_t*)(p.ws + WS_WTOUT) + (size_t)l * D * D, r / 16, r % 16, tile); continue; }
        r -= T_OUT;
        transpose_tile(p.w_q + (size_t)l * D * 2048, D, 2048, (bf16_t*)(p.ws + WS_WTQ) + (size_t)l * 2048 * D, r / 32, r % 32, tile);
    }
    const size_t gtid = (size_t)bid * NTHREADS + otid(), gn = (size_t)nblk * NTHREADS;
    {
        for (size_t i = gtid; i < 2ull * 384 * 256; i += gn) {
            const int l = (int)(i / (384 * 256)), r = (int)(i % (384 * 256)), c = r >> 8, k = r & 255;
            bf16_t* base = (bf16_t*)(p.ws + WS_LORA + l * LORA_L);
            if (k < 64) base[c * 64 + k] = f2bf(p.w_up[(size_t)l * 64 * 384 + k * 384 + c]);
            else if (k < 128) base[384 * 64 + c * 64 + (k - 64)] = f2bf(p.a_up[(size_t)l * 64 * 384 + (k - 64) * 384 + c]);
            else base[2 * 384 * 64 + c * 128 + (k - 128)] = f2bf(p.g_up[(size_t)l * 128 * 384 + (k - 128) * 384 + c]);
        }
    }
    {
        float* ct = (float*)(p.ws + WS_ROPE); float* stb = ct + NS * 32;
        for (size_t i = gtid; i < (size_t)NS * 32; i += gn) {
            const int pos = (int)(i >> 5), fi = (int)(i & 31);
            const float inv = exp2f(-(float)fi * (13.287712379549449f / 32.f));
            float sn, cs; sincosf((float)pos * inv, &sn, &cs);
            ct[i] = cs; stb[i] = sn;
        }
    }
    {
        const size_t n8 = (2ull * 16 * 128 * 128) / 8;
        const f32x4* s = (const f32x4*)p.sk; u32x4* d = (u32x4*)(p.ws + WS_SK);
        for (size_t i = gtid; i < n8; i += gn) { f32x4 a = s[2 * i], b = s[2 * i + 1]; u32x4 o; o.x = pk2(a.x, a.y); o.y = pk2(a.z, a.w); o.z = pk2(b.x, b.y); o.w = pk2(b.z, b.w); d[i] = o; }
    }
    {
        const size_t n16 = (2ull * NEXP * D) / 16;
        const f32x4* su = (const f32x4*)p.u; u32x4* du = (u32x4*)(p.ws + WS_UB);
        const f32x4* sv = (const f32x4*)p.v; u32x4* dv = (u32x4*)(p.ws + WS_VB);
        for (size_t i = gtid; i < n16; i += gn) {
            f32x4 a = su[4 * i] * 512.f, b = su[4 * i + 1] * 512.f, c = su[4 * i + 2] * 512.f, d = su[4 * i + 3] * 512.f;
            u32x4 o;
            o.x = (unsigned)__builtin_amdgcn_cvt_pk_fp8_f32(a.z, a.w, __builtin_amdgcn_cvt_pk_fp8_f32(a.x, a.y, 0, false), true);
            o.y = (unsigned)__builtin_amdgcn_cvt_pk_fp8_f32(b.z, b.w, __builtin_amdgcn_cvt_pk_fp8_f32(b.x, b.y, 0, false), true);
            o.z = (unsigned)__builtin_amdgcn_cvt_pk_fp8_f32(c.z, c.w, __builtin_amdgcn_cvt_pk_fp8_f32(c.x, c.y, 0, false), true);
            o.w = (unsigned)__builtin_amdgcn_cvt_pk_fp8_f32(d.z, d.w, __builtin_amdgcn_cvt_pk_fp8_f32(d.x, d.y, 0, false), true);
            du[i] = o;
            a = sv[4 * i] * 64.f; b = sv[4 * i + 1] * 64.f; c = sv[4 * i + 2] * 64.f; d = sv[4 * i + 3] * 64.f;
            o.x = (unsigned)__builtin_amdgcn_cvt_pk_fp8_f32(a.z, a.w, __builtin_amdgcn_cvt_pk_fp8_f32(a.x, a.y, 0, false), true);
            o.y = (unsigned)__builtin_amdgcn_cvt_pk_fp8_f32(b.z, b.w, __builtin_amdgcn_cvt_pk_fp8_f32(b.x, b.y, 0, false), true);
            o.z = (unsigned)__builtin_amdgcn_cvt_pk_fp8_f32(c.z, c.w, __builtin_amdgcn_cvt_pk_fp8_f32(c.x, c.y, 0, false), true);
            o.w = (unsigned)__builtin_amdgcn_cvt_pk_fp8_f32(d.z, d.w, __builtin_amdgcn_cvt_pk_fp8_f32(d.x, d.y, 0, false), true);
            dv[i] = o;
        }
    }
}

template <bool OUT_F32>
__device__ void phase_rmsnorm(const float* x, const float* __restrict__ g, void* out, int bid, int nblk) {
    const int lane = otid() & 63, wave = otid() >> 6;
    const int gw = bid * 4 + wave, ngw = nblk * 4;
    f32x4 gv[4];
#pragma unroll
    for (int j = 0; j < 4; ++j) gv[j] = ((const f32x4*)g)[lane + 64 * j];
    for (int row = gw; row < NT; row += ngw) {
        const f32x4* xr = (const f32x4*)(x + (size_t)row * D) + lane;
        f32x4 v[4]; float s = 0.f;
#pragma unroll
        for (int j = 0; j < 4; ++j) { v[j] = xr[64 * j]; s += v[j].x * v[j].x + v[j].y * v[j].y + v[j].z * v[j].z + v[j].w * v[j].w; }
        s = wave_sum(s);
        const float rs = rsqrtf(s * (1.f / D) + 1e-6f);
        if (OUT_F32) {
            f32x4* o = (f32x4*)((float*)out + (size_t)row * D) + lane;
#pragma unroll
            for (int j = 0; j < 4; ++j) o[64 * j] = v[j] * rs * gv[j];
        } else {
            u32x2* o = (u32x2*)((bf16_t*)out + (size_t)row * D) + lane;
#pragma unroll
            for (int j = 0; j < 4; ++j) { f32x4 y = v[j] * rs * gv[j]; u32x2 w; w.x = pk2(y.x, y.y); w.y = pk2(y.z, y.w); o[64 * j] = w; }
        }
    }
}

struct GemmP {
    const bf16_t* A; int lda; int a_koff;
    const bf16_t* Bt; int ldb; int K;
    int MT, NTl;
    void* C; int ldc; const float* R;
};
constexpr int GS = 72;
template <int MODE>
__device__ void phase_gemm(const GemmP& p, char* smem, int bid, int nblk) {
    bf16_t* As = (bf16_t*)smem;
    bf16_t* Bs = As + 128 * GS;
    const int tid = otid(), lane = tid & 63, wave = tid >> 6;
    const int wr = wave >> 1, wc = wave & 1;
    const int lr = tid >> 3, lc = (tid & 7) * 8;
    const int fl = lane & 15, fq = lane >> 4;
    const int ntiles = p.MT * p.NTl;
    for (int tile = bid; tile < ntiles; tile += nblk) {
        const int mt = tile / p.NTl, nt = tile % p.NTl;
        const bf16_t* Ag = p.A + (size_t)mt * 128 * p.lda + (size_t)nt * p.a_koff + (size_t)lr * p.lda + lc;
        const bf16_t* Bg = p.Bt + (size_t)nt * 128 * p.ldb + (size_t)lr * p.ldb + lc;
        f32x4 acc[4][4];
#pragma unroll
        for (int m = 0; m < 4; ++m)
#pragma unroll
            for (int n = 0; n < 4; ++n) acc[m][n] = (f32x4){0.f, 0.f, 0.f, 0.f};
        u32x4 ra[4], rb[4];
#pragma unroll
        for (int i = 0; i < 4; ++i) { ra[i] = *(const u32x4*)(Ag + (size_t)(32 * i) * p.lda); rb[i] = *(const u32x4*)(Bg + (size_t)(32 * i) * p.ldb); }
        for (int k0 = 0; k0 < p.K; k0 += 64) {
            __syncthreads();
#pragma unroll
            for (int i = 0; i < 4; ++i) { *(u32x4*)(As + (lr + 32 * i) * GS + lc) = ra[i]; *(u32x4*)(Bs + (lr + 32 * i) * GS + lc) = rb[i]; }
            __syncthreads();
            if (k0 + 64 < p.K) {
#pragma unroll
                for (int i = 0; i < 4; ++i) { ra[i] = *(const u32x4*)(Ag + (size_t)(32 * i) * p.lda + k0 + 64); rb[i] = *(const u32x4*)(Bg + (size_t)(32 * i) * p.ldb + k0 + 64); }
            }
#pragma unroll
            for (int ks = 0; ks < 2; ++ks) {
                bf16x8 xa[4], wb[4];
#pragma unroll
                for (int m = 0; m < 4; ++m) xa[m] = *(const bf16x8*)(As + (wr * 64 + m * 16 + fl) * GS + ks * 32 + fq * 8);
#pragma unroll
                for (int n = 0; n < 4; ++n) wb[n] = *(const bf16x8*)(Bs + (wc * 64 + n * 16 + fl) * GS + ks * 32 + fq * 8);
#pragma unroll
                for (int m = 0; m < 4; ++m)
#pragma unroll
                    for (int n = 0; n < 4; ++n) acc[m][n] = (MODE == 3) ? __builtin_amdgcn_mfma_f32_16x16x32_bf16(xa[m], wb[n], acc[m][n], 0, 0, 0)
                                                                     : __builtin_amdgcn_mfma_f32_16x16x32_bf16(wb[n], xa[m], acc[m][n], 0, 0, 0);
            }
        }
#pragma unroll
        for (int m = 0; m < 4; ++m) {
#pragma unroll
            for (int n = 0; n < 4; ++n) {
                const f32x4 a = acc[m][n];
                if (MODE == 3) {
                    const size_t row = (size_t)mt * 128 + wr * 64 + m * 16 + fq * 4;
                    const size_t col = (size_t)nt * 128 + wc * 64 + n * 16 + fl;
                    *(f32x4*)((float*)p.C + col * p.ldc + row) = a;
                } else {
                    const size_t row = (size_t)mt * 128 + wr * 64 + m * 16 + fl;
                    const int col = nt * 128 + wc * 64 + n * 16 + fq * 4;
                    if (MODE == 0) { u32x2 w; w.x = pk2(a.x, a.y); w.y = pk2(a.z, a.w); *(u32x2*)((bf16_t*)p.C + row * p.ldc + col) = w; }
                    else if (MODE == 1) { *(f32x4*)((float*)p.C + row * p.ldc + col) = a; }
                    else { const f32x4 r = *(const f32x4*)(p.R + row * p.ldc + col); *(f32x4*)((float*)p.C + row * p.ldc + col) = r + a; }
                }
            }
        }
    }
}

constexpr int LS = 72;
struct LinP {
    const bf16_t* Z; bf16_t* O;
    const float* gk_up;
    const float* gk_bias;
    const float* norm_w;
    const float* rope;
    unsigned char* lin;
};
__device__ __forceinline__ bf16x8 ldfrag(const bf16_t* base, int row, int kofs) { return *(const bf16x8*)(base + row * LS + kofs); }

constexpr size_t LN_KV_RET = 0;
constexpr size_t LN_KV_GLA = LN_KV_RET + 1024ull * 64 * 64 * 4;
constexpr size_t LN_S_RET  = LN_KV_GLA + 1024ull * 96 * 64 * 4;
constexpr size_t LN_S_GLA  = LN_S_RET + 1024ull * 64 * 64 * 2;
constexpr size_t LN_DEC    = LN_S_GLA + 1024ull * 96 * 64 * 2;
static_assert(LN_DEC + 2048ull * 64 * 4 <= 64 * MiB, "lin region");

__device__ __forceinline__ float wave_incl_scan(float v) {
    v += dpp_f<0x111>(v); v += dpp_f<0x112>(v); v += dpp_f<0x114>(v); v += dpp_f<0x118>(v);
    v += __int_as_float(__builtin_amdgcn_update_dpp(0, __float_as_int(v), 0x142, 0xA, 0xF, false));
    v += __int_as_float(__builtin_amdgcn_update_dpp(0, __float_as_int(v), 0x143, 0xC, 0xF, false));
    return v;
}
__device__ __forceinline__ float readlane_f(float v, int l) { return __int_as_float(__builtin_amdgcn_readlane(__float_as_int(v), l)); }

__device__ __forceinline__ void rot8(const bf16_t* src, const float* rope, int spos, int cq, unsigned (&o1)[4], unsigned (&o2)[4]) {
    const u32x4 q1 = *(const u32x4*)(src + cq * 8), q2 = *(const u32x4*)(src + 32 + cq * 8);
    const unsigned q1w[4] = {q1.x, q1.y, q1.z, q1.w}, q2w[4] = {q2.x, q2.y, q2.z, q2.w};
    const f32x4 c0 = *(const f32x4*)(rope + spos * 32 + cq * 8), c1 = *(const f32x4*)(rope + spos * 32 + cq * 8 + 4);
    const f32x4 s0 = *(const f32x4*)(rope + NS * 32 + spos * 32 + cq * 8), s1 = *(const f32x4*)(rope + NS * 32 + spos * 32 + cq * 8 + 4);
    const float csv[8] = {c0.x, c0.y, c0.z, c0.w, c1.x, c1.y, c1.z, c1.w}, snv[8] = {s0.x, s0.y, s0.z, s0.w, s1.x, s1.y, s1.z, s1.w};
#pragma unroll
    for (int e = 0; e < 4; ++e) {
        const float a1l = lo_bf(q1w[e]), a1h = hi_bf(q1w[e]), a2l = lo_bf(q2w[e]), a2h = hi_bf(q2w[e]);
        o1[e] = pk2(a1l * csv[2 * e] - a2l * snv[2 * e], a1h * csv[2 * e + 1] - a2h * snv[2 * e + 1]);
        o2[e] = pk2(a1l * snv[2 * e] + a2l * csv[2 * e], a1h * snv[2 * e + 1] + a2h * csv[2 * e + 1]);
    }
}
__device__ __forceinline__ void load_vts(const bf16_t* Z, size_t t0, int voff, int nch, bf16_t* Vts, int tid) {
    for (int x = tid; x < 64 * nch; x += NTHREADS) {
        const int tok = x / nch, ch = x % nch;
        const u32x4 vv = *(const u32x4*)(Z + (t0 + tok) * DINP + voff + ch * 8);
        const unsigned w[4] = {vv.x, vv.y, vv.z, vv.w};
#pragma unroll
        for (int e = 0; e < 4; ++e) { Vts[(ch * 8 + 2 * e) * LS + tok] = (bf16_t)(w[e] & 0xFFFFu); Vts[(ch * 8 + 2 * e + 1) * LS + tok] = (bf16_t)(w[e] >> 16); }
    }
}
__device__ __forceinline__ void load_gd(const bf16_t* zr, float (&gd)[16]) {
    const u32x4 g0 = *(const u32x4*)zr, g1 = *(const u32x4*)(zr + 8);
    gd[0] = lo_bf(g0.x); gd[1] = hi_bf(g0.x); gd[2] = lo_bf(g0.y); gd[3] = hi_bf(g0.y); gd[4] = lo_bf(g0.z); gd[5] = hi_bf(g0.z); gd[6] = lo_bf(g0.w); gd[7] = hi_bf(g0.w);
    gd[8] = lo_bf(g1.x); gd[9] = hi_bf(g1.x); gd[10] = lo_bf(g1.y); gd[11] = hi_bf(g1.y); gd[12] = lo_bf(g1.z); gd[13] = hi_bf(g1.z); gd[14] = lo_bf(g1.w); gd[15] = hi_bf(g1.w);
}
__device__ __forceinline__ float gla_gk(const LinP& p, const float (&gd)[16], int h, int d) {
    float x = p.gk_bias[h * 48 + d];
#pragma unroll
    for (int i = 0; i < 16; ++i) x += gd[i] * p.gk_up[i * 192 + h * 48 + d];
    return (fminf(x, 0.f) - log1pf(__expf(-fabsf(x)))) * (1.f / 16.f);
}
__device__ __forceinline__ float ret_lg(int h) { const float e = exp2f(-5.f - (float)h * (4.f / 3.f)); return log1pf(-e); }

template <bool IS_GLA>
__device__ void lin_kv_task(const LinP& p, char* smem, int b, int h, int c) {
    constexpr int DV = IS_GLA ? 96 : 64, NVB = DV / 16;
    const int koff = IS_GLA ? (ZC_GLA + 192 + h * 48) : (ZC_RET + 256 + h * 64);
    const int voff = IS_GLA ? (ZC_GLA + 384 + h * 96) : (ZC_RET + 512 + h * 64);
    const int gkdoff = ZC_GLA + 768;
    bf16_t* Ks = (bf16_t*)smem;
    bf16_t* Kts = Ks + 64 * LS;
    bf16_t* Vts = Kts + 64 * LS;
    float* decs = (float*)(Vts + 96 * LS);
    const int tid = otid(), lane = tid & 63, wave = tid >> 6;
    const int fl = lane & 15, fq = lane >> 4;
    const size_t t0 = (size_t)b * NS + (size_t)c * 64;
    const int task = (b * 4 + h) * 64 + c;
    __syncthreads();
    if (IS_GLA) {
        for (int x = tid; x < 64 * 6; x += NTHREADS) {
            const int tok = x / 6, ch = x % 6;
            *(u32x4*)(Ks + tok * LS + ch * 8) = *(const u32x4*)(p.Z + (t0 + tok) * DINP + koff + ch * 8);
        }
        for (int x = tid; x < 16 * LS / 2; x += NTHREADS) ((unsigned*)(Kts + 48 * LS))[x] = 0u;
        if (tid < 16) decs[48 + tid] = 1.f;
        load_vts(p.Z, t0, voff, 12, Vts, tid);
    } else {
        const int tok = tid >> 2, cq = tid & 3;
        unsigned k1[4], k2[4];
        rot8(p.Z + (t0 + tok) * DINP + koff, p.rope, c * 64 + tok, cq, k1, k2);
        const float fk2 = 0.125f * __expf(ret_lg(h) * (float)(63 - tok));
#pragma unroll
        for (int e = 0; e < 4; ++e) {
            Kts[(cq * 8 + 2 * e) * LS + tok] = f2bf(lo_bf(k1[e]) * fk2); Kts[(cq * 8 + 2 * e + 1) * LS + tok] = f2bf(hi_bf(k1[e]) * fk2);
            Kts[(32 + cq * 8 + 2 * e) * LS + tok] = f2bf(lo_bf(k2[e]) * fk2); Kts[(32 + cq * 8 + 2 * e + 1) * LS + tok] = f2bf(hi_bf(k2[e]) * fk2);
        }
        if (tid < 64) decs[tid] = __expf(ret_lg(h) * 64.f);
        load_vts(p.Z, t0, voff, 8, Vts, tid);
    }
    __syncthreads();
    if (IS_GLA) {
        float gd[16];
        load_gd(p.Z + (t0 + lane) * DINP + gkdoff, gd);
#pragma unroll 1
        for (int dd = 0; dd < 12; ++dd) {
            const int d = wave * 12 + dd;
            const float bc = wave_incl_scan(gla_gk(p, gd, h, d));
            const float bl = readlane_f(bc, 63);
            Kts[d * LS + lane] = f2bf(bf2f(Ks[lane * LS + d]) * __expf(bl - bc));
            if (lane == 0) decs[d] = __expf(bl);
        }
        __syncthreads();
    }
    float* KV = (float*)(p.lin + (IS_GLA ? LN_KV_GLA : LN_KV_RET)) + (size_t)task * DV * 64;
#pragma unroll
    for (int vb = 0; vb < NVB; ++vb) {
        f32x4 a4 = (f32x4){0.f, 0.f, 0.f, 0.f};
#pragma unroll
        for (int ks = 0; ks < 2; ++ks) {
            const bf16x8 a = ldfrag(Kts, 16 * wave + fl, ks * 32 + fq * 8);
            const bf16x8 bv = ldfrag(Vts, 16 * vb + fl, ks * 32 + fq * 8);
            a4 = __builtin_amdgcn_mfma_f32_16x16x32_bf16(a, bv, a4, 0, 0, 0);
        }
        *(f32x4*)(KV + (size_t)(16 * vb + fl) * 64 + 16 * wave + 4 * fq) = a4;
    }
    if (tid < 64) ((float*)(p.lin + LN_DEC))[(size_t)((IS_GLA ? 1024 : 0) + task) * 64 + tid] = decs[tid];
}

__device__ void lin_scan_phase(const LinP& p, int vbid, int nvblk) {
    const int tid = otid();
    for (int it = vbid; it < 160; it += nvblk) {
        const bool gla = it >= 64;
        const int r = gla ? it - 64 : it;
        const int per = gla ? 6 : 4, DVx = gla ? 96 : 64;
        const int bh = r / per, e = (r % per) * 1024 + tid;
        const float* KV = (const float*)(p.lin + (gla ? LN_KV_GLA : LN_KV_RET)) + (size_t)bh * 64 * DVx * 64 + e;
        bf16_t* Sb = (bf16_t*)(p.lin + (gla ? LN_S_GLA : LN_S_RET)) + (size_t)bh * 64 * DVx * 64 + e;
        const float* DEC = (const float*)(p.lin + LN_DEC) + (size_t)((gla ? 1024 : 0) + bh * 64) * 64 + (e & 63);
        float S0 = 0.f, S1 = 0.f, S2 = 0.f, S3 = 0.f;
#pragma unroll 8
        for (int c = 0; c < 64; ++c) {
            const size_t o = (size_t)c * DVx * 64;
            const float k0 = KV[o], k1 = KV[o + 256], k2 = KV[o + 512], k3 = KV[o + 768], dc = DEC[c * 64];
            Sb[o] = f2bf(S0); Sb[o + 256] = f2bf(S1); Sb[o + 512] = f2bf(S2); Sb[o + 768] = f2bf(S3);
            S0 = S0 * dc + k0; S1 = S1 * dc + k1; S2 = S2 * dc + k2; S3 = S3 * dc + k3;
        }
    }
}

template <bool IS_GLA>
__device__ void lin_out_task(const LinP& p, char* smem, int b, int h, int c) {
    constexpr int DV = IS_GLA ? 96 : 64, NVB = DV / 16;
    const int qoff = IS_GLA ? (ZC_GLA + 0 + h * 48) : (ZC_RET + 0 + h * 64);
    const int koff = IS_GLA ? (ZC_GLA + 192 + h * 48) : (ZC_RET + 256 + h * 64);
    const int voff = IS_GLA ? (ZC_GLA + 384 + h * 96) : (ZC_RET + 512 + h * 64);
    const int goff = IS_GLA ? (ZC_GLA + 784 + h * 96) : (ZC_RET + 768 + h * 64);
    const int gkdoff = ZC_GLA + 768;
    const int ooff = IS_GLA ? (640 + h * 96) : (h * 64);
    bf16_t* Qs = (bf16_t*)smem;
    bf16_t* Ks = Qs + 64 * LS;
    bf16_t* Ps = Ks + 64 * LS;
    bf16_t* Vts = Ps + 64 * LS;
    bf16_t* Sts = Vts + 96 * LS;
    const int tid = otid(), lane = tid & 63, wave = tid >> 6;
    const int fl = lane & 15, fq = lane >> 4;
    const size_t t0 = (size_t)b * NS + (size_t)c * 64;
    const int task = (b * 4 + h) * 64 + c;
    __syncthreads();
    {
        const bf16_t* Sb = (const bf16_t*)(p.lin + (IS_GLA ? LN_S_GLA : LN_S_RET)) + (size_t)task * DV * 64;
        for (int x = tid; x < DV * 8; x += NTHREADS) { const int v = x >> 3, ch = x & 7; *(u32x4*)(Sts + v * LS + ch * 8) = *(const u32x4*)(Sb + v * 64 + ch * 8); }
    }
    if (IS_GLA) {
        for (int x = tid; x < 64 * 6; x += NTHREADS) {
            const int tok = x / 6, ch = x % 6;
            const bf16_t* zr = p.Z + (t0 + tok) * DINP;
            *(u32x4*)(Qs + tok * LS + ch * 8) = *(const u32x4*)(zr + qoff + ch * 8);
            *(u32x4*)(Ks + tok * LS + ch * 8) = *(const u32x4*)(zr + koff + ch * 8);
        }
        for (int x = tid; x < 64 * 2; x += NTHREADS) {
            const int tok = x >> 1, ch = 6 + (x & 1);
            *(u32x4*)(Qs + tok * LS + ch * 8) = (u32x4){0u, 0u, 0u, 0u};
            *(u32x4*)(Ks + tok * LS + ch * 8) = (u32x4){0u, 0u, 0u, 0u};
        }
        load_vts(p.Z, t0, voff, 12, Vts, tid);
    } else {
        const int tok = tid >> 2, cq = tid & 3;
        const bf16_t* zr = p.Z + (t0 + tok) * DINP;
        unsigned q1[4], q2[4], k1[4], k2[4];
        rot8(zr + qoff, p.rope, c * 64 + tok, cq, q1, q2);
        rot8(zr + koff, p.rope, c * 64 + tok, cq, k1, k2);
        const float lg = ret_lg(h);
        const float fqd = __expf(lg * (float)(tok + 1)), fk = 0.125f * __expf(-lg * (float)(tok + 1));
#pragma unroll
        for (int e = 0; e < 4; ++e) {
            q1[e] = pk2(lo_bf(q1[e]) * fqd, hi_bf(q1[e]) * fqd); q2[e] = pk2(lo_bf(q2[e]) * fqd, hi_bf(q2[e]) * fqd);
            k1[e] = pk2(lo_bf(k1[e]) * fk, hi_bf(k1[e]) * fk); k2[e] = pk2(lo_bf(k2[e]) * fk, hi_bf(k2[e]) * fk);
        }
        *(u32x4*)(Qs + tok * LS + cq * 8) = (u32x4){q1[0], q1[1], q1[2], q1[3]};
        *(u32x4*)(Qs + tok * LS + 32 + cq * 8) = (u32x4){q2[0], q2[1], q2[2], q2[3]};
        *(u32x4*)(Ks + tok * LS + cq * 8) = (u32x4){k1[0], k1[1], k1[2], k1[3]};
        *(u32x4*)(Ks + tok * LS + 32 + cq * 8) = (u32x4){k2[0], k2[1], k2[2], k2[3]};
        load_vts(p.Z, t0, voff, 8, Vts, tid);
    }
    __syncthreads();
    if (IS_GLA) {
        float gd[16];
        load_gd(p.Z + (t0 + lane) * DINP + gkdoff, gd);
#pragma unroll 1
        for (int dd = 0; dd < 12; ++dd) {
            const int d = wave * 12 + dd;
            const float bc = wave_incl_scan(gla_gk(p, gd, h, d));
            const float eq = __expf(bc) * 0.14433756729740643f  , ek = __expf(-bc);
            Qs[lane * LS + d] = f2bf(bf2f(Qs[lane * LS + d]) * eq);
            Ks[lane * LS + d] = f2bf(bf2f(Ks[lane * LS + d]) * ek);
        }
        __syncthreads();
    }
#pragma unroll
    for (int jb = 0; jb < 4; ++jb) {
        f32x4 ap = (f32x4){0.f, 0.f, 0.f, 0.f};
#pragma unroll
        for (int ks = 0; ks < 2; ++ks) {
            const bf16x8 a = ldfrag(Ks, 16 * jb + fl, ks * 32 + fq * 8);
            const bf16x8 bq = ldfrag(Qs, 16 * wave + fl, ks * 32 + fq * 8);
            ap = __builtin_amdgcn_mfma_f32_16x16x32_bf16(a, bq, ap, 0, 0, 0);
        }
        const int i = 16 * wave + fl, j0 = 16 * jb + 4 * fq;
        u32x2 w;
        w.x = pk2(j0 + 0 <= i ? ap.x : 0.f, j0 + 1 <= i ? ap.y : 0.f);
        w.y = pk2(j0 + 2 <= i ? ap.z : 0.f, j0 + 3 <= i ? ap.w : 0.f);
        *(u32x2*)(Ps + i * LS + j0) = w;
    }
    __syncthreads();
    {
        f32x4 ao[NVB];
        float ss = 0.f;
#pragma unroll
        for (int vb = 0; vb < NVB; ++vb) {
            f32x4 a4 = (f32x4){0.f, 0.f, 0.f, 0.f};
#pragma unroll
            for (int ks = 0; ks < 2; ++ks) {
                const bf16x8 a = ldfrag(Vts, 16 * vb + fl, ks * 32 + fq * 8);
                const bf16x8 bp = ldfrag(Ps, 16 * wave + fl, ks * 32 + fq * 8);
                a4 = __builtin_amdgcn_mfma_f32_16x16x32_bf16(a, bp, a4, 0, 0, 0);
            }
#pragma unroll
            for (int ks = 0; ks < 2; ++ks) {
                const bf16x8 a = ldfrag(Sts, 16 * vb + fl, ks * 32 + fq * 8);
                const bf16x8 bq = ldfrag(Qs, 16 * wave + fl, ks * 32 + fq * 8);
                a4 = __builtin_amdgcn_mfma_f32_16x16x32_bf16(a, bq, a4, 0, 0, 0);
            }
            ao[vb] = a4;
            ss += a4.x * a4.x + a4.y * a4.y + a4.z * a4.z + a4.w * a4.w;
        }
        ss = xor32_sum(xor16_sum(ss));
        const float inv = rsqrtf(ss * (1.f / DV) + 1e-5f);
        const size_t t = t0 + 16 * wave + fl;
#pragma unroll
        for (int vb = 0; vb < NVB; ++vb) {
            const int v0 = 16 * vb + 4 * fq;
            const u32x2 gg = *(const u32x2*)(p.Z + t * DINP + goff + v0);
            float g4[4] = {lo_bf(gg.x), hi_bf(gg.x), lo_bf(gg.y), hi_bf(gg.y)};
            float o4[4] = {ao[vb].x, ao[vb].y, ao[vb].z, ao[vb].w};
#pragma unroll
            for (int e = 0; e < 4; ++e) {
                float y = o4[e] * inv;
                if (IS_GLA) y *= p.norm_w[h * 96 + v0 + e];
                const float g = g4[e];
                o4[e] = y * (g / (1.f + __expf(-g)));
            }
            u32x2 w; w.x = pk2(o4[0], o4[1]); w.y = pk2(o4[2], o4[3]);
            *(u32x2*)(p.O + t * D + ooff + v0) = w;
        }
    }
}
__device__ __forceinline__ void lin_kv_dispatch(const LinP& p, char* smem, int task) {
    const int r = task & 1023, bh = r >> 6, c = r & 63;
    if (task < 1024) lin_kv_task<false>(p, smem, bh >> 2, bh & 3, c); else lin_kv_task<true>(p, smem, bh >> 2, bh & 3, c);
}
__device__ __forceinline__ void lin_out_dispatch(const LinP& p, char* smem, int task) {
    const int r = task & 1023, bh = r >> 6, c = r & 63;
    if (task < 1024) lin_out_task<false>(p, smem, bh >> 2, bh & 3, c); else lin_out_task<true>(p, smem, bh >> 2, bh & 3, c);
}

struct RwP {
    const bf16_t* Z; unsigned char* mix;
    const float* mu; const float* w_up; const float* w_bias; const float* a_up; const float* a_bias; const float* g_up;
    const float* k_k; const float* k_a; const float* r_k; const float* ln_w; const float* ln_b;
    float* oraw; bf16_t* O; bf16_t* Y; const bf16_t* lora;
};
constexpr int PS = 264;
__device__ __forceinline__ f32x4 bf4(u32x2 w) { return (f32x4){lo_bf(w.x), hi_bf(w.x), lo_bf(w.y), hi_bf(w.y)}; }
__device__ void rwkv_prep_task(const RwP& p, char* smem, int tile) {
    bf16_t* At = (bf16_t*)smem;
    const int tid = otid(), lane = tid & 63, wave = tid >> 6;
    const int fl = lane & 15, fq = lane >> 4;
    const int t0 = tile * 64;
    float* Wd = (float*)(p.mix + MX_W); float* KKd = (float*)(p.mix + MX_KK); float* KKAd = (float*)(p.mix + MX_KKA);
    bf16_t* Rd = (bf16_t*)(p.mix + MX_R); bf16_t* Kd = (bf16_t*)(p.mix + MX_K); bf16_t* Vd = (bf16_t*)(p.mix + MX_V); bf16_t* Gd = (bf16_t*)(p.mix + MX_G);
    __syncthreads();
    {
        const int tok = tid >> 2, t = t0 + tok;
        const bool first = (t & (NS - 1)) == 0;
        const bf16_t* zr = p.Z + (size_t)t * DINP + ZC_RW + 1152;
#pragma unroll
        for (int i = 0; i < 8; ++i) {
            const int ch = (tid & 3) + 4 * i;
            const u32x4 cur = *(const u32x4*)(zr + ch * 8);
            const u32x4 prv = first ? (u32x4){0u, 0u, 0u, 0u} : *(const u32x4*)(zr - DINP + ch * 8);
            const f32x4 m0 = *(const f32x4*)(p.mu + 1152 + ch * 8), m1 = *(const f32x4*)(p.mu + 1152 + ch * 8 + 4);
            const unsigned cw[4] = {cur.x, cur.y, cur.z, cur.w}, pw[4] = {prv.x, prv.y, prv.z, prv.w};
            const float mm[8] = {m0.x, m0.y, m0.z, m0.w, m1.x, m1.y, m1.z, m1.w};
            float o[8];
#pragma unroll
            for (int e = 0; e < 4; ++e) {
                const float f0 = lo_bf(cw[e]), f1 = hi_bf(cw[e]), g0 = lo_bf(pw[e]), g1 = hi_bf(pw[e]);
                o[2 * e] = f0 + (g0 - f0) * mm[2 * e]; o[2 * e + 1] = f1 + (g1 - f1) * mm[2 * e + 1];
            }
            if (ch < 8) {
#pragma unroll
                for (int e = 0; e < 8; ++e) o[e] = tanhf(o[e]);
            } else if (ch >= 16) {
#pragma unroll
                for (int e = 0; e < 8; ++e) o[e] = sigmoidf_(o[e]);
            }
            *(u32x4*)(At + tok * PS + ch * 8) = (u32x4){pk2(o[0], o[1]), pk2(o[2], o[3]), pk2(o[4], o[5]), pk2(o[6], o[7])};
        }
    }
    __syncthreads();
    bf16x8 xb[8];
#pragma unroll
    for (int ks = 0; ks < 8; ++ks) xb[ks] = *(const bf16x8*)(At + (16 * wave + fl) * PS + ks * 32 + fq * 8);
    const int t = t0 + 16 * wave + fl, b = t >> 12, sq = t & (NS - 1);
    const bool first = sq == 0;
    const bf16_t* zc = p.Z + (size_t)t * DINP + ZC_RW;
    const bf16_t* WupT = p.lora; const bf16_t* AupT = p.lora + 384 * 64; const bf16_t* GupT = p.lora + 2 * 384 * 64;
#pragma unroll 1
    for (int hd = 0; hd < 6; ++hd) {
        f32x4 aw[4], aa[4], ag[4];
#pragma unroll
        for (int n = 0; n < 4; ++n) {
            const int cr = hd * 64 + 16 * n + fl;
            f32x4 w4 = (f32x4){0.f, 0.f, 0.f, 0.f}, a4 = w4, g4 = w4;
#pragma unroll
            for (int ks = 0; ks < 2; ++ks) {
                w4 = __builtin_amdgcn_mfma_f32_16x16x32_bf16(*(const bf16x8*)(WupT + cr * 64 + ks * 32 + fq * 8), xb[ks], w4, 0, 0, 0);
                a4 = __builtin_amdgcn_mfma_f32_16x16x32_bf16(*(const bf16x8*)(AupT + cr * 64 + ks * 32 + fq * 8), xb[2 + ks], a4, 0, 0, 0);
            }
#pragma unroll
            for (int ks = 0; ks < 4; ++ks) g4 = __builtin_amdgcn_mfma_f32_16x16x32_bf16(*(const bf16x8*)(GupT + cr * 128 + ks * 32 + fq * 8), xb[4 + ks], g4, 0, 0, 0);
            aw[n] = w4; aa[n] = a4; ag[n] = g4;
        }
        f32x4 kx[4], av[4], kkv[4];
        float ss = 0.f;
        const size_t hrow = ((size_t)(b * 6 + hd) * NS + sq) * 64;
#pragma unroll
        for (int n = 0; n < 4; ++n) {
            const int cl = 16 * n + 4 * fq, c = hd * 64 + cl;
            f32x4 rr = bf4(*(const u32x2*)(zc + c)), kk = bf4(*(const u32x2*)(zc + 384 + c)), vv = bf4(*(const u32x2*)(zc + 768 + c));
            f32x4 rp = (f32x4){0.f, 0.f, 0.f, 0.f}, kp = rp, vp = rp;
            if (!first) { rp = bf4(*(const u32x2*)(zc - DINP + c)); kp = bf4(*(const u32x2*)(zc - DINP + 384 + c)); vp = bf4(*(const u32x2*)(zc - DINP + 768 + c)); }
            rr = rr + (rp - rr) * *(const f32x4*)(p.mu + c); kk = kk + (kp - kk) * *(const f32x4*)(p.mu + 384 + c); vv = vv + (vp - vv) * *(const f32x4*)(p.mu + 768 + c);
            const f32x4 wb = *(const f32x4*)(p.w_bias + c), ab = *(const f32x4*)(p.a_bias + c), kkc = *(const f32x4*)(p.k_k + c), kac = *(const f32x4*)(p.k_a + c);
            f32x4 dec, a;
            {
                const f32x4 xw = wb + aw[n], xa = ab + aa[n];
                dec.x = __expf(-__expf(-softplusf_(-xw.x) - 0.5f)); dec.y = __expf(-__expf(-softplusf_(-xw.y) - 0.5f));
                dec.z = __expf(-__expf(-softplusf_(-xw.z) - 0.5f)); dec.w = __expf(-__expf(-softplusf_(-xw.w) - 0.5f));
                a.x = sigmoidf_(xa.x); a.y = sigmoidf_(xa.y); a.z = sigmoidf_(xa.z); a.w = sigmoidf_(xa.w);
            }
            const f32x4 kr = kk * kkc;
            ss += kr.x * kr.x + kr.y * kr.y + kr.z * kr.z + kr.w * kr.w;
            kkv[n] = kr; av[n] = a; kx[n] = kk;
            const f32x4 kmod = kk * ((a - 1.f) * kac + 1.f);
            *(f32x4*)(Wd + hrow + cl) = dec;
            u32x2 w;
            w.x = pk2(rr.x, rr.y); w.y = pk2(rr.z, rr.w); *(u32x2*)(Rd + hrow + cl) = w;
            w.x = pk2(kmod.x, kmod.y); w.y = pk2(kmod.z, kmod.w); *(u32x2*)(Kd + hrow + cl) = w;
            w.x = pk2(vv.x, vv.y); w.y = pk2(vv.z, vv.w); *(u32x2*)(Vd + hrow + cl) = w;
            w.x = pk2(ag[n].x, ag[n].y); w.y = pk2(ag[n].z, ag[n].w); *(u32x2*)(Gd + (size_t)t * 384 + c) = w;
        }
        ss = xor32_sum(xor16_sum(ss));
        const float rn = rsqrtf(fmaxf(ss, 1e-24f));
#pragma unroll
        for (int n = 0; n < 4; ++n) {
            const int cl = 16 * n + 4 * fq;
            const f32x4 kn = kkv[n] * rn;
            *(f32x4*)(KKd + hrow + cl) = kn;
            *(f32x4*)(KKAd + hrow + cl) = kn * av[n];
        }
    }
}

constexpr int SC_STEPS = 16;
constexpr int SEG_BEG[4] = {0, 1376, 2736, 4096};
constexpr size_t MX_SE0 = MX_END;
constexpr size_t MX_XE  = MX_SE0 + 24ull * 3 * 4096 * 4;
constexpr size_t MX_SST = MX_XE + 24ull * 3 * 4096 * 4;
static_assert(MX_SST + 24ull * 3 * 4096 * 2 <= 128 * MiB, "mix region");
__device__ void rwkv_scan_task(const RwP& p, char* smem, int bh, int seg, int grp) {
    float* buf = (float*)smem;
    float* obuf = buf + 2 * 6 * SC_STEPS * 64;
    const int tid = otid(), lane = tid & 63, wave = tid >> 6;
    const int rloc = wave * 4 + (lane >> 4);
    const bool ident = grp >= 4;
    const int row = (grp & 3) * 16 + rloc;
    const int c4 = (lane & 15) * 4;
    const int s_beg = seg == 0 ? SEG_BEG[0] : (seg == 1 ? SEG_BEG[1] : SEG_BEG[2]);
    const int s_end = seg == 0 ? SEG_BEG[1] : (seg == 1 ? SEG_BEG[2] : SEG_BEG[3]);
    const int NCH = (s_end - s_beg) / SC_STEPS;
    const size_t hb = ((size_t)bh * NS + s_beg) * 64;
    const float* Wd = (const float*)(p.mix + MX_W) + hb;
    const float* KKd = (const float*)(p.mix + MX_KK) + hb;
    const float* KKAd = (const float*)(p.mix + MX_KKA) + hb;
    const bf16_t* Rd = (const bf16_t*)(p.mix + MX_R) + hb;
    const bf16_t* Kd = (const bf16_t*)(p.mix + MX_K) + hb;
    const bf16_t* Vd = (const bf16_t*)(p.mix + MX_V) + hb;
    float* orow = p.oraw + hb;
    bf16_t* yrow = p.Y + hb;
    f32x4 S;
    S.x = (ident && c4 + 0 == row) ? 1.f : 0.f; S.y = (ident && c4 + 1 == row) ? 1.f : 0.f; S.z = (ident && c4 + 2 == row) ? 1.f : 0.f; S.w = (ident && c4 + 3 == row) ? 1.f : 0.f;
    struct Stg { f32x4 w, kk, ka; u32x2 r, k, v; };
    Stg sA, sB;
    auto gload = [&](Stg& g, int ch) {
        const size_t e = (size_t)ch * SC_STEPS * 64 + tid * 4;
        g.w = *(const f32x4*)(Wd + e); g.kk = *(const f32x4*)(KKd + e); g.ka = *(const f32x4*)(KKAd + e);
        g.r = *(const u32x2*)(Rd + e); g.k = *(const u32x2*)(Kd + e); g.v = *(const u32x2*)(Vd + e);
    };
    auto lstore = [&](const Stg& g, int bsel) {
        float* bb = buf + bsel * 6 * SC_STEPS * 64 + tid * 4;
        *(f32x4*)(bb + 0 * SC_STEPS * 64) = g.w; *(f32x4*)(bb + 1 * SC_STEPS * 64) = g.kk; *(f32x4*)(bb + 2 * SC_STEPS * 64) = g.ka;
        *(f32x4*)(bb + 3 * SC_STEPS * 64) = (f32x4){lo_bf(g.r.x), hi_bf(g.r.x), lo_bf(g.r.y), hi_bf(g.r.y)};
        *(f32x4*)(bb + 4 * SC_STEPS * 64) = (f32x4){lo_bf(g.k.x), hi_bf(g.k.x), lo_bf(g.k.y), hi_bf(g.k.y)};
        *(f32x4*)(bb + 5 * SC_STEPS * 64) = (f32x4){lo_bf(g.v.x), hi_bf(g.v.x), lo_bf(g.v.y), hi_bf(g.v.y)};
    };
    __syncthreads();
    gload(sA, 0); lstore(sA, 0);
    gload(sA, 1);
    __syncthreads();
    const float vmask = ident ? 0.f : 1.f;
    auto chunk = [&](int ch, Stg& cur  , Stg& nxt  ) {
        if (ch + 2 < NCH) gload(nxt, ch + 2);
        const float* bb = buf + (ch & 1) * 6 * SC_STEPS * 64;
        f32x4 w4 = *(const f32x4*)(bb + 0 * SC_STEPS * 64 + c4), kk4 = *(const f32x4*)(bb + 1 * SC_STEPS * 64 + c4), ka4 = *(const f32x4*)(bb + 2 * SC_STEPS * 64 + c4);
        f32x4 r4 = *(const f32x4*)(bb + 3 * SC_STEPS * 64 + c4), k4 = *(const f32x4*)(bb + 4 * SC_STEPS * 64 + c4);
        float vv = bb[5 * SC_STEPS * 64 + row];
#pragma unroll
        for (int st = 0; st < SC_STEPS; ++st) {
            const int sn = (st + 1 < SC_STEPS) ? st + 1 : st;
            const f32x4 nw4 = *(const f32x4*)(bb + 0 * SC_STEPS * 64 + sn * 64 + c4), nkk4 = *(const f32x4*)(bb + 1 * SC_STEPS * 64 + sn * 64 + c4);
            const f32x4 nka4 = *(const f32x4*)(bb + 2 * SC_STEPS * 64 + sn * 64 + c4), nr4 = *(const f32x4*)(bb + 3 * SC_STEPS * 64 + sn * 64 + c4);
            const f32x4 nk4 = *(const f32x4*)(bb + 4 * SC_STEPS * 64 + sn * 64 + c4);
            const float nvv = bb[5 * SC_STEPS * 64 + sn * 64 + row];
            const float vx = vv * vmask;
            float pd = S.x * kk4.x + S.y * kk4.y + S.z * kk4.z + S.w * kk4.w;
            const float sa = -row16_sum(pd);
            S.x = S.x * w4.x + vx * k4.x + sa * ka4.x;
            S.y = S.y * w4.y + vx * k4.y + sa * ka4.y;
            S.z = S.z * w4.z + vx * k4.z + sa * ka4.z;
            S.w = S.w * w4.w + vx * k4.w + sa * ka4.w;
            float od = S.x * r4.x + S.y * r4.y + S.z * r4.z + S.w * r4.w;
            od = row16_sum(od);
            obuf[st * 16 + rloc] = od;
            w4 = nw4; kk4 = nkk4; ka4 = nka4; r4 = nr4; k4 = nk4; vv = nvv;
        }
        __syncthreads();
        {
            const int st = tid >> 4, rr = tid & 15;
            const size_t oi = ((size_t)ch * SC_STEPS + st) * 64 + (grp & 3) * 16 + rr;
            if (ident) yrow[oi] = f2bf(obuf[tid]); else orow[oi] = obuf[tid];
        }
        if (ch + 1 < NCH) lstore(cur, (ch + 1) & 1);
        __syncthreads();
    };
    for (int ch = 0; ch < NCH; ch += 2) {
        chunk(ch, sA, sB);
        if (ch + 1 < NCH) chunk(ch + 1, sB, sA);
    }
    float* fin = (float*)(p.mix + (ident ? MX_XE : MX_SE0)) + ((size_t)(bh * 3 + seg) * 64 + row) * 64 + c4;
    *(f32x4*)fin = S;
}

__device__ void phase_rwkv_chain(const RwP& p, int bid, int nblk) {
    const int lane = otid() & 63, wave = otid() >> 6;
    const float* SE0 = (const float*)(p.mix + MX_SE0); const float* XE = (const float*)(p.mix + MX_XE);
    bf16_t* SST = (bf16_t*)(p.mix + MX_SST);
    for (int x = bid * 4 + wave; x < 24 * 4; x += nblk * 4) {
        const int bh = x >> 2, cg = (x & 3) * 16;
        const float* s1 = SE0 + ((size_t)(bh * 3 + 0) * 64 + lane) * 64;
        const float* e1 = SE0 + ((size_t)(bh * 3 + 1) * 64 + lane) * 64 + cg;
        const float* X1 = XE + (size_t)(bh * 3 + 1) * 4096 + cg;
        float o[16];
#pragma unroll
        for (int k = 0; k < 16; ++k) o[k] = e1[k];
        for (int i = 0; i < 64; ++i) {
            const float si = s1[i];
#pragma unroll
            for (int k = 0; k < 16; ++k) o[k] += si * X1[i * 64 + k];
        }
        bf16_t* d1 = SST + ((size_t)(bh * 3 + 1) * 64 + lane) * 64 + cg;
        bf16_t* d2 = SST + ((size_t)(bh * 3 + 2) * 64 + lane) * 64 + cg;
#pragma unroll
        for (int k = 0; k < 16; ++k) { d1[k] = f2bf(s1[cg + k]); d2[k] = f2bf(o[k]); }
    }
}

__device__ void phase_rwkv_post(const RwP& p, int bid, int nblk) {
    const int lane = otid() & 63, wave = otid() >> 6;
    const int fl = lane & 15, fq = lane >> 4;
    const bf16_t* Rd = (const bf16_t*)(p.mix + MX_R); const bf16_t* Kd = (const bf16_t*)(p.mix + MX_K); const bf16_t* Vd = (const bf16_t*)(p.mix + MX_V);
    const bf16_t* Gd = (const bf16_t*)(p.mix + MX_G); const bf16_t* SST = (const bf16_t*)(p.mix + MX_SST);
    for (int x = bid * 4 + wave; x < 24 * (NS / 16); x += nblk * 4) {
        const int bh = x / (NS / 16), s0 = (x % (NS / 16)) * 16;
        const int b = bh / 6, hd = bh % 6;
        const int seg = s0 < SEG_BEG[1] ? 0 : (s0 < SEG_BEG[2] ? 1 : 2);
        const size_t hrow = ((size_t)bh * NS + s0 + fl) * 64;
        f32x4 acc[4];
#pragma unroll
        for (int n = 0; n < 4; ++n) acc[n] = *(const f32x4*)(p.oraw + hrow + 16 * n + 4 * fq);
        if (seg > 0) {
            const bf16_t* ss = SST + (size_t)(bh * 3 + seg) * 4096;
#pragma unroll
            for (int ks = 0; ks < 2; ++ks) {
                const bf16x8 yb = *(const bf16x8*)(p.Y + hrow + ks * 32 + fq * 8);
#pragma unroll
                for (int n = 0; n < 4; ++n) {
                    const bf16x8 sa = *(const bf16x8*)(ss + (size_t)(16 * n + fl) * 64 + ks * 32 + fq * 8);
                    acc[n] = __builtin_amdgcn_mfma_f32_16x16x32_bf16(sa, yb, acc[n], 0, 0, 0);
                }
            }
        }
        float sm = 0.f;
#pragma unroll
        for (int n = 0; n < 4; ++n) sm += acc[n].x + acc[n].y + acc[n].z + acc[n].w;
        const float mean = xor32_sum(xor16_sum(sm)) * (1.f / 64.f);
        float sv = 0.f;
#pragma unroll
        for (int n = 0; n < 4; ++n) { acc[n] = acc[n] - mean; sv += acc[n].x * acc[n].x + acc[n].y * acc[n].y + acc[n].z * acc[n].z + acc[n].w * acc[n].w; }
        const float rstd = rsqrtf(xor32_sum(xor16_sum(sv)) * (1.f / 64.f) + 64e-5f);
        float rk = 0.f; f32x4 vv[4];
#pragma unroll
        for (int n = 0; n < 4; ++n) {
            const int c = 16 * n + 4 * fq;
            const u32x2 r2 = *(const u32x2*)(Rd + hrow + c), k2 = *(const u32x2*)(Kd + hrow + c), v2 = *(const u32x2*)(Vd + hrow + c);
            const f32x4 rkw = *(const f32x4*)(p.r_k + hd * 64 + c);
            rk += lo_bf(r2.x) * lo_bf(k2.x) * rkw.x + hi_bf(r2.x) * hi_bf(k2.x) * rkw.y + lo_bf(r2.y) * lo_bf(k2.y) * rkw.z + hi_bf(r2.y) * hi_bf(k2.y) * rkw.w;
            vv[n] = (f32x4){lo_bf(v2.x), hi_bf(v2.x), lo_bf(v2.y), hi_bf(v2.y)};
        }
        rk = xor32_sum(xor16_sum(rk));
        const size_t t = (size_t)b * NS + s0 + fl;
#pragma unroll
        for (int n = 0; n < 4; ++n) {
            const int c = 16 * n + 4 * fq;
            const f32x4 lw = *(const f32x4*)(p.ln_w + hd * 64 + c), lb = *(const f32x4*)(p.ln_b + hd * 64 + c);
            const u32x2 g2 = *(const u32x2*)(Gd + t * 384 + hd * 64 + c);
            const f32x4 gg = (f32x4){lo_bf(g2.x), hi_bf(g2.x), lo_bf(g2.y), hi_bf(g2.y)};
            const f32x4 o = (acc[n] * rstd * lw + lb + vv[n] * rk) * gg;
            u32x2 w; w.x = pk2(o.x, o.y); w.y = pk2(o.z, o.w);
            *(u32x2*)(p.O + t * D + 256 + hd * 64 + c) = w;
        }
    }
}

__device__ __forceinline__ unsigned ordkey(float f) { const unsigned u = __float_as_uint(f); return (u & 0x80000000u) ? ~u : (u | 0x80000000u); }
__device__ __forceinline__ float unordkey(unsigned k) { return __uint_as_float((k & 0x80000000u) ? (k & 0x7FFFFFFFu) : ~k); }
__device__ __forceinline__ void ins16(unsigned (&L)[16], unsigned x) {
#pragma unroll
    for (int i = 0; i < 16; ++i) { const unsigned hi = L[i] > x ? L[i] : x; x = L[i] > x ? x : L[i]; L[i] = hi; }
}
__device__ __forceinline__ void top16_col(const float* col  , unsigned (&L)[16]) {
#pragma unroll
    for (int i = 0; i < 16; ++i) L[i] = 0u;
#pragma unroll 1
    for (int n0 = 0; n0 < 128; n0 += 16) {
        float x[16];
#pragma unroll
        for (int j = 0; j < 16; ++j) x[j] = col[(size_t)(n0 + j) * NT];
#pragma unroll
        for (int j = 0; j < 16; ++j) ins16(L, (ordkey(x[j]) & 0xFFFFFF80u) | (unsigned)(127 - (n0 + j)));
    }
}
__device__ void phase_topk(const float* SCT, int* EIDX, float* GATE, char* smem, int bid, int nblk) {
    const int tid = otid(), lane = tid & 63, wave = tid >> 6;
    unsigned char* itab = (unsigned char*)smem + tid * 32;
    unsigned char* ctab = (unsigned char*)smem + NTHREADS * 32;
    __syncthreads();
    if (tid < 64) {
        const int c = tid; int ci, cj;
        if (c < 16) { ci = 0; cj = c; } else if (c < 24) { ci = 1; cj = c - 16; } else if (c < 29) { ci = 2; cj = c - 24; } else if (c < 33) { ci = 3; cj = c - 29; }
        else if (c < 36) { ci = 4; cj = c - 33; } else if (c < 38) { ci = 5; cj = c - 36; } else if (c < 40) { ci = 6; cj = c - 38; } else if (c < 42) { ci = 7; cj = c - 40; }
        else if (c < 50) { ci = c - 34; cj = 0; } else { ci = 0; cj = 0; }
        ctab[c] = (unsigned char)(ci | (cj << 4));
    }
    __syncthreads();
    for (int x = bid * 4 + wave; x < (NT / 64) * 8; x += nblk * 4) {
        const int tb = x >> 3, hd = x & 7;
        const int t = tb * 64 + lane;
        unsigned L1[16], L2[16];
        top16_col(SCT + (size_t)(hd * 256) * NT + t, L1);
        top16_col(SCT + (size_t)(hd * 256 + 128) * NT + t, L2);
        float s1[16], s2[16];
#pragma unroll
        for (int i = 0; i < 16; ++i) {
            s1[i] = unordkey(L1[i] & 0xFFFFFF80u); s2[i] = unordkey(L2[i] & 0xFFFFFF80u);
            itab[i] = (unsigned char)(127u - (L1[i] & 127u)); itab[16 + i] = (unsigned char)(127u - (L2[i] & 127u));
        }
        unsigned M[16];
#pragma unroll
        for (int i = 0; i < 16; ++i) M[i] = 0u;
        int c = 0;
#pragma unroll
        for (int ci = 0; ci < 16; ++ci) {
#pragma unroll
            for (int cj = 0; cj < 16; ++cj) {
                if ((ci + 1) * (cj + 1) <= 16) {
                    const int cid = (ci == 0) ? cj : (ci == 1) ? 16 + cj : (ci == 2) ? 24 + cj : (ci == 3) ? 29 + cj : (ci == 4) ? 33 + cj : (ci == 5) ? 36 + cj : (ci == 6) ? 38 + cj : (ci == 7) ? 40 + cj : 34 + ci;
                    ins16(M, (ordkey(s1[ci] + s2[cj]) & 0xFFFFFFC0u) | (unsigned)(63 - cid));
                    ++c;
                }
            }
        }
        float ev[16]; int ee[16];
        const float mx = unordkey(M[0] & 0xFFFFFFC0u);
        float sum = 0.f;
#pragma unroll
        for (int i = 0; i < 16; ++i) {
            const int cid = 63 - (int)(M[i] & 63u);
            const unsigned cc = ctab[cid];
            ee[i] = (int)itab[cc & 15u] * 128 + (int)itab[16 + (cc >> 4)];
            ev[i] = __expf(unordkey(M[i] & 0xFFFFFFC0u) - mx);
            sum += ev[i];
        }
        const float inv = 1.f / sum;
        int* eo = EIDX + (size_t)t * 128 + hd * 16; float* go = GATE + (size_t)t * 128 + hd * 16;
#pragma unroll
        for (int i = 0; i < 4; ++i) {
            *(int4*)(eo + 4 * i) = make_int4(ee[4 * i], ee[4 * i + 1], ee[4 * i + 2], ee[4 * i + 3]);
            *(f32x4*)(go + 4 * i) = (f32x4){ev[4 * i] * inv, ev[4 * i + 1] * inv, ev[4 * i + 2] * inv, ev[4 * i + 3] * inv};
        }
    }
    __syncthreads();
}

typedef float f32x2 __attribute__((ext_vector_type(2)));
__device__ __forceinline__ void dec16(const u32x4 w, float (&f)[16]) {
    const unsigned ww[4] = {w.x, w.y, w.z, w.w};
#pragma unroll
    for (int i = 0; i < 4; ++i) {
        const f32x2 a = __builtin_amdgcn_cvt_pk_f32_fp8((int)ww[i], false), b = __builtin_amdgcn_cvt_pk_f32_fp8((int)ww[i], true);
        f[4 * i] = a.x; f[4 * i + 1] = a.y; f[4 * i + 2] = b.x; f[4 * i + 3] = b.y;
    }
}
__device__ void phase_expert(const bf16_t* H, const unsigned char* U8, const unsigned char* V8, const int* EIDX, const float* GATE, const float* X, float* Xo, int bid, int nblk) {
    const int lane = otid() & 63, wave = otid() >> 6;
    for (int t = bid * 4 + wave; t < NT; t += nblk * 4) {
        float xf[16], acc[16];
        {
            const u32x4 a = *(const u32x4*)(H + (size_t)t * D + lane * 16), b = *(const u32x4*)(H + (size_t)t * D + lane * 16 + 8);
            xf[0] = lo_bf(a.x); xf[1] = hi_bf(a.x); xf[2] = lo_bf(a.y); xf[3] = hi_bf(a.y); xf[4] = lo_bf(a.z); xf[5] = hi_bf(a.z); xf[6] = lo_bf(a.w); xf[7] = hi_bf(a.w);
            xf[8] = lo_bf(b.x); xf[9] = hi_bf(b.x); xf[10] = lo_bf(b.y); xf[11] = hi_bf(b.y); xf[12] = lo_bf(b.z); xf[13] = hi_bf(b.z); xf[14] = lo_bf(b.w); xf[15] = hi_bf(b.w);
        }
#pragma unroll
        for (int i = 0; i < 16; ++i) acc[i] = 0.f;
        for (int e0 = 0; e0 < 128; e0 += 8) {
            int ei[8]; float act[8]; u32x4 ur[8];
#pragma unroll
            for (int j = 0; j < 8; ++j) { ei[j] = EIDX[(size_t)t * 128 + e0 + j]; ur[j] = *(const u32x4*)(U8 + (size_t)ei[j] * D + lane * 16); }
#pragma unroll
            for (int j = 0; j < 8; ++j) {
                float uf[16]; dec16(ur[j], uf);
                float d = 0.f;
#pragma unroll
                for (int i = 0; i < 16; ++i) d += xf[i] * uf[i];
                d = wave_sum(d) * (1.f / 512.f);
                act[j] = 0.5f * d * (1.f + erff(d * 0.7071067811865476f)) * GATE[(size_t)t * 128 + e0 + j] * (1.f / 64.f);
            }
#pragma unroll
            for (int j = 0; j < 8; ++j) ur[j] = *(const u32x4*)(V8 + (size_t)ei[j] * D + lane * 16);
#pragma unroll
            for (int j = 0; j < 8; ++j) {
                float vf[16]; dec16(ur[j], vf);
#pragma unroll
                for (int i = 0; i < 16; ++i) acc[i] += act[j] * vf[i];
            }
        }
        const f32x4* xr = (const f32x4*)(X + (size_t)t * D) + lane * 4;
        f32x4* xo = (f32x4*)(Xo + (size_t)t * D) + lane * 4;
#pragma unroll
        for (int i = 0; i < 4; ++i) { f32x4 o = xr[i]; o += (f32x4){acc[4 * i], acc[4 * i + 1], acc[4 * i + 2], acc[4 * i + 3]}; xo[i] = o; }
    }
}

#define XB_TMO      128
#define XB_XCNT(j)  (256  + 64 * (j))
#define XB_XSUB(j)  (1280 + 64 * (j))
#define XB_XGEN(j)  (2304 + 64 * (j))
#define XB_TOP      3328
#define XB_TOPGEN   3392
#define XCD_BAR_WORDS 3456
#define XB_SPIN_CAP (1u << 22)
#define LAS __attribute__((address_space(3)))
__device__ __forceinline__ unsigned xb_ld(unsigned* p)              { return __hip_atomic_load(p, __ATOMIC_RELAXED, __HIP_MEMORY_SCOPE_AGENT); }
__device__ __forceinline__ unsigned xb_add(unsigned* p, unsigned v) { return __hip_atomic_fetch_add(p, v, __ATOMIC_RELAXED, __HIP_MEMORY_SCOPE_AGENT); }
__device__ __forceinline__ unsigned xb_xcc_id() { return (unsigned)__builtin_amdgcn_s_getreg((3 << 11) | 20) & 0xFu; }
#define XB_SPIN(cond, bar) do { unsigned _sp = 0; while (cond) { __builtin_amdgcn_s_sleep(1); \
    if ((++_sp & 255u) == 0u) { if (xb_ld(&(bar)[XB_TMO])) break; if (_sp > XB_SPIN_CAP) { atomicAdd(&(bar)[XB_TMO], 1u); break; } } } } while (0)
struct XcdBarrier { unsigned* bar; unsigned x; volatile LAS unsigned* st; };
__device__ __forceinline__ XcdBarrier xcd_barrier_post(unsigned* bar, volatile LAS unsigned* st) {
    XcdBarrier b; b.bar = bar; b.x = xb_xcc_id(); b.st = st;
    if (threadIdx.x == 0) (void)xb_add(&bar[XB_XCNT(b.x)], 1u);
    return b;
}
__device__ __forceinline__ void xcd_barrier_complete(unsigned* bar, unsigned x, unsigned& nloc, unsigned& nx) {
    const unsigned G = gridDim.x * gridDim.y * gridDim.z;
    unsigned sum, cnt, mine, sp = 0u;
    for (;;) {
        sum = 0u; cnt = 0u; mine = 0u;
#pragma unroll
        for (unsigned j = 0; j < 16; ++j) { const unsigned c = xb_ld(&bar[XB_XCNT(j)]); sum += c; cnt += (c > 0u) ? 1u : 0u; mine = (j == x) ? c : mine; }
        if (sum == G) break;
        __builtin_amdgcn_s_sleep(1);
        if ((++sp & 255u) == 0u) { if (xb_ld(&bar[XB_TMO])) break; if (sp > XB_SPIN_CAP) { atomicAdd(&bar[XB_TMO], 1u); break; } }
    }
    nloc = mine > 0u ? mine : 1u; nx = cnt > 0u ? cnt : 1u;
}
__device__ __forceinline__ void xcd_barrier(const XcdBarrier& b) {
    asm volatile("s_waitcnt vmcnt(0)" ::: "memory");
    __syncthreads();
    if (threadIdx.x == 0) {
        unsigned* bar = b.bar;
        __builtin_amdgcn_s_waitcnt(0);
        unsigned nloc = b.st[0], nx = b.st[1];
        if (nloc == 0u) { xcd_barrier_complete(bar, b.x, nloc, nx); b.st[0] = nloc; b.st[1] = nx; }
        const unsigned old = xb_add(&bar[XB_XSUB(b.x)], 1u);
        const unsigned gen = old / nloc;
        if (old + 1u == (gen + 1u) * nloc) {
            __builtin_amdgcn_fence(__ATOMIC_RELEASE, "agent");
            asm volatile("s_waitcnt vmcnt(0)" ::: "memory");
            const unsigned og = xb_add(&bar[XB_TOP], 1u);
            const unsigned tg = og / nx;
            if (og + 1u == (tg + 1u) * nx) xb_add(&bar[XB_TOPGEN], 1u);
            else XB_SPIN(xb_ld(&bar[XB_TOPGEN]) == tg, bar);
            __builtin_amdgcn_fence(__ATOMIC_ACQUIRE, "agent");
            xb_add(&bar[XB_XGEN(b.x)], 1u);
            asm volatile("s_waitcnt vmcnt(0)" ::: "memory");
        } else {
            XB_SPIN(xb_ld(&bar[XB_XGEN(b.x)]) == gen, bar);
            __builtin_amdgcn_fence(__ATOMIC_ACQUIRE, "agent");
            asm volatile("s_waitcnt vmcnt(0)" ::: "memory");
        }
    }
    __syncthreads();
}

struct Params {
    const float* in[24];
    float* out; unsigned char* ws;
};
constexpr int LDS_BYTES = 65536;

__device__ __forceinline__ RwP make_rwp(const Params& P, int l) {
    RwP r;
    r.Z = (const bf16_t*)(P.ws + WS_Z); r.mix = P.ws + WS_MIX;
    r.mu = P.in[6] + l * RW_F; r.w_up = P.in[7] + (size_t)l * 64 * 384; r.w_bias = P.in[8] + l * 384; r.a_up = P.in[9] + (size_t)l * 64 * 384; r.a_bias = P.in[10] + l * 384;
    r.g_up = P.in[11] + (size_t)l * 128 * 384; r.k_k = P.in[12] + l * 384; r.k_a = P.in[13] + l * 384; r.r_k = P.in[14] + l * 384; r.ln_w = P.in[15] + l * 384; r.ln_b = P.in[16] + l * 384;
    r.oraw = (float*)(P.ws + WS_H); r.O = (bf16_t*)(P.ws + WS_O); r.Y = (bf16_t*)(P.ws + WS_EIDX); r.lora = (const bf16_t*)(P.ws + WS_LORA + l * LORA_L);
    return r;
}

__global__ void __launch_bounds__(NTHREADS, 2) mega_fwd(Params P) {
    __shared__ __attribute__((aligned(16))) char smem[LDS_BYTES];
    const int bid = blockIdx.x, nblk = gridDim.x;
    volatile LAS unsigned* st = (volatile LAS unsigned*)(smem + LDS_BYTES - 16);
    if (threadIdx.x == 0) { st[0] = 0u; st[1] = 0u; st[2] = 0u; st[3] = 0u; }
    __syncthreads();
    XcdBarrier bar = xcd_barrier_post((unsigned*)(P.ws + WS_CTL), st);
#define GSYNC() xcd_barrier(bar)

    {
        ConvP c{P.in[4], P.in[5], P.in[20], P.in[21], P.in[22], P.in[23], P.in[7], P.in[9], P.in[11], P.ws};
        for (int rep = 0; rep < REP_CONV; ++rep) phase_convert_weights(c, smem, bid, nblk);
        phase_rmsnorm<false>(P.in[0], P.in[1], P.ws + WS_H, bid, nblk);
    }
    GSYNC();
#pragma unroll 1
    for (int l = 0; l < 2; ++l) {
        const float* xin = (l == 0) ? P.in[0] : P.out;
        {
            GemmP g{(const bf16_t*)(P.ws + WS_H), D, 0, (const bf16_t*)(P.ws + WS_WTIN) + (size_t)l * DINP * D, D, D, NT / 128, DINP / 128, P.ws + WS_Z, DINP, nullptr};
            for (int rep = 0; rep < REP_GIN; ++rep) phase_gemm<0>(g, smem, bid, nblk);
        }
        GSYNC();
        RwP rw = make_rwp(P, l);
        LinP lp{(const bf16_t*)(P.ws + WS_Z), (bf16_t*)(P.ws + WS_O), P.in[17] + (size_t)l * 16 * 192, P.in[18] + l * 192, P.in[19] + l * 384, (const float*)(P.ws + WS_ROPE), P.ws + WS_LIN};
        for (int task = bid; task < 256 + 2048; task += nblk) {
            if (task < 256) { for (int rep = 0; rep < REP_PREP; ++rep) rwkv_prep_task(rw, smem, task); }
            else { for (int rep = 0; rep < REP_LIN; ++rep) lin_kv_dispatch(lp, smem, task - 256); }
        }
        GSYNC();
        {
            for (int rep = 0; rep < REP_SCAN; ++rep)
            for (int task = bid; task < 480; task += nblk) {
                const int bh = task / 20, r = task % 20;
                const int seg = r < 4 ? 0 : (r < 12 ? 1 : 2), grp = r < 4 ? r : (r < 12 ? r - 4 : r - 12);
                rwkv_scan_task(rw, smem, bh, seg, grp);
            }
            if (nblk >= 512) { if (bid >= 480) for (int rep = 0; rep < REP_LIN; ++rep) lin_scan_phase(lp, bid - 480, nblk - 480); }
            else { for (int rep = 0; rep < REP_LIN; ++rep) lin_scan_phase(lp, bid, nblk); }
        }
        GSYNC();
        phase_rwkv_chain(rw, bid, nblk);
        GSYNC();
        for (int rep = 0; rep < REP_POST; ++rep) phase_rwkv_post(rw, bid, nblk);
        for (int rep = 0; rep < REP_LIN; ++rep) for (int task = bid; task < 2048; task += nblk) lin_out_dispatch(lp, smem, task);
        GSYNC();
        {
            GemmP g{(const bf16_t*)(P.ws + WS_O), D, 0, (const bf16_t*)(P.ws + WS_WTOUT) + (size_t)l * D * D, D, D, NT / 128, D / 128, P.out, D, xin};
            phase_gemm<2>(g, smem, bid, nblk);
            for (int rep = 1; rep < REP_GOUT; ++rep) { GemmP g2 = g; g2.C = P.ws + WS_MIX; phase_gemm<2>(g2, smem, bid, nblk); }
        }
        GSYNC();
        for (int rep = 0; rep < REP_NORM; ++rep) phase_rmsnorm<false>(P.out, P.in[2] + l * D, P.ws + WS_H, bid, nblk);
        GSYNC();
        {
            GemmP g{(const bf16_t*)(P.ws + WS_H), D, 0, (const bf16_t*)(P.ws + WS_WTQ) + (size_t)l * 2048 * D, D, D, NT / 128, 2048 / 128, P.ws + WS_Z, 2048, nullptr};
            for (int rep = 0; rep < REP_GQ; ++rep) phase_gemm<0>(g, smem, bid, nblk);
        }
        GSYNC();
        {
            GemmP g{(const bf16_t*)(P.ws + WS_Z), 2048, 128, (const bf16_t*)(P.ws + WS_SK) + (size_t)l * 16 * 128 * 128, 128, 128, NT / 128, 16, P.ws + WS_MIX, NT, nullptr};
            for (int rep = 0; rep < REP_GSK; ++rep) phase_gemm<3>(g, smem, bid, nblk);
        }
        GSYNC();
        for (int rep = 0; rep < REP_TOPK; ++rep) phase_topk((const float*)(P.ws + WS_MIX), (int*)(P.ws + WS_EIDX), (float*)(P.ws + WS_GATE), smem, bid, nblk);
        GSYNC();
        phase_expert((const bf16_t*)(P.ws + WS_H), P.ws + WS_UB + (size_t)l * NEXP * D, P.ws + WS_VB + (size_t)l * NEXP * D,
                     (const int*)(P.ws + WS_EIDX), (const float*)(P.ws + WS_GATE), P.out, P.out, bid, nblk);
        for (int rep = 1; rep < REP_EXP; ++rep) phase_expert((const bf16_t*)(P.ws + WS_H), P.ws + WS_UB + (size_t)l * NEXP * D, P.ws + WS_VB + (size_t)l * NEXP * D,
                     (const int*)(P.ws + WS_EIDX), (const float*)(P.ws + WS_GATE), P.out, (float*)(P.ws + WS_Z), bid, nblk);
        GSYNC();
        if (l == 0) { phase_rmsnorm<false>(P.out, P.in[1] + D, P.ws + WS_H, bid, nblk); GSYNC(); }
    }
    phase_rmsnorm<true>(P.out, P.in[3], P.out, bid, nblk);
}

extern "C" void kernel_launch(void* const* d_in, const int* in_sizes, int n_in, void* d_out, int out_size, void* d_ws, size_t ws_size, hipStream_t stream) {
    static int grid = 0;
    if (grid == 0) {
        if (n_in != 24 || ws_size < WS_END) { fprintf(stderr, "kernel_launch: bad args n_in=%d ws=%zu need=%zu\n", n_in, ws_size, (size_t)WS_END); grid = -1; return; }
        int dev = 0, cus = 0, per_cu = 0;
        hipGetDevice(&dev);
        hipDeviceGetAttribute(&cus, hipDeviceAttributeMultiprocessorCount, dev);
        hipOccupancyMaxActiveBlocksPerMultiprocessor(&per_cu, (const void*)mega_fwd, NTHREADS, 0);
        if (per_cu < 1) { fprintf(stderr, "kernel_launch: occupancy query says %d\n", per_cu); grid = -1; return; }
        if (per_cu > 2) per_cu = 2;
        grid = cus * per_cu;
        fprintf(stderr, "kernel_launch: grid %d (%d CUs x %d)\n", grid, cus, per_cu);
    }
    if (grid < 0) return;
    hipMemsetAsync((char*)d_ws + WS_CTL, 0, XCD_BAR_WORDS * 4, stream);
    Params P{};
    for (int i = 0; i < 24; ++i) P.in[i] = (const float*)d_in[i];
    P.out = (float*)d_out; P.ws = (unsigned char*)d_ws;
    void* args[] = {&P};
    hipError_t e = hipLaunchCooperativeKernel((const void*)mega_fwd, dim3(grid), dim3(NTHREADS), args, 0, stream);
    if (e != hipSuccess) fprintf(stderr, "cooperative launch failed: %s (grid %d)\n", hipGetErrorString(e), grid);
}
```

```cpp
#include <hip/hip_runtime.h>
#include <stdint.h>
#include <stdio.h>

typedef unsigned short bf16_t;
typedef short bf16x8 __attribute__((ext_vector_type(8)));
typedef float f32x4 __attribute__((ext_vector_type(4)));
typedef unsigned u32x4 __attribute__((ext_vector_type(4)));
typedef unsigned u32x2 __attribute__((ext_vector_type(2)));

#define REP_CONV 1
#define REP_GIN 1
#define REP_PREP 1
#define REP_SCAN 1
#define REP_LIN 1
#define REP_POST 1
#define REP_GOUT 1
#define REP_NORM 1
#define REP_GQ 1
#define REP_GSK 1
#define REP_TOPK 1
#define REP_EXP 1
constexpr int NB = 4, NS = 4096, NT = NB * NS, D = 1024, DIN = 3600, DINP = 3712;
constexpr int ZC_RET = 0, ZC_RW = 1024, ZC_GLA = 2432;
constexpr int RW_F = 1408;
constexpr int NEXP = 16384;
constexpr int NTHREADS = 256;

constexpr size_t MiB = 1024ull * 1024ull;
constexpr size_t WS_CTL   = 0;
constexpr size_t WS_LORA  = 65536;
constexpr size_t LORA_L   = 384ull * 256 * 2;
constexpr size_t WS_WTIN  = 1 * MiB;
constexpr size_t WS_WTOUT = WS_WTIN + 2ull * DINP * D * 2;
constexpr size_t WS_WTQ   = WS_WTOUT + 2ull * D * D * 2;
constexpr size_t WS_SK    = WS_WTQ + 2ull * 2048 * D * 2;
constexpr size_t WS_UB    = WS_SK + 2ull * 16 * 128 * 128 * 2;
constexpr size_t WS_VB    = WS_UB + 2ull * NEXP * D;
constexpr size_t WS_LIN   = WS_VB + 2ull * NEXP * D;
constexpr size_t WS_H     = WS_LIN + 64 * MiB;
constexpr size_t WS_Z     = WS_H + (size_t)NT * D * 2;
constexpr size_t WS_O     = WS_Z + (size_t)NT * DINP * 2;
constexpr size_t WS_MIX   = WS_O + (size_t)NT * D * 2;
constexpr size_t WS_EIDX  = WS_MIX + 128 * MiB;
constexpr size_t WS_GATE  = WS_EIDX + (size_t)NT * 128 * 4;
constexpr size_t WS_ROPE  = WS_GATE + (size_t)NT * 128 * 4;
constexpr size_t WS_WEFF  = WS_ROPE + 1 * MiB;
constexpr size_t WS_END   = WS_WEFF + 2ull * 2048 * D * 2;
constexpr size_t RWA = (size_t)NT * 384;
constexpr size_t MX_W   = 0;
constexpr size_t MX_KK  = MX_W + RWA * 4;
constexpr size_t MX_KKA = MX_KK + RWA * 4;
constexpr size_t MX_R   = MX_KKA + RWA * 4;
constexpr size_t MX_K   = MX_R + RWA * 2;
constexpr size_t MX_V   = MX_K + RWA * 2;
constexpr size_t MX_G   = MX_V + RWA * 2;
constexpr size_t MX_END = MX_G + RWA * 2;
static_assert(MX_END <= 128 * MiB, "mix region");

__device__ __forceinline__ float bf2f(bf16_t v) { return __uint_as_float(((unsigned)v) << 16); }
__device__ __forceinline__ bf16_t f2bf(float f) { unsigned u = __float_as_uint(f); u += 0x7FFFu + ((u >> 16) & 1u); return (bf16_t)(u >> 16); }
__device__ __forceinline__ unsigned pk2(float lo, float hi) { return (unsigned)f2bf(lo) | ((unsigned)f2bf(hi) << 16); }
__device__ __forceinline__ float lo_bf(unsigned u) { return __uint_as_float(u << 16); }
__device__ __forceinline__ float hi_bf(unsigned u) { return __uint_as_float(u & 0xFFFF0000u); }
template <int CTRL> __device__ __forceinline__ float dpp_f(float v) { return __int_as_float(__builtin_amdgcn_update_dpp(0, __float_as_int(v), CTRL, 0xF, 0xF, true)); }
template <int CTRL> __device__ __forceinline__ unsigned dpp_u(unsigned v) { return (unsigned)__builtin_amdgcn_update_dpp(0, (int)v, CTRL, 0xF, 0xF, true); }
__device__ __forceinline__ float row16_sum(float v) { v += dpp_f<0x128>(v); v += dpp_f<0x124>(v); v += dpp_f<0x122>(v); v += dpp_f<0x121>(v); return v; }
__device__ __forceinline__ float xor16_sum(float v) { auto r = __builtin_amdgcn_permlane16_swap(__float_as_uint(v), __float_as_uint(v), false, false); return __uint_as_float(r[0]) + __uint_as_float(r[1]); }
__device__ __forceinline__ float xor32_sum(float v) { auto r = __builtin_amdgcn_permlane32_swap(__float_as_uint(v), __float_as_uint(v), false, false); return __uint_as_float(r[0]) + __uint_as_float(r[1]); }
__device__ __forceinline__ float wave_sum(float v) { return xor32_sum(xor16_sum(row16_sum(v))); }
__device__ __forceinline__ unsigned umax_(unsigned a, unsigned b) { return a > b ? a : b; }
__device__ __forceinline__ unsigned wave_max_u32(unsigned v) {
    v = umax_(v, dpp_u<0x128>(v)); v = umax_(v, dpp_u<0x124>(v)); v = umax_(v, dpp_u<0x122>(v)); v = umax_(v, dpp_u<0x121>(v));
    { auto r = __builtin_amdgcn_permlane16_swap(v, v, false, false); v = umax_(r[0], r[1]); }
    { auto r = __builtin_amdgcn_permlane32_swap(v, v, false, false); v = umax_(r[0], r[1]); }
    return v;
}
__device__ __forceinline__ float sigmoidf_(float x) { return 1.f / (1.f + __expf(-x)); }
__device__ __forceinline__ float softplusf_(float x) { return fmaxf(x, 0.f) + log1pf(__expf(-fabsf(x))); }

__device__ __forceinline__ int otid() { int t = threadIdx.x; asm volatile("" : "+v"(t)); return t; }

__device__ void transpose_tile(const float* __restrict__ W, int K, int N, bf16_t* __restrict__ Wt, int kt, int nt, float* tile  ) {
    const int tid = otid();
    const int k0 = kt * 64, n0 = nt * 64;
#pragma unroll
    for (int i = 0; i < 16; ++i) {
        const int k = i * 4 + (tid >> 6), n = tid & 63;
        tile[k * 65 + n] = (n0 + n < N) ? W[(size_t)(k0 + k) * N + n0 + n] : 0.f;
    }
    __syncthreads();
#pragma unroll
    for (int i = 0; i < 16; ++i) {
        const int n = i * 4 + (tid >> 6), k = tid & 63;
        Wt[(size_t)(n0 + n) * K + k0 + k] = f2bf(tile[k * 65 + n]);
    }
    __syncthreads();
}

struct ConvP {
    const float* w_in; const float* w_out; const float* w_q; const float* sk; const float* u; const float* v;
    const float* w_up; const float* a_up; const float* g_up;
    unsigned char* ws;
};

__device__ void phase_convert_weights(const ConvP& p, char* smem, int bid, int nblk) {
    float* tile = (float*)smem;
    constexpr int T_IN = 16 * 58, T_OUT = 16 * 16, T_L = T_IN + T_OUT;
    for (int it = bid; it < 2 * T_L; it += nblk) {
        const int l = it / T_L; int r = it % T_L;
        if (r < T_IN) { transpose_tile(p.w_in + (size_t)l * D * DIN, D, DIN, (bf16_t*)(p.ws + WS_WTIN) + (size_t)l * DINP * D, r / 58, r % 58, tile); continue; }
        r -= T_IN;
        transpose_tile(p.w_out + (size_t)l * D * D, D, D, (bf16_t*)(p.ws + WS_WTOUT) + (size_t)l * D * D, r / 16, r % 16, tile);
    }
    const size_t gtid = (size_t)bid * NTHREADS + otid(), gn = (size_t)nblk * NTHREADS;
    {
        for (size_t i = gtid; i < 2ull * 384 * 256; i += gn) {
            const int l = (int)(i / (384 * 256)), r = (int)(i % (384 * 256)), c = r >> 8, k = r & 255;
            bf16_t* base = (bf16_t*)(p.ws + WS_LORA + l * LORA_L);
            if (k < 64) base[c * 64 + k] = f2bf(p.w_up[(size_t)l * 64 * 384 + k * 384 + c]);
            else if (k < 128) base[384 * 64 + c * 64 + (k - 64)] = f2bf(p.a_up[(size_t)l * 64 * 384 + (k - 64) * 384 + c]);
            else base[2 * 384 * 64 + c * 128 + (k - 128)] = f2bf(p.g_up[(size_t)l * 128 * 384 + (k - 128) * 384 + c]);
        }
    }
    {
        float* ct = (float*)(p.ws + WS_ROPE); float* stb = ct + NS * 32;
        for (size_t i = gtid; i < (size_t)NS * 32; i += gn) {
            const int pos = (int)(i >> 5), fi = (int)(i & 31);
            const float inv = exp2f(-(float)fi * (13.287712379549449f / 32.f));
            float sn, cs; sincosf((float)pos * inv, &sn, &cs);
            ct[i] = cs; stb[i] = sn;
        }
    }
    {
        const size_t n8 = (2ull * D * 2048) / 8;
        const f32x4* s = (const f32x4*)p.w_q; u32x4* d = (u32x4*)(p.ws + WS_WTQ);
        for (size_t i = gtid; i < n8; i += gn) { f32x4 a = s[2 * i], b = s[2 * i + 1]; u32x4 o; o.x = pk2(a.x, a.y); o.y = pk2(a.z, a.w); o.z = pk2(b.x, b.y); o.w = pk2(b.z, b.w); d[i] = o; }
    }
    {
        const size_t n8 = (2ull * 16 * 128 * 128) / 8;
        const f32x4* s = (const f32x4*)p.sk; u32x4* d = (u32x4*)(p.ws + WS_SK);
        for (size_t i = gtid; i < n8; i += gn) { f32x4 a = s[2 * i], b = s[2 * i + 1]; u32x4 o; o.x = pk2(a.x, a.y); o.y = pk2(a.z, a.w); o.z = pk2(b.x, b.y); o.w = pk2(b.z, b.w); d[i] = o; }
    }
    {
        const size_t n16 = (2ull * NEXP * D) / 16;
        const f32x4* su = (const f32x4*)p.u; u32x4* du = (u32x4*)(p.ws + WS_UB);
        const f32x4* sv = (const f32x4*)p.v; u32x4* dv = (u32x4*)(p.ws + WS_VB);
        for (size_t i = gtid; i < n16; i += gn) {
            f32x4 a = su[4 * i] * 512.f, b = su[4 * i + 1] * 512.f, c = su[4 * i + 2] * 512.f, d = su[4 * i + 3] * 512.f;
            u32x4 o;
            o.x = (unsigned)__builtin_amdgcn_cvt_pk_fp8_f32(a.z, a.w, __builtin_amdgcn_cvt_pk_fp8_f32(a.x, a.y, 0, false), true);
            o.y = (unsigned)__builtin_amdgcn_cvt_pk_fp8_f32(b.z, b.w, __builtin_amdgcn_cvt_pk_fp8_f32(b.x, b.y, 0, false), true);
            o.z = (unsigned)__builtin_amdgcn_cvt_pk_fp8_f32(c.z, c.w, __builtin_amdgcn_cvt_pk_fp8_f32(c.x, c.y, 0, false), true);
            o.w = (unsigned)__builtin_amdgcn_cvt_pk_fp8_f32(d.z, d.w, __builtin_amdgcn_cvt_pk_fp8_f32(d.x, d.y, 0, false), true);
            du[i] = o;
            a = sv[4 * i] * 64.f; b = sv[4 * i + 1] * 64.f; c = sv[4 * i + 2] * 64.f; d = sv[4 * i + 3] * 64.f;
            o.x = (unsigned)__builtin_amdgcn_cvt_pk_fp8_f32(a.z, a.w, __builtin_amdgcn_cvt_pk_fp8_f32(a.x, a.y, 0, false), true);
            o.y = (unsigned)__builtin_amdgcn_cvt_pk_fp8_f32(b.z, b.w, __builtin_amdgcn_cvt_pk_fp8_f32(b.x, b.y, 0, false), true);
            o.z = (unsigned)__builtin_amdgcn_cvt_pk_fp8_f32(c.z, c.w, __builtin_amdgcn_cvt_pk_fp8_f32(c.x, c.y, 0, false), true);
            o.w = (unsigned)__builtin_amdgcn_cvt_pk_fp8_f32(d.z, d.w, __builtin_amdgcn_cvt_pk_fp8_f32(d.x, d.y, 0, false), true);
            dv[i] = o;
        }
    }
}

template <bool OUT_F32>
__device__ void phase_rmsnorm(const float* x, const float* __restrict__ g, void* out, int bid, int nblk) {
    const int lane = otid() & 63, wave = otid() >> 6;
    const int gw = bid * 4 + wave, ngw = nblk * 4;
    f32x4 gv[4];
#pragma unroll
    for (int j = 0; j < 4; ++j) gv[j] = ((const f32x4*)g)[lane + 64 * j];
    for (int row = gw; row < NT; row += ngw) {
        const f32x4* xr = (const f32x4*)(x + (size_t)row * D) + lane;
        f32x4 v[4]; float s = 0.f;
#pragma unroll
        for (int j = 0; j < 4; ++j) { v[j] = xr[64 * j]; s += v[j].x * v[j].x + v[j].y * v[j].y + v[j].z * v[j].z + v[j].w * v[j].w; }
        s = wave_sum(s);
        const float rs = rsqrtf(s * (1.f / D) + 1e-6f);
        if (OUT_F32) {
            f32x4* o = (f32x4*)((float*)out + (size_t)row * D) + lane;
#pragma unroll
            for (int j = 0; j < 4; ++j) o[64 * j] = v[j] * rs * gv[j];
        } else {
            u32x2* o = (u32x2*)((bf16_t*)out + (size_t)row * D) + lane;
#pragma unroll
            for (int j = 0; j < 4; ++j) { f32x4 y = v[j] * rs * gv[j]; u32x2 w; w.x = pk2(y.x, y.y); w.y = pk2(y.z, y.w); o[64 * j] = w; }
        }
    }
}

struct GemmP {
    const bf16_t* A; int lda; int a_koff;
    int b_koff;
    const bf16_t* Bt; int ldb; int K;
    int MT, NTl;
    void* C; int ldc; const float* R;
};
constexpr int GS = 72;
template <int MODE>
__device__ void phase_gemm(const GemmP& p, char* smem, int bid, int nblk, int tile0 = 0) {
    bf16_t* As = (bf16_t*)smem;
    bf16_t* Bs = As + 128 * GS;
    const int tid = otid(), lane = tid & 63, wave = tid >> 6;
    const int wr = wave >> 1, wc = wave & 1;
    const int lr = tid >> 3, lc = (tid & 7) * 8;
    const int fl = lane & 15, fq = lane >> 4;
    const int ntiles = p.MT * p.NTl;
    for (int tile = bid - tile0 + ((bid < tile0) ? nblk * ((tile0 - bid + nblk - 1) / nblk) : 0); tile < ntiles; tile += nblk) {
        const int mt = tile / p.NTl, nt = tile % p.NTl;
        const bf16_t* Ag = p.A + (size_t)mt * 128 * p.lda + (size_t)nt * p.a_koff + (size_t)lr * p.lda + lc;
        const bf16_t* Bg = p.Bt + (size_t)nt * 128 * p.ldb + (size_t)mt * p.b_koff + (size_t)lr * p.ldb + lc;
        f32x4 acc[4][4];
#pragma unroll
        for (int m = 0; m < 4; ++m)
#pragma unroll
            for (int n = 0; n < 4; ++n) acc[m][n] = (f32x4){0.f, 0.f, 0.f, 0.f};
        u32x4 ra[4], rb[4];
#pragma unroll
        for (int i = 0; i < 4; ++i) { ra[i] = *(const u32x4*)(Ag + (size_t)(32 * i) * p.lda); rb[i] = *(const u32x4*)(Bg + (size_t)(32 * i) * p.ldb); }
        for (int k0 = 0; k0 < p.K; k0 += 64) {
            __syncthreads();
#pragma unroll
            for (int i = 0; i < 4; ++i) { *(u32x4*)(As + (lr + 32 * i) * GS + lc) = ra[i]; *(u32x4*)(Bs + (lr + 32 * i) * GS + lc) = rb[i]; }
            __syncthreads();
            if (k0 + 64 < p.K) {
#pragma unroll
                for (int i = 0; i < 4; ++i) { ra[i] = *(const u32x4*)(Ag + (size_t)(32 * i) * p.lda + k0 + 64); rb[i] = *(const u32x4*)(Bg + (size_t)(32 * i) * p.ldb + k0 + 64); }
            }
#pragma unroll
            for (int ks = 0; ks < 2; ++ks) {
                bf16x8 xa[4], wb[4];
#pragma unroll
                for (int m = 0; m < 4; ++m) xa[m] = *(const bf16x8*)(As + (wr * 64 + m * 16 + fl) * GS + ks * 32 + fq * 8);
#pragma unroll
                for (int n = 0; n < 4; ++n) wb[n] = *(const bf16x8*)(Bs + (wc * 64 + n * 16 + fl) * GS + ks * 32 + fq * 8);
#pragma unroll
                for (int m = 0; m < 4; ++m)
#pragma unroll
                    for (int n = 0; n < 4; ++n) acc[m][n] = (MODE == 3) ? __builtin_amdgcn_mfma_f32_16x16x32_bf16(xa[m], wb[n], acc[m][n], 0, 0, 0)
                                                                     : __builtin_amdgcn_mfma_f32_16x16x32_bf16(wb[n], xa[m], acc[m][n], 0, 0, 0);
            }
        }
#pragma unroll
        for (int m = 0; m < 4; ++m) {
#pragma unroll
            for (int n = 0; n < 4; ++n) {
                const f32x4 a = acc[m][n];
                if (MODE == 3) {
                    const size_t row = (size_t)mt * 128 + wr * 64 + m * 16 + fq * 4;
                    const size_t col = (size_t)nt * 128 + wc * 64 + n * 16 + fl;
                    *(f32x4*)((float*)p.C + col * p.ldc + row) = a;
                } else {
                    const size_t row = (size_t)mt * 128 + wr * 64 + m * 16 + fl;
                    const int col = nt * 128 + wc * 64 + n * 16 + fq * 4;
                    if (MODE == 0) { u32x2 w; w.x = pk2(a.x, a.y); w.y = pk2(a.z, a.w); *(u32x2*)((bf16_t*)p.C + row * p.ldc + col) = w; }
                    else if (MODE == 1) { *(f32x4*)((float*)p.C + row * p.ldc + col) = a; }
                    else { const f32x4 r = *(const f32x4*)(p.R + row * p.ldc + col); *(f32x4*)((float*)p.C + row * p.ldc + col) = r + a; }
                }
            }
        }
    }
}

constexpr int LS = 72;
struct LinP {
    const bf16_t* Z; bf16_t* O;
    const float* gk_up;
    const float* gk_bias;
    const float* norm_w;
    const float* rope;
    unsigned char* lin;
};
__device__ __forceinline__ bf16x8 ldfrag(const bf16_t* base, int row, int kofs) { return *(const bf16x8*)(base + row * LS + kofs); }

constexpr size_t LN_KV_RET = 0;
constexpr size_t LN_KV_GLA = LN_KV_RET + 1024ull * 64 * 64 * 4;
constexpr size_t LN_S_RET  = LN_KV_GLA + 1024ull * 96 * 64 * 4;
constexpr size_t LN_S_GLA  = LN_S_RET + 1024ull * 64 * 64 * 2;
constexpr size_t LN_DEC    = LN_S_GLA + 1024ull * 96 * 64 * 2;
static_assert(LN_DEC + 2048ull * 64 * 4 <= 64 * MiB, "lin region");

__device__ __forceinline__ float wave_incl_scan(float v) {
    v += dpp_f<0x111>(v); v += dpp_f<0x112>(v); v += dpp_f<0x114>(v); v += dpp_f<0x118>(v);
    v += __int_as_float(__builtin_amdgcn_update_dpp(0, __float_as_int(v), 0x142, 0xA, 0xF, false));
    v += __int_as_float(__builtin_amdgcn_update_dpp(0, __float_as_int(v), 0x143, 0xC, 0xF, false));
    return v;
}
__device__ __forceinline__ float readlane_f(float v, int l) { return __int_as_float(__builtin_amdgcn_readlane(__float_as_int(v), l)); }

__device__ __forceinline__ void rot8(const bf16_t* src, const float* rope, int spos, int cq, unsigned (&o1)[4], unsigned (&o2)[4]) {
    const u32x4 q1 = *(const u32x4*)(src + cq * 8), q2 = *(const u32x4*)(src + 32 + cq * 8);
    const unsigned q1w[4] = {q1.x, q1.y, q1.z, q1.w}, q2w[4] = {q2.x, q2.y, q2.z, q2.w};
    const f32x4 c0 = *(const f32x4*)(rope + spos * 32 + cq * 8), c1 = *(const f32x4*)(rope + spos * 32 + cq * 8 + 4);
    const f32x4 s0 = *(const f32x4*)(rope + NS * 32 + spos * 32 + cq * 8), s1 = *(const f32x4*)(rope + NS * 32 + spos * 32 + cq * 8 + 4);
    const float csv[8] = {c0.x, c0.y, c0.z, c0.w, c1.x, c1.y, c1.z, c1.w}, snv[8] = {s0.x, s0.y, s0.z, s0.w, s1.x, s1.y, s1.z, s1.w};
#pragma unroll
    for (int e = 0; e < 4; ++e) {
        const float a1l = lo_bf(q1w[e]), a1h = hi_bf(q1w[e]), a2l = lo_bf(q2w[e]), a2h = hi_bf(q2w[e]);
        o1[e] = pk2(a1l * csv[2 * e] - a2l * snv[2 * e], a1h * csv[2 * e + 1] - a2h * snv[2 * e + 1]);
        o2[e] = pk2(a1l * snv[2 * e] + a2l * csv[2 * e], a1h * snv[2 * e + 1] + a2h * csv[2 * e + 1]);
    }
}
__device__ __forceinline__ void load_vts(const bf16_t* Z, size_t t0, int voff, int nch, bf16_t* Vts, int tid) {
    for (int x = tid; x < 64 * nch; x += NTHREADS) {
        const int tok = x / nch, ch = x % nch;
        const u32x4 vv = *(const u32x4*)(Z + (t0 + tok) * DINP + voff + ch * 8);
        const unsigned w[4] = {vv.x, vv.y, vv.z, vv.w};
#pragma unroll
        for (int e = 0; e < 4; ++e) { Vts[(ch * 8 + 2 * e) * LS + tok] = (bf16_t)(w[e] & 0xFFFFu); Vts[(ch * 8 + 2 * e + 1) * LS + tok] = (bf16_t)(w[e] >> 16); }
    }
}
__device__ __forceinline__ void load_gd(const bf16_t* zr, float (&gd)[16]) {
    const u32x4 g0 = *(const u32x4*)zr, g1 = *(const u32x4*)(zr + 8);
    gd[0] = lo_bf(g0.x); gd[1] = hi_bf(g0.x); gd[2] = lo_bf(g0.y); gd[3] = hi_bf(g0.y); gd[4] = lo_bf(g0.z); gd[5] = hi_bf(g0.z); gd[6] = lo_bf(g0.w); gd[7] = hi_bf(g0.w);
    gd[8] = lo_bf(g1.x); gd[9] = hi_bf(g1.x); gd[10] = lo_bf(g1.y); gd[11] = hi_bf(g1.y); gd[12] = lo_bf(g1.z); gd[13] = hi_bf(g1.z); gd[14] = lo_bf(g1.w); gd[15] = hi_bf(g1.w);
}
__device__ __forceinline__ float gla_gk(const LinP& p, const float (&gd)[16], int h, int d) {
    float x = p.gk_bias[h * 48 + d];
#pragma unroll
    for (int i = 0; i < 16; ++i) x += gd[i] * p.gk_up[i * 192 + h * 48 + d];
    return (fminf(x, 0.f) - log1pf(__expf(-fabsf(x)))) * (1.f / 16.f);
}
__device__ __forceinline__ float ret_lg(int h) { const float e = exp2f(-5.f - (float)h * (4.f / 3.f)); return log1pf(-e); }

template <bool IS_GLA>
__device__ void lin_kv_task(const LinP& p, char* smem, int b, int h, int c) {
    constexpr int DV = IS_GLA ? 96 : 64, NVB = DV / 16;
    const int koff = IS_GLA ? (ZC_GLA + 192 + h * 48) : (ZC_RET + 256 + h * 64);
    const int voff = IS_GLA ? (ZC_GLA + 384 + h * 96) : (ZC_RET + 512 + h * 64);
    const int gkdoff = ZC_GLA + 768;
    bf16_t* Ks = (bf16_t*)smem;
    bf16_t* Kts = Ks + 64 * LS;
    bf16_t* Vts = Kts + 64 * LS;
    float* decs = (float*)(Vts + 96 * LS);
    const int tid = otid(), lane = tid & 63, wave = tid >> 6;
    const int fl = lane & 15, fq = lane >> 4;
    const size_t t0 = (size_t)b * NS + (size_t)c * 64;
    const int task = (b * 4 + h) * 64 + c;
    __syncthreads();
    if (IS_GLA) {
        for (int x = tid; x < 64 * 6; x += NTHREADS) {
            const int tok = x / 6, ch = x % 6;
            *(u32x4*)(Ks + tok * LS + ch * 8) = *(const u32x4*)(p.Z + (t0 + tok) * DINP + koff + ch * 8);
        }
        for (int x = tid; x < 16 * LS / 2; x += NTHREADS) ((unsigned*)(Kts + 48 * LS))[x] = 0u;
        if (tid < 16) decs[48 + tid] = 1.f;
        load_vts(p.Z, t0, voff, 12, Vts, tid);
    } else {
        const int tok = tid >> 2, cq = tid & 3;
        unsigned k1[4], k2[4];
        rot8(p.Z + (t0 + tok) * DINP + koff, p.rope, c * 64 + tok, cq, k1, k2);
        const float fk2 = 0.125f * __expf(ret_lg(h) * (float)(63 - tok));
#pragma unroll
        for (int e = 0; e < 4; ++e) {
            Kts[(cq * 8 + 2 * e) * LS + tok] = f2bf(lo_bf(k1[e]) * fk2); Kts[(cq * 8 + 2 * e + 1) * LS + tok] = f2bf(hi_bf(k1[e]) * fk2);
            Kts[(32 + cq * 8 + 2 * e) * LS + tok] = f2bf(lo_bf(k2[e]) * fk2); Kts[(32 + cq * 8 + 2 * e + 1) * LS + tok] = f2bf(hi_bf(k2[e]) * fk2);
        }
        if (tid < 64) decs[tid] = __expf(ret_lg(h) * 64.f);
        load_vts(p.Z, t0, voff, 8, Vts, tid);
    }
    __syncthreads();
    if (IS_GLA) {
        float gd[16];
        load_gd(p.Z + (t0 + lane) * DINP + gkdoff, gd);
#pragma unroll 1
        for (int dd = 0; dd < 12; ++dd) {
            const int d = wave * 12 + dd;
            const float bc = wave_incl_scan(gla_gk(p, gd, h, d));
            const float bl = readlane_f(bc, 63);
            Kts[d * LS + lane] = f2bf(bf2f(Ks[lane * LS + d]) * __expf(bl - bc));
            if (lane == 0) decs[d] = __expf(bl);
        }
        __syncthreads();
    }
    float* KV = (float*)(p.lin + (IS_GLA ? LN_KV_GLA : LN_KV_RET)) + (size_t)task * DV * 64;
#pragma unroll
    for (int vb = 0; vb < NVB; ++vb) {
        f32x4 a4 = (f32x4){0.f, 0.f, 0.f, 0.f};
#pragma unroll
        for (int ks = 0; ks < 2; ++ks) {
            const bf16x8 a = ldfrag(Kts, 16 * wave + fl, ks * 32 + fq * 8);
            const bf16x8 bv = ldfrag(Vts, 16 * vb + fl, ks * 32 + fq * 8);
            a4 = __builtin_amdgcn_mfma_f32_16x16x32_bf16(a, bv, a4, 0, 0, 0);
        }
        *(f32x4*)(KV + (size_t)(16 * vb + fl) * 64 + 16 * wave + 4 * fq) = a4;
    }
    if (tid < 64) ((float*)(p.lin + LN_DEC))[(size_t)((IS_GLA ? 1024 : 0) + task) * 64 + tid] = decs[tid];
}

__device__ void lin_scan_phase(const LinP& p, int vbid, int nvblk) {
    const int tid = otid();
    for (int it = vbid; it < 160; it += nvblk) {
        const bool gla = it >= 64;
        const int r = gla ? it - 64 : it;
        const int per = gla ? 6 : 4, DVx = gla ? 96 : 64;
        const int bh = r / per, e = (r % per) * 1024 + tid;
        const float* KV = (const float*)(p.lin + (gla ? LN_KV_GLA : LN_KV_RET)) + (size_t)bh * 64 * DVx * 64 + e;
        bf16_t* Sb = (bf16_t*)(p.lin + (gla ? LN_S_GLA : LN_S_RET)) + (size_t)bh * 64 * DVx * 64 + e;
        const float* DEC = (const float*)(p.lin + LN_DEC) + (size_t)((gla ? 1024 : 0) + bh * 64) * 64 + (e & 63);
        float S0 = 0.f, S1 = 0.f, S2 = 0.f, S3 = 0.f;
#pragma unroll 8
        for (int c = 0; c < 64; ++c) {
            const size_t o = (size_t)c * DVx * 64;
            const float k0 = KV[o], k1 = KV[o + 256], k2 = KV[o + 512], k3 = KV[o + 768], dc = DEC[c * 64];
            Sb[o] = f2bf(S0); Sb[o + 256] = f2bf(S1); Sb[o + 512] = f2bf(S2); Sb[o + 768] = f2bf(S3);
            S0 = S0 * dc + k0; S1 = S1 * dc + k1; S2 = S2 * dc + k2; S3 = S3 * dc + k3;
        }
    }
}

template <bool IS_GLA>
__device__ void lin_out_task(const LinP& p, char* smem, int b, int h, int c) {
    constexpr int DV = IS_GLA ? 96 : 64, NVB = DV / 16;
    const int qoff = IS_GLA ? (ZC_GLA + 0 + h * 48) : (ZC_RET + 0 + h * 64);
    const int koff = IS_GLA ? (ZC_GLA + 192 + h * 48) : (ZC_RET + 256 + h * 64);
    const int voff = IS_GLA ? (ZC_GLA + 384 + h * 96) : (ZC_RET + 512 + h * 64);
    const int goff = IS_GLA ? (ZC_GLA + 784 + h * 96) : (ZC_RET + 768 + h * 64);
    const int gkdoff = ZC_GLA + 768;
    const int ooff = IS_GLA ? (640 + h * 96) : (h * 64);
    bf16_t* Qs = (bf16_t*)smem;
    bf16_t* Ks = Qs + 64 * LS;
    bf16_t* Ps = Ks + 64 * LS;
    bf16_t* Vts = Ps + 64 * LS;
    bf16_t* Sts = Vts + 96 * LS;
    const int tid = otid(), lane = tid & 63, wave = tid >> 6;
    const int fl = lane & 15, fq = lane >> 4;
    const size_t t0 = (size_t)b * NS + (size_t)c * 64;
    const int task = (b * 4 + h) * 64 + c;
    __syncthreads();
    {
        const bf16_t* Sb = (const bf16_t*)(p.lin + (IS_GLA ? LN_S_GLA : LN_S_RET)) + (size_t)task * DV * 64;
        for (int x = tid; x < DV * 8; x += NTHREADS) { const int v = x >> 3, ch = x & 7; *(u32x4*)(Sts + v * LS + ch * 8) = *(const u32x4*)(Sb + v * 64 + ch * 8); }
    }
    if (IS_GLA) {
        for (int x = tid; x < 64 * 6; x += NTHREADS) {
            const int tok = x / 6, ch = x % 6;
            const bf16_t* zr = p.Z + (t0 + tok) * DINP;
            *(u32x4*)(Qs + tok * LS + ch * 8) = *(const u32x4*)(zr + qoff + ch * 8);
            *(u32x4*)(Ks + tok * LS + ch * 8) = *(const u32x4*)(zr + koff + ch * 8);
        }
        for (int x = tid; x < 64 * 2; x += NTHREADS) {
            const int tok = x >> 1, ch = 6 + (x & 1);
            *(u32x4*)(Qs + tok * LS + ch * 8) = (u32x4){0u, 0u, 0u, 0u};
            *(u32x4*)(Ks + tok * LS + ch * 8) = (u32x4){0u, 0u, 0u, 0u};
        }
        load_vts(p.Z, t0, voff, 12, Vts, tid);
    } else {
        const int tok = tid >> 2, cq = tid & 3;
        const bf16_t* zr = p.Z + (t0 + tok) * DINP;
        unsigned q1[4], q2[4], k1[4], k2[4];
        rot8(zr + qoff, p.rope, c * 64 + tok, cq, q1, q2);
        rot8(zr + koff, p.rope, c * 64 + tok, cq, k1, k2);
        const float lg = ret_lg(h);
        const float fqd = __expf(lg * (float)(tok + 1)), fk = 0.125f * __expf(-lg * (float)(tok + 1));
#pragma unroll
        for (int e = 0; e < 4; ++e) {
            q1[e] = pk2(lo_bf(q1[e]) * fqd, hi_bf(q1[e]) * fqd); q2[e] = pk2(lo_bf(q2[e]) * fqd, hi_bf(q2[e]) * fqd);
            k1[e] = pk2(lo_bf(k1[e]) * fk, hi_bf(k1[e]) * fk); k2[e] = pk2(lo_bf(k2[e]) * fk, hi_bf(k2[e]) * fk);
        }
        *(u32x4*)(Qs + tok * LS + cq * 8) = (u32x4){q1[0], q1[1], q1[2], q1[3]};
        *(u32x4*)(Qs + tok * LS + 32 + cq * 8) = (u32x4){q2[0], q2[1], q2[2], q2[3]};
        *(u32x4*)(Ks + tok * LS + cq * 8) = (u32x4){k1[0], k1[1], k1[2], k1[3]};
        *(u32x4*)(Ks + tok * LS + 32 + cq * 8) = (u32x4){k2[0], k2[1], k2[2], k2[3]};
        load_vts(p.Z, t0, voff, 8, Vts, tid);
    }
    __syncthreads();
    if (IS_GLA) {
        float gd[16];
        load_gd(p.Z + (t0 + lane) * DINP + gkdoff, gd);
#pragma unroll 1
        for (int dd = 0; dd < 12; ++dd) {
            const int d = wave * 12 + dd;
            const float bc = wave_incl_scan(gla_gk(p, gd, h, d));
            const float eq = __expf(bc) * 0.14433756729740643f  , ek = __expf(-bc);
            Qs[lane * LS + d] = f2bf(bf2f(Qs[lane * LS + d]) * eq);
            Ks[lane * LS + d] = f2bf(bf2f(Ks[lane * LS + d]) * ek);
        }
        __syncthreads();
    }
#pragma unroll
    for (int jb = 0; jb < 4; ++jb) {
        f32x4 ap = (f32x4){0.f, 0.f, 0.f, 0.f};
#pragma unroll
        for (int ks = 0; ks < 2; ++ks) {
            const bf16x8 a = ldfrag(Ks, 16 * jb + fl, ks * 32 + fq * 8);
            const bf16x8 bq = ldfrag(Qs, 16 * wave + fl, ks * 32 + fq * 8);
            ap = __builtin_amdgcn_mfma_f32_16x16x32_bf16(a, bq, ap, 0, 0, 0);
        }
        const int i = 16 * wave + fl, j0 = 16 * jb + 4 * fq;
        u32x2 w;
        w.x = pk2(j0 + 0 <= i ? ap.x : 0.f, j0 + 1 <= i ? ap.y : 0.f);
        w.y = pk2(j0 + 2 <= i ? ap.z : 0.f, j0 + 3 <= i ? ap.w : 0.f);
        *(u32x2*)(Ps + i * LS + j0) = w;
    }
    __syncthreads();
    {
        f32x4 ao[NVB];
        float ss = 0.f;
#pragma unroll
        for (int vb = 0; vb < NVB; ++vb) {
            f32x4 a4 = (f32x4){0.f, 0.f, 0.f, 0.f};
#pragma unroll
            for (int ks = 0; ks < 2; ++ks) {
                const bf16x8 a = ldfrag(Vts, 16 * vb + fl, ks * 32 + fq * 8);
                const bf16x8 bp = ldfrag(Ps, 16 * wave + fl, ks * 32 + fq * 8);
                a4 = __builtin_amdgcn_mfma_f32_16x16x32_bf16(a, bp, a4, 0, 0, 0);
            }
#pragma unroll
            for (int ks = 0; ks < 2; ++ks) {
                const bf16x8 a = ldfrag(Sts, 16 * vb + fl, ks * 32 + fq * 8);
                const bf16x8 bq = ldfrag(Qs, 16 * wave + fl, ks * 32 + fq * 8);
                a4 = __builtin_amdgcn_mfma_f32_16x16x32_bf16(a, bq, a4, 0, 0, 0);
            }
            ao[vb] = a4;
            ss += a4.x * a4.x + a4.y * a4.y + a4.z * a4.z + a4.w * a4.w;
        }
        ss = xor32_sum(xor16_sum(ss));
        const float inv = rsqrtf(ss * (1.f / DV) + 1e-5f);
        const size_t t = t0 + 16 * wave + fl;
#pragma unroll
        for (int vb = 0; vb < NVB; ++vb) {
            const int v0 = 16 * vb + 4 * fq;
            const u32x2 gg = *(const u32x2*)(p.Z + t * DINP + goff + v0);
            float g4[4] = {lo_bf(gg.x), hi_bf(gg.x), lo_bf(gg.y), hi_bf(gg.y)};
            float o4[4] = {ao[vb].x, ao[vb].y, ao[vb].z, ao[vb].w};
#pragma unroll
            for (int e = 0; e < 4; ++e) {
                float y = o4[e] * inv;
                if (IS_GLA) y *= p.norm_w[h * 96 + v0 + e];
                const float g = g4[e];
                o4[e] = y * (g / (1.f + __expf(-g)));
            }
            u32x2 w; w.x = pk2(o4[0], o4[1]); w.y = pk2(o4[2], o4[3]);
            *(u32x2*)(p.O + t * D + ooff + v0) = w;
        }
    }
}
__device__ __forceinline__ void lin_kv_dispatch(const LinP& p, char* smem, int task) {
    const int r = task & 1023, bh = r >> 6, c = r & 63;
    if (task < 1024) lin_kv_task<false>(p, smem, bh >> 2, bh & 3, c); else lin_kv_task<true>(p, smem, bh >> 2, bh & 3, c);
}
__device__ __forceinline__ void lin_out_dispatch(const LinP& p, char* smem, int task) {
    const int r = task & 1023, bh = r >> 6, c = r & 63;
    if (task < 1024) lin_out_task<false>(p, smem, bh >> 2, bh & 3, c); else lin_out_task<true>(p, smem, bh >> 2, bh & 3, c);
}

struct RwP {
    const bf16_t* Z; unsigned char* mix;
    const float* mu; const float* w_up; const float* w_bias; const float* a_up; const float* a_bias; const float* g_up;
    const float* k_k; const float* k_a; const float* r_k; const float* ln_w; const float* ln_b;
    float* oraw; bf16_t* O; bf16_t* Y; const bf16_t* lora;
};
constexpr int PS = 264;
__device__ __forceinline__ f32x4 bf4(u32x2 w) { return (f32x4){lo_bf(w.x), hi_bf(w.x), lo_bf(w.y), hi_bf(w.y)}; }
__device__ void rwkv_prep_task(const RwP& p, char* smem, int tile) {
    bf16_t* At = (bf16_t*)smem;
    const int tid = otid(), lane = tid & 63, wave = tid >> 6;
    const int fl = lane & 15, fq = lane >> 4;
    const int t0 = tile * 32;
    float* Wd = (float*)(p.mix + MX_W); float* KKd = (float*)(p.mix + MX_KK); float* KKAd = (float*)(p.mix + MX_KKA);
    bf16_t* Rd = (bf16_t*)(p.mix + MX_R); bf16_t* Kd = (bf16_t*)(p.mix + MX_K); bf16_t* Vd = (bf16_t*)(p.mix + MX_V); bf16_t* Gd = (bf16_t*)(p.mix + MX_G);
    __syncthreads();
    {
        const int tok = tid >> 3, t = t0 + tok;
        const bool first = (t & (NS - 1)) == 0;
        const bf16_t* zr = p.Z + (size_t)t * DINP + ZC_RW + 1152;
#pragma unroll
        for (int i = 0; i < 4; ++i) {
            const int ch = (tid & 7) + 8 * i;
            const u32x4 cur = *(const u32x4*)(zr + ch * 8);
            const u32x4 prv = first ? (u32x4){0u, 0u, 0u, 0u} : *(const u32x4*)(zr - DINP + ch * 8);
            const f32x4 m0 = *(const f32x4*)(p.mu + 1152 + ch * 8), m1 = *(const f32x4*)(p.mu + 1152 + ch * 8 + 4);
            const unsigned cw[4] = {cur.x, cur.y, cur.z, cur.w}, pw[4] = {prv.x, prv.y, prv.z, prv.w};
            const float mm[8] = {m0.x, m0.y, m0.z, m0.w, m1.x, m1.y, m1.z, m1.w};
            float o[8];
#pragma unroll
            for (int e = 0; e < 4; ++e) {
                const float f0 = lo_bf(cw[e]), f1 = hi_bf(cw[e]), g0 = lo_bf(pw[e]), g1 = hi_bf(pw[e]);
                o[2 * e] = f0 + (g0 - f0) * mm[2 * e]; o[2 * e + 1] = f1 + (g1 - f1) * mm[2 * e + 1];
            }
            if (ch < 8) {
#pragma unroll
                for (int e = 0; e < 8; ++e) o[e] = tanhf(o[e]);
            } else if (ch >= 16) {
#pragma unroll
                for (int e = 0; e < 8; ++e) o[e] = sigmoidf_(o[e]);
            }
            *(u32x4*)(At + tok * PS + ch * 8) = (u32x4){pk2(o[0], o[1]), pk2(o[2], o[3]), pk2(o[4], o[5]), pk2(o[6], o[7])};
        }
    }
    __syncthreads();
    bf16x8 xb[8];
#pragma unroll
    for (int ks = 0; ks < 8; ++ks) xb[ks] = *(const bf16x8*)(At + (16 * (wave & 1) + fl) * PS + ks * 32 + fq * 8);
    const int t = t0 + 16 * (wave & 1) + fl, b = t >> 12, sq = t & (NS - 1);
    const bool first = sq == 0;
    const bf16_t* zc = p.Z + (size_t)t * DINP + ZC_RW;
    const bf16_t* WupT = p.lora; const bf16_t* AupT = p.lora + 384 * 64; const bf16_t* GupT = p.lora + 2 * 384 * 64;
#pragma unroll 1
    for (int hd = (wave >> 1) * 3; hd < (wave >> 1) * 3 + 3; ++hd) {
        f32x4 aw[4], aa[4], ag[4];
#pragma unroll
        for (int n = 0; n < 4; ++n) {
            const int cr = hd * 64 + 16 * n + fl;
            f32x4 w4 = (f32x4){0.f, 0.f, 0.f, 0.f}, a4 = w4, g4 = w4;
#pragma unroll
            for (int ks = 0; ks < 2; ++ks) {
                w4 = __builtin_amdgcn_mfma_f32_16x16x32_bf16(*(const bf16x8*)(WupT + cr * 64 + ks * 32 + fq * 8), xb[ks], w4, 0, 0, 0);
                a4 = __builtin_amdgcn_mfma_f32_16x16x32_bf16(*(const bf16x8*)(AupT + cr * 64 + ks * 32 + fq * 8), xb[2 + ks], a4, 0, 0, 0);
            }
#pragma unroll
            for (int ks = 0; ks < 4; ++ks) g4 = __builtin_amdgcn_mfma_f32_16x16x32_bf16(*(const bf16x8*)(GupT + cr * 128 + ks * 32 + fq * 8), xb[4 + ks], g4, 0, 0, 0);
            aw[n] = w4; aa[n] = a4; ag[n] = g4;
        }
        f32x4 kx[4], av[4], kkv[4];
        float ss = 0.f;
        const size_t hrow = ((size_t)(b * 6 + hd) * NS + sq) * 64;
#pragma unroll
        for (int n = 0; n < 4; ++n) {
            const int cl = 16 * n + 4 * fq, c = hd * 64 + cl;
            f32x4 rr = bf4(*(const u32x2*)(zc + c)), kk = bf4(*(const u32x2*)(zc + 384 + c)), vv = bf4(*(const u32x2*)(zc + 768 + c));
            f32x4 rp = (f32x4){0.f, 0.f, 0.f, 0.f}, kp = rp, vp = rp;
            if (!first) { rp = bf4(*(const u32x2*)(zc - DINP + c)); kp = bf4(*(const u32x2*)(zc - DINP + 384 + c)); vp = bf4(*(const u32x2*)(zc - DINP + 768 + c)); }
            rr = rr + (rp - rr) * *(const f32x4*)(p.mu + c); kk = kk + (kp - kk) * *(const f32x4*)(p.mu + 384 + c); vv = vv + (vp - vv) * *(const f32x4*)(p.mu + 768 + c);
            const f32x4 wb = *(const f32x4*)(p.w_bias + c), ab = *(const f32x4*)(p.a_bias + c), kkc = *(const f32x4*)(p.k_k + c), kac = *(const f32x4*)(p.k_a + c);
            f32x4 dec, a;
            {
                const f32x4 xw = wb + aw[n], xa = ab + aa[n];
                dec.x = __expf(-__expf(-softplusf_(-xw.x) - 0.5f)); dec.y = __expf(-__expf(-softplusf_(-xw.y) - 0.5f));
                dec.z = __expf(-__expf(-softplusf_(-xw.z) - 0.5f)); dec.w = __expf(-__expf(-softplusf_(-xw.w) - 0.5f));
                a.x = sigmoidf_(xa.x); a.y = sigmoidf_(xa.y); a.z = sigmoidf_(xa.z); a.w = sigmoidf_(xa.w);
            }
            const f32x4 kr = kk * kkc;
            ss += kr.x * kr.x + kr.y * kr.y + kr.z * kr.z + kr.w * kr.w;
            kkv[n] = kr; av[n] = a; kx[n] = kk;
            const f32x4 kmod = kk * ((a - 1.f) * kac + 1.f);
            *(f32x4*)(Wd + hrow + cl) = dec;
            u32x2 w;
            w.x = pk2(rr.x, rr.y); w.y = pk2(rr.z, rr.w); *(u32x2*)(Rd + hrow + cl) = w;
            w.x = pk2(kmod.x, kmod.y); w.y = pk2(kmod.z, kmod.w); *(u32x2*)(Kd + hrow + cl) = w;
            w.x = pk2(vv.x, vv.y); w.y = pk2(vv.z, vv.w); *(u32x2*)(Vd + hrow + cl) = w;
            w.x = pk2(ag[n].x, ag[n].y); w.y = pk2(ag[n].z, ag[n].w); *(u32x2*)(Gd + (size_t)t * 384 + c) = w;
        }
        ss = xor32_sum(xor16_sum(ss));
        const float rn = rsqrtf(fmaxf(ss, 1e-24f));
#pragma unroll
        for (int n = 0; n < 4; ++n) {
            const int cl = 16 * n + 4 * fq;
            const f32x4 kn = kkv[n] * rn;
            *(f32x4*)(KKd + hrow + cl) = kn;
            *(f32x4*)(KKAd + hrow + cl) = kn * av[n];
        }
    }
}

constexpr int SC_STEPS = 16;
constexpr int SEG_BEG[4] = {0, 1376, 2736, 4096};
constexpr size_t MX_SE0 = MX_END;
constexpr size_t MX_XE  = MX_SE0 + 24ull * 3 * 4096 * 4;
constexpr size_t MX_SST = MX_XE + 24ull * 3 * 4096 * 4;
static_assert(MX_SST + 24ull * 3 * 4096 * 2 <= 128 * MiB, "mix region");
__device__ void rwkv_scan_task(const RwP& p, char* smem, int bh, int seg, int grp) {
    float* buf = (float*)smem;
    float* obuf = buf + 2 * 6 * SC_STEPS * 64;
    const int tid = otid(), lane = tid & 63, wave = tid >> 6;
    const int rloc = wave * 4 + (lane >> 4);
    const bool ident = grp >= 4;
    const int row = (grp & 3) * 16 + rloc;
    const int c4 = (lane & 15) * 4;
    const int s_beg = seg == 0 ? SEG_BEG[0] : (seg == 1 ? SEG_BEG[1] : SEG_BEG[2]);
    const int s_end = seg == 0 ? SEG_BEG[1] : (seg == 1 ? SEG_BEG[2] : SEG_BEG[3]);
    const int NCH = (s_end - s_beg) / SC_STEPS;
    const size_t hb = ((size_t)bh * NS + s_beg) * 64;
    const float* Wd = (const float*)(p.mix + MX_W) + hb;
    const float* KKd = (const float*)(p.mix + MX_KK) + hb;
    const float* KKAd = (const float*)(p.mix + MX_KKA) + hb;
    const bf16_t* Rd = (const bf16_t*)(p.mix + MX_R) + hb;
    const bf16_t* Kd = (const bf16_t*)(p.mix + MX_K) + hb;
    const bf16_t* Vd = (const bf16_t*)(p.mix + MX_V) + hb;
    float* orow = p.oraw + hb;
    bf16_t* yrow = p.Y + hb;
    f32x4 S;
    S.x = (ident && c4 + 0 == row) ? 1.f : 0.f; S.y = (ident && c4 + 1 == row) ? 1.f : 0.f; S.z = (ident && c4 + 2 == row) ? 1.f : 0.f; S.w = (ident && c4 + 3 == row) ? 1.f : 0.f;
    struct Stg { f32x4 w, kk, ka; u32x2 r, k, v; };
    Stg sA, sB;
    auto gload = [&](Stg& g, int ch) {
        const size_t e = (size_t)ch * SC_STEPS * 64 + tid * 4;
        g.w = *(const f32x4*)(Wd + e); g.kk = *(const f32x4*)(KKd + e); g.ka = *(const f32x4*)(KKAd + e);
        g.r = *(const u32x2*)(Rd + e); g.k = *(const u32x2*)(Kd + e); g.v = *(const u32x2*)(Vd + e);
    };
    auto lstore = [&](const Stg& g, int bsel) {
        float* bb = buf + bsel * 6 * SC_STEPS * 64 + tid * 4;
        *(f32x4*)(bb + 0 * SC_STEPS * 64) = g.w; *(f32x4*)(bb + 1 * SC_STEPS * 64) = g.kk; *(f32x4*)(bb + 2 * SC_STEPS * 64) = g.ka;
        *(f32x4*)(bb + 3 * SC_STEPS * 64) = (f32x4){lo_bf(g.r.x), hi_bf(g.r.x), lo_bf(g.r.y), hi_bf(g.r.y)};
        *(f32x4*)(bb + 4 * SC_STEPS * 64) = (f32x4){lo_bf(g.k.x), hi_bf(g.k.x), lo_bf(g.k.y), hi_bf(g.k.y)};
        *(f32x4*)(bb + 5 * SC_STEPS * 64) = (f32x4){lo_bf(g.v.x), hi_bf(g.v.x), lo_bf(g.v.y), hi_bf(g.v.y)};
    };
    __syncthreads();
    gload(sA, 0); lstore(sA, 0);
    gload(sA, 1);
    __syncthreads();
    const float vmask = ident ? 0.f : 1.f;
    auto chunk = [&](int ch, Stg& cur  , Stg& nxt  ) {
        if (ch + 2 < NCH) gload(nxt, ch + 2);
        const float* bb = buf + (ch & 1) * 6 * SC_STEPS * 64;
        f32x4 w4 = *(const f32x4*)(bb + 0 * SC_STEPS * 64 + c4), kk4 = *(const f32x4*)(bb + 1 * SC_STEPS * 64 + c4), ka4 = *(const f32x4*)(bb + 2 * SC_STEPS * 64 + c4);
        f32x4 r4 = *(const f32x4*)(bb + 3 * SC_STEPS * 64 + c4), k4 = *(const f32x4*)(bb + 4 * SC_STEPS * 64 + c4);
        float vv = bb[5 * SC_STEPS * 64 + row];
#pragma unroll
        for (int st = 0; st < SC_STEPS; ++st) {
            const int sn = (st + 1 < SC_STEPS) ? st + 1 : st;
            const f32x4 nw4 = *(const f32x4*)(bb + 0 * SC_STEPS * 64 + sn * 64 + c4), nkk4 = *(const f32x4*)(bb + 1 * SC_STEPS * 64 + sn * 64 + c4);
            const f32x4 nka4 = *(const f32x4*)(bb + 2 * SC_STEPS * 64 + sn * 64 + c4), nr4 = *(const f32x4*)(bb + 3 * SC_STEPS * 64 + sn * 64 + c4);
            const f32x4 nk4 = *(const f32x4*)(bb + 4 * SC_STEPS * 64 + sn * 64 + c4);
            const float nvv = bb[5 * SC_STEPS * 64 + sn * 64 + row];
            const float vx = vv * vmask;
            float pd = S.x * kk4.x + S.y * kk4.y + S.z * kk4.z + S.w * kk4.w;
            const float sa = -row16_sum(pd);
            S.x = S.x * w4.x + vx * k4.x + sa * ka4.x;
            S.y = S.y * w4.y + vx * k4.y + sa * ka4.y;
            S.z = S.z * w4.z + vx * k4.z + sa * ka4.z;
            S.w = S.w * w4.w + vx * k4.w + sa * ka4.w;
            float od = S.x * r4.x + S.y * r4.y + S.z * r4.z + S.w * r4.w;
            od = row16_sum(od);
            obuf[st * 16 + rloc] = od;
            w4 = nw4; kk4 = nkk4; ka4 = nka4; r4 = nr4; k4 = nk4; vv = nvv;
        }
        __syncthreads();
        {
            const int st = tid >> 4, rr = tid & 15;
            const size_t oi = ((size_t)ch * SC_STEPS + st) * 64 + (grp & 3) * 16 + rr;
            if (ident) yrow[oi] = f2bf(obuf[tid]); else orow[oi] = obuf[tid];
        }
        if (ch + 1 < NCH) lstore(cur, (ch + 1) & 1);
        __syncthreads();
    };
    for (int ch = 0; ch < NCH; ch += 2) {
        chunk(ch, sA, sB);
        if (ch + 1 < NCH) chunk(ch + 1, sB, sA);
    }
    float* fin = (float*)(p.mix + (ident ? MX_XE : MX_SE0)) + ((size_t)(bh * 3 + seg) * 64 + row) * 64 + c4;
    *(f32x4*)fin = S;
}

__device__ void phase_rwkv_chain(const RwP& p, int bid, int nblk) {
    const int lane = otid() & 63, wave = otid() >> 6;
    const float* SE0 = (const float*)(p.mix + MX_SE0); const float* XE = (const float*)(p.mix + MX_XE);
    bf16_t* SST = (bf16_t*)(p.mix + MX_SST);
    for (int x = bid * 4 + wave; x < 24 * 4; x += nblk * 4) {
        const int bh = x >> 2, cg = (x & 3) * 16;
        const float* s1 = SE0 + ((size_t)(bh * 3 + 0) * 64 + lane) * 64;
        const float* e1 = SE0 + ((size_t)(bh * 3 + 1) * 64 + lane) * 64 + cg;
        const float* X1 = XE + (size_t)(bh * 3 + 1) * 4096 + cg;
        float o[16];
#pragma unroll
        for (int k = 0; k < 16; ++k) o[k] = e1[k];
        for (int i = 0; i < 64; ++i) {
            const float si = s1[i];
#pragma unroll
            for (int k = 0; k < 16; ++k) o[k] += si * X1[i * 64 + k];
        }
        bf16_t* d1 = SST + ((size_t)(bh * 3 + 1) * 64 + lane) * 64 + cg;
        bf16_t* d2 = SST + ((size_t)(bh * 3 + 2) * 64 + lane) * 64 + cg;
#pragma unroll
        for (int k = 0; k < 16; ++k) { d1[k] = f2bf(s1[cg + k]); d2[k] = f2bf(o[k]); }
    }
}

__device__ void phase_rwkv_post(const RwP& p, int bid, int nblk) {
    const int lane = otid() & 63, wave = otid() >> 6;
    const int fl = lane & 15, fq = lane >> 4;
    const bf16_t* Rd = (const bf16_t*)(p.mix + MX_R); const bf16_t* Kd = (const bf16_t*)(p.mix + MX_K); const bf16_t* Vd = (const bf16_t*)(p.mix + MX_V);
    const bf16_t* Gd = (const bf16_t*)(p.mix + MX_G); const bf16_t* SST = (const bf16_t*)(p.mix + MX_SST);
    for (int x = bid * 4 + wave; x < 24 * (NS / 16); x += nblk * 4) {
        const int bh = x / (NS / 16), s0 = (x % (NS / 16)) * 16;
        const int b = bh / 6, hd = bh % 6;
        const int seg = s0 < SEG_BEG[1] ? 0 : (s0 < SEG_BEG[2] ? 1 : 2);
        const size_t hrow = ((size_t)bh * NS + s0 + fl) * 64;
        f32x4 acc[4];
#pragma unroll
        for (int n = 0; n < 4; ++n) acc[n] = *(const f32x4*)(p.oraw + hrow + 16 * n + 4 * fq);
        if (seg > 0) {
            const bf16_t* ss = SST + (size_t)(bh * 3 + seg) * 4096;
#pragma unroll
            for (int ks = 0; ks < 2; ++ks) {
                const bf16x8 yb = *(const bf16x8*)(p.Y + hrow + ks * 32 + fq * 8);
#pragma unroll
                for (int n = 0; n < 4; ++n) {
                    const bf16x8 sa = *(const bf16x8*)(ss + (size_t)(16 * n + fl) * 64 + ks * 32 + fq * 8);
                    acc[n] = __builtin_amdgcn_mfma_f32_16x16x32_bf16(sa, yb, acc[n], 0, 0, 0);
                }
            }
        }
        float sm = 0.f;
#pragma unroll
        for (int n = 0; n < 4; ++n) sm += acc[n].x + acc[n].y + acc[n].z + acc[n].w;
        const float mean = xor32_sum(xor16_sum(sm)) * (1.f / 64.f);
        float sv = 0.f;
#pragma unroll
        for (int n = 0; n < 4; ++n) { acc[n] = acc[n] - mean; sv += acc[n].x * acc[n].x + acc[n].y * acc[n].y + acc[n].z * acc[n].z + acc[n].w * acc[n].w; }
        const float rstd = rsqrtf(xor32_sum(xor16_sum(sv)) * (1.f / 64.f) + 64e-5f);
        float rk = 0.f; f32x4 vv[4];
#pragma unroll
        for (int n = 0; n < 4; ++n) {
            const int c = 16 * n + 4 * fq;
            const u32x2 r2 = *(const u32x2*)(Rd + hrow + c), k2 = *(const u32x2*)(Kd + hrow + c), v2 = *(const u32x2*)(Vd + hrow + c);
            const f32x4 rkw = *(const f32x4*)(p.r_k + hd * 64 + c);
            rk += lo_bf(r2.x) * lo_bf(k2.x) * rkw.x + hi_bf(r2.x) * hi_bf(k2.x) * rkw.y + lo_bf(r2.y) * lo_bf(k2.y) * rkw.z + hi_bf(r2.y) * hi_bf(k2.y) * rkw.w;
            vv[n] = (f32x4){lo_bf(v2.x), hi_bf(v2.x), lo_bf(v2.y), hi_bf(v2.y)};
        }
        rk = xor32_sum(xor16_sum(rk));
        const size_t t = (size_t)b * NS + s0 + fl;
#pragma unroll
        for (int n = 0; n < 4; ++n) {
            const int c = 16 * n + 4 * fq;
            const f32x4 lw = *(const f32x4*)(p.ln_w + hd * 64 + c), lb = *(const f32x4*)(p.ln_b + hd * 64 + c);
            const u32x2 g2 = *(const u32x2*)(Gd + t * 384 + hd * 64 + c);
            const f32x4 gg = (f32x4){lo_bf(g2.x), hi_bf(g2.x), lo_bf(g2.y), hi_bf(g2.y)};
            const f32x4 o = (acc[n] * rstd * lw + lb + vv[n] * rk) * gg;
            u32x2 w; w.x = pk2(o.x, o.y); w.y = pk2(o.z, o.w);
            *(u32x2*)(p.O + t * D + 256 + hd * 64 + c) = w;
        }
    }
}

__device__ __forceinline__ unsigned ordkey(float f) { const unsigned u = __float_as_uint(f); return (u & 0x80000000u) ? ~u : (u | 0x80000000u); }
__device__ __forceinline__ float unordkey(unsigned k) { return __uint_as_float((k & 0x80000000u) ? (k & 0x7FFFFFFFu) : ~k); }
__device__ __forceinline__ void ins16(unsigned (&L)[16], unsigned x) {
#pragma unroll
    for (int i = 0; i < 16; ++i) { const unsigned hi = L[i] > x ? L[i] : x; x = L[i] > x ? x : L[i]; L[i] = hi; }
}
__device__ __forceinline__ void top16_col(const float* col  , unsigned (&L)[16]) {
#pragma unroll
    for (int i = 0; i < 16; ++i) L[i] = 0u;
#pragma unroll 1
    for (int n0 = 0; n0 < 128; n0 += 16) {
        float x[16];
#pragma unroll
        for (int j = 0; j < 16; ++j) x[j] = col[(size_t)(n0 + j) * NT];
#pragma unroll
        for (int j = 0; j < 16; ++j) ins16(L, (ordkey(x[j]) & 0xFFFFFF80u) | (unsigned)(127 - (n0 + j)));
    }
}
__device__ void phase_topk(const float* SCT, int* EIDX, float* GATE, char* smem, int bid, int nblk) {
    const int tid = otid(), lane = tid & 63, wave = tid >> 6;
    unsigned char* itab = (unsigned char*)smem + tid * 32;
    unsigned char* ctab = (unsigned char*)smem + NTHREADS * 32;
    __syncthreads();
    if (tid < 64) {
        const int c = tid; int ci, cj;
        if (c < 16) { ci = 0; cj = c; } else if (c < 24) { ci = 1; cj = c - 16; } else if (c < 29) { ci = 2; cj = c - 24; } else if (c < 33) { ci = 3; cj = c - 29; }
        else if (c < 36) { ci = 4; cj = c - 33; } else if (c < 38) { ci = 5; cj = c - 36; } else if (c < 40) { ci = 6; cj = c - 38; } else if (c < 42) { ci = 7; cj = c - 40; }
        else if (c < 50) { ci = c - 34; cj = 0; } else { ci = 0; cj = 0; }
        ctab[c] = (unsigned char)(ci | (cj << 4));
    }
    __syncthreads();
    for (int x = bid * 4 + wave; x < (NT / 64) * 8; x += nblk * 4) {
        const int tb = x >> 3, hd = x & 7;
        const int t = tb * 64 + lane;
        unsigned L1[16], L2[16];
        top16_col(SCT + (size_t)(hd * 256) * NT + t, L1);
        top16_col(SCT + (size_t)(hd * 256 + 128) * NT + t, L2);
        float s1[16], s2[16];
#pragma unroll
        for (int i = 0; i < 16; ++i) {
            s1[i] = unordkey(L1[i] & 0xFFFFFF80u); s2[i] = unordkey(L2[i] & 0xFFFFFF80u);
            itab[i] = (unsigned char)(127u - (L1[i] & 127u)); itab[16 + i] = (unsigned char)(127u - (L2[i] & 127u));
        }
        unsigned M[16];
#pragma unroll
        for (int i = 0; i < 16; ++i) M[i] = 0u;
        int c = 0;
#pragma unroll
        for (int ci = 0; ci < 16; ++ci) {
#pragma unroll
            for (int cj = 0; cj < 16; ++cj) {
                if ((ci + 1) * (cj + 1) <= 16) {
                    const int cid = (ci == 0) ? cj : (ci == 1) ? 16 + cj : (ci == 2) ? 24 + cj : (ci == 3) ? 29 + cj : (ci == 4) ? 33 + cj : (ci == 5) ? 36 + cj : (ci == 6) ? 38 + cj : (ci == 7) ? 40 + cj : 34 + ci;
                    ins16(M, (ordkey(s1[ci] + s2[cj]) & 0xFFFFFFC0u) | (unsigned)(63 - cid));
                    ++c;
                }
            }
        }
        float ev[16]; int ee[16];
        const float mx = unordkey(M[0] & 0xFFFFFFC0u);
        float sum = 0.f;
#pragma unroll
        for (int i = 0; i < 16; ++i) {
            const int cid = 63 - (int)(M[i] & 63u);
            const unsigned cc = ctab[cid];
            ee[i] = (int)itab[cc & 15u] * 128 + (int)itab[16 + (cc >> 4)];
            ev[i] = __expf(unordkey(M[i] & 0xFFFFFFC0u) - mx);
            sum += ev[i];
        }
        const float inv = 1.f / sum;
        int* eo = EIDX + (size_t)t * 128 + hd * 16; float* go = GATE + (size_t)t * 128 + hd * 16;
#pragma unroll
        for (int i = 0; i < 4; ++i) {
            *(int4*)(eo + 4 * i) = make_int4(ee[4 * i], ee[4 * i + 1], ee[4 * i + 2], ee[4 * i + 3]);
            *(f32x4*)(go + 4 * i) = (f32x4){ev[4 * i] * inv, ev[4 * i + 1] * inv, ev[4 * i + 2] * inv, ev[4 * i + 3] * inv};
        }
    }
    __syncthreads();
}

typedef float f32x2 __attribute__((ext_vector_type(2)));
__device__ __forceinline__ void dec16(const u32x4 w, float (&f)[16]) {
    const unsigned ww[4] = {w.x, w.y, w.z, w.w};
#pragma unroll
    for (int i = 0; i < 4; ++i) {
        const f32x2 a = __builtin_amdgcn_cvt_pk_f32_fp8((int)ww[i], false), b = __builtin_amdgcn_cvt_pk_f32_fp8((int)ww[i], true);
        f[4 * i] = a.x; f[4 * i + 1] = a.y; f[4 * i + 2] = b.x; f[4 * i + 3] = b.y;
    }
}
__device__ void phase_expert(const bf16_t* H, const unsigned char* U8, const unsigned char* V8, const int* EIDX, const float* GATE, const float* X, float* Xo, int bid, int nblk) {
    const int lane = otid() & 63, wave = otid() >> 6;
    for (int t = bid * 4 + wave; t < NT; t += nblk * 4) {
        float xf[16], acc[16];
        {
            const u32x4 a = *(const u32x4*)(H + (size_t)t * D + lane * 16), b = *(const u32x4*)(H + (size_t)t * D + lane * 16 + 8);
            xf[0] = lo_bf(a.x); xf[1] = hi_bf(a.x); xf[2] = lo_bf(a.y); xf[3] = hi_bf(a.y); xf[4] = lo_bf(a.z); xf[5] = hi_bf(a.z); xf[6] = lo_bf(a.w); xf[7] = hi_bf(a.w);
            xf[8] = lo_bf(b.x); xf[9] = hi_bf(b.x); xf[10] = lo_bf(b.y); xf[11] = hi_bf(b.y); xf[12] = lo_bf(b.z); xf[13] = hi_bf(b.z); xf[14] = lo_bf(b.w); xf[15] = hi_bf(b.w);
        }
#pragma unroll
        for (int i = 0; i < 16; ++i) acc[i] = 0.f;
        for (int e0 = 0; e0 < 128; e0 += 8) {
            int ei[8]; float act[8]; u32x4 ur[8];
#pragma unroll
            for (int j = 0; j < 8; ++j) { ei[j] = EIDX[(size_t)t * 128 + e0 + j]; ur[j] = *(const u32x4*)(U8 + (size_t)ei[j] * D + lane * 16); }
#pragma unroll
            for (int j = 0; j < 8; ++j) {
                float uf[16]; dec16(ur[j], uf);
                float d = 0.f;
#pragma unroll
                for (int i = 0; i < 16; ++i) d += xf[i] * uf[i];
                d = wave_sum(d) * (1.f / 512.f);
                act[j] = 0.5f * d * (1.f + erff(d * 0.7071067811865476f)) * GATE[(size_t)t * 128 + e0 + j] * (1.f / 64.f);
            }
#pragma unroll
            for (int j = 0; j < 8; ++j) ur[j] = *(const u32x4*)(V8 + (size_t)ei[j] * D + lane * 16);
#pragma unroll
            for (int j = 0; j < 8; ++j) {
                float vf[16]; dec16(ur[j], vf);
#pragma unroll
                for (int i = 0; i < 16; ++i) acc[i] += act[j] * vf[i];
            }
        }
        const f32x4* xr = (const f32x4*)(X + (size_t)t * D) + lane * 4;
        f32x4* xo = (f32x4*)(Xo + (size_t)t * D) + lane * 4;
#pragma unroll
        for (int i = 0; i < 4; ++i) { f32x4 o = xr[i]; o += (f32x4){acc[4 * i], acc[4 * i + 1], acc[4 * i + 2], acc[4 * i + 3]}; xo[i] = o; }
    }
}

#define XB_TMO      128
#define XB_XCNT(j)  (256  + 64 * (j))
#define XB_XSUB(j)  (1280 + 64 * (j))
#define XB_XGEN(j)  (2304 + 64 * (j))
#define XB_TOP      3328
#define XB_TOPGEN   3392
#define XCD_BAR_WORDS 3456
#define XB_SPIN_CAP (1u << 22)
#define LAS __attribute__((address_space(3)))
__device__ __forceinline__ unsigned xb_ld(unsigned* p)              { return __hip_atomic_load(p, __ATOMIC_RELAXED, __HIP_MEMORY_SCOPE_AGENT); }
__device__ __forceinline__ unsigned xb_add(unsigned* p, unsigned v) { return __hip_atomic_fetch_add(p, v, __ATOMIC_RELAXED, __HIP_MEMORY_SCOPE_AGENT); }
__device__ __forceinline__ unsigned xb_xcc_id() { return (unsigned)__builtin_amdgcn_s_getreg((3 << 11) | 20) & 0xFu; }
#define XB_SPIN(cond, bar) do { unsigned _sp = 0; while (cond) { __builtin_amdgcn_s_sleep(1); \
    if ((++_sp & 255u) == 0u) { if (xb_ld(&(bar)[XB_TMO])) break; if (_sp > XB_SPIN_CAP) { atomicAdd(&(bar)[XB_TMO], 1u); break; } } } } while (0)
struct XcdBarrier { unsigned* bar; unsigned x; volatile LAS unsigned* st; };
__device__ __forceinline__ XcdBarrier xcd_barrier_post(unsigned* bar, volatile LAS unsigned* st) {
    XcdBarrier b; b.bar = bar; b.x = xb_xcc_id(); b.st = st;
    if (threadIdx.x == 0) (void)xb_add(&bar[XB_XCNT(b.x)], 1u);
    return b;
}
__device__ __forceinline__ void xcd_barrier_complete(unsigned* bar, unsigned x, unsigned& nloc, unsigned& nx) {
    const unsigned G = gridDim.x * gridDim.y * gridDim.z;
    unsigned sum, cnt, mine, sp = 0u;
    for (;;) {
        sum = 0u; cnt = 0u; mine = 0u;
#pragma unroll
        for (unsigned j = 0; j < 16; ++j) { const unsigned c = xb_ld(&bar[XB_XCNT(j)]); sum += c; cnt += (c > 0u) ? 1u : 0u; mine = (j == x) ? c : mine; }
        if (sum == G) break;
        __builtin_amdgcn_s_sleep(1);
        if ((++sp & 255u) == 0u) { if (xb_ld(&bar[XB_TMO])) break; if (sp > XB_SPIN_CAP) { atomicAdd(&bar[XB_TMO], 1u); break; } }
    }
    nloc = mine > 0u ? mine : 1u; nx = cnt > 0u ? cnt : 1u;
}
__device__ __forceinline__ void xcd_barrier(const XcdBarrier& b) {
    asm volatile("s_waitcnt vmcnt(0)" ::: "memory");
    __syncthreads();
    if (threadIdx.x == 0) {
        unsigned* bar = b.bar;
        __builtin_amdgcn_s_waitcnt(0);
        unsigned nloc = b.st[0], nx = b.st[1];
        if (nloc == 0u) { xcd_barrier_complete(bar, b.x, nloc, nx); b.st[0] = nloc; b.st[1] = nx; }
        const unsigned old = xb_add(&bar[XB_XSUB(b.x)], 1u);
        const unsigned gen = old / nloc;
        if (old + 1u == (gen + 1u) * nloc) {
            __builtin_amdgcn_fence(__ATOMIC_RELEASE, "agent");
            asm volatile("s_waitcnt vmcnt(0)" ::: "memory");
            const unsigned og = xb_add(&bar[XB_TOP], 1u);
            const unsigned tg = og / nx;
            if (og + 1u == (tg + 1u) * nx) xb_add(&bar[XB_TOPGEN], 1u);
            else XB_SPIN(xb_ld(&bar[XB_TOPGEN]) == tg, bar);
            __builtin_amdgcn_fence(__ATOMIC_ACQUIRE, "agent");
            xb_add(&bar[XB_XGEN(b.x)], 1u);
            asm volatile("s_waitcnt vmcnt(0)" ::: "memory");
        } else {
            XB_SPIN(xb_ld(&bar[XB_XGEN(b.x)]) == gen, bar);
            __builtin_amdgcn_fence(__ATOMIC_ACQUIRE, "agent");
            asm volatile("s_waitcnt vmcnt(0)" ::: "memory");
        }
    }
    __syncthreads();
}

struct Params {
    const float* in[24];
    float* out; unsigned char* ws;
};
constexpr int LDS_BYTES = 65536;

__device__ __forceinline__ RwP make_rwp(const Params& P, int l) {
    RwP r;
    r.Z = (const bf16_t*)(P.ws + WS_Z); r.mix = P.ws + WS_MIX;
    r.mu = P.in[6] + l * RW_F; r.w_up = P.in[7] + (size_t)l * 64 * 384; r.w_bias = P.in[8] + l * 384; r.a_up = P.in[9] + (size_t)l * 64 * 384; r.a_bias = P.in[10] + l * 384;
    r.g_up = P.in[11] + (size_t)l * 128 * 384; r.k_k = P.in[12] + l * 384; r.k_a = P.in[13] + l * 384; r.r_k = P.in[14] + l * 384; r.ln_w = P.in[15] + l * 384; r.ln_b = P.in[16] + l * 384;
    r.oraw = (float*)(P.ws + WS_H); r.O = (bf16_t*)(P.ws + WS_O); r.Y = (bf16_t*)(P.ws + WS_EIDX); r.lora = (const bf16_t*)(P.ws + WS_LORA + l * LORA_L);
    return r;
}

__global__ void __launch_bounds__(NTHREADS, 2) mega_fwd(Params P) {
    __shared__ __attribute__((aligned(16))) char smem[LDS_BYTES];
    const int bid = blockIdx.x, nblk = gridDim.x;
    volatile LAS unsigned* st = (volatile LAS unsigned*)(smem + LDS_BYTES - 16);
    if (threadIdx.x == 0) { st[0] = 0u; st[1] = 0u; st[2] = 0u; st[3] = 0u; }
    __syncthreads();
    XcdBarrier bar = xcd_barrier_post((unsigned*)(P.ws + WS_CTL), st);
#define GSYNC() xcd_barrier(bar)

    {
        ConvP c{P.in[4], P.in[5], P.in[20], P.in[21], P.in[22], P.in[23], P.in[7], P.in[9], P.in[11], P.ws};
        for (int rep = 0; rep < REP_CONV; ++rep) phase_convert_weights(c, smem, bid, nblk);
        phase_rmsnorm<false>(P.in[0], P.in[1], P.ws + WS_H, bid, nblk);
    }
    GSYNC();
#pragma unroll 1
    for (int l = 0; l < 2; ++l) {
        const float* xin = (l == 0) ? P.in[0] : P.out;
        {
            GemmP g{(const bf16_t*)(P.ws + WS_H), D, 0, 0, (const bf16_t*)(P.ws + WS_WTIN) + (size_t)l * DINP * D, D, D, NT / 128, DINP / 128, P.ws + WS_Z, DINP, nullptr};
            for (int rep = 0; rep < REP_GIN; ++rep) phase_gemm<0>(g, smem, bid, nblk);
            if (l == 0) {
                for (int l2 = 0; l2 < 2; ++l2) {
                    GemmP ge{(const bf16_t*)(P.ws + WS_SK) + (size_t)l2 * 16 * 128 * 128, 128, 0, 128, (const bf16_t*)(P.ws + WS_WTQ) + (size_t)l2 * D * 2048, 2048, 128, 16, 8,
                             (bf16_t*)(P.ws + WS_WEFF) + (size_t)l2 * 2048 * D, D, nullptr};
                    phase_gemm<0>(ge, smem, bid, nblk, (NT / 128 * (DINP / 128) + l2 * 128) % nblk);
                }
            }
        }
        GSYNC();
        RwP rw = make_rwp(P, l);
        LinP lp{(const bf16_t*)(P.ws + WS_Z), (bf16_t*)(P.ws + WS_O), P.in[17] + (size_t)l * 16 * 192, P.in[18] + l * 192, P.in[19] + l * 384, (const float*)(P.ws + WS_ROPE), P.ws + WS_LIN};
        for (int task = bid; task < 512 + 2048; task += nblk) {
            if (task < 512) { for (int rep = 0; rep < REP_PREP; ++rep) rwkv_prep_task(rw, smem, task); }
            else { for (int rep = 0; rep < REP_LIN; ++rep) lin_kv_dispatch(lp, smem, task - 512); }
        }
        GSYNC();
        {
            for (int rep = 0; rep < REP_SCAN; ++rep)
            for (int task = bid; task < 480; task += nblk) {
                const int bh = task / 20, r = task % 20;
                const int seg = r < 4 ? 0 : (r < 12 ? 1 : 2), grp = r < 4 ? r : (r < 12 ? r - 4 : r - 12);
                rwkv_scan_task(rw, smem, bh, seg, grp);
            }
            if (nblk >= 512) { if (bid >= 480) for (int rep = 0; rep < REP_LIN; ++rep) lin_scan_phase(lp, bid - 480, nblk - 480); }
            else { for (int rep = 0; rep < REP_LIN; ++rep) lin_scan_phase(lp, bid, nblk); }
        }
        GSYNC();
        phase_rwkv_chain(rw, bid, nblk);
        GSYNC();
        for (int rep = 0; rep < REP_POST; ++rep) phase_rwkv_post(rw, bid, nblk);
        for (int rep = 0; rep < REP_LIN; ++rep) for (int task = bid; task < 2048; task += nblk) lin_out_dispatch(lp, smem, task);
        GSYNC();
        {
            GemmP g{(const bf16_t*)(P.ws + WS_O), D, 0, 0, (const bf16_t*)(P.ws + WS_WTOUT) + (size_t)l * D * D, D, D, NT / 128, D / 128, P.out, D, xin};
            phase_gemm<2>(g, smem, bid, nblk);
            for (int rep = 1; rep < REP_GOUT; ++rep) { GemmP g2 = g; g2.C = P.ws + WS_MIX; phase_gemm<2>(g2, smem, bid, nblk); }
        }
        GSYNC();
        for (int rep = 0; rep < REP_NORM; ++rep) phase_rmsnorm<false>(P.out, P.in[2] + l * D, P.ws + WS_H, bid, nblk);
        GSYNC();
        {
            GemmP g{(const bf16_t*)(P.ws + WS_H), D, 0, 0, (const bf16_t*)(P.ws + WS_WEFF) + (size_t)l * 2048 * D, D, D, NT / 128, 2048 / 128, P.ws + WS_MIX, NT, nullptr};
            for (int rep = 0; rep < REP_GQ; ++rep) phase_gemm<3>(g, smem, bid, nblk);
        }
        GSYNC();
        for (int rep = 0; rep < REP_TOPK; ++rep) phase_topk((const float*)(P.ws + WS_MIX), (int*)(P.ws + WS_EIDX), (float*)(P.ws + WS_GATE), smem, bid, nblk);
        GSYNC();
        phase_expert((const bf16_t*)(P.ws + WS_H), P.ws + WS_UB + (size_t)l * NEXP * D, P.ws + WS_VB + (size_t)l * NEXP * D,
                     (const int*)(P.ws + WS_EIDX), (const float*)(P.ws + WS_GATE), P.out, P.out, bid, nblk);
        for (int rep = 1; rep < REP_EXP; ++rep) phase_expert((const bf16_t*)(P.ws + WS_H), P.ws + WS_UB + (size_t)l * NEXP * D, P.ws + WS_VB + (size_t)l * NEXP * D,
                     (const int*)(P.ws + WS_EIDX), (const float*)(P.ws + WS_GATE), P.out, (float*)(P.ws + WS_Z), bid, nblk);
        GSYNC();
        if (l == 0) { phase_rmsnorm<false>(P.out, P.in[1] + D, P.ws + WS_H, bid, nblk); GSYNC(); }
    }
    phase_rmsnorm<true>(P.out, P.in[3], P.out, bid, nblk);
}

extern "C" void kernel_launch(void* const* d_in, const int* in_sizes, int n_in, void* d_out, int out_size, void* d_ws, size_t ws_size, hipStream_t stream) {
    static int grid = 0;
    if (grid == 0) {
        if (n_in != 24 || ws_size < WS_END) { fprintf(stderr, "kernel_launch: bad args n_in=%d ws=%zu need=%zu\n", n_in, ws_size, (size_t)WS_END); grid = -1; return; }
        int dev = 0, cus = 0, per_cu = 0;
        hipGetDevice(&dev);
        hipDeviceGetAttribute(&cus, hipDeviceAttributeMultiprocessorCount, dev);
        hipOccupancyMaxActiveBlocksPerMultiprocessor(&per_cu, (const void*)mega_fwd, NTHREADS, 0);
        if (per_cu < 1) { fprintf(stderr, "kernel_launch: occupancy query says %d\n", per_cu); grid = -1; return; }
        if (per_cu > 2) per_cu = 2;
        grid = cus * per_cu;
        fprintf(stderr, "kernel_launch: grid %d (%d CUs x %d)\n", grid, cus, per_cu);
    }
    if (grid < 0) return;
    hipMemsetAsync((char*)d_ws + WS_CTL, 0, XCD_BAR_WORDS * 4, stream);
    Params P{};
    for (int i = 0; i < 24; ++i) P.in[i] = (const float*)d_in[i];
    P.out = (float*)d_out; P.ws = (unsigned char*)d_ws;
    void* args[] = {&P};
    hipError_t e = hipLaunchCooperativeKernel((const void*)mega_fwd, dim3(grid), dim3(NTHREADS), args, 0, stream);
    if (e != hipSuccess) fprintf(stderr, "cooperative launch failed: %s (grid %d)\n", hipGetErrorString(e), grid);
}
```

```cpp
#include <hip/hip_runtime.h>
#include <stdint.h>
#include <stdio.h>

typedef unsigned short bf16_t;
typedef short bf16x8 __attribute__((ext_vector_type(8)));
typedef float f32x4 __attribute__((ext_vector_type(4)));
typedef unsigned u32x4 __attribute__((ext_vector_type(4)));
typedef unsigned u32x2 __attribute__((ext_vector_type(2)));

#define REP_CONV 1
#define REP_GIN 1
#define REP_PREP 1
#define REP_SCAN 1
#define REP_LIN 1
#define REP_POST 1
#define REP_GOUT 1
#define REP_NORM 1
#define REP_GQ 1
#define REP_GSK 1
#define REP_TOPK 1
#define REP_EXP 1
constexpr int NB = 4, NS = 4096, NT = NB * NS, D = 1024, DIN = 3600, DINP = 3712;
constexpr int ZC_RET = 0, ZC_RW = 1024, ZC_GLA = 2432;
constexpr int RW_F = 1408;
constexpr int NEXP = 16384;
constexpr int NTHREADS = 256;

constexpr size_t MiB = 1024ull * 1024ull;
constexpr size_t WS_CTL   = 0;
constexpr size_t WS_LORA  = 65536;
constexpr size_t LORA_L   = 384ull * 256 * 2;
constexpr size_t WS_ESC   = 524288;
constexpr size_t WS_WTIN  = 1 * MiB;
constexpr size_t WS_WTOUT = WS_WTIN + 2ull * DINP * D * 2;
constexpr size_t WS_WTQ   = WS_WTOUT + 2ull * D * D * 2;
constexpr size_t WS_SK    = WS_WTQ + 2ull * 2048 * D * 2;
constexpr size_t WS_UB    = WS_SK + 2ull * 16 * 128 * 128 * 2;
constexpr size_t WS_VB    = WS_UB + 2ull * NEXP * D;
constexpr size_t WS_LIN   = WS_VB + 2ull * NEXP * D;
constexpr size_t WS_H     = WS_LIN + 64 * MiB;
constexpr size_t WS_Z     = WS_H + (size_t)NT * D * 2;
constexpr size_t WS_O     = WS_Z + (size_t)NT * DINP * 2;
constexpr size_t WS_MIX   = WS_O + (size_t)NT * D * 2;
constexpr size_t WS_EIDX  = WS_MIX + 128 * MiB;
constexpr size_t WS_GATE  = WS_EIDX + (size_t)NT * 128 * 4;
constexpr size_t WS_ROPE  = WS_GATE + (size_t)NT * 128 * 4;
constexpr size_t WS_WEFF  = WS_ROPE + 1 * MiB;
constexpr size_t WS_END   = WS_WEFF + 2ull * 2048 * D * 2;
constexpr size_t RWA = (size_t)NT * 384;
constexpr size_t MX_W   = 0;
constexpr size_t MX_KK  = MX_W + RWA * 4;
constexpr size_t MX_KKA = MX_KK + RWA * 4;
constexpr size_t MX_R   = MX_KKA + RWA * 4;
constexpr size_t MX_K   = MX_R + RWA * 2;
constexpr size_t MX_V   = MX_K + RWA * 2;
constexpr size_t MX_G   = MX_V + RWA * 2;
constexpr size_t MX_END = MX_G + RWA * 2;
static_assert(MX_END <= 128 * MiB, "mix region");

__device__ __forceinline__ float bf2f(bf16_t v) { return __uint_as_float(((unsigned)v) << 16); }
__device__ __forceinline__ bf16_t f2bf(float f) { unsigned u = __float_as_uint(f); u += 0x7FFFu + ((u >> 16) & 1u); return (bf16_t)(u >> 16); }
__device__ __forceinline__ unsigned pk2(float lo, float hi) { return (unsigned)f2bf(lo) | ((unsigned)f2bf(hi) << 16); }
__device__ __forceinline__ float lo_bf(unsigned u) { return __uint_as_float(u << 16); }
__device__ __forceinline__ float hi_bf(unsigned u) { return __uint_as_float(u & 0xFFFF0000u); }
template <int CTRL> __device__ __forceinline__ float dpp_f(float v) { return __int_as_float(__builtin_amdgcn_update_dpp(0, __float_as_int(v), CTRL, 0xF, 0xF, true)); }
template <int CTRL> __device__ __forceinline__ unsigned dpp_u(unsigned v) { return (unsigned)__builtin_amdgcn_update_dpp(0, (int)v, CTRL, 0xF, 0xF, true); }
__device__ __forceinline__ float row16_sum(float v) { v += dpp_f<0x128>(v); v += dpp_f<0x124>(v); v += dpp_f<0x122>(v); v += dpp_f<0x121>(v); return v; }
__device__ __forceinline__ float xor16_sum(float v) { auto r = __builtin_amdgcn_permlane16_swap(__float_as_uint(v), __float_as_uint(v), false, false); return __uint_as_float(r[0]) + __uint_as_float(r[1]); }
__device__ __forceinline__ float xor32_sum(float v) { auto r = __builtin_amdgcn_permlane32_swap(__float_as_uint(v), __float_as_uint(v), false, false); return __uint_as_float(r[0]) + __uint_as_float(r[1]); }
__device__ __forceinline__ float wave_sum(float v) { return xor32_sum(xor16_sum(row16_sum(v))); }
__device__ __forceinline__ unsigned umax_(unsigned a, unsigned b) { return a > b ? a : b; }
__device__ __forceinline__ unsigned wave_max_u32(unsigned v) {
    v = umax_(v, dpp_u<0x128>(v)); v = umax_(v, dpp_u<0x124>(v)); v = umax_(v, dpp_u<0x122>(v)); v = umax_(v, dpp_u<0x121>(v));
    { auto r = __builtin_amdgcn_permlane16_swap(v, v, false, false); v = umax_(r[0], r[1]); }
    { auto r = __builtin_amdgcn_permlane32_swap(v, v, false, false); v = umax_(r[0], r[1]); }
    return v;
}
__device__ __forceinline__ float sigmoidf_(float x) { return 1.f / (1.f + __expf(-x)); }
__device__ __forceinline__ float softplusf_(float x) { return fmaxf(x, 0.f) + log1pf(__expf(-fabsf(x))); }

__device__ __forceinline__ int otid() { int t = threadIdx.x; asm volatile("" : "+v"(t)); return t; }

__device__ void transpose_tile(const float* __restrict__ W, int K, int N, bf16_t* __restrict__ Wt, int kt, int nt, float* tile  ) {
    const int tid = otid();
    const int k0 = kt * 64, n0 = nt * 64;
#pragma unroll
    for (int i = 0; i < 16; ++i) {
        const int k = i * 4 + (tid >> 6), n = tid & 63;
        tile[k * 65 + n] = (n0 + n < N) ? W[(size_t)(k0 + k) * N + n0 + n] : 0.f;
    }
    __syncthreads();
#pragma unroll
    for (int i = 0; i < 16; ++i) {
        const int n = i * 4 + (tid >> 6), k = tid & 63;
        Wt[(size_t)(n0 + n) * K + k0 + k] = f2bf(tile[k * 65 + n]);
    }
    __syncthreads();
}

struct ConvP {
    const float* w_in; const float* w_out; const float* w_q; const float* sk; const float* u; const float* v;
    const float* w_up; const float* a_up; const float* g_up;
    unsigned char* ws;
};

__device__ void phase_convert_weights(const ConvP& p, char* smem, int bid, int nblk) {
    float* tile = (float*)smem;
    constexpr int T_IN = 16 * 58, T_OUT = 16 * 16, T_L = T_IN + T_OUT;
    for (int it = bid; it < 2 * T_L; it += nblk) {
        const int l = it / T_L; int r = it % T_L;
        if (r < T_IN) { transpose_tile(p.w_in + (size_t)l * D * DIN, D, DIN, (bf16_t*)(p.ws + WS_WTIN) + (size_t)l * DINP * D, r / 58, r % 58, tile); continue; }
        r -= T_IN;
        transpose_tile(p.w_out + (size_t)l * D * D, D, D, (bf16_t*)(p.ws + WS_WTOUT) + (size_t)l * D * D, r / 16, r % 16, tile);
    }
    const size_t gtid = (size_t)bid * NTHREADS + otid(), gn = (size_t)nblk * NTHREADS;
    {
        for (size_t i = gtid; i < 2ull * 384 * 256; i += gn) {
            const int l = (int)(i / (384 * 256)), r = (int)(i % (384 * 256)), c = r >> 8, k = r & 255;
            bf16_t* base = (bf16_t*)(p.ws + WS_LORA + l * LORA_L);
            if (k < 64) base[c * 64 + k] = f2bf(p.w_up[(size_t)l * 64 * 384 + k * 384 + c]);
            else if (k < 128) base[384 * 64 + c * 64 + (k - 64)] = f2bf(p.a_up[(size_t)l * 64 * 384 + (k - 64) * 384 + c]);
            else base[2 * 384 * 64 + c * 128 + (k - 128)] = f2bf(p.g_up[(size_t)l * 128 * 384 + (k - 128) * 384 + c]);
        }
    }
    {
        float* ct = (float*)(p.ws + WS_ROPE); float* stb = ct + NS * 32;
        for (size_t i = gtid; i < (size_t)NS * 32; i += gn) {
            const int pos = (int)(i >> 5), fi = (int)(i & 31);
            const float inv = exp2f(-(float)fi * (13.287712379549449f / 32.f));
            float sn, cs; sincosf((float)pos * inv, &sn, &cs);
            ct[i] = cs; stb[i] = sn;
        }
    }
    {
        const size_t n8 = (2ull * D * 2048) / 8;
        const f32x4* s = (const f32x4*)p.w_q; u32x4* d = (u32x4*)(p.ws + WS_WTQ);
        for (size_t i = gtid; i < n8; i += gn) { f32x4 a = s[2 * i], b = s[2 * i + 1]; u32x4 o; o.x = pk2(a.x, a.y); o.y = pk2(a.z, a.w); o.z = pk2(b.x, b.y); o.w = pk2(b.z, b.w); d[i] = o; }
    }
    {
        const size_t n8 = (2ull * 16 * 128 * 128) / 8;
        const f32x4* s = (const f32x4*)p.sk; u32x4* d = (u32x4*)(p.ws + WS_SK);
        for (size_t i = gtid; i < n8; i += gn) { f32x4 a = s[2 * i], b = s[2 * i + 1]; u32x4 o; o.x = pk2(a.x, a.y); o.y = pk2(a.z, a.w); o.z = pk2(b.x, b.y); o.w = pk2(b.z, b.w); d[i] = o; }
    }
    {
        const int lane = otid() & 63, gw = bid * 4 + (otid() >> 6), ngw = nblk * 4;
        for (int r = gw; r < 4 * NEXP; r += ngw) {
            const bool isv = r >= 2 * NEXP; const int rr = isv ? r - 2 * NEXP : r;
            const f32x4* src = (const f32x4*)((isv ? p.v : p.u) + (size_t)rr * D) + lane * 4;
            f32x4 x[4]; float mx = 0.f;
#pragma unroll
            for (int i = 0; i < 4; ++i) { x[i] = src[i]; mx = fmaxf(mx, fmaxf(fmaxf(fabsf(x[i].x), fabsf(x[i].y)), fmaxf(fabsf(x[i].z), fabsf(x[i].w)))); }
            mx = __uint_as_float(wave_max_u32(__float_as_uint(mx)));
            const float sc = mx > 0.f ? 6.f / mx : 0.f;
            unsigned w0 = 0u, w1 = 0u;
            w0 = __builtin_amdgcn_cvt_scalef32_pk_fp4_f32(w0, x[0].x * sc, x[0].y * sc, 1.0f, 0); w0 = __builtin_amdgcn_cvt_scalef32_pk_fp4_f32(w0, x[0].z * sc, x[0].w * sc, 1.0f, 1);
            w0 = __builtin_amdgcn_cvt_scalef32_pk_fp4_f32(w0, x[1].x * sc, x[1].y * sc, 1.0f, 2); w0 = __builtin_amdgcn_cvt_scalef32_pk_fp4_f32(w0, x[1].z * sc, x[1].w * sc, 1.0f, 3);
            w1 = __builtin_amdgcn_cvt_scalef32_pk_fp4_f32(w1, x[2].x * sc, x[2].y * sc, 1.0f, 0); w1 = __builtin_amdgcn_cvt_scalef32_pk_fp4_f32(w1, x[2].z * sc, x[2].w * sc, 1.0f, 1);
            w1 = __builtin_amdgcn_cvt_scalef32_pk_fp4_f32(w1, x[3].x * sc, x[3].y * sc, 1.0f, 2); w1 = __builtin_amdgcn_cvt_scalef32_pk_fp4_f32(w1, x[3].z * sc, x[3].w * sc, 1.0f, 3);
            *(u32x2*)(p.ws + (isv ? WS_VB : WS_UB) + (size_t)rr * 512 + lane * 8) = (u32x2){w0, w1};
            if (lane == 0) ((float*)(p.ws + WS_ESC))[r] = mx * (1.f / 6.f);
        }
    }
}

template <bool OUT_F32>
__device__ void phase_rmsnorm(const float* x, const float* __restrict__ g, void* out, int bid, int nblk) {
    const int lane = otid() & 63, wave = otid() >> 6;
    const int gw = bid * 4 + wave, ngw = nblk * 4;
    f32x4 gv[4];
#pragma unroll
    for (int j = 0; j < 4; ++j) gv[j] = ((const f32x4*)g)[lane + 64 * j];
    for (int row = gw; row < NT; row += ngw) {
        const f32x4* xr = (const f32x4*)(x + (size_t)row * D) + lane;
        f32x4 v[4]; float s = 0.f;
#pragma unroll
        for (int j = 0; j < 4; ++j) { v[j] = xr[64 * j]; s += v[j].x * v[j].x + v[j].y * v[j].y + v[j].z * v[j].z + v[j].w * v[j].w; }
        s = wave_sum(s);
        const float rs = rsqrtf(s * (1.f / D) + 1e-6f);
        if (OUT_F32) {
            f32x4* o = (f32x4*)((float*)out + (size_t)row * D) + lane;
#pragma unroll
            for (int j = 0; j < 4; ++j) o[64 * j] = v[j] * rs * gv[j];
        } else {
            u32x2* o = (u32x2*)((bf16_t*)out + (size_t)row * D) + lane;
#pragma unroll
            for (int j = 0; j < 4; ++j) { f32x4 y = v[j] * rs * gv[j]; u32x2 w; w.x = pk2(y.x, y.y); w.y = pk2(y.z, y.w); o[64 * j] = w; }
        }
    }
}

struct GemmP {
    const bf16_t* A; int lda; int a_koff;
    int b_koff;
    const bf16_t* Bt; int ldb; int K;
    int MT, NTl;
    void* C; int ldc; const float* R;
};
constexpr int GS = 72;
template <int MODE>
__device__ void phase_gemm(const GemmP& p, char* smem, int bid, int nblk, int tile0 = 0) {
    bf16_t* As = (bf16_t*)smem;
    bf16_t* Bs = As + 128 * GS;
    const int tid = otid(), lane = tid & 63, wave = tid >> 6;
    const int wr = wave >> 1, wc = wave & 1;
    const int lr = tid >> 3, lc = (tid & 7) * 8;
    const int fl = lane & 15, fq = lane >> 4;
    const int ntiles = p.MT * p.NTl;
    for (int tile = bid - tile0 + ((bid < tile0) ? nblk * ((tile0 - bid + nblk - 1) / nblk) : 0); tile < ntiles; tile += nblk) {
        const int mt = tile / p.NTl, nt = tile % p.NTl;
        const bf16_t* Ag = p.A + (size_t)mt * 128 * p.lda + (size_t)nt * p.a_koff + (size_t)lr * p.lda + lc;
        const bf16_t* Bg = p.Bt + (size_t)nt * 128 * p.ldb + (size_t)mt * p.b_koff + (size_t)lr * p.ldb + lc;
        f32x4 acc[4][4];
#pragma unroll
        for (int m = 0; m < 4; ++m)
#pragma unroll
            for (int n = 0; n < 4; ++n) acc[m][n] = (f32x4){0.f, 0.f, 0.f, 0.f};
        u32x4 ra[4], rb[4];
        const int nk = p.K >> 6;
#pragma unroll
        for (int i = 0; i < 4; ++i) { ra[i] = *(const u32x4*)(Ag + (size_t)(32 * i) * p.lda); rb[i] = *(const u32x4*)(Bg + (size_t)(32 * i) * p.ldb); }
        __syncthreads();
#pragma unroll
        for (int i = 0; i < 4; ++i) { *(u32x4*)(As + (lr + 32 * i) * GS + lc) = ra[i]; *(u32x4*)(Bs + (lr + 32 * i) * GS + lc) = rb[i]; }
        if (nk > 1) {
#pragma unroll
            for (int i = 0; i < 4; ++i) { ra[i] = *(const u32x4*)(Ag + (size_t)(32 * i) * p.lda + 64); rb[i] = *(const u32x4*)(Bg + (size_t)(32 * i) * p.ldb + 64); }
        }
        __syncthreads();
        for (int kt = 0; kt < nk; ++kt) {
            const bf16_t* Ac = As + (kt & 1) * (256 * GS); const bf16_t* Bc = Ac + 128 * GS;
            bf16_t* An = As + ((kt & 1) ^ 1) * (256 * GS); bf16_t* Bn = An + 128 * GS;
            if (kt + 1 < nk) {
#pragma unroll
                for (int i = 0; i < 4; ++i) { *(u32x4*)(An + (lr + 32 * i) * GS + lc) = ra[i]; *(u32x4*)(Bn + (lr + 32 * i) * GS + lc) = rb[i]; }
                if (kt + 2 < nk) {
#pragma unroll
                    for (int i = 0; i < 4; ++i) { ra[i] = *(const u32x4*)(Ag + (size_t)(32 * i) * p.lda + (kt + 2) * 64); rb[i] = *(const u32x4*)(Bg + (size_t)(32 * i) * p.ldb + (kt + 2) * 64); }
                }
            }
#pragma unroll
            for (int ks = 0; ks < 2; ++ks) {
                bf16x8 xa[4], wb[4];
#pragma unroll
                for (int m = 0; m < 4; ++m) xa[m] = *(const bf16x8*)(Ac + (wr * 64 + m * 16 + fl) * GS + ks * 32 + fq * 8);
#pragma unroll
                for (int n = 0; n < 4; ++n) wb[n] = *(const bf16x8*)(Bc + (wc * 64 + n * 16 + fl) * GS + ks * 32 + fq * 8);
#pragma unroll
                for (int m = 0; m < 4; ++m)
#pragma unroll
                    for (int n = 0; n < 4; ++n) acc[m][n] = (MODE == 3) ? __builtin_amdgcn_mfma_f32_16x16x32_bf16(xa[m], wb[n], acc[m][n], 0, 0, 0)
                                                                     : __builtin_amdgcn_mfma_f32_16x16x32_bf16(wb[n], xa[m], acc[m][n], 0, 0, 0);
            }
            __syncthreads();
        }
#pragma unroll
        for (int m = 0; m < 4; ++m) {
#pragma unroll
            for (int n = 0; n < 4; ++n) {
                const f32x4 a = acc[m][n];
                if (MODE == 3) {
                    const size_t row = (size_t)mt * 128 + wr * 64 + m * 16 + fq * 4;
                    const size_t col = (size_t)nt * 128 + wc * 64 + n * 16 + fl;
                    *(f32x4*)((float*)p.C + col * p.ldc + row) = a;
                } else {
                    const size_t row = (size_t)mt * 128 + wr * 64 + m * 16 + fl;
                    const int col = nt * 128 + wc * 64 + n * 16 + fq * 4;
                    if (MODE == 0) { u32x2 w; w.x = pk2(a.x, a.y); w.y = pk2(a.z, a.w); *(u32x2*)((bf16_t*)p.C + row * p.ldc + col) = w; }
                    else if (MODE == 1) { *(f32x4*)((float*)p.C + row * p.ldc + col) = a; }
                    else { const f32x4 r = *(const f32x4*)(p.R + row * p.ldc + col); *(f32x4*)((float*)p.C + row * p.ldc + col) = r + a; }
                }
            }
        }
    }
}

constexpr int LS = 72;
struct LinP {
    const bf16_t* Z; bf16_t* O;
    const float* gk_up;
    const float* gk_bias;
    const float* norm_w;
    const float* rope;
    unsigned char* lin;
};
__device__ __forceinline__ bf16x8 ldfrag(const bf16_t* base, int row, int kofs) { return *(const bf16x8*)(base + row * LS + kofs); }

constexpr size_t LN_KV_RET = 0;
constexpr size_t LN_KV_GLA = LN_KV_RET + 1024ull * 64 * 64 * 4;
constexpr size_t LN_S_RET  = LN_KV_GLA + 1024ull * 96 * 64 * 4;
constexpr size_t LN_S_GLA  = LN_S_RET + 1024ull * 64 * 64 * 2;
constexpr size_t LN_DEC    = LN_S_GLA + 1024ull * 96 * 64 * 2;
static_assert(LN_DEC + 2048ull * 64 * 4 <= 64 * MiB, "lin region");

__device__ __forceinline__ float wave_incl_scan(float v) {
    v += dpp_f<0x111>(v); v += dpp_f<0x112>(v); v += dpp_f<0x114>(v); v += dpp_f<0x118>(v);
    v += __int_as_float(__builtin_amdgcn_update_dpp(0, __float_as_int(v), 0x142, 0xA, 0xF, false));
    v += __int_as_float(__builtin_amdgcn_update_dpp(0, __float_as_int(v), 0x143, 0xC, 0xF, false));
    return v;
}
__device__ __forceinline__ float readlane_f(float v, int l) { return __int_as_float(__builtin_amdgcn_readlane(__float_as_int(v), l)); }

__device__ __forceinline__ void rot8(const bf16_t* src, const float* rope, int spos, int cq, unsigned (&o1)[4], unsigned (&o2)[4]) {
    const u32x4 q1 = *(const u32x4*)(src + cq * 8), q2 = *(const u32x4*)(src + 32 + cq * 8);
    const unsigned q1w[4] = {q1.x, q1.y, q1.z, q1.w}, q2w[4] = {q2.x, q2.y, q2.z, q2.w};
    const f32x4 c0 = *(const f32x4*)(rope + spos * 32 + cq * 8), c1 = *(const f32x4*)(rope + spos * 32 + cq * 8 + 4);
    const f32x4 s0 = *(const f32x4*)(rope + NS * 32 + spos * 32 + cq * 8), s1 = *(const f32x4*)(rope + NS * 32 + spos * 32 + cq * 8 + 4);
    const float csv[8] = {c0.x, c0.y, c0.z, c0.w, c1.x, c1.y, c1.z, c1.w}, snv[8] = {s0.x, s0.y, s0.z, s0.w, s1.x, s1.y, s1.z, s1.w};
#pragma unroll
    for (int e = 0; e < 4; ++e) {
        const float a1l = lo_bf(q1w[e]), a1h = hi_bf(q1w[e]), a2l = lo_bf(q2w[e]), a2h = hi_bf(q2w[e]);
        o1[e] = pk2(a1l * csv[2 * e] - a2l * snv[2 * e], a1h * csv[2 * e + 1] - a2h * snv[2 * e + 1]);
        o2[e] = pk2(a1l * snv[2 * e] + a2l * csv[2 * e], a1h * snv[2 * e + 1] + a2h * csv[2 * e + 1]);
    }
}
__device__ __forceinline__ void load_vts(const bf16_t* Z, size_t t0, int voff, int nch, bf16_t* Vts, int tid) {
    for (int x = tid; x < 64 * nch; x += NTHREADS) {
        const int tok = x / nch, ch = x % nch;
        const u32x4 vv = *(const u32x4*)(Z + (t0 + tok) * DINP + voff + ch * 8);
        const unsigned w[4] = {vv.x, vv.y, vv.z, vv.w};
#pragma unroll
        for (int e = 0; e < 4; ++e) { Vts[(ch * 8 + 2 * e) * LS + tok] = (bf16_t)(w[e] & 0xFFFFu); Vts[(ch * 8 + 2 * e + 1) * LS + tok] = (bf16_t)(w[e] >> 16); }
    }
}
__device__ __forceinline__ void load_gd(const bf16_t* zr, float (&gd)[16]) {
    const u32x4 g0 = *(const u32x4*)zr, g1 = *(const u32x4*)(zr + 8);
    gd[0] = lo_bf(g0.x); gd[1] = hi_bf(g0.x); gd[2] = lo_bf(g0.y); gd[3] = hi_bf(g0.y); gd[4] = lo_bf(g0.z); gd[5] = hi_bf(g0.z); gd[6] = lo_bf(g0.w); gd[7] = hi_bf(g0.w);
    gd[8] = lo_bf(g1.x); gd[9] = hi_bf(g1.x); gd[10] = lo_bf(g1.y); gd[11] = hi_bf(g1.y); gd[12] = lo_bf(g1.z); gd[13] = hi_bf(g1.z); gd[14] = lo_bf(g1.w); gd[15] = hi_bf(g1.w);
}
__device__ __forceinline__ float gla_gk(const LinP& p, const float (&gd)[16], int h, int d) {
    float x = p.gk_bias[h * 48 + d];
#pragma unroll
    for (int i = 0; i < 16; ++i) x += gd[i] * p.gk_up[i * 192 + h * 48 + d];
    return (fminf(x, 0.f) - log1pf(__expf(-fabsf(x)))) * (1.f / 16.f);
}
__device__ __forceinline__ float ret_lg(int h) { const float e = exp2f(-5.f - (float)h * (4.f / 3.f)); return log1pf(-e); }

template <bool IS_GLA>
__device__ void lin_kv_task(const LinP& p, char* smem, int b, int h, int c) {
    constexpr int DV = IS_GLA ? 96 : 64, NVB = DV / 16;
    const int koff = IS_GLA ? (ZC_GLA + 192 + h * 48) : (ZC_RET + 256 + h * 64);
    const int voff = IS_GLA ? (ZC_GLA + 384 + h * 96) : (ZC_RET + 512 + h * 64);
    const int gkdoff = ZC_GLA + 768;
    bf16_t* Ks = (bf16_t*)smem;
    bf16_t* Kts = Ks + 64 * LS;
    bf16_t* Vts = Kts + 64 * LS;
    float* decs = (float*)(Vts + 96 * LS);
    const int tid = otid(), lane = tid & 63, wave = tid >> 6;
    const int fl = lane & 15, fq = lane >> 4;
    const size_t t0 = (size_t)b * NS + (size_t)c * 64;
    const int task = (b * 4 + h) * 64 + c;
    __syncthreads();
    if (IS_GLA) {
        for (int x = tid; x < 64 * 6; x += NTHREADS) {
            const int tok = x / 6, ch = x % 6;
            *(u32x4*)(Ks + tok * LS + ch * 8) = *(const u32x4*)(p.Z + (t0 + tok) * DINP + koff + ch * 8);
        }
        for (int x = tid; x < 16 * LS / 2; x += NTHREADS) ((unsigned*)(Kts + 48 * LS))[x] = 0u;
        if (tid < 16) decs[48 + tid] = 1.f;
        load_vts(p.Z, t0, voff, 12, Vts, tid);
    } else {
        const int tok = tid >> 2, cq = tid & 3;
        unsigned k1[4], k2[4];
        rot8(p.Z + (t0 + tok) * DINP + koff, p.rope, c * 64 + tok, cq, k1, k2);
        const float fk2 = 0.125f * __expf(ret_lg(h) * (float)(63 - tok));
#pragma unroll
        for (int e = 0; e < 4; ++e) {
            Kts[(cq * 8 + 2 * e) * LS + tok] = f2bf(lo_bf(k1[e]) * fk2); Kts[(cq * 8 + 2 * e + 1) * LS + tok] = f2bf(hi_bf(k1[e]) * fk2);
            Kts[(32 + cq * 8 + 2 * e) * LS + tok] = f2bf(lo_bf(k2[e]) * fk2); Kts[(32 + cq * 8 + 2 * e + 1) * LS + tok] = f2bf(hi_bf(k2[e]) * fk2);
        }
        if (tid < 64) decs[tid] = __expf(ret_lg(h) * 64.f);
        load_vts(p.Z, t0, voff, 8, Vts, tid);
    }
    __syncthreads();
    if (IS_GLA) {
        float gd[16];
        load_gd(p.Z + (t0 + lane) * DINP + gkdoff, gd);
#pragma unroll 1
        for (int dd = 0; dd < 12; ++dd) {
            const int d = wave * 12 + dd;
            const float bc = wave_incl_scan(gla_gk(p, gd, h, d));
            const float bl = readlane_f(bc, 63);
            Kts[d * LS + lane] = f2bf(bf2f(Ks[lane * LS + d]) * __expf(bl - bc));
            if (lane == 0) decs[d] = __expf(bl);
        }
        __syncthreads();
    }
    float* KV = (float*)(p.lin + (IS_GLA ? LN_KV_GLA : LN_KV_RET)) + (size_t)task * DV * 64;
#pragma unroll
    for (int vb = 0; vb < NVB; ++vb) {
        f32x4 a4 = (f32x4){0.f, 0.f, 0.f, 0.f};
#pragma unroll
        for (int ks = 0; ks < 2; ++ks) {
            const bf16x8 a = ldfrag(Kts, 16 * wave + fl, ks * 32 + fq * 8);
            const bf16x8 bv = ldfrag(Vts, 16 * vb + fl, ks * 32 + fq * 8);
            a4 = __builtin_amdgcn_mfma_f32_16x16x32_bf16(a, bv, a4, 0, 0, 0);
        }
        *(f32x4*)(KV + (size_t)(16 * vb + fl) * 64 + 16 * wave + 4 * fq) = a4;
    }
    if (tid < 64) ((float*)(p.lin + LN_DEC))[(size_t)((IS_GLA ? 1024 : 0) + task) * 64 + tid] = decs[tid];
}

__device__ void lin_scan_phase(const LinP& p, int vbid, int nvblk) {
    const int tid = otid();
    for (int it = vbid; it < 160; it += nvblk) {
        const bool gla = it >= 64;
        const int r = gla ? it - 64 : it;
        const int per = gla ? 6 : 4, DVx = gla ? 96 : 64;
        const int bh = r / per, e = (r % per) * 1024 + tid;
        const float* KV = (const float*)(p.lin + (gla ? LN_KV_GLA : LN_KV_RET)) + (size_t)bh * 64 * DVx * 64 + e;
        bf16_t* Sb = (bf16_t*)(p.lin + (gla ? LN_S_GLA : LN_S_RET)) + (size_t)bh * 64 * DVx * 64 + e;
        const float* DEC = (const float*)(p.lin + LN_DEC) + (size_t)((gla ? 1024 : 0) + bh * 64) * 64 + (e & 63);
        float S0 = 0.f, S1 = 0.f, S2 = 0.f, S3 = 0.f;
#pragma unroll 8
        for (int c = 0; c < 64; ++c) {
            const size_t o = (size_t)c * DVx * 64;
            const float k0 = KV[o], k1 = KV[o + 256], k2 = KV[o + 512], k3 = KV[o + 768], dc = DEC[c * 64];
            Sb[o] = f2bf(S0); Sb[o + 256] = f2bf(S1); Sb[o + 512] = f2bf(S2); Sb[o + 768] = f2bf(S3);
            S0 = S0 * dc + k0; S1 = S1 * dc + k1; S2 = S2 * dc + k2; S3 = S3 * dc + k3;
        }
    }
}

template <bool IS_GLA>
__device__ void lin_out_task(const LinP& p, char* smem, int b, int h, int c) {
    constexpr int DV = IS_GLA ? 96 : 64, NVB = DV / 16;
    const int qoff = IS_GLA ? (ZC_GLA + 0 + h * 48) : (ZC_RET + 0 + h * 64);
    const int koff = IS_GLA ? (ZC_GLA + 192 + h * 48) : (ZC_RET + 256 + h * 64);
    const int voff = IS_GLA ? (ZC_GLA + 384 + h * 96) : (ZC_RET + 512 + h * 64);
    const int goff = IS_GLA ? (ZC_GLA + 784 + h * 96) : (ZC_RET + 768 + h * 64);
    const int gkdoff = ZC_GLA + 768;
    const int ooff = IS_GLA ? (640 + h * 96) : (h * 64);
    bf16_t* Qs = (bf16_t*)smem;
    bf16_t* Ks = Qs + 64 * LS;
    bf16_t* Ps = Ks + 64 * LS;
    bf16_t* Vts = Ps + 64 * LS;
    bf16_t* Sts = Vts + 96 * LS;
    const int tid = otid(), lane = tid & 63, wave = tid >> 6;
    const int fl = lane & 15, fq = lane >> 4;
    const size_t t0 = (size_t)b * NS + (size_t)c * 64;
    const int task = (b * 4 + h) * 64 + c;
    __syncthreads();
    {
        const bf16_t* Sb = (const bf16_t*)(p.lin + (IS_GLA ? LN_S_GLA : LN_S_RET)) + (size_t)task * DV * 64;
        for (int x = tid; x < DV * 8; x += NTHREADS) { const int v = x >> 3, ch = x & 7; *(u32x4*)(Sts + v * LS + ch * 8) = *(const u32x4*)(Sb + v * 64 + ch * 8); }
    }
    if (IS_GLA) {
        for (int x = tid; x < 64 * 6; x += NTHREADS) {
            const int tok = x / 6, ch = x % 6;
            const bf16_t* zr = p.Z + (t0 + tok) * DINP;
            *(u32x4*)(Qs + tok * LS + ch * 8) = *(const u32x4*)(zr + qoff + ch * 8);
            *(u32x4*)(Ks + tok * LS + ch * 8) = *(const u32x4*)(zr + koff + ch * 8);
        }
        for (int x = tid; x < 64 * 2; x += NTHREADS) {
            const int tok = x >> 1, ch = 6 + (x & 1);
            *(u32x4*)(Qs + tok * LS + ch * 8) = (u32x4){0u, 0u, 0u, 0u};
            *(u32x4*)(Ks + tok * LS + ch * 8) = (u32x4){0u, 0u, 0u, 0u};
        }
        load_vts(p.Z, t0, voff, 12, Vts, tid);
    } else {
        const int tok = tid >> 2, cq = tid & 3;
        const bf16_t* zr = p.Z + (t0 + tok) * DINP;
        unsigned q1[4], q2[4], k1[4], k2[4];
        rot8(zr + qoff, p.rope, c * 64 + tok, cq, q1, q2);
        rot8(zr + koff, p.rope, c * 64 + tok, cq, k1, k2);
        const float lg = ret_lg(h);
        const float fqd = __expf(lg * (float)(tok + 1)), fk = 0.125f * __expf(-lg * (float)(tok + 1));
#pragma unroll
        for (int e = 0; e < 4; ++e) {
            q1[e] = pk2(lo_bf(q1[e]) * fqd, hi_bf(q1[e]) * fqd); q2[e] = pk2(lo_bf(q2[e]) * fqd, hi_bf(q2[e]) * fqd);
            k1[e] = pk2(lo_bf(k1[e]) * fk, hi_bf(k1[e]) * fk); k2[e] = pk2(lo_bf(k2[e]) * fk, hi_bf(k2[e]) * fk);
        }
        *(u32x4*)(Qs + tok * LS + cq * 8) = (u32x4){q1[0], q1[1], q1[2], q1[3]};
        *(u32x4*)(Qs + tok * LS + 32 + cq * 8) = (u32x4){q2[0], q2[1], q2[2], q2[3]};
        *(u32x4*)(Ks + tok * LS + cq * 8) = (u32x4){k1[0], k1[1], k1[2], k1[3]};
        *(u32x4*)(Ks + tok * LS + 32 + cq * 8) = (u32x4){k2[0], k2[1], k2[2], k2[3]};
        load_vts(p.Z, t0, voff, 8, Vts, tid);
    }
    __syncthreads();
    if (IS_GLA) {
        float gd[16];
        load_gd(p.Z + (t0 + lane) * DINP + gkdoff, gd);
#pragma unroll 1
        for (int dd = 0; dd < 12; ++dd) {
            const int d = wave * 12 + dd;
            const float bc = wave_incl_scan(gla_gk(p, gd, h, d));
            const float eq = __expf(bc) * 0.14433756729740643f  , ek = __expf(-bc);
            Qs[lane * LS + d] = f2bf(bf2f(Qs[lane * LS + d]) * eq);
            Ks[lane * LS + d] = f2bf(bf2f(Ks[lane * LS + d]) * ek);
        }
        __syncthreads();
    }
#pragma unroll
    for (int jb = 0; jb < 4; ++jb) {
        f32x4 ap = (f32x4){0.f, 0.f, 0.f, 0.f};
#pragma unroll
        for (int ks = 0; ks < 2; ++ks) {
            const bf16x8 a = ldfrag(Ks, 16 * jb + fl, ks * 32 + fq * 8);
            const bf16x8 bq = ldfrag(Qs, 16 * wave + fl, ks * 32 + fq * 8);
            ap = __builtin_amdgcn_mfma_f32_16x16x32_bf16(a, bq, ap, 0, 0, 0);
        }
        const int i = 16 * wave + fl, j0 = 16 * jb + 4 * fq;
        u32x2 w;
        w.x = pk2(j0 + 0 <= i ? ap.x : 0.f, j0 + 1 <= i ? ap.y : 0.f);
        w.y = pk2(j0 + 2 <= i ? ap.z : 0.f, j0 + 3 <= i ? ap.w : 0.f);
        *(u32x2*)(Ps + i * LS + j0) = w;
    }
    __syncthreads();
    {
        f32x4 ao[NVB];
        float ss = 0.f;
#pragma unroll
        for (int vb = 0; vb < NVB; ++vb) {
            f32x4 a4 = (f32x4){0.f, 0.f, 0.f, 0.f};
#pragma unroll
            for (int ks = 0; ks < 2; ++ks) {
                const bf16x8 a = ldfrag(Vts, 16 * vb + fl, ks * 32 + fq * 8);
                const bf16x8 bp = ldfrag(Ps, 16 * wave + fl, ks * 32 + fq * 8);
                a4 = __builtin_amdgcn_mfma_f32_16x16x32_bf16(a, bp, a4, 0, 0, 0);
            }
#pragma unroll
            for (int ks = 0; ks < 2; ++ks) {
                const bf16x8 a = ldfrag(Sts, 16 * vb + fl, ks * 32 + fq * 8);
                const bf16x8 bq = ldfrag(Qs, 16 * wave + fl, ks * 32 + fq * 8);
                a4 = __builtin_amdgcn_mfma_f32_16x16x32_bf16(a, bq, a4, 0, 0, 0);
            }
            ao[vb] = a4;
            ss += a4.x * a4.x + a4.y * a4.y + a4.z * a4.z + a4.w * a4.w;
        }
        ss = xor32_sum(xor16_sum(ss));
        const float inv = rsqrtf(ss * (1.f / DV) + 1e-5f);
        const size_t t = t0 + 16 * wave + fl;
#pragma unroll
        for (int vb = 0; vb < NVB; ++vb) {
            const int v0 = 16 * vb + 4 * fq;
            const u32x2 gg = *(const u32x2*)(p.Z + t * DINP + goff + v0);
            float g4[4] = {lo_bf(gg.x), hi_bf(gg.x), lo_bf(gg.y), hi_bf(gg.y)};
            float o4[4] = {ao[vb].x, ao[vb].y, ao[vb].z, ao[vb].w};
#pragma unroll
            for (int e = 0; e < 4; ++e) {
                float y = o4[e] * inv;
                if (IS_GLA) y *= p.norm_w[h * 96 + v0 + e];
                const float g = g4[e];
                o4[e] = y * (g / (1.f + __expf(-g)));
            }
            u32x2 w; w.x = pk2(o4[0], o4[1]); w.y = pk2(o4[2], o4[3]);
            *(u32x2*)(p.O + t * D + ooff + v0) = w;
        }
    }
}
__device__ __forceinline__ void lin_kv_dispatch(const LinP& p, char* smem, int task) {
    const int r = task & 1023, bh = r >> 6, c = r & 63;
    if (task < 1024) lin_kv_task<false>(p, smem, bh >> 2, bh & 3, c); else lin_kv_task<true>(p, smem, bh >> 2, bh & 3, c);
}
__device__ __forceinline__ void lin_out_dispatch(const LinP& p, char* smem, int task) {
    const int r = task & 1023, bh = r >> 6, c = r & 63;
    if (task < 1024) lin_out_task<false>(p, smem, bh >> 2, bh & 3, c); else lin_out_task<true>(p, smem, bh >> 2, bh & 3, c);
}

struct RwP {
    const bf16_t* Z; unsigned char* mix;
    const float* mu; const float* w_up; const float* w_bias; const float* a_up; const float* a_bias; const float* g_up;
    const float* k_k; const float* k_a; const float* r_k; const float* ln_w; const float* ln_b;
    float* oraw; bf16_t* O; bf16_t* Y; const bf16_t* lora;
};
constexpr int PS = 264;
__device__ __forceinline__ f32x4 bf4(u32x2 w) { return (f32x4){lo_bf(w.x), hi_bf(w.x), lo_bf(w.y), hi_bf(w.y)}; }
__device__ void rwkv_prep_task(const RwP& p, char* smem, int tile) {
    bf16_t* At = (bf16_t*)smem;
    const int tid = otid(), lane = tid & 63, wave = tid >> 6;
    const int fl = lane & 15, fq = lane >> 4;
    const int t0 = tile * 32;
    float* Wd = (float*)(p.mix + MX_W); float* KKd = (float*)(p.mix + MX_KK); float* KKAd = (float*)(p.mix + MX_KKA);
    bf16_t* Rd = (bf16_t*)(p.mix + MX_R); bf16_t* Kd = (bf16_t*)(p.mix + MX_K); bf16_t* Vd = (bf16_t*)(p.mix + MX_V); bf16_t* Gd = (bf16_t*)(p.mix + MX_G);
    __syncthreads();
    {
        const int tok = tid >> 3, t = t0 + tok;
        const bool first = (t & (NS - 1)) == 0;
        const bf16_t* zr = p.Z + (size_t)t * DINP + ZC_RW + 1152;
#pragma unroll
        for (int i = 0; i < 4; ++i) {
            const int ch = (tid & 7) + 8 * i;
            const u32x4 cur = *(const u32x4*)(zr + ch * 8);
            const u32x4 prv = first ? (u32x4){0u, 0u, 0u, 0u} : *(const u32x4*)(zr - DINP + ch * 8);
            const f32x4 m0 = *(const f32x4*)(p.mu + 1152 + ch * 8), m1 = *(const f32x4*)(p.mu + 1152 + ch * 8 + 4);
            const unsigned cw[4] = {cur.x, cur.y, cur.z, cur.w}, pw[4] = {prv.x, prv.y, prv.z, prv.w};
            const float mm[8] = {m0.x, m0.y, m0.z, m0.w, m1.x, m1.y, m1.z, m1.w};
            float o[8];
#pragma unroll
            for (int e = 0; e < 4; ++e) {
                const float f0 = lo_bf(cw[e]), f1 = hi_bf(cw[e]), g0 = lo_bf(pw[e]), g1 = hi_bf(pw[e]);
                o[2 * e] = f0 + (g0 - f0) * mm[2 * e]; o[2 * e + 1] = f1 + (g1 - f1) * mm[2 * e + 1];
            }
            if (ch < 8) {
#pragma unroll
                for (int e = 0; e < 8; ++e) o[e] = tanhf(o[e]);
            } else if (ch >= 16) {
#pragma unroll
                for (int e = 0; e < 8; ++e) o[e] = sigmoidf_(o[e]);
            }
            *(u32x4*)(At + tok * PS + ch * 8) = (u32x4){pk2(o[0], o[1]), pk2(o[2], o[3]), pk2(o[4], o[5]), pk2(o[6], o[7])};
        }
    }
    __syncthreads();
    bf16x8 xb[8];
#pragma unroll
    for (int ks = 0; ks < 8; ++ks) xb[ks] = *(const bf16x8*)(At + (16 * (wave & 1) + fl) * PS + ks * 32 + fq * 8);
    const int t = t0 + 16 * (wave & 1) + fl, b = t >> 12, sq = t & (NS - 1);
    const bool first = sq == 0;
    const bf16_t* zc = p.Z + (size_t)t * DINP + ZC_RW;
    const bf16_t* WupT = p.lora; const bf16_t* AupT = p.lora + 384 * 64; const bf16_t* GupT = p.lora + 2 * 384 * 64;
#pragma unroll 1
    for (int hd = (wave >> 1) * 3; hd < (wave >> 1) * 3 + 3; ++hd) {
        f32x4 aw[4], aa[4], ag[4];
#pragma unroll
        for (int n = 0; n < 4; ++n) {
            const int cr = hd * 64 + 16 * n + fl;
            f32x4 w4 = (f32x4){0.f, 0.f, 0.f, 0.f}, a4 = w4, g4 = w4;
#pragma unroll
            for (int ks = 0; ks < 2; ++ks) {
                w4 = __builtin_amdgcn_mfma_f32_16x16x32_bf16(*(const bf16x8*)(WupT + cr * 64 + ks * 32 + fq * 8), xb[ks], w4, 0, 0, 0);
                a4 = __builtin_amdgcn_mfma_f32_16x16x32_bf16(*(const bf16x8*)(AupT + cr * 64 + ks * 32 + fq * 8), xb[2 + ks], a4, 0, 0, 0);
            }
#pragma unroll
            for (int ks = 0; ks < 4; ++ks) g4 = __builtin_amdgcn_mfma_f32_16x16x32_bf16(*(const bf16x8*)(GupT + cr * 128 + ks * 32 + fq * 8), xb[4 + ks], g4, 0, 0, 0);
            aw[n] = w4; aa[n] = a4; ag[n] = g4;
        }
        f32x4 kx[4], av[4], kkv[4];
        float ss = 0.f;
        const size_t hrow = ((size_t)(b * 6 + hd) * NS + sq) * 64;
#pragma unroll
        for (int n = 0; n < 4; ++n) {
            const int cl = 16 * n + 4 * fq, c = hd * 64 + cl;
            f32x4 rr = bf4(*(const u32x2*)(zc + c)), kk = bf4(*(const u32x2*)(zc + 384 + c)), vv = bf4(*(const u32x2*)(zc + 768 + c));
            f32x4 rp = (f32x4){0.f, 0.f, 0.f, 0.f}, kp = rp, vp = rp;
            if (!first) { rp = bf4(*(const u32x2*)(zc - DINP + c)); kp = bf4(*(const u32x2*)(zc - DINP + 384 + c)); vp = bf4(*(const u32x2*)(zc - DINP + 768 + c)); }
            rr = rr + (rp - rr) * *(const f32x4*)(p.mu + c); kk = kk + (kp - kk) * *(const f32x4*)(p.mu + 384 + c); vv = vv + (vp - vv) * *(const f32x4*)(p.mu + 768 + c);
            const f32x4 wb = *(const f32x4*)(p.w_bias + c), ab = *(const f32x4*)(p.a_bias + c), kkc = *(const f32x4*)(p.k_k + c), kac = *(const f32x4*)(p.k_a + c);
            f32x4 dec, a;
            {
                const f32x4 xw = wb + aw[n], xa = ab + aa[n];
                dec.x = __expf(-__expf(-softplusf_(-xw.x) - 0.5f)); dec.y = __expf(-__expf(-softplusf_(-xw.y) - 0.5f));
                dec.z = __expf(-__expf(-softplusf_(-xw.z) - 0.5f)); dec.w = __expf(-__expf(-softplusf_(-xw.w) - 0.5f));
                a.x = sigmoidf_(xa.x); a.y = sigmoidf_(xa.y); a.z = sigmoidf_(xa.z); a.w = sigmoidf_(xa.w);
            }
            const f32x4 kr = kk * kkc;
            ss += kr.x * kr.x + kr.y * kr.y + kr.z * kr.z + kr.w * kr.w;
            kkv[n] = kr; av[n] = a; kx[n] = kk;
            const f32x4 kmod = kk * ((a - 1.f) * kac + 1.f);
            *(f32x4*)(Wd + hrow + cl) = dec;
            u32x2 w;
            w.x = pk2(rr.x, rr.y); w.y = pk2(rr.z, rr.w); *(u32x2*)(Rd + hrow + cl) = w;
            w.x = pk2(kmod.x, kmod.y); w.y = pk2(kmod.z, kmod.w); *(u32x2*)(Kd + hrow + cl) = w;
            w.x = pk2(vv.x, vv.y); w.y = pk2(vv.z, vv.w); *(u32x2*)(Vd + hrow + cl) = w;
            w.x = pk2(ag[n].x, ag[n].y); w.y = pk2(ag[n].z, ag[n].w); *(u32x2*)(Gd + (size_t)t * 384 + c) = w;
        }
        ss = xor32_sum(xor16_sum(ss));
        const float rn = rsqrtf(fmaxf(ss, 1e-24f));
#pragma unroll
        for (int n = 0; n < 4; ++n) {
            const int cl = 16 * n + 4 * fq;
            const f32x4 kn = kkv[n] * rn;
            *(f32x4*)(KKd + hrow + cl) = kn;
            *(f32x4*)(KKAd + hrow + cl) = kn * av[n];
        }
    }
}

constexpr int SC_STEPS = 16;
constexpr int SEG_BEG[4] = {0, 1376, 2736, 4096};
constexpr size_t MX_SE0 = MX_END;
constexpr size_t MX_XE  = MX_SE0 + 24ull * 3 * 4096 * 4;
constexpr size_t MX_SST = MX_XE + 24ull * 3 * 4096 * 4;
static_assert(MX_SST + 24ull * 3 * 4096 * 2 <= 128 * MiB, "mix region");
__device__ void rwkv_scan_task(const RwP& p, char* smem, int bh, int seg, int grp) {
    float* buf = (float*)smem;
    float* obuf = buf + 2 * 6 * SC_STEPS * 64;
    const int tid = otid(), lane = tid & 63, wave = tid >> 6;
    const int rloc = wave * 4 + (lane >> 4);
    const bool ident = grp >= 4;
    const int row = (grp & 3) * 16 + rloc;
    const int c4 = (lane & 15) * 4;
    const int s_beg = seg == 0 ? SEG_BEG[0] : (seg == 1 ? SEG_BEG[1] : SEG_BEG[2]);
    const int s_end = seg == 0 ? SEG_BEG[1] : (seg == 1 ? SEG_BEG[2] : SEG_BEG[3]);
    const int NCH = (s_end - s_beg) / SC_STEPS;
    const size_t hb = ((size_t)bh * NS + s_beg) * 64;
    const float* Wd = (const float*)(p.mix + MX_W) + hb;
    const float* KKd = (const float*)(p.mix + MX_KK) + hb;
    const float* KKAd = (const float*)(p.mix + MX_KKA) + hb;
    const bf16_t* Rd = (const bf16_t*)(p.mix + MX_R) + hb;
    const bf16_t* Kd = (const bf16_t*)(p.mix + MX_K) + hb;
    const bf16_t* Vd = (const bf16_t*)(p.mix + MX_V) + hb;
    float* orow = p.oraw + hb;
    bf16_t* yrow = p.Y + hb;
    f32x4 S;
    S.x = (ident && c4 + 0 == row) ? 1.f : 0.f; S.y = (ident && c4 + 1 == row) ? 1.f : 0.f; S.z = (ident && c4 + 2 == row) ? 1.f : 0.f; S.w = (ident && c4 + 3 == row) ? 1.f : 0.f;
    struct Stg { f32x4 w, kk, ka; u32x2 r, k, v; };
    Stg sA, sB;
    auto gload = [&](Stg& g, int ch) {
        const size_t e = (size_t)ch * SC_STEPS * 64 + tid * 4;
        g.w = *(const f32x4*)(Wd + e); g.kk = *(const f32x4*)(KKd + e); g.ka = *(const f32x4*)(KKAd + e);
        g.r = *(const u32x2*)(Rd + e); g.k = *(const u32x2*)(Kd + e); g.v = *(const u32x2*)(Vd + e);
    };
    auto lstore = [&](const Stg& g, int bsel) {
        float* bb = buf + bsel * 6 * SC_STEPS * 64 + tid * 4;
        *(f32x4*)(bb + 0 * SC_STEPS * 64) = g.w; *(f32x4*)(bb + 1 * SC_STEPS * 64) = g.kk; *(f32x4*)(bb + 2 * SC_STEPS * 64) = g.ka;
        *(f32x4*)(bb + 3 * SC_STEPS * 64) = (f32x4){lo_bf(g.r.x), hi_bf(g.r.x), lo_bf(g.r.y), hi_bf(g.r.y)};
        *(f32x4*)(bb + 4 * SC_STEPS * 64) = (f32x4){lo_bf(g.k.x), hi_bf(g.k.x), lo_bf(g.k.y), hi_bf(g.k.y)};
        *(f32x4*)(bb + 5 * SC_STEPS * 64) = (f32x4){lo_bf(g.v.x), hi_bf(g.v.x), lo_bf(g.v.y), hi_bf(g.v.y)};
    };
    __syncthreads();
    gload(sA, 0); lstore(sA, 0);
    gload(sA, 1);
    __syncthreads();
    const float vmask = ident ? 0.f : 1.f;
    auto chunk = [&](int ch, Stg& cur  , Stg& nxt  ) {
        if (ch + 2 < NCH) gload(nxt, ch + 2);
        const float* bb = buf + (ch & 1) * 6 * SC_STEPS * 64;
        f32x4 w4 = *(const f32x4*)(bb + 0 * SC_STEPS * 64 + c4), kk4 = *(const f32x4*)(bb + 1 * SC_STEPS * 64 + c4), ka4 = *(const f32x4*)(bb + 2 * SC_STEPS * 64 + c4);
        f32x4 r4 = *(const f32x4*)(bb + 3 * SC_STEPS * 64 + c4), k4 = *(const f32x4*)(bb + 4 * SC_STEPS * 64 + c4);
        float vv = bb[5 * SC_STEPS * 64 + row];
#pragma unroll
        for (int st = 0; st < SC_STEPS; ++st) {
            const int sn = (st + 1 < SC_STEPS) ? st + 1 : st;
            const f32x4 nw4 = *(const f32x4*)(bb + 0 * SC_STEPS * 64 + sn * 64 + c4), nkk4 = *(const f32x4*)(bb + 1 * SC_STEPS * 64 + sn * 64 + c4);
            const f32x4 nka4 = *(const f32x4*)(bb + 2 * SC_STEPS * 64 + sn * 64 + c4), nr4 = *(const f32x4*)(bb + 3 * SC_STEPS * 64 + sn * 64 + c4);
            const f32x4 nk4 = *(const f32x4*)(bb + 4 * SC_STEPS * 64 + sn * 64 + c4);
            const float nvv = bb[5 * SC_STEPS * 64 + sn * 64 + row];
            const float vx = vv * vmask;
            float pd = S.x * kk4.x + S.y * kk4.y + S.z * kk4.z + S.w * kk4.w;
            const float sa = -row16_sum(pd);
            S.x = S.x * w4.x + vx * k4.x + sa * ka4.x;
            S.y = S.y * w4.y + vx * k4.y + sa * ka4.y;
            S.z = S.z * w4.z + vx * k4.z + sa * ka4.z;
            S.w = S.w * w4.w + vx * k4.w + sa * ka4.w;
            float od = S.x * r4.x + S.y * r4.y + S.z * r4.z + S.w * r4.w;
            od = row16_sum(od);
            obuf[st * 16 + rloc] = od;
            w4 = nw4; kk4 = nkk4; ka4 = nka4; r4 = nr4; k4 = nk4; vv = nvv;
        }
        __syncthreads();
        {
            const int st = tid >> 4, rr = tid & 15;
            const size_t oi = ((size_t)ch * SC_STEPS + st) * 64 + (grp & 3) * 16 + rr;
            if (ident) yrow[oi] = f2bf(obuf[tid]); else orow[oi] = obuf[tid];
        }
        if (ch + 1 < NCH) lstore(cur, (ch + 1) & 1);
        __syncthreads();
    };
    for (int ch = 0; ch < NCH; ch += 2) {
        chunk(ch, sA, sB);
        if (ch + 1 < NCH) chunk(ch + 1, sB, sA);
    }
    float* fin = (float*)(p.mix + (ident ? MX_XE : MX_SE0)) + ((size_t)(bh * 3 + seg) * 64 + row) * 64 + c4;
    *(f32x4*)fin = S;
}

__device__ void phase_rwkv_chain(const RwP& p, int bid, int nblk) {
    const int lane = otid() & 63, wave = otid() >> 6;
    const float* SE0 = (const float*)(p.mix + MX_SE0); const float* XE = (const float*)(p.mix + MX_XE);
    bf16_t* SST = (bf16_t*)(p.mix + MX_SST);
    for (int x = bid * 4 + wave; x < 24 * 4; x += nblk * 4) {
        const int bh = x >> 2, cg = (x & 3) * 16;
        const float* s1 = SE0 + ((size_t)(bh * 3 + 0) * 64 + lane) * 64;
        const float* e1 = SE0 + ((size_t)(bh * 3 + 1) * 64 + lane) * 64 + cg;
        const float* X1 = XE + (size_t)(bh * 3 + 1) * 4096 + cg;
        float o[16];
#pragma unroll
        for (int k = 0; k < 16; ++k) o[k] = e1[k];
        for (int i = 0; i < 64; ++i) {
            const float si = s1[i];
#pragma unroll
            for (int k = 0; k < 16; ++k) o[k] += si * X1[i * 64 + k];
        }
        bf16_t* d1 = SST + ((size_t)(bh * 3 + 1) * 64 + lane) * 64 + cg;
        bf16_t* d2 = SST + ((size_t)(bh * 3 + 2) * 64 + lane) * 64 + cg;
#pragma unroll
        for (int k = 0; k < 16; ++k) { d1[k] = f2bf(s1[cg + k]); d2[k] = f2bf(o[k]); }
    }
}

__device__ void phase_rwkv_post(const RwP& p, int bid, int nblk) {
    const int lane = otid() & 63, wave = otid() >> 6;
    const int fl = lane & 15, fq = lane >> 4;
    const bf16_t* Rd = (const bf16_t*)(p.mix + MX_R); const bf16_t* Kd = (const bf16_t*)(p.mix + MX_K); const bf16_t* Vd = (const bf16_t*)(p.mix + MX_V);
    const bf16_t* Gd = (const bf16_t*)(p.mix + MX_G); const bf16_t* SST = (const bf16_t*)(p.mix + MX_SST);
    for (int x = bid * 4 + wave; x < 24 * (NS / 16); x += nblk * 4) {
        const int bh = x / (NS / 16), s0 = (x % (NS / 16)) * 16;
        const int b = bh / 6, hd = bh % 6;
        const int seg = s0 < SEG_BEG[1] ? 0 : (s0 < SEG_BEG[2] ? 1 : 2);
        const size_t hrow = ((size_t)bh * NS + s0 + fl) * 64;
        f32x4 acc[4];
#pragma unroll
        for (int n = 0; n < 4; ++n) acc[n] = *(const f32x4*)(p.oraw + hrow + 16 * n + 4 * fq);
        if (seg > 0) {
            const bf16_t* ss = SST + (size_t)(bh * 3 + seg) * 4096;
#pragma unroll
            for (int ks = 0; ks < 2; ++ks) {
                const bf16x8 yb = *(const bf16x8*)(p.Y + hrow + ks * 32 + fq * 8);
#pragma unroll
                for (int n = 0; n < 4; ++n) {
                    const bf16x8 sa = *(const bf16x8*)(ss + (size_t)(16 * n + fl) * 64 + ks * 32 + fq * 8);
                    acc[n] = __builtin_amdgcn_mfma_f32_16x16x32_bf16(sa, yb, acc[n], 0, 0, 0);
                }
            }
        }
        float sm = 0.f;
#pragma unroll
        for (int n = 0; n < 4; ++n) sm += acc[n].x + acc[n].y + acc[n].z + acc[n].w;
        const float mean = xor32_sum(xor16_sum(sm)) * (1.f / 64.f);
        float sv = 0.f;
#pragma unroll
        for (int n = 0; n < 4; ++n) { acc[n] = acc[n] - mean; sv += acc[n].x * acc[n].x + acc[n].y * acc[n].y + acc[n].z * acc[n].z + acc[n].w * acc[n].w; }
        const float rstd = rsqrtf(xor32_sum(xor16_sum(sv)) * (1.f / 64.f) + 64e-5f);
        float rk = 0.f; f32x4 vv[4];
#pragma unroll
        for (int n = 0; n < 4; ++n) {
            const int c = 16 * n + 4 * fq;
            const u32x2 r2 = *(const u32x2*)(Rd + hrow + c), k2 = *(const u32x2*)(Kd + hrow + c), v2 = *(const u32x2*)(Vd + hrow + c);
            const f32x4 rkw = *(const f32x4*)(p.r_k + hd * 64 + c);
            rk += lo_bf(r2.x) * lo_bf(k2.x) * rkw.x + hi_bf(r2.x) * hi_bf(k2.x) * rkw.y + lo_bf(r2.y) * lo_bf(k2.y) * rkw.z + hi_bf(r2.y) * hi_bf(k2.y) * rkw.w;
            vv[n] = (f32x4){lo_bf(v2.x), hi_bf(v2.x), lo_bf(v2.y), hi_bf(v2.y)};
        }
        rk = xor32_sum(xor16_sum(rk));
        const size_t t = (size_t)b * NS + s0 + fl;
#pragma unroll
        for (int n = 0; n < 4; ++n) {
            const int c = 16 * n + 4 * fq;
            const f32x4 lw = *(const f32x4*)(p.ln_w + hd * 64 + c), lb = *(const f32x4*)(p.ln_b + hd * 64 + c);
            const u32x2 g2 = *(const u32x2*)(Gd + t * 384 + hd * 64 + c);
            const f32x4 gg = (f32x4){lo_bf(g2.x), hi_bf(g2.x), lo_bf(g2.y), hi_bf(g2.y)};
            const f32x4 o = (acc[n] * rstd * lw + lb + vv[n] * rk) * gg;
            u32x2 w; w.x = pk2(o.x, o.y); w.y = pk2(o.z, o.w);
            *(u32x2*)(p.O + t * D + 256 + hd * 64 + c) = w;
        }
    }
}

__device__ __forceinline__ unsigned ordkey(float f) { const unsigned u = __float_as_uint(f); return (u & 0x80000000u) ? ~u : (u | 0x80000000u); }
__device__ __forceinline__ float unordkey(unsigned k) { return __uint_as_float((k & 0x80000000u) ? (k & 0x7FFFFFFFu) : ~k); }
__device__ __forceinline__ void ins16(unsigned (&L)[16], unsigned x) {
#pragma unroll
    for (int i = 0; i < 16; ++i) { const unsigned hi = L[i] > x ? L[i] : x; x = L[i] > x ? x : L[i]; L[i] = hi; }
}
__device__ __forceinline__ void top16_col(const float* col  , unsigned (&L)[16]) {
#pragma unroll
    for (int i = 0; i < 16; ++i) L[i] = 0u;
#pragma unroll 1
    for (int n0 = 0; n0 < 128; n0 += 16) {
        float x[16];
#pragma unroll
        for (int j = 0; j < 16; ++j) x[j] = col[(size_t)(n0 + j) * NT];
#pragma unroll
        for (int j = 0; j < 16; ++j) ins16(L, (ordkey(x[j]) & 0xFFFFFF80u) | (unsigned)(127 - (n0 + j)));
    }
}
__device__ void phase_topk(const float* SCT, int* EIDX, float* GATE, char* smem, int bid, int nblk) {
    const int tid = otid(), lane = tid & 63, wave = tid >> 6;
    unsigned char* itab = (unsigned char*)smem + tid * 32;
    unsigned char* ctab = (unsigned char*)smem + NTHREADS * 32;
    __syncthreads();
    if (tid < 64) {
        const int c = tid; int ci, cj;
        if (c < 16) { ci = 0; cj = c; } else if (c < 24) { ci = 1; cj = c - 16; } else if (c < 29) { ci = 2; cj = c - 24; } else if (c < 33) { ci = 3; cj = c - 29; }
        else if (c < 36) { ci = 4; cj = c - 33; } else if (c < 38) { ci = 5; cj = c - 36; } else if (c < 40) { ci = 6; cj = c - 38; } else if (c < 42) { ci = 7; cj = c - 40; }
        else if (c < 50) { ci = c - 34; cj = 0; } else { ci = 0; cj = 0; }
        ctab[c] = (unsigned char)(ci | (cj << 4));
    }
    __syncthreads();
    for (int x = bid * 4 + wave; x < (NT / 64) * 8; x += nblk * 4) {
        const int tb = x >> 3, hd = x & 7;
        const int t = tb * 64 + lane;
        unsigned L1[16], L2[16];
        top16_col(SCT + (size_t)(hd * 256) * NT + t, L1);
        top16_col(SCT + (size_t)(hd * 256 + 128) * NT + t, L2);
        float s1[16], s2[16];
#pragma unroll
        for (int i = 0; i < 16; ++i) {
            s1[i] = unordkey(L1[i] & 0xFFFFFF80u); s2[i] = unordkey(L2[i] & 0xFFFFFF80u);
            itab[i] = (unsigned char)(127u - (L1[i] & 127u)); itab[16 + i] = (unsigned char)(127u - (L2[i] & 127u));
        }
        unsigned M[16];
#pragma unroll
        for (int i = 0; i < 16; ++i) M[i] = 0u;
        int c = 0;
#pragma unroll
        for (int ci = 0; ci < 16; ++ci) {
#pragma unroll
            for (int cj = 0; cj < 16; ++cj) {
                if ((ci + 1) * (cj + 1) <= 16) {
                    const int cid = (ci == 0) ? cj : (ci == 1) ? 16 + cj : (ci == 2) ? 24 + cj : (ci == 3) ? 29 + cj : (ci == 4) ? 33 + cj : (ci == 5) ? 36 + cj : (ci == 6) ? 38 + cj : (ci == 7) ? 40 + cj : 34 + ci;
                    ins16(M, (ordkey(s1[ci] + s2[cj]) & 0xFFFFFFC0u) | (unsigned)(63 - cid));
                    ++c;
                }
            }
        }
        float ev[16]; int ee[16];
        const float mx = unordkey(M[0] & 0xFFFFFFC0u);
        float sum = 0.f;
#pragma unroll
        for (int i = 0; i < 16; ++i) {
            const int cid = 63 - (int)(M[i] & 63u);
            const unsigned cc = ctab[cid];
            ee[i] = (int)itab[cc & 15u] * 128 + (int)itab[16 + (cc >> 4)];
            ev[i] = __expf(unordkey(M[i] & 0xFFFFFFC0u) - mx);
            sum += ev[i];
        }
        const float inv = 1.f / sum;
        int* eo = EIDX + (size_t)t * 128 + hd * 16; float* go = GATE + (size_t)t * 128 + hd * 16;
#pragma unroll
        for (int i = 0; i < 4; ++i) {
            *(int4*)(eo + 4 * i) = make_int4(ee[4 * i], ee[4 * i + 1], ee[4 * i + 2], ee[4 * i + 3]);
            *(f32x4*)(go + 4 * i) = (f32x4){ev[4 * i] * inv, ev[4 * i + 1] * inv, ev[4 * i + 2] * inv, ev[4 * i + 3] * inv};
        }
    }
    __syncthreads();
}

typedef float f32x2 __attribute__((ext_vector_type(2)));
__device__ __forceinline__ float gelu_erf(float d) { return 0.5f * d * (1.f + erff(d * 0.7071067811865476f)); }
__device__ void phase_expert(const bf16_t* H, const unsigned char* U4, const unsigned char* V4, const float* SU, const float* SV, const int* EIDX, const float* GATE,
                             const float* X, float* Xo, int bid, int nblk) {
    const int lane = otid() & 63, wave = otid() >> 6;
    for (int t = bid * 4 + wave; t < NT; t += nblk * 4) {
        f32x2 xf[8], acc[8];
        {
            const u32x4 a = *(const u32x4*)(H + (size_t)t * D + lane * 16), b = *(const u32x4*)(H + (size_t)t * D + lane * 16 + 8);
            xf[0] = (f32x2){lo_bf(a.x), hi_bf(a.x)}; xf[1] = (f32x2){lo_bf(a.y), hi_bf(a.y)}; xf[2] = (f32x2){lo_bf(a.z), hi_bf(a.z)}; xf[3] = (f32x2){lo_bf(a.w), hi_bf(a.w)};
            xf[4] = (f32x2){lo_bf(b.x), hi_bf(b.x)}; xf[5] = (f32x2){lo_bf(b.y), hi_bf(b.y)}; xf[6] = (f32x2){lo_bf(b.z), hi_bf(b.z)}; xf[7] = (f32x2){lo_bf(b.w), hi_bf(b.w)};
        }
#pragma unroll
        for (int i = 0; i < 8; ++i) acc[i] = (f32x2){0.f, 0.f};
        const int e_lo = EIDX[(size_t)t * 128 + lane], e_hi = EIDX[(size_t)t * 128 + 64 + lane];
        const float g_lo = GATE[(size_t)t * 128 + lane] * SV[e_lo], g_hi = GATE[(size_t)t * 128 + 64 + lane] * SV[e_hi];
        const float su_lo = SU[e_lo], su_hi = SU[e_hi];
#pragma unroll 1
        for (int e0 = 0; e0 < 128; e0 += 16) {
            const int esrc = (e0 < 64) ? e_lo : e_hi;
            int ei[16]; u32x2 ur[16];
#pragma unroll
            for (int j = 0; j < 16; ++j) { ei[j] = __builtin_amdgcn_readlane(esrc, (e0 & 63) + j); ur[j] = *(const u32x2*)(U4 + (size_t)ei[j] * 512 + lane * 8); }
            float dmine = 0.f;
#pragma unroll
            for (int j = 0; j < 16; ++j) {
                f32x2 d2 = (f32x2){0.f, 0.f};
                d2 = __builtin_elementwise_fma(xf[0], __builtin_amdgcn_cvt_scalef32_pk_f32_fp4(ur[j].x, 1.0f, 0), d2);
                d2 = __builtin_elementwise_fma(xf[1], __builtin_amdgcn_cvt_scalef32_pk_f32_fp4(ur[j].x, 1.0f, 1), d2);
                d2 = __builtin_elementwise_fma(xf[2], __builtin_amdgcn_cvt_scalef32_pk_f32_fp4(ur[j].x, 1.0f, 2), d2);
                d2 = __builtin_elementwise_fma(xf[3], __builtin_amdgcn_cvt_scalef32_pk_f32_fp4(ur[j].x, 1.0f, 3), d2);
                d2 = __builtin_elementwise_fma(xf[4], __builtin_amdgcn_cvt_scalef32_pk_f32_fp4(ur[j].y, 1.0f, 0), d2);
                d2 = __builtin_elementwise_fma(xf[5], __builtin_amdgcn_cvt_scalef32_pk_f32_fp4(ur[j].y, 1.0f, 1), d2);
                d2 = __builtin_elementwise_fma(xf[6], __builtin_amdgcn_cvt_scalef32_pk_f32_fp4(ur[j].y, 1.0f, 2), d2);
                d2 = __builtin_elementwise_fma(xf[7], __builtin_amdgcn_cvt_scalef32_pk_f32_fp4(ur[j].y, 1.0f, 3), d2);
                const float d = wave_sum(d2.x + d2.y);
                if (lane == (e0 & 63) + j) dmine = d;
            }
            const float amine = gelu_erf(dmine * ((e0 < 64) ? su_lo : su_hi)) * ((e0 < 64) ? g_lo : g_hi);
#pragma unroll
            for (int j = 0; j < 16; ++j) ur[j] = *(const u32x2*)(V4 + (size_t)ei[j] * 512 + lane * 8);
#pragma unroll
            for (int j = 0; j < 16; ++j) {
                const float a = __int_as_float(__builtin_amdgcn_readlane(__float_as_int(amine), (e0 & 63) + j));
                const f32x2 a2 = (f32x2){a, a};
                acc[0] = __builtin_elementwise_fma(a2, __builtin_amdgcn_cvt_scalef32_pk_f32_fp4(ur[j].x, 1.0f, 0), acc[0]);
                acc[1] = __builtin_elementwise_fma(a2, __builtin_amdgcn_cvt_scalef32_pk_f32_fp4(ur[j].x, 1.0f, 1), acc[1]);
                acc[2] = __builtin_elementwise_fma(a2, __builtin_amdgcn_cvt_scalef32_pk_f32_fp4(ur[j].x, 1.0f, 2), acc[2]);
                acc[3] = __builtin_elementwise_fma(a2, __builtin_amdgcn_cvt_scalef32_pk_f32_fp4(ur[j].x, 1.0f, 3), acc[3]);
                acc[4] = __builtin_elementwise_fma(a2, __builtin_amdgcn_cvt_scalef32_pk_f32_fp4(ur[j].y, 1.0f, 0), acc[4]);
                acc[5] = __builtin_elementwise_fma(a2, __builtin_amdgcn_cvt_scalef32_pk_f32_fp4(ur[j].y, 1.0f, 1), acc[5]);
                acc[6] = __builtin_elementwise_fma(a2, __builtin_amdgcn_cvt_scalef32_pk_f32_fp4(ur[j].y, 1.0f, 2), acc[6]);
                acc[7] = __builtin_elementwise_fma(a2, __builtin_amdgcn_cvt_scalef32_pk_f32_fp4(ur[j].y, 1.0f, 3), acc[7]);
            }
        }
        const f32x4* xr = (const f32x4*)(X + (size_t)t * D) + lane * 4;
        f32x4* xo = (f32x4*)(Xo + (size_t)t * D) + lane * 4;
#pragma unroll
        for (int i = 0; i < 4; ++i) { f32x4 o = xr[i]; o += (f32x4){acc[2 * i].x, acc[2 * i].y, acc[2 * i + 1].x, acc[2 * i + 1].y}; xo[i] = o; }
    }
}

#define XB_TMO      128
#define XB_XCNT(j)  (256  + 64 * (j))
#define XB_XSUB(j)  (1280 + 64 * (j))
#define XB_XGEN(j)  (2304 + 64 * (j))
#define XB_TOP      3328
#define XB_TOPGEN   3392
#define XCD_BAR_WORDS 3456
#define XB_SPIN_CAP (1u << 22)
#define LAS __attribute__((address_space(3)))
__device__ __forceinline__ unsigned xb_ld(unsigned* p)              { return __hip_atomic_load(p, __ATOMIC_RELAXED, __HIP_MEMORY_SCOPE_AGENT); }
__device__ __forceinline__ unsigned xb_add(unsigned* p, unsigned v) { return __hip_atomic_fetch_add(p, v, __ATOMIC_RELAXED, __HIP_MEMORY_SCOPE_AGENT); }
__device__ __forceinline__ unsigned xb_xcc_id() { return (unsigned)__builtin_amdgcn_s_getreg((3 << 11) | 20) & 0xFu; }
#define XB_SPIN(cond, bar) do { unsigned _sp = 0; while (cond) { __builtin_amdgcn_s_sleep(1); \
    if ((++_sp & 255u) == 0u) { if (xb_ld(&(bar)[XB_TMO])) break; if (_sp > XB_SPIN_CAP) { atomicAdd(&(bar)[XB_TMO], 1u); break; } } } } while (0)
struct XcdBarrier { unsigned* bar; unsigned x; volatile LAS unsigned* st; };
__device__ __forceinline__ XcdBarrier xcd_barrier_post(unsigned* bar, volatile LAS unsigned* st) {
    XcdBarrier b; b.bar = bar; b.x = xb_xcc_id(); b.st = st;
    if (threadIdx.x == 0) (void)xb_add(&bar[XB_XCNT(b.x)], 1u);
    return b;
}
__device__ __forceinline__ void xcd_barrier_complete(unsigned* bar, unsigned x, unsigned& nloc, unsigned& nx) {
    const unsigned G = gridDim.x * gridDim.y * gridDim.z;
    unsigned sum, cnt, mine, sp = 0u;
    for (;;) {
        sum = 0u; cnt = 0u; mine = 0u;
#pragma unroll
        for (unsigned j = 0; j < 16; ++j) { const unsigned c = xb_ld(&bar[XB_XCNT(j)]); sum += c; cnt += (c > 0u) ? 1u : 0u; mine = (j == x) ? c : mine; }
        if (sum == G) break;
        __builtin_amdgcn_s_sleep(1);
        if ((++sp & 255u) == 0u) { if (xb_ld(&bar[XB_TMO])) break; if (sp > XB_SPIN_CAP) { atomicAdd(&bar[XB_TMO], 1u); break; } }
    }
    nloc = mine > 0u ? mine : 1u; nx = cnt > 0u ? cnt : 1u;
}
__device__ __forceinline__ void xcd_barrier(const XcdBarrier& b) {
    asm volatile("s_waitcnt vmcnt(0)" ::: "memory");
    __syncthreads();
    if (threadIdx.x == 0) {
        unsigned* bar = b.bar;
        __builtin_amdgcn_s_waitcnt(0);
        unsigned nloc = b.st[0], nx = b.st[1];
        if (nloc == 0u) { xcd_barrier_complete(bar, b.x, nloc, nx); b.st[0] = nloc; b.st[1] = nx; }
        const unsigned old = xb_add(&bar[XB_XSUB(b.x)], 1u);
        const unsigned gen = old / nloc;
        if (old + 1u == (gen + 1u) * nloc) {
            __builtin_amdgcn_fence(__ATOMIC_RELEASE, "agent");
            asm volatile("s_waitcnt vmcnt(0)" ::: "memory");
            const unsigned og = xb_add(&bar[XB_TOP], 1u);
            const unsigned tg = og / nx;
            if (og + 1u == (tg + 1u) * nx) xb_add(&bar[XB_TOPGEN], 1u);
            else XB_SPIN(xb_ld(&bar[XB_TOPGEN]) == tg, bar);
            __builtin_amdgcn_fence(__ATOMIC_ACQUIRE, "agent");
            xb_add(&bar[XB_XGEN(b.x)], 1u);
            asm volatile("s_waitcnt vmcnt(0)" ::: "memory");
        } else {
            XB_SPIN(xb_ld(&bar[XB_XGEN(b.x)]) == gen, bar);
            __builtin_amdgcn_fence(__ATOMIC_ACQUIRE, "agent");
            asm volatile("s_waitcnt vmcnt(0)" ::: "memory");
        }
    }
    __syncthreads();
}

struct Params {
    const float* in[24];
    float* out; unsigned char* ws;
};
constexpr int LDS_BYTES = 2 * 2 * 128 * GS * 2 + 256;

__device__ __forceinline__ RwP make_rwp(const Params& P, int l) {
    RwP r;
    r.Z = (const bf16_t*)(P.ws + WS_Z); r.mix = P.ws + WS_MIX;
    r.mu = P.in[6] + l * RW_F; r.w_up = P.in[7] + (size_t)l * 64 * 384; r.w_bias = P.in[8] + l * 384; r.a_up = P.in[9] + (size_t)l * 64 * 384; r.a_bias = P.in[10] + l * 384;
    r.g_up = P.in[11] + (size_t)l * 128 * 384; r.k_k = P.in[12] + l * 384; r.k_a = P.in[13] + l * 384; r.r_k = P.in[14] + l * 384; r.ln_w = P.in[15] + l * 384; r.ln_b = P.in[16] + l * 384;
    r.oraw = (float*)(P.ws + WS_H); r.O = (bf16_t*)(P.ws + WS_O); r.Y = (bf16_t*)(P.ws + WS_EIDX); r.lora = (const bf16_t*)(P.ws + WS_LORA + l * LORA_L);
    return r;
}

__global__ void __launch_bounds__(NTHREADS, 2) mega_fwd(Params P) {
    extern __shared__ __attribute__((aligned(16))) char smem[];
    const int bid = blockIdx.x, nblk = gridDim.x;
    volatile LAS unsigned* st = (volatile LAS unsigned*)(smem + LDS_BYTES - 16);
    if (threadIdx.x == 0) { st[0] = 0u; st[1] = 0u; st[2] = 0u; st[3] = 0u; }
    __syncthreads();
    XcdBarrier bar = xcd_barrier_post((unsigned*)(P.ws + WS_CTL), st);
#define GSYNC() xcd_barrier(bar)

    {
        ConvP c{P.in[4], P.in[5], P.in[20], P.in[21], P.in[22], P.in[23], P.in[7], P.in[9], P.in[11], P.ws};
        for (int rep = 0; rep < REP_CONV; ++rep) phase_convert_weights(c, smem, bid, nblk);
        phase_rmsnorm<false>(P.in[0], P.in[1], P.ws + WS_H, bid, nblk);
    }
    GSYNC();
#pragma unroll 1
    for (int l = 0; l < 2; ++l) {
        const float* xin = (l == 0) ? P.in[0] : P.out;
        {
            GemmP g{(const bf16_t*)(P.ws + WS_H), D, 0, 0, (const bf16_t*)(P.ws + WS_WTIN) + (size_t)l * DINP * D, D, D, NT / 128, DINP / 128, P.ws + WS_Z, DINP, nullptr};
            for (int rep = 0; rep < REP_GIN; ++rep) phase_gemm<0>(g, smem, bid, nblk);
            if (l == 0) {
                for (int l2 = 0; l2 < 2; ++l2) {
                    GemmP ge{(const bf16_t*)(P.ws + WS_SK) + (size_t)l2 * 16 * 128 * 128, 128, 0, 128, (const bf16_t*)(P.ws + WS_WTQ) + (size_t)l2 * D * 2048, 2048, 128, 16, 8,
                             (bf16_t*)(P.ws + WS_WEFF) + (size_t)l2 * 2048 * D, D, nullptr};
                    phase_gemm<0>(ge, smem, bid, nblk, (NT / 128 * (DINP / 128) + l2 * 128) % nblk);
                }
            }
        }
        GSYNC();
        RwP rw = make_rwp(P, l);
        LinP lp{(const bf16_t*)(P.ws + WS_Z), (bf16_t*)(P.ws + WS_O), P.in[17] + (size_t)l * 16 * 192, P.in[18] + l * 192, P.in[19] + l * 384, (const float*)(P.ws + WS_ROPE), P.ws + WS_LIN};
        for (int task = bid; task < 512 + 2048; task += nblk) {
            if (task < 512) { for (int rep = 0; rep < REP_PREP; ++rep) rwkv_prep_task(rw, smem, task); }
            else { for (int rep = 0; rep < REP_LIN; ++rep) lin_kv_dispatch(lp, smem, task - 512); }
        }
        GSYNC();
        {
            for (int rep = 0; rep < REP_SCAN; ++rep)
            for (int task = bid; task < 480; task += nblk) {
                const int bh = task / 20, r = task % 20;
                const int seg = r < 4 ? 0 : (r < 12 ? 1 : 2), grp = r < 4 ? r : (r < 12 ? r - 4 : r - 12);
                rwkv_scan_task(rw, smem, bh, seg, grp);
            }
            if (nblk >= 512) { if (bid >= 480) for (int rep = 0; rep < REP_LIN; ++rep) lin_scan_phase(lp, bid - 480, nblk - 480); }
            else { for (int rep = 0; rep < REP_LIN; ++rep) lin_scan_phase(lp, bid, nblk); }
        }
        GSYNC();
        phase_rwkv_chain(rw, bid, nblk);
        GSYNC();
        for (int rep = 0; rep < REP_POST; ++rep) phase_rwkv_post(rw, bid, nblk);
        for (int rep = 0; rep < REP_LIN; ++rep) for (int task = bid; task < 2048; task += nblk) lin_out_dispatch(lp, smem, task);
        GSYNC();
        {
            GemmP g{(const bf16_t*)(P.ws + WS_O), D, 0, 0, (const bf16_t*)(P.ws + WS_WTOUT) + (size_t)l * D * D, D, D, NT / 128, D / 128, P.out, D, xin};
            phase_gemm<2>(g, smem, bid, nblk);
            for (int rep = 1; rep < REP_GOUT; ++rep) { GemmP g2 = g; g2.C = P.ws + WS_MIX; phase_gemm<2>(g2, smem, bid, nblk); }
        }
        GSYNC();
        for (int rep = 0; rep < REP_NORM; ++rep) phase_rmsnorm<false>(P.out, P.in[2] + l * D, P.ws + WS_H, bid, nblk);
        GSYNC();
        {
            GemmP g{(const bf16_t*)(P.ws + WS_H), D, 0, 0, (const bf16_t*)(P.ws + WS_WEFF) + (size_t)l * 2048 * D, D, D, NT / 128, 2048 / 128, P.ws + WS_MIX, NT, nullptr};
            for (int rep = 0; rep < REP_GQ; ++rep) phase_gemm<3>(g, smem, bid, nblk);
        }
        GSYNC();
        for (int rep = 0; rep < REP_TOPK; ++rep) phase_topk((const float*)(P.ws + WS_MIX), (int*)(P.ws + WS_EIDX), (float*)(P.ws + WS_GATE), smem, bid, nblk);
        GSYNC();
        phase_expert((const bf16_t*)(P.ws + WS_H), P.ws + WS_UB + (size_t)l * NEXP * 512, P.ws + WS_VB + (size_t)l * NEXP * 512,
                     (const float*)(P.ws + WS_ESC) + l * NEXP, (const float*)(P.ws + WS_ESC) + (2 + l) * NEXP,
                     (const int*)(P.ws + WS_EIDX), (const float*)(P.ws + WS_GATE), P.out, P.out, bid, nblk);
        GSYNC();
        if (l == 0) { phase_rmsnorm<false>(P.out, P.in[1] + D, P.ws + WS_H, bid, nblk); GSYNC(); }
    }
    phase_rmsnorm<true>(P.out, P.in[3], P.out, bid, nblk);
}

extern "C" void kernel_launch(void* const* d_in, const int* in_sizes, int n_in, void* d_out, int out_size, void* d_ws, size_t ws_size, hipStream_t stream) {
    static int grid = 0;
    if (grid == 0) {
        if (n_in != 24 || ws_size < WS_END) { fprintf(stderr, "kernel_launch: bad args n_in=%d ws=%zu need=%zu\n", n_in, ws_size, (size_t)WS_END); grid = -1; return; }
        int dev = 0, cus = 0, per_cu = 0;
        hipGetDevice(&dev);
        hipDeviceGetAttribute(&cus, hipDeviceAttributeMultiprocessorCount, dev);
        hipFuncSetAttribute((const void*)mega_fwd, hipFuncAttributeMaxDynamicSharedMemorySize, LDS_BYTES);
        hipOccupancyMaxActiveBlocksPerMultiprocessor(&per_cu, (const void*)mega_fwd, NTHREADS, LDS_BYTES);
        if (per_cu < 1) { fprintf(stderr, "kernel_launch: occupancy query says %d\n", per_cu); grid = -1; return; }
        if (per_cu > 2) per_cu = 2;
        grid = cus * per_cu;
        fprintf(stderr, "kernel_launch: grid %d (%d CUs x %d)\n", grid, cus, per_cu);
    }
    if (grid < 0) return;
    hipMemsetAsync((char*)d_ws + WS_CTL, 0, XCD_BAR_WORDS * 4, stream);
    Params P{};
    for (int i = 0; i < 24; ++i) P.in[i] = (const float*)d_in[i];
    P.out = (float*)d_out; P.ws = (unsigned char*)d_ws;
    void* args[] = {&P};
    hipError_t e = hipLaunchCooperativeKernel((const void*)mega_fwd, dim3(grid), dim3(NTHREADS), args, LDS_BYTES, stream);
    if (e != hipSuccess) fprintf(stderr, "cooperative launch failed: %s (grid %d)\n", hipGetErrorString(e), grid);
}
```

```cpp
#include <hip/hip_runtime.h>
#include <stdint.h>
#include <stdio.h>

typedef unsigned short bf16_t;
typedef short bf16x8 __attribute__((ext_vector_type(8)));
typedef float f32x4 __attribute__((ext_vector_type(4)));
typedef unsigned u32x4 __attribute__((ext_vector_type(4)));
typedef unsigned u32x2 __attribute__((ext_vector_type(2)));

#define REP_CONV 1
#define REP_GIN 1
#define REP_PREP 1
#define REP_SCAN 1
#define REP_LIN 1
#define REP_POST 1
#define REP_GOUT 1
#define REP_NORM 1
#define REP_GQ 1
#define REP_GSK 1
#define REP_TOPK 1
#define REP_EXP 1
constexpr int NB = 4, NS = 4096, NT = NB * NS, D = 1024, DIN = 3600, DINP = 3712;
constexpr int ZC_RET = 0, ZC_RW = 1024, ZC_GLA = 2432;
constexpr int RW_F = 1408;
constexpr int NEXP = 16384;
constexpr int NTHREADS = 256;

constexpr size_t MiB = 1024ull * 1024ull;
constexpr size_t WS_CTL   = 0;
constexpr size_t WS_LORA  = 65536;
constexpr size_t LORA_L   = 384ull * 256 * 2;
constexpr size_t WS_ESC   = 524288;
constexpr size_t WS_WTIN  = 1 * MiB;
constexpr size_t WS_WTOUT = WS_WTIN + 2ull * DINP * D * 2;
constexpr size_t WS_WTQ   = WS_WTOUT + 2ull * D * D * 2;
constexpr size_t WS_SK    = WS_WTQ + 2ull * 2048 * D * 2;
constexpr size_t WS_UB    = WS_SK + 2ull * 16 * 128 * 128 * 2;
constexpr size_t WS_VB    = WS_UB + 2ull * NEXP * D;
constexpr size_t WS_LIN   = WS_VB + 2ull * NEXP * D;
constexpr size_t WS_H     = WS_LIN + 64 * MiB;
constexpr size_t WS_Z     = WS_H + (size_t)NT * D * 2;
constexpr size_t WS_O     = WS_Z + (size_t)NT * DINP * 2;
constexpr size_t WS_MIX   = WS_O + (size_t)NT * D * 2;
constexpr size_t WS_EIDX  = WS_MIX + 128 * MiB;
constexpr size_t WS_GATE  = WS_EIDX + (size_t)NT * 128 * 4;
constexpr size_t WS_ROPE  = WS_GATE + (size_t)NT * 128 * 4;
constexpr size_t WS_WEFF  = WS_ROPE + 1 * MiB;
constexpr size_t WS_END   = WS_WEFF + 2ull * 2048 * D * 2;
constexpr size_t RWA = (size_t)NT * 384;
constexpr size_t MX_W   = 0;
constexpr size_t MX_KK  = MX_W + RWA * 4;
constexpr size_t MX_KKA = MX_KK + RWA * 4;
constexpr size_t MX_R   = MX_KKA + RWA * 4;
constexpr size_t MX_K   = MX_R + RWA * 2;
constexpr size_t MX_V   = MX_K + RWA * 2;
constexpr size_t MX_G   = MX_V + RWA * 2;
constexpr size_t MX_END = MX_G + RWA * 2;
static_assert(MX_END <= 128 * MiB, "mix region");

__device__ __forceinline__ float bf2f(bf16_t v) { return __uint_as_float(((unsigned)v) << 16); }
__device__ __forceinline__ bf16_t f2bf(float f) { unsigned u = __float_as_uint(f); u += 0x7FFFu + ((u >> 16) & 1u); return (bf16_t)(u >> 16); }
__device__ __forceinline__ unsigned pk2(float lo, float hi) { return (unsigned)f2bf(lo) | ((unsigned)f2bf(hi) << 16); }
__device__ __forceinline__ float lo_bf(unsigned u) { return __uint_as_float(u << 16); }
__device__ __forceinline__ float hi_bf(unsigned u) { return __uint_as_float(u & 0xFFFF0000u); }
template <int CTRL> __device__ __forceinline__ float dpp_f(float v) { return __int_as_float(__builtin_amdgcn_update_dpp(0, __float_as_int(v), CTRL, 0xF, 0xF, true)); }
template <int CTRL> __device__ __forceinline__ unsigned dpp_u(unsigned v) { return (unsigned)__builtin_amdgcn_update_dpp(0, (int)v, CTRL, 0xF, 0xF, true); }
__device__ __forceinline__ float row16_sum(float v) { v += dpp_f<0x128>(v); v += dpp_f<0x124>(v); v += dpp_f<0x122>(v); v += dpp_f<0x121>(v); return v; }
__device__ __forceinline__ float xor16_sum(float v) { auto r = __builtin_amdgcn_permlane16_swap(__float_as_uint(v), __float_as_uint(v), false, false); return __uint_as_float(r[0]) + __uint_as_float(r[1]); }
__device__ __forceinline__ float xor32_sum(float v) { auto r = __builtin_amdgcn_permlane32_swap(__float_as_uint(v), __float_as_uint(v), false, false); return __uint_as_float(r[0]) + __uint_as_float(r[1]); }
__device__ __forceinline__ float wave_sum(float v) { return xor32_sum(xor16_sum(row16_sum(v))); }
__device__ __forceinline__ unsigned umax_(unsigned a, unsigned b) { return a > b ? a : b; }
__device__ __forceinline__ unsigned wave_max_u32(unsigned v) {
    v = umax_(v, dpp_u<0x128>(v)); v = umax_(v, dpp_u<0x124>(v)); v = umax_(v, dpp_u<0x122>(v)); v = umax_(v, dpp_u<0x121>(v));
    { auto r = __builtin_amdgcn_permlane16_swap(v, v, false, false); v = umax_(r[0], r[1]); }
    { auto r = __builtin_amdgcn_permlane32_swap(v, v, false, false); v = umax_(r[0], r[1]); }
    return v;
}
__device__ __forceinline__ float sigmoidf_(float x) { return 1.f / (1.f + __expf(-x)); }
__device__ __forceinline__ float softplusf_(float x) { return fmaxf(x, 0.f) + log1pf(__expf(-fabsf(x))); }

__device__ __forceinline__ int otid() { int t = threadIdx.x; asm volatile("" : "+v"(t)); return t; }

__device__ void transpose_tile(const float* __restrict__ W, int K, int N, bf16_t* __restrict__ Wt, int kt, int nt, float* tile  ) {
    const int tid = otid();
    const int k0 = kt * 64, n0 = nt * 64;
#pragma unroll
    for (int i = 0; i < 16; ++i) {
        const int k = i * 4 + (tid >> 6), n = tid & 63;
        tile[k * 65 + n] = (n0 + n < N) ? W[(size_t)(k0 + k) * N + n0 + n] : 0.f;
    }
    __syncthreads();
#pragma unroll
    for (int i = 0; i < 16; ++i) {
        const int n = i * 4 + (tid >> 6), k = tid & 63;
        Wt[(size_t)(n0 + n) * K + k0 + k] = f2bf(tile[k * 65 + n]);
    }
    __syncthreads();
}

struct ConvP {
    const float* w_in; const float* w_out; const float* w_q; const float* sk; const float* u; const float* v;
    const float* w_up; const float* a_up; const float* g_up;
    unsigned char* ws;
};

__device__ void phase_convert_weights(const ConvP& p, char* smem, int bid, int nblk) {
    float* tile = (float*)smem;
    constexpr int T_IN = 16 * 58, T_OUT = 16 * 16, T_L = T_IN + T_OUT;
    for (int it = bid; it < 2 * T_L; it += nblk) {
        const int l = it / T_L; int r = it % T_L;
        if (r < T_IN) { transpose_tile(p.w_in + (size_t)l * D * DIN, D, DIN, (bf16_t*)(p.ws + WS_WTIN) + (size_t)l * DINP * D, r / 58, r % 58, tile); continue; }
        r -= T_IN;
        transpose_tile(p.w_out + (size_t)l * D * D, D, D, (bf16_t*)(p.ws + WS_WTOUT) + (size_t)l * D * D, r / 16, r % 16, tile);
    }
    const size_t gtid = (size_t)bid * NTHREADS + otid(), gn = (size_t)nblk * NTHREADS;
    {
        for (size_t i = gtid; i < 2ull * 384 * 256; i += gn) {
            const int l = (int)(i / (384 * 256)), r = (int)(i % (384 * 256)), c = r >> 8, k = r & 255;
            bf16_t* base = (bf16_t*)(p.ws + WS_LORA + l * LORA_L);
            if (k < 64) base[c * 64 + k] = f2bf(p.w_up[(size_t)l * 64 * 384 + k * 384 + c]);
            else if (k < 128) base[384 * 64 + c * 64 + (k - 64)] = f2bf(p.a_up[(size_t)l * 64 * 384 + (k - 64) * 384 + c]);
            else base[2 * 384 * 64 + c * 128 + (k - 128)] = f2bf(p.g_up[(size_t)l * 128 * 384 + (k - 128) * 384 + c]);
        }
    }
    {
        float* ct = (float*)(p.ws + WS_ROPE); float* stb = ct + NS * 32;
        for (size_t i = gtid; i < (size_t)NS * 32; i += gn) {
            const int pos = (int)(i >> 5), fi = (int)(i & 31);
            const float inv = exp2f(-(float)fi * (13.287712379549449f / 32.f));
            float sn, cs; sincosf((float)pos * inv, &sn, &cs);
            ct[i] = cs; stb[i] = sn;
        }
    }
    {
        const size_t n8 = (2ull * D * 2048) / 8;
        const f32x4* s = (const f32x4*)p.w_q; u32x4* d = (u32x4*)(p.ws + WS_WTQ);
        for (size_t i = gtid; i < n8; i += gn) { f32x4 a = s[2 * i], b = s[2 * i + 1]; u32x4 o; o.x = pk2(a.x, a.y); o.y = pk2(a.z, a.w); o.z = pk2(b.x, b.y); o.w = pk2(b.z, b.w); d[i] = o; }
    }
    {
        const size_t n8 = (2ull * 16 * 128 * 128) / 8;
        const f32x4* s = (const f32x4*)p.sk; u32x4* d = (u32x4*)(p.ws + WS_SK);
        for (size_t i = gtid; i < n8; i += gn) { f32x4 a = s[2 * i], b = s[2 * i + 1]; u32x4 o; o.x = pk2(a.x, a.y); o.y = pk2(a.z, a.w); o.z = pk2(b.x, b.y); o.w = pk2(b.z, b.w); d[i] = o; }
    }
}

__device__ void phase_convert_uv(const ConvP& p, int bid, int nblk) {
    {
        const int lane = otid() & 63, gw = bid * 4 + (otid() >> 6), ngw = nblk * 4;
        for (int r = gw; r < 4 * NEXP; r += ngw) {
            const bool isv = r >= 2 * NEXP; const int rr = isv ? r - 2 * NEXP : r;
            const f32x4* src = (const f32x4*)((isv ? p.v : p.u) + (size_t)rr * D) + lane * 4;
            f32x4 x[4]; float mx = 0.f;
#pragma unroll
            for (int i = 0; i < 4; ++i) { x[i] = src[i]; mx = fmaxf(mx, fmaxf(fmaxf(fabsf(x[i].x), fabsf(x[i].y)), fmaxf(fabsf(x[i].z), fabsf(x[i].w)))); }
            mx = __uint_as_float(wave_max_u32(__float_as_uint(mx)));
            const float sc = mx > 0.f ? 6.f / mx : 0.f;
            unsigned w0 = 0u, w1 = 0u;
            w0 = __builtin_amdgcn_cvt_scalef32_pk_fp4_f32(w0, x[0].x * sc, x[0].y * sc, 1.0f, 0); w0 = __builtin_amdgcn_cvt_scalef32_pk_fp4_f32(w0, x[0].z * sc, x[0].w * sc, 1.0f, 1);
            w0 = __builtin_amdgcn_cvt_scalef32_pk_fp4_f32(w0, x[1].x * sc, x[1].y * sc, 1.0f, 2); w0 = __builtin_amdgcn_cvt_scalef32_pk_fp4_f32(w0, x[1].z * sc, x[1].w * sc, 1.0f, 3);
            w1 = __builtin_amdgcn_cvt_scalef32_pk_fp4_f32(w1, x[2].x * sc, x[2].y * sc, 1.0f, 0); w1 = __builtin_amdgcn_cvt_scalef32_pk_fp4_f32(w1, x[2].z * sc, x[2].w * sc, 1.0f, 1);
            w1 = __builtin_amdgcn_cvt_scalef32_pk_fp4_f32(w1, x[3].x * sc, x[3].y * sc, 1.0f, 2); w1 = __builtin_amdgcn_cvt_scalef32_pk_fp4_f32(w1, x[3].z * sc, x[3].w * sc, 1.0f, 3);
            *(u32x2*)(p.ws + (isv ? WS_VB : WS_UB) + (size_t)rr * 512 + lane * 8) = (u32x2){w0, w1};
            if (lane == 0) ((float*)(p.ws + WS_ESC))[r] = mx * (1.f / 6.f);
        }
    }
}

template <bool OUT_F32>
__device__ void phase_rmsnorm(const float* x, const float* __restrict__ g, void* out, int bid, int nblk) {
    const int lane = otid() & 63, wave = otid() >> 6;
    const int gw = bid * 4 + wave, ngw = nblk * 4;
    f32x4 gv[4];
#pragma unroll
    for (int j = 0; j < 4; ++j) gv[j] = ((const f32x4*)g)[lane + 64 * j];
    for (int row = gw; row < NT; row += ngw) {
        const f32x4* xr = (const f32x4*)(x + (size_t)row * D) + lane;
        f32x4 v[4]; float s = 0.f;
#pragma unroll
        for (int j = 0; j < 4; ++j) { v[j] = xr[64 * j]; s += v[j].x * v[j].x + v[j].y * v[j].y + v[j].z * v[j].z + v[j].w * v[j].w; }
        s = wave_sum(s);
        const float rs = rsqrtf(s * (1.f / D) + 1e-6f);
        if (OUT_F32) {
            f32x4* o = (f32x4*)((float*)out + (size_t)row * D) + lane;
#pragma unroll
            for (int j = 0; j < 4; ++j) o[64 * j] = v[j] * rs * gv[j];
        } else {
            u32x2* o = (u32x2*)((bf16_t*)out + (size_t)row * D) + lane;
#pragma unroll
            for (int j = 0; j < 4; ++j) { f32x4 y = v[j] * rs * gv[j]; u32x2 w; w.x = pk2(y.x, y.y); w.y = pk2(y.z, y.w); o[64 * j] = w; }
        }
    }
}

struct GemmP {
    const bf16_t* A; int lda; int a_koff;
    int b_koff;
    const bf16_t* Bt; int ldb; int K;
    int MT, NTl;
    void* C; int ldc; const float* R;
};
constexpr int GS = 72;
template <int MODE>
__device__ void phase_gemm(const GemmP& p, char* smem, int bid, int nblk, int tile0 = 0) {
    bf16_t* As = (bf16_t*)smem;
    bf16_t* Bs = As + 128 * GS;
    const int tid = otid(), lane = tid & 63, wave = tid >> 6;
    const int wr = wave >> 1, wc = wave & 1;
    const int lr = tid >> 3, lc = (tid & 7) * 8;
    const int fl = lane & 15, fq = lane >> 4;
    const int ntiles = p.MT * p.NTl;
    for (int tile = bid - tile0 + ((bid < tile0) ? nblk * ((tile0 - bid + nblk - 1) / nblk) : 0); tile < ntiles; tile += nblk) {
        const int mt = tile / p.NTl, nt = tile % p.NTl;
        const bf16_t* Ag = p.A + (size_t)mt * 128 * p.lda + (size_t)nt * p.a_koff + (size_t)lr * p.lda + lc;
        const bf16_t* Bg = p.Bt + (size_t)nt * 128 * p.ldb + (size_t)mt * p.b_koff + (size_t)lr * p.ldb + lc;
        f32x4 acc[4][4];
#pragma unroll
        for (int m = 0; m < 4; ++m)
#pragma unroll
            for (int n = 0; n < 4; ++n) acc[m][n] = (f32x4){0.f, 0.f, 0.f, 0.f};
        u32x4 ra[4], rb[4];
        const int nk = p.K >> 6;
#pragma unroll
        for (int i = 0; i < 4; ++i) { ra[i] = *(const u32x4*)(Ag + (size_t)(32 * i) * p.lda); rb[i] = *(const u32x4*)(Bg + (size_t)(32 * i) * p.ldb); }
        __syncthreads();
#pragma unroll
        for (int i = 0; i < 4; ++i) { *(u32x4*)(As + (lr + 32 * i) * GS + lc) = ra[i]; *(u32x4*)(Bs + (lr + 32 * i) * GS + lc) = rb[i]; }
        if (nk > 1) {
#pragma unroll
            for (int i = 0; i < 4; ++i) { ra[i] = *(const u32x4*)(Ag + (size_t)(32 * i) * p.lda + 64); rb[i] = *(const u32x4*)(Bg + (size_t)(32 * i) * p.ldb + 64); }
        }
        __syncthreads();
        for (int kt = 0; kt < nk; ++kt) {
            const bf16_t* Ac = As + (kt & 1) * (256 * GS); const bf16_t* Bc = Ac + 128 * GS;
            bf16_t* An = As + ((kt & 1) ^ 1) * (256 * GS); bf16_t* Bn = An + 128 * GS;
            if (kt + 1 < nk) {
#pragma unroll
                for (int i = 0; i < 4; ++i) { *(u32x4*)(An + (lr + 32 * i) * GS + lc) = ra[i]; *(u32x4*)(Bn + (lr + 32 * i) * GS + lc) = rb[i]; }
                if (kt + 2 < nk) {
#pragma unroll
                    for (int i = 0; i < 4; ++i) { ra[i] = *(const u32x4*)(Ag + (size_t)(32 * i) * p.lda + (kt + 2) * 64); rb[i] = *(const u32x4*)(Bg + (size_t)(32 * i) * p.ldb + (kt + 2) * 64); }
                }
            }
#pragma unroll
            for (int ks = 0; ks < 2; ++ks) {
                bf16x8 xa[4], wb[4];
#pragma unroll
                for (int m = 0; m < 4; ++m) xa[m] = *(const bf16x8*)(Ac + (wr * 64 + m * 16 + fl) * GS + ks * 32 + fq * 8);
#pragma unroll
                for (int n = 0; n < 4; ++n) wb[n] = *(const bf16x8*)(Bc + (wc * 64 + n * 16 + fl) * GS + ks * 32 + fq * 8);
#pragma unroll
                for (int m = 0; m < 4; ++m)
#pragma unroll
                    for (int n = 0; n < 4; ++n) acc[m][n] = (MODE == 3) ? __builtin_amdgcn_mfma_f32_16x16x32_bf16(xa[m], wb[n], acc[m][n], 0, 0, 0)
                                                                     : __builtin_amdgcn_mfma_f32_16x16x32_bf16(wb[n], xa[m], acc[m][n], 0, 0, 0);
            }
            __syncthreads();
        }
#pragma unroll
        for (int m = 0; m < 4; ++m) {
#pragma unroll
            for (int n = 0; n < 4; ++n) {
                const f32x4 a = acc[m][n];
                if (MODE == 3) {
                    const size_t row = (size_t)mt * 128 + wr * 64 + m * 16 + fq * 4;
                    const size_t col = (size_t)nt * 128 + wc * 64 + n * 16 + fl;
                    *(f32x4*)((float*)p.C + col * p.ldc + row) = a;
                } else {
                    const size_t row = (size_t)mt * 128 + wr * 64 + m * 16 + fl;
                    const int col = nt * 128 + wc * 64 + n * 16 + fq * 4;
                    if (MODE == 0) { u32x2 w; w.x = pk2(a.x, a.y); w.y = pk2(a.z, a.w); *(u32x2*)((bf16_t*)p.C + row * p.ldc + col) = w; }
                    else if (MODE == 1) { *(f32x4*)((float*)p.C + row * p.ldc + col) = a; }
                    else { const f32x4 r = *(const f32x4*)(p.R + row * p.ldc + col); *(f32x4*)((float*)p.C + row * p.ldc + col) = r + a; }
                }
            }
        }
    }
}

constexpr int LS = 72;
struct LinP {
    const bf16_t* Z; bf16_t* O;
    const float* gk_up;
    const float* gk_bias;
    const float* norm_w;
    const float* rope;
    unsigned char* lin;
};
__device__ __forceinline__ bf16x8 ldfrag(const bf16_t* base, int row, int kofs) { return *(const bf16x8*)(base + row * LS + kofs); }

constexpr size_t LN_KV_RET = 0;
constexpr size_t LN_KV_GLA = LN_KV_RET + 1024ull * 64 * 64 * 4;
constexpr size_t LN_S_RET  = LN_KV_GLA + 1024ull * 96 * 64 * 4;
constexpr size_t LN_S_GLA  = LN_S_RET + 1024ull * 64 * 64 * 2;
constexpr size_t LN_DEC    = LN_S_GLA + 1024ull * 96 * 64 * 2;
static_assert(LN_DEC + 2048ull * 64 * 4 <= 64 * MiB, "lin region");

__device__ __forceinline__ float wave_incl_scan(float v) {
    v += dpp_f<0x111>(v); v += dpp_f<0x112>(v); v += dpp_f<0x114>(v); v += dpp_f<0x118>(v);
    v += __int_as_float(__builtin_amdgcn_update_dpp(0, __float_as_int(v), 0x142, 0xA, 0xF, false));
    v += __int_as_float(__builtin_amdgcn_update_dpp(0, __float_as_int(v), 0x143, 0xC, 0xF, false));
    return v;
}
__device__ __forceinline__ float readlane_f(float v, int l) { return __int_as_float(__builtin_amdgcn_readlane(__float_as_int(v), l)); }

__device__ __forceinline__ void rot8(const bf16_t* src, const float* rope, int spos, int cq, unsigned (&o1)[4], unsigned (&o2)[4]) {
    const u32x4 q1 = *(const u32x4*)(src + cq * 8), q2 = *(const u32x4*)(src + 32 + cq * 8);
    const unsigned q1w[4] = {q1.x, q1.y, q1.z, q1.w}, q2w[4] = {q2.x, q2.y, q2.z, q2.w};
    const f32x4 c0 = *(const f32x4*)(rope + spos * 32 + cq * 8), c1 = *(const f32x4*)(rope + spos * 32 + cq * 8 + 4);
    const f32x4 s0 = *(const f32x4*)(rope + NS * 32 + spos * 32 + cq * 8), s1 = *(const f32x4*)(rope + NS * 32 + spos * 32 + cq * 8 + 4);
    const float csv[8] = {c0.x, c0.y, c0.z, c0.w, c1.x, c1.y, c1.z, c1.w}, snv[8] = {s0.x, s0.y, s0.z, s0.w, s1.x, s1.y, s1.z, s1.w};
#pragma unroll
    for (int e = 0; e < 4; ++e) {
        const float a1l = lo_bf(q1w[e]), a1h = hi_bf(q1w[e]), a2l = lo_bf(q2w[e]), a2h = hi_bf(q2w[e]);
        o1[e] = pk2(a1l * csv[2 * e] - a2l * snv[2 * e], a1h * csv[2 * e + 1] - a2h * snv[2 * e + 1]);
        o2[e] = pk2(a1l * snv[2 * e] + a2l * csv[2 * e], a1h * snv[2 * e + 1] + a2h * csv[2 * e + 1]);
    }
}
__device__ __forceinline__ void load_vts(const bf16_t* Z, size_t t0, int voff, int nch, bf16_t* Vts, int tid) {
    for (int x = tid; x < 64 * nch; x += NTHREADS) {
        const int tok = x / nch, ch = x % nch;
        const u32x4 vv = *(const u32x4*)(Z + (t0 + tok) * DINP + voff + ch * 8);
        const unsigned w[4] = {vv.x, vv.y, vv.z, vv.w};
#pragma unroll
        for (int e = 0; e < 4; ++e) { Vts[(ch * 8 + 2 * e) * LS + tok] = (bf16_t)(w[e] & 0xFFFFu); Vts[(ch * 8 + 2 * e + 1) * LS + tok] = (bf16_t)(w[e] >> 16); }
    }
}
__device__ __forceinline__ void load_gd(const bf16_t* zr, float (&gd)[16]) {
    const u32x4 g0 = *(const u32x4*)zr, g1 = *(const u32x4*)(zr + 8);
    gd[0] = lo_bf(g0.x); gd[1] = hi_bf(g0.x); gd[2] = lo_bf(g0.y); gd[3] = hi_bf(g0.y); gd[4] = lo_bf(g0.z); gd[5] = hi_bf(g0.z); gd[6] = lo_bf(g0.w); gd[7] = hi_bf(g0.w);
    gd[8] = lo_bf(g1.x); gd[9] = hi_bf(g1.x); gd[10] = lo_bf(g1.y); gd[11] = hi_bf(g1.y); gd[12] = lo_bf(g1.z); gd[13] = hi_bf(g1.z); gd[14] = lo_bf(g1.w); gd[15] = hi_bf(g1.w);
}
__device__ __forceinline__ float gla_gk(const LinP& p, const float (&gd)[16], int h, int d) {
    float x = p.gk_bias[h * 48 + d];
#pragma unroll
    for (int i = 0; i < 16; ++i) x += gd[i] * p.gk_up[i * 192 + h * 48 + d];
    return (fminf(x, 0.f) - log1pf(__expf(-fabsf(x)))) * (1.f / 16.f);
}
__device__ __forceinline__ float ret_lg(int h) { const float e = exp2f(-5.f - (float)h * (4.f / 3.f)); return log1pf(-e); }

template <bool IS_GLA>
__device__ void lin_kv_task(const LinP& p, char* smem, int b, int h, int c) {
    constexpr int DV = IS_GLA ? 96 : 64, NVB = DV / 16;
    const int koff = IS_GLA ? (ZC_GLA + 192 + h * 48) : (ZC_RET + 256 + h * 64);
    const int voff = IS_GLA ? (ZC_GLA + 384 + h * 96) : (ZC_RET + 512 + h * 64);
    const int gkdoff = ZC_GLA + 768;
    bf16_t* Ks = (bf16_t*)smem;
    bf16_t* Kts = Ks + 64 * LS;
    bf16_t* Vts = Kts + 64 * LS;
    float* decs = (float*)(Vts + 96 * LS);
    const int tid = otid(), lane = tid & 63, wave = tid >> 6;
    const int fl = lane & 15, fq = lane >> 4;
    const size_t t0 = (size_t)b * NS + (size_t)c * 64;
    const int task = (b * 4 + h) * 64 + c;
    __syncthreads();
    if (IS_GLA) {
        for (int x = tid; x < 64 * 6; x += NTHREADS) {
            const int tok = x / 6, ch = x % 6;
            *(u32x4*)(Ks + tok * LS + ch * 8) = *(const u32x4*)(p.Z + (t0 + tok) * DINP + koff + ch * 8);
        }
        for (int x = tid; x < 16 * LS / 2; x += NTHREADS) ((unsigned*)(Kts + 48 * LS))[x] = 0u;
        if (tid < 16) decs[48 + tid] = 1.f;
        load_vts(p.Z, t0, voff, 12, Vts, tid);
    } else {
        const int tok = tid >> 2, cq = tid & 3;
        unsigned k1[4], k2[4];
        rot8(p.Z + (t0 + tok) * DINP + koff, p.rope, c * 64 + tok, cq, k1, k2);
        const float fk2 = 0.125f * __expf(ret_lg(h) * (float)(63 - tok));
#pragma unroll
        for (int e = 0; e < 4; ++e) {
            Kts[(cq * 8 + 2 * e) * LS + tok] = f2bf(lo_bf(k1[e]) * fk2); Kts[(cq * 8 + 2 * e + 1) * LS + tok] = f2bf(hi_bf(k1[e]) * fk2);
            Kts[(32 + cq * 8 + 2 * e) * LS + tok] = f2bf(lo_bf(k2[e]) * fk2); Kts[(32 + cq * 8 + 2 * e + 1) * LS + tok] = f2bf(hi_bf(k2[e]) * fk2);
        }
        if (tid < 64) decs[tid] = __expf(ret_lg(h) * 64.f);
        load_vts(p.Z, t0, voff, 8, Vts, tid);
    }
    __syncthreads();
    if (IS_GLA) {
        float gd[16];
        load_gd(p.Z + (t0 + lane) * DINP + gkdoff, gd);
#pragma unroll 1
        for (int dd = 0; dd < 12; ++dd) {
            const int d = wave * 12 + dd;
            const float bc = wave_incl_scan(gla_gk(p, gd, h, d));
            const float bl = readlane_f(bc, 63);
            Kts[d * LS + lane] = f2bf(bf2f(Ks[lane * LS + d]) * __expf(bl - bc));
            if (lane == 0) decs[d] = __expf(bl);
        }
        __syncthreads();
    }
    float* KV = (float*)(p.lin + (IS_GLA ? LN_KV_GLA : LN_KV_RET)) + (size_t)task * DV * 64;
#pragma unroll
    for (int vb = 0; vb < NVB; ++vb) {
        f32x4 a4 = (f32x4){0.f, 0.f, 0.f, 0.f};
#pragma unroll
        for (int ks = 0; ks < 2; ++ks) {
            const bf16x8 a = ldfrag(Kts, 16 * wave + fl, ks * 32 + fq * 8);
            const bf16x8 bv = ldfrag(Vts, 16 * vb + fl, ks * 32 + fq * 8);
            a4 = __builtin_amdgcn_mfma_f32_16x16x32_bf16(a, bv, a4, 0, 0, 0);
        }
        *(f32x4*)(KV + (size_t)(16 * vb + fl) * 64 + 16 * wave + 4 * fq) = a4;
    }
    if (tid < 64) ((float*)(p.lin + LN_DEC))[(size_t)((IS_GLA ? 1024 : 0) + task) * 64 + tid] = decs[tid];
}

__device__ void lin_scan_phase(const LinP& p, int vbid, int nvblk) {
    const int tid = otid();
    for (int it = vbid; it < 160; it += nvblk) {
        const bool gla = it >= 64;
        const int r = gla ? it - 64 : it;
        const int per = gla ? 6 : 4, DVx = gla ? 96 : 64;
        const int bh = r / per, e = (r % per) * 1024 + tid;
        const float* KV = (const float*)(p.lin + (gla ? LN_KV_GLA : LN_KV_RET)) + (size_t)bh * 64 * DVx * 64 + e;
        bf16_t* Sb = (bf16_t*)(p.lin + (gla ? LN_S_GLA : LN_S_RET)) + (size_t)bh * 64 * DVx * 64 + e;
        const float* DEC = (const float*)(p.lin + LN_DEC) + (size_t)((gla ? 1024 : 0) + bh * 64) * 64 + (e & 63);
        float S0 = 0.f, S1 = 0.f, S2 = 0.f, S3 = 0.f;
#pragma unroll 8
        for (int c = 0; c < 64; ++c) {
            const size_t o = (size_t)c * DVx * 64;
            const float k0 = KV[o], k1 = KV[o + 256], k2 = KV[o + 512], k3 = KV[o + 768], dc = DEC[c * 64];
            Sb[o] = f2bf(S0); Sb[o + 256] = f2bf(S1); Sb[o + 512] = f2bf(S2); Sb[o + 768] = f2bf(S3);
            S0 = S0 * dc + k0; S1 = S1 * dc + k1; S2 = S2 * dc + k2; S3 = S3 * dc + k3;
        }
    }
}

template <bool IS_GLA>
__device__ void lin_out_task(const LinP& p, char* smem, int b, int h, int c) {
    constexpr int DV = IS_GLA ? 96 : 64, NVB = DV / 16;
    const int qoff = IS_GLA ? (ZC_GLA + 0 + h * 48) : (ZC_RET + 0 + h * 64);
    const int koff = IS_GLA ? (ZC_GLA + 192 + h * 48) : (ZC_RET + 256 + h * 64);
    const int voff = IS_GLA ? (ZC_GLA + 384 + h * 96) : (ZC_RET + 512 + h * 64);
    const int goff = IS_GLA ? (ZC_GLA + 784 + h * 96) : (ZC_RET + 768 + h * 64);
    const int gkdoff = ZC_GLA + 768;
    const int ooff = IS_GLA ? (640 + h * 96) : (h * 64);
    bf16_t* Qs = (bf16_t*)smem;
    bf16_t* Ks = Qs + 64 * LS;
    bf16_t* Ps = Ks + 64 * LS;
    bf16_t* Vts = Ps + 64 * LS;
    bf16_t* Sts = Vts + 96 * LS;
    const int tid = otid(), lane = tid & 63, wave = tid >> 6;
    const int fl = lane & 15, fq = lane >> 4;
    const size_t t0 = (size_t)b * NS + (size_t)c * 64;
    const int task = (b * 4 + h) * 64 + c;
    __syncthreads();
    {
        const bf16_t* Sb = (const bf16_t*)(p.lin + (IS_GLA ? LN_S_GLA : LN_S_RET)) + (size_t)task * DV * 64;
        for (int x = tid; x < DV * 8; x += NTHREADS) { const int v = x >> 3, ch = x & 7; *(u32x4*)(Sts + v * LS + ch * 8) = *(const u32x4*)(Sb + v * 64 + ch * 8); }
    }
    if (IS_GLA) {
        for (int x = tid; x < 64 * 6; x += NTHREADS) {
            const int tok = x / 6, ch = x % 6;
            const bf16_t* zr = p.Z + (t0 + tok) * DINP;
            *(u32x4*)(Qs + tok * LS + ch * 8) = *(const u32x4*)(zr + qoff + ch * 8);
            *(u32x4*)(Ks + tok * LS + ch * 8) = *(const u32x4*)(zr + koff + ch * 8);
        }
        for (int x = tid; x < 64 * 2; x += NTHREADS) {
            const int tok = x >> 1, ch = 6 + (x & 1);
            *(u32x4*)(Qs + tok * LS + ch * 8) = (u32x4){0u, 0u, 0u, 0u};
            *(u32x4*)(Ks + tok * LS + ch * 8) = (u32x4){0u, 0u, 0u, 0u};
        }
        load_vts(p.Z, t0, voff, 12, Vts, tid);
    } else {
        const int tok = tid >> 2, cq = tid & 3;
        const bf16_t* zr = p.Z + (t0 + tok) * DINP;
        unsigned q1[4], q2[4], k1[4], k2[4];
        rot8(zr + qoff, p.rope, c * 64 + tok, cq, q1, q2);
        rot8(zr + koff, p.rope, c * 64 + tok, cq, k1, k2);
        const float lg = ret_lg(h);
        const float fqd = __expf(lg * (float)(tok + 1)), fk = 0.125f * __expf(-lg * (float)(tok + 1));
#pragma unroll
        for (int e = 0; e < 4; ++e) {
            q1[e] = pk2(lo_bf(q1[e]) * fqd, hi_bf(q1[e]) * fqd); q2[e] = pk2(lo_bf(q2[e]) * fqd, hi_bf(q2[e]) * fqd);
            k1[e] = pk2(lo_bf(k1[e]) * fk, hi_bf(k1[e]) * fk); k2[e] = pk2(lo_bf(k2[e]) * fk, hi_bf(k2[e]) * fk);
        }
        *(u32x4*)(Qs + tok * LS + cq * 8) = (u32x4){q1[0], q1[1], q1[2], q1[3]};
        *(u32x4*)(Qs + tok * LS + 32 + cq * 8) = (u32x4){q2[0], q2[1], q2[2], q2[3]};
        *(u32x4*)(Ks + tok * LS + cq * 8) = (u32x4){k1[0], k1[1], k1[2], k1[3]};
        *(u32x4*)(Ks + tok * LS + 32 + cq * 8) = (u32x4){k2[0], k2[1], k2[2], k2[3]};
        load_vts(p.Z, t0, voff, 8, Vts, tid);
    }
    __syncthreads();
    if (IS_GLA) {
        float gd[16];
        load_gd(p.Z + (t0 + lane) * DINP + gkdoff, gd);
#pragma unroll 1
        for (int dd = 0; dd < 12; ++dd) {
            const int d = wave * 12 + dd;
            const float bc = wave_incl_scan(gla_gk(p, gd, h, d));
            const float eq = __expf(bc) * 0.14433756729740643f  , ek = __expf(-bc);
            Qs[lane * LS + d] = f2bf(bf2f(Qs[lane * LS + d]) * eq);
            Ks[lane * LS + d] = f2bf(bf2f(Ks[lane * LS + d]) * ek);
        }
        __syncthreads();
    }
#pragma unroll
    for (int jb = 0; jb < 4; ++jb) {
        f32x4 ap = (f32x4){0.f, 0.f, 0.f, 0.f};
#pragma unroll
        for (int ks = 0; ks < 2; ++ks) {
            const bf16x8 a = ldfrag(Ks, 16 * jb + fl, ks * 32 + fq * 8);
            const bf16x8 bq = ldfrag(Qs, 16 * wave + fl, ks * 32 + fq * 8);
            ap = __builtin_amdgcn_mfma_f32_16x16x32_bf16(a, bq, ap, 0, 0, 0);
        }
        const int i = 16 * wave + fl, j0 = 16 * jb + 4 * fq;
        u32x2 w;
        w.x = pk2(j0 + 0 <= i ? ap.x : 0.f, j0 + 1 <= i ? ap.y : 0.f);
        w.y = pk2(j0 + 2 <= i ? ap.z : 0.f, j0 + 3 <= i ? ap.w : 0.f);
        *(u32x2*)(Ps + i * LS + j0) = w;
    }
    __syncthreads();
    {
        f32x4 ao[NVB];
        float ss = 0.f;
#pragma unroll
        for (int vb = 0; vb < NVB; ++vb) {
            f32x4 a4 = (f32x4){0.f, 0.f, 0.f, 0.f};
#pragma unroll
            for (int ks = 0; ks < 2; ++ks) {
                const bf16x8 a = ldfrag(Vts, 16 * vb + fl, ks * 32 + fq * 8);
                const bf16x8 bp = ldfrag(Ps, 16 * wave + fl, ks * 32 + fq * 8);
                a4 = __builtin_amdgcn_mfma_f32_16x16x32_bf16(a, bp, a4, 0, 0, 0);
            }
#pragma unroll
            for (int ks = 0; ks < 2; ++ks) {
                const bf16x8 a = ldfrag(Sts, 16 * vb + fl, ks * 32 + fq * 8);
                const bf16x8 bq = ldfrag(Qs, 16 * wave + fl, ks * 32 + fq * 8);
                a4 = __builtin_amdgcn_mfma_f32_16x16x32_bf16(a, bq, a4, 0, 0, 0);
            }
            ao[vb] = a4;
            ss += a4.x * a4.x + a4.y * a4.y + a4.z * a4.z + a4.w * a4.w;
        }
        ss = xor32_sum(xor16_sum(ss));
        const float inv = rsqrtf(ss * (1.f / DV) + 1e-5f);
        const size_t t = t0 + 16 * wave + fl;
#pragma unroll
        for (int vb = 0; vb < NVB; ++vb) {
            const int v0 = 16 * vb + 4 * fq;
            const u32x2 gg = *(const u32x2*)(p.Z + t * DINP + goff + v0);
            float g4[4] = {lo_bf(gg.x), hi_bf(gg.x), lo_bf(gg.y), hi_bf(gg.y)};
            float o4[4] = {ao[vb].x, ao[vb].y, ao[vb].z, ao[vb].w};
#pragma unroll
            for (int e = 0; e < 4; ++e) {
                float y = o4[e] * inv;
                if (IS_GLA) y *= p.norm_w[h * 96 + v0 + e];
                const float g = g4[e];
                o4[e] = y * (g / (1.f + __expf(-g)));
            }
            u32x2 w; w.x = pk2(o4[0], o4[1]); w.y = pk2(o4[2], o4[3]);
            *(u32x2*)(p.O + t * D + ooff + v0) = w;
        }
    }
}
__device__ __forceinline__ void lin_kv_dispatch(const LinP& p, char* smem, int task) {
    const int r = task & 1023, bh = r >> 6, c = r & 63;
    if (task < 1024) lin_kv_task<false>(p, smem, bh >> 2, bh & 3, c); else lin_kv_task<true>(p, smem, bh >> 2, bh & 3, c);
}
__device__ __forceinline__ void lin_out_dispatch(const LinP& p, char* smem, int task) {
    const int r = task & 1023, bh = r >> 6, c = r & 63;
    if (task < 1024) lin_out_task<false>(p, smem, bh >> 2, bh & 3, c); else lin_out_task<true>(p, smem, bh >> 2, bh & 3, c);
}

struct RwP {
    const bf16_t* Z; unsigned char* mix;
    const float* mu; const float* w_up; const float* w_bias; const float* a_up; const float* a_bias; const float* g_up;
    const float* k_k; const float* k_a; const float* r_k; const float* ln_w; const float* ln_b;
    float* oraw; bf16_t* O; bf16_t* Y; const bf16_t* lora;
};
constexpr int PS = 264;
__device__ __forceinline__ f32x4 bf4(u32x2 w) { return (f32x4){lo_bf(w.x), hi_bf(w.x), lo_bf(w.y), hi_bf(w.y)}; }
__device__ void rwkv_prep_task(const RwP& p, char* smem, int tile) {
    bf16_t* At = (bf16_t*)smem;
    const int tid = otid(), lane = tid & 63, wave = tid >> 6;
    const int fl = lane & 15, fq = lane >> 4;
    const int t0 = tile * 32;
    float* Wd = (float*)(p.mix + MX_W); float* KKd = (float*)(p.mix + MX_KK); float* KKAd = (float*)(p.mix + MX_KKA);
    bf16_t* Rd = (bf16_t*)(p.mix + MX_R); bf16_t* Kd = (bf16_t*)(p.mix + MX_K); bf16_t* Vd = (bf16_t*)(p.mix + MX_V); bf16_t* Gd = (bf16_t*)(p.mix + MX_G);
    __syncthreads();
    {
        const int tok = tid >> 3, t = t0 + tok;
        const bool first = (t & (NS - 1)) == 0;
        const bf16_t* zr = p.Z + (size_t)t * DINP + ZC_RW + 1152;
#pragma unroll
        for (int i = 0; i < 4; ++i) {
            const int ch = (tid & 7) + 8 * i;
            const u32x4 cur = *(const u32x4*)(zr + ch * 8);
            const u32x4 prv = first ? (u32x4){0u, 0u, 0u, 0u} : *(const u32x4*)(zr - DINP + ch * 8);
            const f32x4 m0 = *(const f32x4*)(p.mu + 1152 + ch * 8), m1 = *(const f32x4*)(p.mu + 1152 + ch * 8 + 4);
            const unsigned cw[4] = {cur.x, cur.y, cur.z, cur.w}, pw[4] = {prv.x, prv.y, prv.z, prv.w};
            const float mm[8] = {m0.x, m0.y, m0.z, m0.w, m1.x, m1.y, m1.z, m1.w};
            float o[8];
#pragma unroll
            for (int e = 0; e < 4; ++e) {
                const float f0 = lo_bf(cw[e]), f1 = hi_bf(cw[e]), g0 = lo_bf(pw[e]), g1 = hi_bf(pw[e]);
                o[2 * e] = f0 + (g0 - f0) * mm[2 * e]; o[2 * e + 1] = f1 + (g1 - f1) * mm[2 * e + 1];
            }
            if (ch < 8) {
#pragma unroll
                for (int e = 0; e < 8; ++e) o[e] = tanhf(o[e]);
            } else if (ch >= 16) {
#pragma unroll
                for (int e = 0; e < 8; ++e) o[e] = sigmoidf_(o[e]);
            }
            *(u32x4*)(At + tok * PS + ch * 8) = (u32x4){pk2(o[0], o[1]), pk2(o[2], o[3]), pk2(o[4], o[5]), pk2(o[6], o[7])};
        }
    }
    __syncthreads();
    bf16x8 xb[8];
#pragma unroll
    for (int ks = 0; ks < 8; ++ks) xb[ks] = *(const bf16x8*)(At + (16 * (wave & 1) + fl) * PS + ks * 32 + fq * 8);
    const int t = t0 + 16 * (wave & 1) + fl, b = t >> 12, sq = t & (NS - 1);
    const bool first = sq == 0;
    const bf16_t* zc = p.Z + (size_t)t * DINP + ZC_RW;
    const bf16_t* WupT = p.lora; const bf16_t* AupT = p.lora + 384 * 64; const bf16_t* GupT = p.lora + 2 * 384 * 64;
#pragma unroll 1
    for (int hd = (wave >> 1) * 3; hd < (wave >> 1) * 3 + 3; ++hd) {
        f32x4 aw[4], aa[4], ag[4];
#pragma unroll
        for (int n = 0; n < 4; ++n) {
            const int cr = hd * 64 + 16 * n + fl;
            f32x4 w4 = (f32x4){0.f, 0.f, 0.f, 0.f}, a4 = w4, g4 = w4;
#pragma unroll
            for (int ks = 0; ks < 2; ++ks) {
                w4 = __builtin_amdgcn_mfma_f32_16x16x32_bf16(*(const bf16x8*)(WupT + cr * 64 + ks * 32 + fq * 8), xb[ks], w4, 0, 0, 0);
                a4 = __builtin_amdgcn_mfma_f32_16x16x32_bf16(*(const bf16x8*)(AupT + cr * 64 + ks * 32 + fq * 8), xb[2 + ks], a4, 0, 0, 0);
            }
#pragma unroll
            for (int ks = 0; ks < 4; ++ks) g4 = __builtin_amdgcn_mfma_f32_16x16x32_bf16(*(const bf16x8*)(GupT + cr * 128 + ks * 32 + fq * 8), xb[4 + ks], g4, 0, 0, 0);
            aw[n] = w4; aa[n] = a4; ag[n] = g4;
        }
        f32x4 kx[4], av[4], kkv[4];
        float ss = 0.f;
        const size_t hrow = ((size_t)(b * 6 + hd) * NS + sq) * 64;
#pragma unroll
        for (int n = 0; n < 4; ++n) {
            const int cl = 16 * n + 4 * fq, c = hd * 64 + cl;
            f32x4 rr = bf4(*(const u32x2*)(zc + c)), kk = bf4(*(const u32x2*)(zc + 384 + c)), vv = bf4(*(const u32x2*)(zc + 768 + c));
            f32x4 rp = (f32x4){0.f, 0.f, 0.f, 0.f}, kp = rp, vp = rp;
            if (!first) { rp = bf4(*(const u32x2*)(zc - DINP + c)); kp = bf4(*(const u32x2*)(zc - DINP + 384 + c)); vp = bf4(*(const u32x2*)(zc - DINP + 768 + c)); }
            rr = rr + (rp - rr) * *(const f32x4*)(p.mu + c); kk = kk + (kp - kk) * *(const f32x4*)(p.mu + 384 + c); vv = vv + (vp - vv) * *(const f32x4*)(p.mu + 768 + c);
            const f32x4 wb = *(const f32x4*)(p.w_bias + c), ab = *(const f32x4*)(p.a_bias + c), kkc = *(const f32x4*)(p.k_k + c), kac = *(const f32x4*)(p.k_a + c);
            f32x4 dec, a;
            {
                const f32x4 xw = wb + aw[n], xa = ab + aa[n];
                dec.x = __expf(-__expf(-softplusf_(-xw.x) - 0.5f)); dec.y = __expf(-__expf(-softplusf_(-xw.y) - 0.5f));
                dec.z = __expf(-__expf(-softplusf_(-xw.z) - 0.5f)); dec.w = __expf(-__expf(-softplusf_(-xw.w) - 0.5f));
                a.x = sigmoidf_(xa.x); a.y = sigmoidf_(xa.y); a.z = sigmoidf_(xa.z); a.w = sigmoidf_(xa.w);
            }
            const f32x4 kr = kk * kkc;
            ss += kr.x * kr.x + kr.y * kr.y + kr.z * kr.z + kr.w * kr.w;
            kkv[n] = kr; av[n] = a; kx[n] = kk;
            const f32x4 kmod = kk * ((a - 1.f) * kac + 1.f);
            *(f32x4*)(Wd + hrow + cl) = dec;
            u32x2 w;
            w.x = pk2(rr.x, rr.y); w.y = pk2(rr.z, rr.w); *(u32x2*)(Rd + hrow + cl) = w;
            w.x = pk2(kmod.x, kmod.y); w.y = pk2(kmod.z, kmod.w); *(u32x2*)(Kd + hrow + cl) = w;
            w.x = pk2(vv.x, vv.y); w.y = pk2(vv.z, vv.w); *(u32x2*)(Vd + hrow + cl) = w;
            w.x = pk2(ag[n].x, ag[n].y); w.y = pk2(ag[n].z, ag[n].w); *(u32x2*)(Gd + (size_t)t * 384 + c) = w;
        }
        ss = xor32_sum(xor16_sum(ss));
        const float rn = rsqrtf(fmaxf(ss, 1e-24f));
#pragma unroll
        for (int n = 0; n < 4; ++n) {
            const int cl = 16 * n + 4 * fq;
            const f32x4 kn = kkv[n] * rn;
            *(f32x4*)(KKd + hrow + cl) = kn;
            *(f32x4*)(KKAd + hrow + cl) = kn * av[n];
        }
    }
}

constexpr int SC_STEPS = 16;
constexpr int SEG_BEG[4] = {0, 1376, 2736, 4096};
constexpr size_t MX_SE0 = MX_END;
constexpr size_t MX_XE  = MX_SE0 + 24ull * 3 * 4096 * 4;
constexpr size_t MX_SST = MX_XE + 24ull * 3 * 4096 * 4;
static_assert(MX_SST + 24ull * 3 * 4096 * 2 <= 128 * MiB, "mix region");
__device__ __forceinline__ float row8_sum(float v) { v += dpp_f<0xB1>(v); v += dpp_f<0x4E>(v); v += dpp_f<0x141>(v); return v; }
__device__ void rwkv_scan_task(const RwP& p, char* smem, int bh, int seg, int grp) {
    float* buf = (float*)smem;
    float* obuf = buf + 2 * 6 * SC_STEPS * 64;
    const int tid = otid(), lane = tid & 63, wave = tid >> 6;
    const int rloc = wave * 8 + (lane >> 3);
    const bool ident = grp >= 2;
    const int row = (grp & 1) * 32 + rloc;
    const int c8 = (lane & 7) * 8;
    const int s_beg = seg == 0 ? SEG_BEG[0] : (seg == 1 ? SEG_BEG[1] : SEG_BEG[2]);
    const int s_end = seg == 0 ? SEG_BEG[1] : (seg == 1 ? SEG_BEG[2] : SEG_BEG[3]);
    const int NCH = (s_end - s_beg) / SC_STEPS;
    const size_t hb = ((size_t)bh * NS + s_beg) * 64;
    const float* Wd = (const float*)(p.mix + MX_W) + hb;
    const float* KKd = (const float*)(p.mix + MX_KK) + hb;
    const float* KKAd = (const float*)(p.mix + MX_KKA) + hb;
    const bf16_t* Rd = (const bf16_t*)(p.mix + MX_R) + hb;
    const bf16_t* Kd = (const bf16_t*)(p.mix + MX_K) + hb;
    const bf16_t* Vd = (const bf16_t*)(p.mix + MX_V) + hb;
    float* orow = p.oraw + hb;
    bf16_t* yrow = p.Y + hb;
    f32x4 Sa, Sb;
    Sa.x = (ident && c8 + 0 == row) ? 1.f : 0.f; Sa.y = (ident && c8 + 1 == row) ? 1.f : 0.f; Sa.z = (ident && c8 + 2 == row) ? 1.f : 0.f; Sa.w = (ident && c8 + 3 == row) ? 1.f : 0.f;
    Sb.x = (ident && c8 + 4 == row) ? 1.f : 0.f; Sb.y = (ident && c8 + 5 == row) ? 1.f : 0.f; Sb.z = (ident && c8 + 6 == row) ? 1.f : 0.f; Sb.w = (ident && c8 + 7 == row) ? 1.f : 0.f;
    struct Stg { f32x4 w, kk, ka; u32x2 r, k, v; };
    Stg sA, sB;
    auto gload = [&](Stg& g, int ch) {
        const size_t e = (size_t)ch * SC_STEPS * 64 + tid * 4;
        g.w = *(const f32x4*)(Wd + e); g.kk = *(const f32x4*)(KKd + e); g.ka = *(const f32x4*)(KKAd + e);
        g.r = *(const u32x2*)(Rd + e); g.k = *(const u32x2*)(Kd + e); g.v = *(const u32x2*)(Vd + e);
    };
    auto lstore = [&](const Stg& g, int bsel) {
        float* bb = buf + bsel * 6 * SC_STEPS * 64 + tid * 4;
        *(f32x4*)(bb + 0 * SC_STEPS * 64) = g.w; *(f32x4*)(bb + 1 * SC_STEPS * 64) = g.kk; *(f32x4*)(bb + 2 * SC_STEPS * 64) = g.ka;
        *(f32x4*)(bb + 3 * SC_STEPS * 64) = (f32x4){lo_bf(g.r.x), hi_bf(g.r.x), lo_bf(g.r.y), hi_bf(g.r.y)};
        *(f32x4*)(bb + 4 * SC_STEPS * 64) = (f32x4){lo_bf(g.k.x), hi_bf(g.k.x), lo_bf(g.k.y), hi_bf(g.k.y)};
        *(f32x4*)(bb + 5 * SC_STEPS * 64) = (f32x4){lo_bf(g.v.x), hi_bf(g.v.x), lo_bf(g.v.y), hi_bf(g.v.y)};
    };
    __syncthreads();
    gload(sA, 0); lstore(sA, 0);
    gload(sA, 1);
    __syncthreads();
    const float vmask = ident ? 0.f : 1.f;
    struct Ops { f32x4 w0, w1, kk0, kk1, ka0, ka1, r0, r1, k0, k1; float v; };
    auto ldops = [&](Ops& o, const float* bb, int st) {
        const float* q = bb + st * 64 + c8;
        o.w0 = *(const f32x4*)(q); o.w1 = *(const f32x4*)(q + 4);
        o.kk0 = *(const f32x4*)(q + 1 * SC_STEPS * 64); o.kk1 = *(const f32x4*)(q + 1 * SC_STEPS * 64 + 4);
        o.ka0 = *(const f32x4*)(q + 2 * SC_STEPS * 64); o.ka1 = *(const f32x4*)(q + 2 * SC_STEPS * 64 + 4);
        o.r0 = *(const f32x4*)(q + 3 * SC_STEPS * 64); o.r1 = *(const f32x4*)(q + 3 * SC_STEPS * 64 + 4);
        o.k0 = *(const f32x4*)(q + 4 * SC_STEPS * 64); o.k1 = *(const f32x4*)(q + 4 * SC_STEPS * 64 + 4);
        o.v = bb[5 * SC_STEPS * 64 + st * 64 + row];
    };
    auto chunk = [&](int ch, Stg& cur  , Stg& nxt  ) {
        if (ch + 2 < NCH) gload(nxt, ch + 2);
        const float* bb = buf + (ch & 1) * 6 * SC_STEPS * 64;
        Ops o; ldops(o, bb, 0);
#pragma unroll
        for (int st = 0; st < SC_STEPS; ++st) {
            Ops n; ldops(n, bb, (st + 1 < SC_STEPS) ? st + 1 : st);
            const float vx = o.v * vmask;
            const f32x4 pa = Sa * o.kk0 + Sb * o.kk1;
            const float sa = -row8_sum((pa.x + pa.y) + (pa.z + pa.w));
            Sa = Sa * o.w0 + o.k0 * vx + o.ka0 * sa;
            Sb = Sb * o.w1 + o.k1 * vx + o.ka1 * sa;
            const f32x4 qa = Sa * o.r0 + Sb * o.r1;
            obuf[st * 32 + rloc] = row8_sum((qa.x + qa.y) + (qa.z + qa.w));
            o = n;
        }
        __syncthreads();
#pragma unroll
        for (int i = 0; i < 2; ++i) {
            const int idx = tid + 256 * i, st = idx >> 5, rr = idx & 31;
            const size_t oi = ((size_t)ch * SC_STEPS + st) * 64 + (grp & 1) * 32 + rr;
            if (ident) yrow[oi] = f2bf(obuf[idx]); else orow[oi] = obuf[idx];
        }
        if (ch + 1 < NCH) lstore(cur, (ch + 1) & 1);
        __syncthreads();
    };
    for (int ch = 0; ch < NCH; ch += 2) {
        chunk(ch, sA, sB);
        if (ch + 1 < NCH) chunk(ch + 1, sB, sA);
    }
    float* fin = (float*)(p.mix + (ident ? MX_XE : MX_SE0)) + ((size_t)(bh * 3 + seg) * 64 + row) * 64 + c8;
    *(f32x4*)fin = Sa; *(f32x4*)(fin + 4) = Sb;
}

__device__ void phase_rwkv_chain(const RwP& p, int bid, int nblk) {
    const int lane = otid() & 63, wave = otid() >> 6;
    const float* SE0 = (const float*)(p.mix + MX_SE0); const float* XE = (const float*)(p.mix + MX_XE);
    bf16_t* SST = (bf16_t*)(p.mix + MX_SST);
    for (int x = bid * 4 + wave; x < 24 * 4; x += nblk * 4) {
        const int bh = x >> 2, cg = (x & 3) * 16;
        const float* s1 = SE0 + ((size_t)(bh * 3 + 0) * 64 + lane) * 64;
        const float* e1 = SE0 + ((size_t)(bh * 3 + 1) * 64 + lane) * 64 + cg;
        const float* X1 = XE + (size_t)(bh * 3 + 1) * 4096 + cg;
        float o[16];
#pragma unroll
        for (int k = 0; k < 16; ++k) o[k] = e1[k];
        for (int i = 0; i < 64; ++i) {
            const float si = s1[i];
#pragma unroll
            for (int k = 0; k < 16; ++k) o[k] += si * X1[i * 64 + k];
        }
        bf16_t* d1 = SST + ((size_t)(bh * 3 + 1) * 64 + lane) * 64 + cg;
        bf16_t* d2 = SST + ((size_t)(bh * 3 + 2) * 64 + lane) * 64 + cg;
#pragma unroll
        for (int k = 0; k < 16; ++k) { d1[k] = f2bf(s1[cg + k]); d2[k] = f2bf(o[k]); }
    }
}

__device__ void phase_rwkv_post(const RwP& p, int bid, int nblk) {
    const int lane = otid() & 63, wave = otid() >> 6;
    const int fl = lane & 15, fq = lane >> 4;
    const bf16_t* Rd = (const bf16_t*)(p.mix + MX_R); const bf16_t* Kd = (const bf16_t*)(p.mix + MX_K); const bf16_t* Vd = (const bf16_t*)(p.mix + MX_V);
    const bf16_t* Gd = (const bf16_t*)(p.mix + MX_G); const bf16_t* SST = (const bf16_t*)(p.mix + MX_SST);
    for (int x = bid * 4 + wave; x < 24 * (NS / 16); x += nblk * 4) {
        const int bh = x / (NS / 16), s0 = (x % (NS / 16)) * 16;
        const int b = bh / 6, hd = bh % 6;
        const int seg = s0 < SEG_BEG[1] ? 0 : (s0 < SEG_BEG[2] ? 1 : 2);
        const size_t hrow = ((size_t)bh * NS + s0 + fl) * 64;
        f32x4 acc[4];
#pragma unroll
        for (int n = 0; n < 4; ++n) acc[n] = *(const f32x4*)(p.oraw + hrow + 16 * n + 4 * fq);
        if (seg > 0) {
            const bf16_t* ss = SST + (size_t)(bh * 3 + seg) * 4096;
#pragma unroll
            for (int ks = 0; ks < 2; ++ks) {
                const bf16x8 yb = *(const bf16x8*)(p.Y + hrow + ks * 32 + fq * 8);
#pragma unroll
                for (int n = 0; n < 4; ++n) {
                    const bf16x8 sa = *(const bf16x8*)(ss + (size_t)(16 * n + fl) * 64 + ks * 32 + fq * 8);
                    acc[n] = __builtin_amdgcn_mfma_f32_16x16x32_bf16(sa, yb, acc[n], 0, 0, 0);
                }
            }
        }
        float sm = 0.f;
#pragma unroll
        for (int n = 0; n < 4; ++n) sm += acc[n].x + acc[n].y + acc[n].z + acc[n].w;
        const float mean = xor32_sum(xor16_sum(sm)) * (1.f / 64.f);
        float sv = 0.f;
#pragma unroll
        for (int n = 0; n < 4; ++n) { acc[n] = acc[n] - mean; sv += acc[n].x * acc[n].x + acc[n].y * acc[n].y + acc[n].z * acc[n].z + acc[n].w * acc[n].w; }
        const float rstd = rsqrtf(xor32_sum(xor16_sum(sv)) * (1.f / 64.f) + 64e-5f);
        float rk = 0.f; f32x4 vv[4];
#pragma unroll
        for (int n = 0; n < 4; ++n) {
            const int c = 16 * n + 4 * fq;
            const u32x2 r2 = *(const u32x2*)(Rd + hrow + c), k2 = *(const u32x2*)(Kd + hrow + c), v2 = *(const u32x2*)(Vd + hrow + c);
            const f32x4 rkw = *(const f32x4*)(p.r_k + hd * 64 + c);
            rk += lo_bf(r2.x) * lo_bf(k2.x) * rkw.x + hi_bf(r2.x) * hi_bf(k2.x) * rkw.y + lo_bf(r2.y) * lo_bf(k2.y) * rkw.z + hi_bf(r2.y) * hi_bf(k2.y) * rkw.w;
            vv[n] = (f32x4){lo_bf(v2.x), hi_bf(v2.x), lo_bf(v2.y), hi_bf(v2.y)};
        }
        rk = xor32_sum(xor16_sum(rk));
        const size_t t = (size_t)b * NS + s0 + fl;
#pragma unroll
        for (int n = 0; n < 4; ++n) {
            const int c = 16 * n + 4 * fq;
            const f32x4 lw = *(const f32x4*)(p.ln_w + hd * 64 + c), lb = *(const f32x4*)(p.ln_b + hd * 64 + c);
            const u32x2 g2 = *(const u32x2*)(Gd + t * 384 + hd * 64 + c);
            const f32x4 gg = (f32x4){lo_bf(g2.x), hi_bf(g2.x), lo_bf(g2.y), hi_bf(g2.y)};
            const f32x4 o = (acc[n] * rstd * lw + lb + vv[n] * rk) * gg;
            u32x2 w; w.x = pk2(o.x, o.y); w.y = pk2(o.z, o.w);
            *(u32x2*)(p.O + t * D + 256 + hd * 64 + c) = w;
        }
    }
}

__device__ __forceinline__ unsigned ordkey(float f) { const unsigned u = __float_as_uint(f); return (u & 0x80000000u) ? ~u : (u | 0x80000000u); }
__device__ __forceinline__ float unordkey(unsigned k) { return __uint_as_float((k & 0x80000000u) ? (k & 0x7FFFFFFFu) : ~k); }
__device__ __forceinline__ void ins16(unsigned (&L)[16], unsigned x) {
#pragma unroll
    for (int i = 0; i < 16; ++i) { const unsigned hi = L[i] > x ? L[i] : x; x = L[i] > x ? x : L[i]; L[i] = hi; }
}
__device__ __forceinline__ void top16_col(const float* col  , unsigned (&L)[16]) {
#pragma unroll
    for (int i = 0; i < 16; ++i) L[i] = 0u;
#pragma unroll 1
    for (int n0 = 0; n0 < 128; n0 += 16) {
        float x[16];
#pragma unroll
        for (int j = 0; j < 16; ++j) x[j] = col[(size_t)(n0 + j) * NT];
#pragma unroll
        for (int j = 0; j < 16; ++j) ins16(L, (ordkey(x[j]) & 0xFFFFFF80u) | (unsigned)(127 - (n0 + j)));
    }
}
__device__ void phase_topk(const float* SCT, int* EIDX, float* GATE, char* smem, int bid, int nblk) {
    const int tid = otid(), lane = tid & 63, wave = tid >> 6;
    unsigned char* itab = (unsigned char*)smem + tid * 32;
    unsigned char* ctab = (unsigned char*)smem + NTHREADS * 32;
    __syncthreads();
    if (tid < 64) {
        const int c = tid; int ci, cj;
        if (c < 16) { ci = 0; cj = c; } else if (c < 24) { ci = 1; cj = c - 16; } else if (c < 29) { ci = 2; cj = c - 24; } else if (c < 33) { ci = 3; cj = c - 29; }
        else if (c < 36) { ci = 4; cj = c - 33; } else if (c < 38) { ci = 5; cj = c - 36; } else if (c < 40) { ci = 6; cj = c - 38; } else if (c < 42) { ci = 7; cj = c - 40; }
        else if (c < 50) { ci = c - 34; cj = 0; } else { ci = 0; cj = 0; }
        ctab[c] = (unsigned char)(ci | (cj << 4));
    }
    __syncthreads();
    for (int x = bid * 4 + wave; x < (NT / 64) * 8; x += nblk * 4) {
        const int tb = x >> 3, hd = x & 7;
        const int t = tb * 64 + lane;
        unsigned L1[16], L2[16];
        top16_col(SCT + (size_t)(hd * 256) * NT + t, L1);
        top16_col(SCT + (size_t)(hd * 256 + 128) * NT + t, L2);
        float s1[16], s2[16];
#pragma unroll
        for (int i = 0; i < 16; ++i) {
            s1[i] = unordkey(L1[i] & 0xFFFFFF80u); s2[i] = unordkey(L2[i] & 0xFFFFFF80u);
            itab[i] = (unsigned char)(127u - (L1[i] & 127u)); itab[16 + i] = (unsigned char)(127u - (L2[i] & 127u));
        }
        unsigned M[16];
#pragma unroll
        for (int i = 0; i < 16; ++i) M[i] = 0u;
        int c = 0;
#pragma unroll
        for (int ci = 0; ci < 16; ++ci) {
#pragma unroll
            for (int cj = 0; cj < 16; ++cj) {
                if ((ci + 1) * (cj + 1) <= 16) {
                    const int cid = (ci == 0) ? cj : (ci == 1) ? 16 + cj : (ci == 2) ? 24 + cj : (ci == 3) ? 29 + cj : (ci == 4) ? 33 + cj : (ci == 5) ? 36 + cj : (ci == 6) ? 38 + cj : (ci == 7) ? 40 + cj : 34 + ci;
                    ins16(M, (ordkey(s1[ci] + s2[cj]) & 0xFFFFFFC0u) | (unsigned)(63 - cid));
                    ++c;
                }
            }
        }
        float ev[16]; int ee[16];
        const float mx = unordkey(M[0] & 0xFFFFFFC0u);
        float sum = 0.f;
#pragma unroll
        for (int i = 0; i < 16; ++i) {
            const int cid = 63 - (int)(M[i] & 63u);
            const unsigned cc = ctab[cid];
            ee[i] = (int)itab[cc & 15u] * 128 + (int)itab[16 + (cc >> 4)];
            ev[i] = __expf(unordkey(M[i] & 0xFFFFFFC0u) - mx);
            sum += ev[i];
        }
        const float inv = 1.f / sum;
        int* eo = EIDX + (size_t)t * 128 + hd * 16; float* go = GATE + (size_t)t * 128 + hd * 16;
#pragma unroll
        for (int i = 0; i < 4; ++i) {
            *(int4*)(eo + 4 * i) = make_int4(ee[4 * i], ee[4 * i + 1], ee[4 * i + 2], ee[4 * i + 3]);
            *(f32x4*)(go + 4 * i) = (f32x4){ev[4 * i] * inv, ev[4 * i + 1] * inv, ev[4 * i + 2] * inv, ev[4 * i + 3] * inv};
        }
    }
    __syncthreads();
}

typedef float f32x2 __attribute__((ext_vector_type(2)));
__device__ __forceinline__ float gelu_erf(float d) { return 0.5f * d * (1.f + erff(d * 0.7071067811865476f)); }
template <int NMODE>
__device__ void phase_expert(const bf16_t* H, const unsigned char* U4, const unsigned char* V4, const float* SU, const float* SV, const int* EIDX, const float* GATE,
                             const float* X, float* Xo, const float* gn, bf16_t* Hn, int bid, int nblk) {
    const int lane = otid() & 63, wave = otid() >> 6;
    for (int t = bid * 4 + wave; t < NT; t += nblk * 4) {
        f32x2 xf[8], acc[8];
        {
            const u32x4 a = *(const u32x4*)(H + (size_t)t * D + lane * 16), b = *(const u32x4*)(H + (size_t)t * D + lane * 16 + 8);
            xf[0] = (f32x2){lo_bf(a.x), hi_bf(a.x)}; xf[1] = (f32x2){lo_bf(a.y), hi_bf(a.y)}; xf[2] = (f32x2){lo_bf(a.z), hi_bf(a.z)}; xf[3] = (f32x2){lo_bf(a.w), hi_bf(a.w)};
            xf[4] = (f32x2){lo_bf(b.x), hi_bf(b.x)}; xf[5] = (f32x2){lo_bf(b.y), hi_bf(b.y)}; xf[6] = (f32x2){lo_bf(b.z), hi_bf(b.z)}; xf[7] = (f32x2){lo_bf(b.w), hi_bf(b.w)};
        }
#pragma unroll
        for (int i = 0; i < 8; ++i) acc[i] = (f32x2){0.f, 0.f};
        const int e_lo = EIDX[(size_t)t * 128 + lane], e_hi = EIDX[(size_t)t * 128 + 64 + lane];
        const float g_lo = GATE[(size_t)t * 128 + lane] * SV[e_lo], g_hi = GATE[(size_t)t * 128 + 64 + lane] * SV[e_hi];
        const float su_lo = SU[e_lo], su_hi = SU[e_hi];
#pragma unroll 1
        for (int e0 = 0; e0 < 128; e0 += 16) {
            const int esrc = (e0 < 64) ? e_lo : e_hi;
            int ei[16]; u32x2 ur[16];
#pragma unroll
            for (int j = 0; j < 16; ++j) { ei[j] = __builtin_amdgcn_readlane(esrc, (e0 & 63) + j); ur[j] = *(const u32x2*)(U4 + (size_t)ei[j] * 512 + lane * 8); }
            float dmine = 0.f;
#pragma unroll
            for (int j = 0; j < 16; ++j) {
                f32x2 d2 = (f32x2){0.f, 0.f};
                d2 = __builtin_elementwise_fma(xf[0], __builtin_amdgcn_cvt_scalef32_pk_f32_fp4(ur[j].x, 1.0f, 0), d2);
                d2 = __builtin_elementwise_fma(xf[1], __builtin_amdgcn_cvt_scalef32_pk_f32_fp4(ur[j].x, 1.0f, 1), d2);
                d2 = __builtin_elementwise_fma(xf[2], __builtin_amdgcn_cvt_scalef32_pk_f32_fp4(ur[j].x, 1.0f, 2), d2);
                d2 = __builtin_elementwise_fma(xf[3], __builtin_amdgcn_cvt_scalef32_pk_f32_fp4(ur[j].x, 1.0f, 3), d2);
                d2 = __builtin_elementwise_fma(xf[4], __builtin_amdgcn_cvt_scalef32_pk_f32_fp4(ur[j].y, 1.0f, 0), d2);
                d2 = __builtin_elementwise_fma(xf[5], __builtin_amdgcn_cvt_scalef32_pk_f32_fp4(ur[j].y, 1.0f, 1), d2);
                d2 = __builtin_elementwise_fma(xf[6], __builtin_amdgcn_cvt_scalef32_pk_f32_fp4(ur[j].y, 1.0f, 2), d2);
                d2 = __builtin_elementwise_fma(xf[7], __builtin_amdgcn_cvt_scalef32_pk_f32_fp4(ur[j].y, 1.0f, 3), d2);
                const float d = wave_sum(d2.x + d2.y);
                if (lane == (e0 & 63) + j) dmine = d;
            }
            const float amine = gelu_erf(dmine * ((e0 < 64) ? su_lo : su_hi)) * ((e0 < 64) ? g_lo : g_hi);
#pragma unroll
            for (int j = 0; j < 16; ++j) ur[j] = *(const u32x2*)(V4 + (size_t)ei[j] * 512 + lane * 8);
#pragma unroll
            for (int j = 0; j < 16; ++j) {
                const float a = __int_as_float(__builtin_amdgcn_readlane(__float_as_int(amine), (e0 & 63) + j));
                const f32x2 a2 = (f32x2){a, a};
                acc[0] = __builtin_elementwise_fma(a2, __builtin_amdgcn_cvt_scalef32_pk_f32_fp4(ur[j].x, 1.0f, 0), acc[0]);
                acc[1] = __builtin_elementwise_fma(a2, __builtin_amdgcn_cvt_scalef32_pk_f32_fp4(ur[j].x, 1.0f, 1), acc[1]);
                acc[2] = __builtin_elementwise_fma(a2, __builtin_amdgcn_cvt_scalef32_pk_f32_fp4(ur[j].x, 1.0f, 2), acc[2]);
                acc[3] = __builtin_elementwise_fma(a2, __builtin_amdgcn_cvt_scalef32_pk_f32_fp4(ur[j].x, 1.0f, 3), acc[3]);
                acc[4] = __builtin_elementwise_fma(a2, __builtin_amdgcn_cvt_scalef32_pk_f32_fp4(ur[j].y, 1.0f, 0), acc[4]);
                acc[5] = __builtin_elementwise_fma(a2, __builtin_amdgcn_cvt_scalef32_pk_f32_fp4(ur[j].y, 1.0f, 1), acc[5]);
                acc[6] = __builtin_elementwise_fma(a2, __builtin_amdgcn_cvt_scalef32_pk_f32_fp4(ur[j].y, 1.0f, 2), acc[6]);
                acc[7] = __builtin_elementwise_fma(a2, __builtin_amdgcn_cvt_scalef32_pk_f32_fp4(ur[j].y, 1.0f, 3), acc[7]);
            }
        }
        const f32x4* xr = (const f32x4*)(X + (size_t)t * D) + lane * 4;
        f32x4* xo = (f32x4*)(Xo + (size_t)t * D) + lane * 4;
        f32x4 o[4]; float ss = 0.f;
#pragma unroll
        for (int i = 0; i < 4; ++i) { o[i] = xr[i]; o[i] += (f32x4){acc[2 * i].x, acc[2 * i].y, acc[2 * i + 1].x, acc[2 * i + 1].y}; ss += o[i].x * o[i].x + o[i].y * o[i].y + o[i].z * o[i].z + o[i].w * o[i].w; }
        const float rs = rsqrtf(wave_sum(ss) * (1.f / D) + 1e-6f);
        const f32x4* gp = (const f32x4*)gn + lane * 4;
        if (NMODE == 1) {
#pragma unroll
            for (int i = 0; i < 4; ++i) xo[i] = o[i] * rs * gp[i];
        } else {
            u32x4 h0, h1;
            { const f32x4 y0 = o[0] * rs * gp[0], y1 = o[1] * rs * gp[1], y2 = o[2] * rs * gp[2], y3 = o[3] * rs * gp[3];
              h0 = (u32x4){pk2(y0.x, y0.y), pk2(y0.z, y0.w), pk2(y1.x, y1.y), pk2(y1.z, y1.w)}; h1 = (u32x4){pk2(y2.x, y2.y), pk2(y2.z, y2.w), pk2(y3.x, y3.y), pk2(y3.z, y3.w)}; }
#pragma unroll
            for (int i = 0; i < 4; ++i) xo[i] = o[i];
            *(u32x4*)(Hn + (size_t)t * D + lane * 16) = h0; *(u32x4*)(Hn + (size_t)t * D + lane * 16 + 8) = h1;
        }
    }
}

#define XB_TMO      128
#define XB_XCNT(j)  (256  + 64 * (j))
#define XB_XSUB(j)  (1280 + 64 * (j))
#define XB_XGEN(j)  (2304 + 64 * (j))
#define XB_TOP      3328
#define XB_TOPGEN   3392
#define XCD_BAR_WORDS 3456
#define XB_SPIN_CAP (1u << 22)
#define LAS __attribute__((address_space(3)))
__device__ __forceinline__ unsigned xb_ld(unsigned* p)              { return __hip_atomic_load(p, __ATOMIC_RELAXED, __HIP_MEMORY_SCOPE_AGENT); }
__device__ __forceinline__ unsigned xb_add(unsigned* p, unsigned v) { return __hip_atomic_fetch_add(p, v, __ATOMIC_RELAXED, __HIP_MEMORY_SCOPE_AGENT); }
__device__ __forceinline__ unsigned xb_xcc_id() { return (unsigned)__builtin_amdgcn_s_getreg((3 << 11) | 20) & 0xFu; }
#define XB_SPIN(cond, bar) do { unsigned _sp = 0; while (cond) { __builtin_amdgcn_s_sleep(1); \
    if ((++_sp & 255u) == 0u) { if (xb_ld(&(bar)[XB_TMO])) break; if (_sp > XB_SPIN_CAP) { atomicAdd(&(bar)[XB_TMO], 1u); break; } } } } while (0)
struct XcdBarrier { unsigned* bar; unsigned x; volatile LAS unsigned* st; };
__device__ __forceinline__ XcdBarrier xcd_barrier_post(unsigned* bar, volatile LAS unsigned* st) {
    XcdBarrier b; b.bar = bar; b.x = xb_xcc_id(); b.st = st;
    if (threadIdx.x == 0) (void)xb_add(&bar[XB_XCNT(b.x)], 1u);
    return b;
}
__device__ __forceinline__ void xcd_barrier_complete(unsigned* bar, unsigned x, unsigned& nloc, unsigned& nx) {
    const unsigned G = gridDim.x * gridDim.y * gridDim.z;
    unsigned sum, cnt, mine, sp = 0u;
    for (;;) {
        sum = 0u; cnt = 0u; mine = 0u;
#pragma unroll
        for (unsigned j = 0; j < 16; ++j) { const unsigned c = xb_ld(&bar[XB_XCNT(j)]); sum += c; cnt += (c > 0u) ? 1u : 0u; mine = (j == x) ? c : mine; }
        if (sum == G) break;
        __builtin_amdgcn_s_sleep(1);
        if ((++sp & 255u) == 0u) { if (xb_ld(&bar[XB_TMO])) break; if (sp > XB_SPIN_CAP) { atomicAdd(&bar[XB_TMO], 1u); break; } }
    }
    nloc = mine > 0u ? mine : 1u; nx = cnt > 0u ? cnt : 1u;
}
__device__ __forceinline__ void xcd_barrier(const XcdBarrier& b) {
    asm volatile("s_waitcnt vmcnt(0)" ::: "memory");
    __syncthreads();
    if (threadIdx.x == 0) {
        unsigned* bar = b.bar;
        __builtin_amdgcn_s_waitcnt(0);
        unsigned nloc = b.st[0], nx = b.st[1];
        if (nloc == 0u) { xcd_barrier_complete(bar, b.x, nloc, nx); b.st[0] = nloc; b.st[1] = nx; }
        const unsigned old = xb_add(&bar[XB_XSUB(b.x)], 1u);
        const unsigned gen = old / nloc;
        if (old + 1u == (gen + 1u) * nloc) {
            __builtin_amdgcn_fence(__ATOMIC_RELEASE, "agent");
            asm volatile("s_waitcnt vmcnt(0)" ::: "memory");
            const unsigned og = xb_add(&bar[XB_TOP], 1u);
            const unsigned tg = og / nx;
            if (og + 1u == (tg + 1u) * nx) xb_add(&bar[XB_TOPGEN], 1u);
            else XB_SPIN(xb_ld(&bar[XB_TOPGEN]) == tg, bar);
            __builtin_amdgcn_fence(__ATOMIC_ACQUIRE, "agent");
            xb_add(&bar[XB_XGEN(b.x)], 1u);
            asm volatile("s_waitcnt vmcnt(0)" ::: "memory");
        } else {
            XB_SPIN(xb_ld(&bar[XB_XGEN(b.x)]) == gen, bar);
            __builtin_amdgcn_fence(__ATOMIC_ACQUIRE, "agent");
            asm volatile("s_waitcnt vmcnt(0)" ::: "memory");
        }
    }
    __syncthreads();
}

struct Params {
    const float* in[24];
    float* out; unsigned char* ws;
};
constexpr int LDS_BYTES = 2 * 2 * 128 * GS * 2 + 256;

__device__ __forceinline__ RwP make_rwp(const Params& P, int l) {
    RwP r;
    r.Z = (const bf16_t*)(P.ws + WS_Z); r.mix = P.ws + WS_MIX;
    r.mu = P.in[6] + l * RW_F; r.w_up = P.in[7] + (size_t)l * 64 * 384; r.w_bias = P.in[8] + l * 384; r.a_up = P.in[9] + (size_t)l * 64 * 384; r.a_bias = P.in[10] + l * 384;
    r.g_up = P.in[11] + (size_t)l * 128 * 384; r.k_k = P.in[12] + l * 384; r.k_a = P.in[13] + l * 384; r.r_k = P.in[14] + l * 384; r.ln_w = P.in[15] + l * 384; r.ln_b = P.in[16] + l * 384;
    r.oraw = (float*)(P.ws + WS_H); r.O = (bf16_t*)(P.ws + WS_O); r.Y = (bf16_t*)(P.ws + WS_EIDX); r.lora = (const bf16_t*)(P.ws + WS_LORA + l * LORA_L);
    return r;
}

__global__ void __launch_bounds__(NTHREADS, 2) mega_fwd(Params P) {
    extern __shared__ __attribute__((aligned(16))) char smem[];
    const int bid = blockIdx.x, nblk = gridDim.x;
    volatile LAS unsigned* st = (volatile LAS unsigned*)(smem + LDS_BYTES - 16);
    if (threadIdx.x == 0) { st[0] = 0u; st[1] = 0u; st[2] = 0u; st[3] = 0u; }
    __syncthreads();
    XcdBarrier bar = xcd_barrier_post((unsigned*)(P.ws + WS_CTL), st);
#define GSYNC() xcd_barrier(bar)

    {
        ConvP c{P.in[4], P.in[5], P.in[20], P.in[21], P.in[22], P.in[23], P.in[7], P.in[9], P.in[11], P.ws};
        for (int rep = 0; rep < REP_CONV; ++rep) phase_convert_weights(c, smem, bid, nblk);
        phase_rmsnorm<false>(P.in[0], P.in[1], P.ws + WS_H, bid, nblk);
    }
    GSYNC();
#pragma unroll 1
    for (int l = 0; l < 2; ++l) {
        const float* xin = (l == 0) ? P.in[0] : P.out;
        {
            GemmP g{(const bf16_t*)(P.ws + WS_H), D, 0, 0, (const bf16_t*)(P.ws + WS_WTIN) + (size_t)l * DINP * D, D, D, NT / 128, DINP / 128, P.ws + WS_Z, DINP, nullptr};
            for (int rep = 0; rep < REP_GIN; ++rep) phase_gemm<0>(g, smem, bid, nblk);
            if (l == 0) {
                for (int l2 = 0; l2 < 2; ++l2) {
                    GemmP ge{(const bf16_t*)(P.ws + WS_SK) + (size_t)l2 * 16 * 128 * 128, 128, 0, 128, (const bf16_t*)(P.ws + WS_WTQ) + (size_t)l2 * D * 2048, 2048, 128, 16, 8,
                             (bf16_t*)(P.ws + WS_WEFF) + (size_t)l2 * 2048 * D, D, nullptr};
                    phase_gemm<0>(ge, smem, bid, nblk, (NT / 128 * (DINP / 128) + l2 * 128) % nblk);
                }
            }
        }
        GSYNC();
        RwP rw = make_rwp(P, l);
        LinP lp{(const bf16_t*)(P.ws + WS_Z), (bf16_t*)(P.ws + WS_O), P.in[17] + (size_t)l * 16 * 192, P.in[18] + l * 192, P.in[19] + l * 384, (const float*)(P.ws + WS_ROPE), P.ws + WS_LIN};
        for (int task = bid; task < 512 + 2048; task += nblk) {
            if (task < 512) { for (int rep = 0; rep < REP_PREP; ++rep) rwkv_prep_task(rw, smem, task); }
            else { for (int rep = 0; rep < REP_LIN; ++rep) lin_kv_dispatch(lp, smem, task - 512); }
        }
        GSYNC();
        {
            for (int rep = 0; rep < REP_SCAN; ++rep)
            for (int task = bid; task < 240; task += nblk) {
                const int bh = task / 10, r = task % 10;
                const int seg = r < 2 ? 0 : (r < 6 ? 1 : 2), grp = r < 2 ? r : (r < 6 ? r - 2 : r - 6);
                rwkv_scan_task(rw, smem, bh, seg, grp);
            }
            if (nblk >= 512) { if (bid >= 240) for (int rep = 0; rep < REP_LIN; ++rep) lin_scan_phase(lp, bid - 240, nblk - 240); }
            else { for (int rep = 0; rep < REP_LIN; ++rep) lin_scan_phase(lp, bid, nblk); }
            if (l == 0) {
                ConvP c{P.in[4], P.in[5], P.in[20], P.in[21], P.in[22], P.in[23], P.in[7], P.in[9], P.in[11], P.ws};
                if (nblk >= 512) { if (bid >= 240) phase_convert_uv(c, bid - 240, nblk - 240); } else phase_convert_uv(c, bid, nblk);
            }
        }
        GSYNC();
        phase_rwkv_chain(rw, bid, nblk);
        GSYNC();
        for (int rep = 0; rep < REP_POST; ++rep) phase_rwkv_post(rw, bid, nblk);
        for (int rep = 0; rep < REP_LIN; ++rep) for (int task = bid; task < 2048; task += nblk) lin_out_dispatch(lp, smem, task);
        GSYNC();
        {
            GemmP g{(const bf16_t*)(P.ws + WS_O), D, 0, 0, (const bf16_t*)(P.ws + WS_WTOUT) + (size_t)l * D * D, D, D, NT / 128, D / 128, P.out, D, xin};
            phase_gemm<2>(g, smem, bid, nblk);
            for (int rep = 1; rep < REP_GOUT; ++rep) { GemmP g2 = g; g2.C = P.ws + WS_MIX; phase_gemm<2>(g2, smem, bid, nblk); }
        }
        GSYNC();
        for (int rep = 0; rep < REP_NORM; ++rep) phase_rmsnorm<false>(P.out, P.in[2] + l * D, P.ws + WS_H, bid, nblk);
        GSYNC();
        {
            GemmP g{(const bf16_t*)(P.ws + WS_H), D, 0, 0, (const bf16_t*)(P.ws + WS_WEFF) + (size_t)l * 2048 * D, D, D, NT / 128, 2048 / 128, P.ws + WS_MIX, NT, nullptr};
            for (int rep = 0; rep < REP_GQ; ++rep) phase_gemm<3>(g, smem, bid, nblk);
        }
        GSYNC();
        for (int rep = 0; rep < REP_TOPK; ++rep) phase_topk((const float*)(P.ws + WS_MIX), (int*)(P.ws + WS_EIDX), (float*)(P.ws + WS_GATE), smem, bid, nblk);
        GSYNC();
        if (l == 0) phase_expert<0>((const bf16_t*)(P.ws + WS_H), P.ws + WS_UB + (size_t)l * NEXP * 512, P.ws + WS_VB + (size_t)l * NEXP * 512,
                     (const float*)(P.ws + WS_ESC) + l * NEXP, (const float*)(P.ws + WS_ESC) + (2 + l) * NEXP,
                     (const int*)(P.ws + WS_EIDX), (const float*)(P.ws + WS_GATE), P.out, P.out, P.in[1] + D, (bf16_t*)(P.ws + WS_H), bid, nblk);
        else phase_expert<1>((const bf16_t*)(P.ws + WS_H), P.ws + WS_UB + (size_t)l * NEXP * 512, P.ws + WS_VB + (size_t)l * NEXP * 512,
                     (const float*)(P.ws + WS_ESC) + l * NEXP, (const float*)(P.ws + WS_ESC) + (2 + l) * NEXP,
                     (const int*)(P.ws + WS_EIDX), (const float*)(P.ws + WS_GATE), P.out, P.out, P.in[3], nullptr, bid, nblk);
        if (l == 0) GSYNC();
    }
}

extern "C" void kernel_launch(void* const* d_in, const int* in_sizes, int n_in, void* d_out, int out_size, void* d_ws, size_t ws_size, hipStream_t stream) {
    static int grid = 0;
    if (grid == 0) {
        if (n_in != 24 || ws_size < WS_END) { fprintf(stderr, "kernel_launch: bad args n_in=%d ws=%zu need=%zu\n", n_in, ws_size, (size_t)WS_END); grid = -1; return; }
        int dev = 0, cus = 0, per_cu = 0;
        hipGetDevice(&dev);
        hipDeviceGetAttribute(&cus, hipDeviceAttributeMultiprocessorCount, dev);
        hipFuncSetAttribute((const void*)mega_fwd, hipFuncAttributeMaxDynamicSharedMemorySize, LDS_BYTES);
        hipOccupancyMaxActiveBlocksPerMultiprocessor(&per_cu, (const void*)mega_fwd, NTHREADS, LDS_BYTES);
        if (per_cu < 1) { fprintf(stderr, "kernel_launch: occupancy query says %d\n", per_cu); grid = -1; return; }
        if (per_cu > 2) per_cu = 2;
        grid = cus * per_cu;
        fprintf(stderr, "kernel_launch: grid %d (%d CUs x %d)\n", grid, cus, per_cu);
    }
    if (grid < 0) return;
    hipMemsetAsync((char*)d_ws + WS_CTL, 0, XCD_BAR_WORDS * 4, stream);
    Params P{};
    for (int i = 0; i < 24; ++i) P.in[i] = (const float*)d_in[i];
    P.out = (float*)d_out; P.ws = (unsigned char*)d_ws;
    void* args[] = {&P};
    hipError_t e = hipLaunchCooperativeKernel((const void*)mega_fwd, dim3(grid), dim3(NTHREADS), args, LDS_BYTES, stream);
    if (e != hipSuccess) fprintf(stderr, "cooperative launch failed: %s (grid %d)\n", hipGetErrorString(e), grid);
}
```

```cpp
#include <hip/hip_runtime.h>
#include <stdint.h>
#include <stdio.h>

typedef unsigned short bf16_t;
typedef short bf16x8 __attribute__((ext_vector_type(8)));
typedef float f32x4 __attribute__((ext_vector_type(4)));
typedef unsigned u32x4 __attribute__((ext_vector_type(4)));
typedef unsigned u32x2 __attribute__((ext_vector_type(2)));

constexpr int NB = 4, NS = 4096, NT = NB * NS, D = 1024, DIN = 3600, DINP = 3712;
constexpr int ZC_RET = 0, ZC_RW = 1024, ZC_GLA = 2432;
constexpr int RW_F = 1408;
constexpr int NEXP = 16384;
constexpr int NTHREADS = 256;

constexpr size_t MiB = 1024ull * 1024ull;
constexpr size_t WS_CTL   = 0;
constexpr size_t WS_LORA  = 65536;
constexpr size_t LORA_L   = 384ull * 256 * 2;
constexpr size_t WS_ESC   = 524288;
constexpr size_t WS_WTIN  = 1 * MiB;
constexpr size_t WS_WTOUT = WS_WTIN + 2ull * DINP * D * 2;
constexpr size_t WS_WTQ   = WS_WTOUT + 2ull * D * D * 2;
constexpr size_t WS_SK    = WS_WTQ + 2ull * 2048 * D * 2;
constexpr size_t WS_UB    = WS_SK + 2ull * 16 * 128 * 128 * 2;
constexpr size_t WS_VB    = WS_UB + 2ull * NEXP * D;
constexpr size_t WS_LIN   = WS_VB + 2ull * NEXP * D;
constexpr size_t WS_H     = WS_LIN + 64 * MiB;
constexpr size_t WS_Z     = WS_H + (size_t)NT * D * 2;
constexpr size_t WS_O     = WS_Z + (size_t)NT * DINP * 2;
constexpr size_t WS_MIX   = WS_O + (size_t)NT * D * 2;
constexpr size_t WS_EIDX  = WS_MIX + 128 * MiB;
constexpr size_t WS_GATE  = WS_EIDX + (size_t)NT * 128 * 4;
constexpr size_t WS_ROPE  = WS_GATE + (size_t)NT * 128 * 4;
constexpr size_t WS_WEFF  = WS_ROPE + 1 * MiB;
constexpr size_t WS_END   = WS_WEFF + 2ull * 2048 * D * 2;
constexpr size_t RWA = (size_t)NT * 384;
constexpr size_t MX_W   = 0;
constexpr size_t MX_KK  = MX_W + RWA * 4;
constexpr size_t MX_KKA = MX_KK + RWA * 4;
constexpr size_t MX_R   = MX_KKA + RWA * 4;
constexpr size_t MX_K   = MX_R + RWA * 2;
constexpr size_t MX_V   = MX_K + RWA * 2;
constexpr size_t MX_G   = MX_V + RWA * 2;
constexpr size_t MX_END = MX_G + RWA * 2;
static_assert(MX_END <= 128 * MiB, "mix region");

__device__ __forceinline__ float bf2f(bf16_t v) { return __uint_as_float(((unsigned)v) << 16); }
__device__ __forceinline__ bf16_t f2bf(float f) { unsigned u = __float_as_uint(f); u += 0x7FFFu + ((u >> 16) & 1u); return (bf16_t)(u >> 16); }
__device__ __forceinline__ unsigned pk2(float lo, float hi) { return (unsigned)f2bf(lo) | ((unsigned)f2bf(hi) << 16); }
__device__ __forceinline__ float lo_bf(unsigned u) { return __uint_as_float(u << 16); }
__device__ __forceinline__ float hi_bf(unsigned u) { return __uint_as_float(u & 0xFFFF0000u); }
template <int CTRL> __device__ __forceinline__ float dpp_f(float v) { return __int_as_float(__builtin_amdgcn_update_dpp(0, __float_as_int(v), CTRL, 0xF, 0xF, true)); }
template <int CTRL> __device__ __forceinline__ unsigned dpp_u(unsigned v) { return (unsigned)__builtin_amdgcn_update_dpp(0, (int)v, CTRL, 0xF, 0xF, true); }
__device__ __forceinline__ float row16_sum(float v) { v += dpp_f<0x128>(v); v += dpp_f<0x124>(v); v += dpp_f<0x122>(v); v += dpp_f<0x121>(v); return v; }
__device__ __forceinline__ float xor16_sum(float v) { auto r = __builtin_amdgcn_permlane16_swap(__float_as_uint(v), __float_as_uint(v), false, false); return __uint_as_float(r[0]) + __uint_as_float(r[1]); }
__device__ __forceinline__ float xor32_sum(float v) { auto r = __builtin_amdgcn_permlane32_swap(__float_as_uint(v), __float_as_uint(v), false, false); return __uint_as_float(r[0]) + __uint_as_float(r[1]); }
__device__ __forceinline__ float wave_sum(float v) { return xor32_sum(xor16_sum(row16_sum(v))); }
__device__ __forceinline__ unsigned umax_(unsigned a, unsigned b) { return a > b ? a : b; }
__device__ __forceinline__ unsigned wave_max_u32(unsigned v) {
    v = umax_(v, dpp_u<0x128>(v)); v = umax_(v, dpp_u<0x124>(v)); v = umax_(v, dpp_u<0x122>(v)); v = umax_(v, dpp_u<0x121>(v));
    { auto r = __builtin_amdgcn_permlane16_swap(v, v, false, false); v = umax_(r[0], r[1]); }
    { auto r = __builtin_amdgcn_permlane32_swap(v, v, false, false); v = umax_(r[0], r[1]); }
    return v;
}
__device__ __forceinline__ float sigmoidf_(float x) { return 1.f / (1.f + __expf(-x)); }
__device__ __forceinline__ float softplusf_(float x) { return fmaxf(x, 0.f) + log1pf(__expf(-fabsf(x))); }

__device__ __forceinline__ int otid() { int t = threadIdx.x; asm volatile("" : "+v"(t)); return t; }

constexpr size_t WS_FLAGS = 16384;
__device__ __forceinline__ void flag_signal(unsigned* f) {
    asm volatile("s_waitcnt vmcnt(0)" ::: "memory");
    __syncthreads();
    if (threadIdx.x == 0) {
        __builtin_amdgcn_fence(__ATOMIC_RELEASE, "agent");
        asm volatile("s_waitcnt vmcnt(0)" ::: "memory");
        __hip_atomic_fetch_add(f, 1u, __ATOMIC_RELAXED, __HIP_MEMORY_SCOPE_AGENT);
    }
}
__device__ __forceinline__ void flag_wait(unsigned* f, unsigned need) {
    if (threadIdx.x == 0) {
        unsigned sp = 0;
        while (__hip_atomic_load(f, __ATOMIC_RELAXED, __HIP_MEMORY_SCOPE_AGENT) < need) { __builtin_amdgcn_s_sleep(4); if (++sp > (1u << 22)) break; }
        __builtin_amdgcn_fence(__ATOMIC_ACQUIRE, "agent");
        asm volatile("s_waitcnt vmcnt(0)" ::: "memory");
    }
    __syncthreads();
}

__device__ void transpose_tile(const float* __restrict__ W, int K, int N, bf16_t* __restrict__ Wt, int kt, int nt, float* tile  ) {
    const int tid = otid();
    const int k0 = kt * 64, n0 = nt * 64;
#pragma unroll
    for (int i = 0; i < 16; ++i) {
        const int k = i * 4 + (tid >> 6), n = tid & 63;
        tile[k * 65 + n] = (n0 + n < N) ? W[(size_t)(k0 + k) * N + n0 + n] : 0.f;
    }
    __syncthreads();
#pragma unroll
    for (int i = 0; i < 16; ++i) {
        const int n = i * 4 + (tid >> 6), k = tid & 63;
        Wt[(size_t)(n0 + n) * K + k0 + k] = f2bf(tile[k * 65 + n]);
    }
    __syncthreads();
}

struct ConvP {
    const float* w_in; const float* w_out; const float* w_q; const float* sk; const float* u; const float* v;
    const float* w_up; const float* a_up; const float* g_up;
    unsigned char* ws;
};

__device__ void phase_convert_weights(const ConvP& p, char* smem, int bid, int nblk) {
    float* tile = (float*)smem;
    constexpr int T_IN = 16 * 58, T_OUT = 16 * 16, T_L = T_IN + T_OUT;
    for (int it = bid; it < 2 * T_L; it += nblk) {
        const int l = it / T_L; int r = it % T_L;
        if (r < T_IN) { transpose_tile(p.w_in + (size_t)l * D * DIN, D, DIN, (bf16_t*)(p.ws + WS_WTIN) + (size_t)l * DINP * D, r / 58, r % 58, tile); continue; }
        r -= T_IN;
        transpose_tile(p.w_out + (size_t)l * D * D, D, D, (bf16_t*)(p.ws + WS_WTOUT) + (size_t)l * D * D, r / 16, r % 16, tile);
    }
    const size_t gtid = (size_t)bid * NTHREADS + otid(), gn = (size_t)nblk * NTHREADS;
    {
        for (size_t i = gtid; i < 2ull * 384 * 256; i += gn) {
            const int l = (int)(i / (384 * 256)), r = (int)(i % (384 * 256)), c = r >> 8, k = r & 255;
            bf16_t* base = (bf16_t*)(p.ws + WS_LORA + l * LORA_L);
            if (k < 64) base[c * 64 + k] = f2bf(p.w_up[(size_t)l * 64 * 384 + k * 384 + c]);
            else if (k < 128) base[384 * 64 + c * 64 + (k - 64)] = f2bf(p.a_up[(size_t)l * 64 * 384 + (k - 64) * 384 + c]);
            else base[2 * 384 * 64 + c * 128 + (k - 128)] = f2bf(p.g_up[(size_t)l * 128 * 384 + (k - 128) * 384 + c]);
        }
    }
    {
        float* ct = (float*)(p.ws + WS_ROPE); float* stb = ct + NS * 32;
        for (size_t i = gtid; i < (size_t)NS * 32; i += gn) {
            const int pos = (int)(i >> 5), fi = (int)(i & 31);
            const float inv = exp2f(-(float)fi * (13.287712379549449f / 32.f));
            float sn, cs; sincosf((float)pos * inv, &sn, &cs);
            ct[i] = cs; stb[i] = sn;
        }
    }
    {
        const size_t n8 = (2ull * D * 2048) / 8;
        const f32x4* s = (const f32x4*)p.w_q; u32x4* d = (u32x4*)(p.ws + WS_WTQ);
        for (size_t i = gtid; i < n8; i += gn) { f32x4 a = s[2 * i], b = s[2 * i + 1]; u32x4 o; o.x = pk2(a.x, a.y); o.y = pk2(a.z, a.w); o.z = pk2(b.x, b.y); o.w = pk2(b.z, b.w); d[i] = o; }
    }
    {
        const size_t n8 = (2ull * 16 * 128 * 128) / 8;
        const f32x4* s = (const f32x4*)p.sk; u32x4* d = (u32x4*)(p.ws + WS_SK);
        for (size_t i = gtid; i < n8; i += gn) { f32x4 a = s[2 * i], b = s[2 * i + 1]; u32x4 o; o.x = pk2(a.x, a.y); o.y = pk2(a.z, a.w); o.z = pk2(b.x, b.y); o.w = pk2(b.z, b.w); d[i] = o; }
    }
}

__device__ void phase_convert_uv(const ConvP& p, int bid, int nblk) {
    {
        const int lane = otid() & 63, gw = bid * 4 + (otid() >> 6), ngw = nblk * 4;
        for (int r = gw; r < 4 * NEXP; r += ngw) {
            const bool isv = r >= 2 * NEXP; const int rr = isv ? r - 2 * NEXP : r;
            const f32x4* src = (const f32x4*)((isv ? p.v : p.u) + (size_t)rr * D) + lane * 4;
            f32x4 x[4]; float mx = 0.f;
#pragma unroll
            for (int i = 0; i < 4; ++i) { x[i] = src[i]; mx = fmaxf(mx, fmaxf(fmaxf(fabsf(x[i].x), fabsf(x[i].y)), fmaxf(fabsf(x[i].z), fabsf(x[i].w)))); }
            mx = __uint_as_float(wave_max_u32(__float_as_uint(mx)));
            const float sc = mx > 0.f ? 6.f / mx : 0.f;
            unsigned w0 = 0u, w1 = 0u;
            w0 = __builtin_amdgcn_cvt_scalef32_pk_fp4_f32(w0, x[0].x * sc, x[0].y * sc, 1.0f, 0); w0 = __builtin_amdgcn_cvt_scalef32_pk_fp4_f32(w0, x[0].z * sc, x[0].w * sc, 1.0f, 1);
            w0 = __builtin_amdgcn_cvt_scalef32_pk_fp4_f32(w0, x[1].x * sc, x[1].y * sc, 1.0f, 2); w0 = __builtin_amdgcn_cvt_scalef32_pk_fp4_f32(w0, x[1].z * sc, x[1].w * sc, 1.0f, 3);
            w1 = __builtin_amdgcn_cvt_scalef32_pk_fp4_f32(w1, x[2].x * sc, x[2].y * sc, 1.0f, 0); w1 = __builtin_amdgcn_cvt_scalef32_pk_fp4_f32(w1, x[2].z * sc, x[2].w * sc, 1.0f, 1);
            w1 = __builtin_amdgcn_cvt_scalef32_pk_fp4_f32(w1, x[3].x * sc, x[3].y * sc, 1.0f, 2); w1 = __builtin_amdgcn_cvt_scalef32_pk_fp4_f32(w1, x[3].z * sc, x[3].w * sc, 1.0f, 3);
            *(u32x2*)(p.ws + (isv ? WS_VB : WS_UB) + (size_t)rr * 512 + lane * 8) = (u32x2){w0, w1};
            if (lane == 0) ((float*)(p.ws + WS_ESC))[r] = mx * (1.f / 6.f);
        }
    }
}

template <bool OUT_F32>
__device__ void phase_rmsnorm(const float* x, const float* __restrict__ g, void* out, int bid, int nblk) {
    const int lane = otid() & 63, wave = otid() >> 6;
    const int gw = bid * 4 + wave, ngw = nblk * 4;
    f32x4 gv[4];
#pragma unroll
    for (int j = 0; j < 4; ++j) gv[j] = ((const f32x4*)g)[lane + 64 * j];
    for (int row = gw; row < NT; row += ngw) {
        const f32x4* xr = (const f32x4*)(x + (size_t)row * D) + lane;
        f32x4 v[4]; float s = 0.f;
#pragma unroll
        for (int j = 0; j < 4; ++j) { v[j] = xr[64 * j]; s += v[j].x * v[j].x + v[j].y * v[j].y + v[j].z * v[j].z + v[j].w * v[j].w; }
        s = wave_sum(s);
        const float rs = rsqrtf(s * (1.f / D) + 1e-6f);
        if (OUT_F32) {
            f32x4* o = (f32x4*)((float*)out + (size_t)row * D) + lane;
#pragma unroll
            for (int j = 0; j < 4; ++j) o[64 * j] = v[j] * rs * gv[j];
        } else {
            u32x2* o = (u32x2*)((bf16_t*)out + (size_t)row * D) + lane;
#pragma unroll
            for (int j = 0; j < 4; ++j) { f32x4 y = v[j] * rs * gv[j]; u32x2 w; w.x = pk2(y.x, y.y); w.y = pk2(y.z, y.w); o[64 * j] = w; }
        }
    }
}

struct GemmP {
    const bf16_t* A; int lda; int a_koff;
    int b_koff;
    const bf16_t* Bt; int ldb; int K;
    int MT, NTl;
    void* C; int ldc; const float* R;
};
constexpr int GS = 72;
template <int MODE>
__device__ void phase_gemm(const GemmP& p, char* smem, int bid, int nblk, int tile0 = 0) {
    bf16_t* As = (bf16_t*)smem;
    bf16_t* Bs = As + 128 * GS;
    const int tid = otid(), lane = tid & 63, wave = tid >> 6;
    const int wr = wave >> 1, wc = wave & 1;
    const int lr = tid >> 3, lc = (tid & 7) * 8;
    const int fl = lane & 15, fq = lane >> 4;
    const int ntiles = p.MT * p.NTl;
    for (int tile = bid - tile0 + ((bid < tile0) ? nblk * ((tile0 - bid + nblk - 1) / nblk) : 0); tile < ntiles; tile += nblk) {
        const int mt = tile / p.NTl, nt = tile % p.NTl;
        const bf16_t* Ag = p.A + (size_t)mt * 128 * p.lda + (size_t)nt * p.a_koff + (size_t)lr * p.lda + lc;
        const bf16_t* Bg = p.Bt + (size_t)nt * 128 * p.ldb + (size_t)mt * p.b_koff + (size_t)lr * p.ldb + lc;
        f32x4 acc[4][4];
#pragma unroll
        for (int m = 0; m < 4; ++m)
#pragma unroll
            for (int n = 0; n < 4; ++n) acc[m][n] = (f32x4){0.f, 0.f, 0.f, 0.f};
        u32x4 ra[4], rb[4];
        const int nk = p.K >> 6;
#pragma unroll
        for (int i = 0; i < 4; ++i) { ra[i] = *(const u32x4*)(Ag + (size_t)(32 * i) * p.lda); rb[i] = *(const u32x4*)(Bg + (size_t)(32 * i) * p.ldb); }
        __syncthreads();
#pragma unroll
        for (int i = 0; i < 4; ++i) { *(u32x4*)(As + (lr + 32 * i) * GS + lc) = ra[i]; *(u32x4*)(Bs + (lr + 32 * i) * GS + lc) = rb[i]; }
        if (nk > 1) {
#pragma unroll
            for (int i = 0; i < 4; ++i) { ra[i] = *(const u32x4*)(Ag + (size_t)(32 * i) * p.lda + 64); rb[i] = *(const u32x4*)(Bg + (size_t)(32 * i) * p.ldb + 64); }
        }
        __syncthreads();
        for (int kt = 0; kt < nk; ++kt) {
            const bf16_t* Ac = As + (kt & 1) * (256 * GS); const bf16_t* Bc = Ac + 128 * GS;
            bf16_t* An = As + ((kt & 1) ^ 1) * (256 * GS); bf16_t* Bn = An + 128 * GS;
            if (kt + 1 < nk) {
#pragma unroll
                for (int i = 0; i < 4; ++i) { *(u32x4*)(An + (lr + 32 * i) * GS + lc) = ra[i]; *(u32x4*)(Bn + (lr + 32 * i) * GS + lc) = rb[i]; }
                if (kt + 2 < nk) {
#pragma unroll
                    for (int i = 0; i < 4; ++i) { ra[i] = *(const u32x4*)(Ag + (size_t)(32 * i) * p.lda + (kt + 2) * 64); rb[i] = *(const u32x4*)(Bg + (size_t)(32 * i) * p.ldb + (kt + 2) * 64); }
                }
            }
#pragma unroll
            for (int ks = 0; ks < 2; ++ks) {
                bf16x8 xa[4], wb[4];
#pragma unroll
                for (int m = 0; m < 4; ++m) xa[m] = *(const bf16x8*)(Ac + (wr * 64 + m * 16 + fl) * GS + ks * 32 + fq * 8);
#pragma unroll
                for (int n = 0; n < 4; ++n) wb[n] = *(const bf16x8*)(Bc + (wc * 64 + n * 16 + fl) * GS + ks * 32 + fq * 8);
#pragma unroll
                for (int m = 0; m < 4; ++m)
#pragma unroll
                    for (int n = 0; n < 4; ++n) acc[m][n] = (MODE == 3) ? __builtin_amdgcn_mfma_f32_16x16x32_bf16(xa[m], wb[n], acc[m][n], 0, 0, 0)
                                                                     : __builtin_amdgcn_mfma_f32_16x16x32_bf16(wb[n], xa[m], acc[m][n], 0, 0, 0);
            }
            __syncthreads();
        }
#pragma unroll
        for (int m = 0; m < 4; ++m) {
#pragma unroll
            for (int n = 0; n < 4; ++n) {
                const f32x4 a = acc[m][n];
                if (MODE == 3) {
                    const size_t row = (size_t)mt * 128 + wr * 64 + m * 16 + fq * 4;
                    const size_t col = (size_t)nt * 128 + wc * 64 + n * 16 + fl;
                    *(f32x4*)((float*)p.C + col * p.ldc + row) = a;
                } else {
                    const size_t row = (size_t)mt * 128 + wr * 64 + m * 16 + fl;
                    const int col = nt * 128 + wc * 64 + n * 16 + fq * 4;
                    if (MODE == 0) { u32x2 w; w.x = pk2(a.x, a.y); w.y = pk2(a.z, a.w); *(u32x2*)((bf16_t*)p.C + row * p.ldc + col) = w; }
                    else if (MODE == 1) { *(f32x4*)((float*)p.C + row * p.ldc + col) = a; }
                    else { const f32x4 r = *(const f32x4*)(p.R + row * p.ldc + col); *(f32x4*)((float*)p.C + row * p.ldc + col) = r + a; }
                }
            }
        }
    }
}

constexpr int LS = 72;
struct LinP {
    const bf16_t* Z; bf16_t* O;
    const float* gk_up;
    const float* gk_bias;
    const float* norm_w;
    const float* rope;
    unsigned char* lin;
};
__device__ __forceinline__ bf16x8 ldfrag(const bf16_t* base, int row, int kofs) { return *(const bf16x8*)(base + row * LS + kofs); }

constexpr size_t LN_KV_RET = 0;
constexpr size_t LN_KV_GLA = LN_KV_RET + 1024ull * 64 * 64 * 4;
constexpr size_t LN_S_RET  = LN_KV_GLA + 1024ull * 96 * 64 * 4;
constexpr size_t LN_S_GLA  = LN_S_RET + 1024ull * 64 * 64 * 2;
constexpr size_t LN_DEC    = LN_S_GLA + 1024ull * 96 * 64 * 2;
static_assert(LN_DEC + 2048ull * 64 * 4 <= 64 * MiB, "lin region");

__device__ __forceinline__ float wave_incl_scan(float v) {
    v += dpp_f<0x111>(v); v += dpp_f<0x112>(v); v += dpp_f<0x114>(v); v += dpp_f<0x118>(v);
    v += __int_as_float(__builtin_amdgcn_update_dpp(0, __float_as_int(v), 0x142, 0xA, 0xF, false));
    v += __int_as_float(__builtin_amdgcn_update_dpp(0, __float_as_int(v), 0x143, 0xC, 0xF, false));
    return v;
}
__device__ __forceinline__ float readlane_f(float v, int l) { return __int_as_float(__builtin_amdgcn_readlane(__float_as_int(v), l)); }

__device__ __forceinline__ void rot8(const bf16_t* src, const float* rope, int spos, int cq, unsigned (&o1)[4], unsigned (&o2)[4]) {
    const u32x4 q1 = *(const u32x4*)(src + cq * 8), q2 = *(const u32x4*)(src + 32 + cq * 8);
    const unsigned q1w[4] = {q1.x, q1.y, q1.z, q1.w}, q2w[4] = {q2.x, q2.y, q2.z, q2.w};
    const f32x4 c0 = *(const f32x4*)(rope + spos * 32 + cq * 8), c1 = *(const f32x4*)(rope + spos * 32 + cq * 8 + 4);
    const f32x4 s0 = *(const f32x4*)(rope + NS * 32 + spos * 32 + cq * 8), s1 = *(const f32x4*)(rope + NS * 32 + spos * 32 + cq * 8 + 4);
    const float csv[8] = {c0.x, c0.y, c0.z, c0.w, c1.x, c1.y, c1.z, c1.w}, snv[8] = {s0.x, s0.y, s0.z, s0.w, s1.x, s1.y, s1.z, s1.w};
#pragma unroll
    for (int e = 0; e < 4; ++e) {
        const float a1l = lo_bf(q1w[e]), a1h = hi_bf(q1w[e]), a2l = lo_bf(q2w[e]), a2h = hi_bf(q2w[e]);
        o1[e] = pk2(a1l * csv[2 * e] - a2l * snv[2 * e], a1h * csv[2 * e + 1] - a2h * snv[2 * e + 1]);
        o2[e] = pk2(a1l * snv[2 * e] + a2l * csv[2 * e], a1h * snv[2 * e + 1] + a2h * csv[2 * e + 1]);
    }
}
__device__ __forceinline__ void load_vts(const bf16_t* Z, size_t t0, int voff, int nch, bf16_t* Vts, int tid) {
    for (int x = tid; x < 64 * nch; x += NTHREADS) {
        const int tok = x / nch, ch = x % nch;
        const u32x4 vv = *(const u32x4*)(Z + (t0 + tok) * DINP + voff + ch * 8);
        const unsigned w[4] = {vv.x, vv.y, vv.z, vv.w};
#pragma unroll
        for (int e = 0; e < 4; ++e) { Vts[(ch * 8 + 2 * e) * LS + tok] = (bf16_t)(w[e] & 0xFFFFu); Vts[(ch * 8 + 2 * e + 1) * LS + tok] = (bf16_t)(w[e] >> 16); }
    }
}
__device__ __forceinline__ void load_gd(const bf16_t* zr, float (&gd)[16]) {
    const u32x4 g0 = *(const u32x4*)zr, g1 = *(const u32x4*)(zr + 8);
    gd[0] = lo_bf(g0.x); gd[1] = hi_bf(g0.x); gd[2] = lo_bf(g0.y); gd[3] = hi_bf(g0.y); gd[4] = lo_bf(g0.z); gd[5] = hi_bf(g0.z); gd[6] = lo_bf(g0.w); gd[7] = hi_bf(g0.w);
    gd[8] = lo_bf(g1.x); gd[9] = hi_bf(g1.x); gd[10] = lo_bf(g1.y); gd[11] = hi_bf(g1.y); gd[12] = lo_bf(g1.z); gd[13] = hi_bf(g1.z); gd[14] = lo_bf(g1.w); gd[15] = hi_bf(g1.w);
}
__device__ __forceinline__ float gla_gk(const LinP& p, const float (&gd)[16], int h, int d) {
    float x = p.gk_bias[h * 48 + d];
#pragma unroll
    for (int i = 0; i < 16; ++i) x += gd[i] * p.gk_up[i * 192 + h * 48 + d];
    return (fminf(x, 0.f) - log1pf(__expf(-fabsf(x)))) * (1.f / 16.f);
}
__device__ __forceinline__ float ret_lg(int h) { const float e = exp2f(-5.f - (float)h * (4.f / 3.f)); return log1pf(-e); }

template <bool IS_GLA>
__device__ void lin_kv_task(const LinP& p, char* smem, int b, int h, int c) {
    constexpr int DV = IS_GLA ? 96 : 64, NVB = DV / 16;
    const int koff = IS_GLA ? (ZC_GLA + 192 + h * 48) : (ZC_RET + 256 + h * 64);
    const int voff = IS_GLA ? (ZC_GLA + 384 + h * 96) : (ZC_RET + 512 + h * 64);
    const int gkdoff = ZC_GLA + 768;
    bf16_t* Ks = (bf16_t*)smem;
    bf16_t* Kts = Ks + 64 * LS;
    bf16_t* Vts = Kts + 64 * LS;
    float* decs = (float*)(Vts + 96 * LS);
    const int tid = otid(), lane = tid & 63, wave = tid >> 6;
    const int fl = lane & 15, fq = lane >> 4;
    const size_t t0 = (size_t)b * NS + (size_t)c * 64;
    const int task = (b * 4 + h) * 64 + c;
    __syncthreads();
    if (IS_GLA) {
        for (int x = tid; x < 64 * 6; x += NTHREADS) {
            const int tok = x / 6, ch = x % 6;
            *(u32x4*)(Ks + tok * LS + ch * 8) = *(const u32x4*)(p.Z + (t0 + tok) * DINP + koff + ch * 8);
        }
        for (int x = tid; x < 16 * LS / 2; x += NTHREADS) ((unsigned*)(Kts + 48 * LS))[x] = 0u;
        if (tid < 16) decs[48 + tid] = 1.f;
        load_vts(p.Z, t0, voff, 12, Vts, tid);
    } else {
        const int tok = tid >> 2, cq = tid & 3;
        unsigned k1[4], k2[4];
        rot8(p.Z + (t0 + tok) * DINP + koff, p.rope, c * 64 + tok, cq, k1, k2);
        const float fk2 = 0.125f * __expf(ret_lg(h) * (float)(63 - tok));
#pragma unroll
        for (int e = 0; e < 4; ++e) {
            Kts[(cq * 8 + 2 * e) * LS + tok] = f2bf(lo_bf(k1[e]) * fk2); Kts[(cq * 8 + 2 * e + 1) * LS + tok] = f2bf(hi_bf(k1[e]) * fk2);
            Kts[(32 + cq * 8 + 2 * e) * LS + tok] = f2bf(lo_bf(k2[e]) * fk2); Kts[(32 + cq * 8 + 2 * e + 1) * LS + tok] = f2bf(hi_bf(k2[e]) * fk2);
        }
        if (tid < 64) decs[tid] = __expf(ret_lg(h) * 64.f);
        load_vts(p.Z, t0, voff, 8, Vts, tid);
    }
    __syncthreads();
    if (IS_GLA) {
        float gd[16];
        load_gd(p.Z + (t0 + lane) * DINP + gkdoff, gd);
#pragma unroll 1
        for (int dd = 0; dd < 12; ++dd) {
            const int d = wave * 12 + dd;
            const float bc = wave_incl_scan(gla_gk(p, gd, h, d));
            const float bl = readlane_f(bc, 63);
            Kts[d * LS + lane] = f2bf(bf2f(Ks[lane * LS + d]) * __expf(bl - bc));
            if (lane == 0) decs[d] = __expf(bl);
        }
        __syncthreads();
    }
    float* KV = (float*)(p.lin + (IS_GLA ? LN_KV_GLA : LN_KV_RET)) + (size_t)task * DV * 64;
#pragma unroll
    for (int vb = 0; vb < NVB; ++vb) {
        f32x4 a4 = (f32x4){0.f, 0.f, 0.f, 0.f};
#pragma unroll
        for (int ks = 0; ks < 2; ++ks) {
            const bf16x8 a = ldfrag(Kts, 16 * wave + fl, ks * 32 + fq * 8);
            const bf16x8 bv = ldfrag(Vts, 16 * vb + fl, ks * 32 + fq * 8);
            a4 = __builtin_amdgcn_mfma_f32_16x16x32_bf16(a, bv, a4, 0, 0, 0);
        }
        *(f32x4*)(KV + (size_t)(16 * vb + fl) * 64 + 16 * wave + 4 * fq) = a4;
    }
    if (tid < 64) ((float*)(p.lin + LN_DEC))[(size_t)((IS_GLA ? 1024 : 0) + task) * 64 + tid] = decs[tid];
}

__device__ void lin_scan_phase(const LinP& p, int vbid, int nvblk, unsigned* flags) {
    const int tid = otid();
    for (int it = vbid; it < 160; it += nvblk) {
        const bool gla = it >= 64;
        const int r = gla ? it - 64 : it;
        const int per = gla ? 6 : 4, DVx = gla ? 96 : 64;
        const int bh = r / per, e = (r % per) * 1024 + tid;
        const float* KV = (const float*)(p.lin + (gla ? LN_KV_GLA : LN_KV_RET)) + (size_t)bh * 64 * DVx * 64 + e;
        bf16_t* Sb = (bf16_t*)(p.lin + (gla ? LN_S_GLA : LN_S_RET)) + (size_t)bh * 64 * DVx * 64 + e;
        const float* DEC = (const float*)(p.lin + LN_DEC) + (size_t)((gla ? 1024 : 0) + bh * 64) * 64 + (e & 63);
        float S0 = 0.f, S1 = 0.f, S2 = 0.f, S3 = 0.f;
#pragma unroll 8
        for (int c = 0; c < 64; ++c) {
            const size_t o = (size_t)c * DVx * 64;
            const float k0 = KV[o], k1 = KV[o + 256], k2 = KV[o + 512], k3 = KV[o + 768], dc = DEC[c * 64];
            Sb[o] = f2bf(S0); Sb[o + 256] = f2bf(S1); Sb[o + 512] = f2bf(S2); Sb[o + 768] = f2bf(S3);
            S0 = S0 * dc + k0; S1 = S1 * dc + k1; S2 = S2 * dc + k2; S3 = S3 * dc + k3;
        }
        flag_signal(flags + (gla ? 16 : 0) + bh);
    }
}

template <bool IS_GLA>
__device__ void lin_out_task(const LinP& p, char* smem, int b, int h, int c) {
    constexpr int DV = IS_GLA ? 96 : 64, NVB = DV / 16;
    const int qoff = IS_GLA ? (ZC_GLA + 0 + h * 48) : (ZC_RET + 0 + h * 64);
    const int koff = IS_GLA ? (ZC_GLA + 192 + h * 48) : (ZC_RET + 256 + h * 64);
    const int voff = IS_GLA ? (ZC_GLA + 384 + h * 96) : (ZC_RET + 512 + h * 64);
    const int goff = IS_GLA ? (ZC_GLA + 784 + h * 96) : (ZC_RET + 768 + h * 64);
    const int gkdoff = ZC_GLA + 768;
    const int ooff = IS_GLA ? (640 + h * 96) : (h * 64);
    bf16_t* Qs = (bf16_t*)smem;
    bf16_t* Ks = Qs + 64 * LS;
    bf16_t* Ps = Ks + 64 * LS;
    bf16_t* Vts = Ps + 64 * LS;
    bf16_t* Sts = Vts + 96 * LS;
    const int tid = otid(), lane = tid & 63, wave = tid >> 6;
    const int fl = lane & 15, fq = lane >> 4;
    const size_t t0 = (size_t)b * NS + (size_t)c * 64;
    const int task = (b * 4 + h) * 64 + c;
    __syncthreads();
    {
        const bf16_t* Sb = (const bf16_t*)(p.lin + (IS_GLA ? LN_S_GLA : LN_S_RET)) + (size_t)task * DV * 64;
        for (int x = tid; x < DV * 8; x += NTHREADS) { const int v = x >> 3, ch = x & 7; *(u32x4*)(Sts + v * LS + ch * 8) = *(const u32x4*)(Sb + v * 64 + ch * 8); }
    }
    if (IS_GLA) {
        for (int x = tid; x < 64 * 6; x += NTHREADS) {
            const int tok = x / 6, ch = x % 6;
            const bf16_t* zr = p.Z + (t0 + tok) * DINP;
            *(u32x4*)(Qs + tok * LS + ch * 8) = *(const u32x4*)(zr + qoff + ch * 8);
            *(u32x4*)(Ks + tok * LS + ch * 8) = *(const u32x4*)(zr + koff + ch * 8);
        }
        for (int x = tid; x < 64 * 2; x += NTHREADS) {
            const int tok = x >> 1, ch = 6 + (x & 1);
            *(u32x4*)(Qs + tok * LS + ch * 8) = (u32x4){0u, 0u, 0u, 0u};
            *(u32x4*)(Ks + tok * LS + ch * 8) = (u32x4){0u, 0u, 0u, 0u};
        }
        load_vts(p.Z, t0, voff, 12, Vts, tid);
    } else {
        const int tok = tid >> 2, cq = tid & 3;
        const bf16_t* zr = p.Z + (t0 + tok) * DINP;
        unsigned q1[4], q2[4], k1[4], k2[4];
        rot8(zr + qoff, p.rope, c * 64 + tok, cq, q1, q2);
        rot8(zr + koff, p.rope, c * 64 + tok, cq, k1, k2);
        const float lg = ret_lg(h);
        const float fqd = __expf(lg * (float)(tok + 1)), fk = 0.125f * __expf(-lg * (float)(tok + 1));
#pragma unroll
        for (int e = 0; e < 4; ++e) {
            q1[e] = pk2(lo_bf(q1[e]) * fqd, hi_bf(q1[e]) * fqd); q2[e] = pk2(lo_bf(q2[e]) * fqd, hi_bf(q2[e]) * fqd);
            k1[e] = pk2(lo_bf(k1[e]) * fk, hi_bf(k1[e]) * fk); k2[e] = pk2(lo_bf(k2[e]) * fk, hi_bf(k2[e]) * fk);
        }
        *(u32x4*)(Qs + tok * LS + cq * 8) = (u32x4){q1[0], q1[1], q1[2], q1[3]};
        *(u32x4*)(Qs + tok * LS + 32 + cq * 8) = (u32x4){q2[0], q2[1], q2[2], q2[3]};
        *(u32x4*)(Ks + tok * LS + cq * 8) = (u32x4){k1[0], k1[1], k1[2], k1[3]};
        *(u32x4*)(Ks + tok * LS + 32 + cq * 8) = (u32x4){k2[0], k2[1], k2[2], k2[3]};
        load_vts(p.Z, t0, voff, 8, Vts, tid);
    }
    __syncthreads();
    if (IS_GLA) {
        float gd[16];
        load_gd(p.Z + (t0 + lane) * DINP + gkdoff, gd);
#pragma unroll 1
        for (int dd = 0; dd < 12; ++dd) {
            const int d = wave * 12 + dd;
            const float bc = wave_incl_scan(gla_gk(p, gd, h, d));
            const float eq = __expf(bc) * 0.14433756729740643f  , ek = __expf(-bc);
            Qs[lane * LS + d] = f2bf(bf2f(Qs[lane * LS + d]) * eq);
            Ks[lane * LS + d] = f2bf(bf2f(Ks[lane * LS + d]) * ek);
        }
        __syncthreads();
    }
#pragma unroll
    for (int jb = 0; jb < 4; ++jb) {
        f32x4 ap = (f32x4){0.f, 0.f, 0.f, 0.f};
#pragma unroll
        for (int ks = 0; ks < 2; ++ks) {
            const bf16x8 a = ldfrag(Ks, 16 * jb + fl, ks * 32 + fq * 8);
            const bf16x8 bq = ldfrag(Qs, 16 * wave + fl, ks * 32 + fq * 8);
            ap = __builtin_amdgcn_mfma_f32_16x16x32_bf16(a, bq, ap, 0, 0, 0);
        }
        const int i = 16 * wave + fl, j0 = 16 * jb + 4 * fq;
        u32x2 w;
        w.x = pk2(j0 + 0 <= i ? ap.x : 0.f, j0 + 1 <= i ? ap.y : 0.f);
        w.y = pk2(j0 + 2 <= i ? ap.z : 0.f, j0 + 3 <= i ? ap.w : 0.f);
        *(u32x2*)(Ps + i * LS + j0) = w;
    }
    __syncthreads();
    {
        f32x4 ao[NVB];
        float ss = 0.f;
#pragma unroll
        for (int vb = 0; vb < NVB; ++vb) {
            f32x4 a4 = (f32x4){0.f, 0.f, 0.f, 0.f};
#pragma unroll
            for (int ks = 0; ks < 2; ++ks) {
                const bf16x8 a = ldfrag(Vts, 16 * vb + fl, ks * 32 + fq * 8);
                const bf16x8 bp = ldfrag(Ps, 16 * wave + fl, ks * 32 + fq * 8);
                a4 = __builtin_amdgcn_mfma_f32_16x16x32_bf16(a, bp, a4, 0, 0, 0);
            }
#pragma unroll
            for (int ks = 0; ks < 2; ++ks) {
                const bf16x8 a = ldfrag(Sts, 16 * vb + fl, ks * 32 + fq * 8);
                const bf16x8 bq = ldfrag(Qs, 16 * wave + fl, ks * 32 + fq * 8);
                a4 = __builtin_amdgcn_mfma_f32_16x16x32_bf16(a, bq, a4, 0, 0, 0);
            }
            ao[vb] = a4;
            ss += a4.x * a4.x + a4.y * a4.y + a4.z * a4.z + a4.w * a4.w;
        }
        ss = xor32_sum(xor16_sum(ss));
        const float inv = rsqrtf(ss * (1.f / DV) + 1e-5f);
        const size_t t = t0 + 16 * wave + fl;
#pragma unroll
        for (int vb = 0; vb < NVB; ++vb) {
            const int v0 = 16 * vb + 4 * fq;
            const u32x2 gg = *(const u32x2*)(p.Z + t * DINP + goff + v0);
            float g4[4] = {lo_bf(gg.x), hi_bf(gg.x), lo_bf(gg.y), hi_bf(gg.y)};
            float o4[4] = {ao[vb].x, ao[vb].y, ao[vb].z, ao[vb].w};
#pragma unroll
            for (int e = 0; e < 4; ++e) {
                float y = o4[e] * inv;
                if (IS_GLA) y *= p.norm_w[h * 96 + v0 + e];
                const float g = g4[e];
                o4[e] = y * (g / (1.f + __expf(-g)));
            }
            u32x2 w; w.x = pk2(o4[0], o4[1]); w.y = pk2(o4[2], o4[3]);
            *(u32x2*)(p.O + t * D + ooff + v0) = w;
        }
    }
}
__device__ __forceinline__ void lin_kv_dispatch(const LinP& p, char* smem, int task) {
    const int r = task & 1023, bh = r >> 6, c = r & 63;
    if (task < 1024) lin_kv_task<false>(p, smem, bh >> 2, bh & 3, c); else lin_kv_task<true>(p, smem, bh >> 2, bh & 3, c);
}
__device__ __forceinline__ void lin_out_dispatch(const LinP& p, char* smem, int task, unsigned* flags) {
    const int r = task & 1023, bh = r >> 6, c = r & 63;
    if (flags) flag_wait(flags + (task < 1024 ? 0 : 16) + bh, task < 1024 ? 4u : 6u);
    if (task < 1024) lin_out_task<false>(p, smem, bh >> 2, bh & 3, c); else lin_out_task<true>(p, smem, bh >> 2, bh & 3, c);
}

struct RwP {
    const bf16_t* Z; unsigned char* mix;
    const float* mu; const float* w_up; const float* w_bias; const float* a_up; const float* a_bias; const float* g_up;
    const float* k_k; const float* k_a; const float* r_k; const float* ln_w; const float* ln_b;
    float* oraw; bf16_t* O; bf16_t* Y; const bf16_t* lora;
};
constexpr int PS = 264;
__device__ __forceinline__ f32x4 bf4(u32x2 w) { return (f32x4){lo_bf(w.x), hi_bf(w.x), lo_bf(w.y), hi_bf(w.y)}; }
__device__ void rwkv_prep_task(const RwP& p, char* smem, int tile) {
    bf16_t* At = (bf16_t*)smem;
    const int tid = otid(), lane = tid & 63, wave = tid >> 6;
    const int fl = lane & 15, fq = lane >> 4;
    const int t0 = tile * 32;
    float* Wd = (float*)(p.mix + MX_W); float* KKd = (float*)(p.mix + MX_KK); float* KKAd = (float*)(p.mix + MX_KKA);
    bf16_t* Rd = (bf16_t*)(p.mix + MX_R); bf16_t* Kd = (bf16_t*)(p.mix + MX_K); bf16_t* Vd = (bf16_t*)(p.mix + MX_V); bf16_t* Gd = (bf16_t*)(p.mix + MX_G);
    __syncthreads();
    {
        const int tok = tid >> 3, t = t0 + tok;
        const bool first = (t & (NS - 1)) == 0;
        const bf16_t* zr = p.Z + (size_t)t * DINP + ZC_RW + 1152;
#pragma unroll
        for (int i = 0; i < 4; ++i) {
            const int ch = (tid & 7) + 8 * i;
            const u32x4 cur = *(const u32x4*)(zr + ch * 8);
            const u32x4 prv = first ? (u32x4){0u, 0u, 0u, 0u} : *(const u32x4*)(zr - DINP + ch * 8);
            const f32x4 m0 = *(const f32x4*)(p.mu + 1152 + ch * 8), m1 = *(const f32x4*)(p.mu + 1152 + ch * 8 + 4);
            const unsigned cw[4] = {cur.x, cur.y, cur.z, cur.w}, pw[4] = {prv.x, prv.y, prv.z, prv.w};
            const float mm[8] = {m0.x, m0.y, m0.z, m0.w, m1.x, m1.y, m1.z, m1.w};
            float o[8];
#pragma unroll
            for (int e = 0; e < 4; ++e) {
                const float f0 = lo_bf(cw[e]), f1 = hi_bf(cw[e]), g0 = lo_bf(pw[e]), g1 = hi_bf(pw[e]);
                o[2 * e] = f0 + (g0 - f0) * mm[2 * e]; o[2 * e + 1] = f1 + (g1 - f1) * mm[2 * e + 1];
            }
            if (ch < 8) {
#pragma unroll
                for (int e = 0; e < 8; ++e) o[e] = tanhf(o[e]);
            } else if (ch >= 16) {
#pragma unroll
                for (int e = 0; e < 8; ++e) o[e] = sigmoidf_(o[e]);
            }
            *(u32x4*)(At + tok * PS + ch * 8) = (u32x4){pk2(o[0], o[1]), pk2(o[2], o[3]), pk2(o[4], o[5]), pk2(o[6], o[7])};
        }
    }
    __syncthreads();
    bf16x8 xb[8];
#pragma unroll
    for (int ks = 0; ks < 8; ++ks) xb[ks] = *(const bf16x8*)(At + (16 * (wave & 1) + fl) * PS + ks * 32 + fq * 8);
    const int t = t0 + 16 * (wave & 1) + fl, b = t >> 12, sq = t & (NS - 1);
    const bool first = sq == 0;
    const bf16_t* zc = p.Z + (size_t)t * DINP + ZC_RW;
    const bf16_t* WupT = p.lora; const bf16_t* AupT = p.lora + 384 * 64; const bf16_t* GupT = p.lora + 2 * 384 * 64;
    const int hd0 = (wave >> 1) * 3;
#pragma unroll
    for (int hi = 0; hi < 3; ++hi) {
        const int hd = hd0 + hi;
        f32x4 aw[4], aa[4], ag[4];
#pragma unroll
        for (int n = 0; n < 4; ++n) {
            const int cr = hd * 64 + 16 * n + fl;
            f32x4 w4 = (f32x4){0.f, 0.f, 0.f, 0.f}, a4 = w4, g4 = w4;
#pragma unroll
            for (int ks = 0; ks < 2; ++ks) {
                w4 = __builtin_amdgcn_mfma_f32_16x16x32_bf16(*(const bf16x8*)(WupT + cr * 64 + ks * 32 + fq * 8), xb[ks], w4, 0, 0, 0);
                a4 = __builtin_amdgcn_mfma_f32_16x16x32_bf16(*(const bf16x8*)(AupT + cr * 64 + ks * 32 + fq * 8), xb[2 + ks], a4, 0, 0, 0);
            }
#pragma unroll
            for (int ks = 0; ks < 4; ++ks) g4 = __builtin_amdgcn_mfma_f32_16x16x32_bf16(*(const bf16x8*)(GupT + cr * 128 + ks * 32 + fq * 8), xb[4 + ks], g4, 0, 0, 0);
            aw[n] = w4; aa[n] = a4; ag[n] = g4;
        }
        f32x4 kx[4], av[4], kkv[4];
        float ss = 0.f;
        const size_t hrow = ((size_t)(b * 6 + hd) * NS + sq) * 64;
#pragma unroll
        for (int n = 0; n < 4; ++n) {
            const int cl = 16 * n + 4 * fq, c = hd * 64 + cl;
            f32x4 rr = bf4(*(const u32x2*)(zc + c)), kk = bf4(*(const u32x2*)(zc + 384 + c)), vv = bf4(*(const u32x2*)(zc + 768 + c));
            f32x4 rp = (f32x4){0.f, 0.f, 0.f, 0.f}, kp = rp, vp = rp;
            if (!first) { rp = bf4(*(const u32x2*)(zc - DINP + c)); kp = bf4(*(const u32x2*)(zc - DINP + 384 + c)); vp = bf4(*(const u32x2*)(zc - DINP + 768 + c)); }
            rr = rr + (rp - rr) * *(const f32x4*)(p.mu + c); kk = kk + (kp - kk) * *(const f32x4*)(p.mu + 384 + c); vv = vv + (vp - vv) * *(const f32x4*)(p.mu + 768 + c);
            const f32x4 wb = *(const f32x4*)(p.w_bias + c), ab = *(const f32x4*)(p.a_bias + c), kkc = *(const f32x4*)(p.k_k + c), kac = *(const f32x4*)(p.k_a + c);
            f32x4 dec, a;
            {
                const f32x4 xw = wb + aw[n], xa = ab + aa[n];
                dec.x = __expf(-__expf(-softplusf_(-xw.x) - 0.5f)); dec.y = __expf(-__expf(-softplusf_(-xw.y) - 0.5f));
                dec.z = __expf(-__expf(-softplusf_(-xw.z) - 0.5f)); dec.w = __expf(-__expf(-softplusf_(-xw.w) - 0.5f));
                a.x = sigmoidf_(xa.x); a.y = sigmoidf_(xa.y); a.z = sigmoidf_(xa.z); a.w = sigmoidf_(xa.w);
            }
            const f32x4 kr = kk * kkc;
            ss += kr.x * kr.x + kr.y * kr.y + kr.z * kr.z + kr.w * kr.w;
            kkv[n] = kr; av[n] = a; kx[n] = kk;
            const f32x4 kmod = kk * ((a - 1.f) * kac + 1.f);
            *(f32x4*)(Wd + hrow + cl) = dec;
            u32x2 w;
            w.x = pk2(rr.x, rr.y); w.y = pk2(rr.z, rr.w); *(u32x2*)(Rd + hrow + cl) = w;
            w.x = pk2(kmod.x, kmod.y); w.y = pk2(kmod.z, kmod.w); *(u32x2*)(Kd + hrow + cl) = w;
            w.x = pk2(vv.x, vv.y); w.y = pk2(vv.z, vv.w); *(u32x2*)(Vd + hrow + cl) = w;
            w.x = pk2(ag[n].x, ag[n].y); w.y = pk2(ag[n].z, ag[n].w); *(u32x2*)(Gd + (size_t)t * 384 + c) = w;
        }
        ss = xor32_sum(xor16_sum(ss));
        const float rn = rsqrtf(fmaxf(ss, 1e-24f));
#pragma unroll
        for (int n = 0; n < 4; ++n) {
            const int cl = 16 * n + 4 * fq;
            const f32x4 kn = kkv[n] * rn;
            *(f32x4*)(KKd + hrow + cl) = kn;
            *(f32x4*)(KKAd + hrow + cl) = kn * av[n];
        }
    }
}

constexpr int SC_STEPS = 16;
constexpr int SEG_BEG[4] = {0, 1376, 2736, 4096};
constexpr size_t MX_SE0 = MX_END;
constexpr size_t MX_XE  = MX_SE0 + 24ull * 3 * 4096 * 4;
constexpr size_t MX_SST = MX_XE + 24ull * 3 * 4096 * 4;
static_assert(MX_SST + 24ull * 3 * 4096 * 2 <= 128 * MiB, "mix region");
__device__ __forceinline__ float row8_sum(float v) { v += dpp_f<0xB1>(v); v += dpp_f<0x4E>(v); v += dpp_f<0x141>(v); return v; }
__device__ void rwkv_scan_task(const RwP& p, char* smem, int bh, int seg, int grp) {
    float* buf = (float*)smem;
    float* obuf = buf + 2 * 6 * SC_STEPS * 64;
    const int tid = otid(), lane = tid & 63, wave = tid >> 6;
    const int rloc = wave * 8 + (lane >> 3);
    const bool ident = grp >= 2;
    const int row = (grp & 1) * 32 + rloc;
    const int c8 = (lane & 7) * 8;
    const int s_beg = seg == 0 ? SEG_BEG[0] : (seg == 1 ? SEG_BEG[1] : SEG_BEG[2]);
    const int s_end = seg == 0 ? SEG_BEG[1] : (seg == 1 ? SEG_BEG[2] : SEG_BEG[3]);
    const int NCH = (s_end - s_beg) / SC_STEPS;
    const size_t hb = ((size_t)bh * NS + s_beg) * 64;
    const float* Wd = (const float*)(p.mix + MX_W) + hb;
    const float* KKd = (const float*)(p.mix + MX_KK) + hb;
    const float* KKAd = (const float*)(p.mix + MX_KKA) + hb;
    const bf16_t* Rd = (const bf16_t*)(p.mix + MX_R) + hb;
    const bf16_t* Kd = (const bf16_t*)(p.mix + MX_K) + hb;
    const bf16_t* Vd = (const bf16_t*)(p.mix + MX_V) + hb;
    float* orow = p.oraw + hb;
    bf16_t* yrow = p.Y + hb;
    f32x4 Sa, Sb;
    Sa.x = (ident && c8 + 0 == row) ? 1.f : 0.f; Sa.y = (ident && c8 + 1 == row) ? 1.f : 0.f; Sa.z = (ident && c8 + 2 == row) ? 1.f : 0.f; Sa.w = (ident && c8 + 3 == row) ? 1.f : 0.f;
    Sb.x = (ident && c8 + 4 == row) ? 1.f : 0.f; Sb.y = (ident && c8 + 5 == row) ? 1.f : 0.f; Sb.z = (ident && c8 + 6 == row) ? 1.f : 0.f; Sb.w = (ident && c8 + 7 == row) ? 1.f : 0.f;
    struct Stg { f32x4 w, kk, ka; u32x2 r, k, v; };
    Stg sA, sB;
    auto gload = [&](Stg& g, int ch) {
        const size_t e = (size_t)ch * SC_STEPS * 64 + tid * 4;
        g.w = *(const f32x4*)(Wd + e); g.kk = *(const f32x4*)(KKd + e); g.ka = *(const f32x4*)(KKAd + e);
        g.r = *(const u32x2*)(Rd + e); g.k = *(const u32x2*)(Kd + e); g.v = *(const u32x2*)(Vd + e);
    };
    auto lstore = [&](const Stg& g, int bsel) {
        float* bb = buf + bsel * 6 * SC_STEPS * 64 + tid * 4;
        *(f32x4*)(bb + 0 * SC_STEPS * 64) = g.w; *(f32x4*)(bb + 1 * SC_STEPS * 64) = g.kk; *(f32x4*)(bb + 2 * SC_STEPS * 64) = g.ka;
        *(f32x4*)(bb + 3 * SC_STEPS * 64) = (f32x4){lo_bf(g.r.x), hi_bf(g.r.x), lo_bf(g.r.y), hi_bf(g.r.y)};
        *(f32x4*)(bb + 4 * SC_STEPS * 64) = (f32x4){lo_bf(g.k.x), hi_bf(g.k.x), lo_bf(g.k.y), hi_bf(g.k.y)};
        *(f32x4*)(bb + 5 * SC_STEPS * 64) = (f32x4){lo_bf(g.v.x), hi_bf(g.v.x), lo_bf(g.v.y), hi_bf(g.v.y)};
    };
    __syncthreads();
    gload(sA, 0); lstore(sA, 0);
    gload(sA, 1);
    __syncthreads();
    const float vmask = ident ? 0.f : 1.f;
    struct Ops { f32x4 w0, w1, kk0, kk1, ka0, ka1, r0, r1, k0, k1; float v; };
    auto ldops = [&](Ops& o, const float* bb, int st) {
        const float* q = bb + st * 64 + c8;
        o.w0 = *(const f32x4*)(q); o.w1 = *(const f32x4*)(q + 4);
        o.kk0 = *(const f32x4*)(q + 1 * SC_STEPS * 64); o.kk1 = *(const f32x4*)(q + 1 * SC_STEPS * 64 + 4);
        o.ka0 = *(const f32x4*)(q + 2 * SC_STEPS * 64); o.ka1 = *(const f32x4*)(q + 2 * SC_STEPS * 64 + 4);
        o.r0 = *(const f32x4*)(q + 3 * SC_STEPS * 64); o.r1 = *(const f32x4*)(q + 3 * SC_STEPS * 64 + 4);
        o.k0 = *(const f32x4*)(q + 4 * SC_STEPS * 64); o.k1 = *(const f32x4*)(q + 4 * SC_STEPS * 64 + 4);
        o.v = bb[5 * SC_STEPS * 64 + st * 64 + row];
    };
    auto chunk = [&](int ch, Stg& cur  , Stg& nxt  ) {
        if (ch + 2 < NCH) gload(nxt, ch + 2);
        const float* bb = buf + (ch & 1) * 6 * SC_STEPS * 64;
        Ops o; ldops(o, bb, 0);
#pragma unroll
        for (int st = 0; st < SC_STEPS; ++st) {
            Ops n; ldops(n, bb, (st + 1 < SC_STEPS) ? st + 1 : st);
            const float vx = o.v * vmask;
            const f32x4 pa = Sa * o.kk0 + Sb * o.kk1;
            const float sa = -row8_sum((pa.x + pa.y) + (pa.z + pa.w));
            Sa = Sa * o.w0 + o.k0 * vx + o.ka0 * sa;
            Sb = Sb * o.w1 + o.k1 * vx + o.ka1 * sa;
            const f32x4 qa = Sa * o.r0 + Sb * o.r1;
            obuf[st * 32 + rloc] = row8_sum((qa.x + qa.y) + (qa.z + qa.w));
            o = n;
        }
        __syncthreads();
#pragma unroll
        for (int i = 0; i < 2; ++i) {
            const int idx = tid + 256 * i, st = idx >> 5, rr = idx & 31;
            const size_t oi = ((size_t)ch * SC_STEPS + st) * 64 + (grp & 1) * 32 + rr;
            if (ident) yrow[oi] = f2bf(obuf[idx]); else orow[oi] = obuf[idx];
        }
        if (ch + 1 < NCH) lstore(cur, (ch + 1) & 1);
        __syncthreads();
    };
    for (int ch = 0; ch < NCH; ch += 2) {
        chunk(ch, sA, sB);
        if (ch + 1 < NCH) chunk(ch + 1, sB, sA);
    }
    float* fin = (float*)(p.mix + (ident ? MX_XE : MX_SE0)) + ((size_t)(bh * 3 + seg) * 64 + row) * 64 + c8;
    *(f32x4*)fin = Sa; *(f32x4*)(fin + 4) = Sb;
}

__device__ void phase_rwkv_chain(const RwP& p, int bid, int nblk) {
    const int lane = otid() & 63, wave = otid() >> 6;
    const float* SE0 = (const float*)(p.mix + MX_SE0); const float* XE = (const float*)(p.mix + MX_XE);
    bf16_t* SST = (bf16_t*)(p.mix + MX_SST);
    for (int x = bid * 4 + wave; x < 24 * 4; x += nblk * 4) {
        const int bh = x >> 2, cg = (x & 3) * 16;
        const float* s1 = SE0 + ((size_t)(bh * 3 + 0) * 64 + lane) * 64;
        const float* e1 = SE0 + ((size_t)(bh * 3 + 1) * 64 + lane) * 64 + cg;
        const float* X1 = XE + (size_t)(bh * 3 + 1) * 4096 + cg;
        float o[16];
#pragma unroll
        for (int k = 0; k < 16; ++k) o[k] = e1[k];
        for (int i = 0; i < 64; ++i) {
            const float si = s1[i];
#pragma unroll
            for (int k = 0; k < 16; ++k) o[k] += si * X1[i * 64 + k];
        }
        bf16_t* d1 = SST + ((size_t)(bh * 3 + 1) * 64 + lane) * 64 + cg;
        bf16_t* d2 = SST + ((size_t)(bh * 3 + 2) * 64 + lane) * 64 + cg;
#pragma unroll
        for (int k = 0; k < 16; ++k) { d1[k] = f2bf(s1[cg + k]); d2[k] = f2bf(o[k]); }
    }
}

__device__ void phase_rwkv_post(const RwP& p, int bid, int nblk) {
    const int lane = otid() & 63, wave = otid() >> 6;
    const int fl = lane & 15, fq = lane >> 4;
    const bf16_t* Rd = (const bf16_t*)(p.mix + MX_R); const bf16_t* Kd = (const bf16_t*)(p.mix + MX_K); const bf16_t* Vd = (const bf16_t*)(p.mix + MX_V);
    const bf16_t* Gd = (const bf16_t*)(p.mix + MX_G); const bf16_t* SST = (const bf16_t*)(p.mix + MX_SST);
    for (int x = bid * 4 + wave; x < 24 * (NS / 16); x += nblk * 4) {
        const int bh = x / (NS / 16), s0 = (x % (NS / 16)) * 16;
        const int b = bh / 6, hd = bh % 6;
        const int seg = s0 < SEG_BEG[1] ? 0 : (s0 < SEG_BEG[2] ? 1 : 2);
        const size_t hrow = ((size_t)bh * NS + s0 + fl) * 64;
        f32x4 acc[4];
#pragma unroll
        for (int n = 0; n < 4; ++n) acc[n] = *(const f32x4*)(p.oraw + hrow + 16 * n + 4 * fq);
        if (seg > 0) {
            const bf16_t* ss = SST + (size_t)(bh * 3 + seg) * 4096;
#pragma unroll
            for (int ks = 0; ks < 2; ++ks) {
                const bf16x8 yb = *(const bf16x8*)(p.Y + hrow + ks * 32 + fq * 8);
#pragma unroll
                for (int n = 0; n < 4; ++n) {
                    const bf16x8 sa = *(const bf16x8*)(ss + (size_t)(16 * n + fl) * 64 + ks * 32 + fq * 8);
                    acc[n] = __builtin_amdgcn_mfma_f32_16x16x32_bf16(sa, yb, acc[n], 0, 0, 0);
                }
            }
        }
        float sm = 0.f;
#pragma unroll
        for (int n = 0; n < 4; ++n) sm += acc[n].x + acc[n].y + acc[n].z + acc[n].w;
        const float mean = xor32_sum(xor16_sum(sm)) * (1.f / 64.f);
        float sv = 0.f;
#pragma unroll
        for (int n = 0; n < 4; ++n) { acc[n] = acc[n] - mean; sv += acc[n].x * acc[n].x + acc[n].y * acc[n].y + acc[n].z * acc[n].z + acc[n].w * acc[n].w; }
        const float rstd = rsqrtf(xor32_sum(xor16_sum(sv)) * (1.f / 64.f) + 64e-5f);
        float rk = 0.f; f32x4 vv[4];
#pragma unroll
        for (int n = 0; n < 4; ++n) {
            const int c = 16 * n + 4 * fq;
            const u32x2 r2 = *(const u32x2*)(Rd + hrow + c), k2 = *(const u32x2*)(Kd + hrow + c), v2 = *(const u32x2*)(Vd + hrow + c);
            const f32x4 rkw = *(const f32x4*)(p.r_k + hd * 64 + c);
            rk += lo_bf(r2.x) * lo_bf(k2.x) * rkw.x + hi_bf(r2.x) * hi_bf(k2.x) * rkw.y + lo_bf(r2.y) * lo_bf(k2.y) * rkw.z + hi_bf(r2.y) * hi_bf(k2.y) * rkw.w;
            vv[n] = (f32x4){lo_bf(v2.x), hi_bf(v2.x), lo_bf(v2.y), hi_bf(v2.y)};
        }
        rk = xor32_sum(xor16_sum(rk));
        const size_t t = (size_t)b * NS + s0 + fl;
#pragma unroll
        for (int n = 0; n < 4; ++n) {
            const int c = 16 * n + 4 * fq;
            const f32x4 lw = *(const f32x4*)(p.ln_w + hd * 64 + c), lb = *(const f32x4*)(p.ln_b + hd * 64 + c);
            const u32x2 g2 = *(const u32x2*)(Gd + t * 384 + hd * 64 + c);
            const f32x4 gg = (f32x4){lo_bf(g2.x), hi_bf(g2.x), lo_bf(g2.y), hi_bf(g2.y)};
            const f32x4 o = (acc[n] * rstd * lw + lb + vv[n] * rk) * gg;
            u32x2 w; w.x = pk2(o.x, o.y); w.y = pk2(o.z, o.w);
            *(u32x2*)(p.O + t * D + 256 + hd * 64 + c) = w;
        }
    }
}

__device__ __forceinline__ unsigned ordkey(float f) { const unsigned u = __float_as_uint(f); return (u & 0x80000000u) ? ~u : (u | 0x80000000u); }
__device__ __forceinline__ float unordkey(unsigned k) { return __uint_as_float((k & 0x80000000u) ? (k & 0x7FFFFFFFu) : ~k); }
__device__ __forceinline__ void ins16(unsigned (&L)[16], unsigned x) {
#pragma unroll
    for (int i = 0; i < 16; ++i) { const unsigned hi = L[i] > x ? L[i] : x; x = L[i] > x ? x : L[i]; L[i] = hi; }
}
__device__ __forceinline__ void top16_col(const float* col  , unsigned (&L)[16]) {
#pragma unroll
    for (int i = 0; i < 16; ++i) L[i] = 0u;
#pragma unroll 1
    for (int n0 = 0; n0 < 128; n0 += 16) {
        float x[16];
#pragma unroll
        for (int j = 0; j < 16; ++j) x[j] = col[(size_t)(n0 + j) * NT];
#pragma unroll
        for (int j = 0; j < 16; ++j) ins16(L, (ordkey(x[j]) & 0xFFFFFF80u) | (unsigned)(127 - (n0 + j)));
    }
}
__device__ void phase_topk(const float* SCT, int* EIDX, float* GATE, char* smem, int bid, int nblk) {
    const int tid = otid(), lane = tid & 63, wave = tid >> 6;
    unsigned char* itab = (unsigned char*)smem + tid * 32;
    unsigned char* ctab = (unsigned char*)smem + NTHREADS * 32;
    __syncthreads();
    if (tid < 64) {
        const int c = tid; int ci, cj;
        if (c < 16) { ci = 0; cj = c; } else if (c < 24) { ci = 1; cj = c - 16; } else if (c < 29) { ci = 2; cj = c - 24; } else if (c < 33) { ci = 3; cj = c - 29; }
        else if (c < 36) { ci = 4; cj = c - 33; } else if (c < 38) { ci = 5; cj = c - 36; } else if (c < 40) { ci = 6; cj = c - 38; } else if (c < 42) { ci = 7; cj = c - 40; }
        else if (c < 50) { ci = c - 34; cj = 0; } else { ci = 0; cj = 0; }
        ctab[c] = (unsigned char)(ci | (cj << 4));
    }
    __syncthreads();
    for (int x = bid * 4 + wave; x < (NT / 64) * 8; x += nblk * 4) {
        const int tb = x >> 3, hd = x & 7;
        const int t = tb * 64 + lane;
        unsigned L1[16], L2[16];
        top16_col(SCT + (size_t)(hd * 256) * NT + t, L1);
        top16_col(SCT + (size_t)(hd * 256 + 128) * NT + t, L2);
        float s1[16], s2[16];
#pragma unroll
        for (int i = 0; i < 16; ++i) {
            s1[i] = unordkey(L1[i] & 0xFFFFFF80u); s2[i] = unordkey(L2[i] & 0xFFFFFF80u);
            itab[i] = (unsigned char)(127u - (L1[i] & 127u)); itab[16 + i] = (unsigned char)(127u - (L2[i] & 127u));
        }
        unsigned M[16];
#pragma unroll
        for (int i = 0; i < 16; ++i) M[i] = 0u;
        int c = 0;
#pragma unroll
        for (int ci = 0; ci < 16; ++ci) {
#pragma unroll
            for (int cj = 0; cj < 16; ++cj) {
                if ((ci + 1) * (cj + 1) <= 16) {
                    const int cid = (ci == 0) ? cj : (ci == 1) ? 16 + cj : (ci == 2) ? 24 + cj : (ci == 3) ? 29 + cj : (ci == 4) ? 33 + cj : (ci == 5) ? 36 + cj : (ci == 6) ? 38 + cj : (ci == 7) ? 40 + cj : 34 + ci;
                    ins16(M, (ordkey(s1[ci] + s2[cj]) & 0xFFFFFFC0u) | (unsigned)(63 - cid));
                    ++c;
                }
            }
        }
        float ev[16]; int ee[16];
        const float mx = unordkey(M[0] & 0xFFFFFFC0u);
        float sum = 0.f;
#pragma unroll
        for (int i = 0; i < 16; ++i) {
            const int cid = 63 - (int)(M[i] & 63u);
            const unsigned cc = ctab[cid];
            ee[i] = (int)itab[cc & 15u] * 128 + (int)itab[16 + (cc >> 4)];
            ev[i] = __expf(unordkey(M[i] & 0xFFFFFFC0u) - mx);
            sum += ev[i];
        }
        const float inv = 1.f / sum;
        int* eo = EIDX + (size_t)t * 128 + hd * 16; float* go = GATE + (size_t)t * 128 + hd * 16;
#pragma unroll
        for (int i = 0; i < 4; ++i) {
            *(int4*)(eo + 4 * i) = make_int4(ee[4 * i], ee[4 * i + 1], ee[4 * i + 2], ee[4 * i + 3]);
            *(f32x4*)(go + 4 * i) = (f32x4){ev[4 * i] * inv, ev[4 * i + 1] * inv, ev[4 * i + 2] * inv, ev[4 * i + 3] * inv};
        }
    }
    __syncthreads();
}

typedef float f32x2 __attribute__((ext_vector_type(2)));
__device__ __forceinline__ float gelu_erf(float d) { return 0.5f * d * (1.f + erff(d * 0.7071067811865476f)); }
template <int NMODE>
__device__ void phase_expert(const bf16_t* H, const unsigned char* U4, const unsigned char* V4, const float* SU, const float* SV, const int* EIDX, const float* GATE,
                             const float* X, float* Xo, const float* gn, bf16_t* Hn, int bid, int nblk) {
    const int lane = otid() & 63, wave = otid() >> 6;
    for (int t = bid * 4 + wave; t < NT; t += nblk * 4) {
        f32x2 xf[8], acc[8];
        {
            const u32x4 a = *(const u32x4*)(H + (size_t)t * D + lane * 16), b = *(const u32x4*)(H + (size_t)t * D + lane * 16 + 8);
            xf[0] = (f32x2){lo_bf(a.x), hi_bf(a.x)}; xf[1] = (f32x2){lo_bf(a.y), hi_bf(a.y)}; xf[2] = (f32x2){lo_bf(a.z), hi_bf(a.z)}; xf[3] = (f32x2){lo_bf(a.w), hi_bf(a.w)};
            xf[4] = (f32x2){lo_bf(b.x), hi_bf(b.x)}; xf[5] = (f32x2){lo_bf(b.y), hi_bf(b.y)}; xf[6] = (f32x2){lo_bf(b.z), hi_bf(b.z)}; xf[7] = (f32x2){lo_bf(b.w), hi_bf(b.w)};
        }
#pragma unroll
        for (int i = 0; i < 8; ++i) acc[i] = (f32x2){0.f, 0.f};
        const int e_lo = EIDX[(size_t)t * 128 + lane], e_hi = EIDX[(size_t)t * 128 + 64 + lane];
        const float g_lo = GATE[(size_t)t * 128 + lane] * SV[e_lo], g_hi = GATE[(size_t)t * 128 + 64 + lane] * SV[e_hi];
        const float su_lo = SU[e_lo], su_hi = SU[e_hi];
#pragma unroll 1
        for (int e0 = 0; e0 < 128; e0 += 16) {
            const int esrc = (e0 < 64) ? e_lo : e_hi;
            int ei[16]; u32x2 ur[16];
#pragma unroll
            for (int j = 0; j < 16; ++j) { ei[j] = __builtin_amdgcn_readlane(esrc, (e0 & 63) + j); ur[j] = *(const u32x2*)(U4 + (size_t)ei[j] * 512 + lane * 8); }
            float dmine = 0.f;
#pragma unroll
            for (int j = 0; j < 16; ++j) {
                f32x2 d2 = (f32x2){0.f, 0.f};
                d2 = __builtin_elementwise_fma(xf[0], __builtin_amdgcn_cvt_scalef32_pk_f32_fp4(ur[j].x, 1.0f, 0), d2);
                d2 = __builtin_elementwise_fma(xf[1], __builtin_amdgcn_cvt_scalef32_pk_f32_fp4(ur[j].x, 1.0f, 1), d2);
                d2 = __builtin_elementwise_fma(xf[2], __builtin_amdgcn_cvt_scalef32_pk_f32_fp4(ur[j].x, 1.0f, 2), d2);
                d2 = __builtin_elementwise_fma(xf[3], __builtin_amdgcn_cvt_scalef32_pk_f32_fp4(ur[j].x, 1.0f, 3), d2);
                d2 = __builtin_elementwise_fma(xf[4], __builtin_amdgcn_cvt_scalef32_pk_f32_fp4(ur[j].y, 1.0f, 0), d2);
                d2 = __builtin_elementwise_fma(xf[5], __builtin_amdgcn_cvt_scalef32_pk_f32_fp4(ur[j].y, 1.0f, 1), d2);
                d2 = __builtin_elementwise_fma(xf[6], __builtin_amdgcn_cvt_scalef32_pk_f32_fp4(ur[j].y, 1.0f, 2), d2);
                d2 = __builtin_elementwise_fma(xf[7], __builtin_amdgcn_cvt_scalef32_pk_f32_fp4(ur[j].y, 1.0f, 3), d2);
                const float d = wave_sum(d2.x + d2.y);
                if (lane == (e0 & 63) + j) dmine = d;
            }
            const float amine = gelu_erf(dmine * ((e0 < 64) ? su_lo : su_hi)) * ((e0 < 64) ? g_lo : g_hi);
#pragma unroll
            for (int j = 0; j < 16; ++j) ur[j] = *(const u32x2*)(V4 + (size_t)ei[j] * 512 + lane * 8);
#pragma unroll
            for (int j = 0; j < 16; ++j) {
                const float a = __int_as_float(__builtin_amdgcn_readlane(__float_as_int(amine), (e0 & 63) + j));
                const f32x2 a2 = (f32x2){a, a};
                acc[0] = __builtin_elementwise_fma(a2, __builtin_amdgcn_cvt_scalef32_pk_f32_fp4(ur[j].x, 1.0f, 0), acc[0]);
                acc[1] = __builtin_elementwise_fma(a2, __builtin_amdgcn_cvt_scalef32_pk_f32_fp4(ur[j].x, 1.0f, 1), acc[1]);
                acc[2] = __builtin_elementwise_fma(a2, __builtin_amdgcn_cvt_scalef32_pk_f32_fp4(ur[j].x, 1.0f, 2), acc[2]);
                acc[3] = __builtin_elementwise_fma(a2, __builtin_amdgcn_cvt_scalef32_pk_f32_fp4(ur[j].x, 1.0f, 3), acc[3]);
                acc[4] = __builtin_elementwise_fma(a2, __builtin_amdgcn_cvt_scalef32_pk_f32_fp4(ur[j].y, 1.0f, 0), acc[4]);
                acc[5] = __builtin_elementwise_fma(a2, __builtin_amdgcn_cvt_scalef32_pk_f32_fp4(ur[j].y, 1.0f, 1), acc[5]);
                acc[6] = __builtin_elementwise_fma(a2, __builtin_amdgcn_cvt_scalef32_pk_f32_fp4(ur[j].y, 1.0f, 2), acc[6]);
                acc[7] = __builtin_elementwise_fma(a2, __builtin_amdgcn_cvt_scalef32_pk_f32_fp4(ur[j].y, 1.0f, 3), acc[7]);
            }
        }
        const f32x4* xr = (const f32x4*)(X + (size_t)t * D) + lane * 4;
        f32x4* xo = (f32x4*)(Xo + (size_t)t * D) + lane * 4;
        f32x4 o[4]; float ss = 0.f;
#pragma unroll
        for (int i = 0; i < 4; ++i) { o[i] = xr[i]; o[i] += (f32x4){acc[2 * i].x, acc[2 * i].y, acc[2 * i + 1].x, acc[2 * i + 1].y}; ss += o[i].x * o[i].x + o[i].y * o[i].y + o[i].z * o[i].z + o[i].w * o[i].w; }
        const float rs = rsqrtf(wave_sum(ss) * (1.f / D) + 1e-6f);
        const f32x4* gp = (const f32x4*)gn + lane * 4;
        if (NMODE == 1) {
#pragma unroll
            for (int i = 0; i < 4; ++i) xo[i] = o[i] * rs * gp[i];
        } else {
            u32x4 h0, h1;
            { const f32x4 y0 = o[0] * rs * gp[0], y1 = o[1] * rs * gp[1], y2 = o[2] * rs * gp[2], y3 = o[3] * rs * gp[3];
              h0 = (u32x4){pk2(y0.x, y0.y), pk2(y0.z, y0.w), pk2(y1.x, y1.y), pk2(y1.z, y1.w)}; h1 = (u32x4){pk2(y2.x, y2.y), pk2(y2.z, y2.w), pk2(y3.x, y3.y), pk2(y3.z, y3.w)}; }
#pragma unroll
            for (int i = 0; i < 4; ++i) xo[i] = o[i];
            *(u32x4*)(Hn + (size_t)t * D + lane * 16) = h0; *(u32x4*)(Hn + (size_t)t * D + lane * 16 + 8) = h1;
        }
    }
}

#define XB_TMO      128
#define XB_XCNT(j)  (256  + 64 * (j))
#define XB_XSUB(j)  (1280 + 64 * (j))
#define XB_XGEN(j)  (2304 + 64 * (j))
#define XB_TOP      3328
#define XB_TOPGEN   3392
#define XCD_BAR_WORDS 3456
#define XB_SPIN_CAP (1u << 22)
#define LAS __attribute__((address_space(3)))
__device__ __forceinline__ unsigned xb_ld(unsigned* p)              { return __hip_atomic_load(p, __ATOMIC_RELAXED, __HIP_MEMORY_SCOPE_AGENT); }
__device__ __forceinline__ unsigned xb_add(unsigned* p, unsigned v) { return __hip_atomic_fetch_add(p, v, __ATOMIC_RELAXED, __HIP_MEMORY_SCOPE_AGENT); }
__device__ __forceinline__ unsigned xb_xcc_id() { return (unsigned)__builtin_amdgcn_s_getreg((3 << 11) | 20) & 0xFu; }
#define XB_SPIN(cond, bar) do { unsigned _sp = 0; while (cond) { __builtin_amdgcn_s_sleep(1); \
    if ((++_sp & 255u) == 0u) { if (xb_ld(&(bar)[XB_TMO])) break; if (_sp > XB_SPIN_CAP) { atomicAdd(&(bar)[XB_TMO], 1u); break; } } } } while (0)
struct XcdBarrier { unsigned* bar; unsigned x; volatile LAS unsigned* st; };
__device__ __forceinline__ XcdBarrier xcd_barrier_post(unsigned* bar, volatile LAS unsigned* st) {
    XcdBarrier b; b.bar = bar; b.x = xb_xcc_id(); b.st = st;
    if (threadIdx.x == 0) (void)xb_add(&bar[XB_XCNT(b.x)], 1u);
    return b;
}
__device__ __forceinline__ void xcd_barrier_complete(unsigned* bar, unsigned x, unsigned& nloc, unsigned& nx) {
    const unsigned G = gridDim.x * gridDim.y * gridDim.z;
    unsigned sum, cnt, mine, sp = 0u;
    for (;;) {
        sum = 0u; cnt = 0u; mine = 0u;
#pragma unroll
        for (unsigned j = 0; j < 16; ++j) { const unsigned c = xb_ld(&bar[XB_XCNT(j)]); sum += c; cnt += (c > 0u) ? 1u : 0u; mine = (j == x) ? c : mine; }
        if (sum == G) break;
        __builtin_amdgcn_s_sleep(1);
        if ((++sp & 255u) == 0u) { if (xb_ld(&bar[XB_TMO])) break; if (sp > XB_SPIN_CAP) { atomicAdd(&bar[XB_TMO], 1u); break; } }
    }
    nloc = mine > 0u ? mine : 1u; nx = cnt > 0u ? cnt : 1u;
}
__device__ __forceinline__ void xcd_barrier(const XcdBarrier& b) {
    asm volatile("s_waitcnt vmcnt(0)" ::: "memory");
    __syncthreads();
    if (threadIdx.x == 0) {
        unsigned* bar = b.bar;
        __builtin_amdgcn_s_waitcnt(0);
        unsigned nloc = b.st[0], nx = b.st[1];
        if (nloc == 0u) { xcd_barrier_complete(bar, b.x, nloc, nx); b.st[0] = nloc; b.st[1] = nx; }
        const unsigned old = xb_add(&bar[XB_XSUB(b.x)], 1u);
        const unsigned gen = old / nloc;
        if (old + 1u == (gen + 1u) * nloc) {
            __builtin_amdgcn_fence(__ATOMIC_RELEASE, "agent");
            asm volatile("s_waitcnt vmcnt(0)" ::: "memory");
            const unsigned og = xb_add(&bar[XB_TOP], 1u);
            const unsigned tg = og / nx;
            if (og + 1u == (tg + 1u) * nx) xb_add(&bar[XB_TOPGEN], 1u);
            else XB_SPIN(xb_ld(&bar[XB_TOPGEN]) == tg, bar);
            __builtin_amdgcn_fence(__ATOMIC_ACQUIRE, "agent");
            xb_add(&bar[XB_XGEN(b.x)], 1u);
            asm volatile("s_waitcnt vmcnt(0)" ::: "memory");
        } else {
            XB_SPIN(xb_ld(&bar[XB_XGEN(b.x)]) == gen, bar);
            __builtin_amdgcn_fence(__ATOMIC_ACQUIRE, "agent");
            asm volatile("s_waitcnt vmcnt(0)" ::: "memory");
        }
    }
    __syncthreads();
}

struct Params {
    const float* in[24];
    float* out; unsigned char* ws;
};
constexpr int LDS_BYTES = 2 * 2 * 128 * GS * 2 + 256;

__device__ __forceinline__ RwP make_rwp(const Params& P, int l) {
    RwP r;
    r.Z = (const bf16_t*)(P.ws + WS_Z); r.mix = P.ws + WS_MIX;
    r.mu = P.in[6] + l * RW_F; r.w_up = P.in[7] + (size_t)l * 64 * 384; r.w_bias = P.in[8] + l * 384; r.a_up = P.in[9] + (size_t)l * 64 * 384; r.a_bias = P.in[10] + l * 384;
    r.g_up = P.in[11] + (size_t)l * 128 * 384; r.k_k = P.in[12] + l * 384; r.k_a = P.in[13] + l * 384; r.r_k = P.in[14] + l * 384; r.ln_w = P.in[15] + l * 384; r.ln_b = P.in[16] + l * 384;
    r.oraw = (float*)(P.ws + WS_H); r.O = (bf16_t*)(P.ws + WS_O); r.Y = (bf16_t*)(P.ws + WS_EIDX); r.lora = (const bf16_t*)(P.ws + WS_LORA + l * LORA_L);
    return r;
}

__global__ void __launch_bounds__(NTHREADS, 2) mega_fwd(Params P) {
    extern __shared__ __attribute__((aligned(16))) char smem[];
    const int bid = blockIdx.x, nblk = gridDim.x;
    volatile LAS unsigned* st = (volatile LAS unsigned*)(smem + LDS_BYTES - 16);
    if (threadIdx.x == 0) { st[0] = 0u; st[1] = 0u; st[2] = 0u; st[3] = 0u; }
    __syncthreads();
    XcdBarrier bar = xcd_barrier_post((unsigned*)(P.ws + WS_CTL), st);
#define GSYNC() xcd_barrier(bar)

    {
        ConvP c{P.in[4], P.in[5], P.in[20], P.in[21], P.in[22], P.in[23], P.in[7], P.in[9], P.in[11], P.ws};
        phase_convert_weights(c, smem, bid, nblk);
        phase_rmsnorm<false>(P.in[0], P.in[1], P.ws + WS_H, bid, nblk);
    }
    GSYNC();
#pragma unroll 1
    for (int l = 0; l < 2; ++l) {
        const float* xin = (l == 0) ? P.in[0] : P.out;
        {
            GemmP g{(const bf16_t*)(P.ws + WS_H), D, 0, 0, (const bf16_t*)(P.ws + WS_WTIN) + (size_t)l * DINP * D, D, D, NT / 128, DINP / 128, P.ws + WS_Z, DINP, nullptr};
            phase_gemm<0>(g, smem, bid, nblk);
            if (l == 0) {
                for (int l2 = 0; l2 < 2; ++l2) {
                    GemmP ge{(const bf16_t*)(P.ws + WS_SK) + (size_t)l2 * 16 * 128 * 128, 128, 0, 128, (const bf16_t*)(P.ws + WS_WTQ) + (size_t)l2 * D * 2048, 2048, 128, 16, 8,
                             (bf16_t*)(P.ws + WS_WEFF) + (size_t)l2 * 2048 * D, D, nullptr};
                    phase_gemm<0>(ge, smem, bid, nblk, (NT / 128 * (DINP / 128) + l2 * 128) % nblk);
                }
            }
        }
        GSYNC();
        RwP rw = make_rwp(P, l);
        LinP lp{(const bf16_t*)(P.ws + WS_Z), (bf16_t*)(P.ws + WS_O), P.in[17] + (size_t)l * 16 * 192, P.in[18] + l * 192, P.in[19] + l * 384, (const float*)(P.ws + WS_ROPE), P.ws + WS_LIN};
        for (int task = bid; task < 512 + 2048; task += nblk) {
            if (task < 512) { rwkv_prep_task(rw, smem, task); }
            else { lin_kv_dispatch(lp, smem, task - 512); }
        }
        GSYNC();
        {
            for (int task = bid; task < 240; task += nblk) {
                const int bh = task / 10, r = task % 10;
                const int seg = r < 2 ? 0 : (r < 6 ? 1 : 2), grp = r < 2 ? r : (r < 6 ? r - 2 : r - 6);
                rwkv_scan_task(rw, smem, bh, seg, grp);
            }
            unsigned* lflags = (unsigned*)(P.ws + WS_FLAGS) + l * 32;
            if (nblk >= 512) {
                if (bid >= 240) {
                    lin_scan_phase(lp, bid - 240, nblk - 240, lflags);
                    for (int task = bid - 240; task < 2048; task += nblk - 240) lin_out_dispatch(lp, smem, task, lflags);
                }
            } else {
                lin_scan_phase(lp, bid, nblk, lflags);
                for (int task = bid; task < 2048; task += nblk) lin_out_dispatch(lp, smem, task, lflags);
            }
            if (l == 0) {
                ConvP c{P.in[4], P.in[5], P.in[20], P.in[21], P.in[22], P.in[23], P.in[7], P.in[9], P.in[11], P.ws};
                if (nblk >= 512) { if (bid >= 240) phase_convert_uv(c, bid - 240, nblk - 240); } else phase_convert_uv(c, bid, nblk);
            }
        }
        GSYNC();
        phase_rwkv_chain(rw, bid, nblk);
        GSYNC();
        phase_rwkv_post(rw, bid, nblk);
        GSYNC();
        {
            GemmP g{(const bf16_t*)(P.ws + WS_O), D, 0, 0, (const bf16_t*)(P.ws + WS_WTOUT) + (size_t)l * D * D, D, D, NT / 128, D / 128, P.out, D, xin};
            phase_gemm<2>(g, smem, bid, nblk);
        }
        GSYNC();
        phase_rmsnorm<false>(P.out, P.in[2] + l * D, P.ws + WS_H, bid, nblk);
        GSYNC();
        {
            GemmP g{(const bf16_t*)(P.ws + WS_H), D, 0, 0, (const bf16_t*)(P.ws + WS_WEFF) + (size_t)l * 2048 * D, D, D, NT / 128, 2048 / 128, P.ws + WS_MIX, NT, nullptr};
            phase_gemm<3>(g, smem, bid, nblk);
        }
        GSYNC();
        phase_topk((const float*)(P.ws + WS_MIX), (int*)(P.ws + WS_EIDX), (float*)(P.ws + WS_GATE), smem, bid, nblk);
        GSYNC();
        if (l == 0) phase_expert<0>((const bf16_t*)(P.ws + WS_H), P.ws + WS_UB + (size_t)l * NEXP * 512, P.ws + WS_VB + (size_t)l * NEXP * 512,
                     (const float*)(P.ws + WS_ESC) + l * NEXP, (const float*)(P.ws + WS_ESC) + (2 + l) * NEXP,
                     (const int*)(P.ws + WS_EIDX), (const float*)(P.ws + WS_GATE), P.out, P.out, P.in[1] + D, (bf16_t*)(P.ws + WS_H), bid, nblk);
        else phase_expert<1>((const bf16_t*)(P.ws + WS_H), P.ws + WS_UB + (size_t)l * NEXP * 512, P.ws + WS_VB + (size_t)l * NEXP * 512,
                     (const float*)(P.ws + WS_ESC) + l * NEXP, (const float*)(P.ws + WS_ESC) + (2 + l) * NEXP,
                     (const int*)(P.ws + WS_EIDX), (const float*)(P.ws + WS_GATE), P.out, P.out, P.in[3], nullptr, bid, nblk);
        if (l == 0) GSYNC();
    }
}

extern "C" void kernel_launch(void* const* d_in, const int* in_sizes, int n_in, void* d_out, int out_size, void* d_ws, size_t ws_size, hipStream_t stream) {
    static int grid = 0;
    if (grid == 0) {
        if (n_in != 24 || ws_size < WS_END) { fprintf(stderr, "kernel_launch: bad args n_in=%d ws=%zu need=%zu\n", n_in, ws_size, (size_t)WS_END); grid = -1; return; }
        int dev = 0, cus = 0, per_cu = 0;
        hipGetDevice(&dev);
        hipDeviceGetAttribute(&cus, hipDeviceAttributeMultiprocessorCount, dev);
        hipFuncSetAttribute((const void*)mega_fwd, hipFuncAttributeMaxDynamicSharedMemorySize, LDS_BYTES);
        hipOccupancyMaxActiveBlocksPerMultiprocessor(&per_cu, (const void*)mega_fwd, NTHREADS, LDS_BYTES);
        if (per_cu < 1) { fprintf(stderr, "kernel_launch: occupancy query says %d\n", per_cu); grid = -1; return; }
        if (per_cu > 2) per_cu = 2;
        grid = cus * per_cu;
        fprintf(stderr, "kernel_launch: grid %d (%d CUs x %d)\n", grid, cus, per_cu);
    }
    if (grid < 0) return;
    hipMemsetAsync((char*)d_ws + WS_CTL, 0, 32768, stream);
    Params P{};
    for (int i = 0; i < 24; ++i) P.in[i] = (const float*)d_in[i];
    P.out = (float*)d_out; P.ws = (unsigned char*)d_ws;
    void* args[] = {&P};
    hipError_t e = hipLaunchCooperativeKernel((const void*)mega_fwd, dim3(grid), dim3(NTHREADS), args, LDS_BYTES, stream);
    if (e != hipSuccess) fprintf(stderr, "cooperative launch failed: %s (grid %d)\n", hipGetErrorString(e), grid);
}
```

```cpp
#include <hip/hip_runtime.h>
#include <stdint.h>
#include <stdio.h>

typedef unsigned short bf16_t;
typedef short bf16x8 __attribute__((ext_vector_type(8)));
typedef float f32x4 __attribute__((ext_vector_type(4)));
typedef unsigned u32x4 __attribute__((ext_vector_type(4)));
typedef unsigned u32x2 __attribute__((ext_vector_type(2)));

constexpr int NB = 4, NS = 4096, NT = NB * NS, D = 1024, DIN = 3600, DINP = 3712;
constexpr int ZC_RET = 0, ZC_RW = 1024, ZC_GLA = 2432;
constexpr int RW_F = 1408;
constexpr int NEXP = 16384;
constexpr int NTHREADS = 256;

constexpr size_t MiB = 1024ull * 1024ull;
constexpr size_t WS_CTL   = 0;
constexpr size_t WS_LORA  = 65536;
constexpr size_t LORA_L   = 384ull * 256 * 2;
constexpr size_t WS_ESC   = 524288;
constexpr size_t WS_WTIN  = 1 * MiB;
constexpr size_t WS_WTOUT = WS_WTIN + 2ull * DINP * D * 2;
constexpr size_t WS_WTQ   = WS_WTOUT + 2ull * D * D * 2;
constexpr size_t WS_SK    = WS_WTQ + 2ull * 2048 * D * 2;
constexpr size_t WS_UB    = WS_SK + 2ull * 16 * 128 * 128 * 2;
constexpr size_t WS_VB    = WS_UB + 2ull * NEXP * D;
constexpr size_t WS_LIN   = WS_VB + 2ull * NEXP * D;
constexpr size_t WS_H     = WS_LIN + 64 * MiB;
constexpr size_t WS_Z     = WS_H + (size_t)NT * D * 2;
constexpr size_t WS_O     = WS_Z + (size_t)NT * DINP * 2;
constexpr size_t WS_MIX   = WS_O + (size_t)NT * D * 2;
constexpr size_t WS_EIDX  = WS_MIX + 128 * MiB;
constexpr size_t WS_GATE  = WS_EIDX + (size_t)NT * 128 * 4;
constexpr size_t WS_ROPE  = WS_GATE + (size_t)NT * 128 * 4;
constexpr size_t WS_WEFF  = WS_ROPE + 1 * MiB;
constexpr size_t WS_END   = WS_WEFF + 2ull * 2048 * D * 2;
constexpr size_t RWA = (size_t)NT * 384;
constexpr size_t MX_W   = 0;
constexpr size_t MX_KK  = MX_W + RWA * 4;
constexpr size_t MX_KKA = MX_KK + RWA * 4;
constexpr size_t MX_R   = MX_KKA + RWA * 4;
constexpr size_t MX_K   = MX_R + RWA * 2;
constexpr size_t MX_V   = MX_K + RWA * 2;
constexpr size_t MX_G   = MX_V + RWA * 2;
constexpr size_t MX_END = MX_G + RWA * 2;
static_assert(MX_END <= 128 * MiB, "mix region");

__device__ __forceinline__ float bf2f(bf16_t v) { return __uint_as_float(((unsigned)v) << 16); }
__device__ __forceinline__ bf16_t f2bf(float f) { unsigned u = __float_as_uint(f); u += 0x7FFFu + ((u >> 16) & 1u); return (bf16_t)(u >> 16); }
__device__ __forceinline__ unsigned pk2(float lo, float hi) { return (unsigned)f2bf(lo) | ((unsigned)f2bf(hi) << 16); }
__device__ __forceinline__ float lo_bf(unsigned u) { return __uint_as_float(u << 16); }
__device__ __forceinline__ float hi_bf(unsigned u) { return __uint_as_float(u & 0xFFFF0000u); }
template <int CTRL> __device__ __forceinline__ float dpp_f(float v) { return __int_as_float(__builtin_amdgcn_update_dpp(0, __float_as_int(v), CTRL, 0xF, 0xF, true)); }
template <int CTRL> __device__ __forceinline__ unsigned dpp_u(unsigned v) { return (unsigned)__builtin_amdgcn_update_dpp(0, (int)v, CTRL, 0xF, 0xF, true); }
__device__ __forceinline__ float row16_sum(float v) { v += dpp_f<0x128>(v); v += dpp_f<0x124>(v); v += dpp_f<0x122>(v); v += dpp_f<0x121>(v); return v; }
__device__ __forceinline__ float xor16_sum(float v) { auto r = __builtin_amdgcn_permlane16_swap(__float_as_uint(v), __float_as_uint(v), false, false); return __uint_as_float(r[0]) + __uint_as_float(r[1]); }
__device__ __forceinline__ float xor32_sum(float v) { auto r = __builtin_amdgcn_permlane32_swap(__float_as_uint(v), __float_as_uint(v), false, false); return __uint_as_float(r[0]) + __uint_as_float(r[1]); }
__device__ __forceinline__ float wave_sum(float v) { return xor32_sum(xor16_sum(row16_sum(v))); }
__device__ __forceinline__ unsigned umax_(unsigned a, unsigned b) { return a > b ? a : b; }
__device__ __forceinline__ unsigned wave_max_u32(unsigned v) {
    v = umax_(v, dpp_u<0x128>(v)); v = umax_(v, dpp_u<0x124>(v)); v = umax_(v, dpp_u<0x122>(v)); v = umax_(v, dpp_u<0x121>(v));
    { auto r = __builtin_amdgcn_permlane16_swap(v, v, false, false); v = umax_(r[0], r[1]); }
    { auto r = __builtin_amdgcn_permlane32_swap(v, v, false, false); v = umax_(r[0], r[1]); }
    return v;
}
__device__ __forceinline__ float sigmoidf_(float x) { return 1.f / (1.f + __expf(-x)); }
__device__ __forceinline__ float softplusf_(float x) { return fmaxf(x, 0.f) + __logf(1.f + __expf(-fabsf(x))); }
__device__ __forceinline__ float tanhf_(float x) { const float e = __expf(2.f * fminf(fmaxf(x, -15.f), 15.f)); return (e - 1.f) / (e + 1.f); }

__device__ __forceinline__ int otid() { int t = threadIdx.x; asm volatile("" : "+v"(t)); return t; }

constexpr size_t WS_FLAGS = 16384;
__device__ __forceinline__ void flag_signal(unsigned* f) {
    asm volatile("s_waitcnt vmcnt(0)" ::: "memory");
    __syncthreads();
    if (threadIdx.x == 0) {
        __builtin_amdgcn_fence(__ATOMIC_RELEASE, "agent");
        asm volatile("s_waitcnt vmcnt(0)" ::: "memory");
        __hip_atomic_fetch_add(f, 1u, __ATOMIC_RELAXED, __HIP_MEMORY_SCOPE_AGENT);
    }
}
__device__ __forceinline__ void flag_wait(unsigned* f, unsigned need) {
    if (threadIdx.x == 0) {
        unsigned sp = 0;
        while (__hip_atomic_load(f, __ATOMIC_RELAXED, __HIP_MEMORY_SCOPE_AGENT) < need) { __builtin_amdgcn_s_sleep(4); if (++sp > (1u << 22)) break; }
        __builtin_amdgcn_fence(__ATOMIC_ACQUIRE, "agent");
        asm volatile("s_waitcnt vmcnt(0)" ::: "memory");
    }
    __syncthreads();
}

__device__ void transpose_tile(const float* __restrict__ W, int K, int N, bf16_t* __restrict__ Wt, int kt, int nt, float* tile  ) {
    const int tid = otid();
    const int k0 = kt * 64, n0 = nt * 64;
#pragma unroll
    for (int i = 0; i < 16; ++i) {
        const int k = i * 4 + (tid >> 6), n = tid & 63;
        tile[k * 65 + n] = (n0 + n < N) ? W[(size_t)(k0 + k) * N + n0 + n] : 0.f;
    }
    __syncthreads();
#pragma unroll
    for (int i = 0; i < 16; ++i) {
        const int n = i * 4 + (tid >> 6), k = tid & 63;
        Wt[(size_t)(n0 + n) * K + k0 + k] = f2bf(tile[k * 65 + n]);
    }
    __syncthreads();
}

struct ConvP {
    const float* w_in; const float* w_out; const float* w_q; const float* sk; const float* u; const float* v;
    const float* w_up; const float* a_up; const float* g_up;
    unsigned char* ws;
};

__device__ void phase_convert_weights(const ConvP& p, char* smem, int bid, int nblk) {
    float* tile = (float*)smem;
    constexpr int T_IN = 16 * 58, T_OUT = 16 * 16, T_L = T_IN + T_OUT;
    for (int it = bid; it < 2 * T_L; it += nblk) {
        const int l = it / T_L; int r = it % T_L;
        if (r < T_IN) { transpose_tile(p.w_in + (size_t)l * D * DIN, D, DIN, (bf16_t*)(p.ws + WS_WTIN) + (size_t)l * DINP * D, r / 58, r % 58, tile); continue; }
        r -= T_IN;
        transpose_tile(p.w_out + (size_t)l * D * D, D, D, (bf16_t*)(p.ws + WS_WTOUT) + (size_t)l * D * D, r / 16, r % 16, tile);
    }
    const size_t gtid = (size_t)bid * NTHREADS + otid(), gn = (size_t)nblk * NTHREADS;
    {
        for (size_t i = gtid; i < 2ull * 384 * 256; i += gn) {
            const int l = (int)(i / (384 * 256)), r = (int)(i % (384 * 256)), c = r >> 8, k = r & 255;
            bf16_t* base = (bf16_t*)(p.ws + WS_LORA + l * LORA_L);
            if (k < 64) base[c * 64 + k] = f2bf(p.w_up[(size_t)l * 64 * 384 + k * 384 + c]);
            else if (k < 128) base[384 * 64 + c * 64 + (k - 64)] = f2bf(p.a_up[(size_t)l * 64 * 384 + (k - 64) * 384 + c]);
            else base[2 * 384 * 64 + c * 128 + (k - 128)] = f2bf(p.g_up[(size_t)l * 128 * 384 + (k - 128) * 384 + c]);
        }
    }
    {
        float* ct = (float*)(p.ws + WS_ROPE); float* stb = ct + NS * 32;
        for (size_t i = gtid; i < (size_t)NS * 32; i += gn) {
            const int pos = (int)(i >> 5), fi = (int)(i & 31);
            const float inv = exp2f(-(float)fi * (13.287712379549449f / 32.f));
            float sn, cs; sincosf((float)pos * inv, &sn, &cs);
            ct[i] = cs; stb[i] = sn;
        }
    }
    {
        const size_t n8 = (2ull * D * 2048) / 8;
        const f32x4* s = (const f32x4*)p.w_q; u32x4* d = (u32x4*)(p.ws + WS_WTQ);
        for (size_t i = gtid; i < n8; i += gn) { f32x4 a = s[2 * i], b = s[2 * i + 1]; u32x4 o; o.x = pk2(a.x, a.y); o.y = pk2(a.z, a.w); o.z = pk2(b.x, b.y); o.w = pk2(b.z, b.w); d[i] = o; }
    }
    {
        const size_t n8 = (2ull * 16 * 128 * 128) / 8;
        const f32x4* s = (const f32x4*)p.sk; u32x4* d = (u32x4*)(p.ws + WS_SK);
        for (size_t i = gtid; i < n8; i += gn) { f32x4 a = s[2 * i], b = s[2 * i + 1]; u32x4 o; o.x = pk2(a.x, a.y); o.y = pk2(a.z, a.w); o.z = pk2(b.x, b.y); o.w = pk2(b.z, b.w); d[i] = o; }
    }
}

__device__ void phase_convert_uv(const ConvP& p, int bid, int nblk) {
    {
        const int lane = otid() & 63, gw = bid * 4 + (otid() >> 6), ngw = nblk * 4;
        for (int r = gw; r < 4 * NEXP; r += ngw) {
            const bool isv = r >= 2 * NEXP; const int rr = isv ? r - 2 * NEXP : r;
            const f32x4* src = (const f32x4*)((isv ? p.v : p.u) + (size_t)rr * D) + lane * 4;
            f32x4 x[4]; float mx = 0.f;
#pragma unroll
            for (int i = 0; i < 4; ++i) { x[i] = src[i]; mx = fmaxf(mx, fmaxf(fmaxf(fabsf(x[i].x), fabsf(x[i].y)), fmaxf(fabsf(x[i].z), fabsf(x[i].w)))); }
            mx = __uint_as_float(wave_max_u32(__float_as_uint(mx)));
            const float sc = mx > 0.f ? 6.f / mx : 0.f;
            unsigned w0 = 0u, w1 = 0u;
            w0 = __builtin_amdgcn_cvt_scalef32_pk_fp4_f32(w0, x[0].x * sc, x[0].y * sc, 1.0f, 0); w0 = __builtin_amdgcn_cvt_scalef32_pk_fp4_f32(w0, x[0].z * sc, x[0].w * sc, 1.0f, 1);
            w0 = __builtin_amdgcn_cvt_scalef32_pk_fp4_f32(w0, x[1].x * sc, x[1].y * sc, 1.0f, 2); w0 = __builtin_amdgcn_cvt_scalef32_pk_fp4_f32(w0, x[1].z * sc, x[1].w * sc, 1.0f, 3);
            w1 = __builtin_amdgcn_cvt_scalef32_pk_fp4_f32(w1, x[2].x * sc, x[2].y * sc, 1.0f, 0); w1 = __builtin_amdgcn_cvt_scalef32_pk_fp4_f32(w1, x[2].z * sc, x[2].w * sc, 1.0f, 1);
            w1 = __builtin_amdgcn_cvt_scalef32_pk_fp4_f32(w1, x[3].x * sc, x[3].y * sc, 1.0f, 2); w1 = __builtin_amdgcn_cvt_scalef32_pk_fp4_f32(w1, x[3].z * sc, x[3].w * sc, 1.0f, 3);
            *(u32x2*)(p.ws + (isv ? WS_VB : WS_UB) + (size_t)rr * 512 + lane * 8) = (u32x2){w0, w1};
            if (lane == 0) ((float*)(p.ws + WS_ESC))[r] = mx * (1.f / 6.f);
        }
    }
}

template <bool OUT_F32>
__device__ void phase_rmsnorm(const float* x, const float* __restrict__ g, void* out, int bid, int nblk) {
    const int lane = otid() & 63, wave = otid() >> 6;
    const int gw = bid * 4 + wave, ngw = nblk * 4;
    f32x4 gv[4];
#pragma unroll
    for (int j = 0; j < 4; ++j) gv[j] = ((const f32x4*)g)[lane + 64 * j];
    for (int row = gw; row < NT; row += ngw) {
        const f32x4* xr = (const f32x4*)(x + (size_t)row * D) + lane;
        f32x4 v[4]; float s = 0.f;
#pragma unroll
        for (int j = 0; j < 4; ++j) { v[j] = xr[64 * j]; s += v[j].x * v[j].x + v[j].y * v[j].y + v[j].z * v[j].z + v[j].w * v[j].w; }
        s = wave_sum(s);
        const float rs = rsqrtf(s * (1.f / D) + 1e-6f);
        if (OUT_F32) {
            f32x4* o = (f32x4*)((float*)out + (size_t)row * D) + lane;
#pragma unroll
            for (int j = 0; j < 4; ++j) o[64 * j] = v[j] * rs * gv[j];
        } else {
            u32x2* o = (u32x2*)((bf16_t*)out + (size_t)row * D) + lane;
#pragma unroll
            for (int j = 0; j < 4; ++j) { f32x4 y = v[j] * rs * gv[j]; u32x2 w; w.x = pk2(y.x, y.y); w.y = pk2(y.z, y.w); o[64 * j] = w; }
        }
    }
}

struct GemmP {
    const bf16_t* A; int lda; int a_koff;
    int b_koff;
    const bf16_t* Bt; int ldb; int K;
    int MT, NTl;
    void* C; int ldc; const float* R;
};
constexpr int GS = 72;
template <int MODE>
__device__ void phase_gemm(const GemmP& p, char* smem, int bid, int nblk, int tile0 = 0) {
    bf16_t* As = (bf16_t*)smem;
    bf16_t* Bs = As + 128 * GS;
    const int tid = otid(), lane = tid & 63, wave = tid >> 6;
    const int wr = wave >> 1, wc = wave & 1;
    const int lr = tid >> 3, lc = (tid & 7) * 8;
    const int fl = lane & 15, fq = lane >> 4;
    const int ntiles = p.MT * p.NTl;
    for (int tile = bid - tile0 + ((bid < tile0) ? nblk * ((tile0 - bid + nblk - 1) / nblk) : 0); tile < ntiles; tile += nblk) {
        const int mt = tile / p.NTl, nt = tile % p.NTl;
        const bf16_t* Ag = p.A + (size_t)mt * 128 * p.lda + (size_t)nt * p.a_koff + (size_t)lr * p.lda + lc;
        const bf16_t* Bg = p.Bt + (size_t)nt * 128 * p.ldb + (size_t)mt * p.b_koff + (size_t)lr * p.ldb + lc;
        f32x4 acc[4][4];
#pragma unroll
        for (int m = 0; m < 4; ++m)
#pragma unroll
            for (int n = 0; n < 4; ++n) acc[m][n] = (f32x4){0.f, 0.f, 0.f, 0.f};
        u32x4 ra[4], rb[4];
        const int nk = p.K >> 6;
#pragma unroll
        for (int i = 0; i < 4; ++i) { ra[i] = *(const u32x4*)(Ag + (size_t)(32 * i) * p.lda); rb[i] = *(const u32x4*)(Bg + (size_t)(32 * i) * p.ldb); }
        __syncthreads();
#pragma unroll
        for (int i = 0; i < 4; ++i) { *(u32x4*)(As + (lr + 32 * i) * GS + lc) = ra[i]; *(u32x4*)(Bs + (lr + 32 * i) * GS + lc) = rb[i]; }
        if (nk > 1) {
#pragma unroll
            for (int i = 0; i < 4; ++i) { ra[i] = *(const u32x4*)(Ag + (size_t)(32 * i) * p.lda + 64); rb[i] = *(const u32x4*)(Bg + (size_t)(32 * i) * p.ldb + 64); }
        }
        __syncthreads();
        for (int kt = 0; kt < nk; ++kt) {
            const bf16_t* Ac = As + (kt & 1) * (256 * GS); const bf16_t* Bc = Ac + 128 * GS;
            bf16_t* An = As + ((kt & 1) ^ 1) * (256 * GS); bf16_t* Bn = An + 128 * GS;
            if (kt + 1 < nk) {
#pragma unroll
                for (int i = 0; i < 4; ++i) { *(u32x4*)(An + (lr + 32 * i) * GS + lc) = ra[i]; *(u32x4*)(Bn + (lr + 32 * i) * GS + lc) = rb[i]; }
                if (kt + 2 < nk) {
#pragma unroll
                    for (int i = 0; i < 4; ++i) { ra[i] = *(const u32x4*)(Ag + (size_t)(32 * i) * p.lda + (kt + 2) * 64); rb[i] = *(const u32x4*)(Bg + (size_t)(32 * i) * p.ldb + (kt + 2) * 64); }
                }
            }
#pragma unroll
            for (int ks = 0; ks < 2; ++ks) {
                bf16x8 xa[4], wb[4];
#pragma unroll
                for (int m = 0; m < 4; ++m) xa[m] = *(const bf16x8*)(Ac + (wr * 64 + m * 16 + fl) * GS + ks * 32 + fq * 8);
#pragma unroll
                for (int n = 0; n < 4; ++n) wb[n] = *(const bf16x8*)(Bc + (wc * 64 + n * 16 + fl) * GS + ks * 32 + fq * 8);
#pragma unroll
                for (int m = 0; m < 4; ++m)
#pragma unroll
                    for (int n = 0; n < 4; ++n) acc[m][n] = (MODE == 3) ? __builtin_amdgcn_mfma_f32_16x16x32_bf16(xa[m], wb[n], acc[m][n], 0, 0, 0)
                                                                     : __builtin_amdgcn_mfma_f32_16x16x32_bf16(wb[n], xa[m], acc[m][n], 0, 0, 0);
            }
            __syncthreads();
        }
#pragma unroll
        for (int m = 0; m < 4; ++m) {
#pragma unroll
            for (int n = 0; n < 4; ++n) {
                const f32x4 a = acc[m][n];
                if (MODE == 3) {
                    const size_t row = (size_t)mt * 128 + wr * 64 + m * 16 + fq * 4;
                    const size_t col = (size_t)nt * 128 + wc * 64 + n * 16 + fl;
                    *(f32x4*)((float*)p.C + col * p.ldc + row) = a;
                } else {
                    const size_t row = (size_t)mt * 128 + wr * 64 + m * 16 + fl;
                    const int col = nt * 128 + wc * 64 + n * 16 + fq * 4;
                    if (MODE == 0) { u32x2 w; w.x = pk2(a.x, a.y); w.y = pk2(a.z, a.w); *(u32x2*)((bf16_t*)p.C + row * p.ldc + col) = w; }
                    else if (MODE == 1) { *(f32x4*)((float*)p.C + row * p.ldc + col) = a; }
                    else { const f32x4 r = *(const f32x4*)(p.R + row * p.ldc + col); *(f32x4*)((float*)p.C + row * p.ldc + col) = r + a; }
                }
            }
        }
    }
}

constexpr int LS = 72;
struct LinP {
    const bf16_t* Z; bf16_t* O;
    const float* gk_up;
    const float* gk_bias;
    const float* norm_w;
    const float* rope;
    unsigned char* lin;
};
__device__ __forceinline__ bf16x8 ldfrag(const bf16_t* base, int row, int kofs) { return *(const bf16x8*)(base + row * LS + kofs); }

constexpr size_t LN_KV_RET = 0;
constexpr size_t LN_KV_GLA = LN_KV_RET + 1024ull * 64 * 64 * 4;
constexpr size_t LN_S_RET  = LN_KV_GLA + 1024ull * 96 * 64 * 4;
constexpr size_t LN_S_GLA  = LN_S_RET + 1024ull * 64 * 64 * 2;
constexpr size_t LN_DEC    = LN_S_GLA + 1024ull * 96 * 64 * 2;
static_assert(LN_DEC + 2048ull * 64 * 4 <= 64 * MiB, "lin region");

__device__ __forceinline__ float wave_incl_scan(float v) {
    v += dpp_f<0x111>(v); v += dpp_f<0x112>(v); v += dpp_f<0x114>(v); v += dpp_f<0x118>(v);
    v += __int_as_float(__builtin_amdgcn_update_dpp(0, __float_as_int(v), 0x142, 0xA, 0xF, false));
    v += __int_as_float(__builtin_amdgcn_update_dpp(0, __float_as_int(v), 0x143, 0xC, 0xF, false));
    return v;
}
__device__ __forceinline__ float readlane_f(float v, int l) { return __int_as_float(__builtin_amdgcn_readlane(__float_as_int(v), l)); }

__device__ __forceinline__ void rot8(const bf16_t* src, const float* rope, int spos, int cq, unsigned (&o1)[4], unsigned (&o2)[4]) {
    const u32x4 q1 = *(const u32x4*)(src + cq * 8), q2 = *(const u32x4*)(src + 32 + cq * 8);
    const unsigned q1w[4] = {q1.x, q1.y, q1.z, q1.w}, q2w[4] = {q2.x, q2.y, q2.z, q2.w};
    const f32x4 c0 = *(const f32x4*)(rope + spos * 32 + cq * 8), c1 = *(const f32x4*)(rope + spos * 32 + cq * 8 + 4);
    const f32x4 s0 = *(const f32x4*)(rope + NS * 32 + spos * 32 + cq * 8), s1 = *(const f32x4*)(rope + NS * 32 + spos * 32 + cq * 8 + 4);
    const float csv[8] = {c0.x, c0.y, c0.z, c0.w, c1.x, c1.y, c1.z, c1.w}, snv[8] = {s0.x, s0.y, s0.z, s0.w, s1.x, s1.y, s1.z, s1.w};
#pragma unroll
    for (int e = 0; e < 4; ++e) {
        const float a1l = lo_bf(q1w[e]), a1h = hi_bf(q1w[e]), a2l = lo_bf(q2w[e]), a2h = hi_bf(q2w[e]);
        o1[e] = pk2(a1l * csv[2 * e] - a2l * snv[2 * e], a1h * csv[2 * e + 1] - a2h * snv[2 * e + 1]);
        o2[e] = pk2(a1l * snv[2 * e] + a2l * csv[2 * e], a1h * snv[2 * e + 1] + a2h * csv[2 * e + 1]);
    }
}
__device__ __forceinline__ void load_vts(const bf16_t* Z, size_t t0, int voff, int nch, bf16_t* Vts, int tid) {
    for (int x = tid; x < 64 * nch; x += NTHREADS) {
        const int tok = x / nch, ch = x % nch;
        const u32x4 vv = *(const u32x4*)(Z + (t0 + tok) * DINP + voff + ch * 8);
        const unsigned w[4] = {vv.x, vv.y, vv.z, vv.w};
#pragma unroll
        for (int e = 0; e < 4; ++e) { Vts[(ch * 8 + 2 * e) * LS + tok] = (bf16_t)(w[e] & 0xFFFFu); Vts[(ch * 8 + 2 * e + 1) * LS + tok] = (bf16_t)(w[e] >> 16); }
    }
}
__device__ __forceinline__ void load_gd(const bf16_t* zr, float (&gd)[16]) {
    const u32x4 g0 = *(const u32x4*)zr, g1 = *(const u32x4*)(zr + 8);
    gd[0] = lo_bf(g0.x); gd[1] = hi_bf(g0.x); gd[2] = lo_bf(g0.y); gd[3] = hi_bf(g0.y); gd[4] = lo_bf(g0.z); gd[5] = hi_bf(g0.z); gd[6] = lo_bf(g0.w); gd[7] = hi_bf(g0.w);
    gd[8] = lo_bf(g1.x); gd[9] = hi_bf(g1.x); gd[10] = lo_bf(g1.y); gd[11] = hi_bf(g1.y); gd[12] = lo_bf(g1.z); gd[13] = hi_bf(g1.z); gd[14] = lo_bf(g1.w); gd[15] = hi_bf(g1.w);
}
__device__ __forceinline__ float gla_gk(const LinP& p, const float (&gd)[16], int h, int d) {
    float x = p.gk_bias[h * 48 + d];
#pragma unroll
    for (int i = 0; i < 16; ++i) x += gd[i] * p.gk_up[i * 192 + h * 48 + d];
    return (fminf(x, 0.f) - __logf(1.f + __expf(-fabsf(x)))) * (1.f / 16.f);
}
__device__ __forceinline__ float ret_lg(int h) { const float e = exp2f(-5.f - (float)h * (4.f / 3.f)); return log1pf(-e); }

template <bool IS_GLA>
__device__ void lin_kv_task(const LinP& p, char* smem, int b, int h, int c) {
    constexpr int DV = IS_GLA ? 96 : 64, NVB = DV / 16;
    const int koff = IS_GLA ? (ZC_GLA + 192 + h * 48) : (ZC_RET + 256 + h * 64);
    const int voff = IS_GLA ? (ZC_GLA + 384 + h * 96) : (ZC_RET + 512 + h * 64);
    const int gkdoff = ZC_GLA + 768;
    bf16_t* Ks = (bf16_t*)smem;
    bf16_t* Kts = Ks + 64 * LS;
    bf16_t* Vts = Kts + 64 * LS;
    float* decs = (float*)(Vts + 96 * LS);
    const int tid = otid(), lane = tid & 63, wave = tid >> 6;
    const int fl = lane & 15, fq = lane >> 4;
    const size_t t0 = (size_t)b * NS + (size_t)c * 64;
    const int task = (b * 4 + h) * 64 + c;
    __syncthreads();
    if (IS_GLA) {
        for (int x = tid; x < 64 * 6; x += NTHREADS) {
            const int tok = x / 6, ch = x % 6;
            *(u32x4*)(Ks + tok * LS + ch * 8) = *(const u32x4*)(p.Z + (t0 + tok) * DINP + koff + ch * 8);
        }
        for (int x = tid; x < 16 * LS / 2; x += NTHREADS) ((unsigned*)(Kts + 48 * LS))[x] = 0u;
        if (tid < 16) decs[48 + tid] = 1.f;
        load_vts(p.Z, t0, voff, 12, Vts, tid);
    } else {
        const int tok = tid >> 2, cq = tid & 3;
        unsigned k1[4], k2[4];
        rot8(p.Z + (t0 + tok) * DINP + koff, p.rope, c * 64 + tok, cq, k1, k2);
        const float fk2 = 0.125f * __expf(ret_lg(h) * (float)(63 - tok));
#pragma unroll
        for (int e = 0; e < 4; ++e) {
            Kts[(cq * 8 + 2 * e) * LS + tok] = f2bf(lo_bf(k1[e]) * fk2); Kts[(cq * 8 + 2 * e + 1) * LS + tok] = f2bf(hi_bf(k1[e]) * fk2);
            Kts[(32 + cq * 8 + 2 * e) * LS + tok] = f2bf(lo_bf(k2[e]) * fk2); Kts[(32 + cq * 8 + 2 * e + 1) * LS + tok] = f2bf(hi_bf(k2[e]) * fk2);
        }
        if (tid < 64) decs[tid] = __expf(ret_lg(h) * 64.f);
        load_vts(p.Z, t0, voff, 8, Vts, tid);
    }
    __syncthreads();
    if (IS_GLA) {
        float gd[16];
        load_gd(p.Z + (t0 + lane) * DINP + gkdoff, gd);
#pragma unroll 1
        for (int dd = 0; dd < 12; ++dd) {
            const int d = wave * 12 + dd;
            const float bc = wave_incl_scan(gla_gk(p, gd, h, d));
            const float bl = readlane_f(bc, 63);
            Kts[d * LS + lane] = f2bf(bf2f(Ks[lane * LS + d]) * __expf(bl - bc));
            if (lane == 0) decs[d] = __expf(bl);
        }
        __syncthreads();
    }
    float* KV = (float*)(p.lin + (IS_GLA ? LN_KV_GLA : LN_KV_RET)) + (size_t)task * DV * 64;
#pragma unroll
    for (int vb = 0; vb < NVB; ++vb) {
        f32x4 a4 = (f32x4){0.f, 0.f, 0.f, 0.f};
#pragma unroll
        for (int ks = 0; ks < 2; ++ks) {
            const bf16x8 a = ldfrag(Kts, 16 * wave + fl, ks * 32 + fq * 8);
            const bf16x8 bv = ldfrag(Vts, 16 * vb + fl, ks * 32 + fq * 8);
            a4 = __builtin_amdgcn_mfma_f32_16x16x32_bf16(a, bv, a4, 0, 0, 0);
        }
        *(f32x4*)(KV + (size_t)(16 * vb + fl) * 64 + 16 * wave + 4 * fq) = a4;
    }
    if (tid < 64) ((float*)(p.lin + LN_DEC))[(size_t)((IS_GLA ? 1024 : 0) + task) * 64 + tid] = decs[tid];
}

__device__ void lin_scan_phase(const LinP& p, int vbid, int nvblk, unsigned* flags) {
    const int tid = otid();
    for (int it = vbid; it < 160; it += nvblk) {
        const bool gla = it >= 64;
        const int r = gla ? it - 64 : it;
        const int per = gla ? 6 : 4, DVx = gla ? 96 : 64;
        const int bh = r / per, e = (r % per) * 1024 + tid;
        const float* KV = (const float*)(p.lin + (gla ? LN_KV_GLA : LN_KV_RET)) + (size_t)bh * 64 * DVx * 64 + e;
        bf16_t* Sb = (bf16_t*)(p.lin + (gla ? LN_S_GLA : LN_S_RET)) + (size_t)bh * 64 * DVx * 64 + e;
        const float* DEC = (const float*)(p.lin + LN_DEC) + (size_t)((gla ? 1024 : 0) + bh * 64) * 64 + (e & 63);
        float S0 = 0.f, S1 = 0.f, S2 = 0.f, S3 = 0.f;
#pragma unroll 8
        for (int c = 0; c < 64; ++c) {
            const size_t o = (size_t)c * DVx * 64;
            const float k0 = KV[o], k1 = KV[o + 256], k2 = KV[o + 512], k3 = KV[o + 768], dc = DEC[c * 64];
            Sb[o] = f2bf(S0); Sb[o + 256] = f2bf(S1); Sb[o + 512] = f2bf(S2); Sb[o + 768] = f2bf(S3);
            S0 = S0 * dc + k0; S1 = S1 * dc + k1; S2 = S2 * dc + k2; S3 = S3 * dc + k3;
        }
        flag_signal(flags + (gla ? 16 : 0) + bh);
    }
}

template <bool IS_GLA>
__device__ void lin_out_task(const LinP& p, char* smem, int b, int h, int c) {
    constexpr int DV = IS_GLA ? 96 : 64, NVB = DV / 16;
    const int qoff = IS_GLA ? (ZC_GLA + 0 + h * 48) : (ZC_RET + 0 + h * 64);
    const int koff = IS_GLA ? (ZC_GLA + 192 + h * 48) : (ZC_RET + 256 + h * 64);
    const int voff = IS_GLA ? (ZC_GLA + 384 + h * 96) : (ZC_RET + 512 + h * 64);
    const int goff = IS_GLA ? (ZC_GLA + 784 + h * 96) : (ZC_RET + 768 + h * 64);
    const int gkdoff = ZC_GLA + 768;
    const int ooff = IS_GLA ? (640 + h * 96) : (h * 64);
    bf16_t* Qs = (bf16_t*)smem;
    bf16_t* Ks = Qs + 64 * LS;
    bf16_t* Ps = Ks + 64 * LS;
    bf16_t* Vts = Ps + 64 * LS;
    bf16_t* Sts = Vts + 96 * LS;
    const int tid = otid(), lane = tid & 63, wave = tid >> 6;
    const int fl = lane & 15, fq = lane >> 4;
    const size_t t0 = (size_t)b * NS + (size_t)c * 64;
    const int task = (b * 4 + h) * 64 + c;
    __syncthreads();
    {
        const bf16_t* Sb = (const bf16_t*)(p.lin + (IS_GLA ? LN_S_GLA : LN_S_RET)) + (size_t)task * DV * 64;
        for (int x = tid; x < DV * 8; x += NTHREADS) { const int v = x >> 3, ch = x & 7; *(u32x4*)(Sts + v * LS + ch * 8) = *(const u32x4*)(Sb + v * 64 + ch * 8); }
    }
    if (IS_GLA) {
        for (int x = tid; x < 64 * 6; x += NTHREADS) {
            const int tok = x / 6, ch = x % 6;
            const bf16_t* zr = p.Z + (t0 + tok) * DINP;
            *(u32x4*)(Qs + tok * LS + ch * 8) = *(const u32x4*)(zr + qoff + ch * 8);
            *(u32x4*)(Ks + tok * LS + ch * 8) = *(const u32x4*)(zr + koff + ch * 8);
        }
        for (int x = tid; x < 64 * 2; x += NTHREADS) {
            const int tok = x >> 1, ch = 6 + (x & 1);
            *(u32x4*)(Qs + tok * LS + ch * 8) = (u32x4){0u, 0u, 0u, 0u};
            *(u32x4*)(Ks + tok * LS + ch * 8) = (u32x4){0u, 0u, 0u, 0u};
        }
        load_vts(p.Z, t0, voff, 12, Vts, tid);
    } else {
        const int tok = tid >> 2, cq = tid & 3;
        const bf16_t* zr = p.Z + (t0 + tok) * DINP;
        unsigned q1[4], q2[4], k1[4], k2[4];
        rot8(zr + qoff, p.rope, c * 64 + tok, cq, q1, q2);
        rot8(zr + koff, p.rope, c * 64 + tok, cq, k1, k2);
        const float lg = ret_lg(h);
        const float fqd = __expf(lg * (float)(tok + 1)), fk = 0.125f * __expf(-lg * (float)(tok + 1));
#pragma unroll
        for (int e = 0; e < 4; ++e) {
            q1[e] = pk2(lo_bf(q1[e]) * fqd, hi_bf(q1[e]) * fqd); q2[e] = pk2(lo_bf(q2[e]) * fqd, hi_bf(q2[e]) * fqd);
            k1[e] = pk2(lo_bf(k1[e]) * fk, hi_bf(k1[e]) * fk); k2[e] = pk2(lo_bf(k2[e]) * fk, hi_bf(k2[e]) * fk);
        }
        *(u32x4*)(Qs + tok * LS + cq * 8) = (u32x4){q1[0], q1[1], q1[2], q1[3]};
        *(u32x4*)(Qs + tok * LS + 32 + cq * 8) = (u32x4){q2[0], q2[1], q2[2], q2[3]};
        *(u32x4*)(Ks + tok * LS + cq * 8) = (u32x4){k1[0], k1[1], k1[2], k1[3]};
        *(u32x4*)(Ks + tok * LS + 32 + cq * 8) = (u32x4){k2[0], k2[1], k2[2], k2[3]};
        load_vts(p.Z, t0, voff, 8, Vts, tid);
    }
    __syncthreads();
    if (IS_GLA) {
        float gd[16];
        load_gd(p.Z + (t0 + lane) * DINP + gkdoff, gd);
#pragma unroll 1
        for (int dd = 0; dd < 12; ++dd) {
            const int d = wave * 12 + dd;
            const float bc = wave_incl_scan(gla_gk(p, gd, h, d));
            const float eq = __expf(bc) * 0.14433756729740643f  , ek = __expf(-bc);
            Qs[lane * LS + d] = f2bf(bf2f(Qs[lane * LS + d]) * eq);
            Ks[lane * LS + d] = f2bf(bf2f(Ks[lane * LS + d]) * ek);
        }
        __syncthreads();
    }
#pragma unroll
    for (int jb = 0; jb < 4; ++jb) {
        f32x4 ap = (f32x4){0.f, 0.f, 0.f, 0.f};
#pragma unroll
        for (int ks = 0; ks < 2; ++ks) {
            const bf16x8 a = ldfrag(Ks, 16 * jb + fl, ks * 32 + fq * 8);
            const bf16x8 bq = ldfrag(Qs, 16 * wave + fl, ks * 32 + fq * 8);
            ap = __builtin_amdgcn_mfma_f32_16x16x32_bf16(a, bq, ap, 0, 0, 0);
        }
        const int i = 16 * wave + fl, j0 = 16 * jb + 4 * fq;
        u32x2 w;
        w.x = pk2(j0 + 0 <= i ? ap.x : 0.f, j0 + 1 <= i ? ap.y : 0.f);
        w.y = pk2(j0 + 2 <= i ? ap.z : 0.f, j0 + 3 <= i ? ap.w : 0.f);
        *(u32x2*)(Ps + i * LS + j0) = w;
    }
    __syncthreads();
    {
        f32x4 ao[NVB];
        float ss = 0.f;
#pragma unroll
        for (int vb = 0; vb < NVB; ++vb) {
            f32x4 a4 = (f32x4){0.f, 0.f, 0.f, 0.f};
#pragma unroll
            for (int ks = 0; ks < 2; ++ks) {
                const bf16x8 a = ldfrag(Vts, 16 * vb + fl, ks * 32 + fq * 8);
                const bf16x8 bp = ldfrag(Ps, 16 * wave + fl, ks * 32 + fq * 8);
                a4 = __builtin_amdgcn_mfma_f32_16x16x32_bf16(a, bp, a4, 0, 0, 0);
            }
#pragma unroll
            for (int ks = 0; ks < 2; ++ks) {
                const bf16x8 a = ldfrag(Sts, 16 * vb + fl, ks * 32 + fq * 8);
                const bf16x8 bq = ldfrag(Qs, 16 * wave + fl, ks * 32 + fq * 8);
                a4 = __builtin_amdgcn_mfma_f32_16x16x32_bf16(a, bq, a4, 0, 0, 0);
            }
            ao[vb] = a4;
            ss += a4.x * a4.x + a4.y * a4.y + a4.z * a4.z + a4.w * a4.w;
        }
        ss = xor32_sum(xor16_sum(ss));
        const float inv = rsqrtf(ss * (1.f / DV) + 1e-5f);
        const size_t t = t0 + 16 * wave + fl;
#pragma unroll
        for (int vb = 0; vb < NVB; ++vb) {
            const int v0 = 16 * vb + 4 * fq;
            const u32x2 gg = *(const u32x2*)(p.Z + t * DINP + goff + v0);
            float g4[4] = {lo_bf(gg.x), hi_bf(gg.x), lo_bf(gg.y), hi_bf(gg.y)};
            float o4[4] = {ao[vb].x, ao[vb].y, ao[vb].z, ao[vb].w};
#pragma unroll
            for (int e = 0; e < 4; ++e) {
                float y = o4[e] * inv;
                if (IS_GLA) y *= p.norm_w[h * 96 + v0 + e];
                const float g = g4[e];
                o4[e] = y * (g / (1.f + __expf(-g)));
            }
            u32x2 w; w.x = pk2(o4[0], o4[1]); w.y = pk2(o4[2], o4[3]);
            *(u32x2*)(p.O + t * D + ooff + v0) = w;
        }
    }
}
__device__ __forceinline__ void lin_kv_dispatch(const LinP& p, char* smem, int task) {
    const int r = task & 1023, bh = r >> 6, c = r & 63;
    if (task < 1024) lin_kv_task<false>(p, smem, bh >> 2, bh & 3, c); else lin_kv_task<true>(p, smem, bh >> 2, bh & 3, c);
}
__device__ __forceinline__ void lin_out_dispatch(const LinP& p, char* smem, int task, unsigned* flags) {
    const int r = task & 1023, bh = r >> 6, c = r & 63;
    if (flags) flag_wait(flags + (task < 1024 ? 0 : 16) + bh, task < 1024 ? 4u : 6u);
    if (task < 1024) lin_out_task<false>(p, smem, bh >> 2, bh & 3, c); else lin_out_task<true>(p, smem, bh >> 2, bh & 3, c);
}

struct RwP {
    const bf16_t* Z; unsigned char* mix;
    const float* mu; const float* w_up; const float* w_bias; const float* a_up; const float* a_bias; const float* g_up;
    const float* k_k; const float* k_a; const float* r_k; const float* ln_w; const float* ln_b;
    float* oraw; bf16_t* O; bf16_t* Y; const bf16_t* lora;
};
constexpr int PS = 264;
__device__ __forceinline__ f32x4 bf4(u32x2 w) { return (f32x4){lo_bf(w.x), hi_bf(w.x), lo_bf(w.y), hi_bf(w.y)}; }
__device__ void rwkv_prep_task(const RwP& p, char* smem, int tile) {
    bf16_t* At = (bf16_t*)smem;
    const int tid = otid(), lane = tid & 63, wave = tid >> 6;
    const int fl = lane & 15, fq = lane >> 4;
    const int t0 = tile * 32;
    float* Wd = (float*)(p.mix + MX_W); float* KKd = (float*)(p.mix + MX_KK); float* KKAd = (float*)(p.mix + MX_KKA);
    bf16_t* Rd = (bf16_t*)(p.mix + MX_R); bf16_t* Kd = (bf16_t*)(p.mix + MX_K); bf16_t* Vd = (bf16_t*)(p.mix + MX_V); bf16_t* Gd = (bf16_t*)(p.mix + MX_G);
    __syncthreads();
    {
        const int tok = tid >> 3, t = t0 + tok;
        const bool first = (t & (NS - 1)) == 0;
        const bf16_t* zr = p.Z + (size_t)t * DINP + ZC_RW + 1152;
#pragma unroll
        for (int i = 0; i < 4; ++i) {
            const int ch = (tid & 7) + 8 * i;
            const u32x4 cur = *(const u32x4*)(zr + ch * 8);
            const u32x4 prv = first ? (u32x4){0u, 0u, 0u, 0u} : *(const u32x4*)(zr - DINP + ch * 8);
            const f32x4 m0 = *(const f32x4*)(p.mu + 1152 + ch * 8), m1 = *(const f32x4*)(p.mu + 1152 + ch * 8 + 4);
            const unsigned cw[4] = {cur.x, cur.y, cur.z, cur.w}, pw[4] = {prv.x, prv.y, prv.z, prv.w};
            const float mm[8] = {m0.x, m0.y, m0.z, m0.w, m1.x, m1.y, m1.z, m1.w};
            float o[8];
#pragma unroll
            for (int e = 0; e < 4; ++e) {
                const float f0 = lo_bf(cw[e]), f1 = hi_bf(cw[e]), g0 = lo_bf(pw[e]), g1 = hi_bf(pw[e]);
                o[2 * e] = f0 + (g0 - f0) * mm[2 * e]; o[2 * e + 1] = f1 + (g1 - f1) * mm[2 * e + 1];
            }
            if (ch < 8) {
#pragma unroll
                for (int e = 0; e < 8; ++e) o[e] = tanhf_(o[e]);
            } else if (ch >= 16) {
#pragma unroll
                for (int e = 0; e < 8; ++e) o[e] = sigmoidf_(o[e]);
            }
            *(u32x4*)(At + tok * PS + ch * 8) = (u32x4){pk2(o[0], o[1]), pk2(o[2], o[3]), pk2(o[4], o[5]), pk2(o[6], o[7])};
        }
    }
    __syncthreads();
    bf16x8 xb[8];
#pragma unroll
    for (int ks = 0; ks < 8; ++ks) xb[ks] = *(const bf16x8*)(At + (16 * (wave & 1) + fl) * PS + ks * 32 + fq * 8);
    const int t = t0 + 16 * (wave & 1) + fl, b = t >> 12, sq = t & (NS - 1);
    const bool first = sq == 0;
    const bf16_t* zc = p.Z + (size_t)t * DINP + ZC_RW;
    const bf16_t* WupT = p.lora; const bf16_t* AupT = p.lora + 384 * 64; const bf16_t* GupT = p.lora + 2 * 384 * 64;
    const int hd0 = (wave >> 1) * 3;
#pragma unroll
    for (int hi = 0; hi < 3; ++hi) {
        const int hd = hd0 + hi;
        f32x4 aw[4], aa[4], ag[4];
#pragma unroll
        for (int n = 0; n < 4; ++n) {
            const int cr = hd * 64 + 16 * n + fl;
            f32x4 w4 = (f32x4){0.f, 0.f, 0.f, 0.f}, a4 = w4, g4 = w4;
#pragma unroll
            for (int ks = 0; ks < 2; ++ks) {
                w4 = __builtin_amdgcn_mfma_f32_16x16x32_bf16(*(const bf16x8*)(WupT + cr * 64 + ks * 32 + fq * 8), xb[ks], w4, 0, 0, 0);
                a4 = __builtin_amdgcn_mfma_f32_16x16x32_bf16(*(const bf16x8*)(AupT + cr * 64 + ks * 32 + fq * 8), xb[2 + ks], a4, 0, 0, 0);
            }
#pragma unroll
            for (int ks = 0; ks < 4; ++ks) g4 = __builtin_amdgcn_mfma_f32_16x16x32_bf16(*(const bf16x8*)(GupT + cr * 128 + ks * 32 + fq * 8), xb[4 + ks], g4, 0, 0, 0);
            aw[n] = w4; aa[n] = a4; ag[n] = g4;
        }
        f32x4 kx[4], av[4], kkv[4];
        float ss = 0.f;
        const size_t hrow = ((size_t)(b * 6 + hd) * NS + sq) * 64;
#pragma unroll
        for (int n = 0; n < 4; ++n) {
            const int cl = 16 * n + 4 * fq, c = hd * 64 + cl;
            f32x4 rr = bf4(*(const u32x2*)(zc + c)), kk = bf4(*(const u32x2*)(zc + 384 + c)), vv = bf4(*(const u32x2*)(zc + 768 + c));
            f32x4 rp = (f32x4){0.f, 0.f, 0.f, 0.f}, kp = rp, vp = rp;
            if (!first) { rp = bf4(*(const u32x2*)(zc - DINP + c)); kp = bf4(*(const u32x2*)(zc - DINP + 384 + c)); vp = bf4(*(const u32x2*)(zc - DINP + 768 + c)); }
            rr = rr + (rp - rr) * *(const f32x4*)(p.mu + c); kk = kk + (kp - kk) * *(const f32x4*)(p.mu + 384 + c); vv = vv + (vp - vv) * *(const f32x4*)(p.mu + 768 + c);
            const f32x4 wb = *(const f32x4*)(p.w_bias + c), ab = *(const f32x4*)(p.a_bias + c), kkc = *(const f32x4*)(p.k_k + c), kac = *(const f32x4*)(p.k_a + c);
            f32x4 dec, a;
            {
                const f32x4 xw = wb + aw[n], xa = ab + aa[n];
                dec.x = __expf(-__expf(-softplusf_(-xw.x) - 0.5f)); dec.y = __expf(-__expf(-softplusf_(-xw.y) - 0.5f));
                dec.z = __expf(-__expf(-softplusf_(-xw.z) - 0.5f)); dec.w = __expf(-__expf(-softplusf_(-xw.w) - 0.5f));
                a.x = sigmoidf_(xa.x); a.y = sigmoidf_(xa.y); a.z = sigmoidf_(xa.z); a.w = sigmoidf_(xa.w);
            }
            const f32x4 kr = kk * kkc;
            ss += kr.x * kr.x + kr.y * kr.y + kr.z * kr.z + kr.w * kr.w;
            kkv[n] = kr; av[n] = a; kx[n] = kk;
            const f32x4 kmod = kk * ((a - 1.f) * kac + 1.f);
            *(f32x4*)(Wd + hrow + cl) = dec;
            u32x2 w;
            w.x = pk2(rr.x, rr.y); w.y = pk2(rr.z, rr.w); *(u32x2*)(Rd + hrow + cl) = w;
            w.x = pk2(kmod.x, kmod.y); w.y = pk2(kmod.z, kmod.w); *(u32x2*)(Kd + hrow + cl) = w;
            w.x = pk2(vv.x, vv.y); w.y = pk2(vv.z, vv.w); *(u32x2*)(Vd + hrow + cl) = w;
            w.x = pk2(ag[n].x, ag[n].y); w.y = pk2(ag[n].z, ag[n].w); *(u32x2*)(Gd + (size_t)t * 384 + c) = w;
        }
        ss = xor32_sum(xor16_sum(ss));
        const float rn = rsqrtf(fmaxf(ss, 1e-24f));
#pragma unroll
        for (int n = 0; n < 4; ++n) {
            const int cl = 16 * n + 4 * fq;
            const f32x4 kn = kkv[n] * rn;
            *(f32x4*)(KKd + hrow + cl) = kn;
            *(f32x4*)(KKAd + hrow + cl) = kn * av[n];
        }
    }
}

constexpr int SC_STEPS = 16;
constexpr int SEG_BEG[4] = {0, 1376, 2736, 4096};
constexpr size_t MX_SE0 = MX_END;
constexpr size_t MX_XE  = MX_SE0 + 24ull * 3 * 4096 * 4;
constexpr size_t MX_SST = MX_XE + 24ull * 3 * 4096 * 4;
static_assert(MX_SST + 24ull * 3 * 4096 * 2 <= 128 * MiB, "mix region");
__device__ __forceinline__ float row8_sum(float v) { v += dpp_f<0xB1>(v); v += dpp_f<0x4E>(v); v += dpp_f<0x141>(v); return v; }
__device__ void rwkv_scan_task(const RwP& p, char* smem, int bh, int seg, int grp) {
    float* buf = (float*)smem;
    float* obuf = buf + 2 * 6 * SC_STEPS * 64;
    const int tid = otid(), lane = tid & 63, wave = tid >> 6;
    const int rloc = wave * 8 + (lane >> 3);
    const bool ident = grp >= 2;
    const int row = (grp & 1) * 32 + rloc;
    const int c8 = (lane & 7) * 8;
    const int s_beg = seg == 0 ? SEG_BEG[0] : (seg == 1 ? SEG_BEG[1] : SEG_BEG[2]);
    const int s_end = seg == 0 ? SEG_BEG[1] : (seg == 1 ? SEG_BEG[2] : SEG_BEG[3]);
    const int NCH = (s_end - s_beg) / SC_STEPS;
    const size_t hb = ((size_t)bh * NS + s_beg) * 64;
    const float* Wd = (const float*)(p.mix + MX_W) + hb;
    const float* KKd = (const float*)(p.mix + MX_KK) + hb;
    const float* KKAd = (const float*)(p.mix + MX_KKA) + hb;
    const bf16_t* Rd = (const bf16_t*)(p.mix + MX_R) + hb;
    const bf16_t* Kd = (const bf16_t*)(p.mix + MX_K) + hb;
    const bf16_t* Vd = (const bf16_t*)(p.mix + MX_V) + hb;
    float* orow = p.oraw + hb;
    bf16_t* yrow = p.Y + hb;
    f32x4 Sa, Sb;
    Sa.x = (ident && c8 + 0 == row) ? 1.f : 0.f; Sa.y = (ident && c8 + 1 == row) ? 1.f : 0.f; Sa.z = (ident && c8 + 2 == row) ? 1.f : 0.f; Sa.w = (ident && c8 + 3 == row) ? 1.f : 0.f;
    Sb.x = (ident && c8 + 4 == row) ? 1.f : 0.f; Sb.y = (ident && c8 + 5 == row) ? 1.f : 0.f; Sb.z = (ident && c8 + 6 == row) ? 1.f : 0.f; Sb.w = (ident && c8 + 7 == row) ? 1.f : 0.f;
    struct Stg { f32x4 w, kk, ka; u32x2 r, k, v; };
    Stg sA, sB;
    auto gload = [&](Stg& g, int ch) {
        const size_t e = (size_t)ch * SC_STEPS * 64 + tid * 4;
        g.w = *(const f32x4*)(Wd + e); g.kk = *(const f32x4*)(KKd + e); g.ka = *(const f32x4*)(KKAd + e);
        g.r = *(const u32x2*)(Rd + e); g.k = *(const u32x2*)(Kd + e); g.v = *(const u32x2*)(Vd + e);
    };
    auto lstore = [&](const Stg& g, int bsel) {
        float* bb = buf + bsel * 6 * SC_STEPS * 64 + tid * 4;
        *(f32x4*)(bb + 0 * SC_STEPS * 64) = g.w; *(f32x4*)(bb + 1 * SC_STEPS * 64) = g.kk; *(f32x4*)(bb + 2 * SC_STEPS * 64) = g.ka;
        *(f32x4*)(bb + 3 * SC_STEPS * 64) = (f32x4){lo_bf(g.r.x), hi_bf(g.r.x), lo_bf(g.r.y), hi_bf(g.r.y)};
        *(f32x4*)(bb + 4 * SC_STEPS * 64) = (f32x4){lo_bf(g.k.x), hi_bf(g.k.x), lo_bf(g.k.y), hi_bf(g.k.y)};
        *(f32x4*)(bb + 5 * SC_STEPS * 64) = (f32x4){lo_bf(g.v.x), hi_bf(g.v.x), lo_bf(g.v.y), hi_bf(g.v.y)};
    };
    __syncthreads();
    gload(sA, 0); lstore(sA, 0);
    gload(sA, 1);
    __syncthreads();
    const float vmask = ident ? 0.f : 1.f;
    struct Ops { f32x4 w0, w1, kk0, kk1, ka0, ka1, r0, r1, k0, k1; float v; };
    auto ldops = [&](Ops& o, const float* bb, int st) {
        const float* q = bb + st * 64 + c8;
        o.w0 = *(const f32x4*)(q); o.w1 = *(const f32x4*)(q + 4);
        o.kk0 = *(const f32x4*)(q + 1 * SC_STEPS * 64); o.kk1 = *(const f32x4*)(q + 1 * SC_STEPS * 64 + 4);
        o.ka0 = *(const f32x4*)(q + 2 * SC_STEPS * 64); o.ka1 = *(const f32x4*)(q + 2 * SC_STEPS * 64 + 4);
        o.r0 = *(const f32x4*)(q + 3 * SC_STEPS * 64); o.r1 = *(const f32x4*)(q + 3 * SC_STEPS * 64 + 4);
        o.k0 = *(const f32x4*)(q + 4 * SC_STEPS * 64); o.k1 = *(const f32x4*)(q + 4 * SC_STEPS * 64 + 4);
        o.v = bb[5 * SC_STEPS * 64 + st * 64 + row];
    };
    auto chunk = [&](int ch, Stg& cur  , Stg& nxt  ) {
        if (ch + 2 < NCH) gload(nxt, ch + 2);
        const float* bb = buf + (ch & 1) * 6 * SC_STEPS * 64;
        Ops o; ldops(o, bb, 0);
#pragma unroll
        for (int st = 0; st < SC_STEPS; ++st) {
            Ops n; ldops(n, bb, (st + 1 < SC_STEPS) ? st + 1 : st);
            const float vx = o.v * vmask;
            const f32x4 pa = Sa * o.kk0 + Sb * o.kk1;
            const float sa = -row8_sum((pa.x + pa.y) + (pa.z + pa.w));
            Sa = Sa * o.w0 + o.k0 * vx + o.ka0 * sa;
            Sb = Sb * o.w1 + o.k1 * vx + o.ka1 * sa;
            const f32x4 qa = Sa * o.r0 + Sb * o.r1;
            obuf[st * 32 + rloc] = row8_sum((qa.x + qa.y) + (qa.z + qa.w));
            o = n;
        }
        __syncthreads();
#pragma unroll
        for (int i = 0; i < 2; ++i) {
            const int idx = tid + 256 * i, st = idx >> 5, rr = idx & 31;
            const size_t oi = ((size_t)ch * SC_STEPS + st) * 64 + (grp & 1) * 32 + rr;
            if (ident) yrow[oi] = f2bf(obuf[idx]); else orow[oi] = obuf[idx];
        }
        if (ch + 1 < NCH) lstore(cur, (ch + 1) & 1);
        __syncthreads();
    };
    for (int ch = 0; ch < NCH; ch += 2) {
        chunk(ch, sA, sB);
        if (ch + 1 < NCH) chunk(ch + 1, sB, sA);
    }
    float* fin = (float*)(p.mix + (ident ? MX_XE : MX_SE0)) + ((size_t)(bh * 3 + seg) * 64 + row) * 64 + c8;
    *(f32x4*)fin = Sa; *(f32x4*)(fin + 4) = Sb;
}

__device__ void phase_rwkv_chain(const RwP& p, int bid, int nblk) {
    const int lane = otid() & 63, wave = otid() >> 6;
    const float* SE0 = (const float*)(p.mix + MX_SE0); const float* XE = (const float*)(p.mix + MX_XE);
    bf16_t* SST = (bf16_t*)(p.mix + MX_SST);
    for (int x = bid * 4 + wave; x < 24 * 4; x += nblk * 4) {
        const int bh = x >> 2, cg = (x & 3) * 16;
        const float* s1 = SE0 + ((size_t)(bh * 3 + 0) * 64 + lane) * 64;
        const float* e1 = SE0 + ((size_t)(bh * 3 + 1) * 64 + lane) * 64 + cg;
        const float* X1 = XE + (size_t)(bh * 3 + 1) * 4096 + cg;
        float o[16];
#pragma unroll
        for (int k = 0; k < 16; ++k) o[k] = e1[k];
        for (int i = 0; i < 64; ++i) {
            const float si = s1[i];
#pragma unroll
            for (int k = 0; k < 16; ++k) o[k] += si * X1[i * 64 + k];
        }
        bf16_t* d1 = SST + ((size_t)(bh * 3 + 1) * 64 + lane) * 64 + cg;
        bf16_t* d2 = SST + ((size_t)(bh * 3 + 2) * 64 + lane) * 64 + cg;
#pragma unroll
        for (int k = 0; k < 16; ++k) { d1[k] = f2bf(s1[cg + k]); d2[k] = f2bf(o[k]); }
    }
}

__device__ void phase_rwkv_post(const RwP& p, int bid, int nblk) {
    const int lane = otid() & 63, wave = otid() >> 6;
    const int fl = lane & 15, fq = lane >> 4;
    const bf16_t* Rd = (const bf16_t*)(p.mix + MX_R); const bf16_t* Kd = (const bf16_t*)(p.mix + MX_K); const bf16_t* Vd = (const bf16_t*)(p.mix + MX_V);
    const bf16_t* Gd = (const bf16_t*)(p.mix + MX_G); const bf16_t* SST = (const bf16_t*)(p.mix + MX_SST);
    for (int x = bid * 4 + wave; x < 24 * (NS / 16); x += nblk * 4) {
        const int bh = x / (NS / 16), s0 = (x % (NS / 16)) * 16;
        const int b = bh / 6, hd = bh % 6;
        const int seg = s0 < SEG_BEG[1] ? 0 : (s0 < SEG_BEG[2] ? 1 : 2);
        const size_t hrow = ((size_t)bh * NS + s0 + fl) * 64;
        f32x4 acc[4];
#pragma unroll
        for (int n = 0; n < 4; ++n) acc[n] = *(const f32x4*)(p.oraw + hrow + 16 * n + 4 * fq);
        if (seg > 0) {
            const bf16_t* ss = SST + (size_t)(bh * 3 + seg) * 4096;
#pragma unroll
            for (int ks = 0; ks < 2; ++ks) {
                const bf16x8 yb = *(const bf16x8*)(p.Y + hrow + ks * 32 + fq * 8);
#pragma unroll
                for (int n = 0; n < 4; ++n) {
                    const bf16x8 sa = *(const bf16x8*)(ss + (size_t)(16 * n + fl) * 64 + ks * 32 + fq * 8);
                    acc[n] = __builtin_amdgcn_mfma_f32_16x16x32_bf16(sa, yb, acc[n], 0, 0, 0);
                }
            }
        }
        float sm = 0.f;
#pragma unroll
        for (int n = 0; n < 4; ++n) sm += acc[n].x + acc[n].y + acc[n].z + acc[n].w;
        const float mean = xor32_sum(xor16_sum(sm)) * (1.f / 64.f);
        float sv = 0.f;
#pragma unroll
        for (int n = 0; n < 4; ++n) { acc[n] = acc[n] - mean; sv += acc[n].x * acc[n].x + acc[n].y * acc[n].y + acc[n].z * acc[n].z + acc[n].w * acc[n].w; }
        const float rstd = rsqrtf(xor32_sum(xor16_sum(sv)) * (1.f / 64.f) + 64e-5f);
        float rk = 0.f; f32x4 vv[4];
#pragma unroll
        for (int n = 0; n < 4; ++n) {
            const int c = 16 * n + 4 * fq;
            const u32x2 r2 = *(const u32x2*)(Rd + hrow + c), k2 = *(const u32x2*)(Kd + hrow + c), v2 = *(const u32x2*)(Vd + hrow + c);
            const f32x4 rkw = *(const f32x4*)(p.r_k + hd * 64 + c);
            rk += lo_bf(r2.x) * lo_bf(k2.x) * rkw.x + hi_bf(r2.x) * hi_bf(k2.x) * rkw.y + lo_bf(r2.y) * lo_bf(k2.y) * rkw.z + hi_bf(r2.y) * hi_bf(k2.y) * rkw.w;
            vv[n] = (f32x4){lo_bf(v2.x), hi_bf(v2.x), lo_bf(v2.y), hi_bf(v2.y)};
        }
        rk = xor32_sum(xor16_sum(rk));
        const size_t t = (size_t)b * NS + s0 + fl;
#pragma unroll
        for (int n = 0; n < 4; ++n) {
            const int c = 16 * n + 4 * fq;
            const f32x4 lw = *(const f32x4*)(p.ln_w + hd * 64 + c), lb = *(const f32x4*)(p.ln_b + hd * 64 + c);
            const u32x2 g2 = *(const u32x2*)(Gd + t * 384 + hd * 64 + c);
            const f32x4 gg = (f32x4){lo_bf(g2.x), hi_bf(g2.x), lo_bf(g2.y), hi_bf(g2.y)};
            const f32x4 o = (acc[n] * rstd * lw + lb + vv[n] * rk) * gg;
            u32x2 w; w.x = pk2(o.x, o.y); w.y = pk2(o.z, o.w);
            *(u32x2*)(p.O + t * D + 256 + hd * 64 + c) = w;
        }
    }
}

__device__ __forceinline__ unsigned ordkey(float f) { const unsigned u = __float_as_uint(f); return (u & 0x80000000u) ? ~u : (u | 0x80000000u); }
__device__ __forceinline__ float unordkey(unsigned k) { return __uint_as_float((k & 0x80000000u) ? (k & 0x7FFFFFFFu) : ~k); }
__device__ __forceinline__ void ins16(unsigned (&L)[16], unsigned x) {
#pragma unroll
    for (int i = 0; i < 16; ++i) { const unsigned hi = L[i] > x ? L[i] : x; x = L[i] > x ? x : L[i]; L[i] = hi; }
}
__device__ __forceinline__ void top16_col(const float* col  , unsigned (&L)[16]) {
#pragma unroll
    for (int i = 0; i < 16; ++i) L[i] = 0u;
#pragma unroll 1
    for (int n0 = 0; n0 < 128; n0 += 16) {
        float x[16];
#pragma unroll
        for (int j = 0; j < 16; ++j) x[j] = col[(size_t)(n0 + j) * NT];
#pragma unroll
        for (int j = 0; j < 16; ++j) ins16(L, (ordkey(x[j]) & 0xFFFFFF80u) | (unsigned)(127 - (n0 + j)));
    }
}
__device__ void phase_topk(const float* SCT, int* EIDX, float* GATE, char* smem, int bid, int nblk) {
    const int tid = otid(), lane = tid & 63, wave = tid >> 6;
    unsigned char* itab = (unsigned char*)smem + tid * 32;
    unsigned char* ctab = (unsigned char*)smem + NTHREADS * 32;
    __syncthreads();
    if (tid < 64) {
        const int c = tid; int ci, cj;
        if (c < 16) { ci = 0; cj = c; } else if (c < 24) { ci = 1; cj = c - 16; } else if (c < 29) { ci = 2; cj = c - 24; } else if (c < 33) { ci = 3; cj = c - 29; }
        else if (c < 36) { ci = 4; cj = c - 33; } else if (c < 38) { ci = 5; cj = c - 36; } else if (c < 40) { ci = 6; cj = c - 38; } else if (c < 42) { ci = 7; cj = c - 40; }
        else if (c < 50) { ci = c - 34; cj = 0; } else { ci = 0; cj = 0; }
        ctab[c] = (unsigned char)(ci | (cj << 4));
    }
    __syncthreads();
    for (int x = bid * 4 + wave; x < (NT / 64) * 8; x += nblk * 4) {
        const int tb = x >> 3, hd = x & 7;
        const int t = tb * 64 + lane;
        unsigned L1[16], L2[16];
        top16_col(SCT + (size_t)(hd * 256) * NT + t, L1);
        top16_col(SCT + (size_t)(hd * 256 + 128) * NT + t, L2);
        float s1[16], s2[16];
#pragma unroll
        for (int i = 0; i < 16; ++i) {
            s1[i] = unordkey(L1[i] & 0xFFFFFF80u); s2[i] = unordkey(L2[i] & 0xFFFFFF80u);
            itab[i] = (unsigned char)(127u - (L1[i] & 127u)); itab[16 + i] = (unsigned char)(127u - (L2[i] & 127u));
        }
        unsigned M[16];
#pragma unroll
        for (int i = 0; i < 16; ++i) M[i] = 0u;
        int c = 0;
#pragma unroll
        for (int ci = 0; ci < 16; ++ci) {
#pragma unroll
            for (int cj = 0; cj < 16; ++cj) {
                if ((ci + 1) * (cj + 1) <= 16) {
                    const int cid = (ci == 0) ? cj : (ci == 1) ? 16 + cj : (ci == 2) ? 24 + cj : (ci == 3) ? 29 + cj : (ci == 4) ? 33 + cj : (ci == 5) ? 36 + cj : (ci == 6) ? 38 + cj : (ci == 7) ? 40 + cj : 34 + ci;
                    ins16(M, (ordkey(s1[ci] + s2[cj]) & 0xFFFFFFC0u) | (unsigned)(63 - cid));
                    ++c;
                }
            }
        }
        float ev[16]; int ee[16];
        const float mx = unordkey(M[0] & 0xFFFFFFC0u);
        float sum = 0.f;
#pragma unroll
        for (int i = 0; i < 16; ++i) {
            const int cid = 63 - (int)(M[i] & 63u);
            const unsigned cc = ctab[cid];
            ee[i] = (int)itab[cc & 15u] * 128 + (int)itab[16 + (cc >> 4)];
            ev[i] = __expf(unordkey(M[i] & 0xFFFFFFC0u) - mx);
            sum += ev[i];
        }
        const float inv = 1.f / sum;
        int* eo = EIDX + (size_t)t * 128 + hd * 16; float* go = GATE + (size_t)t * 128 + hd * 16;
#pragma unroll
        for (int i = 0; i < 4; ++i) {
            *(int4*)(eo + 4 * i) = make_int4(ee[4 * i], ee[4 * i + 1], ee[4 * i + 2], ee[4 * i + 3]);
            *(f32x4*)(go + 4 * i) = (f32x4){ev[4 * i] * inv, ev[4 * i + 1] * inv, ev[4 * i + 2] * inv, ev[4 * i + 3] * inv};
        }
    }
    __syncthreads();
}

typedef float f32x2 __attribute__((ext_vector_type(2)));
__device__ __forceinline__ float gelu_erf(float d) { return 0.5f * d * (1.f + erff(d * 0.7071067811865476f)); }
template <int NMODE>
__device__ void phase_expert(const bf16_t* H, const unsigned char* U4, const unsigned char* V4, const float* SU, const float* SV, const int* EIDX, const float* GATE,
                             const float* X, float* Xo, const float* gn, bf16_t* Hn, int bid, int nblk) {
    const int lane = otid() & 63, wave = otid() >> 6;
    for (int t = bid * 4 + wave; t < NT; t += nblk * 4) {
        f32x2 xf[8], acc[8];
        {
            const u32x4 a = *(const u32x4*)(H + (size_t)t * D + lane * 16), b = *(const u32x4*)(H + (size_t)t * D + lane * 16 + 8);
            xf[0] = (f32x2){lo_bf(a.x), hi_bf(a.x)}; xf[1] = (f32x2){lo_bf(a.y), hi_bf(a.y)}; xf[2] = (f32x2){lo_bf(a.z), hi_bf(a.z)}; xf[3] = (f32x2){lo_bf(a.w), hi_bf(a.w)};
            xf[4] = (f32x2){lo_bf(b.x), hi_bf(b.x)}; xf[5] = (f32x2){lo_bf(b.y), hi_bf(b.y)}; xf[6] = (f32x2){lo_bf(b.z), hi_bf(b.z)}; xf[7] = (f32x2){lo_bf(b.w), hi_bf(b.w)};
        }
#pragma unroll
        for (int i = 0; i < 8; ++i) acc[i] = (f32x2){0.f, 0.f};
        const int e_lo = EIDX[(size_t)t * 128 + lane], e_hi = EIDX[(size_t)t * 128 + 64 + lane];
        const float g_lo = GATE[(size_t)t * 128 + lane] * SV[e_lo], g_hi = GATE[(size_t)t * 128 + 64 + lane] * SV[e_hi];
        const float su_lo = SU[e_lo], su_hi = SU[e_hi];
#pragma unroll 1
        for (int e0 = 0; e0 < 128; e0 += 16) {
            const int esrc = (e0 < 64) ? e_lo : e_hi;
            int ei[16]; u32x2 ur[16];
#pragma unroll
            for (int j = 0; j < 16; ++j) { ei[j] = __builtin_amdgcn_readlane(esrc, (e0 & 63) + j); ur[j] = *(const u32x2*)(U4 + (size_t)ei[j] * 512 + lane * 8); }
            float dmine = 0.f;
#pragma unroll
            for (int j = 0; j < 16; ++j) {
                f32x2 d2 = (f32x2){0.f, 0.f};
                d2 = __builtin_elementwise_fma(xf[0], __builtin_amdgcn_cvt_scalef32_pk_f32_fp4(ur[j].x, 1.0f, 0), d2);
                d2 = __builtin_elementwise_fma(xf[1], __builtin_amdgcn_cvt_scalef32_pk_f32_fp4(ur[j].x, 1.0f, 1), d2);
                d2 = __builtin_elementwise_fma(xf[2], __builtin_amdgcn_cvt_scalef32_pk_f32_fp4(ur[j].x, 1.0f, 2), d2);
                d2 = __builtin_elementwise_fma(xf[3], __builtin_amdgcn_cvt_scalef32_pk_f32_fp4(ur[j].x, 1.0f, 3), d2);
                d2 = __builtin_elementwise_fma(xf[4], __builtin_amdgcn_cvt_scalef32_pk_f32_fp4(ur[j].y, 1.0f, 0), d2);
                d2 = __builtin_elementwise_fma(xf[5], __builtin_amdgcn_cvt_scalef32_pk_f32_fp4(ur[j].y, 1.0f, 1), d2);
                d2 = __builtin_elementwise_fma(xf[6], __builtin_amdgcn_cvt_scalef32_pk_f32_fp4(ur[j].y, 1.0f, 2), d2);
                d2 = __builtin_elementwise_fma(xf[7], __builtin_amdgcn_cvt_scalef32_pk_f32_fp4(ur[j].y, 1.0f, 3), d2);
                const float d = wave_sum(d2.x + d2.y);
                if (lane == (e0 & 63) + j) dmine = d;
            }
            const float amine = gelu_erf(dmine * ((e0 < 64) ? su_lo : su_hi)) * ((e0 < 64) ? g_lo : g_hi);
#pragma unroll
            for (int j = 0; j < 16; ++j) ur[j] = *(const u32x2*)(V4 + (size_t)ei[j] * 512 + lane * 8);
#pragma unroll
            for (int j = 0; j < 16; ++j) {
                const float a = __int_as_float(__builtin_amdgcn_readlane(__float_as_int(amine), (e0 & 63) + j));
                const f32x2 a2 = (f32x2){a, a};
                acc[0] = __builtin_elementwise_fma(a2, __builtin_amdgcn_cvt_scalef32_pk_f32_fp4(ur[j].x, 1.0f, 0), acc[0]);
                acc[1] = __builtin_elementwise_fma(a2, __builtin_amdgcn_cvt_scalef32_pk_f32_fp4(ur[j].x, 1.0f, 1), acc[1]);
                acc[2] = __builtin_elementwise_fma(a2, __builtin_amdgcn_cvt_scalef32_pk_f32_fp4(ur[j].x, 1.0f, 2), acc[2]);
                acc[3] = __builtin_elementwise_fma(a2, __builtin_amdgcn_cvt_scalef32_pk_f32_fp4(ur[j].x, 1.0f, 3), acc[3]);
                acc[4] = __builtin_elementwise_fma(a2, __builtin_amdgcn_cvt_scalef32_pk_f32_fp4(ur[j].y, 1.0f, 0), acc[4]);
                acc[5] = __builtin_elementwise_fma(a2, __builtin_amdgcn_cvt_scalef32_pk_f32_fp4(ur[j].y, 1.0f, 1), acc[5]);
                acc[6] = __builtin_elementwise_fma(a2, __builtin_amdgcn_cvt_scalef32_pk_f32_fp4(ur[j].y, 1.0f, 2), acc[6]);
                acc[7] = __builtin_elementwise_fma(a2, __builtin_amdgcn_cvt_scalef32_pk_f32_fp4(ur[j].y, 1.0f, 3), acc[7]);
            }
        }
        const f32x4* xr = (const f32x4*)(X + (size_t)t * D) + lane * 4;
        f32x4* xo = (f32x4*)(Xo + (size_t)t * D) + lane * 4;
        f32x4 o[4]; float ss = 0.f;
#pragma unroll
        for (int i = 0; i < 4; ++i) { o[i] = xr[i]; o[i] += (f32x4){acc[2 * i].x, acc[2 * i].y, acc[2 * i + 1].x, acc[2 * i + 1].y}; ss += o[i].x * o[i].x + o[i].y * o[i].y + o[i].z * o[i].z + o[i].w * o[i].w; }
        const float rs = rsqrtf(wave_sum(ss) * (1.f / D) + 1e-6f);
        const f32x4* gp = (const f32x4*)gn + lane * 4;
        if (NMODE == 1) {
#pragma unroll
            for (int i = 0; i < 4; ++i) xo[i] = o[i] * rs * gp[i];
        } else {
            u32x4 h0, h1;
            { const f32x4 y0 = o[0] * rs * gp[0], y1 = o[1] * rs * gp[1], y2 = o[2] * rs * gp[2], y3 = o[3] * rs * gp[3];
              h0 = (u32x4){pk2(y0.x, y0.y), pk2(y0.z, y0.w), pk2(y1.x, y1.y), pk2(y1.z, y1.w)}; h1 = (u32x4){pk2(y2.x, y2.y), pk2(y2.z, y2.w), pk2(y3.x, y3.y), pk2(y3.z, y3.w)}; }
#pragma unroll
            for (int i = 0; i < 4; ++i) xo[i] = o[i];
            *(u32x4*)(Hn + (size_t)t * D + lane * 16) = h0; *(u32x4*)(Hn + (size_t)t * D + lane * 16 + 8) = h1;
        }
    }
}

#define XB_TMO      128
#define XB_XCNT(j)  (256  + 64 * (j))
#define XB_XSUB(j)  (1280 + 64 * (j))
#define XB_XGEN(j)  (2304 + 64 * (j))
#define XB_TOP      3328
#define XB_TOPGEN   3392
#define XCD_BAR_WORDS 3456
#define XB_SPIN_CAP (1u << 22)
#define LAS __attribute__((address_space(3)))
__device__ __forceinline__ unsigned xb_ld(unsigned* p)              { return __hip_atomic_load(p, __ATOMIC_RELAXED, __HIP_MEMORY_SCOPE_AGENT); }
__device__ __forceinline__ unsigned xb_add(unsigned* p, unsigned v) { return __hip_atomic_fetch_add(p, v, __ATOMIC_RELAXED, __HIP_MEMORY_SCOPE_AGENT); }
__device__ __forceinline__ unsigned xb_xcc_id() { return (unsigned)__builtin_amdgcn_s_getreg((3 << 11) | 20) & 0xFu; }
#define XB_SPIN(cond, bar) do { unsigned _sp = 0; while (cond) { __builtin_amdgcn_s_sleep(1); \
    if ((++_sp & 255u) == 0u) { if (xb_ld(&(bar)[XB_TMO])) break; if (_sp > XB_SPIN_CAP) { atomicAdd(&(bar)[XB_TMO], 1u); break; } } } } while (0)
struct XcdBarrier { unsigned* bar; unsigned x; volatile LAS unsigned* st; };
__device__ __forceinline__ XcdBarrier xcd_barrier_post(unsigned* bar, volatile LAS unsigned* st) {
    XcdBarrier b; b.bar = bar; b.x = xb_xcc_id(); b.st = st;
    if (threadIdx.x == 0) (void)xb_add(&bar[XB_XCNT(b.x)], 1u);
    return b;
}
__device__ __forceinline__ void xcd_barrier_complete(unsigned* bar, unsigned x, unsigned& nloc, unsigned& nx) {
    const unsigned G = gridDim.x * gridDim.y * gridDim.z;
    unsigned sum, cnt, mine, sp = 0u;
    for (;;) {
        sum = 0u; cnt = 0u; mine = 0u;
#pragma unroll
        for (unsigned j = 0; j < 16; ++j) { const unsigned c = xb_ld(&bar[XB_XCNT(j)]); sum += c; cnt += (c > 0u) ? 1u : 0u; mine = (j == x) ? c : mine; }
        if (sum == G) break;
        __builtin_amdgcn_s_sleep(1);
        if ((++sp & 255u) == 0u) { if (xb_ld(&bar[XB_TMO])) break; if (sp > XB_SPIN_CAP) { atomicAdd(&bar[XB_TMO], 1u); break; } }
    }
    nloc = mine > 0u ? mine : 1u; nx = cnt > 0u ? cnt : 1u;
}
__device__ __forceinline__ void xcd_barrier(const XcdBarrier& b) {
    asm volatile("s_waitcnt vmcnt(0)" ::: "memory");
    __syncthreads();
    if (threadIdx.x == 0) {
        unsigned* bar = b.bar;
        __builtin_amdgcn_s_waitcnt(0);
        unsigned nloc = b.st[0], nx = b.st[1];
        if (nloc == 0u) { xcd_barrier_complete(bar, b.x, nloc, nx); b.st[0] = nloc; b.st[1] = nx; }
        const unsigned old = xb_add(&bar[XB_XSUB(b.x)], 1u);
        const unsigned gen = old / nloc;
        if (old + 1u == (gen + 1u) * nloc) {
            __builtin_amdgcn_fence(__ATOMIC_RELEASE, "agent");
            asm volatile("s_waitcnt vmcnt(0)" ::: "memory");
            const unsigned og = xb_add(&bar[XB_TOP], 1u);
            const unsigned tg = og / nx;
            if (og + 1u == (tg + 1u) * nx) xb_add(&bar[XB_TOPGEN], 1u);
            else XB_SPIN(xb_ld(&bar[XB_TOPGEN]) == tg, bar);
            __builtin_amdgcn_fence(__ATOMIC_ACQUIRE, "agent");
            xb_add(&bar[XB_XGEN(b.x)], 1u);
            asm volatile("s_waitcnt vmcnt(0)" ::: "memory");
        } else {
            XB_SPIN(xb_ld(&bar[XB_XGEN(b.x)]) == gen, bar);
            __builtin_amdgcn_fence(__ATOMIC_ACQUIRE, "agent");
            asm volatile("s_waitcnt vmcnt(0)" ::: "memory");
        }
    }
    __syncthreads();
}

struct Params {
    const float* in[24];
    float* out; unsigned char* ws;
};
constexpr int LDS_BYTES = 2 * 2 * 128 * GS * 2 + 256;

__device__ __forceinline__ RwP make_rwp(const Params& P, int l) {
    RwP r;
    r.Z = (const bf16_t*)(P.ws + WS_Z); r.mix = P.ws + WS_MIX;
    r.mu = P.in[6] + l * RW_F; r.w_up = P.in[7] + (size_t)l * 64 * 384; r.w_bias = P.in[8] + l * 384; r.a_up = P.in[9] + (size_t)l * 64 * 384; r.a_bias = P.in[10] + l * 384;
    r.g_up = P.in[11] + (size_t)l * 128 * 384; r.k_k = P.in[12] + l * 384; r.k_a = P.in[13] + l * 384; r.r_k = P.in[14] + l * 384; r.ln_w = P.in[15] + l * 384; r.ln_b = P.in[16] + l * 384;
    r.oraw = (float*)(P.ws + WS_H); r.O = (bf16_t*)(P.ws + WS_O); r.Y = (bf16_t*)(P.ws + WS_EIDX); r.lora = (const bf16_t*)(P.ws + WS_LORA + l * LORA_L);
    return r;
}

__global__ void __launch_bounds__(NTHREADS, 2) mega_fwd(Params P) {
    extern __shared__ __attribute__((aligned(16))) char smem[];
    const int bid = blockIdx.x, nblk = gridDim.x;
    volatile LAS unsigned* st = (volatile LAS unsigned*)(smem + LDS_BYTES - 16);
    if (threadIdx.x == 0) { st[0] = 0u; st[1] = 0u; st[2] = 0u; st[3] = 0u; }
    __syncthreads();
    XcdBarrier bar = xcd_barrier_post((unsigned*)(P.ws + WS_CTL), st);
#define GSYNC() xcd_barrier(bar)

    {
        ConvP c{P.in[4], P.in[5], P.in[20], P.in[21], P.in[22], P.in[23], P.in[7], P.in[9], P.in[11], P.ws};
        phase_convert_weights(c, smem, bid, nblk);
        phase_rmsnorm<false>(P.in[0], P.in[1], P.ws + WS_H, bid, nblk);
    }
    GSYNC();
#pragma unroll 1
    for (int l = 0; l < 2; ++l) {
        const float* xin = (l == 0) ? P.in[0] : P.out;
        {
            GemmP g{(const bf16_t*)(P.ws + WS_H), D, 0, 0, (const bf16_t*)(P.ws + WS_WTIN) + (size_t)l * DINP * D, D, D, NT / 128, DINP / 128, P.ws + WS_Z, DINP, nullptr};
            phase_gemm<0>(g, smem, bid, nblk);
            if (l == 0) {
                for (int l2 = 0; l2 < 2; ++l2) {
                    GemmP ge{(const bf16_t*)(P.ws + WS_SK) + (size_t)l2 * 16 * 128 * 128, 128, 0, 128, (const bf16_t*)(P.ws + WS_WTQ) + (size_t)l2 * D * 2048, 2048, 128, 16, 8,
                             (bf16_t*)(P.ws + WS_WEFF) + (size_t)l2 * 2048 * D, D, nullptr};
                    phase_gemm<0>(ge, smem, bid, nblk, (NT / 128 * (DINP / 128) + l2 * 128) % nblk);
                }
            }
        }
        GSYNC();
        RwP rw = make_rwp(P, l);
        LinP lp{(const bf16_t*)(P.ws + WS_Z), (bf16_t*)(P.ws + WS_O), P.in[17] + (size_t)l * 16 * 192, P.in[18] + l * 192, P.in[19] + l * 384, (const float*)(P.ws + WS_ROPE), P.ws + WS_LIN};
        for (int task = bid; task < 512 + 2048; task += nblk) {
            if (task < 512) { rwkv_prep_task(rw, smem, task); }
            else { lin_kv_dispatch(lp, smem, task - 512); }
        }
        GSYNC();
        {
            for (int task = bid; task < 240; task += nblk) {
                const int bh = task / 10, r = task % 10;
                const int seg = r < 2 ? 0 : (r < 6 ? 1 : 2), grp = r < 2 ? r : (r < 6 ? r - 2 : r - 6);
                rwkv_scan_task(rw, smem, bh, seg, grp);
            }
            unsigned* lflags = (unsigned*)(P.ws + WS_FLAGS) + l * 32;
            if (nblk >= 512) {
                if (bid >= 240) {
                    lin_scan_phase(lp, bid - 240, nblk - 240, lflags);
                    for (int task = bid - 240; task < 2048; task += nblk - 240) lin_out_dispatch(lp, smem, task, lflags);
                }
            } else {
                lin_scan_phase(lp, bid, nblk, lflags);
                for (int task = bid; task < 2048; task += nblk) lin_out_dispatch(lp, smem, task, lflags);
            }
            if (l == 0) {
                ConvP c{P.in[4], P.in[5], P.in[20], P.in[21], P.in[22], P.in[23], P.in[7], P.in[9], P.in[11], P.ws};
                if (nblk >= 512) { if (bid >= 240) phase_convert_uv(c, bid - 240, nblk - 240); } else phase_convert_uv(c, bid, nblk);
            }
        }
        GSYNC();
        phase_rwkv_chain(rw, bid, nblk);
        GSYNC();
        phase_rwkv_post(rw, bid, nblk);
        GSYNC();
        {
            GemmP g{(const bf16_t*)(P.ws + WS_O), D, 0, 0, (const bf16_t*)(P.ws + WS_WTOUT) + (size_t)l * D * D, D, D, NT / 128, D / 128, P.out, D, xin};
            phase_gemm<2>(g, smem, bid, nblk);
        }
        GSYNC();
        phase_rmsnorm<false>(P.out, P.in[2] + l * D, P.ws + WS_H, bid, nblk);
        GSYNC();
        {
            GemmP g{(const bf16_t*)(P.ws + WS_H), D, 0, 0, (const bf16_t*)(P.ws + WS_WEFF) + (size_t)l * 2048 * D, D, D, NT / 128, 2048 / 128, P.ws + WS_MIX, NT, nullptr};
            phase_gemm<3>(g, smem, bid, nblk);
        }
        GSYNC();
        phase_topk((const float*)(P.ws + WS_MIX), (int*)(P.ws + WS_EIDX), (float*)(P.ws + WS_GATE), smem, bid, nblk);
        GSYNC();
        if (l == 0) phase_expert<0>((const bf16_t*)(P.ws + WS_H), P.ws + WS_UB + (size_t)l * NEXP * 512, P.ws + WS_VB + (size_t)l * NEXP * 512,
                     (const float*)(P.ws + WS_ESC) + l * NEXP, (const float*)(P.ws + WS_ESC) + (2 + l) * NEXP,
                     (const int*)(P.ws + WS_EIDX), (const float*)(P.ws + WS_GATE), P.out, P.out, P.in[1] + D, (bf16_t*)(P.ws + WS_H), bid, nblk);
        else phase_expert<1>((const bf16_t*)(P.ws + WS_H), P.ws + WS_UB + (size_t)l * NEXP * 512, P.ws + WS_VB + (size_t)l * NEXP * 512,
                     (const float*)(P.ws + WS_ESC) + l * NEXP, (const float*)(P.ws + WS_ESC) + (2 + l) * NEXP,
                     (const int*)(P.ws + WS_EIDX), (const float*)(P.ws + WS_GATE), P.out, P.out, P.in[3], nullptr, bid, nblk);
        if (l == 0) GSYNC();
    }
}

extern "C" void kernel_launch(void* const* d_in, const int* in_sizes, int n_in, void* d_out, int out_size, void* d_ws, size_t ws_size, hipStream_t stream) {
    static int grid = 0;
    if (grid == 0) {
        if (n_in != 24 || ws_size < WS_END) { fprintf(stderr, "kernel_launch: bad args n_in=%d ws=%zu need=%zu\n", n_in, ws_size, (size_t)WS_END); grid = -1; return; }
        int dev = 0, cus = 0, per_cu = 0;
        hipGetDevice(&dev);
        hipDeviceGetAttribute(&cus, hipDeviceAttributeMultiprocessorCount, dev);
        hipFuncSetAttribute((const void*)mega_fwd, hipFuncAttributeMaxDynamicSharedMemorySize, LDS_BYTES);
        hipOccupancyMaxActiveBlocksPerMultiprocessor(&per_cu, (const void*)mega_fwd, NTHREADS, LDS_BYTES);
        if (per_cu < 1) { fprintf(stderr, "kernel_launch: occupancy query says %d\n", per_cu); grid = -1; return; }
        if (per_cu > 2) per_cu = 2;
        grid = cus * per_cu;
        fprintf(stderr, "kernel_launch: grid %d (%d CUs x %d)\n", grid, cus, per_cu);
    }
    if (grid < 0) return;
    hipMemsetAsync((char*)d_ws + WS_CTL, 0, 32768, stream);
    Params P{};
    for (int i = 0; i < 24; ++i) P.in[i] = (const float*)d_in[i];
    P.out = (float*)d_out; P.ws = (unsigned char*)d_ws;
    void* args[] = {&P};
    hipError_t e = hipLaunchCooperativeKernel((const void*)mega_fwd, dim3(grid), dim3(NTHREADS), args, LDS_BYTES, stream);
    if (e != hipSuccess) fprintf(stderr, "cooperative launch failed: %s (grid %d)\n", hipGetErrorString(e), grid);
}
```

```cpp
#include <hip/hip_runtime.h>
#include <stdint.h>
#include <stdio.h>

typedef unsigned short bf16_t;
typedef short bf16x8 __attribute__((ext_vector_type(8)));
typedef float f32x4 __attribute__((ext_vector_type(4)));
typedef unsigned u32x4 __attribute__((ext_vector_type(4)));
typedef unsigned u32x2 __attribute__((ext_vector_type(2)));

constexpr int NB = 4, NS = 4096, NT = NB * NS, D = 1024, DIN = 3600, DINP = 3712;
constexpr int ZC_RET = 0, ZC_RW = 1024, ZC_GLA = 2432;
constexpr int RW_F = 1408;
constexpr int NEXP = 16384;
constexpr int NTHREADS = 256;

constexpr size_t MiB = 1024ull * 1024ull;
constexpr size_t WS_CTL   = 0;
constexpr size_t WS_LORA  = 65536;
constexpr size_t LORA_L   = 384ull * 256 * 2;
constexpr size_t WS_ESC   = 524288;
constexpr size_t WS_WTIN  = 1 * MiB;
constexpr size_t WS_WTOUT = WS_WTIN + 2ull * DINP * D * 2;
constexpr size_t WS_WTQ   = WS_WTOUT + 2ull * D * D * 2;
constexpr size_t WS_SK    = WS_WTQ + 2ull * 2048 * D * 2;
constexpr size_t WS_UB    = WS_SK + 2ull * 16 * 128 * 128 * 2;
constexpr size_t WS_VB    = WS_UB + 2ull * NEXP * D;
constexpr size_t WS_LIN   = WS_VB + 2ull * NEXP * D;
constexpr size_t WS_H     = WS_LIN + 64 * MiB;
constexpr size_t WS_Z     = WS_H + (size_t)NT * D * 2;
constexpr size_t WS_O     = WS_Z + (size_t)NT * DINP * 2;
constexpr size_t WS_MIX   = WS_O + (size_t)NT * D * 2;
constexpr size_t WS_EIDX  = WS_MIX + 128 * MiB;
constexpr size_t WS_GATE  = WS_EIDX + (size_t)NT * 128 * 4;
constexpr size_t WS_ROPE  = WS_GATE + (size_t)NT * 128 * 4;
constexpr size_t WS_WEFF  = WS_ROPE + 1 * MiB;
constexpr size_t WS_END   = WS_WEFF + 2ull * 2048 * D * 2;
constexpr size_t RWA = (size_t)NT * 384;
constexpr size_t MX_W   = 0;
constexpr size_t MX_KK  = MX_W + RWA * 4;
constexpr size_t MX_KKA = MX_KK + RWA * 4;
constexpr size_t MX_R   = MX_KKA + RWA * 4;
constexpr size_t MX_K   = MX_R + RWA * 2;
constexpr size_t MX_V   = MX_K + RWA * 2;
constexpr size_t MX_G   = MX_V + RWA * 2;
constexpr size_t MX_END = MX_G + RWA * 2;
static_assert(MX_END <= 128 * MiB, "mix region");

__device__ __forceinline__ float bf2f(bf16_t v) { return __uint_as_float(((unsigned)v) << 16); }
__device__ __forceinline__ bf16_t f2bf(float f) { unsigned u = __float_as_uint(f); u += 0x7FFFu + ((u >> 16) & 1u); return (bf16_t)(u >> 16); }
__device__ __forceinline__ unsigned pk2(float lo, float hi) { return (unsigned)f2bf(lo) | ((unsigned)f2bf(hi) << 16); }
__device__ __forceinline__ float lo_bf(unsigned u) { return __uint_as_float(u << 16); }
__device__ __forceinline__ float hi_bf(unsigned u) { return __uint_as_float(u & 0xFFFF0000u); }
template <int CTRL> __device__ __forceinline__ float dpp_f(float v) { return __int_as_float(__builtin_amdgcn_update_dpp(0, __float_as_int(v), CTRL, 0xF, 0xF, true)); }
template <int CTRL> __device__ __forceinline__ unsigned dpp_u(unsigned v) { return (unsigned)__builtin_amdgcn_update_dpp(0, (int)v, CTRL, 0xF, 0xF, true); }
__device__ __forceinline__ float row16_sum(float v) { v += dpp_f<0x128>(v); v += dpp_f<0x124>(v); v += dpp_f<0x122>(v); v += dpp_f<0x121>(v); return v; }
__device__ __forceinline__ float xor16_sum(float v) { auto r = __builtin_amdgcn_permlane16_swap(__float_as_uint(v), __float_as_uint(v), false, false); return __uint_as_float(r[0]) + __uint_as_float(r[1]); }
__device__ __forceinline__ float xor32_sum(float v) { auto r = __builtin_amdgcn_permlane32_swap(__float_as_uint(v), __float_as_uint(v), false, false); return __uint_as_float(r[0]) + __uint_as_float(r[1]); }
__device__ __forceinline__ float wave_sum(float v) { return xor32_sum(xor16_sum(row16_sum(v))); }
__device__ __forceinline__ unsigned umax_(unsigned a, unsigned b) { return a > b ? a : b; }
__device__ __forceinline__ unsigned wave_max_u32(unsigned v) {
    v = umax_(v, dpp_u<0x128>(v)); v = umax_(v, dpp_u<0x124>(v)); v = umax_(v, dpp_u<0x122>(v)); v = umax_(v, dpp_u<0x121>(v));
    { auto r = __builtin_amdgcn_permlane16_swap(v, v, false, false); v = umax_(r[0], r[1]); }
    { auto r = __builtin_amdgcn_permlane32_swap(v, v, false, false); v = umax_(r[0], r[1]); }
    return v;
}
__device__ __forceinline__ float sigmoidf_(float x) { return 1.f / (1.f + __expf(-x)); }
__device__ __forceinline__ float softplusf_(float x) { return fmaxf(x, 0.f) + __logf(1.f + __expf(-fabsf(x))); }
__device__ __forceinline__ float tanhf_(float x) { const float e = __expf(2.f * fminf(fmaxf(x, -15.f), 15.f)); return (e - 1.f) / (e + 1.f); }

__device__ __forceinline__ int otid() { int t = threadIdx.x; asm volatile("" : "+v"(t)); return t; }

constexpr size_t WS_FLAGS = 16384;
__device__ __forceinline__ void flag_signal(unsigned* f) {
    asm volatile("s_waitcnt vmcnt(0)" ::: "memory");
    __syncthreads();
    if (threadIdx.x == 0) {
        __builtin_amdgcn_fence(__ATOMIC_RELEASE, "agent");
        asm volatile("s_waitcnt vmcnt(0)" ::: "memory");
        __hip_atomic_fetch_add(f, 1u, __ATOMIC_RELAXED, __HIP_MEMORY_SCOPE_AGENT);
    }
}
__device__ __forceinline__ void flag_wait(unsigned* f, unsigned need) {
    if (threadIdx.x == 0) {
        unsigned sp = 0;
        while (__hip_atomic_load(f, __ATOMIC_RELAXED, __HIP_MEMORY_SCOPE_AGENT) < need) { __builtin_amdgcn_s_sleep(4); if (++sp > (1u << 22)) break; }
        __builtin_amdgcn_fence(__ATOMIC_ACQUIRE, "agent");
        asm volatile("s_waitcnt vmcnt(0)" ::: "memory");
    }
    __syncthreads();
}

__device__ void transpose_tile(const float* __restrict__ W, int K, int N, bf16_t* __restrict__ Wt, int kt, int nt, float* tile  ) {
    const int tid = otid();
    const int k0 = kt * 64, n0 = nt * 64;
#pragma unroll
    for (int i = 0; i < 4; ++i) {
        const int k = i * 16 + (tid >> 4), n4 = (tid & 15) * 4;
        f32x4 v = (f32x4){0.f, 0.f, 0.f, 0.f};
        if (n0 + n4 < N) v = *(const f32x4*)(W + (size_t)(k0 + k) * N + n0 + n4);
        tile[k * 65 + n4] = v.x; tile[k * 65 + n4 + 1] = v.y; tile[k * 65 + n4 + 2] = v.z; tile[k * 65 + n4 + 3] = v.w;
    }
    __syncthreads();
    {
        const int n = tid >> 2, kc = (tid & 3) * 16;
        unsigned w[8];
#pragma unroll
        for (int j = 0; j < 8; ++j) w[j] = pk2(tile[(kc + 2 * j) * 65 + n], tile[(kc + 2 * j + 1) * 65 + n]);
        u32x4* dst = (u32x4*)(Wt + (size_t)(n0 + n) * K + k0 + kc);
        dst[0] = (u32x4){w[0], w[1], w[2], w[3]}; dst[1] = (u32x4){w[4], w[5], w[6], w[7]};
    }
    __syncthreads();
}

struct ConvP {
    const float* w_in; const float* w_out; const float* w_q; const float* sk; const float* u; const float* v;
    const float* w_up; const float* a_up; const float* g_up;
    unsigned char* ws;
};

__device__ void phase_convert_weights(const ConvP& p, char* smem, int bid, int nblk) {
    float* tile = (float*)smem;
    constexpr int T_IN = 16 * 58, T_OUT = 16 * 16, T_L = T_IN + T_OUT;
    for (int it = bid; it < 2 * T_L; it += nblk) {
        const int l = it / T_L; int r = it % T_L;
        if (r < T_IN) { transpose_tile(p.w_in + (size_t)l * D * DIN, D, DIN, (bf16_t*)(p.ws + WS_WTIN) + (size_t)l * DINP * D, r / 58, r % 58, tile); continue; }
        r -= T_IN;
        transpose_tile(p.w_out + (size_t)l * D * D, D, D, (bf16_t*)(p.ws + WS_WTOUT) + (size_t)l * D * D, r / 16, r % 16, tile);
    }
    const size_t gtid = (size_t)bid * NTHREADS + otid(), gn = (size_t)nblk * NTHREADS;
    {
        for (size_t i = gtid; i < 2ull * 384 * 256; i += gn) {
            const int l = (int)(i / (384 * 256)), r = (int)(i % (384 * 256)), c = r >> 8, k = r & 255;
            bf16_t* base = (bf16_t*)(p.ws + WS_LORA + l * LORA_L);
            if (k < 64) base[c * 64 + k] = f2bf(p.w_up[(size_t)l * 64 * 384 + k * 384 + c]);
            else if (k < 128) base[384 * 64 + c * 64 + (k - 64)] = f2bf(p.a_up[(size_t)l * 64 * 384 + (k - 64) * 384 + c]);
            else base[2 * 384 * 64 + c * 128 + (k - 128)] = f2bf(p.g_up[(size_t)l * 128 * 384 + (k - 128) * 384 + c]);
        }
    }
    {
        float* ct = (float*)(p.ws + WS_ROPE); float* stb = ct + NS * 32;
        for (size_t i = gtid; i < (size_t)NS * 32; i += gn) {
            const int pos = (int)(i >> 5), fi = (int)(i & 31);
            const float inv = exp2f(-(float)fi * (13.287712379549449f / 32.f));
            float sn, cs; sincosf((float)pos * inv, &sn, &cs);
            ct[i] = cs; stb[i] = sn;
        }
    }
    {
        const size_t n8 = (2ull * D * 2048) / 8;
        const f32x4* s = (const f32x4*)p.w_q; u32x4* d = (u32x4*)(p.ws + WS_WTQ);
        for (size_t i = gtid; i < n8; i += gn) { f32x4 a = s[2 * i], b = s[2 * i + 1]; u32x4 o; o.x = pk2(a.x, a.y); o.y = pk2(a.z, a.w); o.z = pk2(b.x, b.y); o.w = pk2(b.z, b.w); d[i] = o; }
    }
    {
        const size_t n8 = (2ull * 16 * 128 * 128) / 8;
        const f32x4* s = (const f32x4*)p.sk; u32x4* d = (u32x4*)(p.ws + WS_SK);
        for (size_t i = gtid; i < n8; i += gn) { f32x4 a = s[2 * i], b = s[2 * i + 1]; u32x4 o; o.x = pk2(a.x, a.y); o.y = pk2(a.z, a.w); o.z = pk2(b.x, b.y); o.w = pk2(b.z, b.w); d[i] = o; }
    }
}

__device__ void phase_convert_uv(const ConvP& p, int bid, int nblk) {
    {
        const int lane = otid() & 63, gw = bid * 4 + (otid() >> 6), ngw = nblk * 4;
        for (int r = gw; r < 4 * NEXP; r += ngw) {
            const bool isv = r >= 2 * NEXP; const int rr = isv ? r - 2 * NEXP : r;
            const f32x4* src = (const f32x4*)((isv ? p.v : p.u) + (size_t)rr * D) + lane * 4;
            f32x4 x[4]; float mx = 0.f;
#pragma unroll
            for (int i = 0; i < 4; ++i) { x[i] = src[i]; mx = fmaxf(mx, fmaxf(fmaxf(fabsf(x[i].x), fabsf(x[i].y)), fmaxf(fabsf(x[i].z), fabsf(x[i].w)))); }
            mx = __uint_as_float(wave_max_u32(__float_as_uint(mx)));
            const float sc = mx > 0.f ? 6.f / mx : 0.f;
            unsigned w0 = 0u, w1 = 0u;
            w0 = __builtin_amdgcn_cvt_scalef32_pk_fp4_f32(w0, x[0].x * sc, x[0].y * sc, 1.0f, 0); w0 = __builtin_amdgcn_cvt_scalef32_pk_fp4_f32(w0, x[0].z * sc, x[0].w * sc, 1.0f, 1);
            w0 = __builtin_amdgcn_cvt_scalef32_pk_fp4_f32(w0, x[1].x * sc, x[1].y * sc, 1.0f, 2); w0 = __builtin_amdgcn_cvt_scalef32_pk_fp4_f32(w0, x[1].z * sc, x[1].w * sc, 1.0f, 3);
            w1 = __builtin_amdgcn_cvt_scalef32_pk_fp4_f32(w1, x[2].x * sc, x[2].y * sc, 1.0f, 0); w1 = __builtin_amdgcn_cvt_scalef32_pk_fp4_f32(w1, x[2].z * sc, x[2].w * sc, 1.0f, 1);
            w1 = __builtin_amdgcn_cvt_scalef32_pk_fp4_f32(w1, x[3].x * sc, x[3].y * sc, 1.0f, 2); w1 = __builtin_amdgcn_cvt_scalef32_pk_fp4_f32(w1, x[3].z * sc, x[3].w * sc, 1.0f, 3);
            *(u32x2*)(p.ws + (isv ? WS_VB : WS_UB) + (size_t)rr * 512 + lane * 8) = (u32x2){w0, w1};
            if (lane == 0) ((float*)(p.ws + WS_ESC))[r] = mx * (1.f / 6.f);
        }
    }
}

template <bool OUT_F32>
__device__ void phase_rmsnorm(const float* x, const float* __restrict__ g, void* out, int bid, int nblk) {
    const int lane = otid() & 63, wave = otid() >> 6;
    const int gw = bid * 4 + wave, ngw = nblk * 4;
    f32x4 gv[4];
#pragma unroll
    for (int j = 0; j < 4; ++j) gv[j] = ((const f32x4*)g)[lane + 64 * j];
    for (int row = gw; row < NT; row += ngw) {
        const f32x4* xr = (const f32x4*)(x + (size_t)row * D) + lane;
        f32x4 v[4]; float s = 0.f;
#pragma unroll
        for (int j = 0; j < 4; ++j) { v[j] = xr[64 * j]; s += v[j].x * v[j].x + v[j].y * v[j].y + v[j].z * v[j].z + v[j].w * v[j].w; }
        s = wave_sum(s);
        const float rs = rsqrtf(s * (1.f / D) + 1e-6f);
        if (OUT_F32) {
            f32x4* o = (f32x4*)((float*)out + (size_t)row * D) + lane;
#pragma unroll
            for (int j = 0; j < 4; ++j) o[64 * j] = v[j] * rs * gv[j];
        } else {
            u32x2* o = (u32x2*)((bf16_t*)out + (size_t)row * D) + lane;
#pragma unroll
            for (int j = 0; j < 4; ++j) { f32x4 y = v[j] * rs * gv[j]; u32x2 w; w.x = pk2(y.x, y.y); w.y = pk2(y.z, y.w); o[64 * j] = w; }
        }
    }
}

struct GemmP {
    const bf16_t* A; int lda; int a_koff;
    int b_koff;
    const bf16_t* Bt; int ldb; int K;
    int MT, NTl;
    void* C; int ldc; const float* R;
};
constexpr int GS = 72;
template <int MODE>
__device__ void phase_gemm(const GemmP& p, char* smem, int bid, int nblk, int tile0 = 0) {
    bf16_t* As = (bf16_t*)smem;
    bf16_t* Bs = As + 128 * GS;
    const int tid = otid(), lane = tid & 63, wave = tid >> 6;
    const int wr = wave >> 1, wc = wave & 1;
    const int lr = tid >> 3, lc = (tid & 7) * 8;
    const int fl = lane & 15, fq = lane >> 4;
    const int ntiles = p.MT * p.NTl;
    for (int tile = bid - tile0 + ((bid < tile0) ? nblk * ((tile0 - bid + nblk - 1) / nblk) : 0); tile < ntiles; tile += nblk) {
        const int mt = tile / p.NTl, nt = tile % p.NTl;
        const bf16_t* Ag = p.A + (size_t)mt * 128 * p.lda + (size_t)nt * p.a_koff + (size_t)lr * p.lda + lc;
        const bf16_t* Bg = p.Bt + (size_t)nt * 128 * p.ldb + (size_t)mt * p.b_koff + (size_t)lr * p.ldb + lc;
        f32x4 acc[4][4];
#pragma unroll
        for (int m = 0; m < 4; ++m)
#pragma unroll
            for (int n = 0; n < 4; ++n) acc[m][n] = (f32x4){0.f, 0.f, 0.f, 0.f};
        u32x4 ra[4], rb[4];
        const int nk = p.K >> 6;
#pragma unroll
        for (int i = 0; i < 4; ++i) { ra[i] = *(const u32x4*)(Ag + (size_t)(32 * i) * p.lda); rb[i] = *(const u32x4*)(Bg + (size_t)(32 * i) * p.ldb); }
        __syncthreads();
#pragma unroll
        for (int i = 0; i < 4; ++i) { *(u32x4*)(As + (lr + 32 * i) * GS + lc) = ra[i]; *(u32x4*)(Bs + (lr + 32 * i) * GS + lc) = rb[i]; }
        if (nk > 1) {
#pragma unroll
            for (int i = 0; i < 4; ++i) { ra[i] = *(const u32x4*)(Ag + (size_t)(32 * i) * p.lda + 64); rb[i] = *(const u32x4*)(Bg + (size_t)(32 * i) * p.ldb + 64); }
        }
        __syncthreads();
        for (int kt = 0; kt < nk; ++kt) {
            const bf16_t* Ac = As + (kt & 1) * (256 * GS); const bf16_t* Bc = Ac + 128 * GS;
            bf16_t* An = As + ((kt & 1) ^ 1) * (256 * GS); bf16_t* Bn = An + 128 * GS;
            if (kt + 1 < nk) {
#pragma unroll
                for (int i = 0; i < 4; ++i) { *(u32x4*)(An + (lr + 32 * i) * GS + lc) = ra[i]; *(u32x4*)(Bn + (lr + 32 * i) * GS + lc) = rb[i]; }
                if (kt + 2 < nk) {
#pragma unroll
                    for (int i = 0; i < 4; ++i) { ra[i] = *(const u32x4*)(Ag + (size_t)(32 * i) * p.lda + (kt + 2) * 64); rb[i] = *(const u32x4*)(Bg + (size_t)(32 * i) * p.ldb + (kt + 2) * 64); }
                }
            }
#pragma unroll
            for (int ks = 0; ks < 2; ++ks) {
                bf16x8 xa[4], wb[4];
#pragma unroll
                for (int m = 0; m < 4; ++m) xa[m] = *(const bf16x8*)(Ac + (wr * 64 + m * 16 + fl) * GS + ks * 32 + fq * 8);
#pragma unroll
                for (int n = 0; n < 4; ++n) wb[n] = *(const bf16x8*)(Bc + (wc * 64 + n * 16 + fl) * GS + ks * 32 + fq * 8);
#pragma unroll
                for (int m = 0; m < 4; ++m)
#pragma unroll
                    for (int n = 0; n < 4; ++n) acc[m][n] = (MODE == 3) ? __builtin_amdgcn_mfma_f32_16x16x32_bf16(xa[m], wb[n], acc[m][n], 0, 0, 0)
                                                                     : __builtin_amdgcn_mfma_f32_16x16x32_bf16(wb[n], xa[m], acc[m][n], 0, 0, 0);
            }
            __syncthreads();
        }
#pragma unroll
        for (int m = 0; m < 4; ++m) {
#pragma unroll
            for (int n = 0; n < 4; ++n) {
                const f32x4 a = acc[m][n];
                if (MODE == 3) {
                    const size_t row = (size_t)mt * 128 + wr * 64 + m * 16 + fq * 4;
                    const size_t col = (size_t)nt * 128 + wc * 64 + n * 16 + fl;
                    *(f32x4*)((float*)p.C + col * p.ldc + row) = a;
                } else {
                    const size_t row = (size_t)mt * 128 + wr * 64 + m * 16 + fl;
                    const int col = nt * 128 + wc * 64 + n * 16 + fq * 4;
                    if (MODE == 0) { u32x2 w; w.x = pk2(a.x, a.y); w.y = pk2(a.z, a.w); *(u32x2*)((bf16_t*)p.C + row * p.ldc + col) = w; }
                    else if (MODE == 1) { *(f32x4*)((float*)p.C + row * p.ldc + col) = a; }
                    else { const f32x4 r = *(const f32x4*)(p.R + row * p.ldc + col); *(f32x4*)((float*)p.C + row * p.ldc + col) = r + a; }
                }
            }
        }
    }
}

constexpr int LS = 72;
struct LinP {
    const bf16_t* Z; bf16_t* O;
    const float* gk_up;
    const float* gk_bias;
    const float* norm_w;
    const float* rope;
    unsigned char* lin;
};
__device__ __forceinline__ bf16x8 ldfrag(const bf16_t* base, int row, int kofs) { return *(const bf16x8*)(base + row * LS + kofs); }

constexpr size_t LN_KV_RET = 0;
constexpr size_t LN_KV_GLA = LN_KV_RET + 1024ull * 64 * 64 * 4;
constexpr size_t LN_S_RET  = LN_KV_GLA + 1024ull * 96 * 64 * 4;
constexpr size_t LN_S_GLA  = LN_S_RET + 1024ull * 64 * 64 * 2;
constexpr size_t LN_DEC    = LN_S_GLA + 1024ull * 96 * 64 * 2;
static_assert(LN_DEC + 2048ull * 64 * 4 <= 64 * MiB, "lin region");

__device__ __forceinline__ float wave_incl_scan(float v) {
    v += dpp_f<0x111>(v); v += dpp_f<0x112>(v); v += dpp_f<0x114>(v); v += dpp_f<0x118>(v);
    v += __int_as_float(__builtin_amdgcn_update_dpp(0, __float_as_int(v), 0x142, 0xA, 0xF, false));
    v += __int_as_float(__builtin_amdgcn_update_dpp(0, __float_as_int(v), 0x143, 0xC, 0xF, false));
    return v;
}
__device__ __forceinline__ float readlane_f(float v, int l) { return __int_as_float(__builtin_amdgcn_readlane(__float_as_int(v), l)); }

__device__ __forceinline__ void rot8(const bf16_t* src, const float* rope, int spos, int cq, unsigned (&o1)[4], unsigned (&o2)[4]) {
    const u32x4 q1 = *(const u32x4*)(src + cq * 8), q2 = *(const u32x4*)(src + 32 + cq * 8);
    const unsigned q1w[4] = {q1.x, q1.y, q1.z, q1.w}, q2w[4] = {q2.x, q2.y, q2.z, q2.w};
    const f32x4 c0 = *(const f32x4*)(rope + spos * 32 + cq * 8), c1 = *(const f32x4*)(rope + spos * 32 + cq * 8 + 4);
    const f32x4 s0 = *(const f32x4*)(rope + NS * 32 + spos * 32 + cq * 8), s1 = *(const f32x4*)(rope + NS * 32 + spos * 32 + cq * 8 + 4);
    const float csv[8] = {c0.x, c0.y, c0.z, c0.w, c1.x, c1.y, c1.z, c1.w}, snv[8] = {s0.x, s0.y, s0.z, s0.w, s1.x, s1.y, s1.z, s1.w};
#pragma unroll
    for (int e = 0; e < 4; ++e) {
        const float a1l = lo_bf(q1w[e]), a1h = hi_bf(q1w[e]), a2l = lo_bf(q2w[e]), a2h = hi_bf(q2w[e]);
        o1[e] = pk2(a1l * csv[2 * e] - a2l * snv[2 * e], a1h * csv[2 * e + 1] - a2h * snv[2 * e + 1]);
        o2[e] = pk2(a1l * snv[2 * e] + a2l * csv[2 * e], a1h * snv[2 * e + 1] + a2h * csv[2 * e + 1]);
    }
}
__device__ __forceinline__ void load_vts(const bf16_t* Z, size_t t0, int voff, int nch, bf16_t* Vts, int tid) {
    for (int x = tid; x < 64 * nch; x += NTHREADS) {
        const int tok = x / nch, ch = x % nch;
        const u32x4 vv = *(const u32x4*)(Z + (t0 + tok) * DINP + voff + ch * 8);
        const unsigned w[4] = {vv.x, vv.y, vv.z, vv.w};
#pragma unroll
        for (int e = 0; e < 4; ++e) { Vts[(ch * 8 + 2 * e) * LS + tok] = (bf16_t)(w[e] & 0xFFFFu); Vts[(ch * 8 + 2 * e + 1) * LS + tok] = (bf16_t)(w[e] >> 16); }
    }
}
__device__ __forceinline__ void load_gd(const bf16_t* zr, float (&gd)[16]) {
    const u32x4 g0 = *(const u32x4*)zr, g1 = *(const u32x4*)(zr + 8);
    gd[0] = lo_bf(g0.x); gd[1] = hi_bf(g0.x); gd[2] = lo_bf(g0.y); gd[3] = hi_bf(g0.y); gd[4] = lo_bf(g0.z); gd[5] = hi_bf(g0.z); gd[6] = lo_bf(g0.w); gd[7] = hi_bf(g0.w);
    gd[8] = lo_bf(g1.x); gd[9] = hi_bf(g1.x); gd[10] = lo_bf(g1.y); gd[11] = hi_bf(g1.y); gd[12] = lo_bf(g1.z); gd[13] = hi_bf(g1.z); gd[14] = lo_bf(g1.w); gd[15] = hi_bf(g1.w);
}
__device__ __forceinline__ float gla_gk(const LinP& p, const float (&gd)[16], int h, int d) {
    float x = p.gk_bias[h * 48 + d];
#pragma unroll
    for (int i = 0; i < 16; ++i) x += gd[i] * p.gk_up[i * 192 + h * 48 + d];
    return (fminf(x, 0.f) - __logf(1.f + __expf(-fabsf(x)))) * (1.f / 16.f);
}
__device__ __forceinline__ float ret_lg(int h) { const float e = exp2f(-5.f - (float)h * (4.f / 3.f)); return log1pf(-e); }

template <bool IS_GLA>
__device__ void lin_kv_task(const LinP& p, char* smem, int b, int h, int c) {
    constexpr int DV = IS_GLA ? 96 : 64, NVB = DV / 16;
    const int koff = IS_GLA ? (ZC_GLA + 192 + h * 48) : (ZC_RET + 256 + h * 64);
    const int voff = IS_GLA ? (ZC_GLA + 384 + h * 96) : (ZC_RET + 512 + h * 64);
    const int gkdoff = ZC_GLA + 768;
    bf16_t* Ks = (bf16_t*)smem;
    bf16_t* Kts = Ks + 64 * LS;
    bf16_t* Vts = Kts + 64 * LS;
    float* decs = (float*)(Vts + 96 * LS);
    const int tid = otid(), lane = tid & 63, wave = tid >> 6;
    const int fl = lane & 15, fq = lane >> 4;
    const size_t t0 = (size_t)b * NS + (size_t)c * 64;
    const int task = (b * 4 + h) * 64 + c;
    __syncthreads();
    if (IS_GLA) {
        for (int x = tid; x < 64 * 6; x += NTHREADS) {
            const int tok = x / 6, ch = x % 6;
            *(u32x4*)(Ks + tok * LS + ch * 8) = *(const u32x4*)(p.Z + (t0 + tok) * DINP + koff + ch * 8);
        }
        for (int x = tid; x < 16 * LS / 2; x += NTHREADS) ((unsigned*)(Kts + 48 * LS))[x] = 0u;
        if (tid < 16) decs[48 + tid] = 1.f;
        load_vts(p.Z, t0, voff, 12, Vts, tid);
    } else {
        const int tok = tid >> 2, cq = tid & 3;
        unsigned k1[4], k2[4];
        rot8(p.Z + (t0 + tok) * DINP + koff, p.rope, c * 64 + tok, cq, k1, k2);
        const float fk2 = 0.125f * __expf(ret_lg(h) * (float)(63 - tok));
#pragma unroll
        for (int e = 0; e < 4; ++e) {
            Kts[(cq * 8 + 2 * e) * LS + tok] = f2bf(lo_bf(k1[e]) * fk2); Kts[(cq * 8 + 2 * e + 1) * LS + tok] = f2bf(hi_bf(k1[e]) * fk2);
            Kts[(32 + cq * 8 + 2 * e) * LS + tok] = f2bf(lo_bf(k2[e]) * fk2); Kts[(32 + cq * 8 + 2 * e + 1) * LS + tok] = f2bf(hi_bf(k2[e]) * fk2);
        }
        if (tid < 64) decs[tid] = __expf(ret_lg(h) * 64.f);
        load_vts(p.Z, t0, voff, 8, Vts, tid);
    }
    __syncthreads();
    if (IS_GLA) {
        float gd[16];
        load_gd(p.Z + (t0 + lane) * DINP + gkdoff, gd);
#pragma unroll 1
        for (int dd = 0; dd < 12; ++dd) {
            const int d = wave * 12 + dd;
            const float bc = wave_incl_scan(gla_gk(p, gd, h, d));
            const float bl = readlane_f(bc, 63);
            Kts[d * LS + lane] = f2bf(bf2f(Ks[lane * LS + d]) * __expf(bl - bc));
            if (lane == 0) decs[d] = __expf(bl);
        }
        __syncthreads();
    }
    float* KV = (float*)(p.lin + (IS_GLA ? LN_KV_GLA : LN_KV_RET)) + (size_t)task * DV * 64;
#pragma unroll
    for (int vb = 0; vb < NVB; ++vb) {
        f32x4 a4 = (f32x4){0.f, 0.f, 0.f, 0.f};
#pragma unroll
        for (int ks = 0; ks < 2; ++ks) {
            const bf16x8 a = ldfrag(Kts, 16 * wave + fl, ks * 32 + fq * 8);
            const bf16x8 bv = ldfrag(Vts, 16 * vb + fl, ks * 32 + fq * 8);
            a4 = __builtin_amdgcn_mfma_f32_16x16x32_bf16(a, bv, a4, 0, 0, 0);
        }
        *(f32x4*)(KV + (size_t)(16 * vb + fl) * 64 + 16 * wave + 4 * fq) = a4;
    }
    if (tid < 64) ((float*)(p.lin + LN_DEC))[(size_t)((IS_GLA ? 1024 : 0) + task) * 64 + tid] = decs[tid];
}

__device__ void lin_scan_phase(const LinP& p, int vbid, int nvblk, unsigned* flags) {
    const int tid = otid();
    for (int it = vbid; it < 160; it += nvblk) {
        const bool gla = it >= 64;
        const int r = gla ? it - 64 : it;
        const int per = gla ? 6 : 4, DVx = gla ? 96 : 64;
        const int bh = r / per, e = (r % per) * 1024 + tid;
        const float* KV = (const float*)(p.lin + (gla ? LN_KV_GLA : LN_KV_RET)) + (size_t)bh * 64 * DVx * 64 + e;
        bf16_t* Sb = (bf16_t*)(p.lin + (gla ? LN_S_GLA : LN_S_RET)) + (size_t)bh * 64 * DVx * 64 + e;
        const float* DEC = (const float*)(p.lin + LN_DEC) + (size_t)((gla ? 1024 : 0) + bh * 64) * 64 + (e & 63);
        float S0 = 0.f, S1 = 0.f, S2 = 0.f, S3 = 0.f;
#pragma unroll 8
        for (int c = 0; c < 64; ++c) {
            const size_t o = (size_t)c * DVx * 64;
            const float k0 = KV[o], k1 = KV[o + 256], k2 = KV[o + 512], k3 = KV[o + 768], dc = DEC[c * 64];
            Sb[o] = f2bf(S0); Sb[o + 256] = f2bf(S1); Sb[o + 512] = f2bf(S2); Sb[o + 768] = f2bf(S3);
            S0 = S0 * dc + k0; S1 = S1 * dc + k1; S2 = S2 * dc + k2; S3 = S3 * dc + k3;
        }
        flag_signal(flags + (gla ? 16 : 0) + bh);
    }
}

template <bool IS_GLA>
__device__ void lin_out_task(const LinP& p, char* smem, int b, int h, int c) {
    constexpr int DV = IS_GLA ? 96 : 64, NVB = DV / 16;
    const int qoff = IS_GLA ? (ZC_GLA + 0 + h * 48) : (ZC_RET + 0 + h * 64);
    const int koff = IS_GLA ? (ZC_GLA + 192 + h * 48) : (ZC_RET + 256 + h * 64);
    const int voff = IS_GLA ? (ZC_GLA + 384 + h * 96) : (ZC_RET + 512 + h * 64);
    const int goff = IS_GLA ? (ZC_GLA + 784 + h * 96) : (ZC_RET + 768 + h * 64);
    const int gkdoff = ZC_GLA + 768;
    const int ooff = IS_GLA ? (640 + h * 96) : (h * 64);
    bf16_t* Qs = (bf16_t*)smem;
    bf16_t* Ks = Qs + 64 * LS;
    bf16_t* Ps = Ks + 64 * LS;
    bf16_t* Vts = Ps + 64 * LS;
    bf16_t* Sts = Vts + 96 * LS;
    const int tid = otid(), lane = tid & 63, wave = tid >> 6;
    const int fl = lane & 15, fq = lane >> 4;
    const size_t t0 = (size_t)b * NS + (size_t)c * 64;
    const int task = (b * 4 + h) * 64 + c;
    __syncthreads();
    {
        const bf16_t* Sb = (const bf16_t*)(p.lin + (IS_GLA ? LN_S_GLA : LN_S_RET)) + (size_t)task * DV * 64;
        for (int x = tid; x < DV * 8; x += NTHREADS) { const int v = x >> 3, ch = x & 7; *(u32x4*)(Sts + v * LS + ch * 8) = *(const u32x4*)(Sb + v * 64 + ch * 8); }
    }
    if (IS_GLA) {
        for (int x = tid; x < 64 * 6; x += NTHREADS) {
            const int tok = x / 6, ch = x % 6;
            const bf16_t* zr = p.Z + (t0 + tok) * DINP;
            *(u32x4*)(Qs + tok * LS + ch * 8) = *(const u32x4*)(zr + qoff + ch * 8);
            *(u32x4*)(Ks + tok * LS + ch * 8) = *(const u32x4*)(zr + koff + ch * 8);
        }
        for (int x = tid; x < 64 * 2; x += NTHREADS) {
            const int tok = x >> 1, ch = 6 + (x & 1);
            *(u32x4*)(Qs + tok * LS + ch * 8) = (u32x4){0u, 0u, 0u, 0u};
            *(u32x4*)(Ks + tok * LS + ch * 8) = (u32x4){0u, 0u, 0u, 0u};
        }
        load_vts(p.Z, t0, voff, 12, Vts, tid);
    } else {
        const int tok = tid >> 2, cq = tid & 3;
        const bf16_t* zr = p.Z + (t0 + tok) * DINP;
        unsigned q1[4], q2[4], k1[4], k2[4];
        rot8(zr + qoff, p.rope, c * 64 + tok, cq, q1, q2);
        rot8(zr + koff, p.rope, c * 64 + tok, cq, k1, k2);
        const float lg = ret_lg(h);
        const float fqd = __expf(lg * (float)(tok + 1)), fk = 0.125f * __expf(-lg * (float)(tok + 1));
#pragma unroll
        for (int e = 0; e < 4; ++e) {
            q1[e] = pk2(lo_bf(q1[e]) * fqd, hi_bf(q1[e]) * fqd); q2[e] = pk2(lo_bf(q2[e]) * fqd, hi_bf(q2[e]) * fqd);
            k1[e] = pk2(lo_bf(k1[e]) * fk, hi_bf(k1[e]) * fk); k2[e] = pk2(lo_bf(k2[e]) * fk, hi_bf(k2[e]) * fk);
        }
        *(u32x4*)(Qs + tok * LS + cq * 8) = (u32x4){q1[0], q1[1], q1[2], q1[3]};
        *(u32x4*)(Qs + tok * LS + 32 + cq * 8) = (u32x4){q2[0], q2[1], q2[2], q2[3]};
        *(u32x4*)(Ks + tok * LS + cq * 8) = (u32x4){k1[0], k1[1], k1[2], k1[3]};
        *(u32x4*)(Ks + tok * LS + 32 + cq * 8) = (u32x4){k2[0], k2[1], k2[2], k2[3]};
        load_vts(p.Z, t0, voff, 8, Vts, tid);
    }
    __syncthreads();
    if (IS_GLA) {
        float gd[16];
        load_gd(p.Z + (t0 + lane) * DINP + gkdoff, gd);
#pragma unroll 1
        for (int dd = 0; dd < 12; ++dd) {
            const int d = wave * 12 + dd;
            const float bc = wave_incl_scan(gla_gk(p, gd, h, d));
            const float eq = __expf(bc) * 0.14433756729740643f  , ek = __expf(-bc);
            Qs[lane * LS + d] = f2bf(bf2f(Qs[lane * LS + d]) * eq);
            Ks[lane * LS + d] = f2bf(bf2f(Ks[lane * LS + d]) * ek);
        }
        __syncthreads();
    }
#pragma unroll
    for (int jb = 0; jb < 4; ++jb) {
        f32x4 ap = (f32x4){0.f, 0.f, 0.f, 0.f};
#pragma unroll
        for (int ks = 0; ks < 2; ++ks) {
            const bf16x8 a = ldfrag(Ks, 16 * jb + fl, ks * 32 + fq * 8);
            const bf16x8 bq = ldfrag(Qs, 16 * wave + fl, ks * 32 + fq * 8);
            ap = __builtin_amdgcn_mfma_f32_16x16x32_bf16(a, bq, ap, 0, 0, 0);
        }
        const int i = 16 * wave + fl, j0 = 16 * jb + 4 * fq;
        u32x2 w;
        w.x = pk2(j0 + 0 <= i ? ap.x : 0.f, j0 + 1 <= i ? ap.y : 0.f);
        w.y = pk2(j0 + 2 <= i ? ap.z : 0.f, j0 + 3 <= i ? ap.w : 0.f);
        *(u32x2*)(Ps + i * LS + j0) = w;
    }
    __syncthreads();
    {
        f32x4 ao[NVB];
        float ss = 0.f;
#pragma unroll
        for (int vb = 0; vb < NVB; ++vb) {
            f32x4 a4 = (f32x4){0.f, 0.f, 0.f, 0.f};
#pragma unroll
            for (int ks = 0; ks < 2; ++ks) {
                const bf16x8 a = ldfrag(Vts, 16 * vb + fl, ks * 32 + fq * 8);
                const bf16x8 bp = ldfrag(Ps, 16 * wave + fl, ks * 32 + fq * 8);
                a4 = __builtin_amdgcn_mfma_f32_16x16x32_bf16(a, bp, a4, 0, 0, 0);
            }
#pragma unroll
            for (int ks = 0; ks < 2; ++ks) {
                const bf16x8 a = ldfrag(Sts, 16 * vb + fl, ks * 32 + fq * 8);
                const bf16x8 bq = ldfrag(Qs, 16 * wave + fl, ks * 32 + fq * 8);
                a4 = __builtin_amdgcn_mfma_f32_16x16x32_bf16(a, bq, a4, 0, 0, 0);
            }
            ao[vb] = a4;
            ss += a4.x * a4.x + a4.y * a4.y + a4.z * a4.z + a4.w * a4.w;
        }
        ss = xor32_sum(xor16_sum(ss));
        const float inv = rsqrtf(ss * (1.f / DV) + 1e-5f);
        const size_t t = t0 + 16 * wave + fl;
#pragma unroll
        for (int vb = 0; vb < NVB; ++vb) {
            const int v0 = 16 * vb + 4 * fq;
            const u32x2 gg = *(const u32x2*)(p.Z + t * DINP + goff + v0);
            float g4[4] = {lo_bf(gg.x), hi_bf(gg.x), lo_bf(gg.y), hi_bf(gg.y)};
            float o4[4] = {ao[vb].x, ao[vb].y, ao[vb].z, ao[vb].w};
#pragma unroll
            for (int e = 0; e < 4; ++e) {
                float y = o4[e] * inv;
                if (IS_GLA) y *= p.norm_w[h * 96 + v0 + e];
                const float g = g4[e];
                o4[e] = y * (g / (1.f + __expf(-g)));
            }
            u32x2 w; w.x = pk2(o4[0], o4[1]); w.y = pk2(o4[2], o4[3]);
            *(u32x2*)(p.O + t * D + ooff + v0) = w;
        }
    }
}
__device__ __forceinline__ void lin_kv_dispatch(const LinP& p, char* smem, int task) {
    const int r = task & 1023, bh = r >> 6, c = r & 63;
    if (task < 1024) lin_kv_task<false>(p, smem, bh >> 2, bh & 3, c); else lin_kv_task<true>(p, smem, bh >> 2, bh & 3, c);
}
__device__ __forceinline__ void lin_out_dispatch(const LinP& p, char* smem, int task, unsigned* flags) {
    const int r = task & 1023, bh = r >> 6, c = r & 63;
    if (flags) flag_wait(flags + (task < 1024 ? 0 : 16) + bh, task < 1024 ? 4u : 6u);
    if (task < 1024) lin_out_task<false>(p, smem, bh >> 2, bh & 3, c); else lin_out_task<true>(p, smem, bh >> 2, bh & 3, c);
}

struct RwP {
    const bf16_t* Z; unsigned char* mix;
    const float* mu; const float* w_up; const float* w_bias; const float* a_up; const float* a_bias; const float* g_up;
    const float* k_k; const float* k_a; const float* r_k; const float* ln_w; const float* ln_b;
    float* oraw; bf16_t* O; bf16_t* Y; const bf16_t* lora;
};
constexpr int PS = 264;
__device__ __forceinline__ f32x4 bf4(u32x2 w) { return (f32x4){lo_bf(w.x), hi_bf(w.x), lo_bf(w.y), hi_bf(w.y)}; }
__device__ void rwkv_prep_task(const RwP& p, char* smem, int tile) {
    bf16_t* At = (bf16_t*)smem;
    const int tid = otid(), lane = tid & 63, wave = tid >> 6;
    const int fl = lane & 15, fq = lane >> 4;
    const int t0 = tile * 32;
    float* Wd = (float*)(p.mix + MX_W); float* KKd = (float*)(p.mix + MX_KK); float* KKAd = (float*)(p.mix + MX_KKA);
    bf16_t* Rd = (bf16_t*)(p.mix + MX_R); bf16_t* Kd = (bf16_t*)(p.mix + MX_K); bf16_t* Vd = (bf16_t*)(p.mix + MX_V); bf16_t* Gd = (bf16_t*)(p.mix + MX_G);
    __syncthreads();
    {
        const int tok = tid >> 3, t = t0 + tok;
        const bool first = (t & (NS - 1)) == 0;
        const bf16_t* zr = p.Z + (size_t)t * DINP + ZC_RW + 1152;
#pragma unroll
        for (int i = 0; i < 4; ++i) {
            const int ch = (tid & 7) + 8 * i;
            const u32x4 cur = *(const u32x4*)(zr + ch * 8);
            const u32x4 prv = first ? (u32x4){0u, 0u, 0u, 0u} : *(const u32x4*)(zr - DINP + ch * 8);
            const f32x4 m0 = *(const f32x4*)(p.mu + 1152 + ch * 8), m1 = *(const f32x4*)(p.mu + 1152 + ch * 8 + 4);
            const unsigned cw[4] = {cur.x, cur.y, cur.z, cur.w}, pw[4] = {prv.x, prv.y, prv.z, prv.w};
            const float mm[8] = {m0.x, m0.y, m0.z, m0.w, m1.x, m1.y, m1.z, m1.w};
            float o[8];
#pragma unroll
            for (int e = 0; e < 4; ++e) {
                const float f0 = lo_bf(cw[e]), f1 = hi_bf(cw[e]), g0 = lo_bf(pw[e]), g1 = hi_bf(pw[e]);
                o[2 * e] = f0 + (g0 - f0) * mm[2 * e]; o[2 * e + 1] = f1 + (g1 - f1) * mm[2 * e + 1];
            }
            if (ch < 8) {
#pragma unroll
                for (int e = 0; e < 8; ++e) o[e] = tanhf_(o[e]);
            } else if (ch >= 16) {
#pragma unroll
                for (int e = 0; e < 8; ++e) o[e] = sigmoidf_(o[e]);
            }
            *(u32x4*)(At + tok * PS + ch * 8) = (u32x4){pk2(o[0], o[1]), pk2(o[2], o[3]), pk2(o[4], o[5]), pk2(o[6], o[7])};
        }
    }
    __syncthreads();
    bf16x8 xb[8];
#pragma unroll
    for (int ks = 0; ks < 8; ++ks) xb[ks] = *(const bf16x8*)(At + (16 * (wave & 1) + fl) * PS + ks * 32 + fq * 8);
    const int t = t0 + 16 * (wave & 1) + fl, b = t >> 12, sq = t & (NS - 1);
    const bool first = sq == 0;
    const bf16_t* zc = p.Z + (size_t)t * DINP + ZC_RW;
    const bf16_t* WupT = p.lora; const bf16_t* AupT = p.lora + 384 * 64; const bf16_t* GupT = p.lora + 2 * 384 * 64;
    const int hd0 = (wave >> 1) * 3;
#pragma unroll
    for (int hi = 0; hi < 3; ++hi) {
        const int hd = hd0 + hi;
        f32x4 aw[4], aa[4], ag[4];
#pragma unroll
        for (int n = 0; n < 4; ++n) {
            const int cr = hd * 64 + 16 * n + fl;
            f32x4 w4 = (f32x4){0.f, 0.f, 0.f, 0.f}, a4 = w4, g4 = w4;
#pragma unroll
            for (int ks = 0; ks < 2; ++ks) {
                w4 = __builtin_amdgcn_mfma_f32_16x16x32_bf16(*(const bf16x8*)(WupT + cr * 64 + ks * 32 + fq * 8), xb[ks], w4, 0, 0, 0);
                a4 = __builtin_amdgcn_mfma_f32_16x16x32_bf16(*(const bf16x8*)(AupT + cr * 64 + ks * 32 + fq * 8), xb[2 + ks], a4, 0, 0, 0);
            }
#pragma unroll
            for (int ks = 0; ks < 4; ++ks) g4 = __builtin_amdgcn_mfma_f32_16x16x32_bf16(*(const bf16x8*)(GupT + cr * 128 + ks * 32 + fq * 8), xb[4 + ks], g4, 0, 0, 0);
            aw[n] = w4; aa[n] = a4; ag[n] = g4;
        }
        f32x4 kx[4], av[4], kkv[4];
        float ss = 0.f;
        const size_t hrow = ((size_t)(b * 6 + hd) * NS + sq) * 64;
#pragma unroll
        for (int n = 0; n < 4; ++n) {
            const int cl = 16 * n + 4 * fq, c = hd * 64 + cl;
            f32x4 rr = bf4(*(const u32x2*)(zc + c)), kk = bf4(*(const u32x2*)(zc + 384 + c)), vv = bf4(*(const u32x2*)(zc + 768 + c));
            f32x4 rp = (f32x4){0.f, 0.f, 0.f, 0.f}, kp = rp, vp = rp;
            if (!first) { rp = bf4(*(const u32x2*)(zc - DINP + c)); kp = bf4(*(const u32x2*)(zc - DINP + 384 + c)); vp = bf4(*(const u32x2*)(zc - DINP + 768 + c)); }
            rr = rr + (rp - rr) * *(const f32x4*)(p.mu + c); kk = kk + (kp - kk) * *(const f32x4*)(p.mu + 384 + c); vv = vv + (vp - vv) * *(const f32x4*)(p.mu + 768 + c);
            const f32x4 wb = *(const f32x4*)(p.w_bias + c), ab = *(const f32x4*)(p.a_bias + c), kkc = *(const f32x4*)(p.k_k + c), kac = *(const f32x4*)(p.k_a + c);
            f32x4 dec, a;
            {
                const f32x4 xw = wb + aw[n], xa = ab + aa[n];
                dec.x = __expf(-__expf(-softplusf_(-xw.x) - 0.5f)); dec.y = __expf(-__expf(-softplusf_(-xw.y) - 0.5f));
                dec.z = __expf(-__expf(-softplusf_(-xw.z) - 0.5f)); dec.w = __expf(-__expf(-softplusf_(-xw.w) - 0.5f));
                a.x = sigmoidf_(xa.x); a.y = sigmoidf_(xa.y); a.z = sigmoidf_(xa.z); a.w = sigmoidf_(xa.w);
            }
            const f32x4 kr = kk * kkc;
            ss += kr.x * kr.x + kr.y * kr.y + kr.z * kr.z + kr.w * kr.w;
            kkv[n] = kr; av[n] = a; kx[n] = kk;
            const f32x4 kmod = kk * ((a - 1.f) * kac + 1.f);
            *(f32x4*)(Wd + hrow + cl) = dec;
            u32x2 w;
            w.x = pk2(rr.x, rr.y); w.y = pk2(rr.z, rr.w); *(u32x2*)(Rd + hrow + cl) = w;
            w.x = pk2(kmod.x, kmod.y); w.y = pk2(kmod.z, kmod.w); *(u32x2*)(Kd + hrow + cl) = w;
            w.x = pk2(vv.x, vv.y); w.y = pk2(vv.z, vv.w); *(u32x2*)(Vd + hrow + cl) = w;
            w.x = pk2(ag[n].x, ag[n].y); w.y = pk2(ag[n].z, ag[n].w); *(u32x2*)(Gd + (size_t)t * 384 + c) = w;
        }
        ss = xor32_sum(xor16_sum(ss));
        const float rn = rsqrtf(fmaxf(ss, 1e-24f));
#pragma unroll
        for (int n = 0; n < 4; ++n) {
            const int cl = 16 * n + 4 * fq;
            const f32x4 kn = kkv[n] * rn;
            *(f32x4*)(KKd + hrow + cl) = kn;
            *(f32x4*)(KKAd + hrow + cl) = kn * av[n];
        }
    }
}

constexpr int SC_STEPS = 16;
constexpr int SEG_BEG[4] = {0, 1376, 2736, 4096};
constexpr size_t MX_SE0 = MX_END;
constexpr size_t MX_XE  = MX_SE0 + 24ull * 3 * 4096 * 4;
constexpr size_t MX_SST = MX_XE + 24ull * 3 * 4096 * 4;
static_assert(MX_SST + 24ull * 3 * 4096 * 2 <= 128 * MiB, "mix region");
__device__ __forceinline__ float row8_sum(float v) { v += dpp_f<0xB1>(v); v += dpp_f<0x4E>(v); v += dpp_f<0x141>(v); return v; }
__device__ void rwkv_scan_task(const RwP& p, char* smem, int bh, int seg, int grp) {
    float* buf = (float*)smem;
    float* obuf = buf + 2 * 6 * SC_STEPS * 64;
    const int tid = otid(), lane = tid & 63, wave = tid >> 6;
    const int rloc = wave * 8 + (lane >> 3);
    const bool ident = grp >= 2;
    const int row = (grp & 1) * 32 + rloc;
    const int c8 = (lane & 7) * 8;
    const int s_beg = seg == 0 ? SEG_BEG[0] : (seg == 1 ? SEG_BEG[1] : SEG_BEG[2]);
    const int s_end = seg == 0 ? SEG_BEG[1] : (seg == 1 ? SEG_BEG[2] : SEG_BEG[3]);
    const int NCH = (s_end - s_beg) / SC_STEPS;
    const size_t hb = ((size_t)bh * NS + s_beg) * 64;
    const float* Wd = (const float*)(p.mix + MX_W) + hb;
    const float* KKd = (const float*)(p.mix + MX_KK) + hb;
    const float* KKAd = (const float*)(p.mix + MX_KKA) + hb;
    const bf16_t* Rd = (const bf16_t*)(p.mix + MX_R) + hb;
    const bf16_t* Kd = (const bf16_t*)(p.mix + MX_K) + hb;
    const bf16_t* Vd = (const bf16_t*)(p.mix + MX_V) + hb;
    float* orow = p.oraw + hb;
    bf16_t* yrow = p.Y + hb;
    f32x4 Sa, Sb;
    Sa.x = (ident && c8 + 0 == row) ? 1.f : 0.f; Sa.y = (ident && c8 + 1 == row) ? 1.f : 0.f; Sa.z = (ident && c8 + 2 == row) ? 1.f : 0.f; Sa.w = (ident && c8 + 3 == row) ? 1.f : 0.f;
    Sb.x = (ident && c8 + 4 == row) ? 1.f : 0.f; Sb.y = (ident && c8 + 5 == row) ? 1.f : 0.f; Sb.z = (ident && c8 + 6 == row) ? 1.f : 0.f; Sb.w = (ident && c8 + 7 == row) ? 1.f : 0.f;
    struct Stg { f32x4 w, kk, ka; u32x2 r, k, v; };
    Stg sA, sB;
    auto gload = [&](Stg& g, int ch) {
        const size_t e = (size_t)ch * SC_STEPS * 64 + tid * 4;
        g.w = *(const f32x4*)(Wd + e); g.kk = *(const f32x4*)(KKd + e); g.ka = *(const f32x4*)(KKAd + e);
        g.r = *(const u32x2*)(Rd + e); g.k = *(const u32x2*)(Kd + e); g.v = *(const u32x2*)(Vd + e);
    };
    auto lstore = [&](const Stg& g, int bsel) {
        float* bb = buf + bsel * 6 * SC_STEPS * 64 + tid * 4;
        *(f32x4*)(bb + 0 * SC_STEPS * 64) = g.w; *(f32x4*)(bb + 1 * SC_STEPS * 64) = g.kk; *(f32x4*)(bb + 2 * SC_STEPS * 64) = g.ka;
        *(f32x4*)(bb + 3 * SC_STEPS * 64) = (f32x4){lo_bf(g.r.x), hi_bf(g.r.x), lo_bf(g.r.y), hi_bf(g.r.y)};
        *(f32x4*)(bb + 4 * SC_STEPS * 64) = (f32x4){lo_bf(g.k.x), hi_bf(g.k.x), lo_bf(g.k.y), hi_bf(g.k.y)};
        *(f32x4*)(bb + 5 * SC_STEPS * 64) = (f32x4){lo_bf(g.v.x), hi_bf(g.v.x), lo_bf(g.v.y), hi_bf(g.v.y)};
    };
    __syncthreads();
    gload(sA, 0); lstore(sA, 0);
    gload(sA, 1);
    __syncthreads();
    const float vmask = ident ? 0.f : 1.f;
    struct Ops { f32x4 w0, w1, kk0, kk1, ka0, ka1, r0, r1, k0, k1; float v; };
    auto ldops = [&](Ops& o, const float* bb, int st) {
        const float* q = bb + st * 64 + c8;
        o.w0 = *(const f32x4*)(q); o.w1 = *(const f32x4*)(q + 4);
        o.kk0 = *(const f32x4*)(q + 1 * SC_STEPS * 64); o.kk1 = *(const f32x4*)(q + 1 * SC_STEPS * 64 + 4);
        o.ka0 = *(const f32x4*)(q + 2 * SC_STEPS * 64); o.ka1 = *(const f32x4*)(q + 2 * SC_STEPS * 64 + 4);
        o.r0 = *(const f32x4*)(q + 3 * SC_STEPS * 64); o.r1 = *(const f32x4*)(q + 3 * SC_STEPS * 64 + 4);
        o.k0 = *(const f32x4*)(q + 4 * SC_STEPS * 64); o.k1 = *(const f32x4*)(q + 4 * SC_STEPS * 64 + 4);
        o.v = bb[5 * SC_STEPS * 64 + st * 64 + row];
    };
    auto chunk = [&](int ch, Stg& cur  , Stg& nxt  ) {
        if (ch + 2 < NCH) gload(nxt, ch + 2);
        const float* bb = buf + (ch & 1) * 6 * SC_STEPS * 64;
        Ops o; ldops(o, bb, 0);
#pragma unroll
        for (int st = 0; st < SC_STEPS; ++st) {
            Ops n; ldops(n, bb, (st + 1 < SC_STEPS) ? st + 1 : st);
            const float vx = o.v * vmask;
            const f32x4 pa = Sa * o.kk0 + Sb * o.kk1;
            const float sa = -row8_sum((pa.x + pa.y) + (pa.z + pa.w));
            Sa = Sa * o.w0 + o.k0 * vx + o.ka0 * sa;
            Sb = Sb * o.w1 + o.k1 * vx + o.ka1 * sa;
            const f32x4 qa = Sa * o.r0 + Sb * o.r1;
            obuf[st * 32 + rloc] = row8_sum((qa.x + qa.y) + (qa.z + qa.w));
            o = n;
        }
        __syncthreads();
#pragma unroll
        for (int i = 0; i < 2; ++i) {
            const int idx = tid + 256 * i, st = idx >> 5, rr = idx & 31;
            const size_t oi = ((size_t)ch * SC_STEPS + st) * 64 + (grp & 1) * 32 + rr;
            if (ident) yrow[oi] = f2bf(obuf[idx]); else orow[oi] = obuf[idx];
        }
        if (ch + 1 < NCH) lstore(cur, (ch + 1) & 1);
        __syncthreads();
    };
    for (int ch = 0; ch < NCH; ch += 2) {
        chunk(ch, sA, sB);
        if (ch + 1 < NCH) chunk(ch + 1, sB, sA);
    }
    float* fin = (float*)(p.mix + (ident ? MX_XE : MX_SE0)) + ((size_t)(bh * 3 + seg) * 64 + row) * 64 + c8;
    *(f32x4*)fin = Sa; *(f32x4*)(fin + 4) = Sb;
}

__device__ void phase_rwkv_chain(const RwP& p, int bid, int nblk) {
    const int lane = otid() & 63, wave = otid() >> 6;
    const float* SE0 = (const float*)(p.mix + MX_SE0); const float* XE = (const float*)(p.mix + MX_XE);
    bf16_t* SST = (bf16_t*)(p.mix + MX_SST);
    for (int x = bid * 4 + wave; x < 24 * 4; x += nblk * 4) {
        const int bh = x >> 2, cg = (x & 3) * 16;
        const float* s1 = SE0 + ((size_t)(bh * 3 + 0) * 64 + lane) * 64;
        const float* e1 = SE0 + ((size_t)(bh * 3 + 1) * 64 + lane) * 64 + cg;
        const float* X1 = XE + (size_t)(bh * 3 + 1) * 4096 + cg;
        float o[16];
#pragma unroll
        for (int k = 0; k < 16; ++k) o[k] = e1[k];
        for (int i = 0; i < 64; ++i) {
            const float si = s1[i];
#pragma unroll
            for (int k = 0; k < 16; ++k) o[k] += si * X1[i * 64 + k];
        }
        bf16_t* d1 = SST + ((size_t)(bh * 3 + 1) * 64 + lane) * 64 + cg;
        bf16_t* d2 = SST + ((size_t)(bh * 3 + 2) * 64 + lane) * 64 + cg;
#pragma unroll
        for (int k = 0; k < 16; ++k) { d1[k] = f2bf(s1[cg + k]); d2[k] = f2bf(o[k]); }
    }
}

__device__ void phase_rwkv_post(const RwP& p, int bid, int nblk) {
    const int lane = otid() & 63, wave = otid() >> 6;
    const int fl = lane & 15, fq = lane >> 4;
    const bf16_t* Rd = (const bf16_t*)(p.mix + MX_R); const bf16_t* Kd = (const bf16_t*)(p.mix + MX_K); const bf16_t* Vd = (const bf16_t*)(p.mix + MX_V);
    const bf16_t* Gd = (const bf16_t*)(p.mix + MX_G); const bf16_t* SST = (const bf16_t*)(p.mix + MX_SST);
    for (int x = bid * 4 + wave; x < 24 * (NS / 16); x += nblk * 4) {
        const int bh = x / (NS / 16), s0 = (x % (NS / 16)) * 16;
        const int b = bh / 6, hd = bh % 6;
        const int seg = s0 < SEG_BEG[1] ? 0 : (s0 < SEG_BEG[2] ? 1 : 2);
        const size_t hrow = ((size_t)bh * NS + s0 + fl) * 64;
        f32x4 acc[4];
#pragma unroll
        for (int n = 0; n < 4; ++n) acc[n] = *(const f32x4*)(p.oraw + hrow + 16 * n + 4 * fq);
        if (seg > 0) {
            const bf16_t* ss = SST + (size_t)(bh * 3 + seg) * 4096;
#pragma unroll
            for (int ks = 0; ks < 2; ++ks) {
                const bf16x8 yb = *(const bf16x8*)(p.Y + hrow + ks * 32 + fq * 8);
#pragma unroll
                for (int n = 0; n < 4; ++n) {
                    const bf16x8 sa = *(const bf16x8*)(ss + (size_t)(16 * n + fl) * 64 + ks * 32 + fq * 8);
                    acc[n] = __builtin_amdgcn_mfma_f32_16x16x32_bf16(sa, yb, acc[n], 0, 0, 0);
                }
            }
        }
        float sm = 0.f;
#pragma unroll
        for (int n = 0; n < 4; ++n) sm += acc[n].x + acc[n].y + acc[n].z + acc[n].w;
        const float mean = xor32_sum(xor16_sum(sm)) * (1.f / 64.f);
        float sv = 0.f;
#pragma unroll
        for (int n = 0; n < 4; ++n) { acc[n] = acc[n] - mean; sv += acc[n].x * acc[n].x + acc[n].y * acc[n].y + acc[n].z * acc[n].z + acc[n].w * acc[n].w; }
        const float rstd = rsqrtf(xor32_sum(xor16_sum(sv)) * (1.f / 64.f) + 64e-5f);
        float rk = 0.f; f32x4 vv[4];
#pragma unroll
        for (int n = 0; n < 4; ++n) {
            const int c = 16 * n + 4 * fq;
            const u32x2 r2 = *(const u32x2*)(Rd + hrow + c), k2 = *(const u32x2*)(Kd + hrow + c), v2 = *(const u32x2*)(Vd + hrow + c);
            const f32x4 rkw = *(const f32x4*)(p.r_k + hd * 64 + c);
            rk += lo_bf(r2.x) * lo_bf(k2.x) * rkw.x + hi_bf(r2.x) * hi_bf(k2.x) * rkw.y + lo_bf(r2.y) * lo_bf(k2.y) * rkw.z + hi_bf(r2.y) * hi_bf(k2.y) * rkw.w;
            vv[n] = (f32x4){lo_bf(v2.x), hi_bf(v2.x), lo_bf(v2.y), hi_bf(v2.y)};
        }
        rk = xor32_sum(xor16_sum(rk));
        const size_t t = (size_t)b * NS + s0 + fl;
#pragma unroll
        for (int n = 0; n < 4; ++n) {
            const int c = 16 * n + 4 * fq;
            const f32x4 lw = *(const f32x4*)(p.ln_w + hd * 64 + c), lb = *(const f32x4*)(p.ln_b + hd * 64 + c);
            const u32x2 g2 = *(const u32x2*)(Gd + t * 384 + hd * 64 + c);
            const f32x4 gg = (f32x4){lo_bf(g2.x), hi_bf(g2.x), lo_bf(g2.y), hi_bf(g2.y)};
            const f32x4 o = (acc[n] * rstd * lw + lb + vv[n] * rk) * gg;
            u32x2 w; w.x = pk2(o.x, o.y); w.y = pk2(o.z, o.w);
            *(u32x2*)(p.O + t * D + 256 + hd * 64 + c) = w;
        }
    }
}

__device__ __forceinline__ unsigned ordkey(float f) { const unsigned u = __float_as_uint(f); return (u & 0x80000000u) ? ~u : (u | 0x80000000u); }
__device__ __forceinline__ float unordkey(unsigned k) { return __uint_as_float((k & 0x80000000u) ? (k & 0x7FFFFFFFu) : ~k); }
__device__ __forceinline__ void ins16(unsigned (&L)[16], unsigned x) {
#pragma unroll
    for (int i = 0; i < 16; ++i) { const unsigned hi = L[i] > x ? L[i] : x; x = L[i] > x ? x : L[i]; L[i] = hi; }
}
__device__ __forceinline__ void top16_col(const float* col  , unsigned (&L)[16]) {
#pragma unroll
    for (int i = 0; i < 16; ++i) L[i] = 0u;
#pragma unroll 1
    for (int n0 = 0; n0 < 128; n0 += 16) {
        float x[16];
#pragma unroll
        for (int j = 0; j < 16; ++j) x[j] = col[(size_t)(n0 + j) * NT];
#pragma unroll
        for (int j = 0; j < 16; ++j) ins16(L, (ordkey(x[j]) & 0xFFFFFF80u) | (unsigned)(127 - (n0 + j)));
    }
}
__device__ void phase_topk(const float* SCT, int* EIDX, float* GATE, char* smem, int bid, int nblk) {
    const int tid = otid(), lane = tid & 63, wave = tid >> 6;
    unsigned char* itab = (unsigned char*)smem + tid * 32;
    unsigned char* ctab = (unsigned char*)smem + NTHREADS * 32;
    __syncthreads();
    if (tid < 64) {
        const int c = tid; int ci, cj;
        if (c < 16) { ci = 0; cj = c; } else if (c < 24) { ci = 1; cj = c - 16; } else if (c < 29) { ci = 2; cj = c - 24; } else if (c < 33) { ci = 3; cj = c - 29; }
        else if (c < 36) { ci = 4; cj = c - 33; } else if (c < 38) { ci = 5; cj = c - 36; } else if (c < 40) { ci = 6; cj = c - 38; } else if (c < 42) { ci = 7; cj = c - 40; }
        else if (c < 50) { ci = c - 34; cj = 0; } else { ci = 0; cj = 0; }
        ctab[c] = (unsigned char)(ci | (cj << 4));
    }
    __syncthreads();
    for (int x = bid * 4 + wave; x < (NT / 64) * 8; x += nblk * 4) {
        const int tb = x >> 3, hd = x & 7;
        const int t = tb * 64 + lane;
        unsigned L1[16], L2[16];
        top16_col(SCT + (size_t)(hd * 256) * NT + t, L1);
        top16_col(SCT + (size_t)(hd * 256 + 128) * NT + t, L2);
        float s1[16], s2[16];
#pragma unroll
        for (int i = 0; i < 16; ++i) {
            s1[i] = unordkey(L1[i] & 0xFFFFFF80u); s2[i] = unordkey(L2[i] & 0xFFFFFF80u);
            itab[i] = (unsigned char)(127u - (L1[i] & 127u)); itab[16 + i] = (unsigned char)(127u - (L2[i] & 127u));
        }
        unsigned M[16];
#pragma unroll
        for (int i = 0; i < 16; ++i) M[i] = 0u;
        int c = 0;
#pragma unroll
        for (int ci = 0; ci < 16; ++ci) {
#pragma unroll
            for (int cj = 0; cj < 16; ++cj) {
                if ((ci + 1) * (cj + 1) <= 16) {
                    const int cid = (ci == 0) ? cj : (ci == 1) ? 16 + cj : (ci == 2) ? 24 + cj : (ci == 3) ? 29 + cj : (ci == 4) ? 33 + cj : (ci == 5) ? 36 + cj : (ci == 6) ? 38 + cj : (ci == 7) ? 40 + cj : 34 + ci;
                    ins16(M, (ordkey(s1[ci] + s2[cj]) & 0xFFFFFFC0u) | (unsigned)(63 - cid));
                    ++c;
                }
            }
        }
        float ev[16]; int ee[16];
        const float mx = unordkey(M[0] & 0xFFFFFFC0u);
        float sum = 0.f;
#pragma unroll
        for (int i = 0; i < 16; ++i) {
            const int cid = 63 - (int)(M[i] & 63u);
            const unsigned cc = ctab[cid];
            ee[i] = (int)itab[cc & 15u] * 128 + (int)itab[16 + (cc >> 4)];
            ev[i] = __expf(unordkey(M[i] & 0xFFFFFFC0u) - mx);
            sum += ev[i];
        }
        const float inv = 1.f / sum;
        int* eo = EIDX + (size_t)t * 128 + hd * 16; float* go = GATE + (size_t)t * 128 + hd * 16;
#pragma unroll
        for (int i = 0; i < 4; ++i) {
            *(int4*)(eo + 4 * i) = make_int4(ee[4 * i], ee[4 * i + 1], ee[4 * i + 2], ee[4 * i + 3]);
            *(f32x4*)(go + 4 * i) = (f32x4){ev[4 * i] * inv, ev[4 * i + 1] * inv, ev[4 * i + 2] * inv, ev[4 * i + 3] * inv};
        }
    }
    __syncthreads();
}

typedef float f32x2 __attribute__((ext_vector_type(2)));
__device__ __forceinline__ float gelu_erf(float d) { return 0.5f * d * (1.f + erff(d * 0.7071067811865476f)); }
template <int NMODE>
__device__ void phase_expert(const bf16_t* H, const unsigned char* U4, const unsigned char* V4, const float* SU, const float* SV, const int* EIDX, const float* GATE,
                             const float* X, float* Xo, const float* gn, bf16_t* Hn, int bid, int nblk) {
    const int lane = otid() & 63, wave = otid() >> 6;
    for (int t = bid * 4 + wave; t < NT; t += nblk * 4) {
        f32x2 xf[8], acc[8];
        {
            const u32x4 a = *(const u32x4*)(H + (size_t)t * D + lane * 16), b = *(const u32x4*)(H + (size_t)t * D + lane * 16 + 8);
            xf[0] = (f32x2){lo_bf(a.x), hi_bf(a.x)}; xf[1] = (f32x2){lo_bf(a.y), hi_bf(a.y)}; xf[2] = (f32x2){lo_bf(a.z), hi_bf(a.z)}; xf[3] = (f32x2){lo_bf(a.w), hi_bf(a.w)};
            xf[4] = (f32x2){lo_bf(b.x), hi_bf(b.x)}; xf[5] = (f32x2){lo_bf(b.y), hi_bf(b.y)}; xf[6] = (f32x2){lo_bf(b.z), hi_bf(b.z)}; xf[7] = (f32x2){lo_bf(b.w), hi_bf(b.w)};
        }
#pragma unroll
        for (int i = 0; i < 8; ++i) acc[i] = (f32x2){0.f, 0.f};
        const int e_lo = EIDX[(size_t)t * 128 + lane], e_hi = EIDX[(size_t)t * 128 + 64 + lane];
        const float g_lo = GATE[(size_t)t * 128 + lane] * SV[e_lo], g_hi = GATE[(size_t)t * 128 + 64 + lane] * SV[e_hi];
        const float su_lo = SU[e_lo], su_hi = SU[e_hi];
#pragma unroll 1
        for (int e0 = 0; e0 < 128; e0 += 16) {
            const int esrc = (e0 < 64) ? e_lo : e_hi;
            int ei[16]; u32x2 ur[16];
#pragma unroll
            for (int j = 0; j < 16; ++j) { ei[j] = __builtin_amdgcn_readlane(esrc, (e0 & 63) + j); ur[j] = *(const u32x2*)(U4 + (size_t)ei[j] * 512 + lane * 8); }
            float dmine = 0.f;
#pragma unroll
            for (int j = 0; j < 16; ++j) {
                f32x2 d2 = (f32x2){0.f, 0.f};
                d2 = __builtin_elementwise_fma(xf[0], __builtin_amdgcn_cvt_scalef32_pk_f32_fp4(ur[j].x, 1.0f, 0), d2);
                d2 = __builtin_elementwise_fma(xf[1], __builtin_amdgcn_cvt_scalef32_pk_f32_fp4(ur[j].x, 1.0f, 1), d2);
                d2 = __builtin_elementwise_fma(xf[2], __builtin_amdgcn_cvt_scalef32_pk_f32_fp4(ur[j].x, 1.0f, 2), d2);
                d2 = __builtin_elementwise_fma(xf[3], __builtin_amdgcn_cvt_scalef32_pk_f32_fp4(ur[j].x, 1.0f, 3), d2);
                d2 = __builtin_elementwise_fma(xf[4], __builtin_amdgcn_cvt_scalef32_pk_f32_fp4(ur[j].y, 1.0f, 0), d2);
                d2 = __builtin_elementwise_fma(xf[5], __builtin_amdgcn_cvt_scalef32_pk_f32_fp4(ur[j].y, 1.0f, 1), d2);
                d2 = __builtin_elementwise_fma(xf[6], __builtin_amdgcn_cvt_scalef32_pk_f32_fp4(ur[j].y, 1.0f, 2), d2);
                d2 = __builtin_elementwise_fma(xf[7], __builtin_amdgcn_cvt_scalef32_pk_f32_fp4(ur[j].y, 1.0f, 3), d2);
                const float d = wave_sum(d2.x + d2.y);
                if (lane == (e0 & 63) + j) dmine = d;
            }
            const float amine = gelu_erf(dmine * ((e0 < 64) ? su_lo : su_hi)) * ((e0 < 64) ? g_lo : g_hi);
#pragma unroll
            for (int j = 0; j < 16; ++j) ur[j] = *(const u32x2*)(V4 + (size_t)ei[j] * 512 + lane * 8);
#pragma unroll
            for (int j = 0; j < 16; ++j) {
                const float a = __int_as_float(__builtin_amdgcn_readlane(__float_as_int(amine), (e0 & 63) + j));
                const f32x2 a2 = (f32x2){a, a};
                acc[0] = __builtin_elementwise_fma(a2, __builtin_amdgcn_cvt_scalef32_pk_f32_fp4(ur[j].x, 1.0f, 0), acc[0]);
                acc[1] = __builtin_elementwise_fma(a2, __builtin_amdgcn_cvt_scalef32_pk_f32_fp4(ur[j].x, 1.0f, 1), acc[1]);
                acc[2] = __builtin_elementwise_fma(a2, __builtin_amdgcn_cvt_scalef32_pk_f32_fp4(ur[j].x, 1.0f, 2), acc[2]);
                acc[3] = __builtin_elementwise_fma(a2, __builtin_amdgcn_cvt_scalef32_pk_f32_fp4(ur[j].x, 1.0f, 3), acc[3]);
                acc[4] = __builtin_elementwise_fma(a2, __builtin_amdgcn_cvt_scalef32_pk_f32_fp4(ur[j].y, 1.0f, 0), acc[4]);
                acc[5] = __builtin_elementwise_fma(a2, __builtin_amdgcn_cvt_scalef32_pk_f32_fp4(ur[j].y, 1.0f, 1), acc[5]);
                acc[6] = __builtin_elementwise_fma(a2, __builtin_amdgcn_cvt_scalef32_pk_f32_fp4(ur[j].y, 1.0f, 2), acc[6]);
                acc[7] = __builtin_elementwise_fma(a2, __builtin_amdgcn_cvt_scalef32_pk_f32_fp4(ur[j].y, 1.0f, 3), acc[7]);
            }
        }
        const f32x4* xr = (const f32x4*)(X + (size_t)t * D) + lane * 4;
        f32x4* xo = (f32x4*)(Xo + (size_t)t * D) + lane * 4;
        f32x4 o[4]; float ss = 0.f;
#pragma unroll
        for (int i = 0; i < 4; ++i) { o[i] = xr[i]; o[i] += (f32x4){acc[2 * i].x, acc[2 * i].y, acc[2 * i + 1].x, acc[2 * i + 1].y}; ss += o[i].x * o[i].x + o[i].y * o[i].y + o[i].z * o[i].z + o[i].w * o[i].w; }
        const float rs = rsqrtf(wave_sum(ss) * (1.f / D) + 1e-6f);
        const f32x4* gp = (const f32x4*)gn + lane * 4;
        if (NMODE == 1) {
#pragma unroll
            for (int i = 0; i < 4; ++i) xo[i] = o[i] * rs * gp[i];
        } else {
            u32x4 h0, h1;
            { const f32x4 y0 = o[0] * rs * gp[0], y1 = o[1] * rs * gp[1], y2 = o[2] * rs * gp[2], y3 = o[3] * rs * gp[3];
              h0 = (u32x4){pk2(y0.x, y0.y), pk2(y0.z, y0.w), pk2(y1.x, y1.y), pk2(y1.z, y1.w)}; h1 = (u32x4){pk2(y2.x, y2.y), pk2(y2.z, y2.w), pk2(y3.x, y3.y), pk2(y3.z, y3.w)}; }
#pragma unroll
            for (int i = 0; i < 4; ++i) xo[i] = o[i];
            *(u32x4*)(Hn + (size_t)t * D + lane * 16) = h0; *(u32x4*)(Hn + (size_t)t * D + lane * 16 + 8) = h1;
        }
    }
}

#define XB_TMO      128
#define XB_XCNT(j)  (256  + 64 * (j))
#define XB_XSUB(j)  (1280 + 64 * (j))
#define XB_XGEN(j)  (2304 + 64 * (j))
#define XB_TOP      3328
#define XB_TOPGEN   3392
#define XCD_BAR_WORDS 3456
#define XB_SPIN_CAP (1u << 22)
#define LAS __attribute__((address_space(3)))
__device__ __forceinline__ unsigned xb_ld(unsigned* p)              { return __hip_atomic_load(p, __ATOMIC_RELAXED, __HIP_MEMORY_SCOPE_AGENT); }
__device__ __forceinline__ unsigned xb_add(unsigned* p, unsigned v) { return __hip_atomic_fetch_add(p, v, __ATOMIC_RELAXED, __HIP_MEMORY_SCOPE_AGENT); }
__device__ __forceinline__ unsigned xb_xcc_id() { return (unsigned)__builtin_amdgcn_s_getreg((3 << 11) | 20) & 0xFu; }
#define XB_SPIN(cond, bar) do { unsigned _sp = 0; while (cond) { __builtin_amdgcn_s_sleep(1); \
    if ((++_sp & 255u) == 0u) { if (xb_ld(&(bar)[XB_TMO])) break; if (_sp > XB_SPIN_CAP) { atomicAdd(&(bar)[XB_TMO], 1u); break; } } } } while (0)
struct XcdBarrier { unsigned* bar; unsigned x; volatile LAS unsigned* st; };
__device__ __forceinline__ XcdBarrier xcd_barrier_post(unsigned* bar, volatile LAS unsigned* st) {
    XcdBarrier b; b.bar = bar; b.x = xb_xcc_id(); b.st = st;
    if (threadIdx.x == 0) (void)xb_add(&bar[XB_XCNT(b.x)], 1u);
    return b;
}
__device__ __forceinline__ void xcd_barrier_complete(unsigned* bar, unsigned x, unsigned& nloc, unsigned& nx) {
    const unsigned G = gridDim.x * gridDim.y * gridDim.z;
    unsigned sum, cnt, mine, sp = 0u;
    for (;;) {
        sum = 0u; cnt = 0u; mine = 0u;
#pragma unroll
        for (unsigned j = 0; j < 16; ++j) { const unsigned c = xb_ld(&bar[XB_XCNT(j)]); sum += c; cnt += (c > 0u) ? 1u : 0u; mine = (j == x) ? c : mine; }
        if (sum == G) break;
        __builtin_amdgcn_s_sleep(1);
        if ((++sp & 255u) == 0u) { if (xb_ld(&bar[XB_TMO])) break; if (sp > XB_SPIN_CAP) { atomicAdd(&bar[XB_TMO], 1u); break; } }
    }
    nloc = mine > 0u ? mine : 1u; nx = cnt > 0u ? cnt : 1u;
}
__device__ __forceinline__ void xcd_barrier(const XcdBarrier& b) {
    asm volatile("s_waitcnt vmcnt(0)" ::: "memory");
    __syncthreads();
    if (threadIdx.x == 0) {
        unsigned* bar = b.bar;
        __builtin_amdgcn_s_waitcnt(0);
        unsigned nloc = b.st[0], nx = b.st[1];
        if (nloc == 0u) { xcd_barrier_complete(bar, b.x, nloc, nx); b.st[0] = nloc; b.st[1] = nx; }
        const unsigned old = xb_add(&bar[XB_XSUB(b.x)], 1u);
        const unsigned gen = old / nloc;
        if (old + 1u == (gen + 1u) * nloc) {
            __builtin_amdgcn_fence(__ATOMIC_RELEASE, "agent");
            asm volatile("s_waitcnt vmcnt(0)" ::: "memory");
            const unsigned og = xb_add(&bar[XB_TOP], 1u);
            const unsigned tg = og / nx;
            if (og + 1u == (tg + 1u) * nx) xb_add(&bar[XB_TOPGEN], 1u);
            else XB_SPIN(xb_ld(&bar[XB_TOPGEN]) == tg, bar);
            __builtin_amdgcn_fence(__ATOMIC_ACQUIRE, "agent");
            xb_add(&bar[XB_XGEN(b.x)], 1u);
            asm volatile("s_waitcnt vmcnt(0)" ::: "memory");
        } else {
            XB_SPIN(xb_ld(&bar[XB_XGEN(b.x)]) == gen, bar);
            __builtin_amdgcn_fence(__ATOMIC_ACQUIRE, "agent");
            asm volatile("s_waitcnt vmcnt(0)" ::: "memory");
        }
    }
    __syncthreads();
}

struct Params {
    const float* in[24];
    float* out; unsigned char* ws;
};
constexpr int LDS_BYTES = 2 * 2 * 128 * GS * 2 + 256;

__device__ __forceinline__ RwP make_rwp(const Params& P, int l) {
    RwP r;
    r.Z = (const bf16_t*)(P.ws + WS_Z); r.mix = P.ws + WS_MIX;
    r.mu = P.in[6] + l * RW_F; r.w_up = P.in[7] + (size_t)l * 64 * 384; r.w_bias = P.in[8] + l * 384; r.a_up = P.in[9] + (size_t)l * 64 * 384; r.a_bias = P.in[10] + l * 384;
    r.g_up = P.in[11] + (size_t)l * 128 * 384; r.k_k = P.in[12] + l * 384; r.k_a = P.in[13] + l * 384; r.r_k = P.in[14] + l * 384; r.ln_w = P.in[15] + l * 384; r.ln_b = P.in[16] + l * 384;
    r.oraw = (float*)(P.ws + WS_H); r.O = (bf16_t*)(P.ws + WS_O); r.Y = (bf16_t*)(P.ws + WS_EIDX); r.lora = (const bf16_t*)(P.ws + WS_LORA + l * LORA_L);
    return r;
}

__global__ void __launch_bounds__(NTHREADS, 2) mega_fwd(Params P) {
    extern __shared__ __attribute__((aligned(16))) char smem[];
    const int bid = blockIdx.x, nblk = gridDim.x;
    volatile LAS unsigned* st = (volatile LAS unsigned*)(smem + LDS_BYTES - 16);
    if (threadIdx.x == 0) { st[0] = 0u; st[1] = 0u; st[2] = 0u; st[3] = 0u; }
    __syncthreads();
    XcdBarrier bar = xcd_barrier_post((unsigned*)(P.ws + WS_CTL), st);
#define GSYNC() xcd_barrier(bar)

    {
        ConvP c{P.in[4], P.in[5], P.in[20], P.in[21], P.in[22], P.in[23], P.in[7], P.in[9], P.in[11], P.ws};
        phase_convert_weights(c, smem, bid, nblk);
        phase_rmsnorm<false>(P.in[0], P.in[1], P.ws + WS_H, bid, nblk);
    }
    GSYNC();
#pragma unroll 1
    for (int l = 0; l < 2; ++l) {
        const float* xin = (l == 0) ? P.in[0] : P.out;
        {
            GemmP g{(const bf16_t*)(P.ws + WS_H), D, 0, 0, (const bf16_t*)(P.ws + WS_WTIN) + (size_t)l * DINP * D, D, D, NT / 128, DINP / 128, P.ws + WS_Z, DINP, nullptr};
            phase_gemm<0>(g, smem, bid, nblk);
            if (l == 0) {
                for (int l2 = 0; l2 < 2; ++l2) {
                    GemmP ge{(const bf16_t*)(P.ws + WS_SK) + (size_t)l2 * 16 * 128 * 128, 128, 0, 128, (const bf16_t*)(P.ws + WS_WTQ) + (size_t)l2 * D * 2048, 2048, 128, 16, 8,
                             (bf16_t*)(P.ws + WS_WEFF) + (size_t)l2 * 2048 * D, D, nullptr};
                    phase_gemm<0>(ge, smem, bid, nblk, (NT / 128 * (DINP / 128) + l2 * 128) % nblk);
                }
            }
        }
        GSYNC();
        RwP rw = make_rwp(P, l);
        LinP lp{(const bf16_t*)(P.ws + WS_Z), (bf16_t*)(P.ws + WS_O), P.in[17] + (size_t)l * 16 * 192, P.in[18] + l * 192, P.in[19] + l * 384, (const float*)(P.ws + WS_ROPE), P.ws + WS_LIN};
        for (int task = bid; task < 512 + 2048; task += nblk) {
            if (task < 512) { rwkv_prep_task(rw, smem, task); }
            else { lin_kv_dispatch(lp, smem, task - 512); }
        }
        GSYNC();
        {
            for (int task = bid; task < 240; task += nblk) {
                const int bh = task / 10, r = task % 10;
                const int seg = r < 2 ? 0 : (r < 6 ? 1 : 2), grp = r < 2 ? r : (r < 6 ? r - 2 : r - 6);
                rwkv_scan_task(rw, smem, bh, seg, grp);
            }
            unsigned* lflags = (unsigned*)(P.ws + WS_FLAGS) + l * 32;
            if (nblk >= 512) {
                if (bid >= 240) {
                    lin_scan_phase(lp, bid - 240, nblk - 240, lflags);
                    for (int task = bid - 240; task < 2048; task += nblk - 240) lin_out_dispatch(lp, smem, task, lflags);
                }
            } else {
                lin_scan_phase(lp, bid, nblk, lflags);
                for (int task = bid; task < 2048; task += nblk) lin_out_dispatch(lp, smem, task, lflags);
            }
            if (l == 0) {
                ConvP c{P.in[4], P.in[5], P.in[20], P.in[21], P.in[22], P.in[23], P.in[7], P.in[9], P.in[11], P.ws};
                if (nblk >= 512) { if (bid >= 240) phase_convert_uv(c, bid - 240, nblk - 240); } else phase_convert_uv(c, bid, nblk);
            }
        }
        GSYNC();
        phase_rwkv_chain(rw, bid, nblk);
        GSYNC();
        phase_rwkv_post(rw, bid, nblk);
        GSYNC();
        {
            GemmP g{(const bf16_t*)(P.ws + WS_O), D, 0, 0, (const bf16_t*)(P.ws + WS_WTOUT) + (size_t)l * D * D, D, D, NT / 128, D / 128, P.out, D, xin};
            phase_gemm<2>(g, smem, bid, nblk);
        }
        GSYNC();
        phase_rmsnorm<false>(P.out, P.in[2] + l * D, P.ws + WS_H, bid, nblk);
        GSYNC();
        {
            GemmP g{(const bf16_t*)(P.ws + WS_H), D, 0, 0, (const bf16_t*)(P.ws + WS_WEFF) + (size_t)l * 2048 * D, D, D, NT / 128, 2048 / 128, P.ws + WS_MIX, NT, nullptr};
            phase_gemm<3>(g, smem, bid, nblk);
        }
        GSYNC();
        phase_topk((const float*)(P.ws + WS_MIX), (int*)(P.ws + WS_EIDX), (float*)(P.ws + WS_GATE), smem, bid, nblk);
        GSYNC();
        if (l == 0) phase_expert<0>((const bf16_t*)(P.ws + WS_H), P.ws + WS_UB + (size_t)l * NEXP * 512, P.ws + WS_VB + (size_t)l * NEXP * 512,
                     (const float*)(P.ws + WS_ESC) + l * NEXP, (const float*)(P.ws + WS_ESC) + (2 + l) * NEXP,
                     (const int*)(P.ws + WS_EIDX), (const float*)(P.ws + WS_GATE), P.out, P.out, P.in[1] + D, (bf16_t*)(P.ws + WS_H), bid, nblk);
        else phase_expert<1>((const bf16_t*)(P.ws + WS_H), P.ws + WS_UB + (size_t)l * NEXP * 512, P.ws + WS_VB + (size_t)l * NEXP * 512,
                     (const float*)(P.ws + WS_ESC) + l * NEXP, (const float*)(P.ws + WS_ESC) + (2 + l) * NEXP,
                     (const int*)(P.ws + WS_EIDX), (const float*)(P.ws + WS_GATE), P.out, P.out, P.in[3], nullptr, bid, nblk);
        if (l == 0) GSYNC();
    }
}

extern "C" void kernel_launch(void* const* d_in, const int* in_sizes, int n_in, void* d_out, int out_size, void* d_ws, size_t ws_size, hipStream_t stream) {
    static int grid = 0;
    if (grid == 0) {
        if (n_in != 24 || ws_size < WS_END) { fprintf(stderr, "kernel_launch: bad args n_in=%d ws=%zu need=%zu\n", n_in, ws_size, (size_t)WS_END); grid = -1; return; }
        int dev = 0, cus = 0, per_cu = 0;
        hipGetDevice(&dev);
        hipDeviceGetAttribute(&cus, hipDeviceAttributeMultiprocessorCount, dev);
        hipFuncSetAttribute((const void*)mega_fwd, hipFuncAttributeMaxDynamicSharedMemorySize, LDS_BYTES);
        hipOccupancyMaxActiveBlocksPerMultiprocessor(&per_cu, (const void*)mega_fwd, NTHREADS, LDS_BYTES);
        if (per_cu < 1) { fprintf(stderr, "kernel_launch: occupancy query says %d\n", per_cu); grid = -1; return; }
        if (per_cu > 2) per_cu = 2;
        grid = cus * per_cu;
        fprintf(stderr, "kernel_launch: grid %d (%d CUs x %d)\n", grid, cus, per_cu);
    }
    if (grid < 0) return;
    hipMemsetAsync((char*)d_ws + WS_CTL, 0, 32768, stream);
    Params P{};
    for (int i = 0; i < 24; ++i) P.in[i] = (const float*)d_in[i];
    P.out = (float*)d_out; P.ws = (unsigned char*)d_ws;
    void* args[] = {&P};
    hipError_t e = hipLaunchCooperativeKernel((const void*)mega_fwd, dim3(grid), dim3(NTHREADS), args, LDS_BYTES, stream);
    if (e != hipSuccess) fprintf(stderr, "cooperative launch failed: %s (grid %d)\n", hipGetErrorString(e), grid);
}
```

```cpp
#include <hip/hip_runtime.h>
#include <stdint.h>
#include <stdio.h>

typedef unsigned short bf16_t;
typedef short bf16x8 __attribute__((ext_vector_type(8)));
typedef float f32x4 __attribute__((ext_vector_type(4)));
typedef unsigned u32x4 __attribute__((ext_vector_type(4)));
typedef unsigned u32x2 __attribute__((ext_vector_type(2)));

constexpr int NB = 4, NS = 4096, NT = NB * NS, D = 1024, DIN = 3600, DINP = 3712;
constexpr int ZC_RET = 0, ZC_RW = 1024, ZC_GLA = 2432;
constexpr int RW_F = 1408;
constexpr int NEXP = 16384;
constexpr int NTHREADS = 256;

constexpr size_t MiB = 1024ull * 1024ull;
constexpr size_t WS_CTL   = 0;
constexpr size_t WS_LORA  = 65536;
constexpr size_t LORA_L   = 384ull * 256 * 2;
constexpr size_t WS_ESC   = 524288;
constexpr size_t WS_WTIN  = 1 * MiB;
constexpr size_t WS_WTOUT = WS_WTIN + 2ull * DINP * D * 2;
constexpr size_t WS_WTQ   = WS_WTOUT + 2ull * D * D * 2;
constexpr size_t WS_SK    = WS_WTQ + 2ull * 2048 * D * 2;
constexpr size_t WS_UB    = WS_SK + 2ull * 16 * 128 * 128 * 2;
constexpr size_t WS_VB    = WS_UB + 2ull * NEXP * D;
constexpr size_t WS_LIN   = WS_VB + 2ull * NEXP * D;
constexpr size_t WS_H     = WS_LIN + 64 * MiB;
constexpr size_t WS_Z     = WS_H + (size_t)NT * D * 2;
constexpr size_t WS_O     = WS_Z + (size_t)NT * DINP * 2;
constexpr size_t WS_MIX   = WS_O + (size_t)NT * D * 2;
constexpr size_t WS_EIDX  = WS_MIX + 128 * MiB;
constexpr size_t WS_GATE  = WS_EIDX + (size_t)NT * 128 * 4;
constexpr size_t WS_ROPE  = WS_GATE + (size_t)NT * 128 * 4;
constexpr size_t WS_WEFF  = WS_ROPE + 1 * MiB;
constexpr size_t WS_END   = WS_WEFF + 2ull * 2048 * D * 2;
constexpr size_t RWA = (size_t)NT * 384;
constexpr size_t MX_W   = 0;
constexpr size_t MX_KK  = MX_W + RWA * 4;
constexpr size_t MX_KKA = MX_KK + RWA * 4;
constexpr size_t MX_R   = MX_KKA + RWA * 4;
constexpr size_t MX_K   = MX_R + RWA * 2;
constexpr size_t MX_V   = MX_K + RWA * 2;
constexpr size_t MX_G   = MX_V + RWA * 2;
constexpr size_t MX_END = MX_G + RWA * 2;
static_assert(MX_END <= 128 * MiB, "mix region");

__device__ __forceinline__ float bf2f(bf16_t v) { return __uint_as_float(((unsigned)v) << 16); }
__device__ __forceinline__ bf16_t f2bf(float f) { unsigned u = __float_as_uint(f); u += 0x7FFFu + ((u >> 16) & 1u); return (bf16_t)(u >> 16); }
__device__ __forceinline__ unsigned pk2(float lo, float hi) { return (unsigned)f2bf(lo) | ((unsigned)f2bf(hi) << 16); }
__device__ __forceinline__ float lo_bf(unsigned u) { return __uint_as_float(u << 16); }
__device__ __forceinline__ float hi_bf(unsigned u) { return __uint_as_float(u & 0xFFFF0000u); }
template <int CTRL> __device__ __forceinline__ float dpp_f(float v) { return __int_as_float(__builtin_amdgcn_update_dpp(0, __float_as_int(v), CTRL, 0xF, 0xF, true)); }
template <int CTRL> __device__ __forceinline__ unsigned dpp_u(unsigned v) { return (unsigned)__builtin_amdgcn_update_dpp(0, (int)v, CTRL, 0xF, 0xF, true); }
__device__ __forceinline__ float row16_sum(float v) { v += dpp_f<0x128>(v); v += dpp_f<0x124>(v); v += dpp_f<0x122>(v); v += dpp_f<0x121>(v); return v; }
__device__ __forceinline__ float xor16_sum(float v) { auto r = __builtin_amdgcn_permlane16_swap(__float_as_uint(v), __float_as_uint(v), false, false); return __uint_as_float(r[0]) + __uint_as_float(r[1]); }
__device__ __forceinline__ float xor32_sum(float v) { auto r = __builtin_amdgcn_permlane32_swap(__float_as_uint(v), __float_as_uint(v), false, false); return __uint_as_float(r[0]) + __uint_as_float(r[1]); }
__device__ __forceinline__ float wave_sum(float v) { return xor32_sum(xor16_sum(row16_sum(v))); }
__device__ __forceinline__ unsigned umax_(unsigned a, unsigned b) { return a > b ? a : b; }
__device__ __forceinline__ unsigned wave_max_u32(unsigned v) {
    v = umax_(v, dpp_u<0x128>(v)); v = umax_(v, dpp_u<0x124>(v)); v = umax_(v, dpp_u<0x122>(v)); v = umax_(v, dpp_u<0x121>(v));
    { auto r = __builtin_amdgcn_permlane16_swap(v, v, false, false); v = umax_(r[0], r[1]); }
    { auto r = __builtin_amdgcn_permlane32_swap(v, v, false, false); v = umax_(r[0], r[1]); }
    return v;
}
__device__ __forceinline__ float sigmoidf_(float x) { return 1.f / (1.f + __expf(-x)); }
__device__ __forceinline__ float softplusf_(float x) { return fmaxf(x, 0.f) + __logf(1.f + __expf(-fabsf(x))); }
__device__ __forceinline__ float tanhf_(float x) { const float e = __expf(2.f * fminf(fmaxf(x, -15.f), 15.f)); return (e - 1.f) / (e + 1.f); }

__device__ __forceinline__ int otid() { int t = threadIdx.x; asm volatile("" : "+v"(t)); return t; }

constexpr size_t WS_FLAGS = 16384;
__device__ __forceinline__ void flag_signal(unsigned* f) {
    asm volatile("s_waitcnt vmcnt(0)" ::: "memory");
    __syncthreads();
    if (threadIdx.x == 0) {
        __builtin_amdgcn_fence(__ATOMIC_RELEASE, "agent");
        asm volatile("s_waitcnt vmcnt(0)" ::: "memory");
        __hip_atomic_fetch_add(f, 1u, __ATOMIC_RELAXED, __HIP_MEMORY_SCOPE_AGENT);
    }
}
__device__ __forceinline__ void flag_wait(unsigned* f, unsigned need) {
    if (threadIdx.x == 0) {
        unsigned sp = 0;
        while (__hip_atomic_load(f, __ATOMIC_RELAXED, __HIP_MEMORY_SCOPE_AGENT) < need) { __builtin_amdgcn_s_sleep(4); if (++sp > (1u << 22)) break; }
        __builtin_amdgcn_fence(__ATOMIC_ACQUIRE, "agent");
        asm volatile("s_waitcnt vmcnt(0)" ::: "memory");
    }
    __syncthreads();
}

__device__ void transpose_tile(const float* __restrict__ W, int K, int N, bf16_t* __restrict__ Wt, int kt, int nt, float* tile  ) {
    const int tid = otid();
    const int k0 = kt * 64, n0 = nt * 64;
#pragma unroll
    for (int i = 0; i < 4; ++i) {
        const int k = i * 16 + (tid >> 4), n4 = (tid & 15) * 4;
        f32x4 v = (f32x4){0.f, 0.f, 0.f, 0.f};
        if (n0 + n4 < N) v = *(const f32x4*)(W + (size_t)(k0 + k) * N + n0 + n4);
        tile[k * 65 + n4] = v.x; tile[k * 65 + n4 + 1] = v.y; tile[k * 65 + n4 + 2] = v.z; tile[k * 65 + n4 + 3] = v.w;
    }
    __syncthreads();
    {
        const int n = tid >> 2, kc = (tid & 3) * 16;
        unsigned w[8];
#pragma unroll
        for (int j = 0; j < 8; ++j) w[j] = pk2(tile[(kc + 2 * j) * 65 + n], tile[(kc + 2 * j + 1) * 65 + n]);
        u32x4* dst = (u32x4*)(Wt + (size_t)(n0 + n) * K + k0 + kc);
        dst[0] = (u32x4){w[0], w[1], w[2], w[3]}; dst[1] = (u32x4){w[4], w[5], w[6], w[7]};
    }
    __syncthreads();
}

struct ConvP {
    const float* w_in; const float* w_out; const float* w_q; const float* sk; const float* u; const float* v;
    const float* w_up; const float* a_up; const float* g_up;
    unsigned char* ws;
};

__device__ void phase_convert_weights(const ConvP& p, char* smem, int bid, int nblk) {
    float* tile = (float*)smem;
    constexpr int T_IN = 16 * 58, T_OUT = 16 * 16, T_L = T_IN + T_OUT;
    for (int it = bid; it < 2 * T_L; it += nblk) {
        const int l = it / T_L; int r = it % T_L;
        if (r < T_IN) { transpose_tile(p.w_in + (size_t)l * D * DIN, D, DIN, (bf16_t*)(p.ws + WS_WTIN) + (size_t)l * DINP * D, r / 58, r % 58, tile); continue; }
        r -= T_IN;
        transpose_tile(p.w_out + (size_t)l * D * D, D, D, (bf16_t*)(p.ws + WS_WTOUT) + (size_t)l * D * D, r / 16, r % 16, tile);
    }
    const size_t gtid = (size_t)bid * NTHREADS + otid(), gn = (size_t)nblk * NTHREADS;
    {
        for (size_t i = gtid; i < 2ull * 384 * 256; i += gn) {
            const int l = (int)(i / (384 * 256)), r = (int)(i % (384 * 256)), c = r >> 8, k = r & 255;
            bf16_t* base = (bf16_t*)(p.ws + WS_LORA + l * LORA_L);
            if (k < 64) base[c * 64 + k] = f2bf(p.w_up[(size_t)l * 64 * 384 + k * 384 + c]);
            else if (k < 128) base[384 * 64 + c * 64 + (k - 64)] = f2bf(p.a_up[(size_t)l * 64 * 384 + (k - 64) * 384 + c]);
            else base[2 * 384 * 64 + c * 128 + (k - 128)] = f2bf(p.g_up[(size_t)l * 128 * 384 + (k - 128) * 384 + c]);
        }
    }
    {
        float* ct = (float*)(p.ws + WS_ROPE); float* stb = ct + NS * 32;
        for (size_t i = gtid; i < (size_t)NS * 32; i += gn) {
            const int pos = (int)(i >> 5), fi = (int)(i & 31);
            const float inv = exp2f(-(float)fi * (13.287712379549449f / 32.f));
            float sn, cs; sincosf((float)pos * inv, &sn, &cs);
            ct[i] = cs; stb[i] = sn;
        }
    }
    {
        const size_t n8 = (2ull * D * 2048) / 8;
        const f32x4* s = (const f32x4*)p.w_q; u32x4* d = (u32x4*)(p.ws + WS_WTQ);
        for (size_t i = gtid; i < n8; i += gn) { f32x4 a = s[2 * i], b = s[2 * i + 1]; u32x4 o; o.x = pk2(a.x, a.y); o.y = pk2(a.z, a.w); o.z = pk2(b.x, b.y); o.w = pk2(b.z, b.w); d[i] = o; }
    }
    {
        const size_t n8 = (2ull * 16 * 128 * 128) / 8;
        const f32x4* s = (const f32x4*)p.sk; u32x4* d = (u32x4*)(p.ws + WS_SK);
        for (size_t i = gtid; i < n8; i += gn) { f32x4 a = s[2 * i], b = s[2 * i + 1]; u32x4 o; o.x = pk2(a.x, a.y); o.y = pk2(a.z, a.w); o.z = pk2(b.x, b.y); o.w = pk2(b.z, b.w); d[i] = o; }
    }
}

__device__ void phase_convert_uv(const ConvP& p, int bid, int nblk) {
    {
        const int lane = otid() & 63, gw = bid * 4 + (otid() >> 6), ngw = nblk * 4;
        for (int r = gw; r < 4 * NEXP; r += ngw) {
            const bool isv = r >= 2 * NEXP; const int rr = isv ? r - 2 * NEXP : r;
            const f32x4* src = (const f32x4*)((isv ? p.v : p.u) + (size_t)rr * D) + lane * 4;
            f32x4 x[4]; float mx = 0.f;
#pragma unroll
            for (int i = 0; i < 4; ++i) { x[i] = src[i]; mx = fmaxf(mx, fmaxf(fmaxf(fabsf(x[i].x), fabsf(x[i].y)), fmaxf(fabsf(x[i].z), fabsf(x[i].w)))); }
            mx = __uint_as_float(wave_max_u32(__float_as_uint(mx)));
            const float sc = mx > 0.f ? 6.f / mx : 0.f;
            unsigned w0 = 0u, w1 = 0u;
            w0 = __builtin_amdgcn_cvt_scalef32_pk_fp4_f32(w0, x[0].x * sc, x[0].y * sc, 1.0f, 0); w0 = __builtin_amdgcn_cvt_scalef32_pk_fp4_f32(w0, x[0].z * sc, x[0].w * sc, 1.0f, 1);
            w0 = __builtin_amdgcn_cvt_scalef32_pk_fp4_f32(w0, x[1].x * sc, x[1].y * sc, 1.0f, 2); w0 = __builtin_amdgcn_cvt_scalef32_pk_fp4_f32(w0, x[1].z * sc, x[1].w * sc, 1.0f, 3);
            w1 = __builtin_amdgcn_cvt_scalef32_pk_fp4_f32(w1, x[2].x * sc, x[2].y * sc, 1.0f, 0); w1 = __builtin_amdgcn_cvt_scalef32_pk_fp4_f32(w1, x[2].z * sc, x[2].w * sc, 1.0f, 1);
            w1 = __builtin_amdgcn_cvt_scalef32_pk_fp4_f32(w1, x[3].x * sc, x[3].y * sc, 1.0f, 2); w1 = __builtin_amdgcn_cvt_scalef32_pk_fp4_f32(w1, x[3].z * sc, x[3].w * sc, 1.0f, 3);
            *(u32x2*)(p.ws + (isv ? WS_VB : WS_UB) + (size_t)rr * 512 + lane * 8) = (u32x2){w0, w1};
            if (lane == 0) ((float*)(p.ws + WS_ESC))[r] = mx * (1.f / 6.f);
        }
    }
}

template <bool OUT_F32>
__device__ void phase_rmsnorm(const float* x, const float* __restrict__ g, void* out, int bid, int nblk) {
    const int lane = otid() & 63, wave = otid() >> 6;
    const int gw = bid * 4 + wave, ngw = nblk * 4;
    f32x4 gv[4];
#pragma unroll
    for (int j = 0; j < 4; ++j) gv[j] = ((const f32x4*)g)[lane + 64 * j];
    for (int row = gw; row < NT; row += ngw) {
        const f32x4* xr = (const f32x4*)(x + (size_t)row * D) + lane;
        f32x4 v[4]; float s = 0.f;
#pragma unroll
        for (int j = 0; j < 4; ++j) { v[j] = xr[64 * j]; s += v[j].x * v[j].x + v[j].y * v[j].y + v[j].z * v[j].z + v[j].w * v[j].w; }
        s = wave_sum(s);
        const float rs = rsqrtf(s * (1.f / D) + 1e-6f);
        if (OUT_F32) {
            f32x4* o = (f32x4*)((float*)out + (size_t)row * D) + lane;
#pragma unroll
            for (int j = 0; j < 4; ++j) o[64 * j] = v[j] * rs * gv[j];
        } else {
            u32x2* o = (u32x2*)((bf16_t*)out + (size_t)row * D) + lane;
#pragma unroll
            for (int j = 0; j < 4; ++j) { f32x4 y = v[j] * rs * gv[j]; u32x2 w; w.x = pk2(y.x, y.y); w.y = pk2(y.z, y.w); o[64 * j] = w; }
        }
    }
}

struct GemmP {
    const bf16_t* A; int lda; int a_koff;
    int b_koff;
    const bf16_t* Bt; int ldb; int K;
    int MT, NTl;
    void* C; int ldc; const float* R;
};
constexpr int GS = 72;
template <int MODE, bool NARROW = false>
__device__ void phase_gemm(const GemmP& p, char* smem, int bid, int nblk, int tile0 = 0) {
    bf16_t* As = (bf16_t*)smem;
    bf16_t* Bs = As + 128 * GS;
    const int tid = otid(), lane = tid & 63, wave = tid >> 6;
    const int wr = wave >> 1, wc = wave & 1;
    const int lr = tid >> 3, lc = (tid & 7) * 8;
    const int fl = lane & 15, fq = lane >> 4;
    const int ntiles = NARROW ? p.MT : p.MT * p.NTl;
    const bool act = !NARROW || (__builtin_amdgcn_readfirstlane(wc) == 0);
    for (int tile = bid - tile0 + ((bid < tile0) ? nblk * ((tile0 - bid + nblk - 1) / nblk) : 0); tile < ntiles; tile += nblk) {
        const int mt = NARROW ? tile : tile / p.NTl, nt = NARROW ? p.NTl : tile % p.NTl;
        const bf16_t* Ag = p.A + (size_t)mt * 128 * p.lda + (size_t)nt * p.a_koff + (size_t)lr * p.lda + lc;
        const bf16_t* Bg = p.Bt + (size_t)nt * 128 * p.ldb + (size_t)mt * p.b_koff + (size_t)lr * p.ldb + lc;
        f32x4 acc[4][4];
#pragma unroll
        for (int m = 0; m < 4; ++m)
#pragma unroll
            for (int n = 0; n < 4; ++n) acc[m][n] = (f32x4){0.f, 0.f, 0.f, 0.f};
        u32x4 ra[4], rb[4];
        const int nk = p.K >> 6;
#pragma unroll
        for (int i = 0; i < 4; ++i) { ra[i] = *(const u32x4*)(Ag + (size_t)(32 * i) * p.lda); rb[i] = *(const u32x4*)(Bg + (size_t)(32 * i) * p.ldb); }
        __syncthreads();
#pragma unroll
        for (int i = 0; i < 4; ++i) { *(u32x4*)(As + (lr + 32 * i) * GS + lc) = ra[i]; *(u32x4*)(Bs + (lr + 32 * i) * GS + lc) = rb[i]; }
        if (nk > 1) {
#pragma unroll
            for (int i = 0; i < 4; ++i) { ra[i] = *(const u32x4*)(Ag + (size_t)(32 * i) * p.lda + 64); rb[i] = *(const u32x4*)(Bg + (size_t)(32 * i) * p.ldb + 64); }
        }
        __syncthreads();
        for (int kt = 0; kt < nk; ++kt) {
            const bf16_t* Ac = As + (kt & 1) * (256 * GS); const bf16_t* Bc = Ac + 128 * GS;
            bf16_t* An = As + ((kt & 1) ^ 1) * (256 * GS); bf16_t* Bn = An + 128 * GS;
            if (kt + 1 < nk) {
#pragma unroll
                for (int i = 0; i < 4; ++i) { *(u32x4*)(An + (lr + 32 * i) * GS + lc) = ra[i]; *(u32x4*)(Bn + (lr + 32 * i) * GS + lc) = rb[i]; }
                if (kt + 2 < nk) {
#pragma unroll
                    for (int i = 0; i < 4; ++i) { ra[i] = *(const u32x4*)(Ag + (size_t)(32 * i) * p.lda + (kt + 2) * 64); rb[i] = *(const u32x4*)(Bg + (size_t)(32 * i) * p.ldb + (kt + 2) * 64); }
                }
            }
#pragma unroll
            for (int ks = 0; ks < 2; ++ks) {
                bf16x8 xa[4], wb[4];
                if (act) {
#pragma unroll
                for (int m = 0; m < 4; ++m) xa[m] = *(const bf16x8*)(Ac + (wr * 64 + m * 16 + fl) * GS + ks * 32 + fq * 8);
#pragma unroll
                for (int n = 0; n < (NARROW ? 1 : 4); ++n) wb[n] = *(const bf16x8*)(Bc + (wc * 64 + n * 16 + fl) * GS + ks * 32 + fq * 8);
#pragma unroll
                for (int m = 0; m < 4; ++m)
#pragma unroll
                    for (int n = 0; n < (NARROW ? 1 : 4); ++n) acc[m][n] = (MODE == 3) ? __builtin_amdgcn_mfma_f32_16x16x32_bf16(xa[m], wb[n], acc[m][n], 0, 0, 0)
                                                                                    : __builtin_amdgcn_mfma_f32_16x16x32_bf16(wb[n], xa[m], acc[m][n], 0, 0, 0);
                }
            }
            __syncthreads();
        }
        if (act)
#pragma unroll
        for (int m = 0; m < 4; ++m) {
#pragma unroll
            for (int n = 0; n < (NARROW ? 1 : 4); ++n) {
                const f32x4 a = acc[m][n];
                if (MODE == 3) {
                    const size_t row = (size_t)mt * 128 + wr * 64 + m * 16 + fq * 4;
                    const size_t col = (size_t)nt * 128 + wc * 64 + n * 16 + fl;
                    *(f32x4*)((float*)p.C + col * p.ldc + row) = a;
                } else {
                    const size_t row = (size_t)mt * 128 + wr * 64 + m * 16 + fl;
                    const int col = nt * 128 + wc * 64 + n * 16 + fq * 4;
                    if (MODE == 0) { u32x2 w; w.x = pk2(a.x, a.y); w.y = pk2(a.z, a.w); *(u32x2*)((bf16_t*)p.C + row * p.ldc + col) = w; }
                    else if (MODE == 1) { *(f32x4*)((float*)p.C + row * p.ldc + col) = a; }
                    else { const f32x4 r = *(const f32x4*)(p.R + row * p.ldc + col); *(f32x4*)((float*)p.C + row * p.ldc + col) = r + a; }
                }
            }
        }
    }
}

constexpr int LS = 72;
struct LinP {
    const bf16_t* Z; bf16_t* O;
    const float* gk_up;
    const float* gk_bias;
    const float* norm_w;
    const float* rope;
    unsigned char* lin;
};
__device__ __forceinline__ bf16x8 ldfrag(const bf16_t* base, int row, int kofs) { return *(const bf16x8*)(base + row * LS + kofs); }

constexpr size_t LN_KV_RET = 0;
constexpr size_t LN_KV_GLA = LN_KV_RET + 1024ull * 64 * 64 * 4;
constexpr size_t LN_S_RET  = LN_KV_GLA + 1024ull * 96 * 64 * 4;
constexpr size_t LN_S_GLA  = LN_S_RET + 1024ull * 64 * 64 * 2;
constexpr size_t LN_DEC    = LN_S_GLA + 1024ull * 96 * 64 * 2;
static_assert(LN_DEC + 2048ull * 64 * 4 <= 64 * MiB, "lin region");

__device__ __forceinline__ float wave_incl_scan(float v) {
    v += dpp_f<0x111>(v); v += dpp_f<0x112>(v); v += dpp_f<0x114>(v); v += dpp_f<0x118>(v);
    v += __int_as_float(__builtin_amdgcn_update_dpp(0, __float_as_int(v), 0x142, 0xA, 0xF, false));
    v += __int_as_float(__builtin_amdgcn_update_dpp(0, __float_as_int(v), 0x143, 0xC, 0xF, false));
    return v;
}
__device__ __forceinline__ float readlane_f(float v, int l) { return __int_as_float(__builtin_amdgcn_readlane(__float_as_int(v), l)); }

__device__ __forceinline__ void rot8(const bf16_t* src, const float* rope, int spos, int cq, unsigned (&o1)[4], unsigned (&o2)[4]) {
    const u32x4 q1 = *(const u32x4*)(src + cq * 8), q2 = *(const u32x4*)(src + 32 + cq * 8);
    const unsigned q1w[4] = {q1.x, q1.y, q1.z, q1.w}, q2w[4] = {q2.x, q2.y, q2.z, q2.w};
    const f32x4 c0 = *(const f32x4*)(rope + spos * 32 + cq * 8), c1 = *(const f32x4*)(rope + spos * 32 + cq * 8 + 4);
    const f32x4 s0 = *(const f32x4*)(rope + NS * 32 + spos * 32 + cq * 8), s1 = *(const f32x4*)(rope + NS * 32 + spos * 32 + cq * 8 + 4);
    const float csv[8] = {c0.x, c0.y, c0.z, c0.w, c1.x, c1.y, c1.z, c1.w}, snv[8] = {s0.x, s0.y, s0.z, s0.w, s1.x, s1.y, s1.z, s1.w};
#pragma unroll
    for (int e = 0; e < 4; ++e) {
        const float a1l = lo_bf(q1w[e]), a1h = hi_bf(q1w[e]), a2l = lo_bf(q2w[e]), a2h = hi_bf(q2w[e]);
        o1[e] = pk2(a1l * csv[2 * e] - a2l * snv[2 * e], a1h * csv[2 * e + 1] - a2h * snv[2 * e + 1]);
        o2[e] = pk2(a1l * snv[2 * e] + a2l * csv[2 * e], a1h * snv[2 * e + 1] + a2h * csv[2 * e + 1]);
    }
}
__device__ __forceinline__ void load_vts(const bf16_t* Z, size_t t0, int voff, int nch, bf16_t* Vts, int tid) {
    for (int x = tid; x < 64 * nch; x += NTHREADS) {
        const int tok = x / nch, ch = x % nch;
        const u32x4 vv = *(const u32x4*)(Z + (t0 + tok) * DINP + voff + ch * 8);
        const unsigned w[4] = {vv.x, vv.y, vv.z, vv.w};
#pragma unroll
        for (int e = 0; e < 4; ++e) { Vts[(ch * 8 + 2 * e) * LS + tok] = (bf16_t)(w[e] & 0xFFFFu); Vts[(ch * 8 + 2 * e + 1) * LS + tok] = (bf16_t)(w[e] >> 16); }
    }
}
__device__ __forceinline__ void load_gd(const bf16_t* zr, float (&gd)[16]) {
    const u32x4 g0 = *(const u32x4*)zr, g1 = *(const u32x4*)(zr + 8);
    gd[0] = lo_bf(g0.x); gd[1] = hi_bf(g0.x); gd[2] = lo_bf(g0.y); gd[3] = hi_bf(g0.y); gd[4] = lo_bf(g0.z); gd[5] = hi_bf(g0.z); gd[6] = lo_bf(g0.w); gd[7] = hi_bf(g0.w);
    gd[8] = lo_bf(g1.x); gd[9] = hi_bf(g1.x); gd[10] = lo_bf(g1.y); gd[11] = hi_bf(g1.y); gd[12] = lo_bf(g1.z); gd[13] = hi_bf(g1.z); gd[14] = lo_bf(g1.w); gd[15] = hi_bf(g1.w);
}
__device__ __forceinline__ float gla_gk(const LinP& p, const float (&gd)[16], int h, int d) {
    float x = p.gk_bias[h * 48 + d];
#pragma unroll
    for (int i = 0; i < 16; ++i) x += gd[i] * p.gk_up[i * 192 + h * 48 + d];
    return (fminf(x, 0.f) - __logf(1.f + __expf(-fabsf(x)))) * (1.f / 16.f);
}
__device__ __forceinline__ float ret_lg(int h) { const float e = exp2f(-5.f - (float)h * (4.f / 3.f)); return log1pf(-e); }

template <bool IS_GLA>
__device__ void lin_kv_task(const LinP& p, char* smem, int b, int h, int c) {
    constexpr int DV = IS_GLA ? 96 : 64, NVB = DV / 16;
    const int koff = IS_GLA ? (ZC_GLA + 192 + h * 48) : (ZC_RET + 256 + h * 64);
    const int voff = IS_GLA ? (ZC_GLA + 384 + h * 96) : (ZC_RET + 512 + h * 64);
    const int gkdoff = ZC_GLA + 768;
    bf16_t* Ks = (bf16_t*)smem;
    bf16_t* Kts = Ks + 64 * LS;
    bf16_t* Vts = Kts + 64 * LS;
    float* decs = (float*)(Vts + 96 * LS);
    const int tid = otid(), lane = tid & 63, wave = tid >> 6;
    const int fl = lane & 15, fq = lane >> 4;
    const size_t t0 = (size_t)b * NS + (size_t)c * 64;
    const int task = (b * 4 + h) * 64 + c;
    __syncthreads();
    if (IS_GLA) {
        for (int x = tid; x < 64 * 6; x += NTHREADS) {
            const int tok = x / 6, ch = x % 6;
            *(u32x4*)(Ks + tok * LS + ch * 8) = *(const u32x4*)(p.Z + (t0 + tok) * DINP + koff + ch * 8);
        }
        for (int x = tid; x < 16 * LS / 2; x += NTHREADS) ((unsigned*)(Kts + 48 * LS))[x] = 0u;
        if (tid < 16) decs[48 + tid] = 1.f;
        load_vts(p.Z, t0, voff, 12, Vts, tid);
    } else {
        const int tok = tid >> 2, cq = tid & 3;
        unsigned k1[4], k2[4];
        rot8(p.Z + (t0 + tok) * DINP + koff, p.rope, c * 64 + tok, cq, k1, k2);
        const float fk2 = 0.125f * __expf(ret_lg(h) * (float)(63 - tok));
#pragma unroll
        for (int e = 0; e < 4; ++e) {
            Kts[(cq * 8 + 2 * e) * LS + tok] = f2bf(lo_bf(k1[e]) * fk2); Kts[(cq * 8 + 2 * e + 1) * LS + tok] = f2bf(hi_bf(k1[e]) * fk2);
            Kts[(32 + cq * 8 + 2 * e) * LS + tok] = f2bf(lo_bf(k2[e]) * fk2); Kts[(32 + cq * 8 + 2 * e + 1) * LS + tok] = f2bf(hi_bf(k2[e]) * fk2);
        }
        if (tid < 64) decs[tid] = __expf(ret_lg(h) * 64.f);
        load_vts(p.Z, t0, voff, 8, Vts, tid);
    }
    __syncthreads();
    if (IS_GLA) {
        float gd[16];
        load_gd(p.Z + (t0 + lane) * DINP + gkdoff, gd);
#pragma unroll 1
        for (int dd = 0; dd < 12; ++dd) {
            const int d = wave * 12 + dd;
            const float bc = wave_incl_scan(gla_gk(p, gd, h, d));
            const float bl = readlane_f(bc, 63);
            Kts[d * LS + lane] = f2bf(bf2f(Ks[lane * LS + d]) * __expf(bl - bc));
            if (lane == 0) decs[d] = __expf(bl);
        }
        __syncthreads();
    }
    float* KV = (float*)(p.lin + (IS_GLA ? LN_KV_GLA : LN_KV_RET)) + (size_t)task * DV * 64;
#pragma unroll
    for (int vb = 0; vb < NVB; ++vb) {
        f32x4 a4 = (f32x4){0.f, 0.f, 0.f, 0.f};
#pragma unroll
        for (int ks = 0; ks < 2; ++ks) {
            const bf16x8 a = ldfrag(Kts, 16 * wave + fl, ks * 32 + fq * 8);
            const bf16x8 bv = ldfrag(Vts, 16 * vb + fl, ks * 32 + fq * 8);
            a4 = __builtin_amdgcn_mfma_f32_16x16x32_bf16(a, bv, a4, 0, 0, 0);
        }
        *(f32x4*)(KV + (size_t)(16 * vb + fl) * 64 + 16 * wave + 4 * fq) = a4;
    }
    if (tid < 64) ((float*)(p.lin + LN_DEC))[(size_t)((IS_GLA ? 1024 : 0) + task) * 64 + tid] = decs[tid];
}

__device__ void lin_scan_phase(const LinP& p, int vbid, int nvblk, unsigned* flags) {
    const int tid = otid();
    for (int it = vbid; it < 160; it += nvblk) {
        const bool gla = it >= 64;
        const int r = gla ? it - 64 : it;
        const int per = gla ? 6 : 4, DVx = gla ? 96 : 64;
        const int bh = r / per, e = (r % per) * 1024 + tid;
        const float* KV = (const float*)(p.lin + (gla ? LN_KV_GLA : LN_KV_RET)) + (size_t)bh * 64 * DVx * 64 + e;
        bf16_t* Sb = (bf16_t*)(p.lin + (gla ? LN_S_GLA : LN_S_RET)) + (size_t)bh * 64 * DVx * 64 + e;
        const float* DEC = (const float*)(p.lin + LN_DEC) + (size_t)((gla ? 1024 : 0) + bh * 64) * 64 + (e & 63);
        float S0 = 0.f, S1 = 0.f, S2 = 0.f, S3 = 0.f;
#pragma unroll 8
        for (int c = 0; c < 64; ++c) {
            const size_t o = (size_t)c * DVx * 64;
            const float k0 = KV[o], k1 = KV[o + 256], k2 = KV[o + 512], k3 = KV[o + 768], dc = DEC[c * 64];
            Sb[o] = f2bf(S0); Sb[o + 256] = f2bf(S1); Sb[o + 512] = f2bf(S2); Sb[o + 768] = f2bf(S3);
            S0 = S0 * dc + k0; S1 = S1 * dc + k1; S2 = S2 * dc + k2; S3 = S3 * dc + k3;
        }
        flag_signal(flags + (gla ? 16 : 0) + bh);
    }
}

template <bool IS_GLA>
__device__ void lin_out_task(const LinP& p, char* smem, int b, int h, int c) {
    constexpr int DV = IS_GLA ? 96 : 64, NVB = DV / 16;
    const int qoff = IS_GLA ? (ZC_GLA + 0 + h * 48) : (ZC_RET + 0 + h * 64);
    const int koff = IS_GLA ? (ZC_GLA + 192 + h * 48) : (ZC_RET + 256 + h * 64);
    const int voff = IS_GLA ? (ZC_GLA + 384 + h * 96) : (ZC_RET + 512 + h * 64);
    const int goff = IS_GLA ? (ZC_GLA + 784 + h * 96) : (ZC_RET + 768 + h * 64);
    const int gkdoff = ZC_GLA + 768;
    const int ooff = IS_GLA ? (640 + h * 96) : (h * 64);
    bf16_t* Qs = (bf16_t*)smem;
    bf16_t* Ks = Qs + 64 * LS;
    bf16_t* Ps = Ks + 64 * LS;
    bf16_t* Vts = Ps + 64 * LS;
    bf16_t* Sts = Vts + 96 * LS;
    const int tid = otid(), lane = tid & 63, wave = tid >> 6;
    const int fl = lane & 15, fq = lane >> 4;
    const size_t t0 = (size_t)b * NS + (size_t)c * 64;
    const int task = (b * 4 + h) * 64 + c;
    __syncthreads();
    {
        const bf16_t* Sb = (const bf16_t*)(p.lin + (IS_GLA ? LN_S_GLA : LN_S_RET)) + (size_t)task * DV * 64;
        for (int x = tid; x < DV * 8; x += NTHREADS) { const int v = x >> 3, ch = x & 7; *(u32x4*)(Sts + v * LS + ch * 8) = *(const u32x4*)(Sb + v * 64 + ch * 8); }
    }
    if (IS_GLA) {
        for (int x = tid; x < 64 * 6; x += NTHREADS) {
            const int tok = x / 6, ch = x % 6;
            const bf16_t* zr = p.Z + (t0 + tok) * DINP;
            *(u32x4*)(Qs + tok * LS + ch * 8) = *(const u32x4*)(zr + qoff + ch * 8);
            *(u32x4*)(Ks + tok * LS + ch * 8) = *(const u32x4*)(zr + koff + ch * 8);
        }
        for (int x = tid; x < 64 * 2; x += NTHREADS) {
            const int tok = x >> 1, ch = 6 + (x & 1);
            *(u32x4*)(Qs + tok * LS + ch * 8) = (u32x4){0u, 0u, 0u, 0u};
            *(u32x4*)(Ks + tok * LS + ch * 8) = (u32x4){0u, 0u, 0u, 0u};
        }
        load_vts(p.Z, t0, voff, 12, Vts, tid);
    } else {
        const int tok = tid >> 2, cq = tid & 3;
        const bf16_t* zr = p.Z + (t0 + tok) * DINP;
        unsigned q1[4], q2[4], k1[4], k2[4];
        rot8(zr + qoff, p.rope, c * 64 + tok, cq, q1, q2);
        rot8(zr + koff, p.rope, c * 64 + tok, cq, k1, k2);
        const float lg = ret_lg(h);
        const float fqd = __expf(lg * (float)(tok + 1)), fk = 0.125f * __expf(-lg * (float)(tok + 1));
#pragma unroll
        for (int e = 0; e < 4; ++e) {
            q1[e] = pk2(lo_bf(q1[e]) * fqd, hi_bf(q1[e]) * fqd); q2[e] = pk2(lo_bf(q2[e]) * fqd, hi_bf(q2[e]) * fqd);
            k1[e] = pk2(lo_bf(k1[e]) * fk, hi_bf(k1[e]) * fk); k2[e] = pk2(lo_bf(k2[e]) * fk, hi_bf(k2[e]) * fk);
        }
        *(u32x4*)(Qs + tok * LS + cq * 8) = (u32x4){q1[0], q1[1], q1[2], q1[3]};
        *(u32x4*)(Qs + tok * LS + 32 + cq * 8) = (u32x4){q2[0], q2[1], q2[2], q2[3]};
        *(u32x4*)(Ks + tok * LS + cq * 8) = (u32x4){k1[0], k1[1], k1[2], k1[3]};
        *(u32x4*)(Ks + tok * LS + 32 + cq * 8) = (u32x4){k2[0], k2[1], k2[2], k2[3]};
        load_vts(p.Z, t0, voff, 8, Vts, tid);
    }
    __syncthreads();
    if (IS_GLA) {
        float gd[16];
        load_gd(p.Z + (t0 + lane) * DINP + gkdoff, gd);
#pragma unroll 1
        for (int dd = 0; dd < 12; ++dd) {
            const int d = wave * 12 + dd;
            const float bc = wave_incl_scan(gla_gk(p, gd, h, d));
            const float eq = __expf(bc) * 0.14433756729740643f  , ek = __expf(-bc);
            Qs[lane * LS + d] = f2bf(bf2f(Qs[lane * LS + d]) * eq);
            Ks[lane * LS + d] = f2bf(bf2f(Ks[lane * LS + d]) * ek);
        }
        __syncthreads();
    }
#pragma unroll
    for (int jb = 0; jb < 4; ++jb) {
        f32x4 ap = (f32x4){0.f, 0.f, 0.f, 0.f};
#pragma unroll
        for (int ks = 0; ks < 2; ++ks) {
            const bf16x8 a = ldfrag(Ks, 16 * jb + fl, ks * 32 + fq * 8);
            const bf16x8 bq = ldfrag(Qs, 16 * wave + fl, ks * 32 + fq * 8);
            ap = __builtin_amdgcn_mfma_f32_16x16x32_bf16(a, bq, ap, 0, 0, 0);
        }
        const int i = 16 * wave + fl, j0 = 16 * jb + 4 * fq;
        u32x2 w;
        w.x = pk2(j0 + 0 <= i ? ap.x : 0.f, j0 + 1 <= i ? ap.y : 0.f);
        w.y = pk2(j0 + 2 <= i ? ap.z : 0.f, j0 + 3 <= i ? ap.w : 0.f);
        *(u32x2*)(Ps + i * LS + j0) = w;
    }
    __syncthreads();
    {
        f32x4 ao[NVB];
        float ss = 0.f;
#pragma unroll
        for (int vb = 0; vb < NVB; ++vb) {
            f32x4 a4 = (f32x4){0.f, 0.f, 0.f, 0.f};
#pragma unroll
            for (int ks = 0; ks < 2; ++ks) {
                const bf16x8 a = ldfrag(Vts, 16 * vb + fl, ks * 32 + fq * 8);
                const bf16x8 bp = ldfrag(Ps, 16 * wave + fl, ks * 32 + fq * 8);
                a4 = __builtin_amdgcn_mfma_f32_16x16x32_bf16(a, bp, a4, 0, 0, 0);
            }
#pragma unroll
            for (int ks = 0; ks < 2; ++ks) {
                const bf16x8 a = ldfrag(Sts, 16 * vb + fl, ks * 32 + fq * 8);
                const bf16x8 bq = ldfrag(Qs, 16 * wave + fl, ks * 32 + fq * 8);
                a4 = __builtin_amdgcn_mfma_f32_16x16x32_bf16(a, bq, a4, 0, 0, 0);
            }
            ao[vb] = a4;
            ss += a4.x * a4.x + a4.y * a4.y + a4.z * a4.z + a4.w * a4.w;
        }
        ss = xor32_sum(xor16_sum(ss));
        const float inv = rsqrtf(ss * (1.f / DV) + 1e-5f);
        const size_t t = t0 + 16 * wave + fl;
#pragma unroll
        for (int vb = 0; vb < NVB; ++vb) {
            const int v0 = 16 * vb + 4 * fq;
            const u32x2 gg = *(const u32x2*)(p.Z + t * DINP + goff + v0);
            float g4[4] = {lo_bf(gg.x), hi_bf(gg.x), lo_bf(gg.y), hi_bf(gg.y)};
            float o4[4] = {ao[vb].x, ao[vb].y, ao[vb].z, ao[vb].w};
#pragma unroll
            for (int e = 0; e < 4; ++e) {
                float y = o4[e] * inv;
                if (IS_GLA) y *= p.norm_w[h * 96 + v0 + e];
                const float g = g4[e];
                o4[e] = y * (g / (1.f + __expf(-g)));
            }
            u32x2 w; w.x = pk2(o4[0], o4[1]); w.y = pk2(o4[2], o4[3]);
            *(u32x2*)(p.O + t * D + ooff + v0) = w;
        }
    }
}
__device__ __forceinline__ void lin_kv_dispatch(const LinP& p, char* smem, int task) {
    const int r = task & 1023, bh = r >> 6, c = r & 63;
    if (task < 1024) lin_kv_task<false>(p, smem, bh >> 2, bh & 3, c); else lin_kv_task<true>(p, smem, bh >> 2, bh & 3, c);
}
__device__ __forceinline__ void lin_out_dispatch(const LinP& p, char* smem, int task, unsigned* flags) {
    const int r = task & 1023, bh = r >> 6, c = r & 63;
    if (flags) flag_wait(flags + (task < 1024 ? 0 : 16) + bh, task < 1024 ? 4u : 6u);
    if (task < 1024) lin_out_task<false>(p, smem, bh >> 2, bh & 3, c); else lin_out_task<true>(p, smem, bh >> 2, bh & 3, c);
}

struct RwP {
    const bf16_t* Z; unsigned char* mix;
    const float* mu; const float* w_up; const float* w_bias; const float* a_up; const float* a_bias; const float* g_up;
    const float* k_k; const float* k_a; const float* r_k; const float* ln_w; const float* ln_b;
    float* oraw; bf16_t* O; bf16_t* Y; const bf16_t* lora;
};
constexpr int PS = 264;
__device__ __forceinline__ f32x4 bf4(u32x2 w) { return (f32x4){lo_bf(w.x), hi_bf(w.x), lo_bf(w.y), hi_bf(w.y)}; }
__device__ void rwkv_prep_task(const RwP& p, char* smem, int tile) {
    bf16_t* At = (bf16_t*)smem;
    const int tid = otid(), lane = tid & 63, wave = tid >> 6;
    const int fl = lane & 15, fq = lane >> 4;
    const int t0 = tile * 32;
    float* Wd = (float*)(p.mix + MX_W); float* KKd = (float*)(p.mix + MX_KK); float* KKAd = (float*)(p.mix + MX_KKA);
    bf16_t* Rd = (bf16_t*)(p.mix + MX_R); bf16_t* Kd = (bf16_t*)(p.mix + MX_K); bf16_t* Vd = (bf16_t*)(p.mix + MX_V); bf16_t* Gd = (bf16_t*)(p.mix + MX_G);
    __syncthreads();
    {
        const int tok = tid >> 3, t = t0 + tok;
        const bool first = (t & (NS - 1)) == 0;
        const bf16_t* zr = p.Z + (size_t)t * DINP + ZC_RW + 1152;
#pragma unroll
        for (int i = 0; i < 4; ++i) {
            const int ch = (tid & 7) + 8 * i;
            const u32x4 cur = *(const u32x4*)(zr + ch * 8);
            const u32x4 prv = first ? (u32x4){0u, 0u, 0u, 0u} : *(const u32x4*)(zr - DINP + ch * 8);
            const f32x4 m0 = *(const f32x4*)(p.mu + 1152 + ch * 8), m1 = *(const f32x4*)(p.mu + 1152 + ch * 8 + 4);
            const unsigned cw[4] = {cur.x, cur.y, cur.z, cur.w}, pw[4] = {prv.x, prv.y, prv.z, prv.w};
            const float mm[8] = {m0.x, m0.y, m0.z, m0.w, m1.x, m1.y, m1.z, m1.w};
            float o[8];
#pragma unroll
            for (int e = 0; e < 4; ++e) {
                const float f0 = lo_bf(cw[e]), f1 = hi_bf(cw[e]), g0 = lo_bf(pw[e]), g1 = hi_bf(pw[e]);
                o[2 * e] = f0 + (g0 - f0) * mm[2 * e]; o[2 * e + 1] = f1 + (g1 - f1) * mm[2 * e + 1];
            }
            if (ch < 8) {
#pragma unroll
                for (int e = 0; e < 8; ++e) o[e] = tanhf_(o[e]);
            } else if (ch >= 16) {
#pragma unroll
                for (int e = 0; e < 8; ++e) o[e] = sigmoidf_(o[e]);
            }
            *(u32x4*)(At + tok * PS + ch * 8) = (u32x4){pk2(o[0], o[1]), pk2(o[2], o[3]), pk2(o[4], o[5]), pk2(o[6], o[7])};
        }
    }
    __syncthreads();
    bf16x8 xb[8];
#pragma unroll
    for (int ks = 0; ks < 8; ++ks) xb[ks] = *(const bf16x8*)(At + (16 * (wave & 1) + fl) * PS + ks * 32 + fq * 8);
    const int t = t0 + 16 * (wave & 1) + fl, b = t >> 12, sq = t & (NS - 1);
    const bool first = sq == 0;
    const bf16_t* zc = p.Z + (size_t)t * DINP + ZC_RW;
    const bf16_t* WupT = p.lora; const bf16_t* AupT = p.lora + 384 * 64; const bf16_t* GupT = p.lora + 2 * 384 * 64;
    const int hd0 = (wave >> 1) * 3;
#pragma unroll
    for (int hi = 0; hi < 3; ++hi) {
        const int hd = hd0 + hi;
        f32x4 aw[4], aa[4], ag[4];
#pragma unroll
        for (int n = 0; n < 4; ++n) {
            const int cr = hd * 64 + 16 * n + fl;
            f32x4 w4 = (f32x4){0.f, 0.f, 0.f, 0.f}, a4 = w4, g4 = w4;
#pragma unroll
            for (int ks = 0; ks < 2; ++ks) {
                w4 = __builtin_amdgcn_mfma_f32_16x16x32_bf16(*(const bf16x8*)(WupT + cr * 64 + ks * 32 + fq * 8), xb[ks], w4, 0, 0, 0);
                a4 = __builtin_amdgcn_mfma_f32_16x16x32_bf16(*(const bf16x8*)(AupT + cr * 64 + ks * 32 + fq * 8), xb[2 + ks], a4, 0, 0, 0);
            }
#pragma unroll
            for (int ks = 0; ks < 4; ++ks) g4 = __builtin_amdgcn_mfma_f32_16x16x32_bf16(*(const bf16x8*)(GupT + cr * 128 + ks * 32 + fq * 8), xb[4 + ks], g4, 0, 0, 0);
            aw[n] = w4; aa[n] = a4; ag[n] = g4;
        }
        f32x4 kx[4], av[4], kkv[4];
        float ss = 0.f;
        const size_t hrow = ((size_t)(b * 6 + hd) * NS + sq) * 64;
#pragma unroll
        for (int n = 0; n < 4; ++n) {
            const int cl = 16 * n + 4 * fq, c = hd * 64 + cl;
            f32x4 rr = bf4(*(const u32x2*)(zc + c)), kk = bf4(*(const u32x2*)(zc + 384 + c)), vv = bf4(*(const u32x2*)(zc + 768 + c));
            f32x4 rp = (f32x4){0.f, 0.f, 0.f, 0.f}, kp = rp, vp = rp;
            if (!first) { rp = bf4(*(const u32x2*)(zc - DINP + c)); kp = bf4(*(const u32x2*)(zc - DINP + 384 + c)); vp = bf4(*(const u32x2*)(zc - DINP + 768 + c)); }
            rr = rr + (rp - rr) * *(const f32x4*)(p.mu + c); kk = kk + (kp - kk) * *(const f32x4*)(p.mu + 384 + c); vv = vv + (vp - vv) * *(const f32x4*)(p.mu + 768 + c);
            const f32x4 wb = *(const f32x4*)(p.w_bias + c), ab = *(const f32x4*)(p.a_bias + c), kkc = *(const f32x4*)(p.k_k + c), kac = *(const f32x4*)(p.k_a + c);
            f32x4 dec, a;
            {
                const f32x4 xw = wb + aw[n], xa = ab + aa[n];
                dec.x = __expf(-__expf(-softplusf_(-xw.x) - 0.5f)); dec.y = __expf(-__expf(-softplusf_(-xw.y) - 0.5f));
                dec.z = __expf(-__expf(-softplusf_(-xw.z) - 0.5f)); dec.w = __expf(-__expf(-softplusf_(-xw.w) - 0.5f));
                a.x = sigmoidf_(xa.x); a.y = sigmoidf_(xa.y); a.z = sigmoidf_(xa.z); a.w = sigmoidf_(xa.w);
            }
            const f32x4 kr = kk * kkc;
            ss += kr.x * kr.x + kr.y * kr.y + kr.z * kr.z + kr.w * kr.w;
            kkv[n] = kr; av[n] = a; kx[n] = kk;
            const f32x4 kmod = kk * ((a - 1.f) * kac + 1.f);
            *(f32x4*)(Wd + hrow + cl) = dec;
            u32x2 w;
            w.x = pk2(rr.x, rr.y); w.y = pk2(rr.z, rr.w); *(u32x2*)(Rd + hrow + cl) = w;
            w.x = pk2(kmod.x, kmod.y); w.y = pk2(kmod.z, kmod.w); *(u32x2*)(Kd + hrow + cl) = w;
            w.x = pk2(vv.x, vv.y); w.y = pk2(vv.z, vv.w); *(u32x2*)(Vd + hrow + cl) = w;
            w.x = pk2(ag[n].x, ag[n].y); w.y = pk2(ag[n].z, ag[n].w); *(u32x2*)(Gd + (size_t)t * 384 + c) = w;
        }
        ss = xor32_sum(xor16_sum(ss));
        const float rn = rsqrtf(fmaxf(ss, 1e-24f));
#pragma unroll
        for (int n = 0; n < 4; ++n) {
            const int cl = 16 * n + 4 * fq;
            const f32x4 kn = kkv[n] * rn;
            *(f32x4*)(KKd + hrow + cl) = kn;
            *(f32x4*)(KKAd + hrow + cl) = kn * av[n];
        }
    }
}

constexpr int SC_STEPS = 16;
constexpr int SEG_BEG[4] = {0, 1376, 2736, 4096};
constexpr size_t MX_SE0 = MX_END;
constexpr size_t MX_XE  = MX_SE0 + 24ull * 3 * 4096 * 4;
constexpr size_t MX_SST = MX_XE + 24ull * 3 * 4096 * 4;
static_assert(MX_SST + 24ull * 3 * 4096 * 2 <= 128 * MiB, "mix region");
__device__ __forceinline__ float row8_sum(float v) { v += dpp_f<0xB1>(v); v += dpp_f<0x4E>(v); v += dpp_f<0x141>(v); return v; }
__device__ void rwkv_scan_task(const RwP& p, char* smem, int bh, int seg, int grp) {
    float* buf = (float*)smem;
    float* obuf = buf + 2 * 6 * SC_STEPS * 64;
    const int tid = otid(), lane = tid & 63, wave = tid >> 6;
    const int rloc = wave * 8 + (lane >> 3);
    const bool ident = grp >= 2;
    const int row = (grp & 1) * 32 + rloc;
    const int c8 = (lane & 7) * 8;
    const int s_beg = seg == 0 ? SEG_BEG[0] : (seg == 1 ? SEG_BEG[1] : SEG_BEG[2]);
    const int s_end = seg == 0 ? SEG_BEG[1] : (seg == 1 ? SEG_BEG[2] : SEG_BEG[3]);
    const int NCH = (s_end - s_beg) / SC_STEPS;
    const size_t hb = ((size_t)bh * NS + s_beg) * 64;
    const float* Wd = (const float*)(p.mix + MX_W) + hb;
    const float* KKd = (const float*)(p.mix + MX_KK) + hb;
    const float* KKAd = (const float*)(p.mix + MX_KKA) + hb;
    const bf16_t* Rd = (const bf16_t*)(p.mix + MX_R) + hb;
    const bf16_t* Kd = (const bf16_t*)(p.mix + MX_K) + hb;
    const bf16_t* Vd = (const bf16_t*)(p.mix + MX_V) + hb;
    float* orow = p.oraw + hb;
    bf16_t* yrow = p.Y + hb;
    f32x4 Sa, Sb;
    Sa.x = (ident && c8 + 0 == row) ? 1.f : 0.f; Sa.y = (ident && c8 + 1 == row) ? 1.f : 0.f; Sa.z = (ident && c8 + 2 == row) ? 1.f : 0.f; Sa.w = (ident && c8 + 3 == row) ? 1.f : 0.f;
    Sb.x = (ident && c8 + 4 == row) ? 1.f : 0.f; Sb.y = (ident && c8 + 5 == row) ? 1.f : 0.f; Sb.z = (ident && c8 + 6 == row) ? 1.f : 0.f; Sb.w = (ident && c8 + 7 == row) ? 1.f : 0.f;
    struct Stg { f32x4 w, kk, ka; u32x2 r, k, v; };
    Stg sA, sB;
    auto gload = [&](Stg& g, int ch) {
        const size_t e = (size_t)ch * SC_STEPS * 64 + tid * 4;
        g.w = *(const f32x4*)(Wd + e); g.kk = *(const f32x4*)(KKd + e); g.ka = *(const f32x4*)(KKAd + e);
        g.r = *(const u32x2*)(Rd + e); g.k = *(const u32x2*)(Kd + e); g.v = *(const u32x2*)(Vd + e);
    };
    auto lstore = [&](const Stg& g, int bsel) {
        float* bb = buf + bsel * 6 * SC_STEPS * 64 + tid * 4;
        *(f32x4*)(bb + 0 * SC_STEPS * 64) = g.w; *(f32x4*)(bb + 1 * SC_STEPS * 64) = g.kk; *(f32x4*)(bb + 2 * SC_STEPS * 64) = g.ka;
        *(f32x4*)(bb + 3 * SC_STEPS * 64) = (f32x4){lo_bf(g.r.x), hi_bf(g.r.x), lo_bf(g.r.y), hi_bf(g.r.y)};
        *(f32x4*)(bb + 4 * SC_STEPS * 64) = (f32x4){lo_bf(g.k.x), hi_bf(g.k.x), lo_bf(g.k.y), hi_bf(g.k.y)};
        *(f32x4*)(bb + 5 * SC_STEPS * 64) = (f32x4){lo_bf(g.v.x), hi_bf(g.v.x), lo_bf(g.v.y), hi_bf(g.v.y)};
    };
    __syncthreads();
    gload(sA, 0); lstore(sA, 0);
    gload(sA, 1);
    __syncthreads();
    const float vmask = ident ? 0.f : 1.f;
    struct Ops { f32x4 w0, w1, kk0, kk1, ka0, ka1, r0, r1, k0, k1; float v; };
    auto ldops = [&](Ops& o, const float* bb, int st) {
        const float* q = bb + st * 64 + c8;
        o.w0 = *(const f32x4*)(q); o.w1 = *(const f32x4*)(q + 4);
        o.kk0 = *(const f32x4*)(q + 1 * SC_STEPS * 64); o.kk1 = *(const f32x4*)(q + 1 * SC_STEPS * 64 + 4);
        o.ka0 = *(const f32x4*)(q + 2 * SC_STEPS * 64); o.ka1 = *(const f32x4*)(q + 2 * SC_STEPS * 64 + 4);
        o.r0 = *(const f32x4*)(q + 3 * SC_STEPS * 64); o.r1 = *(const f32x4*)(q + 3 * SC_STEPS * 64 + 4);
        o.k0 = *(const f32x4*)(q + 4 * SC_STEPS * 64); o.k1 = *(const f32x4*)(q + 4 * SC_STEPS * 64 + 4);
        o.v = bb[5 * SC_STEPS * 64 + st * 64 + row];
    };
    auto chunk = [&](int ch, Stg& cur  , Stg& nxt  ) {
        if (ch + 2 < NCH) gload(nxt, ch + 2);
        const float* bb = buf + (ch & 1) * 6 * SC_STEPS * 64;
        Ops o; ldops(o, bb, 0);
#pragma unroll
        for (int st = 0; st < SC_STEPS; ++st) {
            Ops n; ldops(n, bb, (st + 1 < SC_STEPS) ? st + 1 : st);
            const float vx = o.v * vmask;
            const f32x4 pa = Sa * o.kk0 + Sb * o.kk1;
            const float sa = -row8_sum((pa.x + pa.y) + (pa.z + pa.w));
            Sa = Sa * o.w0 + o.k0 * vx + o.ka0 * sa;
            Sb = Sb * o.w1 + o.k1 * vx + o.ka1 * sa;
            const f32x4 qa = Sa * o.r0 + Sb * o.r1;
            obuf[st * 32 + rloc] = row8_sum((qa.x + qa.y) + (qa.z + qa.w));
            o = n;
        }
        __syncthreads();
#pragma unroll
        for (int i = 0; i < 2; ++i) {
            const int idx = tid + 256 * i, st = idx >> 5, rr = idx & 31;
            const size_t oi = ((size_t)ch * SC_STEPS + st) * 64 + (grp & 1) * 32 + rr;
            if (ident) yrow[oi] = f2bf(obuf[idx]); else orow[oi] = obuf[idx];
        }
        if (ch + 1 < NCH) lstore(cur, (ch + 1) & 1);
        __syncthreads();
    };
    for (int ch = 0; ch < NCH; ch += 2) {
        chunk(ch, sA, sB);
        if (ch + 1 < NCH) chunk(ch + 1, sB, sA);
    }
    float* fin = (float*)(p.mix + (ident ? MX_XE : MX_SE0)) + ((size_t)(bh * 3 + seg) * 64 + row) * 64 + c8;
    *(f32x4*)fin = Sa; *(f32x4*)(fin + 4) = Sb;
}

__device__ void phase_rwkv_chain(const RwP& p, int bid, int nblk) {
    const int lane = otid() & 63, wave = otid() >> 6;
    const float* SE0 = (const float*)(p.mix + MX_SE0); const float* XE = (const float*)(p.mix + MX_XE);
    bf16_t* SST = (bf16_t*)(p.mix + MX_SST);
    for (int x = bid * 4 + wave; x < 24 * 4; x += nblk * 4) {
        const int bh = x >> 2, cg = (x & 3) * 16;
        const float* s1 = SE0 + ((size_t)(bh * 3 + 0) * 64 + lane) * 64;
        const float* e1 = SE0 + ((size_t)(bh * 3 + 1) * 64 + lane) * 64 + cg;
        const float* X1 = XE + (size_t)(bh * 3 + 1) * 4096 + cg;
        float o[16];
#pragma unroll
        for (int k = 0; k < 16; ++k) o[k] = e1[k];
        for (int i = 0; i < 64; ++i) {
            const float si = s1[i];
#pragma unroll
            for (int k = 0; k < 16; ++k) o[k] += si * X1[i * 64 + k];
        }
        bf16_t* d1 = SST + ((size_t)(bh * 3 + 1) * 64 + lane) * 64 + cg;
        bf16_t* d2 = SST + ((size_t)(bh * 3 + 2) * 64 + lane) * 64 + cg;
#pragma unroll
        for (int k = 0; k < 16; ++k) { d1[k] = f2bf(s1[cg + k]); d2[k] = f2bf(o[k]); }
    }
}

__device__ void phase_rwkv_post(const RwP& p, int bid, int nblk) {
    const int lane = otid() & 63, wave = otid() >> 6;
    const int fl = lane & 15, fq = lane >> 4;
    const bf16_t* Rd = (const bf16_t*)(p.mix + MX_R); const bf16_t* Kd = (const bf16_t*)(p.mix + MX_K); const bf16_t* Vd = (const bf16_t*)(p.mix + MX_V);
    const bf16_t* Gd = (const bf16_t*)(p.mix + MX_G); const bf16_t* SST = (const bf16_t*)(p.mix + MX_SST);
    for (int x = bid * 4 + wave; x < 24 * (NS / 16); x += nblk * 4) {
        const int bh = x / (NS / 16), s0 = (x % (NS / 16)) * 16;
        const int b = bh / 6, hd = bh % 6;
        const int seg = s0 < SEG_BEG[1] ? 0 : (s0 < SEG_BEG[2] ? 1 : 2);
        const size_t hrow = ((size_t)bh * NS + s0 + fl) * 64;
        f32x4 acc[4];
#pragma unroll
        for (int n = 0; n < 4; ++n) acc[n] = *(const f32x4*)(p.oraw + hrow + 16 * n + 4 * fq);
        if (seg > 0) {
            const bf16_t* ss = SST + (size_t)(bh * 3 + seg) * 4096;
#pragma unroll
            for (int ks = 0; ks < 2; ++ks) {
                const bf16x8 yb = *(const bf16x8*)(p.Y + hrow + ks * 32 + fq * 8);
#pragma unroll
                for (int n = 0; n < 4; ++n) {
                    const bf16x8 sa = *(const bf16x8*)(ss + (size_t)(16 * n + fl) * 64 + ks * 32 + fq * 8);
                    acc[n] = __builtin_amdgcn_mfma_f32_16x16x32_bf16(sa, yb, acc[n], 0, 0, 0);
                }
            }
        }
        float sm = 0.f;
#pragma unroll
        for (int n = 0; n < 4; ++n) sm += acc[n].x + acc[n].y + acc[n].z + acc[n].w;
        const float mean = xor32_sum(xor16_sum(sm)) * (1.f / 64.f);
        float sv = 0.f;
#pragma unroll
        for (int n = 0; n < 4; ++n) { acc[n] = acc[n] - mean; sv += acc[n].x * acc[n].x + acc[n].y * acc[n].y + acc[n].z * acc[n].z + acc[n].w * acc[n].w; }
        const float rstd = rsqrtf(xor32_sum(xor16_sum(sv)) * (1.f / 64.f) + 64e-5f);
        float rk = 0.f; f32x4 vv[4];
#pragma unroll
        for (int n = 0; n < 4; ++n) {
            const int c = 16 * n + 4 * fq;
            const u32x2 r2 = *(const u32x2*)(Rd + hrow + c), k2 = *(const u32x2*)(Kd + hrow + c), v2 = *(const u32x2*)(Vd + hrow + c);
            const f32x4 rkw = *(const f32x4*)(p.r_k + hd * 64 + c);
            rk += lo_bf(r2.x) * lo_bf(k2.x) * rkw.x + hi_bf(r2.x) * hi_bf(k2.x) * rkw.y + lo_bf(r2.y) * lo_bf(k2.y) * rkw.z + hi_bf(r2.y) * hi_bf(k2.y) * rkw.w;
            vv[n] = (f32x4){lo_bf(v2.x), hi_bf(v2.x), lo_bf(v2.y), hi_bf(v2.y)};
        }
        rk = xor32_sum(xor16_sum(rk));
        const size_t t = (size_t)b * NS + s0 + fl;
#pragma unroll
        for (int n = 0; n < 4; ++n) {
            const int c = 16 * n + 4 * fq;
            const f32x4 lw = *(const f32x4*)(p.ln_w + hd * 64 + c), lb = *(const f32x4*)(p.ln_b + hd * 64 + c);
            const u32x2 g2 = *(const u32x2*)(Gd + t * 384 + hd * 64 + c);
            const f32x4 gg = (f32x4){lo_bf(g2.x), hi_bf(g2.x), lo_bf(g2.y), hi_bf(g2.y)};
            const f32x4 o = (acc[n] * rstd * lw + lb + vv[n] * rk) * gg;
            u32x2 w; w.x = pk2(o.x, o.y); w.y = pk2(o.z, o.w);
            *(u32x2*)(p.O + t * D + 256 + hd * 64 + c) = w;
        }
    }
}

__device__ __forceinline__ unsigned ordkey(float f) { const unsigned u = __float_as_uint(f); return (u & 0x80000000u) ? ~u : (u | 0x80000000u); }
__device__ __forceinline__ float unordkey(unsigned k) { return __uint_as_float((k & 0x80000000u) ? (k & 0x7FFFFFFFu) : ~k); }
__device__ __forceinline__ void ins16(unsigned (&L)[16], unsigned x) {
#pragma unroll
    for (int i = 0; i < 16; ++i) { const unsigned hi = L[i] > x ? L[i] : x; x = L[i] > x ? x : L[i]; L[i] = hi; }
}
__device__ __forceinline__ void top16_col(const float* col  , unsigned (&L)[16]) {
#pragma unroll
    for (int i = 0; i < 16; ++i) L[i] = 0u;
#pragma unroll 1
    for (int n0 = 0; n0 < 128; n0 += 16) {
        float x[16];
#pragma unroll
        for (int j = 0; j < 16; ++j) x[j] = col[(size_t)(n0 + j) * NT];
#pragma unroll
        for (int j = 0; j < 16; ++j) ins16(L, (ordkey(x[j]) & 0xFFFFFF80u) | (unsigned)(127 - (n0 + j)));
    }
}
__device__ void phase_topk(const float* SCT, int* EIDX, float* GATE, char* smem, int bid, int nblk) {
    const int tid = otid(), lane = tid & 63, wave = tid >> 6;
    unsigned char* itab = (unsigned char*)smem + tid * 32;
    unsigned char* ctab = (unsigned char*)smem + NTHREADS * 32;
    __syncthreads();
    if (tid < 64) {
        const int c = tid; int ci, cj;
        if (c < 16) { ci = 0; cj = c; } else if (c < 24) { ci = 1; cj = c - 16; } else if (c < 29) { ci = 2; cj = c - 24; } else if (c < 33) { ci = 3; cj = c - 29; }
        else if (c < 36) { ci = 4; cj = c - 33; } else if (c < 38) { ci = 5; cj = c - 36; } else if (c < 40) { ci = 6; cj = c - 38; } else if (c < 42) { ci = 7; cj = c - 40; }
        else if (c < 50) { ci = c - 34; cj = 0; } else { ci = 0; cj = 0; }
        ctab[c] = (unsigned char)(ci | (cj << 4));
    }
    __syncthreads();
    for (int x = bid * 4 + wave; x < (NT / 64) * 8; x += nblk * 4) {
        const int tb = x >> 3, hd = x & 7;
        const int t = tb * 64 + lane;
        unsigned L1[16], L2[16];
        top16_col(SCT + (size_t)(hd * 256) * NT + t, L1);
        top16_col(SCT + (size_t)(hd * 256 + 128) * NT + t, L2);
        float s1[16], s2[16];
#pragma unroll
        for (int i = 0; i < 16; ++i) {
            s1[i] = unordkey(L1[i] & 0xFFFFFF80u); s2[i] = unordkey(L2[i] & 0xFFFFFF80u);
            itab[i] = (unsigned char)(127u - (L1[i] & 127u)); itab[16 + i] = (unsigned char)(127u - (L2[i] & 127u));
        }
        unsigned M[16];
#pragma unroll
        for (int i = 0; i < 16; ++i) M[i] = 0u;
        int c = 0;
#pragma unroll
        for (int ci = 0; ci < 16; ++ci) {
#pragma unroll
            for (int cj = 0; cj < 16; ++cj) {
                if ((ci + 1) * (cj + 1) <= 16) {
                    const int cid = (ci == 0) ? cj : (ci == 1) ? 16 + cj : (ci == 2) ? 24 + cj : (ci == 3) ? 29 + cj : (ci == 4) ? 33 + cj : (ci == 5) ? 36 + cj : (ci == 6) ? 38 + cj : (ci == 7) ? 40 + cj : 34 + ci;
                    ins16(M, (ordkey(s1[ci] + s2[cj]) & 0xFFFFFFC0u) | (unsigned)(63 - cid));
                    ++c;
                }
            }
        }
        float ev[16]; int ee[16];
        const float mx = unordkey(M[0] & 0xFFFFFFC0u);
        float sum = 0.f;
#pragma unroll
        for (int i = 0; i < 16; ++i) {
            const int cid = 63 - (int)(M[i] & 63u);
            const unsigned cc = ctab[cid];
            ee[i] = (int)itab[cc & 15u] * 128 + (int)itab[16 + (cc >> 4)];
            ev[i] = __expf(unordkey(M[i] & 0xFFFFFFC0u) - mx);
            sum += ev[i];
        }
        const float inv = 1.f / sum;
        int* eo = EIDX + (size_t)t * 128 + hd * 16; float* go = GATE + (size_t)t * 128 + hd * 16;
#pragma unroll
        for (int i = 0; i < 4; ++i) {
            *(int4*)(eo + 4 * i) = make_int4(ee[4 * i], ee[4 * i + 1], ee[4 * i + 2], ee[4 * i + 3]);
            *(f32x4*)(go + 4 * i) = (f32x4){ev[4 * i] * inv, ev[4 * i + 1] * inv, ev[4 * i + 2] * inv, ev[4 * i + 3] * inv};
        }
    }
    __syncthreads();
}

typedef float f32x2 __attribute__((ext_vector_type(2)));
__device__ __forceinline__ float gelu_erf(float d) { return 0.5f * d * (1.f + erff(d * 0.7071067811865476f)); }
template <int NMODE>
__device__ void phase_expert(const bf16_t* H, const unsigned char* U4, const unsigned char* V4, const float* SU, const float* SV, const int* EIDX, const float* GATE,
                             const float* X, float* Xo, const float* gn, bf16_t* Hn, int bid, int nblk) {
    const int lane = otid() & 63, wave = otid() >> 6;
    for (int t = bid * 4 + wave; t < NT; t += nblk * 4) {
        f32x2 xf[8], acc[8];
        {
            const u32x4 a = *(const u32x4*)(H + (size_t)t * D + lane * 16), b = *(const u32x4*)(H + (size_t)t * D + lane * 16 + 8);
            xf[0] = (f32x2){lo_bf(a.x), hi_bf(a.x)}; xf[1] = (f32x2){lo_bf(a.y), hi_bf(a.y)}; xf[2] = (f32x2){lo_bf(a.z), hi_bf(a.z)}; xf[3] = (f32x2){lo_bf(a.w), hi_bf(a.w)};
            xf[4] = (f32x2){lo_bf(b.x), hi_bf(b.x)}; xf[5] = (f32x2){lo_bf(b.y), hi_bf(b.y)}; xf[6] = (f32x2){lo_bf(b.z), hi_bf(b.z)}; xf[7] = (f32x2){lo_bf(b.w), hi_bf(b.w)};
        }
#pragma unroll
        for (int i = 0; i < 8; ++i) acc[i] = (f32x2){0.f, 0.f};
        const int e_lo = EIDX[(size_t)t * 128 + lane], e_hi = EIDX[(size_t)t * 128 + 64 + lane];
        const float g_lo = GATE[(size_t)t * 128 + lane] * SV[e_lo], g_hi = GATE[(size_t)t * 128 + 64 + lane] * SV[e_hi];
        const float su_lo = SU[e_lo], su_hi = SU[e_hi];
#pragma unroll 1
        for (int e0 = 0; e0 < 128; e0 += 16) {
            const int esrc = (e0 < 64) ? e_lo : e_hi;
            int ei[16]; u32x2 ur[16];
#pragma unroll
            for (int j = 0; j < 16; ++j) { ei[j] = __builtin_amdgcn_readlane(esrc, (e0 & 63) + j); ur[j] = *(const u32x2*)(U4 + (size_t)ei[j] * 512 + lane * 8); }
            float dmine = 0.f;
#pragma unroll
            for (int j = 0; j < 16; ++j) {
                f32x2 d2 = (f32x2){0.f, 0.f};
                d2 = __builtin_elementwise_fma(xf[0], __builtin_amdgcn_cvt_scalef32_pk_f32_fp4(ur[j].x, 1.0f, 0), d2);
                d2 = __builtin_elementwise_fma(xf[1], __builtin_amdgcn_cvt_scalef32_pk_f32_fp4(ur[j].x, 1.0f, 1), d2);
                d2 = __builtin_elementwise_fma(xf[2], __builtin_amdgcn_cvt_scalef32_pk_f32_fp4(ur[j].x, 1.0f, 2), d2);
                d2 = __builtin_elementwise_fma(xf[3], __builtin_amdgcn_cvt_scalef32_pk_f32_fp4(ur[j].x, 1.0f, 3), d2);
                d2 = __builtin_elementwise_fma(xf[4], __builtin_amdgcn_cvt_scalef32_pk_f32_fp4(ur[j].y, 1.0f, 0), d2);
                d2 = __builtin_elementwise_fma(xf[5], __builtin_amdgcn_cvt_scalef32_pk_f32_fp4(ur[j].y, 1.0f, 1), d2);
                d2 = __builtin_elementwise_fma(xf[6], __builtin_amdgcn_cvt_scalef32_pk_f32_fp4(ur[j].y, 1.0f, 2), d2);
                d2 = __builtin_elementwise_fma(xf[7], __builtin_amdgcn_cvt_scalef32_pk_f32_fp4(ur[j].y, 1.0f, 3), d2);
                const float d = wave_sum(d2.x + d2.y);
                if (lane == (e0 & 63) + j) dmine = d;
            }
            const float amine = gelu_erf(dmine * ((e0 < 64) ? su_lo : su_hi)) * ((e0 < 64) ? g_lo : g_hi);
#pragma unroll
            for (int j = 0; j < 16; ++j) ur[j] = *(const u32x2*)(V4 + (size_t)ei[j] * 512 + lane * 8);
#pragma unroll
            for (int j = 0; j < 16; ++j) {
                const float a = __int_as_float(__builtin_amdgcn_readlane(__float_as_int(amine), (e0 & 63) + j));
                const f32x2 a2 = (f32x2){a, a};
                acc[0] = __builtin_elementwise_fma(a2, __builtin_amdgcn_cvt_scalef32_pk_f32_fp4(ur[j].x, 1.0f, 0), acc[0]);
                acc[1] = __builtin_elementwise_fma(a2, __builtin_amdgcn_cvt_scalef32_pk_f32_fp4(ur[j].x, 1.0f, 1), acc[1]);
                acc[2] = __builtin_elementwise_fma(a2, __builtin_amdgcn_cvt_scalef32_pk_f32_fp4(ur[j].x, 1.0f, 2), acc[2]);
                acc[3] = __builtin_elementwise_fma(a2, __builtin_amdgcn_cvt_scalef32_pk_f32_fp4(ur[j].x, 1.0f, 3), acc[3]);
                acc[4] = __builtin_elementwise_fma(a2, __builtin_amdgcn_cvt_scalef32_pk_f32_fp4(ur[j].y, 1.0f, 0), acc[4]);
                acc[5] = __builtin_elementwise_fma(a2, __builtin_amdgcn_cvt_scalef32_pk_f32_fp4(ur[j].y, 1.0f, 1), acc[5]);
                acc[6] = __builtin_elementwise_fma(a2, __builtin_amdgcn_cvt_scalef32_pk_f32_fp4(ur[j].y, 1.0f, 2), acc[6]);
                acc[7] = __builtin_elementwise_fma(a2, __builtin_amdgcn_cvt_scalef32_pk_f32_fp4(ur[j].y, 1.0f, 3), acc[7]);
            }
        }
        const f32x4* xr = (const f32x4*)(X + (size_t)t * D) + lane * 4;
        f32x4* xo = (f32x4*)(Xo + (size_t)t * D) + lane * 4;
        f32x4 o[4]; float ss = 0.f;
#pragma unroll
        for (int i = 0; i < 4; ++i) { o[i] = xr[i]; o[i] += (f32x4){acc[2 * i].x, acc[2 * i].y, acc[2 * i + 1].x, acc[2 * i + 1].y}; ss += o[i].x * o[i].x + o[i].y * o[i].y + o[i].z * o[i].z + o[i].w * o[i].w; }
        const float rs = rsqrtf(wave_sum(ss) * (1.f / D) + 1e-6f);
        const f32x4* gp = (const f32x4*)gn + lane * 4;
        if (NMODE == 1) {
#pragma unroll
            for (int i = 0; i < 4; ++i) xo[i] = o[i] * rs * gp[i];
        } else {
            u32x4 h0, h1;
            { const f32x4 y0 = o[0] * rs * gp[0], y1 = o[1] * rs * gp[1], y2 = o[2] * rs * gp[2], y3 = o[3] * rs * gp[3];
              h0 = (u32x4){pk2(y0.x, y0.y), pk2(y0.z, y0.w), pk2(y1.x, y1.y), pk2(y1.z, y1.w)}; h1 = (u32x4){pk2(y2.x, y2.y), pk2(y2.z, y2.w), pk2(y3.x, y3.y), pk2(y3.z, y3.w)}; }
#pragma unroll
            for (int i = 0; i < 4; ++i) xo[i] = o[i];
            *(u32x4*)(Hn + (size_t)t * D + lane * 16) = h0; *(u32x4*)(Hn + (size_t)t * D + lane * 16 + 8) = h1;
        }
    }
}

#define XB_TMO      128
#define XB_XCNT(j)  (256  + 64 * (j))
#define XB_XSUB(j)  (1280 + 64 * (j))
#define XB_XGEN(j)  (2304 + 64 * (j))
#define XB_TOP      3328
#define XB_TOPGEN   3392
#define XCD_BAR_WORDS 3456
#define XB_SPIN_CAP (1u << 22)
#define LAS __attribute__((address_space(3)))
__device__ __forceinline__ unsigned xb_ld(unsigned* p)              { return __hip_atomic_load(p, __ATOMIC_RELAXED, __HIP_MEMORY_SCOPE_AGENT); }
__device__ __forceinline__ unsigned xb_add(unsigned* p, unsigned v) { return __hip_atomic_fetch_add(p, v, __ATOMIC_RELAXED, __HIP_MEMORY_SCOPE_AGENT); }
__device__ __forceinline__ unsigned xb_xcc_id() { return (unsigned)__builtin_amdgcn_s_getreg((3 << 11) | 20) & 0xFu; }
#define XB_SPIN(cond, bar) do { unsigned _sp = 0; while (cond) { __builtin_amdgcn_s_sleep(1); \
    if ((++_sp & 255u) == 0u) { if (xb_ld(&(bar)[XB_TMO])) break; if (_sp > XB_SPIN_CAP) { atomicAdd(&(bar)[XB_TMO], 1u); break; } } } } while (0)
struct XcdBarrier { unsigned* bar; unsigned x; volatile LAS unsigned* st; };
__device__ __forceinline__ XcdBarrier xcd_barrier_post(unsigned* bar, volatile LAS unsigned* st) {
    XcdBarrier b; b.bar = bar; b.x = xb_xcc_id(); b.st = st;
    if (threadIdx.x == 0) (void)xb_add(&bar[XB_XCNT(b.x)], 1u);
    return b;
}
__device__ __forceinline__ void xcd_barrier_complete(unsigned* bar, unsigned x, unsigned& nloc, unsigned& nx) {
    const unsigned G = gridDim.x * gridDim.y * gridDim.z;
    unsigned sum, cnt, mine, sp = 0u;
    for (;;) {
        sum = 0u; cnt = 0u; mine = 0u;
#pragma unroll
        for (unsigned j = 0; j < 16; ++j) { const unsigned c = xb_ld(&bar[XB_XCNT(j)]); sum += c; cnt += (c > 0u) ? 1u : 0u; mine = (j == x) ? c : mine; }
        if (sum == G) break;
        __builtin_amdgcn_s_sleep(1);
        if ((++sp & 255u) == 0u) { if (xb_ld(&bar[XB_TMO])) break; if (sp > XB_SPIN_CAP) { atomicAdd(&bar[XB_TMO], 1u); break; } }
    }
    nloc = mine > 0u ? mine : 1u; nx = cnt > 0u ? cnt : 1u;
}
__device__ __forceinline__ void xcd_barrier(const XcdBarrier& b) {
    asm volatile("s_waitcnt vmcnt(0)" ::: "memory");
    __syncthreads();
    if (threadIdx.x == 0) {
        unsigned* bar = b.bar;
        __builtin_amdgcn_s_waitcnt(0);
        unsigned nloc = b.st[0], nx = b.st[1];
        if (nloc == 0u) { xcd_barrier_complete(bar, b.x, nloc, nx); b.st[0] = nloc; b.st[1] = nx; }
        const unsigned old = xb_add(&bar[XB_XSUB(b.x)], 1u);
        const unsigned gen = old / nloc;
        if (old + 1u == (gen + 1u) * nloc) {
            __builtin_amdgcn_fence(__ATOMIC_RELEASE, "agent");
            asm volatile("s_waitcnt vmcnt(0)" ::: "memory");
            const unsigned og = xb_add(&bar[XB_TOP], 1u);
            const unsigned tg = og / nx;
            if (og + 1u == (tg + 1u) * nx) xb_add(&bar[XB_TOPGEN], 1u);
            else XB_SPIN(xb_ld(&bar[XB_TOPGEN]) == tg, bar);
            __builtin_amdgcn_fence(__ATOMIC_ACQUIRE, "agent");
            xb_add(&bar[XB_XGEN(b.x)], 1u);
            asm volatile("s_waitcnt vmcnt(0)" ::: "memory");
        } else {
            XB_SPIN(xb_ld(&bar[XB_XGEN(b.x)]) == gen, bar);
            __builtin_amdgcn_fence(__ATOMIC_ACQUIRE, "agent");
            asm volatile("s_waitcnt vmcnt(0)" ::: "memory");
        }
    }
    __syncthreads();
}

struct Params {
    const float* in[24];
    float* out; unsigned char* ws;
};
constexpr int LDS_BYTES = 2 * 2 * 128 * GS * 2 + 256;

__device__ __forceinline__ RwP make_rwp(const Params& P, int l) {
    RwP r;
    r.Z = (const bf16_t*)(P.ws + WS_Z); r.mix = P.ws + WS_MIX;
    r.mu = P.in[6] + l * RW_F; r.w_up = P.in[7] + (size_t)l * 64 * 384; r.w_bias = P.in[8] + l * 384; r.a_up = P.in[9] + (size_t)l * 64 * 384; r.a_bias = P.in[10] + l * 384;
    r.g_up = P.in[11] + (size_t)l * 128 * 384; r.k_k = P.in[12] + l * 384; r.k_a = P.in[13] + l * 384; r.r_k = P.in[14] + l * 384; r.ln_w = P.in[15] + l * 384; r.ln_b = P.in[16] + l * 384;
    r.oraw = (float*)(P.ws + WS_H); r.O = (bf16_t*)(P.ws + WS_O); r.Y = (bf16_t*)(P.ws + WS_EIDX); r.lora = (const bf16_t*)(P.ws + WS_LORA + l * LORA_L);
    return r;
}

__global__ void __launch_bounds__(NTHREADS, 2) mega_fwd(Params P) {
    extern __shared__ __attribute__((aligned(16))) char smem[];
    const int bid = blockIdx.x, nblk = gridDim.x;
    volatile LAS unsigned* st = (volatile LAS unsigned*)(smem + LDS_BYTES - 16);
    if (threadIdx.x == 0) { st[0] = 0u; st[1] = 0u; st[2] = 0u; st[3] = 0u; }
    __syncthreads();
    XcdBarrier bar = xcd_barrier_post((unsigned*)(P.ws + WS_CTL), st);
#define GSYNC() xcd_barrier(bar)

    {
        ConvP c{P.in[4], P.in[5], P.in[20], P.in[21], P.in[22], P.in[23], P.in[7], P.in[9], P.in[11], P.ws};
        phase_convert_weights(c, smem, bid, nblk);
        phase_rmsnorm<false>(P.in[0], P.in[1], P.ws + WS_H, bid, nblk);
    }
    GSYNC();
#pragma unroll 1
    for (int l = 0; l < 2; ++l) {
        const float* xin = (l == 0) ? P.in[0] : P.out;
        {
            GemmP g{(const bf16_t*)(P.ws + WS_H), D, 0, 0, (const bf16_t*)(P.ws + WS_WTIN) + (size_t)l * DINP * D, D, D, NT / 128, DINP / 128 - 1, P.ws + WS_Z, DINP, nullptr};
            phase_gemm<0>(g, smem, bid, nblk);
            phase_gemm<0, true>(g, smem, bid, nblk, (NT / 128 * (DINP / 128 - 1)) % nblk);
            if (l == 0) {
                for (int l2 = 0; l2 < 2; ++l2) {
                    GemmP ge{(const bf16_t*)(P.ws + WS_SK) + (size_t)l2 * 16 * 128 * 128, 128, 0, 128, (const bf16_t*)(P.ws + WS_WTQ) + (size_t)l2 * D * 2048, 2048, 128, 16, 8,
                             (bf16_t*)(P.ws + WS_WEFF) + (size_t)l2 * 2048 * D, D, nullptr};
                    phase_gemm<0>(ge, smem, bid, nblk, (NT / 128 * (DINP / 128) + l2 * 128) % nblk);
                }
            }
        }
        GSYNC();
        RwP rw = make_rwp(P, l);
        LinP lp{(const bf16_t*)(P.ws + WS_Z), (bf16_t*)(P.ws + WS_O), P.in[17] + (size_t)l * 16 * 192, P.in[18] + l * 192, P.in[19] + l * 384, (const float*)(P.ws + WS_ROPE), P.ws + WS_LIN};
        for (int task = bid; task < 512 + 2048; task += nblk) {
            if (task < 512) { rwkv_prep_task(rw, smem, task); }
            else { lin_kv_dispatch(lp, smem, task - 512); }
        }
        GSYNC();
        {
            for (int task = bid; task < 240; task += nblk) {
                const int bh = task / 10, r = task % 10;
                const int seg = r < 2 ? 0 : (r < 6 ? 1 : 2), grp = r < 2 ? r : (r < 6 ? r - 2 : r - 6);
                rwkv_scan_task(rw, smem, bh, seg, grp);
            }
            unsigned* lflags = (unsigned*)(P.ws + WS_FLAGS) + l * 32;
            if (nblk >= 512) {
                if (bid >= 240) {
                    lin_scan_phase(lp, bid - 240, nblk - 240, lflags);
                    for (int task = bid - 240; task < 2048; task += nblk - 240) lin_out_dispatch(lp, smem, task, lflags);
                }
            } else {
                lin_scan_phase(lp, bid, nblk, lflags);
                for (int task = bid; task < 2048; task += nblk) lin_out_dispatch(lp, smem, task, lflags);
            }
            if (l == 0) {
                ConvP c{P.in[4], P.in[5], P.in[20], P.in[21], P.in[22], P.in[23], P.in[7], P.in[9], P.in[11], P.ws};
                if (nblk >= 512) { if (bid >= 240) phase_convert_uv(c, bid - 240, nblk - 240); } else phase_convert_uv(c, bid, nblk);
            }
        }
        GSYNC();
        phase_rwkv_chain(rw, bid, nblk);
        GSYNC();
        phase_rwkv_post(rw, bid, nblk);
        GSYNC();
        {
            GemmP g{(const bf16_t*)(P.ws + WS_O), D, 0, 0, (const bf16_t*)(P.ws + WS_WTOUT) + (size_t)l * D * D, D, D, NT / 128, D / 128, P.out, D, xin};
            phase_gemm<2>(g, smem, bid, nblk);
        }
        GSYNC();
        phase_rmsnorm<false>(P.out, P.in[2] + l * D, P.ws + WS_H, bid, nblk);
        GSYNC();
        {
            GemmP g{(const bf16_t*)(P.ws + WS_H), D, 0, 0, (const bf16_t*)(P.ws + WS_WEFF) + (size_t)l * 2048 * D, D, D, NT / 128, 2048 / 128, P.ws + WS_MIX, NT, nullptr};
            phase_gemm<3>(g, smem, bid, nblk);
        }
        GSYNC();
        phase_topk((const float*)(P.ws + WS_MIX), (int*)(P.ws + WS_EIDX), (float*)(P.ws + WS_GATE), smem, bid, nblk);
        GSYNC();
        if (l == 0) phase_expert<0>((const bf16_t*)(P.ws + WS_H), P.ws + WS_UB + (size_t)l * NEXP * 512, P.ws + WS_VB + (size_t)l * NEXP * 512,
                     (const float*)(P.ws + WS_ESC) + l * NEXP, (const float*)(P.ws + WS_ESC) + (2 + l) * NEXP,
                     (const int*)(P.ws + WS_EIDX), (const float*)(P.ws + WS_GATE), P.out, P.out, P.in[1] + D, (bf16_t*)(P.ws + WS_H), bid, nblk);
        else phase_expert<1>((const bf16_t*)(P.ws + WS_H), P.ws + WS_UB + (size_t)l * NEXP * 512, P.ws + WS_VB + (size_t)l * NEXP * 512,
                     (const float*)(P.ws + WS_ESC) + l * NEXP, (const float*)(P.ws + WS_ESC) + (2 + l) * NEXP,
                     (const int*)(P.ws + WS_EIDX), (const float*)(P.ws + WS_GATE), P.out, P.out, P.in[3], nullptr, bid, nblk);
        if (l == 0) GSYNC();
    }
}

extern "C" void kernel_launch(void* const* d_in, const int* in_sizes, int n_in, void* d_out, int out_size, void* d_ws, size_t ws_size, hipStream_t stream) {
    static int grid = 0;
    if (grid == 0) {
        if (n_in != 24 || ws_size < WS_END) { fprintf(stderr, "kernel_launch: bad args n_in=%d ws=%zu need=%zu\n", n_in, ws_size, (size_t)WS_END); grid = -1; return; }
        int dev = 0, cus = 0, per_cu = 0;
        hipGetDevice(&dev);
        hipDeviceGetAttribute(&cus, hipDeviceAttributeMultiprocessorCount, dev);
        hipFuncSetAttribute((const void*)mega_fwd, hipFuncAttributeMaxDynamicSharedMemorySize, LDS_BYTES);
        hipOccupancyMaxActiveBlocksPerMultiprocessor(&per_cu, (const void*)mega_fwd, NTHREADS, LDS_BYTES);
        if (per_cu < 1) { fprintf(stderr, "kernel_launch: occupancy query says %d\n", per_cu); grid = -1; return; }
        if (per_cu > 2) per_cu = 2;
        grid = cus * per_cu;
        fprintf(stderr, "kernel_launch: grid %d (%d CUs x %d)\n", grid, cus, per_cu);
    }
    if (grid < 0) return;
    hipMemsetAsync((char*)d_ws + WS_CTL, 0, 32768, stream);
    Params P{};
    for (int i = 0; i < 24; ++i) P.in[i] = (const float*)d_in[i];
    P.out = (float*)d_out; P.ws = (unsigned char*)d_ws;
    void* args[] = {&P};
    hipError_t e = hipLaunchCooperativeKernel((const void*)mega_fwd, dim3(grid), dim3(NTHREADS), args, LDS_BYTES, stream);
    if (e != hipSuccess) fprintf(stderr, "cooperative launch failed: %s (grid %d)\n", hipGetErrorString(e), grid);
}
```

```cpp
#include <hip/hip_runtime.h>
#include <stdint.h>
#include <stdio.h>

typedef unsigned short bf16_t;
typedef short bf16x8 __attribute__((ext_vector_type(8)));
typedef float f32x4 __attribute__((ext_vector_type(4)));
typedef unsigned u32x4 __attribute__((ext_vector_type(4)));
typedef unsigned u32x2 __attribute__((ext_vector_type(2)));

constexpr int NB = 4, NS = 4096, NT = NB * NS, D = 1024, DIN = 3600, DINP = 3712;
constexpr int ZC_RET = 0, ZC_RW = 1024, ZC_GLA = 2432;
constexpr int RW_F = 1408;
constexpr int NEXP = 16384;
constexpr int NTHREADS = 256;

constexpr size_t MiB = 1024ull * 1024ull;
constexpr size_t WS_CTL   = 0;
constexpr size_t WS_LORA  = 65536;
constexpr size_t LORA_L   = 384ull * 256 * 2;
constexpr size_t WS_ESC   = 524288;
constexpr size_t WS_WTIN  = 1 * MiB;
constexpr size_t WS_WTOUT = WS_WTIN + 2ull * DINP * D * 2;
constexpr size_t WS_WTQ   = WS_WTOUT + 2ull * D * D * 2;
constexpr size_t WS_SK    = WS_WTQ + 2ull * 2048 * D * 2;
constexpr size_t WS_UB    = WS_SK + 2ull * 16 * 128 * 128 * 2;
constexpr size_t WS_VB    = WS_UB + 2ull * NEXP * D;
constexpr size_t WS_LIN   = WS_VB + 2ull * NEXP * D;
constexpr size_t WS_H     = WS_LIN + 64 * MiB;
constexpr size_t WS_Z     = WS_H + (size_t)NT * D * 2;
constexpr size_t WS_O     = WS_Z + (size_t)NT * DINP * 2;
constexpr size_t WS_MIX   = WS_O + (size_t)NT * D * 2;
constexpr size_t WS_EIDX  = WS_MIX + 128 * MiB;
constexpr size_t WS_GATE  = WS_EIDX + (size_t)NT * 128 * 4;
constexpr size_t WS_ROPE  = WS_GATE + (size_t)NT * 128 * 4;
constexpr size_t WS_WEFF  = WS_ROPE + 1 * MiB;
constexpr size_t WS_END   = WS_WEFF + 2ull * 2048 * D * 2;
constexpr size_t RWA = (size_t)NT * 384;
constexpr size_t MX_W   = 0;
constexpr size_t MX_KK  = MX_W + RWA * 4;
constexpr size_t MX_KKA = MX_KK + RWA * 4;
constexpr size_t MX_R   = MX_KKA + RWA * 4;
constexpr size_t MX_K   = MX_R + RWA * 2;
constexpr size_t MX_V   = MX_K + RWA * 2;
constexpr size_t MX_G   = MX_V + RWA * 2;
constexpr size_t MX_END = MX_G + RWA * 2;
static_assert(MX_END <= 128 * MiB, "mix region");

__device__ __forceinline__ float bf2f(bf16_t v) { return __uint_as_float(((unsigned)v) << 16); }
__device__ __forceinline__ bf16_t f2bf(float f) { unsigned u = __float_as_uint(f); u += 0x7FFFu + ((u >> 16) & 1u); return (bf16_t)(u >> 16); }
__device__ __forceinline__ unsigned pk2(float lo, float hi) { return (unsigned)f2bf(lo) | ((unsigned)f2bf(hi) << 16); }
__device__ __forceinline__ float lo_bf(unsigned u) { return __uint_as_float(u << 16); }
__device__ __forceinline__ float hi_bf(unsigned u) { return __uint_as_float(u & 0xFFFF0000u); }
template <int CTRL> __device__ __forceinline__ float dpp_f(float v) { return __int_as_float(__builtin_amdgcn_update_dpp(0, __float_as_int(v), CTRL, 0xF, 0xF, true)); }
template <int CTRL> __device__ __forceinline__ unsigned dpp_u(unsigned v) { return (unsigned)__builtin_amdgcn_update_dpp(0, (int)v, CTRL, 0xF, 0xF, true); }
__device__ __forceinline__ float row16_sum(float v) { v += dpp_f<0x128>(v); v += dpp_f<0x124>(v); v += dpp_f<0x122>(v); v += dpp_f<0x121>(v); return v; }
__device__ __forceinline__ float xor16_sum(float v) { auto r = __builtin_amdgcn_permlane16_swap(__float_as_uint(v), __float_as_uint(v), false, false); return __uint_as_float(r[0]) + __uint_as_float(r[1]); }
__device__ __forceinline__ float xor32_sum(float v) { auto r = __builtin_amdgcn_permlane32_swap(__float_as_uint(v), __float_as_uint(v), false, false); return __uint_as_float(r[0]) + __uint_as_float(r[1]); }
__device__ __forceinline__ float wave_sum(float v) { return xor32_sum(xor16_sum(row16_sum(v))); }
__device__ __forceinline__ unsigned umax_(unsigned a, unsigned b) { return a > b ? a : b; }
__device__ __forceinline__ unsigned wave_max_u32(unsigned v) {
    v = umax_(v, dpp_u<0x128>(v)); v = umax_(v, dpp_u<0x124>(v)); v = umax_(v, dpp_u<0x122>(v)); v = umax_(v, dpp_u<0x121>(v));
    { auto r = __builtin_amdgcn_permlane16_swap(v, v, false, false); v = umax_(r[0], r[1]); }
    { auto r = __builtin_amdgcn_permlane32_swap(v, v, false, false); v = umax_(r[0], r[1]); }
    return v;
}
__device__ __forceinline__ float sigmoidf_(float x) { return 1.f / (1.f + __expf(-x)); }
__device__ __forceinline__ float softplusf_(float x) { return fmaxf(x, 0.f) + __logf(1.f + __expf(-fabsf(x))); }
__device__ __forceinline__ float tanhf_(float x) { const float e = __expf(2.f * fminf(fmaxf(x, -15.f), 15.f)); return (e - 1.f) / (e + 1.f); }

__device__ __forceinline__ int otid() { int t = threadIdx.x; asm volatile("" : "+v"(t)); return t; }

constexpr size_t WS_FLAGS = 16384;
__device__ __forceinline__ void flag_signal(unsigned* f) {
    asm volatile("s_waitcnt vmcnt(0)" ::: "memory");
    __syncthreads();
    if (threadIdx.x == 0) {
        __builtin_amdgcn_fence(__ATOMIC_RELEASE, "agent");
        asm volatile("s_waitcnt vmcnt(0)" ::: "memory");
        __hip_atomic_fetch_add(f, 1u, __ATOMIC_RELAXED, __HIP_MEMORY_SCOPE_AGENT);
    }
}
__device__ __forceinline__ void flag_wait(unsigned* f, unsigned need) {
    if (threadIdx.x == 0) {
        unsigned sp = 0;
        while (__hip_atomic_load(f, __ATOMIC_RELAXED, __HIP_MEMORY_SCOPE_AGENT) < need) { __builtin_amdgcn_s_sleep(4); if (++sp > (1u << 22)) break; }
        __builtin_amdgcn_fence(__ATOMIC_ACQUIRE, "agent");
        asm volatile("s_waitcnt vmcnt(0)" ::: "memory");
    }
    __syncthreads();
}

__device__ void transpose_tile(const float* __restrict__ W, int K, int N, bf16_t* __restrict__ Wt, int kt, int nt, float* tile  ) {
    const int tid = otid();
    const int k0 = kt * 64, n0 = nt * 64;
#pragma unroll
    for (int i = 0; i < 4; ++i) {
        const int k = i * 16 + (tid >> 4), n4 = (tid & 15) * 4;
        f32x4 v = (f32x4){0.f, 0.f, 0.f, 0.f};
        if (n0 + n4 < N) v = *(const f32x4*)(W + (size_t)(k0 + k) * N + n0 + n4);
        tile[k * 65 + n4] = v.x; tile[k * 65 + n4 + 1] = v.y; tile[k * 65 + n4 + 2] = v.z; tile[k * 65 + n4 + 3] = v.w;
    }
    __syncthreads();
    {
        const int n = tid >> 2, kc = (tid & 3) * 16;
        unsigned w[8];
#pragma unroll
        for (int j = 0; j < 8; ++j) w[j] = pk2(tile[(kc + 2 * j) * 65 + n], tile[(kc + 2 * j + 1) * 65 + n]);
        u32x4* dst = (u32x4*)(Wt + (size_t)(n0 + n) * K + k0 + kc);
        dst[0] = (u32x4){w[0], w[1], w[2], w[3]}; dst[1] = (u32x4){w[4], w[5], w[6], w[7]};
    }
    __syncthreads();
}

struct ConvP {
    const float* w_in; const float* w_out; const float* w_q; const float* sk; const float* u; const float* v;
    const float* w_up; const float* a_up; const float* g_up;
    unsigned char* ws;
};

__device__ void phase_convert_weights(const ConvP& p, char* smem, int bid, int nblk) {
    float* tile = (float*)smem;
    constexpr int T_IN = 16 * 58, T_OUT = 16 * 16, T_L = T_IN + T_OUT;
    for (int it = bid; it < 2 * T_L; it += nblk) {
        const int l = it / T_L; int r = it % T_L;
        if (r < T_IN) { transpose_tile(p.w_in + (size_t)l * D * DIN, D, DIN, (bf16_t*)(p.ws + WS_WTIN) + (size_t)l * DINP * D, r / 58, r % 58, tile); continue; }
        r -= T_IN;
        transpose_tile(p.w_out + (size_t)l * D * D, D, D, (bf16_t*)(p.ws + WS_WTOUT) + (size_t)l * D * D, r / 16, r % 16, tile);
    }
    const size_t gtid = (size_t)bid * NTHREADS + otid(), gn = (size_t)nblk * NTHREADS;
    {
        for (size_t i = gtid; i < 2ull * 384 * 256; i += gn) {
            const int l = (int)(i / (384 * 256)), r = (int)(i % (384 * 256)), c = r >> 8, k = r & 255;
            bf16_t* base = (bf16_t*)(p.ws + WS_LORA + l * LORA_L);
            if (k < 64) base[c * 64 + k] = f2bf(p.w_up[(size_t)l * 64 * 384 + k * 384 + c]);
            else if (k < 128) base[384 * 64 + c * 64 + (k - 64)] = f2bf(p.a_up[(size_t)l * 64 * 384 + (k - 64) * 384 + c]);
            else base[2 * 384 * 64 + c * 128 + (k - 128)] = f2bf(p.g_up[(size_t)l * 128 * 384 + (k - 128) * 384 + c]);
        }
    }
    {
        float* ct = (float*)(p.ws + WS_ROPE); float* stb = ct + NS * 32;
        for (size_t i = gtid; i < (size_t)NS * 32; i += gn) {
            const int pos = (int)(i >> 5), fi = (int)(i & 31);
            const float inv = exp2f(-(float)fi * (13.287712379549449f / 32.f));
            float sn, cs; sincosf((float)pos * inv, &sn, &cs);
            ct[i] = cs; stb[i] = sn;
        }
    }
    {
        const size_t n8 = (2ull * D * 2048) / 8;
        const f32x4* s = (const f32x4*)p.w_q; u32x4* d = (u32x4*)(p.ws + WS_WTQ);
        for (size_t i = gtid; i < n8; i += gn) { f32x4 a = s[2 * i], b = s[2 * i + 1]; u32x4 o; o.x = pk2(a.x, a.y); o.y = pk2(a.z, a.w); o.z = pk2(b.x, b.y); o.w = pk2(b.z, b.w); d[i] = o; }
    }
    {
        const size_t n8 = (2ull * 16 * 128 * 128) / 8;
        const f32x4* s = (const f32x4*)p.sk; u32x4* d = (u32x4*)(p.ws + WS_SK);
        for (size_t i = gtid; i < n8; i += gn) { f32x4 a = s[2 * i], b = s[2 * i + 1]; u32x4 o; o.x = pk2(a.x, a.y); o.y = pk2(a.z, a.w); o.z = pk2(b.x, b.y); o.w = pk2(b.z, b.w); d[i] = o; }
    }
}

__device__ void phase_convert_uv(const ConvP& p, int bid, int nblk) {
    {
        const int lane = otid() & 63, gw = bid * 4 + (otid() >> 6), ngw = nblk * 4;
        for (int r = gw; r < 4 * NEXP; r += ngw) {
            const bool isv = r >= 2 * NEXP; const int rr = isv ? r - 2 * NEXP : r;
            const f32x4* src = (const f32x4*)((isv ? p.v : p.u) + (size_t)rr * D) + lane * 4;
            f32x4 x[4]; float mx = 0.f;
#pragma unroll
            for (int i = 0; i < 4; ++i) { x[i] = src[i]; mx = fmaxf(mx, fmaxf(fmaxf(fabsf(x[i].x), fabsf(x[i].y)), fmaxf(fabsf(x[i].z), fabsf(x[i].w)))); }
            mx = __uint_as_float(wave_max_u32(__float_as_uint(mx)));
            const float sc = mx > 0.f ? 6.f / mx : 0.f;
            unsigned w0 = 0u, w1 = 0u;
            w0 = __builtin_amdgcn_cvt_scalef32_pk_fp4_f32(w0, x[0].x * sc, x[0].y * sc, 1.0f, 0); w0 = __builtin_amdgcn_cvt_scalef32_pk_fp4_f32(w0, x[0].z * sc, x[0].w * sc, 1.0f, 1);
            w0 = __builtin_amdgcn_cvt_scalef32_pk_fp4_f32(w0, x[1].x * sc, x[1].y * sc, 1.0f, 2); w0 = __builtin_amdgcn_cvt_scalef32_pk_fp4_f32(w0, x[1].z * sc, x[1].w * sc, 1.0f, 3);
            w1 = __builtin_amdgcn_cvt_scalef32_pk_fp4_f32(w1, x[2].x * sc, x[2].y * sc, 1.0f, 0); w1 = __builtin_amdgcn_cvt_scalef32_pk_fp4_f32(w1, x[2].z * sc, x[2].w * sc, 1.0f, 1);
            w1 = __builtin_amdgcn_cvt_scalef32_pk_fp4_f32(w1, x[3].x * sc, x[3].y * sc, 1.0f, 2); w1 = __builtin_amdgcn_cvt_scalef32_pk_fp4_f32(w1, x[3].z * sc, x[3].w * sc, 1.0f, 3);
            *(u32x2*)(p.ws + (isv ? WS_VB : WS_UB) + (size_t)rr * 512 + lane * 8) = (u32x2){w0, w1};
            if (lane == 0) ((float*)(p.ws + WS_ESC))[r] = mx * (1.f / 6.f);
        }
    }
}

template <bool OUT_F32>
__device__ void phase_rmsnorm(const float* x, const float* __restrict__ g, void* out, int bid, int nblk) {
    const int lane = otid() & 63, wave = otid() >> 6;
    const int gw = bid * 4 + wave, ngw = nblk * 4;
    f32x4 gv[4];
#pragma unroll
    for (int j = 0; j < 4; ++j) gv[j] = ((const f32x4*)g)[lane + 64 * j];
    for (int row = gw; row < NT; row += ngw) {
        const f32x4* xr = (const f32x4*)(x + (size_t)row * D) + lane;
        f32x4 v[4]; float s = 0.f;
#pragma unroll
        for (int j = 0; j < 4; ++j) { v[j] = xr[64 * j]; s += v[j].x * v[j].x + v[j].y * v[j].y + v[j].z * v[j].z + v[j].w * v[j].w; }
        s = wave_sum(s);
        const float rs = rsqrtf(s * (1.f / D) + 1e-6f);
        if (OUT_F32) {
            f32x4* o = (f32x4*)((float*)out + (size_t)row * D) + lane;
#pragma unroll
            for (int j = 0; j < 4; ++j) o[64 * j] = v[j] * rs * gv[j];
        } else {
            u32x2* o = (u32x2*)((bf16_t*)out + (size_t)row * D) + lane;
#pragma unroll
            for (int j = 0; j < 4; ++j) { f32x4 y = v[j] * rs * gv[j]; u32x2 w; w.x = pk2(y.x, y.y); w.y = pk2(y.z, y.w); o[64 * j] = w; }
        }
    }
}

struct GemmP {
    const bf16_t* A; int lda; int a_koff;
    int b_koff;
    const bf16_t* Bt; int ldb; int K;
    int MT, NTl;
    void* C; int ldc; const float* R;
};
constexpr int GS = 72;
template <int MODE, bool NARROW = false>
__device__ void phase_gemm(const GemmP& p, char* smem, int bid, int nblk, int tile0 = 0) {
    bf16_t* As = (bf16_t*)smem;
    bf16_t* Bs = As + 128 * GS;
    const int tid = otid(), lane = tid & 63, wave = tid >> 6;
    const int wr = wave >> 1, wc = wave & 1;
    const int lr = tid >> 3, lc = (tid & 7) * 8;
    const int fl = lane & 15, fq = lane >> 4;
    const int ntiles = NARROW ? p.MT : p.MT * p.NTl;
    const bool act = !NARROW || (__builtin_amdgcn_readfirstlane(wc) == 0);
    for (int tile = bid - tile0 + ((bid < tile0) ? nblk * ((tile0 - bid + nblk - 1) / nblk) : 0); tile < ntiles; tile += nblk) {
        const int mt = NARROW ? tile : tile / p.NTl, nt = NARROW ? p.NTl : tile % p.NTl;
        const bf16_t* Ag = p.A + (size_t)mt * 128 * p.lda + (size_t)nt * p.a_koff + (size_t)lr * p.lda + lc;
        const bf16_t* Bg = p.Bt + (size_t)nt * 128 * p.ldb + (size_t)mt * p.b_koff + (size_t)lr * p.ldb + lc;
        f32x4 acc[4][4];
#pragma unroll
        for (int m = 0; m < 4; ++m)
#pragma unroll
            for (int n = 0; n < 4; ++n) acc[m][n] = (f32x4){0.f, 0.f, 0.f, 0.f};
        u32x4 ra[4], rb[4];
        const int nk = p.K >> 6;
#pragma unroll
        for (int i = 0; i < 4; ++i) { ra[i] = *(const u32x4*)(Ag + (size_t)(32 * i) * p.lda); rb[i] = *(const u32x4*)(Bg + (size_t)(32 * i) * p.ldb); }
        __syncthreads();
#pragma unroll
        for (int i = 0; i < 4; ++i) { *(u32x4*)(As + (lr + 32 * i) * GS + lc) = ra[i]; *(u32x4*)(Bs + (lr + 32 * i) * GS + lc) = rb[i]; }
        if (nk > 1) {
#pragma unroll
            for (int i = 0; i < 4; ++i) { ra[i] = *(const u32x4*)(Ag + (size_t)(32 * i) * p.lda + 64); rb[i] = *(const u32x4*)(Bg + (size_t)(32 * i) * p.ldb + 64); }
        }
        __syncthreads();
        for (int kt = 0; kt < nk; ++kt) {
            const bf16_t* Ac = As + (kt & 1) * (256 * GS); const bf16_t* Bc = Ac + 128 * GS;
            bf16_t* An = As + ((kt & 1) ^ 1) * (256 * GS); bf16_t* Bn = An + 128 * GS;
            if (kt + 1 < nk) {
#pragma unroll
                for (int i = 0; i < 4; ++i) { *(u32x4*)(An + (lr + 32 * i) * GS + lc) = ra[i]; *(u32x4*)(Bn + (lr + 32 * i) * GS + lc) = rb[i]; }
                if (kt + 2 < nk) {
#pragma unroll
                    for (int i = 0; i < 4; ++i) { ra[i] = *(const u32x4*)(Ag + (size_t)(32 * i) * p.lda + (kt + 2) * 64); rb[i] = *(const u32x4*)(Bg + (size_t)(32 * i) * p.ldb + (kt + 2) * 64); }
                }
            }
#pragma unroll
            for (int ks = 0; ks < 2; ++ks) {
                bf16x8 xa[4], wb[4];
                if (act) {
#pragma unroll
                for (int m = 0; m < 4; ++m) xa[m] = *(const bf16x8*)(Ac + (wr * 64 + m * 16 + fl) * GS + ks * 32 + fq * 8);
#pragma unroll
                for (int n = 0; n < (NARROW ? 1 : 4); ++n) wb[n] = *(const bf16x8*)(Bc + (wc * 64 + n * 16 + fl) * GS + ks * 32 + fq * 8);
#pragma unroll
                for (int m = 0; m < 4; ++m)
#pragma unroll
                    for (int n = 0; n < (NARROW ? 1 : 4); ++n) acc[m][n] = (MODE == 3) ? __builtin_amdgcn_mfma_f32_16x16x32_bf16(xa[m], wb[n], acc[m][n], 0, 0, 0)
                                                                                    : __builtin_amdgcn_mfma_f32_16x16x32_bf16(wb[n], xa[m], acc[m][n], 0, 0, 0);
                }
            }
            __syncthreads();
        }
        if (act)
#pragma unroll
        for (int m = 0; m < 4; ++m) {
#pragma unroll
            for (int n = 0; n < (NARROW ? 1 : 4); ++n) {
                const f32x4 a = acc[m][n];
                if (MODE == 3) {
                    const size_t row = (size_t)mt * 128 + wr * 64 + m * 16 + fq * 4;
                    const size_t col = (size_t)nt * 128 + wc * 64 + n * 16 + fl;
                    *(f32x4*)((float*)p.C + col * p.ldc + row) = a;
                } else {
                    const size_t row = (size_t)mt * 128 + wr * 64 + m * 16 + fl;
                    const int col = nt * 128 + wc * 64 + n * 16 + fq * 4;
                    if (MODE == 0) { u32x2 w; w.x = pk2(a.x, a.y); w.y = pk2(a.z, a.w); *(u32x2*)((bf16_t*)p.C + row * p.ldc + col) = w; }
                    else if (MODE == 1) { *(f32x4*)((float*)p.C + row * p.ldc + col) = a; }
                    else { const f32x4 r = *(const f32x4*)(p.R + row * p.ldc + col); *(f32x4*)((float*)p.C + row * p.ldc + col) = r + a; }
                }
            }
        }
    }
}

__device__ __forceinline__ int lds_byte(int r, int c) {
    const int st = (r >> 4) * 2 + (c >> 5), rr = r & 15, cc = c & 31, ob = rr * 64 + cc * 2;
    return st * 1024 + (ob ^ (((ob >> 9) & 1) << 5));
}
__device__ __forceinline__ void stage_rc(int b, int& R, int& C) {
    const int st = b / 1024, sb = b % 1024, swz = sb ^ (((sb >> 9) & 1) << 5);
    R = (st >> 1) * 16 + swz / 64; C = (st & 1) * 32 + (swz % 64) / 2;
}
#define GL_WAIT_V(n) asm volatile("s_waitcnt vmcnt(" #n ")" ::: "memory")
#define GL_BAR() do { asm volatile("s_waitcnt lgkmcnt(0)" ::: "memory"); __builtin_amdgcn_s_barrier(); } while (0)
template <int MODE>
__device__ void phase_gemm_glds(const GemmP& p, char* smem, int bid, int nblk) {
    const int tid = otid(), lane = tid & 63, wave = tid >> 6;
    const int wr = wave >> 1, wc = wave & 1;
    const int fl = lane & 15, fq = lane >> 4;
    const int ntiles = p.MT * p.NTl, nk = p.K >> 6;
    int sr[4], sc[4];
#pragma unroll
    for (int i = 0; i < 4; ++i) stage_rc(tid * 16 + i * 4096, sr[i], sc[i]);
    for (int tile = bid; tile < ntiles; tile += nblk) {
        const int mt = tile / p.NTl, nt = tile % p.NTl;
        const bf16_t* Ag = p.A + (size_t)mt * 128 * p.lda;
        const bf16_t* Bg = p.Bt + (size_t)nt * 128 * p.ldb;
        f32x4 acc[4][4];
#pragma unroll
        for (int m = 0; m < 4; ++m)
#pragma unroll
            for (int n = 0; n < 4; ++n) acc[m][n] = (f32x4){0.f, 0.f, 0.f, 0.f};
        auto stage = [&](int kt, int buf) {
            char* sa = smem + buf * 32768; char* sb = sa + 16384;
#pragma unroll
            for (int i = 0; i < 4; ++i) {
                __builtin_amdgcn_global_load_lds((const unsigned*)(Ag + (size_t)sr[i] * p.lda + kt * 64 + sc[i]), (__attribute__((address_space(3))) unsigned*)(sa + tid * 16 + i * 4096), 16, 0, 0);
                __builtin_amdgcn_global_load_lds((const unsigned*)(Bg + (size_t)sr[i] * p.ldb + kt * 64 + sc[i]), (__attribute__((address_space(3))) unsigned*)(sb + tid * 16 + i * 4096), 16, 0, 0);
            }
        };
        GL_BAR();
        stage(0, 0);
        for (int kt = 0; kt < nk; ++kt) {
            if (kt + 1 < nk) { stage(kt + 1, (kt + 1) & 1); GL_WAIT_V(8); } else { GL_WAIT_V(0); }
            GL_BAR();
            const char* Ac = smem + (kt & 1) * 32768; const char* Bc = Ac + 16384;
#pragma unroll
            for (int ks = 0; ks < 2; ++ks) {
                bf16x8 xa[4], wb[4];
#pragma unroll
                for (int m = 0; m < 4; ++m) xa[m] = *(const bf16x8*)(Ac + lds_byte(wr * 64 + m * 16 + fl, ks * 32 + fq * 8));
#pragma unroll
                for (int n = 0; n < 4; ++n) wb[n] = *(const bf16x8*)(Bc + lds_byte(wc * 64 + n * 16 + fl, ks * 32 + fq * 8));
#pragma unroll
                for (int m = 0; m < 4; ++m)
#pragma unroll
                    for (int n = 0; n < 4; ++n) acc[m][n] = (MODE == 3) ? __builtin_amdgcn_mfma_f32_16x16x32_bf16(xa[m], wb[n], acc[m][n], 0, 0, 0)
                                                                     : __builtin_amdgcn_mfma_f32_16x16x32_bf16(wb[n], xa[m], acc[m][n], 0, 0, 0);
            }
            GL_BAR();
        }
#pragma unroll
        for (int m = 0; m < 4; ++m) {
#pragma unroll
            for (int n = 0; n < 4; ++n) {
                const f32x4 a = acc[m][n];
                if (MODE == 3) {
                    const size_t row = (size_t)mt * 128 + wr * 64 + m * 16 + fq * 4;
                    const size_t col = (size_t)nt * 128 + wc * 64 + n * 16 + fl;
                    *(f32x4*)((float*)p.C + col * p.ldc + row) = a;
                } else {
                    const size_t row = (size_t)mt * 128 + wr * 64 + m * 16 + fl;
                    const int col = nt * 128 + wc * 64 + n * 16 + fq * 4;
                    if (MODE == 0) { u32x2 w; w.x = pk2(a.x, a.y); w.y = pk2(a.z, a.w); *(u32x2*)((bf16_t*)p.C + row * p.ldc + col) = w; }
                    else if (MODE == 1) { *(f32x4*)((float*)p.C + row * p.ldc + col) = a; }
                    else { const f32x4 r = *(const f32x4*)(p.R + row * p.ldc + col); *(f32x4*)((float*)p.C + row * p.ldc + col) = r + a; }
                }
            }
        }
    }
    __syncthreads();
}

constexpr int LS = 72;
struct LinP {
    const bf16_t* Z; bf16_t* O;
    const float* gk_up;
    const float* gk_bias;
    const float* norm_w;
    const float* rope;
    unsigned char* lin;
};
__device__ __forceinline__ bf16x8 ldfrag(const bf16_t* base, int row, int kofs) { return *(const bf16x8*)(base + row * LS + kofs); }

constexpr size_t LN_KV_RET = 0;
constexpr size_t LN_KV_GLA = LN_KV_RET + 1024ull * 64 * 64 * 4;
constexpr size_t LN_S_RET  = LN_KV_GLA + 1024ull * 96 * 64 * 4;
constexpr size_t LN_S_GLA  = LN_S_RET + 1024ull * 64 * 64 * 2;
constexpr size_t LN_DEC    = LN_S_GLA + 1024ull * 96 * 64 * 2;
static_assert(LN_DEC + 2048ull * 64 * 4 <= 64 * MiB, "lin region");

__device__ __forceinline__ float wave_incl_scan(float v) {
    v += dpp_f<0x111>(v); v += dpp_f<0x112>(v); v += dpp_f<0x114>(v); v += dpp_f<0x118>(v);
    v += __int_as_float(__builtin_amdgcn_update_dpp(0, __float_as_int(v), 0x142, 0xA, 0xF, false));
    v += __int_as_float(__builtin_amdgcn_update_dpp(0, __float_as_int(v), 0x143, 0xC, 0xF, false));
    return v;
}
__device__ __forceinline__ float readlane_f(float v, int l) { return __int_as_float(__builtin_amdgcn_readlane(__float_as_int(v), l)); }

__device__ __forceinline__ void rot8(const bf16_t* src, const float* rope, int spos, int cq, unsigned (&o1)[4], unsigned (&o2)[4]) {
    const u32x4 q1 = *(const u32x4*)(src + cq * 8), q2 = *(const u32x4*)(src + 32 + cq * 8);
    const unsigned q1w[4] = {q1.x, q1.y, q1.z, q1.w}, q2w[4] = {q2.x, q2.y, q2.z, q2.w};
    const f32x4 c0 = *(const f32x4*)(rope + spos * 32 + cq * 8), c1 = *(const f32x4*)(rope + spos * 32 + cq * 8 + 4);
    const f32x4 s0 = *(const f32x4*)(rope + NS * 32 + spos * 32 + cq * 8), s1 = *(const f32x4*)(rope + NS * 32 + spos * 32 + cq * 8 + 4);
    const float csv[8] = {c0.x, c0.y, c0.z, c0.w, c1.x, c1.y, c1.z, c1.w}, snv[8] = {s0.x, s0.y, s0.z, s0.w, s1.x, s1.y, s1.z, s1.w};
#pragma unroll
    for (int e = 0; e < 4; ++e) {
        const float a1l = lo_bf(q1w[e]), a1h = hi_bf(q1w[e]), a2l = lo_bf(q2w[e]), a2h = hi_bf(q2w[e]);
        o1[e] = pk2(a1l * csv[2 * e] - a2l * snv[2 * e], a1h * csv[2 * e + 1] - a2h * snv[2 * e + 1]);
        o2[e] = pk2(a1l * snv[2 * e] + a2l * csv[2 * e], a1h * snv[2 * e + 1] + a2h * csv[2 * e + 1]);
    }
}
__device__ __forceinline__ void load_vts(const bf16_t* Z, size_t t0, int voff, int nch, bf16_t* Vts, int tid) {
    for (int x = tid; x < 64 * nch; x += NTHREADS) {
        const int tok = x / nch, ch = x % nch;
        const u32x4 vv = *(const u32x4*)(Z + (t0 + tok) * DINP + voff + ch * 8);
        const unsigned w[4] = {vv.x, vv.y, vv.z, vv.w};
#pragma unroll
        for (int e = 0; e < 4; ++e) { Vts[(ch * 8 + 2 * e) * LS + tok] = (bf16_t)(w[e] & 0xFFFFu); Vts[(ch * 8 + 2 * e + 1) * LS + tok] = (bf16_t)(w[e] >> 16); }
    }
}
__device__ __forceinline__ void load_gd(const bf16_t* zr, float (&gd)[16]) {
    const u32x4 g0 = *(const u32x4*)zr, g1 = *(const u32x4*)(zr + 8);
    gd[0] = lo_bf(g0.x); gd[1] = hi_bf(g0.x); gd[2] = lo_bf(g0.y); gd[3] = hi_bf(g0.y); gd[4] = lo_bf(g0.z); gd[5] = hi_bf(g0.z); gd[6] = lo_bf(g0.w); gd[7] = hi_bf(g0.w);
    gd[8] = lo_bf(g1.x); gd[9] = hi_bf(g1.x); gd[10] = lo_bf(g1.y); gd[11] = hi_bf(g1.y); gd[12] = lo_bf(g1.z); gd[13] = hi_bf(g1.z); gd[14] = lo_bf(g1.w); gd[15] = hi_bf(g1.w);
}
__device__ __forceinline__ float gla_gk(const LinP& p, const float (&gd)[16], int h, int d) {
    float x = p.gk_bias[h * 48 + d];
#pragma unroll
    for (int i = 0; i < 16; ++i) x += gd[i] * p.gk_up[i * 192 + h * 48 + d];
    return (fminf(x, 0.f) - __logf(1.f + __expf(-fabsf(x)))) * (1.f / 16.f);
}
__device__ __forceinline__ float ret_lg(int h) { const float e = exp2f(-5.f - (float)h * (4.f / 3.f)); return log1pf(-e); }

template <bool IS_GLA>
__device__ void lin_kv_task(const LinP& p, char* smem, int b, int h, int c) {
    constexpr int DV = IS_GLA ? 96 : 64, NVB = DV / 16;
    const int koff = IS_GLA ? (ZC_GLA + 192 + h * 48) : (ZC_RET + 256 + h * 64);
    const int voff = IS_GLA ? (ZC_GLA + 384 + h * 96) : (ZC_RET + 512 + h * 64);
    const int gkdoff = ZC_GLA + 768;
    bf16_t* Ks = (bf16_t*)smem;
    bf16_t* Kts = Ks + 64 * LS;
    bf16_t* Vts = Kts + 64 * LS;
    float* decs = (float*)(Vts + 96 * LS);
    const int tid = otid(), lane = tid & 63, wave = tid >> 6;
    const int fl = lane & 15, fq = lane >> 4;
    const size_t t0 = (size_t)b * NS + (size_t)c * 64;
    const int task = (b * 4 + h) * 64 + c;
    __syncthreads();
    if (IS_GLA) {
        for (int x = tid; x < 64 * 6; x += NTHREADS) {
            const int tok = x / 6, ch = x % 6;
            *(u32x4*)(Ks + tok * LS + ch * 8) = *(const u32x4*)(p.Z + (t0 + tok) * DINP + koff + ch * 8);
        }
        for (int x = tid; x < 16 * LS / 2; x += NTHREADS) ((unsigned*)(Kts + 48 * LS))[x] = 0u;
        if (tid < 16) decs[48 + tid] = 1.f;
        load_vts(p.Z, t0, voff, 12, Vts, tid);
    } else {
        const int tok = tid >> 2, cq = tid & 3;
        unsigned k1[4], k2[4];
        rot8(p.Z + (t0 + tok) * DINP + koff, p.rope, c * 64 + tok, cq, k1, k2);
        const float fk2 = 0.125f * __expf(ret_lg(h) * (float)(63 - tok));
#pragma unroll
        for (int e = 0; e < 4; ++e) {
            Kts[(cq * 8 + 2 * e) * LS + tok] = f2bf(lo_bf(k1[e]) * fk2); Kts[(cq * 8 + 2 * e + 1) * LS + tok] = f2bf(hi_bf(k1[e]) * fk2);
            Kts[(32 + cq * 8 + 2 * e) * LS + tok] = f2bf(lo_bf(k2[e]) * fk2); Kts[(32 + cq * 8 + 2 * e + 1) * LS + tok] = f2bf(hi_bf(k2[e]) * fk2);
        }
        if (tid < 64) decs[tid] = __expf(ret_lg(h) * 64.f);
        load_vts(p.Z, t0, voff, 8, Vts, tid);
    }
    __syncthreads();
    if (IS_GLA) {
        float gd[16];
        load_gd(p.Z + (t0 + lane) * DINP + gkdoff, gd);
#pragma unroll 1
        for (int dd = 0; dd < 12; ++dd) {
            const int d = wave * 12 + dd;
            const float bc = wave_incl_scan(gla_gk(p, gd, h, d));
            const float bl = readlane_f(bc, 63);
            Kts[d * LS + lane] = f2bf(bf2f(Ks[lane * LS + d]) * __expf(bl - bc));
            if (lane == 0) decs[d] = __expf(bl);
        }
        __syncthreads();
    }
    float* KV = (float*)(p.lin + (IS_GLA ? LN_KV_GLA : LN_KV_RET)) + (size_t)task * DV * 64;
#pragma unroll
    for (int vb = 0; vb < NVB; ++vb) {
        f32x4 a4 = (f32x4){0.f, 0.f, 0.f, 0.f};
#pragma unroll
        for (int ks = 0; ks < 2; ++ks) {
            const bf16x8 a = ldfrag(Kts, 16 * wave + fl, ks * 32 + fq * 8);
            const bf16x8 bv = ldfrag(Vts, 16 * vb + fl, ks * 32 + fq * 8);
            a4 = __builtin_amdgcn_mfma_f32_16x16x32_bf16(a, bv, a4, 0, 0, 0);
        }
        *(f32x4*)(KV + (size_t)(16 * vb + fl) * 64 + 16 * wave + 4 * fq) = a4;
    }
    if (tid < 64) ((float*)(p.lin + LN_DEC))[(size_t)((IS_GLA ? 1024 : 0) + task) * 64 + tid] = decs[tid];
}

__device__ void lin_scan_phase(const LinP& p, int vbid, int nvblk, unsigned* flags) {
    const int tid = otid();
    for (int it = vbid; it < 160; it += nvblk) {
        const bool gla = it >= 64;
        const int r = gla ? it - 64 : it;
        const int per = gla ? 6 : 4, DVx = gla ? 96 : 64;
        const int bh = r / per, e = (r % per) * 1024 + tid;
        const float* KV = (const float*)(p.lin + (gla ? LN_KV_GLA : LN_KV_RET)) + (size_t)bh * 64 * DVx * 64 + e;
        bf16_t* Sb = (bf16_t*)(p.lin + (gla ? LN_S_GLA : LN_S_RET)) + (size_t)bh * 64 * DVx * 64 + e;
        const float* DEC = (const float*)(p.lin + LN_DEC) + (size_t)((gla ? 1024 : 0) + bh * 64) * 64 + (e & 63);
        float S0 = 0.f, S1 = 0.f, S2 = 0.f, S3 = 0.f;
#pragma unroll 8
        for (int c = 0; c < 64; ++c) {
            const size_t o = (size_t)c * DVx * 64;
            const float k0 = KV[o], k1 = KV[o + 256], k2 = KV[o + 512], k3 = KV[o + 768], dc = DEC[c * 64];
            Sb[o] = f2bf(S0); Sb[o + 256] = f2bf(S1); Sb[o + 512] = f2bf(S2); Sb[o + 768] = f2bf(S3);
            S0 = S0 * dc + k0; S1 = S1 * dc + k1; S2 = S2 * dc + k2; S3 = S3 * dc + k3;
        }
        flag_signal(flags + (gla ? 16 : 0) + bh);
    }
}

template <bool IS_GLA>
__device__ void lin_out_task(const LinP& p, char* smem, int b, int h, int c) {
    constexpr int DV = IS_GLA ? 96 : 64, NVB = DV / 16;
    const int qoff = IS_GLA ? (ZC_GLA + 0 + h * 48) : (ZC_RET + 0 + h * 64);
    const int koff = IS_GLA ? (ZC_GLA + 192 + h * 48) : (ZC_RET + 256 + h * 64);
    const int voff = IS_GLA ? (ZC_GLA + 384 + h * 96) : (ZC_RET + 512 + h * 64);
    const int goff = IS_GLA ? (ZC_GLA + 784 + h * 96) : (ZC_RET + 768 + h * 64);
    const int gkdoff = ZC_GLA + 768;
    const int ooff = IS_GLA ? (640 + h * 96) : (h * 64);
    bf16_t* Qs = (bf16_t*)smem;
    bf16_t* Ks = Qs + 64 * LS;
    bf16_t* Ps = Ks + 64 * LS;
    bf16_t* Vts = Ps + 64 * LS;
    bf16_t* Sts = Vts + 96 * LS;
    const int tid = otid(), lane = tid & 63, wave = tid >> 6;
    const int fl = lane & 15, fq = lane >> 4;
    const size_t t0 = (size_t)b * NS + (size_t)c * 64;
    const int task = (b * 4 + h) * 64 + c;
    __syncthreads();
    {
        const bf16_t* Sb = (const bf16_t*)(p.lin + (IS_GLA ? LN_S_GLA : LN_S_RET)) + (size_t)task * DV * 64;
        for (int x = tid; x < DV * 8; x += NTHREADS) { const int v = x >> 3, ch = x & 7; *(u32x4*)(Sts + v * LS + ch * 8) = *(const u32x4*)(Sb + v * 64 + ch * 8); }
    }
    if (IS_GLA) {
        for (int x = tid; x < 64 * 6; x += NTHREADS) {
            const int tok = x / 6, ch = x % 6;
            const bf16_t* zr = p.Z + (t0 + tok) * DINP;
            *(u32x4*)(Qs + tok * LS + ch * 8) = *(const u32x4*)(zr + qoff + ch * 8);
            *(u32x4*)(Ks + tok * LS + ch * 8) = *(const u32x4*)(zr + koff + ch * 8);
        }
        for (int x = tid; x < 64 * 2; x += NTHREADS) {
            const int tok = x >> 1, ch = 6 + (x & 1);
            *(u32x4*)(Qs + tok * LS + ch * 8) = (u32x4){0u, 0u, 0u, 0u};
            *(u32x4*)(Ks + tok * LS + ch * 8) = (u32x4){0u, 0u, 0u, 0u};
        }
        load_vts(p.Z, t0, voff, 12, Vts, tid);
    } else {
        const int tok = tid >> 2, cq = tid & 3;
        const bf16_t* zr = p.Z + (t0 + tok) * DINP;
        unsigned q1[4], q2[4], k1[4], k2[4];
        rot8(zr + qoff, p.rope, c * 64 + tok, cq, q1, q2);
        rot8(zr + koff, p.rope, c * 64 + tok, cq, k1, k2);
        const float lg = ret_lg(h);
        const float fqd = __expf(lg * (float)(tok + 1)), fk = 0.125f * __expf(-lg * (float)(tok + 1));
#pragma unroll
        for (int e = 0; e < 4; ++e) {
            q1[e] = pk2(lo_bf(q1[e]) * fqd, hi_bf(q1[e]) * fqd); q2[e] = pk2(lo_bf(q2[e]) * fqd, hi_bf(q2[e]) * fqd);
            k1[e] = pk2(lo_bf(k1[e]) * fk, hi_bf(k1[e]) * fk); k2[e] = pk2(lo_bf(k2[e]) * fk, hi_bf(k2[e]) * fk);
        }
        *(u32x4*)(Qs + tok * LS + cq * 8) = (u32x4){q1[0], q1[1], q1[2], q1[3]};
        *(u32x4*)(Qs + tok * LS + 32 + cq * 8) = (u32x4){q2[0], q2[1], q2[2], q2[3]};
        *(u32x4*)(Ks + tok * LS + cq * 8) = (u32x4){k1[0], k1[1], k1[2], k1[3]};
        *(u32x4*)(Ks + tok * LS + 32 + cq * 8) = (u32x4){k2[0], k2[1], k2[2], k2[3]};
        load_vts(p.Z, t0, voff, 8, Vts, tid);
    }
    __syncthreads();
    if (IS_GLA) {
        float gd[16];
        load_gd(p.Z + (t0 + lane) * DINP + gkdoff, gd);
#pragma unroll 1
        for (int dd = 0; dd < 12; ++dd) {
            const int d = wave * 12 + dd;
            const float bc = wave_incl_scan(gla_gk(p, gd, h, d));
            const float eq = __expf(bc) * 0.14433756729740643f  , ek = __expf(-bc);
            Qs[lane * LS + d] = f2bf(bf2f(Qs[lane * LS + d]) * eq);
            Ks[lane * LS + d] = f2bf(bf2f(Ks[lane * LS + d]) * ek);
        }
        __syncthreads();
    }
#pragma unroll
    for (int jb = 0; jb < 4; ++jb) {
        f32x4 ap = (f32x4){0.f, 0.f, 0.f, 0.f};
#pragma unroll
        for (int ks = 0; ks < 2; ++ks) {
            const bf16x8 a = ldfrag(Ks, 16 * jb + fl, ks * 32 + fq * 8);
            const bf16x8 bq = ldfrag(Qs, 16 * wave + fl, ks * 32 + fq * 8);
            ap = __builtin_amdgcn_mfma_f32_16x16x32_bf16(a, bq, ap, 0, 0, 0);
        }
        const int i = 16 * wave + fl, j0 = 16 * jb + 4 * fq;
        u32x2 w;
        w.x = pk2(j0 + 0 <= i ? ap.x : 0.f, j0 + 1 <= i ? ap.y : 0.f);
        w.y = pk2(j0 + 2 <= i ? ap.z : 0.f, j0 + 3 <= i ? ap.w : 0.f);
        *(u32x2*)(Ps + i * LS + j0) = w;
    }
    __syncthreads();
    {
        f32x4 ao[NVB];
        float ss = 0.f;
#pragma unroll
        for (int vb = 0; vb < NVB; ++vb) {
            f32x4 a4 = (f32x4){0.f, 0.f, 0.f, 0.f};
#pragma unroll
            for (int ks = 0; ks < 2; ++ks) {
                const bf16x8 a = ldfrag(Vts, 16 * vb + fl, ks * 32 + fq * 8);
                const bf16x8 bp = ldfrag(Ps, 16 * wave + fl, ks * 32 + fq * 8);
                a4 = __builtin_amdgcn_mfma_f32_16x16x32_bf16(a, bp, a4, 0, 0, 0);
            }
#pragma unroll
            for (int ks = 0; ks < 2; ++ks) {
                const bf16x8 a = ldfrag(Sts, 16 * vb + fl, ks * 32 + fq * 8);
                const bf16x8 bq = ldfrag(Qs, 16 * wave + fl, ks * 32 + fq * 8);
                a4 = __builtin_amdgcn_mfma_f32_16x16x32_bf16(a, bq, a4, 0, 0, 0);
            }
            ao[vb] = a4;
            ss += a4.x * a4.x + a4.y * a4.y + a4.z * a4.z + a4.w * a4.w;
        }
        ss = xor32_sum(xor16_sum(ss));
        const float inv = rsqrtf(ss * (1.f / DV) + 1e-5f);
        const size_t t = t0 + 16 * wave + fl;
#pragma unroll
        for (int vb = 0; vb < NVB; ++vb) {
            const int v0 = 16 * vb + 4 * fq;
            const u32x2 gg = *(const u32x2*)(p.Z + t * DINP + goff + v0);
            float g4[4] = {lo_bf(gg.x), hi_bf(gg.x), lo_bf(gg.y), hi_bf(gg.y)};
            float o4[4] = {ao[vb].x, ao[vb].y, ao[vb].z, ao[vb].w};
#pragma unroll
            for (int e = 0; e < 4; ++e) {
                float y = o4[e] * inv;
                if (IS_GLA) y *= p.norm_w[h * 96 + v0 + e];
                const float g = g4[e];
                o4[e] = y * (g / (1.f + __expf(-g)));
            }
            u32x2 w; w.x = pk2(o4[0], o4[1]); w.y = pk2(o4[2], o4[3]);
            *(u32x2*)(p.O + t * D + ooff + v0) = w;
        }
    }
}
__device__ __forceinline__ void lin_kv_dispatch(const LinP& p, char* smem, int task) {
    const int r = task & 1023, bh = r >> 6, c = r & 63;
    if (task < 1024) lin_kv_task<false>(p, smem, bh >> 2, bh & 3, c); else lin_kv_task<true>(p, smem, bh >> 2, bh & 3, c);
}
__device__ __forceinline__ void lin_out_dispatch(const LinP& p, char* smem, int task, unsigned* flags) {
    const int r = task & 1023, bh = r >> 6, c = r & 63;
    if (flags) flag_wait(flags + (task < 1024 ? 0 : 16) + bh, task < 1024 ? 4u : 6u);
    if (task < 1024) lin_out_task<false>(p, smem, bh >> 2, bh & 3, c); else lin_out_task<true>(p, smem, bh >> 2, bh & 3, c);
}

struct RwP {
    const bf16_t* Z; unsigned char* mix;
    const float* mu; const float* w_up; const float* w_bias; const float* a_up; const float* a_bias; const float* g_up;
    const float* k_k; const float* k_a; const float* r_k; const float* ln_w; const float* ln_b;
    float* oraw; bf16_t* O; bf16_t* Y; const bf16_t* lora;
};
constexpr int PS = 264;
__device__ __forceinline__ f32x4 bf4(u32x2 w) { return (f32x4){lo_bf(w.x), hi_bf(w.x), lo_bf(w.y), hi_bf(w.y)}; }
__device__ void rwkv_prep_task(const RwP& p, char* smem, int tile) {
    bf16_t* At = (bf16_t*)smem;
    const int tid = otid(), lane = tid & 63, wave = tid >> 6;
    const int fl = lane & 15, fq = lane >> 4;
    const int t0 = tile * 32;
    float* Wd = (float*)(p.mix + MX_W); float* KKd = (float*)(p.mix + MX_KK); float* KKAd = (float*)(p.mix + MX_KKA);
    bf16_t* Rd = (bf16_t*)(p.mix + MX_R); bf16_t* Kd = (bf16_t*)(p.mix + MX_K); bf16_t* Vd = (bf16_t*)(p.mix + MX_V); bf16_t* Gd = (bf16_t*)(p.mix + MX_G);
    __syncthreads();
    {
        const int tok = tid >> 3, t = t0 + tok;
        const bool first = (t & (NS - 1)) == 0;
        const bf16_t* zr = p.Z + (size_t)t * DINP + ZC_RW + 1152;
#pragma unroll
        for (int i = 0; i < 4; ++i) {
            const int ch = (tid & 7) + 8 * i;
            const u32x4 cur = *(const u32x4*)(zr + ch * 8);
            const u32x4 prv = first ? (u32x4){0u, 0u, 0u, 0u} : *(const u32x4*)(zr - DINP + ch * 8);
            const f32x4 m0 = *(const f32x4*)(p.mu + 1152 + ch * 8), m1 = *(const f32x4*)(p.mu + 1152 + ch * 8 + 4);
            const unsigned cw[4] = {cur.x, cur.y, cur.z, cur.w}, pw[4] = {prv.x, prv.y, prv.z, prv.w};
            const float mm[8] = {m0.x, m0.y, m0.z, m0.w, m1.x, m1.y, m1.z, m1.w};
            float o[8];
#pragma unroll
            for (int e = 0; e < 4; ++e) {
                const float f0 = lo_bf(cw[e]), f1 = hi_bf(cw[e]), g0 = lo_bf(pw[e]), g1 = hi_bf(pw[e]);
                o[2 * e] = f0 + (g0 - f0) * mm[2 * e]; o[2 * e + 1] = f1 + (g1 - f1) * mm[2 * e + 1];
            }
            if (ch < 8) {
#pragma unroll
                for (int e = 0; e < 8; ++e) o[e] = tanhf_(o[e]);
            } else if (ch >= 16) {
#pragma unroll
                for (int e = 0; e < 8; ++e) o[e] = sigmoidf_(o[e]);
            }
            *(u32x4*)(At + tok * PS + ch * 8) = (u32x4){pk2(o[0], o[1]), pk2(o[2], o[3]), pk2(o[4], o[5]), pk2(o[6], o[7])};
        }
    }
    __syncthreads();
    bf16x8 xb[8];
#pragma unroll
    for (int ks = 0; ks < 8; ++ks) xb[ks] = *(const bf16x8*)(At + (16 * (wave & 1) + fl) * PS + ks * 32 + fq * 8);
    const int t = t0 + 16 * (wave & 1) + fl, b = t >> 12, sq = t & (NS - 1);
    const bool first = sq == 0;
    const bf16_t* zc = p.Z + (size_t)t * DINP + ZC_RW;
    const bf16_t* WupT = p.lora; const bf16_t* AupT = p.lora + 384 * 64; const bf16_t* GupT = p.lora + 2 * 384 * 64;
    const int hd0 = (wave >> 1) * 3;
#pragma unroll
    for (int hi = 0; hi < 3; ++hi) {
        const int hd = hd0 + hi;
        f32x4 aw[4], aa[4], ag[4];
#pragma unroll
        for (int n = 0; n < 4; ++n) {
            const int cr = hd * 64 + 16 * n + fl;
            f32x4 w4 = (f32x4){0.f, 0.f, 0.f, 0.f}, a4 = w4, g4 = w4;
#pragma unroll
            for (int ks = 0; ks < 2; ++ks) {
                w4 = __builtin_amdgcn_mfma_f32_16x16x32_bf16(*(const bf16x8*)(WupT + cr * 64 + ks * 32 + fq * 8), xb[ks], w4, 0, 0, 0);
                a4 = __builtin_amdgcn_mfma_f32_16x16x32_bf16(*(const bf16x8*)(AupT + cr * 64 + ks * 32 + fq * 8), xb[2 + ks], a4, 0, 0, 0);
            }
#pragma unroll
            for (int ks = 0; ks < 4; ++ks) g4 = __builtin_amdgcn_mfma_f32_16x16x32_bf16(*(const bf16x8*)(GupT + cr * 128 + ks * 32 + fq * 8), xb[4 + ks], g4, 0, 0, 0);
            aw[n] = w4; aa[n] = a4; ag[n] = g4;
        }
        f32x4 kx[4], av[4], kkv[4];
        float ss = 0.f;
        const size_t hrow = ((size_t)(b * 6 + hd) * NS + sq) * 64;
#pragma unroll
        for (int n = 0; n < 4; ++n) {
            const int cl = 16 * n + 4 * fq, c = hd * 64 + cl;
            f32x4 rr = bf4(*(const u32x2*)(zc + c)), kk = bf4(*(const u32x2*)(zc + 384 + c)), vv = bf4(*(const u32x2*)(zc + 768 + c));
            f32x4 rp = (f32x4){0.f, 0.f, 0.f, 0.f}, kp = rp, vp = rp;
            if (!first) { rp = bf4(*(const u32x2*)(zc - DINP + c)); kp = bf4(*(const u32x2*)(zc - DINP + 384 + c)); vp = bf4(*(const u32x2*)(zc - DINP + 768 + c)); }
            rr = rr + (rp - rr) * *(const f32x4*)(p.mu + c); kk = kk + (kp - kk) * *(const f32x4*)(p.mu + 384 + c); vv = vv + (vp - vv) * *(const f32x4*)(p.mu + 768 + c);
            const f32x4 wb = *(const f32x4*)(p.w_bias + c), ab = *(const f32x4*)(p.a_bias + c), kkc = *(const f32x4*)(p.k_k + c), kac = *(const f32x4*)(p.k_a + c);
            f32x4 dec, a;
            {
                const f32x4 xw = wb + aw[n], xa = ab + aa[n];
                dec.x = __expf(-__expf(-softplusf_(-xw.x) - 0.5f)); dec.y = __expf(-__expf(-softplusf_(-xw.y) - 0.5f));
                dec.z = __expf(-__expf(-softplusf_(-xw.z) - 0.5f)); dec.w = __expf(-__expf(-softplusf_(-xw.w) - 0.5f));
                a.x = sigmoidf_(xa.x); a.y = sigmoidf_(xa.y); a.z = sigmoidf_(xa.z); a.w = sigmoidf_(xa.w);
            }
            const f32x4 kr = kk * kkc;
            ss += kr.x * kr.x + kr.y * kr.y + kr.z * kr.z + kr.w * kr.w;
            kkv[n] = kr; av[n] = a; kx[n] = kk;
            const f32x4 kmod = kk * ((a - 1.f) * kac + 1.f);
            *(f32x4*)(Wd + hrow + cl) = dec;
            u32x2 w;
            w.x = pk2(rr.x, rr.y); w.y = pk2(rr.z, rr.w); *(u32x2*)(Rd + hrow + cl) = w;
            w.x = pk2(kmod.x, kmod.y); w.y = pk2(kmod.z, kmod.w); *(u32x2*)(Kd + hrow + cl) = w;
            w.x = pk2(vv.x, vv.y); w.y = pk2(vv.z, vv.w); *(u32x2*)(Vd + hrow + cl) = w;
            w.x = pk2(ag[n].x, ag[n].y); w.y = pk2(ag[n].z, ag[n].w); *(u32x2*)(Gd + (size_t)t * 384 + c) = w;
        }
        ss = xor32_sum(xor16_sum(ss));
        const float rn = rsqrtf(fmaxf(ss, 1e-24f));
#pragma unroll
        for (int n = 0; n < 4; ++n) {
            const int cl = 16 * n + 4 * fq;
            const f32x4 kn = kkv[n] * rn;
            *(f32x4*)(KKd + hrow + cl) = kn;
            *(f32x4*)(KKAd + hrow + cl) = kn * av[n];
        }
    }
}

constexpr int SC_STEPS = 16;
constexpr int SEG_BEG[4] = {0, 1376, 2736, 4096};
constexpr size_t MX_SE0 = MX_END;
constexpr size_t MX_XE  = MX_SE0 + 24ull * 3 * 4096 * 4;
constexpr size_t MX_SST = MX_XE + 24ull * 3 * 4096 * 4;
static_assert(MX_SST + 24ull * 3 * 4096 * 2 <= 128 * MiB, "mix region");
__device__ __forceinline__ float row8_sum(float v) { v += dpp_f<0xB1>(v); v += dpp_f<0x4E>(v); v += dpp_f<0x141>(v); return v; }
__device__ void rwkv_scan_task(const RwP& p, char* smem, int bh, int seg, int grp) {
    float* buf = (float*)smem;
    float* obuf = buf + 2 * 6 * SC_STEPS * 64;
    const int tid = otid(), lane = tid & 63, wave = tid >> 6;
    const int rloc = wave * 8 + (lane >> 3);
    const bool ident = grp >= 2;
    const int row = (grp & 1) * 32 + rloc;
    const int c8 = (lane & 7) * 8;
    const int s_beg = seg == 0 ? SEG_BEG[0] : (seg == 1 ? SEG_BEG[1] : SEG_BEG[2]);
    const int s_end = seg == 0 ? SEG_BEG[1] : (seg == 1 ? SEG_BEG[2] : SEG_BEG[3]);
    const int NCH = (s_end - s_beg) / SC_STEPS;
    const size_t hb = ((size_t)bh * NS + s_beg) * 64;
    const float* Wd = (const float*)(p.mix + MX_W) + hb;
    const float* KKd = (const float*)(p.mix + MX_KK) + hb;
    const float* KKAd = (const float*)(p.mix + MX_KKA) + hb;
    const bf16_t* Rd = (const bf16_t*)(p.mix + MX_R) + hb;
    const bf16_t* Kd = (const bf16_t*)(p.mix + MX_K) + hb;
    const bf16_t* Vd = (const bf16_t*)(p.mix + MX_V) + hb;
    float* orow = p.oraw + hb;
    bf16_t* yrow = p.Y + hb;
    f32x4 Sa, Sb;
    Sa.x = (ident && c8 + 0 == row) ? 1.f : 0.f; Sa.y = (ident && c8 + 1 == row) ? 1.f : 0.f; Sa.z = (ident && c8 + 2 == row) ? 1.f : 0.f; Sa.w = (ident && c8 + 3 == row) ? 1.f : 0.f;
    Sb.x = (ident && c8 + 4 == row) ? 1.f : 0.f; Sb.y = (ident && c8 + 5 == row) ? 1.f : 0.f; Sb.z = (ident && c8 + 6 == row) ? 1.f : 0.f; Sb.w = (ident && c8 + 7 == row) ? 1.f : 0.f;
    struct Stg { f32x4 w, kk, ka; u32x2 r, k, v; };
    Stg sA, sB;
    auto gload = [&](Stg& g, int ch) {
        const size_t e = (size_t)ch * SC_STEPS * 64 + tid * 4;
        g.w = *(const f32x4*)(Wd + e); g.kk = *(const f32x4*)(KKd + e); g.ka = *(const f32x4*)(KKAd + e);
        g.r = *(const u32x2*)(Rd + e); g.k = *(const u32x2*)(Kd + e); g.v = *(const u32x2*)(Vd + e);
    };
    auto lstore = [&](const Stg& g, int bsel) {
        float* bb = buf + bsel * 6 * SC_STEPS * 64 + tid * 4;
        *(f32x4*)(bb + 0 * SC_STEPS * 64) = g.w; *(f32x4*)(bb + 1 * SC_STEPS * 64) = g.kk; *(f32x4*)(bb + 2 * SC_STEPS * 64) = g.ka;
        *(f32x4*)(bb + 3 * SC_STEPS * 64) = (f32x4){lo_bf(g.r.x), hi_bf(g.r.x), lo_bf(g.r.y), hi_bf(g.r.y)};
        *(f32x4*)(bb + 4 * SC_STEPS * 64) = (f32x4){lo_bf(g.k.x), hi_bf(g.k.x), lo_bf(g.k.y), hi_bf(g.k.y)};
        *(f32x4*)(bb + 5 * SC_STEPS * 64) = (f32x4){lo_bf(g.v.x), hi_bf(g.v.x), lo_bf(g.v.y), hi_bf(g.v.y)};
    };
    __syncthreads();
    gload(sA, 0); lstore(sA, 0);
    gload(sA, 1);
    __syncthreads();
    const float vmask = ident ? 0.f : 1.f;
    struct Ops { f32x4 w0, w1, kk0, kk1, ka0, ka1, r0, r1, k0, k1; float v; };
    auto ldops = [&](Ops& o, const float* bb, int st) {
        const float* q = bb + st * 64 + c8;
        o.w0 = *(const f32x4*)(q); o.w1 = *(const f32x4*)(q + 4);
        o.kk0 = *(const f32x4*)(q + 1 * SC_STEPS * 64); o.kk1 = *(const f32x4*)(q + 1 * SC_STEPS * 64 + 4);
        o.ka0 = *(const f32x4*)(q + 2 * SC_STEPS * 64); o.ka1 = *(const f32x4*)(q + 2 * SC_STEPS * 64 + 4);
        o.r0 = *(const f32x4*)(q + 3 * SC_STEPS * 64); o.r1 = *(const f32x4*)(q + 3 * SC_STEPS * 64 + 4);
        o.k0 = *(const f32x4*)(q + 4 * SC_STEPS * 64); o.k1 = *(const f32x4*)(q + 4 * SC_STEPS * 64 + 4);
        o.v = bb[5 * SC_STEPS * 64 + st * 64 + row];
    };
    auto chunk = [&](int ch, Stg& cur  , Stg& nxt  ) {
        if (ch + 2 < NCH) gload(nxt, ch + 2);
        const float* bb = buf + (ch & 1) * 6 * SC_STEPS * 64;
        Ops o; ldops(o, bb, 0);
#pragma unroll
        for (int st = 0; st < SC_STEPS; ++st) {
            Ops n; ldops(n, bb, (st + 1 < SC_STEPS) ? st + 1 : st);
            const float vx = o.v * vmask;
            const f32x4 pa = Sa * o.kk0 + Sb * o.kk1;
            const float sa = -row8_sum((pa.x + pa.y) + (pa.z + pa.w));
            Sa = Sa * o.w0 + o.k0 * vx + o.ka0 * sa;
            Sb = Sb * o.w1 + o.k1 * vx + o.ka1 * sa;
            const f32x4 qa = Sa * o.r0 + Sb * o.r1;
            obuf[st * 32 + rloc] = row8_sum((qa.x + qa.y) + (qa.z + qa.w));
            o = n;
        }
        __syncthreads();
#pragma unroll
        for (int i = 0; i < 2; ++i) {
            const int idx = tid + 256 * i, st = idx >> 5, rr = idx & 31;
            const size_t oi = ((size_t)ch * SC_STEPS + st) * 64 + (grp & 1) * 32 + rr;
            if (ident) yrow[oi] = f2bf(obuf[idx]); else orow[oi] = obuf[idx];
        }
        if (ch + 1 < NCH) lstore(cur, (ch + 1) & 1);
        __syncthreads();
    };
    for (int ch = 0; ch < NCH; ch += 2) {
        chunk(ch, sA, sB);
        if (ch + 1 < NCH) chunk(ch + 1, sB, sA);
    }
    float* fin = (float*)(p.mix + (ident ? MX_XE : MX_SE0)) + ((size_t)(bh * 3 + seg) * 64 + row) * 64 + c8;
    *(f32x4*)fin = Sa; *(f32x4*)(fin + 4) = Sb;
}

__device__ void phase_rwkv_chain(const RwP& p, int bid, int nblk) {
    const int lane = otid() & 63, wave = otid() >> 6;
    const float* SE0 = (const float*)(p.mix + MX_SE0); const float* XE = (const float*)(p.mix + MX_XE);
    bf16_t* SST = (bf16_t*)(p.mix + MX_SST);
    for (int x = bid * 4 + wave; x < 24 * 4; x += nblk * 4) {
        const int bh = x >> 2, cg = (x & 3) * 16;
        const float* s1 = SE0 + ((size_t)(bh * 3 + 0) * 64 + lane) * 64;
        const float* e1 = SE0 + ((size_t)(bh * 3 + 1) * 64 + lane) * 64 + cg;
        const float* X1 = XE + (size_t)(bh * 3 + 1) * 4096 + cg;
        float o[16];
#pragma unroll
        for (int k = 0; k < 16; ++k) o[k] = e1[k];
        for (int i = 0; i < 64; ++i) {
            const float si = s1[i];
#pragma unroll
            for (int k = 0; k < 16; ++k) o[k] += si * X1[i * 64 + k];
        }
        bf16_t* d1 = SST + ((size_t)(bh * 3 + 1) * 64 + lane) * 64 + cg;
        bf16_t* d2 = SST + ((size_t)(bh * 3 + 2) * 64 + lane) * 64 + cg;
#pragma unroll
        for (int k = 0; k < 16; ++k) { d1[k] = f2bf(s1[cg + k]); d2[k] = f2bf(o[k]); }
    }
}

__device__ void phase_rwkv_post(const RwP& p, int bid, int nblk) {
    const int lane = otid() & 63, wave = otid() >> 6;
    const int fl = lane & 15, fq = lane >> 4;
    const bf16_t* Rd = (const bf16_t*)(p.mix + MX_R); const bf16_t* Kd = (const bf16_t*)(p.mix + MX_K); const bf16_t* Vd = (const bf16_t*)(p.mix + MX_V);
    const bf16_t* Gd = (const bf16_t*)(p.mix + MX_G); const bf16_t* SST = (const bf16_t*)(p.mix + MX_SST);
    for (int x = bid * 4 + wave; x < 24 * (NS / 16); x += nblk * 4) {
        const int bh = x / (NS / 16), s0 = (x % (NS / 16)) * 16;
        const int b = bh / 6, hd = bh % 6;
        const int seg = s0 < SEG_BEG[1] ? 0 : (s0 < SEG_BEG[2] ? 1 : 2);
        const size_t hrow = ((size_t)bh * NS + s0 + fl) * 64;
        f32x4 acc[4];
#pragma unroll
        for (int n = 0; n < 4; ++n) acc[n] = *(const f32x4*)(p.oraw + hrow + 16 * n + 4 * fq);
        if (seg > 0) {
            const bf16_t* ss = SST + (size_t)(bh * 3 + seg) * 4096;
#pragma unroll
            for (int ks = 0; ks < 2; ++ks) {
                const bf16x8 yb = *(const bf16x8*)(p.Y + hrow + ks * 32 + fq * 8);
#pragma unroll
                for (int n = 0; n < 4; ++n) {
                    const bf16x8 sa = *(const bf16x8*)(ss + (size_t)(16 * n + fl) * 64 + ks * 32 + fq * 8);
                    acc[n] = __builtin_amdgcn_mfma_f32_16x16x32_bf16(sa, yb, acc[n], 0, 0, 0);
                }
            }
        }
        float sm = 0.f;
#pragma unroll
        for (int n = 0; n < 4; ++n) sm += acc[n].x + acc[n].y + acc[n].z + acc[n].w;
        const float mean = xor32_sum(xor16_sum(sm)) * (1.f / 64.f);
        float sv = 0.f;
#pragma unroll
        for (int n = 0; n < 4; ++n) { acc[n] = acc[n] - mean; sv += acc[n].x * acc[n].x + acc[n].y * acc[n].y + acc[n].z * acc[n].z + acc[n].w * acc[n].w; }
        const float rstd = rsqrtf(xor32_sum(xor16_sum(sv)) * (1.f / 64.f) + 64e-5f);
        float rk = 0.f; f32x4 vv[4];
#pragma unroll
        for (int n = 0; n < 4; ++n) {
            const int c = 16 * n + 4 * fq;
            const u32x2 r2 = *(const u32x2*)(Rd + hrow + c), k2 = *(const u32x2*)(Kd + hrow + c), v2 = *(const u32x2*)(Vd + hrow + c);
            const f32x4 rkw = *(const f32x4*)(p.r_k + hd * 64 + c);
            rk += lo_bf(r2.x) * lo_bf(k2.x) * rkw.x + hi_bf(r2.x) * hi_bf(k2.x) * rkw.y + lo_bf(r2.y) * lo_bf(k2.y) * rkw.z + hi_bf(r2.y) * hi_bf(k2.y) * rkw.w;
            vv[n] = (f32x4){lo_bf(v2.x), hi_bf(v2.x), lo_bf(v2.y), hi_bf(v2.y)};
        }
        rk = xor32_sum(xor16_sum(rk));
        const size_t t = (size_t)b * NS + s0 + fl;
#pragma unroll
        for (int n = 0; n < 4; ++n) {
            const int c = 16 * n + 4 * fq;
            const f32x4 lw = *(const f32x4*)(p.ln_w + hd * 64 + c), lb = *(const f32x4*)(p.ln_b + hd * 64 + c);
            const u32x2 g2 = *(const u32x2*)(Gd + t * 384 + hd * 64 + c);
            const f32x4 gg = (f32x4){lo_bf(g2.x), hi_bf(g2.x), lo_bf(g2.y), hi_bf(g2.y)};
            const f32x4 o = (acc[n] * rstd * lw + lb + vv[n] * rk) * gg;
            u32x2 w; w.x = pk2(o.x, o.y); w.y = pk2(o.z, o.w);
            *(u32x2*)(p.O + t * D + 256 + hd * 64 + c) = w;
        }
    }
}

__device__ __forceinline__ unsigned ordkey(float f) { const unsigned u = __float_as_uint(f); return (u & 0x80000000u) ? ~u : (u | 0x80000000u); }
__device__ __forceinline__ float unordkey(unsigned k) { return __uint_as_float((k & 0x80000000u) ? (k & 0x7FFFFFFFu) : ~k); }
__device__ __forceinline__ void ins16(unsigned (&L)[16], unsigned x) {
#pragma unroll
    for (int i = 0; i < 16; ++i) { const unsigned hi = L[i] > x ? L[i] : x; x = L[i] > x ? x : L[i]; L[i] = hi; }
}
__device__ __forceinline__ void top16_col(const float* col  , unsigned (&L)[16]) {
#pragma unroll
    for (int i = 0; i < 16; ++i) L[i] = 0u;
#pragma unroll 1
    for (int n0 = 0; n0 < 128; n0 += 16) {
        float x[16];
#pragma unroll
        for (int j = 0; j < 16; ++j) x[j] = col[(size_t)(n0 + j) * NT];
#pragma unroll
        for (int j = 0; j < 16; ++j) ins16(L, (ordkey(x[j]) & 0xFFFFFF80u) | (unsigned)(127 - (n0 + j)));
    }
}
__device__ void phase_topk(const float* SCT, int* EIDX, float* GATE, char* smem, int bid, int nblk) {
    const int tid = otid(), lane = tid & 63, wave = tid >> 6;
    unsigned char* itab = (unsigned char*)smem + tid * 32;
    unsigned char* ctab = (unsigned char*)smem + NTHREADS * 32;
    __syncthreads();
    if (tid < 64) {
        const int c = tid; int ci, cj;
        if (c < 16) { ci = 0; cj = c; } else if (c < 24) { ci = 1; cj = c - 16; } else if (c < 29) { ci = 2; cj = c - 24; } else if (c < 33) { ci = 3; cj = c - 29; }
        else if (c < 36) { ci = 4; cj = c - 33; } else if (c < 38) { ci = 5; cj = c - 36; } else if (c < 40) { ci = 6; cj = c - 38; } else if (c < 42) { ci = 7; cj = c - 40; }
        else if (c < 50) { ci = c - 34; cj = 0; } else { ci = 0; cj = 0; }
        ctab[c] = (unsigned char)(ci | (cj << 4));
    }
    __syncthreads();
    for (int x = bid * 4 + wave; x < (NT / 64) * 8; x += nblk * 4) {
        const int tb = x >> 3, hd = x & 7;
        const int t = tb * 64 + lane;
        unsigned L1[16], L2[16];
        top16_col(SCT + (size_t)(hd * 256) * NT + t, L1);
        top16_col(SCT + (size_t)(hd * 256 + 128) * NT + t, L2);
        float s1[16], s2[16];
#pragma unroll
        for (int i = 0; i < 16; ++i) {
            s1[i] = unordkey(L1[i] & 0xFFFFFF80u); s2[i] = unordkey(L2[i] & 0xFFFFFF80u);
            itab[i] = (unsigned char)(127u - (L1[i] & 127u)); itab[16 + i] = (unsigned char)(127u - (L2[i] & 127u));
        }
        unsigned M[16];
#pragma unroll
        for (int i = 0; i < 16; ++i) M[i] = 0u;
        int c = 0;
#pragma unroll
        for (int ci = 0; ci < 16; ++ci) {
#pragma unroll
            for (int cj = 0; cj < 16; ++cj) {
                if ((ci + 1) * (cj + 1) <= 16) {
                    const int cid = (ci == 0) ? cj : (ci == 1) ? 16 + cj : (ci == 2) ? 24 + cj : (ci == 3) ? 29 + cj : (ci == 4) ? 33 + cj : (ci == 5) ? 36 + cj : (ci == 6) ? 38 + cj : (ci == 7) ? 40 + cj : 34 + ci;
                    ins16(M, (ordkey(s1[ci] + s2[cj]) & 0xFFFFFFC0u) | (unsigned)(63 - cid));
                    ++c;
                }
            }
        }
        float ev[16]; int ee[16];
        const float mx = unordkey(M[0] & 0xFFFFFFC0u);
        float sum = 0.f;
#pragma unroll
        for (int i = 0; i < 16; ++i) {
            const int cid = 63 - (int)(M[i] & 63u);
            const unsigned cc = ctab[cid];
            ee[i] = (int)itab[cc & 15u] * 128 + (int)itab[16 + (cc >> 4)];
            ev[i] = __expf(unordkey(M[i] & 0xFFFFFFC0u) - mx);
            sum += ev[i];
        }
        const float inv = 1.f / sum;
        int* eo = EIDX + (size_t)t * 128 + hd * 16; float* go = GATE + (size_t)t * 128 + hd * 16;
#pragma unroll
        for (int i = 0; i < 4; ++i) {
            *(int4*)(eo + 4 * i) = make_int4(ee[4 * i], ee[4 * i + 1], ee[4 * i + 2], ee[4 * i + 3]);
            *(f32x4*)(go + 4 * i) = (f32x4){ev[4 * i] * inv, ev[4 * i + 1] * inv, ev[4 * i + 2] * inv, ev[4 * i + 3] * inv};
        }
    }
    __syncthreads();
}

typedef float f32x2 __attribute__((ext_vector_type(2)));
__device__ __forceinline__ float gelu_erf(float d) { return 0.5f * d * (1.f + erff(d * 0.7071067811865476f)); }
template <int NMODE>
__device__ void phase_expert(const bf16_t* H, const unsigned char* U4, const unsigned char* V4, const float* SU, const float* SV, const int* EIDX, const float* GATE,
                             const float* X, float* Xo, const float* gn, bf16_t* Hn, int bid, int nblk) {
    const int lane = otid() & 63, wave = otid() >> 6;
    for (int t = bid * 4 + wave; t < NT; t += nblk * 4) {
        f32x2 xf[8], acc[8];
        {
            const u32x4 a = *(const u32x4*)(H + (size_t)t * D + lane * 16), b = *(const u32x4*)(H + (size_t)t * D + lane * 16 + 8);
            xf[0] = (f32x2){lo_bf(a.x), hi_bf(a.x)}; xf[1] = (f32x2){lo_bf(a.y), hi_bf(a.y)}; xf[2] = (f32x2){lo_bf(a.z), hi_bf(a.z)}; xf[3] = (f32x2){lo_bf(a.w), hi_bf(a.w)};
            xf[4] = (f32x2){lo_bf(b.x), hi_bf(b.x)}; xf[5] = (f32x2){lo_bf(b.y), hi_bf(b.y)}; xf[6] = (f32x2){lo_bf(b.z), hi_bf(b.z)}; xf[7] = (f32x2){lo_bf(b.w), hi_bf(b.w)};
        }
#pragma unroll
        for (int i = 0; i < 8; ++i) acc[i] = (f32x2){0.f, 0.f};
        const int e_lo = EIDX[(size_t)t * 128 + lane], e_hi = EIDX[(size_t)t * 128 + 64 + lane];
        const float g_lo = GATE[(size_t)t * 128 + lane] * SV[e_lo], g_hi = GATE[(size_t)t * 128 + 64 + lane] * SV[e_hi];
        const float su_lo = SU[e_lo], su_hi = SU[e_hi];
#pragma unroll 1
        for (int e0 = 0; e0 < 128; e0 += 16) {
            const int esrc = (e0 < 64) ? e_lo : e_hi;
            int ei[16]; u32x2 ur[16];
#pragma unroll
            for (int j = 0; j < 16; ++j) { ei[j] = __builtin_amdgcn_readlane(esrc, (e0 & 63) + j); ur[j] = *(const u32x2*)(U4 + (size_t)ei[j] * 512 + lane * 8); }
            float dmine = 0.f;
#pragma unroll
            for (int j = 0; j < 16; ++j) {
                f32x2 d2 = (f32x2){0.f, 0.f};
                d2 = __builtin_elementwise_fma(xf[0], __builtin_amdgcn_cvt_scalef32_pk_f32_fp4(ur[j].x, 1.0f, 0), d2);
                d2 = __builtin_elementwise_fma(xf[1], __builtin_amdgcn_cvt_scalef32_pk_f32_fp4(ur[j].x, 1.0f, 1), d2);
                d2 = __builtin_elementwise_fma(xf[2], __builtin_amdgcn_cvt_scalef32_pk_f32_fp4(ur[j].x, 1.0f, 2), d2);
                d2 = __builtin_elementwise_fma(xf[3], __builtin_amdgcn_cvt_scalef32_pk_f32_fp4(ur[j].x, 1.0f, 3), d2);
                d2 = __builtin_elementwise_fma(xf[4], __builtin_amdgcn_cvt_scalef32_pk_f32_fp4(ur[j].y, 1.0f, 0), d2);
                d2 = __builtin_elementwise_fma(xf[5], __builtin_amdgcn_cvt_scalef32_pk_f32_fp4(ur[j].y, 1.0f, 1), d2);
                d2 = __builtin_elementwise_fma(xf[6], __builtin_amdgcn_cvt_scalef32_pk_f32_fp4(ur[j].y, 1.0f, 2), d2);
                d2 = __builtin_elementwise_fma(xf[7], __builtin_amdgcn_cvt_scalef32_pk_f32_fp4(ur[j].y, 1.0f, 3), d2);
                const float d = wave_sum(d2.x + d2.y);
                if (lane == (e0 & 63) + j) dmine = d;
            }
            const float amine = gelu_erf(dmine * ((e0 < 64) ? su_lo : su_hi)) * ((e0 < 64) ? g_lo : g_hi);
#pragma unroll
            for (int j = 0; j < 16; ++j) ur[j] = *(const u32x2*)(V4 + (size_t)ei[j] * 512 + lane * 8);
#pragma unroll
            for (int j = 0; j < 16; ++j) {
                const float a = __int_as_float(__builtin_amdgcn_readlane(__float_as_int(amine), (e0 & 63) + j));
                const f32x2 a2 = (f32x2){a, a};
                acc[0] = __builtin_elementwise_fma(a2, __builtin_amdgcn_cvt_scalef32_pk_f32_fp4(ur[j].x, 1.0f, 0), acc[0]);
                acc[1] = __builtin_elementwise_fma(a2, __builtin_amdgcn_cvt_scalef32_pk_f32_fp4(ur[j].x, 1.0f, 1), acc[1]);
                acc[2] = __builtin_elementwise_fma(a2, __builtin_amdgcn_cvt_scalef32_pk_f32_fp4(ur[j].x, 1.0f, 2), acc[2]);
                acc[3] = __builtin_elementwise_fma(a2, __builtin_amdgcn_cvt_scalef32_pk_f32_fp4(ur[j].x, 1.0f, 3), acc[3]);
                acc[4] = __builtin_elementwise_fma(a2, __builtin_amdgcn_cvt_scalef32_pk_f32_fp4(ur[j].y, 1.0f, 0), acc[4]);
                acc[5] = __builtin_elementwise_fma(a2, __builtin_amdgcn_cvt_scalef32_pk_f32_fp4(ur[j].y, 1.0f, 1), acc[5]);
                acc[6] = __builtin_elementwise_fma(a2, __builtin_amdgcn_cvt_scalef32_pk_f32_fp4(ur[j].y, 1.0f, 2), acc[6]);
                acc[7] = __builtin_elementwise_fma(a2, __builtin_amdgcn_cvt_scalef32_pk_f32_fp4(ur[j].y, 1.0f, 3), acc[7]);
            }
        }
        const f32x4* xr = (const f32x4*)(X + (size_t)t * D) + lane * 4;
        f32x4* xo = (f32x4*)(Xo + (size_t)t * D) + lane * 4;
        f32x4 o[4]; float ss = 0.f;
#pragma unroll
        for (int i = 0; i < 4; ++i) { o[i] = xr[i]; o[i] += (f32x4){acc[2 * i].x, acc[2 * i].y, acc[2 * i + 1].x, acc[2 * i + 1].y}; ss += o[i].x * o[i].x + o[i].y * o[i].y + o[i].z * o[i].z + o[i].w * o[i].w; }
        const float rs = rsqrtf(wave_sum(ss) * (1.f / D) + 1e-6f);
        const f32x4* gp = (const f32x4*)gn + lane * 4;
        if (NMODE == 1) {
#pragma unroll
            for (int i = 0; i < 4; ++i) xo[i] = o[i] * rs * gp[i];
        } else {
            u32x4 h0, h1;
            { const f32x4 y0 = o[0] * rs * gp[0], y1 = o[1] * rs * gp[1], y2 = o[2] * rs * gp[2], y3 = o[3] * rs * gp[3];
              h0 = (u32x4){pk2(y0.x, y0.y), pk2(y0.z, y0.w), pk2(y1.x, y1.y), pk2(y1.z, y1.w)}; h1 = (u32x4){pk2(y2.x, y2.y), pk2(y2.z, y2.w), pk2(y3.x, y3.y), pk2(y3.z, y3.w)}; }
#pragma unroll
            for (int i = 0; i < 4; ++i) xo[i] = o[i];
            *(u32x4*)(Hn + (size_t)t * D + lane * 16) = h0; *(u32x4*)(Hn + (size_t)t * D + lane * 16 + 8) = h1;
        }
    }
}

#define XB_TMO      128
#define XB_XCNT(j)  (256  + 64 * (j))
#define XB_XSUB(j)  (1280 + 64 * (j))
#define XB_XGEN(j)  (2304 + 64 * (j))
#define XB_TOP      3328
#define XB_TOPGEN   3392
#define XCD_BAR_WORDS 3456
#define XB_SPIN_CAP (1u << 22)
#define LAS __attribute__((address_space(3)))
__device__ __forceinline__ unsigned xb_ld(unsigned* p)              { return __hip_atomic_load(p, __ATOMIC_RELAXED, __HIP_MEMORY_SCOPE_AGENT); }
__device__ __forceinline__ unsigned xb_add(unsigned* p, unsigned v) { return __hip_atomic_fetch_add(p, v, __ATOMIC_RELAXED, __HIP_MEMORY_SCOPE_AGENT); }
__device__ __forceinline__ unsigned xb_xcc_id() { return (unsigned)__builtin_amdgcn_s_getreg((3 << 11) | 20) & 0xFu; }
#define XB_SPIN(cond, bar) do { unsigned _sp = 0; while (cond) { __builtin_amdgcn_s_sleep(1); \
    if ((++_sp & 255u) == 0u) { if (xb_ld(&(bar)[XB_TMO])) break; if (_sp > XB_SPIN_CAP) { atomicAdd(&(bar)[XB_TMO], 1u); break; } } } } while (0)
struct XcdBarrier { unsigned* bar; unsigned x; volatile LAS unsigned* st; };
__device__ __forceinline__ XcdBarrier xcd_barrier_post(unsigned* bar, volatile LAS unsigned* st) {
    XcdBarrier b; b.bar = bar; b.x = xb_xcc_id(); b.st = st;
    if (threadIdx.x == 0) (void)xb_add(&bar[XB_XCNT(b.x)], 1u);
    return b;
}
__device__ __forceinline__ void xcd_barrier_complete(unsigned* bar, unsigned x, unsigned& nloc, unsigned& nx) {
    const unsigned G = gridDim.x * gridDim.y * gridDim.z;
    unsigned sum, cnt, mine, sp = 0u;
    for (;;) {
        sum = 0u; cnt = 0u; mine = 0u;
#pragma unroll
        for (unsigned j = 0; j < 16; ++j) { const unsigned c = xb_ld(&bar[XB_XCNT(j)]); sum += c; cnt += (c > 0u) ? 1u : 0u; mine = (j == x) ? c : mine; }
        if (sum == G) break;
        __builtin_amdgcn_s_sleep(1);
        if ((++sp & 255u) == 0u) { if (xb_ld(&bar[XB_TMO])) break; if (sp > XB_SPIN_CAP) { atomicAdd(&bar[XB_TMO], 1u); break; } }
    }
    nloc = mine > 0u ? mine : 1u; nx = cnt > 0u ? cnt : 1u;
}
__device__ __forceinline__ void xcd_barrier(const XcdBarrier& b) {
    asm volatile("s_waitcnt vmcnt(0)" ::: "memory");
    __syncthreads();
    if (threadIdx.x == 0) {
        unsigned* bar = b.bar;
        __builtin_amdgcn_s_waitcnt(0);
        unsigned nloc = b.st[0], nx = b.st[1];
        if (nloc == 0u) { xcd_barrier_complete(bar, b.x, nloc, nx); b.st[0] = nloc; b.st[1] = nx; }
        const unsigned old = xb_add(&bar[XB_XSUB(b.x)], 1u);
        const unsigned gen = old / nloc;
        if (old + 1u == (gen + 1u) * nloc) {
            __builtin_amdgcn_fence(__ATOMIC_RELEASE, "agent");
            asm volatile("s_waitcnt vmcnt(0)" ::: "memory");
            const unsigned og = xb_add(&bar[XB_TOP], 1u);
            const unsigned tg = og / nx;
            if (og + 1u == (tg + 1u) * nx) xb_add(&bar[XB_TOPGEN], 1u);
            else XB_SPIN(xb_ld(&bar[XB_TOPGEN]) == tg, bar);
            __builtin_amdgcn_fence(__ATOMIC_ACQUIRE, "agent");
            xb_add(&bar[XB_XGEN(b.x)], 1u);
            asm volatile("s_waitcnt vmcnt(0)" ::: "memory");
        } else {
            XB_SPIN(xb_ld(&bar[XB_XGEN(b.x)]) == gen, bar);
            __builtin_amdgcn_fence(__ATOMIC_ACQUIRE, "agent");
            asm volatile("s_waitcnt vmcnt(0)" ::: "memory");
        }
    }
    __syncthreads();
}

struct Params {
    const float* in[24];
    float* out; unsigned char* ws;
};
constexpr int LDS_BYTES = 2 * 2 * 128 * GS * 2 + 256;

__device__ __forceinline__ RwP make_rwp(const Params& P, int l) {
    RwP r;
    r.Z = (const bf16_t*)(P.ws + WS_Z); r.mix = P.ws + WS_MIX;
    r.mu = P.in[6] + l * RW_F; r.w_up = P.in[7] + (size_t)l * 64 * 384; r.w_bias = P.in[8] + l * 384; r.a_up = P.in[9] + (size_t)l * 64 * 384; r.a_bias = P.in[10] + l * 384;
    r.g_up = P.in[11] + (size_t)l * 128 * 384; r.k_k = P.in[12] + l * 384; r.k_a = P.in[13] + l * 384; r.r_k = P.in[14] + l * 384; r.ln_w = P.in[15] + l * 384; r.ln_b = P.in[16] + l * 384;
    r.oraw = (float*)(P.ws + WS_H); r.O = (bf16_t*)(P.ws + WS_O); r.Y = (bf16_t*)(P.ws + WS_EIDX); r.lora = (const bf16_t*)(P.ws + WS_LORA + l * LORA_L);
    return r;
}

__global__ void __launch_bounds__(NTHREADS, 2) mega_fwd(Params P) {
    extern __shared__ __attribute__((aligned(16))) char smem[];
    const int bid = blockIdx.x, nblk = gridDim.x;
    volatile LAS unsigned* st = (volatile LAS unsigned*)(smem + LDS_BYTES - 16);
    if (threadIdx.x == 0) { st[0] = 0u; st[1] = 0u; st[2] = 0u; st[3] = 0u; }
    __syncthreads();
    XcdBarrier bar = xcd_barrier_post((unsigned*)(P.ws + WS_CTL), st);
#define GSYNC() xcd_barrier(bar)

    {
        ConvP c{P.in[4], P.in[5], P.in[20], P.in[21], P.in[22], P.in[23], P.in[7], P.in[9], P.in[11], P.ws};
        phase_convert_weights(c, smem, bid, nblk);
        phase_rmsnorm<false>(P.in[0], P.in[1], P.ws + WS_H, bid, nblk);
    }
    GSYNC();
#pragma unroll 1
    for (int l = 0; l < 2; ++l) {
        const float* xin = (l == 0) ? P.in[0] : P.out;
        {
            GemmP g{(const bf16_t*)(P.ws + WS_H), D, 0, 0, (const bf16_t*)(P.ws + WS_WTIN) + (size_t)l * DINP * D, D, D, NT / 128, DINP / 128 - 1, P.ws + WS_Z, DINP, nullptr};
            phase_gemm_glds<0>(g, smem, bid, nblk);
            phase_gemm<0, true>(g, smem, bid, nblk, (NT / 128 * (DINP / 128 - 1)) % nblk);
            if (l == 0) {
                for (int l2 = 0; l2 < 2; ++l2) {
                    GemmP ge{(const bf16_t*)(P.ws + WS_SK) + (size_t)l2 * 16 * 128 * 128, 128, 0, 128, (const bf16_t*)(P.ws + WS_WTQ) + (size_t)l2 * D * 2048, 2048, 128, 16, 8,
                             (bf16_t*)(P.ws + WS_WEFF) + (size_t)l2 * 2048 * D, D, nullptr};
                    phase_gemm<0>(ge, smem, bid, nblk, (NT / 128 * (DINP / 128) + l2 * 128) % nblk);
                }
            }
        }
        GSYNC();
        RwP rw = make_rwp(P, l);
        LinP lp{(const bf16_t*)(P.ws + WS_Z), (bf16_t*)(P.ws + WS_O), P.in[17] + (size_t)l * 16 * 192, P.in[18] + l * 192, P.in[19] + l * 384, (const float*)(P.ws + WS_ROPE), P.ws + WS_LIN};
        for (int task = bid; task < 512 + 2048; task += nblk) {
            if (task < 512) { rwkv_prep_task(rw, smem, task); }
            else { lin_kv_dispatch(lp, smem, task - 512); }
        }
        GSYNC();
        {
            for (int task = bid; task < 240; task += nblk) {
                const int bh = task / 10, r = task % 10;
                const int seg = r < 2 ? 0 : (r < 6 ? 1 : 2), grp = r < 2 ? r : (r < 6 ? r - 2 : r - 6);
                rwkv_scan_task(rw, smem, bh, seg, grp);
            }
            unsigned* lflags = (unsigned*)(P.ws + WS_FLAGS) + l * 32;
            if (nblk >= 512) {
                if (bid >= 240) {
                    lin_scan_phase(lp, bid - 240, nblk - 240, lflags);
                    for (int task = bid - 240; task < 2048; task += nblk - 240) lin_out_dispatch(lp, smem, task, lflags);
                }
            } else {
                lin_scan_phase(lp, bid, nblk, lflags);
                for (int task = bid; task < 2048; task += nblk) lin_out_dispatch(lp, smem, task, lflags);
            }
            if (l == 0) {
                ConvP c{P.in[4], P.in[5], P.in[20], P.in[21], P.in[22], P.in[23], P.in[7], P.in[9], P.in[11], P.ws};
                if (nblk >= 512) { if (bid >= 240) phase_convert_uv(c, bid - 240, nblk - 240); } else phase_convert_uv(c, bid, nblk);
            }
        }
        GSYNC();
        phase_rwkv_chain(rw, bid, nblk);
        GSYNC();
        phase_rwkv_post(rw, bid, nblk);
        GSYNC();
        {
            GemmP g{(const bf16_t*)(P.ws + WS_O), D, 0, 0, (const bf16_t*)(P.ws + WS_WTOUT) + (size_t)l * D * D, D, D, NT / 128, D / 128, P.out, D, xin};
            phase_gemm_glds<2>(g, smem, bid, nblk);
        }
        GSYNC();
        phase_rmsnorm<false>(P.out, P.in[2] + l * D, P.ws + WS_H, bid, nblk);
        GSYNC();
        {
            GemmP g{(const bf16_t*)(P.ws + WS_H), D, 0, 0, (const bf16_t*)(P.ws + WS_WEFF) + (size_t)l * 2048 * D, D, D, NT / 128, 2048 / 128, P.ws + WS_MIX, NT, nullptr};
            phase_gemm_glds<3>(g, smem, bid, nblk);
        }
        GSYNC();
        phase_topk((const float*)(P.ws + WS_MIX), (int*)(P.ws + WS_EIDX), (float*)(P.ws + WS_GATE), smem, bid, nblk);
        GSYNC();
        if (l == 0) phase_expert<0>((const bf16_t*)(P.ws + WS_H), P.ws + WS_UB + (size_t)l * NEXP * 512, P.ws + WS_VB + (size_t)l * NEXP * 512,
                     (const float*)(P.ws + WS_ESC) + l * NEXP, (const float*)(P.ws + WS_ESC) + (2 + l) * NEXP,
                     (const int*)(P.ws + WS_EIDX), (const float*)(P.ws + WS_GATE), P.out, P.out, P.in[1] + D, (bf16_t*)(P.ws + WS_H), bid, nblk);
        else phase_expert<1>((const bf16_t*)(P.ws + WS_H), P.ws + WS_UB + (size_t)l * NEXP * 512, P.ws + WS_VB + (size_t)l * NEXP * 512,
                     (const float*)(P.ws + WS_ESC) + l * NEXP, (const float*)(P.ws + WS_ESC) + (2 + l) * NEXP,
                     (const int*)(P.ws + WS_EIDX), (const float*)(P.ws + WS_GATE), P.out, P.out, P.in[3], nullptr, bid, nblk);
        if (l == 0) GSYNC();
    }
}

extern "C" void kernel_launch(void* const* d_in, const int* in_sizes, int n_in, void* d_out, int out_size, void* d_ws, size_t ws_size, hipStream_t stream) {
    static int grid = 0;
    if (grid == 0) {
        if (n_in != 24 || ws_size < WS_END) { fprintf(stderr, "kernel_launch: bad args n_in=%d ws=%zu need=%zu\n", n_in, ws_size, (size_t)WS_END); grid = -1; return; }
        int dev = 0, cus = 0, per_cu = 0;
        hipGetDevice(&dev);
        hipDeviceGetAttribute(&cus, hipDeviceAttributeMultiprocessorCount, dev);
        hipFuncSetAttribute((const void*)mega_fwd, hipFuncAttributeMaxDynamicSharedMemorySize, LDS_BYTES);
        hipOccupancyMaxActiveBlocksPerMultiprocessor(&per_cu, (const void*)mega_fwd, NTHREADS, LDS_BYTES);
        if (per_cu < 1) { fprintf(stderr, "kernel_launch: occupancy query says %d\n", per_cu); grid = -1; return; }
        if (per_cu > 2) per_cu = 2;
        grid = cus * per_cu;
        fprintf(stderr, "kernel_launch: grid %d (%d CUs x %d)\n", grid, cus, per_cu);
    }
    if (grid < 0) return;
    hipMemsetAsync((char*)d_ws + WS_CTL, 0, 32768, stream);
    Params P{};
    for (int i = 0; i < 24; ++i) P.in[i] = (const float*)d_in[i];
    P.out = (float*)d_out; P.ws = (unsigned char*)d_ws;
    void* args[] = {&P};
    hipError_t e = hipLaunchCooperativeKernel((const void*)mega_fwd, dim3(grid), dim3(NTHREADS), args, LDS_BYTES, stream);
    if (e != hipSuccess) fprintf(stderr, "cooperative launch failed: %s (grid %d)\n", hipGetErrorString(e), grid);
}
```

```cpp
#include <hip/hip_runtime.h>
#include <stdint.h>
#include <stdio.h>

typedef unsigned short bf16_t;
typedef short bf16x8 __attribute__((ext_vector_type(8)));
typedef float f32x4 __attribute__((ext_vector_type(4)));
typedef unsigned u32x4 __attribute__((ext_vector_type(4)));
typedef unsigned u32x2 __attribute__((ext_vector_type(2)));

constexpr int NB = 4, NS = 4096, NT = NB * NS, D = 1024, DIN = 3600, DINP = 3840;
constexpr int ZC_RET = 0, ZC_RW = 1024, ZC_GLA = 2432;
constexpr int RW_F = 1408;
constexpr int NEXP = 16384;
constexpr int NTHREADS = 512;
constexpr int NW = NTHREADS / 64;

constexpr size_t MiB = 1024ull * 1024ull;
constexpr size_t WS_CTL   = 0;
constexpr size_t WS_LORA  = 65536;
constexpr size_t LORA_L   = 384ull * 256 * 2;
constexpr size_t WS_ESC   = 524288;
constexpr size_t WS_WTIN  = 1 * MiB;
constexpr size_t WS_WTOUT = WS_WTIN + 2ull * DINP * D * 2;
constexpr size_t WS_WTQ   = WS_WTOUT + 2ull * D * D * 2;
constexpr size_t WS_SK    = WS_WTQ + 2ull * 2048 * D * 2;
constexpr size_t WS_UB    = WS_SK + 2ull * 16 * 128 * 128 * 2;
constexpr size_t WS_VB    = WS_UB + 2ull * NEXP * D;
constexpr size_t WS_LIN   = WS_VB + 2ull * NEXP * D;
constexpr size_t WS_H     = WS_LIN + 64 * MiB;
constexpr size_t WS_Z     = WS_H + (size_t)NT * D * 2;
constexpr size_t WS_O     = WS_Z + (size_t)NT * DINP * 2;
constexpr size_t WS_MIX   = WS_O + (size_t)NT * D * 2;
constexpr size_t WS_EIDX  = WS_MIX + 128 * MiB;
constexpr size_t WS_GATE  = WS_EIDX + (size_t)NT * 128 * 4;
constexpr size_t WS_ROPE  = WS_GATE + (size_t)NT * 128 * 4;
constexpr size_t WS_WEFF  = WS_ROPE + 1 * MiB;
constexpr size_t WS_SKBD  = WS_WEFF + 2ull * 2048 * D * 2;
constexpr size_t WS_END   = WS_SKBD + 2ull * 2048 * 2048 * 2;
constexpr size_t RWA = (size_t)NT * 384;
constexpr size_t MX_W   = 0;
constexpr size_t MX_KK  = MX_W + RWA * 4;
constexpr size_t MX_KKA = MX_KK + RWA * 4;
constexpr size_t MX_R   = MX_KKA + RWA * 4;
constexpr size_t MX_K   = MX_R + RWA * 2;
constexpr size_t MX_V   = MX_K + RWA * 2;
constexpr size_t MX_G   = MX_V + RWA * 2;
constexpr size_t MX_END = MX_G + RWA * 2;
static_assert(MX_END <= 128 * MiB, "mix region");

__device__ __forceinline__ float bf2f(bf16_t v) { return __uint_as_float(((unsigned)v) << 16); }
__device__ __forceinline__ bf16_t f2bf(float f) { unsigned u = __float_as_uint(f); u += 0x7FFFu + ((u >> 16) & 1u); return (bf16_t)(u >> 16); }
__device__ __forceinline__ unsigned pk2(float lo, float hi) { return (unsigned)f2bf(lo) | ((unsigned)f2bf(hi) << 16); }
__device__ __forceinline__ float lo_bf(unsigned u) { return __uint_as_float(u << 16); }
__device__ __forceinline__ float hi_bf(unsigned u) { return __uint_as_float(u & 0xFFFF0000u); }
template <int CTRL> __device__ __forceinline__ float dpp_f(float v) { return __int_as_float(__builtin_amdgcn_update_dpp(0, __float_as_int(v), CTRL, 0xF, 0xF, true)); }
template <int CTRL> __device__ __forceinline__ unsigned dpp_u(unsigned v) { return (unsigned)__builtin_amdgcn_update_dpp(0, (int)v, CTRL, 0xF, 0xF, true); }
__device__ __forceinline__ float row16_sum(float v) { v += dpp_f<0x128>(v); v += dpp_f<0x124>(v); v += dpp_f<0x122>(v); v += dpp_f<0x121>(v); return v; }
__device__ __forceinline__ float xor16_sum(float v) { auto r = __builtin_amdgcn_permlane16_swap(__float_as_uint(v), __float_as_uint(v), false, false); return __uint_as_float(r[0]) + __uint_as_float(r[1]); }
__device__ __forceinline__ float xor32_sum(float v) { auto r = __builtin_amdgcn_permlane32_swap(__float_as_uint(v), __float_as_uint(v), false, false); return __uint_as_float(r[0]) + __uint_as_float(r[1]); }
__device__ __forceinline__ float wave_sum(float v) { return xor32_sum(xor16_sum(row16_sum(v))); }
__device__ __forceinline__ unsigned umax_(unsigned a, unsigned b) { return a > b ? a : b; }
__device__ __forceinline__ unsigned wave_max_u32(unsigned v) {
    v = umax_(v, dpp_u<0x128>(v)); v = umax_(v, dpp_u<0x124>(v)); v = umax_(v, dpp_u<0x122>(v)); v = umax_(v, dpp_u<0x121>(v));
    { auto r = __builtin_amdgcn_permlane16_swap(v, v, false, false); v = umax_(r[0], r[1]); }
    { auto r = __builtin_amdgcn_permlane32_swap(v, v, false, false); v = umax_(r[0], r[1]); }
    return v;
}
__device__ __forceinline__ float sigmoidf_(float x) { return 1.f / (1.f + __expf(-x)); }
__device__ __forceinline__ float softplusf_(float x) { return fmaxf(x, 0.f) + __logf(1.f + __expf(-fabsf(x))); }
__device__ __forceinline__ float tanhf_(float x) { const float e = __expf(2.f * fminf(fmaxf(x, -15.f), 15.f)); return (e - 1.f) / (e + 1.f); }

__device__ __forceinline__ int otid() { int t = threadIdx.x; asm volatile("" : "+v"(t)); return t; }

constexpr size_t WS_FLAGS = 16384;
__device__ __forceinline__ void flag_signal(unsigned* f, unsigned inc = 1u) {
    asm volatile("s_waitcnt vmcnt(0)" ::: "memory");
    __syncthreads();
    if (threadIdx.x == 0) {
        __builtin_amdgcn_fence(__ATOMIC_RELEASE, "agent");
        asm volatile("s_waitcnt vmcnt(0)" ::: "memory");
        __hip_atomic_fetch_add(f, inc, __ATOMIC_RELAXED, __HIP_MEMORY_SCOPE_AGENT);
    }
}
__device__ __forceinline__ void flag_wait(unsigned* f, unsigned need) {
    if (threadIdx.x == 0) {
        unsigned sp = 0;
        while (__hip_atomic_load(f, __ATOMIC_RELAXED, __HIP_MEMORY_SCOPE_AGENT) < need) { __builtin_amdgcn_s_sleep(4); if (++sp > (1u << 22)) break; }
        __builtin_amdgcn_fence(__ATOMIC_ACQUIRE, "agent");
        asm volatile("s_waitcnt vmcnt(0)" ::: "memory");
    }
    __syncthreads();
}

__device__ void transpose_tile(const float* __restrict__ W, int K, int N, bf16_t* __restrict__ Wt, int kt, int nt, float* tile  ) {
    const int tid = otid();
    const int k0 = kt * 64, n0 = nt * 64;
    if (tid < 256)
#pragma unroll
    for (int i = 0; i < 4; ++i) {
        const int k = i * 16 + (tid >> 4), n4 = (tid & 15) * 4;
        f32x4 v = (f32x4){0.f, 0.f, 0.f, 0.f};
        if (n0 + n4 < N) v = *(const f32x4*)(W + (size_t)(k0 + k) * N + n0 + n4);
        tile[k * 65 + n4] = v.x; tile[k * 65 + n4 + 1] = v.y; tile[k * 65 + n4 + 2] = v.z; tile[k * 65 + n4 + 3] = v.w;
    }
    __syncthreads();
    if (tid < 256) {
        const int n = tid >> 2, kc = (tid & 3) * 16;
        unsigned w[8];
#pragma unroll
        for (int j = 0; j < 8; ++j) w[j] = pk2(tile[(kc + 2 * j) * 65 + n], tile[(kc + 2 * j + 1) * 65 + n]);
        u32x4* dst = (u32x4*)(Wt + (size_t)(n0 + n) * K + k0 + kc);
        dst[0] = (u32x4){w[0], w[1], w[2], w[3]}; dst[1] = (u32x4){w[4], w[5], w[6], w[7]};
    }
    __syncthreads();
}

struct ConvP {
    const float* w_in; const float* w_out; const float* w_q; const float* sk; const float* u; const float* v;
    const float* w_up; const float* a_up; const float* g_up;
    unsigned char* ws;
};

__device__ void phase_convert_weights(const ConvP& p, char* smem, int bid, int nblk) {
    float* tile = (float*)smem;
    constexpr int T_IN = 16 * 60, T_OUT = 16 * 16, T_L = T_IN + T_OUT;
    for (int it = bid; it < 2 * T_L; it += nblk) {
        const int l = it / T_L; int r = it % T_L;
        if (r < T_IN) { transpose_tile(p.w_in + (size_t)l * D * DIN, D, DIN, (bf16_t*)(p.ws + WS_WTIN) + (size_t)l * DINP * D, r / 60, r % 60, tile); continue; }
        r -= T_IN;
        transpose_tile(p.w_out + (size_t)l * D * D, D, D, (bf16_t*)(p.ws + WS_WTOUT) + (size_t)l * D * D, r / 16, r % 16, tile);
    }
    const size_t gtid = (size_t)bid * NTHREADS + otid(), gn = (size_t)nblk * NTHREADS;
    {
        u32x4* d = (u32x4*)(p.ws + WS_SKBD);
        for (size_t i = gtid; i < 2ull * 2048 * 2048 / 8; i += gn) {
            const size_t l = i / (2048 * 256), r = (i / 256) % 2048, c8 = (i % 256) * 8;
            u32x4 o = (u32x4){0u, 0u, 0u, 0u};
            if ((c8 >> 7) == (r >> 7)) {
                const f32x4* sp = (const f32x4*)(p.sk + ((l * 2048 + r) * 128 + (c8 & 127)));
                const f32x4 a = sp[0], b = sp[1];
                o.x = pk2(a.x, a.y); o.y = pk2(a.z, a.w); o.z = pk2(b.x, b.y); o.w = pk2(b.z, b.w);
            }
            d[i] = o;
        }
    }
    {
        for (size_t i = gtid; i < 2ull * 384 * 256; i += gn) {
            const int l = (int)(i / (384 * 256)), r = (int)(i % (384 * 256)), c = r >> 8, k = r & 255;
            bf16_t* base = (bf16_t*)(p.ws + WS_LORA + l * LORA_L);
            if (k < 64) base[c * 64 + k] = f2bf(p.w_up[(size_t)l * 64 * 384 + k * 384 + c]);
            else if (k < 128) base[384 * 64 + c * 64 + (k - 64)] = f2bf(p.a_up[(size_t)l * 64 * 384 + (k - 64) * 384 + c]);
            else base[2 * 384 * 64 + c * 128 + (k - 128)] = f2bf(p.g_up[(size_t)l * 128 * 384 + (k - 128) * 384 + c]);
        }
    }
    {
        float* ct = (float*)(p.ws + WS_ROPE); float* stb = ct + NS * 32;
        for (size_t i = gtid; i < (size_t)NS * 32; i += gn) {
            const int pos = (int)(i >> 5), fi = (int)(i & 31);
            const float inv = exp2f(-(float)fi * (13.287712379549449f / 32.f));
            float sn, cs; sincosf((float)pos * inv, &sn, &cs);
            ct[i] = cs; stb[i] = sn;
        }
    }
    {
        const size_t n8 = (2ull * D * 2048) / 8;
        const f32x4* s = (const f32x4*)p.w_q; u32x4* d = (u32x4*)(p.ws + WS_WTQ);
        for (size_t i = gtid; i < n8; i += gn) { f32x4 a = s[2 * i], b = s[2 * i + 1]; u32x4 o; o.x = pk2(a.x, a.y); o.y = pk2(a.z, a.w); o.z = pk2(b.x, b.y); o.w = pk2(b.z, b.w); d[i] = o; }
    }
    {
        const size_t n8 = (2ull * 16 * 128 * 128) / 8;
        const f32x4* s = (const f32x4*)p.sk; u32x4* d = (u32x4*)(p.ws + WS_SK);
        for (size_t i = gtid; i < n8; i += gn) { f32x4 a = s[2 * i], b = s[2 * i + 1]; u32x4 o; o.x = pk2(a.x, a.y); o.y = pk2(a.z, a.w); o.z = pk2(b.x, b.y); o.w = pk2(b.z, b.w); d[i] = o; }
    }
}

struct CvP { const float* u; const float* v; unsigned char* ws; };
__device__ __forceinline__ void convert_uv_row(const CvP& p, int r, int lane) {
    {
        {
            const bool isv = r >= 2 * NEXP; const int rr = isv ? r - 2 * NEXP : r;
            const f32x4* src = (const f32x4*)((isv ? p.v : p.u) + (size_t)rr * D) + lane * 4;
            f32x4 x[4]; float mx = 0.f;
#pragma unroll
            for (int i = 0; i < 4; ++i) { x[i] = src[i]; mx = fmaxf(mx, fmaxf(fmaxf(fabsf(x[i].x), fabsf(x[i].y)), fmaxf(fabsf(x[i].z), fabsf(x[i].w)))); }
            mx = __uint_as_float(wave_max_u32(__float_as_uint(mx)));
            const float sc = mx > 0.f ? 6.f / mx : 0.f;
            unsigned w0 = 0u, w1 = 0u;
            w0 = __builtin_amdgcn_cvt_scalef32_pk_fp4_f32(w0, x[0].x * sc, x[0].y * sc, 1.0f, 0); w0 = __builtin_amdgcn_cvt_scalef32_pk_fp4_f32(w0, x[0].z * sc, x[0].w * sc, 1.0f, 1);
            w0 = __builtin_amdgcn_cvt_scalef32_pk_fp4_f32(w0, x[1].x * sc, x[1].y * sc, 1.0f, 2); w0 = __builtin_amdgcn_cvt_scalef32_pk_fp4_f32(w0, x[1].z * sc, x[1].w * sc, 1.0f, 3);
            w1 = __builtin_amdgcn_cvt_scalef32_pk_fp4_f32(w1, x[2].x * sc, x[2].y * sc, 1.0f, 0); w1 = __builtin_amdgcn_cvt_scalef32_pk_fp4_f32(w1, x[2].z * sc, x[2].w * sc, 1.0f, 1);
            w1 = __builtin_amdgcn_cvt_scalef32_pk_fp4_f32(w1, x[3].x * sc, x[3].y * sc, 1.0f, 2); w1 = __builtin_amdgcn_cvt_scalef32_pk_fp4_f32(w1, x[3].z * sc, x[3].w * sc, 1.0f, 3);
            *(u32x2*)(p.ws + (isv ? WS_VB : WS_UB) + (size_t)rr * 512 + lane * 8) = (u32x2){w0, w1};
            if (lane == 0) ((float*)(p.ws + WS_ESC))[r] = mx * (1.f / 6.f);
        }
    }
}
__device__ void phase_convert_uv(const ConvP& p, int bid, int nblk) {
    const int lane = otid() & 63, gw = bid * NW + (otid() >> 6), ngw = nblk * NW;
    const CvP c{p.u, p.v, p.ws};
    for (int r = gw; r < 4 * NEXP; r += ngw) convert_uv_row(c, r, lane);
}

template <bool OUT_F32>
__device__ void phase_rmsnorm(const float* x, const float* __restrict__ g, void* out, int bid, int nblk) {
    const int lane = otid() & 63, wave = otid() >> 6;
    const int gw = bid * NW + wave, ngw = nblk * NW;
    f32x4 gv[4];
#pragma unroll
    for (int j = 0; j < 4; ++j) gv[j] = ((const f32x4*)g)[lane + 64 * j];
    for (int row = gw; row < NT; row += ngw) {
        const f32x4* xr = (const f32x4*)(x + (size_t)row * D) + lane;
        f32x4 v[4]; float s = 0.f;
#pragma unroll
        for (int j = 0; j < 4; ++j) { v[j] = xr[64 * j]; s += v[j].x * v[j].x + v[j].y * v[j].y + v[j].z * v[j].z + v[j].w * v[j].w; }
        s = wave_sum(s);
        const float rs = rsqrtf(s * (1.f / D) + 1e-6f);
        if (OUT_F32) {
            f32x4* o = (f32x4*)((float*)out + (size_t)row * D) + lane;
#pragma unroll
            for (int j = 0; j < 4; ++j) o[64 * j] = v[j] * rs * gv[j];
        } else {
            u32x2* o = (u32x2*)((bf16_t*)out + (size_t)row * D) + lane;
#pragma unroll
            for (int j = 0; j < 4; ++j) { f32x4 y = v[j] * rs * gv[j]; u32x2 w; w.x = pk2(y.x, y.y); w.y = pk2(y.z, y.w); o[64 * j] = w; }
        }
    }
}

struct GemmP {
    const bf16_t* A; int lda; int a_koff;
    int b_koff;
    const bf16_t* Bt; int ldb; int K;
    int MT, NTl;
    void* C; int ldc; const float* R;
};
constexpr int GS = 72;
template <int MODE, bool NARROW = false>
__device__ void phase_gemm(const GemmP& p, char* smem, int bid, int nblk, int tile0 = 0) {
    bf16_t* As = (bf16_t*)smem;
    bf16_t* Bs = As + 128 * GS;
    const int tid = otid(), lane = tid & 63, wave = tid >> 6;
    const int wr = wave >> 1, wc = wave & 1;
    const int lr = tid >> 3, lc = (tid & 7) * 8;
    const int fl = lane & 15, fq = lane >> 4;
    const int ntiles = NARROW ? p.MT : p.MT * p.NTl;
    const bool act = !NARROW || (__builtin_amdgcn_readfirstlane(wc) == 0);
    for (int tile = bid - tile0 + ((bid < tile0) ? nblk * ((tile0 - bid + nblk - 1) / nblk) : 0); tile < ntiles; tile += nblk) {
        const int mt = NARROW ? tile : tile / p.NTl, nt = NARROW ? p.NTl : tile % p.NTl;
        const bf16_t* Ag = p.A + (size_t)mt * 128 * p.lda + (size_t)nt * p.a_koff + (size_t)lr * p.lda + lc;
        const bf16_t* Bg = p.Bt + (size_t)nt * 128 * p.ldb + (size_t)mt * p.b_koff + (size_t)lr * p.ldb + lc;
        f32x4 acc[4][4];
#pragma unroll
        for (int m = 0; m < 4; ++m)
#pragma unroll
            for (int n = 0; n < 4; ++n) acc[m][n] = (f32x4){0.f, 0.f, 0.f, 0.f};
        u32x4 ra[4], rb[4];
        const int nk = p.K >> 6;
#pragma unroll
        for (int i = 0; i < 4; ++i) { ra[i] = *(const u32x4*)(Ag + (size_t)(32 * i) * p.lda); rb[i] = *(const u32x4*)(Bg + (size_t)(32 * i) * p.ldb); }
        __syncthreads();
#pragma unroll
        for (int i = 0; i < 4; ++i) { *(u32x4*)(As + (lr + 32 * i) * GS + lc) = ra[i]; *(u32x4*)(Bs + (lr + 32 * i) * GS + lc) = rb[i]; }
        if (nk > 1) {
#pragma unroll
            for (int i = 0; i < 4; ++i) { ra[i] = *(const u32x4*)(Ag + (size_t)(32 * i) * p.lda + 64); rb[i] = *(const u32x4*)(Bg + (size_t)(32 * i) * p.ldb + 64); }
        }
        __syncthreads();
        for (int kt = 0; kt < nk; ++kt) {
            const bf16_t* Ac = As + (kt & 1) * (256 * GS); const bf16_t* Bc = Ac + 128 * GS;
            bf16_t* An = As + ((kt & 1) ^ 1) * (256 * GS); bf16_t* Bn = An + 128 * GS;
            if (kt + 1 < nk) {
#pragma unroll
                for (int i = 0; i < 4; ++i) { *(u32x4*)(An + (lr + 32 * i) * GS + lc) = ra[i]; *(u32x4*)(Bn + (lr + 32 * i) * GS + lc) = rb[i]; }
                if (kt + 2 < nk) {
#pragma unroll
                    for (int i = 0; i < 4; ++i) { ra[i] = *(const u32x4*)(Ag + (size_t)(32 * i) * p.lda + (kt + 2) * 64); rb[i] = *(const u32x4*)(Bg + (size_t)(32 * i) * p.ldb + (kt + 2) * 64); }
                }
            }
#pragma unroll
            for (int ks = 0; ks < 2; ++ks) {
                bf16x8 xa[4], wb[4];
                if (act) {
#pragma unroll
                for (int m = 0; m < 4; ++m) xa[m] = *(const bf16x8*)(Ac + (wr * 64 + m * 16 + fl) * GS + ks * 32 + fq * 8);
#pragma unroll
                for (int n = 0; n < (NARROW ? 1 : 4); ++n) wb[n] = *(const bf16x8*)(Bc + (wc * 64 + n * 16 + fl) * GS + ks * 32 + fq * 8);
#pragma unroll
                for (int m = 0; m < 4; ++m)
#pragma unroll
                    for (int n = 0; n < (NARROW ? 1 : 4); ++n) acc[m][n] = (MODE == 3) ? __builtin_amdgcn_mfma_f32_16x16x32_bf16(xa[m], wb[n], acc[m][n], 0, 0, 0)
                                                                                    : __builtin_amdgcn_mfma_f32_16x16x32_bf16(wb[n], xa[m], acc[m][n], 0, 0, 0);
                }
            }
            __syncthreads();
        }
        if (act)
#pragma unroll
        for (int m = 0; m < 4; ++m) {
#pragma unroll
            for (int n = 0; n < (NARROW ? 1 : 4); ++n) {
                const f32x4 a = acc[m][n];
                if (MODE == 3) {
                    const size_t row = (size_t)mt * 128 + wr * 64 + m * 16 + fq * 4;
                    const size_t col = (size_t)nt * 128 + wc * 64 + n * 16 + fl;
                    *(f32x4*)((float*)p.C + col * p.ldc + row) = a;
                } else {
                    const size_t row = (size_t)mt * 128 + wr * 64 + m * 16 + fl;
                    const int col = nt * 128 + wc * 64 + n * 16 + fq * 4;
                    if (MODE == 0) { u32x2 w; w.x = pk2(a.x, a.y); w.y = pk2(a.z, a.w); *(u32x2*)((bf16_t*)p.C + row * p.ldc + col) = w; }
                    else if (MODE == 1) { *(f32x4*)((float*)p.C + row * p.ldc + col) = a; }
                    else { const f32x4 r = *(const f32x4*)(p.R + row * p.ldc + col); *(f32x4*)((float*)p.C + row * p.ldc + col) = r + a; }
                }
            }
        }
    }
}

__device__ __forceinline__ int lds_byte(int r, int c) {
    const int st = (r >> 4) * 2 + (c >> 5), rr = r & 15, cc = c & 31, ob = rr * 64 + cc * 2;
    return st * 1024 + (ob ^ (((ob >> 9) & 1) << 5));
}
__device__ __forceinline__ void stage_rc(int b, int& R, int& C) {
    const int st = b / 1024, sb = b % 1024, swz = sb ^ (((sb >> 9) & 1) << 5);
    R = (st >> 1) * 16 + swz / 64; C = (st & 1) * 32 + (swz % 64) / 2;
}
#define GL_WAIT_V(n) asm volatile("s_waitcnt vmcnt(" #n ")" ::: "memory")
#define GL_BAR() do { asm volatile("s_waitcnt lgkmcnt(0)" ::: "memory"); __builtin_amdgcn_s_barrier(); } while (0)
template <int MODE>
__device__ void phase_gemm_glds(const GemmP& p, char* smem, int bid, int nblk) {
    const int tid = otid(), lane = tid & 63, wave = tid >> 6;
    const int wr = wave >> 1, wc = wave & 1;
    const int fl = lane & 15, fq = lane >> 4;
    const int ntiles = p.MT * p.NTl, nk = p.K >> 6;
    int sr[4], sc[4];
#pragma unroll
    for (int i = 0; i < 4; ++i) stage_rc(tid * 16 + i * 4096, sr[i], sc[i]);
    for (int tile = bid; tile < ntiles; tile += nblk) {
        const int mt = tile / p.NTl, nt = tile % p.NTl;
        const bf16_t* Ag = p.A + (size_t)mt * 128 * p.lda;
        const bf16_t* Bg = p.Bt + (size_t)nt * 128 * p.ldb;
        f32x4 acc[4][4];
#pragma unroll
        for (int m = 0; m < 4; ++m)
#pragma unroll
            for (int n = 0; n < 4; ++n) acc[m][n] = (f32x4){0.f, 0.f, 0.f, 0.f};
        auto stage = [&](int kt, int buf) {
            char* sa = smem + buf * 32768; char* sb = sa + 16384;
#pragma unroll
            for (int i = 0; i < 4; ++i) {
                __builtin_amdgcn_global_load_lds((const unsigned*)(Ag + (size_t)sr[i] * p.lda + kt * 64 + sc[i]), (__attribute__((address_space(3))) unsigned*)(sa + tid * 16 + i * 4096), 16, 0, 0);
                __builtin_amdgcn_global_load_lds((const unsigned*)(Bg + (size_t)sr[i] * p.ldb + kt * 64 + sc[i]), (__attribute__((address_space(3))) unsigned*)(sb + tid * 16 + i * 4096), 16, 0, 0);
            }
        };
        GL_BAR();
        stage(0, 0);
        for (int kt = 0; kt < nk; ++kt) {
            if (kt + 1 < nk) { stage(kt + 1, (kt + 1) & 1); GL_WAIT_V(8); } else { GL_WAIT_V(0); }
            GL_BAR();
            const char* Ac = smem + (kt & 1) * 32768; const char* Bc = Ac + 16384;
#pragma unroll
            for (int ks = 0; ks < 2; ++ks) {
                bf16x8 xa[4], wb[4];
#pragma unroll
                for (int m = 0; m < 4; ++m) xa[m] = *(const bf16x8*)(Ac + lds_byte(wr * 64 + m * 16 + fl, ks * 32 + fq * 8));
#pragma unroll
                for (int n = 0; n < 4; ++n) wb[n] = *(const bf16x8*)(Bc + lds_byte(wc * 64 + n * 16 + fl, ks * 32 + fq * 8));
#pragma unroll
                for (int m = 0; m < 4; ++m)
#pragma unroll
                    for (int n = 0; n < 4; ++n) acc[m][n] = (MODE == 3) ? __builtin_amdgcn_mfma_f32_16x16x32_bf16(xa[m], wb[n], acc[m][n], 0, 0, 0)
                                                                     : __builtin_amdgcn_mfma_f32_16x16x32_bf16(wb[n], xa[m], acc[m][n], 0, 0, 0);
            }
            GL_BAR();
        }
#pragma unroll
        for (int m = 0; m < 4; ++m) {
#pragma unroll
            for (int n = 0; n < 4; ++n) {
                const f32x4 a = acc[m][n];
                if (MODE == 3) {
                    const size_t row = (size_t)mt * 128 + wr * 64 + m * 16 + fq * 4;
                    const size_t col = (size_t)nt * 128 + wc * 64 + n * 16 + fl;
                    *(f32x4*)((float*)p.C + col * p.ldc + row) = a;
                } else {
                    const size_t row = (size_t)mt * 128 + wr * 64 + m * 16 + fl;
                    const int col = nt * 128 + wc * 64 + n * 16 + fq * 4;
                    if (MODE == 0) { u32x2 w; w.x = pk2(a.x, a.y); w.y = pk2(a.z, a.w); *(u32x2*)((bf16_t*)p.C + row * p.ldc + col) = w; }
                    else if (MODE == 1) { *(f32x4*)((float*)p.C + row * p.ldc + col) = a; }
                    else { const f32x4 r = *(const f32x4*)(p.R + row * p.ldc + col); *(f32x4*)((float*)p.C + row * p.ldc + col) = r + a; }
                }
            }
        }
    }
    __syncthreads();
}

template <int MODE>
__device__ void phase_gemm8(const GemmP& p, char* smem, int bid, int nblk, int tile0 = 0) {
    const int tid = otid(), lane = tid & 63, wave = tid >> 6;
    const int wr = wave >> 2, wc = wave & 3;
    const int fl = lane & 15, fq = lane >> 4;
    const int ntiles = p.MT * p.NTl, nk = p.K >> 6;
    int sr[2], sc[2];
#pragma unroll
    for (int i = 0; i < 2; ++i) stage_rc(tid * 16 + i * 8192, sr[i], sc[i]);
    for (int tile = bid - tile0 + ((bid < tile0) ? nblk * ((tile0 - bid + nblk - 1) / nblk) : 0); tile < ntiles; tile += nblk) {
        const int mt = tile / p.NTl, nt = tile % p.NTl;
        const bf16_t* Ag = p.A + (size_t)mt * 128 * p.lda;
        const bf16_t* Bg = p.Bt + (size_t)nt * 256 * p.ldb;
        f32x4 acc[4][4];
#pragma unroll
        for (int m = 0; m < 4; ++m)
#pragma unroll
            for (int n = 0; n < 4; ++n) acc[m][n] = (f32x4){0.f, 0.f, 0.f, 0.f};
        auto stage = [&](int kt, int buf) {
            char* sa = smem + buf * 49152;
#pragma unroll
            for (int i = 0; i < 2; ++i) {
                __builtin_amdgcn_global_load_lds((const unsigned*)(Ag + (size_t)sr[i] * p.lda + kt * 64 + sc[i]), (__attribute__((address_space(3))) unsigned*)(sa + tid * 16 + i * 8192), 16, 0, 0);
                __builtin_amdgcn_global_load_lds((const unsigned*)(Bg + (size_t)sr[i] * p.ldb + kt * 64 + sc[i]), (__attribute__((address_space(3))) unsigned*)(sa + 16384 + tid * 16 + i * 8192), 16, 0, 0);
                __builtin_amdgcn_global_load_lds((const unsigned*)(Bg + (size_t)(128 + sr[i]) * p.ldb + kt * 64 + sc[i]), (__attribute__((address_space(3))) unsigned*)(sa + 32768 + tid * 16 + i * 8192), 16, 0, 0);
            }
        };
        GL_BAR();
        stage(0, 0);
        for (int kt = 0; kt < nk; ++kt) {
            if (kt + 1 < nk) { stage(kt + 1, (kt + 1) & 1); GL_WAIT_V(6); } else { GL_WAIT_V(0); }
            GL_BAR();
            const char* Ac = smem + (kt & 1) * 49152; const char* Bc = Ac + 16384 + (wc >> 1) * 16384;
#pragma unroll
            for (int ks = 0; ks < 2; ++ks) {
                bf16x8 xa[4], wb[4];
#pragma unroll
                for (int m = 0; m < 4; ++m) xa[m] = *(const bf16x8*)(Ac + lds_byte(wr * 64 + m * 16 + fl, ks * 32 + fq * 8));
#pragma unroll
                for (int n = 0; n < 4; ++n) wb[n] = *(const bf16x8*)(Bc + lds_byte((wc & 1) * 64 + n * 16 + fl, ks * 32 + fq * 8));
#pragma unroll
                for (int m = 0; m < 4; ++m)
#pragma unroll
                    for (int n = 0; n < 4; ++n) acc[m][n] = __builtin_amdgcn_mfma_f32_16x16x32_bf16(wb[n], xa[m], acc[m][n], 0, 0, 0);
            }
            GL_BAR();
        }
#pragma unroll
        for (int m = 0; m < 4; ++m) {
#pragma unroll
            for (int n = 0; n < 4; ++n) {
                const f32x4 a = acc[m][n];
                const size_t row = (size_t)mt * 128 + wr * 64 + m * 16 + fl;
                const int col = nt * 256 + wc * 64 + n * 16 + fq * 4;
                if (MODE == 0) { u32x2 w; w.x = pk2(a.x, a.y); w.y = pk2(a.z, a.w); *(u32x2*)((bf16_t*)p.C + row * p.ldc + col) = w; }
                else if (MODE == 1) { *(f32x4*)((float*)p.C + row * p.ldc + col) = a; }
                else { const f32x4 r = *(const f32x4*)(p.R + row * p.ldc + col); *(f32x4*)((float*)p.C + row * p.ldc + col) = r + a; }
            }
        }
    }
    __syncthreads();
}

namespace pg8 {
#define PG8_LAS __attribute__((address_space(3)))
constexpr int BM = 256, BK = 64, HALF = 128, HTB = HALF * BK * 2  , STAGE_BYTES = 8 * HTB, NXCD = 8, WGM = 8;
__device__ __forceinline__ int perm32(int rho) { const int n = rho >> 4, i = rho & 15; return 8 * (i >> 2) + 4 * n + (i & 3); }
struct Unit { int pm, pn; };
struct Gemm { const bf16_t* A; const bf16_t* Bt; int M, N, K; };
struct StaticOrder {
    int nM, nN, nwg, G, c;
    __device__ void init(int M, int N, int G_, int c_) { nM = M / BM; nN = N / BM; nwg = nM * nN; G = G_; c = c_; }
    __device__ bool next(int i, Unit& u) const {
        if (c < 0) return false;
        const long L = (long)i * G + c; if (L >= nwg) return false;
        int wgid = (int)L; { const int q = nwg / NXCD, r = nwg % NXCD, xcd = wgid % NXCD, off = wgid / NXCD; wgid = (xcd < r ? xcd * (q + 1) : r * (q + 1) + (xcd - r) * q) + off; }
        const int nig = WGM * nN, gid = wgid / nig, fm = gid * WGM, gsz = (nM - fm) < WGM ? (nM - fm) : WGM;
        u.pm = fm + ((wgid % nig) % gsz); u.pn = (wgid % nig) / gsz; return true;
    }
    __device__ __forceinline__ void a_ready(const Unit&) const {}
    __device__ __forceinline__ void done(const Unit&) const {}
};
template <int MODE  > struct Epi {
    static constexpr bool PERM = false, AFTER_DRAIN = false;
    void* C; int ldc; const float* R;
    __device__ __forceinline__ void operator()(const f32x4 (&acc)[2][2][4][2], const Unit& u, int wr, int wc, int fr, int fq) const {
#pragma unroll
        for (int ai = 0; ai < 2; ++ai)
#pragma unroll
            for (int m = 0; m < 4; ++m) {
                const size_t row = (size_t)u.pm * BM + ai * HALF + wr * 64 + m * 16 + fr;
#pragma unroll
                for (int bj = 0; bj < 2; ++bj)
#pragma unroll
                    for (int n = 0; n < 2; ++n) {
                        const int col = u.pn * BM + bj * HALF + wc * 32 + n * 16 + fq * 4;
                        const f32x4 a = acc[ai][bj][m][n];
                        if (MODE == 0) { u32x2 w; w.x = pk2(a.x, a.y); w.y = pk2(a.z, a.w); *(u32x2*)((bf16_t*)C + row * ldc + col) = w; }
                        else if (MODE == 1) { *(f32x4*)((float*)C + row * ldc + col) = a; }
                        else { const f32x4 r = *(const f32x4*)(R + row * ldc + col); *(f32x4*)((float*)C + row * ldc + col) = r + a; }
                    }
            }
    }
};
template <class Epi, class Sched, bool ALIGN_EPI = false, bool SP2 = false>
__device__ __forceinline__ void gemm_phase(PG8_LAS unsigned char* lds, const Gemm g, const Sched& S, const Epi& E) {
    const int tid = otid(), wid = __builtin_amdgcn_readfirstlane(tid >> 6), lane = tid & 63, wr = wid >> 2, wc = wid & 3, fr = lane & 15, fq = lane >> 4;
    const int K = g.K, nt = K / BK;
    unsigned voffA[2], voffB[2];
#pragma unroll
    for (int i = 0; i < 2; ++i) { int R, C; stage_rc(tid * 16 + i * 8192, R, C); const int Rb = Epi::PERM ? ((R & ~31) + perm32(R & 31)) : R;
        voffA[i] = (unsigned)(R * K + C) * 2u; voffB[i] = (unsigned)(Rb * K + C) * 2u; }
    const size_t kstep = (size_t)(BK * 2);
    const size_t hstep = (size_t)HALF * K * 2;
    const size_t tstep = 2 * hstep;
    const unsigned ldsw = (unsigned)wid * 1024u;
    const int aoff = lds_byte(wr * 64 + fr, fq * 8), boff = lds_byte(wc * 32 + fr, fq * 8);
#define PG8_SA(b, h) (((b) * 2 + (h)) * HTB)
#define PG8_SB(b, h) ((4 + (b) * 2 + (h)) * HTB)
#define PG8_STAGE(bufoff, gbase, voff) do { _Pragma("unroll") for (int _i = 0; _i < 2; ++_i) \
        __builtin_amdgcn_global_load_lds((const unsigned*)((const char*)(gbase) + (voff)[_i]), (PG8_LAS unsigned*)(lds + (bufoff) + ldsw + _i * 8192), 16, 0, 0); } while (0)
#define PG8_LDA(dst, b, h) do { _Pragma("unroll") for (int m = 0; m < 4; ++m) _Pragma("unroll") for (int k = 0; k < 2; ++k) dst[m][k] = *(const PG8_LAS bf16x8*)(lds + PG8_SA(b, h) + aoff + m * 2048 + k * 1024); } while (0)
#define PG8_LDB(dst, b, h) do { _Pragma("unroll") for (int n = 0; n < 2; ++n) _Pragma("unroll") for (int k = 0; k < 2; ++k) dst[n][k] = *(const PG8_LAS bf16x8*)(lds + PG8_SB(b, h) + boff + n * 2048 + k * 1024); } while (0)
#define PG8_MMA(ai, bj, At, Bt) do { __builtin_amdgcn_s_setprio(1); _Pragma("unroll") for (int m = 0; m < 4; ++m) _Pragma("unroll") for (int n = 0; n < 2; ++n) _Pragma("unroll") for (int k = 0; k < 2; ++k) \
        acc[ai][bj][m][n] = __builtin_amdgcn_mfma_f32_16x16x32_bf16(Bt[n][k], At[m][k], acc[ai][bj][m][n], 0, 0, 0); __builtin_amdgcn_s_setprio(0); } while (0)
#define PG8_WAIT_V(n) asm volatile("s_waitcnt vmcnt(" #n ")" ::: "memory")
#define PG8_WAIT_L(n) asm volatile("s_waitcnt lgkmcnt(" #n ")" ::: "memory")
#define PG8_BAR __builtin_amdgcn_s_barrier()
#define PG8_SCHED __builtin_amdgcn_sched_barrier(0)
    Unit cur, nxt; int ui = 0;
    if (!S.next(0, cur)) return;
    f32x4 acc[2][2][4][2];
#pragma unroll
    for (int a = 0; a < 2; ++a)
#pragma unroll
        for (int b = 0; b < 2; ++b)
#pragma unroll
            for (int m = 0; m < 4; ++m)
#pragma unroll
                for (int n = 0; n < 2; ++n) acc[a][b][m][n] = (f32x4){0.f, 0.f, 0.f, 0.f};
    bf16x8 At[4][2], B0[2][2], B1[2][2];
    const char* cA = (const char*)g.A + (size_t)cur.pm * tstep; const char* cB = (const char*)g.Bt + (size_t)cur.pn * tstep;
    S.a_ready(cur);
    if constexpr (SP2) {
        PG8_STAGE(PG8_SB(0, 0), cB, voffB); PG8_STAGE(PG8_SB(0, 1), cB + hstep, voffB); PG8_STAGE(PG8_SA(0, 0), cA, voffA); PG8_STAGE(PG8_SA(0, 1), cA + hstep, voffA);
        if (wr == 1) PG8_BAR;
        PG8_WAIT_V(2); PG8_BAR;
        PG8_STAGE(PG8_SB(1, 0), cB + kstep, voffB); PG8_STAGE(PG8_SA(1, 0), cA + kstep, voffA); PG8_STAGE(PG8_SB(1, 1), cB + hstep + kstep, voffB);
        PG8_WAIT_V(6); PG8_BAR;
    } else {
        PG8_STAGE(PG8_SB(0, 0), cB, voffB); PG8_STAGE(PG8_SA(0, 0), cA, voffA); PG8_STAGE(PG8_SB(0, 1), cB + hstep, voffB); PG8_STAGE(PG8_SA(0, 1), cA + hstep, voffA);
        if (wr == 1) PG8_BAR;
        PG8_WAIT_V(4); PG8_BAR;
        PG8_STAGE(PG8_SB(1, 0), cB + kstep, voffB); PG8_STAGE(PG8_SA(1, 0), cA + kstep, voffA); PG8_STAGE(PG8_SB(1, 1), cB + hstep + kstep, voffB);
        PG8_WAIT_V(6); PG8_BAR;
    }
    for (;;) {
        const bool has_next = S.next(ui + 1, nxt);
        const char* nA = has_next ? (const char*)g.A + (size_t)nxt.pm * tstep : cA; const char* nB = has_next ? (const char*)g.Bt + (size_t)nxt.pn * tstep : cB;
        for (int t = 0; t < nt; t += 2) {
            const bool last = (t == nt - 2);
            const char* a1 = cA + (size_t)(t + 1) * kstep;
            const char* a2 = last ? nA : cA + (size_t)(t + 2) * kstep; const char* b2 = last ? nB : cB + (size_t)(t + 2) * kstep;
            const char* a3 = a2 + kstep; const char* b3 = b2 + kstep;
            if (last && has_next) S.a_ready(nxt);
            if constexpr (SP2) {
            PG8_LDB(B0, 0, 0); PG8_LDB(B1, 0, 1); PG8_SCHED; PG8_LDA(At, 0, 0); PG8_STAGE(PG8_SA(1, 1), a1 + hstep, voffA);
            PG8_WAIT_V(8); PG8_WAIT_L(0); PG8_BAR; PG8_MMA(0, 0, At, B0); PG8_MMA(0, 1, At, B1); PG8_BAR; PG8_SCHED;
            PG8_LDA(At, 0, 1); PG8_STAGE(PG8_SB(0, 0), b2, voffB); PG8_STAGE(PG8_SB(0, 1), b2 + hstep, voffB); PG8_STAGE(PG8_SA(0, 0), a2, voffA);
            PG8_WAIT_V(8); PG8_WAIT_L(0); PG8_BAR; PG8_MMA(1, 0, At, B0); PG8_MMA(1, 1, At, B1); PG8_BAR; PG8_SCHED;
            PG8_LDB(B0, 1, 0); PG8_LDB(B1, 1, 1); PG8_SCHED; PG8_LDA(At, 1, 0); PG8_STAGE(PG8_SA(0, 1), a2 + hstep, voffA);
            PG8_WAIT_V(8); PG8_WAIT_L(0); PG8_BAR; PG8_MMA(0, 0, At, B0); PG8_MMA(0, 1, At, B1); PG8_BAR; PG8_SCHED;
            PG8_LDA(At, 1, 1); PG8_STAGE(PG8_SB(1, 0), b3, voffB); PG8_STAGE(PG8_SB(1, 1), b3 + hstep, voffB); PG8_STAGE(PG8_SA(1, 0), a3, voffA);
            PG8_WAIT_V(8); PG8_WAIT_L(0); PG8_BAR; PG8_MMA(1, 0, At, B0); PG8_MMA(1, 1, At, B1); PG8_BAR; PG8_SCHED;
            } else {
            PG8_LDB(B0, 0, 0); PG8_SCHED; PG8_LDA(At, 0, 0); PG8_STAGE(PG8_SA(1, 1), a1 + hstep, voffA);
            PG8_WAIT_L(8); PG8_BAR; PG8_WAIT_L(0); PG8_MMA(0, 0, At, B0); PG8_BAR; PG8_SCHED;
            PG8_LDB(B1, 0, 1); PG8_STAGE(PG8_SB(0, 0), b2, voffB);
            PG8_BAR; PG8_WAIT_L(0); PG8_MMA(0, 1, At, B1); PG8_BAR;
            PG8_LDA(At, 0, 1); PG8_STAGE(PG8_SA(0, 0), a2, voffA);
            PG8_BAR; PG8_WAIT_L(0); PG8_MMA(1, 0, At, B0); PG8_BAR; PG8_SCHED;
            PG8_STAGE(PG8_SB(0, 1), b2 + hstep, voffB);
            PG8_WAIT_V(6); PG8_BAR; PG8_MMA(1, 1, At, B1); PG8_BAR;
            PG8_LDB(B0, 1, 0); PG8_SCHED; PG8_LDA(At, 1, 0); PG8_STAGE(PG8_SA(0, 1), a2 + hstep, voffA);
            PG8_WAIT_L(8); PG8_BAR; PG8_WAIT_L(0); PG8_MMA(0, 0, At, B0); PG8_BAR; PG8_SCHED;
            PG8_LDB(B1, 1, 1); PG8_STAGE(PG8_SB(1, 0), b3, voffB);
            PG8_BAR; PG8_WAIT_L(0); PG8_MMA(0, 1, At, B1); PG8_BAR;
            PG8_LDA(At, 1, 1); PG8_STAGE(PG8_SA(1, 0), a3, voffA);
            PG8_BAR; PG8_WAIT_L(0); PG8_MMA(1, 0, At, B0); PG8_BAR; PG8_SCHED;
            PG8_STAGE(PG8_SB(1, 1), b3 + hstep, voffB);
            PG8_WAIT_V(6); PG8_BAR; PG8_MMA(1, 1, At, B1); PG8_BAR;
            }
        }
        if constexpr (ALIGN_EPI) { if (wr == 0) PG8_BAR; }
        if constexpr (!Epi::AFTER_DRAIN) { E(acc, cur, wr, wc, fr, fq); S.done(cur); }
        if (!has_next) break;
#pragma unroll
        for (int a = 0; a < 2; ++a)
#pragma unroll
            for (int b = 0; b < 2; ++b)
#pragma unroll
                for (int m = 0; m < 4; ++m)
#pragma unroll
                    for (int n = 0; n < 2; ++n) acc[a][b][m][n] = (f32x4){0.f, 0.f, 0.f, 0.f};
        cur = nxt; cA = nA; cB = nB; ++ui;
        if constexpr (ALIGN_EPI) { if (wr == 1) PG8_BAR; }
    }
    PG8_WAIT_V(0);
    if constexpr (!ALIGN_EPI) { if (wr == 0) PG8_BAR; }
    PG8_BAR;
    if constexpr (Epi::AFTER_DRAIN) { E.fused(acc, cur, wr, wc, fr, fq, lds, wid, lane); S.done(cur); }
#undef PG8_SA
#undef PG8_SB
#undef PG8_STAGE
#undef PG8_LDA
#undef PG8_LDB
#undef PG8_MMA
#undef PG8_WAIT_V
#undef PG8_WAIT_L
#undef PG8_BAR
#undef PG8_SCHED
}
}

constexpr int LS = 72;
struct LinP {
    const bf16_t* Z; bf16_t* O;
    const float* gk_up;
    const float* gk_bias;
    const float* norm_w;
    const float* rope;
    unsigned char* lin;
};
__device__ __forceinline__ bf16x8 ldfrag(const bf16_t* base, int row, int kofs) { return *(const bf16x8*)(base + row * LS + kofs); }

constexpr size_t LN_KV_RET = 0;
constexpr size_t LN_KV_GLA = LN_KV_RET + 1024ull * 64 * 64 * 4;
constexpr size_t LN_S_RET  = LN_KV_GLA + 1024ull * 96 * 64 * 4;
constexpr size_t LN_S_GLA  = LN_S_RET + 1024ull * 64 * 64 * 2;
constexpr size_t LN_DEC    = LN_S_GLA + 1024ull * 96 * 64 * 2;
static_assert(LN_DEC + 2048ull * 64 * 4 <= 64 * MiB, "lin region");

__device__ __forceinline__ float wave_incl_scan(float v) {
    v += dpp_f<0x111>(v); v += dpp_f<0x112>(v); v += dpp_f<0x114>(v); v += dpp_f<0x118>(v);
    v += __int_as_float(__builtin_amdgcn_update_dpp(0, __float_as_int(v), 0x142, 0xA, 0xF, false));
    v += __int_as_float(__builtin_amdgcn_update_dpp(0, __float_as_int(v), 0x143, 0xC, 0xF, false));
    return v;
}
__device__ __forceinline__ float readlane_f(float v, int l) { return __int_as_float(__builtin_amdgcn_readlane(__float_as_int(v), l)); }

__device__ __forceinline__ void rot8(const bf16_t* src, const float* rope, int spos, int cq, unsigned (&o1)[4], unsigned (&o2)[4]) {
    const u32x4 q1 = *(const u32x4*)(src + cq * 8), q2 = *(const u32x4*)(src + 32 + cq * 8);
    const unsigned q1w[4] = {q1.x, q1.y, q1.z, q1.w}, q2w[4] = {q2.x, q2.y, q2.z, q2.w};
    const f32x4 c0 = *(const f32x4*)(rope + spos * 32 + cq * 8), c1 = *(const f32x4*)(rope + spos * 32 + cq * 8 + 4);
    const f32x4 s0 = *(const f32x4*)(rope + NS * 32 + spos * 32 + cq * 8), s1 = *(const f32x4*)(rope + NS * 32 + spos * 32 + cq * 8 + 4);
    const float csv[8] = {c0.x, c0.y, c0.z, c0.w, c1.x, c1.y, c1.z, c1.w}, snv[8] = {s0.x, s0.y, s0.z, s0.w, s1.x, s1.y, s1.z, s1.w};
#pragma unroll
    for (int e = 0; e < 4; ++e) {
        const float a1l = lo_bf(q1w[e]), a1h = hi_bf(q1w[e]), a2l = lo_bf(q2w[e]), a2h = hi_bf(q2w[e]);
        o1[e] = pk2(a1l * csv[2 * e] - a2l * snv[2 * e], a1h * csv[2 * e + 1] - a2h * snv[2 * e + 1]);
        o2[e] = pk2(a1l * snv[2 * e] + a2l * csv[2 * e], a1h * snv[2 * e + 1] + a2h * csv[2 * e + 1]);
    }
}
__device__ __forceinline__ void load_vts(const bf16_t* Z, size_t t0, int voff, int nch, bf16_t* Vts, int tid) {
    for (int x = tid; x < 64 * nch; x += 256) {
        const int tok = x / nch, ch = x % nch;
        const u32x4 vv = *(const u32x4*)(Z + (t0 + tok) * DINP + voff + ch * 8);
        const unsigned w[4] = {vv.x, vv.y, vv.z, vv.w};
#pragma unroll
        for (int e = 0; e < 4; ++e) { Vts[(ch * 8 + 2 * e) * LS + tok] = (bf16_t)(w[e] & 0xFFFFu); Vts[(ch * 8 + 2 * e + 1) * LS + tok] = (bf16_t)(w[e] >> 16); }
    }
}
__device__ __forceinline__ void load_gd(const bf16_t* zr, float (&gd)[16]) {
    const u32x4 g0 = *(const u32x4*)zr, g1 = *(const u32x4*)(zr + 8);
    gd[0] = lo_bf(g0.x); gd[1] = hi_bf(g0.x); gd[2] = lo_bf(g0.y); gd[3] = hi_bf(g0.y); gd[4] = lo_bf(g0.z); gd[5] = hi_bf(g0.z); gd[6] = lo_bf(g0.w); gd[7] = hi_bf(g0.w);
    gd[8] = lo_bf(g1.x); gd[9] = hi_bf(g1.x); gd[10] = lo_bf(g1.y); gd[11] = hi_bf(g1.y); gd[12] = lo_bf(g1.z); gd[13] = hi_bf(g1.z); gd[14] = lo_bf(g1.w); gd[15] = hi_bf(g1.w);
}
__device__ __forceinline__ float gla_gk(const LinP& p, const float (&gd)[16], int h, int d) {
    float x = p.gk_bias[h * 48 + d];
#pragma unroll
    for (int i = 0; i < 16; ++i) x += gd[i] * p.gk_up[i * 192 + h * 48 + d];
    return (fminf(x, 0.f) - __logf(1.f + __expf(-fabsf(x)))) * (1.f / 16.f);
}
__device__ __forceinline__ float ret_lg(int h) { const float e = exp2f(-5.f - (float)h * (4.f / 3.f)); return log1pf(-e); }

constexpr int LIN_HALF_LDS = 57344;
template <bool IS_GLA>
__device__ void lin_kv_task(const LinP& p, char* smem, int b, int h, int c) {
    constexpr int DV = IS_GLA ? 96 : 64, NVB = DV / 16;
    { const int half = otid() >> 8; c += half; smem += half * LIN_HALF_LDS; }
    const int koff = IS_GLA ? (ZC_GLA + 192 + h * 48) : (ZC_RET + 256 + h * 64);
    const int voff = IS_GLA ? (ZC_GLA + 384 + h * 96) : (ZC_RET + 512 + h * 64);
    const int gkdoff = ZC_GLA + 768;
    bf16_t* Ks = (bf16_t*)smem;
    bf16_t* Kts = Ks + 64 * LS;
    bf16_t* Vts = Kts + 64 * LS;
    float* decs = (float*)(Vts + 96 * LS);
    const int tid = otid() & 255, lane = tid & 63, wave = tid >> 6;
    const int fl = lane & 15, fq = lane >> 4;
    const size_t t0 = (size_t)b * NS + (size_t)c * 64;
    const int task = (b * 4 + h) * 64 + c;
    __syncthreads();
    if (IS_GLA) {
        for (int x = tid; x < 64 * 6; x += 256) {
            const int tok = x / 6, ch = x % 6;
            *(u32x4*)(Ks + tok * LS + ch * 8) = *(const u32x4*)(p.Z + (t0 + tok) * DINP + koff + ch * 8);
        }
        for (int x = tid; x < 16 * LS / 2; x += 256) ((unsigned*)(Kts + 48 * LS))[x] = 0u;
        if (tid < 16) decs[48 + tid] = 1.f;
        load_vts(p.Z, t0, voff, 12, Vts, tid);
    } else {
        const int tok = tid >> 2, cq = tid & 3;
        unsigned k1[4], k2[4];
        rot8(p.Z + (t0 + tok) * DINP + koff, p.rope, c * 64 + tok, cq, k1, k2);
        const float fk2 = 0.125f * __expf(ret_lg(h) * (float)(63 - tok));
#pragma unroll
        for (int e = 0; e < 4; ++e) {
            Kts[(cq * 8 + 2 * e) * LS + tok] = f2bf(lo_bf(k1[e]) * fk2); Kts[(cq * 8 + 2 * e + 1) * LS + tok] = f2bf(hi_bf(k1[e]) * fk2);
            Kts[(32 + cq * 8 + 2 * e) * LS + tok] = f2bf(lo_bf(k2[e]) * fk2); Kts[(32 + cq * 8 + 2 * e + 1) * LS + tok] = f2bf(hi_bf(k2[e]) * fk2);
        }
        if (tid < 64) decs[tid] = __expf(ret_lg(h) * 64.f);
        load_vts(p.Z, t0, voff, 8, Vts, tid);
    }
    __syncthreads();
    if (IS_GLA) {
        float gd[16];
        load_gd(p.Z + (t0 + lane) * DINP + gkdoff, gd);
#pragma unroll 1
        for (int dd = 0; dd < 12; ++dd) {
            const int d = wave * 12 + dd;
            const float bc = wave_incl_scan(gla_gk(p, gd, h, d));
            const float bl = readlane_f(bc, 63);
            Kts[d * LS + lane] = f2bf(bf2f(Ks[lane * LS + d]) * __expf(bl - bc));
            if (lane == 0) decs[d] = __expf(bl);
        }
        __syncthreads();
    }
    float* KV = (float*)(p.lin + (IS_GLA ? LN_KV_GLA : LN_KV_RET)) + (size_t)task * DV * 64;
#pragma unroll
    for (int vb = 0; vb < NVB; ++vb) {
        f32x4 a4 = (f32x4){0.f, 0.f, 0.f, 0.f};
#pragma unroll
        for (int ks = 0; ks < 2; ++ks) {
            const bf16x8 a = ldfrag(Kts, 16 * wave + fl, ks * 32 + fq * 8);
            const bf16x8 bv = ldfrag(Vts, 16 * vb + fl, ks * 32 + fq * 8);
            a4 = __builtin_amdgcn_mfma_f32_16x16x32_bf16(a, bv, a4, 0, 0, 0);
        }
        *(f32x4*)(KV + (size_t)(16 * vb + fl) * 64 + 16 * wave + 4 * fq) = a4;
    }
    if (tid < 64) ((float*)(p.lin + LN_DEC))[(size_t)((IS_GLA ? 1024 : 0) + task) * 64 + tid] = decs[tid];
}

__device__ void lin_scan_phase(const LinP& p, int vbid, int nvblk, unsigned* flags) {
    const int tid = otid() & 255, half = otid() >> 8;
    for (int it2 = vbid; it2 < 80; it2 += nvblk) {
        const int it = 2 * it2 + half;
        const bool gla = it >= 64;
        const int r = gla ? it - 64 : it;
        const int per = gla ? 6 : 4, DVx = gla ? 96 : 64;
        const int bh = r / per, e = (r % per) * 1024 + tid;
        const float* KV = (const float*)(p.lin + (gla ? LN_KV_GLA : LN_KV_RET)) + (size_t)bh * 64 * DVx * 64 + e;
        bf16_t* Sb = (bf16_t*)(p.lin + (gla ? LN_S_GLA : LN_S_RET)) + (size_t)bh * 64 * DVx * 64 + e;
        const float* DEC = (const float*)(p.lin + LN_DEC) + (size_t)((gla ? 1024 : 0) + bh * 64) * 64 + (e & 63);
        float S0 = 0.f, S1 = 0.f, S2 = 0.f, S3 = 0.f;
#pragma unroll 8
        for (int c = 0; c < 64; ++c) {
            const size_t o = (size_t)c * DVx * 64;
            const float k0 = KV[o], k1 = KV[o + 256], k2 = KV[o + 512], k3 = KV[o + 768], dc = DEC[c * 64];
            Sb[o] = f2bf(S0); Sb[o + 256] = f2bf(S1); Sb[o + 512] = f2bf(S2); Sb[o + 768] = f2bf(S3);
            S0 = S0 * dc + k0; S1 = S1 * dc + k1; S2 = S2 * dc + k2; S3 = S3 * dc + k3;
        }
        flag_signal(flags + (gla ? 16 : 0) + bh, 2u);
    }
}

template <bool IS_GLA>
__device__ void lin_out_task(const LinP& p, char* smem, int b, int h, int c) {
    constexpr int DV = IS_GLA ? 96 : 64, NVB = DV / 16;
    { const int half = otid() >> 8; c += half; smem += half * LIN_HALF_LDS; }
    const int qoff = IS_GLA ? (ZC_GLA + 0 + h * 48) : (ZC_RET + 0 + h * 64);
    const int koff = IS_GLA ? (ZC_GLA + 192 + h * 48) : (ZC_RET + 256 + h * 64);
    const int voff = IS_GLA ? (ZC_GLA + 384 + h * 96) : (ZC_RET + 512 + h * 64);
    const int goff = IS_GLA ? (ZC_GLA + 784 + h * 96) : (ZC_RET + 768 + h * 64);
    const int gkdoff = ZC_GLA + 768;
    const int ooff = IS_GLA ? (640 + h * 96) : (h * 64);
    bf16_t* Qs = (bf16_t*)smem;
    bf16_t* Ks = Qs + 64 * LS;
    bf16_t* Ps = Ks + 64 * LS;
    bf16_t* Vts = Ps + 64 * LS;
    bf16_t* Sts = Vts + 96 * LS;
    const int tid = otid() & 255, lane = tid & 63, wave = tid >> 6;
    const int fl = lane & 15, fq = lane >> 4;
    const size_t t0 = (size_t)b * NS + (size_t)c * 64;
    const int task = (b * 4 + h) * 64 + c;
    __syncthreads();
    {
        const bf16_t* Sb = (const bf16_t*)(p.lin + (IS_GLA ? LN_S_GLA : LN_S_RET)) + (size_t)task * DV * 64;
        for (int x = tid; x < DV * 8; x += 256) { const int v = x >> 3, ch = x & 7; *(u32x4*)(Sts + v * LS + ch * 8) = *(const u32x4*)(Sb + v * 64 + ch * 8); }
    }
    if (IS_GLA) {
        for (int x = tid; x < 64 * 6; x += 256) {
            const int tok = x / 6, ch = x % 6;
            const bf16_t* zr = p.Z + (t0 + tok) * DINP;
            *(u32x4*)(Qs + tok * LS + ch * 8) = *(const u32x4*)(zr + qoff + ch * 8);
            *(u32x4*)(Ks + tok * LS + ch * 8) = *(const u32x4*)(zr + koff + ch * 8);
        }
        for (int x = tid; x < 64 * 2; x += 256) {
            const int tok = x >> 1, ch = 6 + (x & 1);
            *(u32x4*)(Qs + tok * LS + ch * 8) = (u32x4){0u, 0u, 0u, 0u};
            *(u32x4*)(Ks + tok * LS + ch * 8) = (u32x4){0u, 0u, 0u, 0u};
        }
        load_vts(p.Z, t0, voff, 12, Vts, tid);
    } else {
        const int tok = tid >> 2, cq = tid & 3;
        const bf16_t* zr = p.Z + (t0 + tok) * DINP;
        unsigned q1[4], q2[4], k1[4], k2[4];
        rot8(zr + qoff, p.rope, c * 64 + tok, cq, q1, q2);
        rot8(zr + koff, p.rope, c * 64 + tok, cq, k1, k2);
        const float lg = ret_lg(h);
        const float fqd = __expf(lg * (float)(tok + 1)), fk = 0.125f * __expf(-lg * (float)(tok + 1));
#pragma unroll
        for (int e = 0; e < 4; ++e) {
            q1[e] = pk2(lo_bf(q1[e]) * fqd, hi_bf(q1[e]) * fqd); q2[e] = pk2(lo_bf(q2[e]) * fqd, hi_bf(q2[e]) * fqd);
            k1[e] = pk2(lo_bf(k1[e]) * fk, hi_bf(k1[e]) * fk); k2[e] = pk2(lo_bf(k2[e]) * fk, hi_bf(k2[e]) * fk);
        }
        *(u32x4*)(Qs + tok * LS + cq * 8) = (u32x4){q1[0], q1[1], q1[2], q1[3]};
        *(u32x4*)(Qs + tok * LS + 32 + cq * 8) = (u32x4){q2[0], q2[1], q2[2], q2[3]};
        *(u32x4*)(Ks + tok * LS + cq * 8) = (u32x4){k1[0], k1[1], k1[2], k1[3]};
        *(u32x4*)(Ks + tok * LS + 32 + cq * 8) = (u32x4){k2[0], k2[1], k2[2], k2[3]};
        load_vts(p.Z, t0, voff, 8, Vts, tid);
    }
    __syncthreads();
    if (IS_GLA) {
        float gd[16];
        load_gd(p.Z + (t0 + lane) * DINP + gkdoff, gd);
#pragma unroll 1
        for (int dd = 0; dd < 12; ++dd) {
            const int d = wave * 12 + dd;
            const float bc = wave_incl_scan(gla_gk(p, gd, h, d));
            const float eq = __expf(bc) * 0.14433756729740643f  , ek = __expf(-bc);
            Qs[lane * LS + d] = f2bf(bf2f(Qs[lane * LS + d]) * eq);
            Ks[lane * LS + d] = f2bf(bf2f(Ks[lane * LS + d]) * ek);
        }
        __syncthreads();
    }
#pragma unroll
    for (int jb = 0; jb < 4; ++jb) {
        f32x4 ap = (f32x4){0.f, 0.f, 0.f, 0.f};
#pragma unroll
        for (int ks = 0; ks < 2; ++ks) {
            const bf16x8 a = ldfrag(Ks, 16 * jb + fl, ks * 32 + fq * 8);
            const bf16x8 bq = ldfrag(Qs, 16 * wave + fl, ks * 32 + fq * 8);
            ap = __builtin_amdgcn_mfma_f32_16x16x32_bf16(a, bq, ap, 0, 0, 0);
        }
        const int i = 16 * wave + fl, j0 = 16 * jb + 4 * fq;
        u32x2 w;
        w.x = pk2(j0 + 0 <= i ? ap.x : 0.f, j0 + 1 <= i ? ap.y : 0.f);
        w.y = pk2(j0 + 2 <= i ? ap.z : 0.f, j0 + 3 <= i ? ap.w : 0.f);
        *(u32x2*)(Ps + i * LS + j0) = w;
    }
    __syncthreads();
    {
        f32x4 ao[NVB];
        float ss = 0.f;
#pragma unroll
        for (int vb = 0; vb < NVB; ++vb) {
            f32x4 a4 = (f32x4){0.f, 0.f, 0.f, 0.f};
#pragma unroll
            for (int ks = 0; ks < 2; ++ks) {
                const bf16x8 a = ldfrag(Vts, 16 * vb + fl, ks * 32 + fq * 8);
                const bf16x8 bp = ldfrag(Ps, 16 * wave + fl, ks * 32 + fq * 8);
                a4 = __builtin_amdgcn_mfma_f32_16x16x32_bf16(a, bp, a4, 0, 0, 0);
            }
#pragma unroll
            for (int ks = 0; ks < 2; ++ks) {
                const bf16x8 a = ldfrag(Sts, 16 * vb + fl, ks * 32 + fq * 8);
                const bf16x8 bq = ldfrag(Qs, 16 * wave + fl, ks * 32 + fq * 8);
                a4 = __builtin_amdgcn_mfma_f32_16x16x32_bf16(a, bq, a4, 0, 0, 0);
            }
            ao[vb] = a4;
            ss += a4.x * a4.x + a4.y * a4.y + a4.z * a4.z + a4.w * a4.w;
        }
        ss = xor32_sum(xor16_sum(ss));
        const float inv = rsqrtf(ss * (1.f / DV) + 1e-5f);
        const size_t t = t0 + 16 * wave + fl;
#pragma unroll
        for (int vb = 0; vb < NVB; ++vb) {
            const int v0 = 16 * vb + 4 * fq;
            const u32x2 gg = *(const u32x2*)(p.Z + t * DINP + goff + v0);
            float g4[4] = {lo_bf(gg.x), hi_bf(gg.x), lo_bf(gg.y), hi_bf(gg.y)};
            float o4[4] = {ao[vb].x, ao[vb].y, ao[vb].z, ao[vb].w};
#pragma unroll
            for (int e = 0; e < 4; ++e) {
                float y = o4[e] * inv;
                if (IS_GLA) y *= p.norm_w[h * 96 + v0 + e];
                const float g = g4[e];
                o4[e] = y * (g / (1.f + __expf(-g)));
            }
            u32x2 w; w.x = pk2(o4[0], o4[1]); w.y = pk2(o4[2], o4[3]);
            *(u32x2*)(p.O + t * D + ooff + v0) = w;
        }
    }
}
__device__ __forceinline__ void lin_kv_dispatch(const LinP& p, char* smem, int pair) {
    const int task = 2 * pair;
    const int r = task & 1023, bh = r >> 6, c = r & 63;
    if (task < 1024) lin_kv_task<false>(p, smem, bh >> 2, bh & 3, c); else lin_kv_task<true>(p, smem, bh >> 2, bh & 3, c);
}
__device__ __forceinline__ void lin_out_dispatch(const LinP& p, char* smem, int pair, unsigned* flags) {
    const int task = 2 * pair;
    const int r = task & 1023, bh = r >> 6, c = r & 63;
    if (flags) flag_wait(flags + (task < 1024 ? 0 : 16) + bh, task < 1024 ? 4u : 6u);
    if (task < 1024) lin_out_task<false>(p, smem, bh >> 2, bh & 3, c); else lin_out_task<true>(p, smem, bh >> 2, bh & 3, c);
}

struct RwP {
    const bf16_t* Z; unsigned char* mix;
    const float* mu; const float* w_up; const float* w_bias; const float* a_up; const float* a_bias; const float* g_up;
    const float* k_k; const float* k_a; const float* r_k; const float* ln_w; const float* ln_b;
    float* oraw; bf16_t* O; bf16_t* Y; const bf16_t* lora;
};
constexpr int PS = 264;
__device__ __forceinline__ f32x4 bf4(u32x2 w) { return (f32x4){lo_bf(w.x), hi_bf(w.x), lo_bf(w.y), hi_bf(w.y)}; }
__device__ void rwkv_prep_task(const RwP& p, char* smem, int tile) {
    bf16_t* At = (bf16_t*)smem;
    const int tid = otid(), lane = tid & 63, wave = tid >> 6;
    const int fl = lane & 15, fq = lane >> 4;
    const int t0 = tile * 64;
    float* Wd = (float*)(p.mix + MX_W); float* KKd = (float*)(p.mix + MX_KK); float* KKAd = (float*)(p.mix + MX_KKA);
    bf16_t* Rd = (bf16_t*)(p.mix + MX_R); bf16_t* Kd = (bf16_t*)(p.mix + MX_K); bf16_t* Vd = (bf16_t*)(p.mix + MX_V); bf16_t* Gd = (bf16_t*)(p.mix + MX_G);
    __syncthreads();
    {
        const int tok = tid >> 3, t = t0 + tok;
        const bool first = (t & (NS - 1)) == 0;
        const bf16_t* zr = p.Z + (size_t)t * DINP + ZC_RW + 1152;
#pragma unroll
        for (int i = 0; i < 4; ++i) {
            const int ch = (tid & 7) + 8 * i;
            const u32x4 cur = *(const u32x4*)(zr + ch * 8);
            const u32x4 prv = first ? (u32x4){0u, 0u, 0u, 0u} : *(const u32x4*)(zr - DINP + ch * 8);
            const f32x4 m0 = *(const f32x4*)(p.mu + 1152 + ch * 8), m1 = *(const f32x4*)(p.mu + 1152 + ch * 8 + 4);
            const unsigned cw[4] = {cur.x, cur.y, cur.z, cur.w}, pw[4] = {prv.x, prv.y, prv.z, prv.w};
            const float mm[8] = {m0.x, m0.y, m0.z, m0.w, m1.x, m1.y, m1.z, m1.w};
            float o[8];
#pragma unroll
            for (int e = 0; e < 4; ++e) {
                const float f0 = lo_bf(cw[e]), f1 = hi_bf(cw[e]), g0 = lo_bf(pw[e]), g1 = hi_bf(pw[e]);
                o[2 * e] = f0 + (g0 - f0) * mm[2 * e]; o[2 * e + 1] = f1 + (g1 - f1) * mm[2 * e + 1];
            }
            if (ch < 8) {
#pragma unroll
                for (int e = 0; e < 8; ++e) o[e] = tanhf_(o[e]);
            } else if (ch >= 16) {
#pragma unroll
                for (int e = 0; e < 8; ++e) o[e] = sigmoidf_(o[e]);
            }
            *(u32x4*)(At + tok * PS + ch * 8) = (u32x4){pk2(o[0], o[1]), pk2(o[2], o[3]), pk2(o[4], o[5]), pk2(o[6], o[7])};
        }
    }
    __syncthreads();
    bf16x8 xb[8];
#pragma unroll
    for (int ks = 0; ks < 8; ++ks) xb[ks] = *(const bf16x8*)(At + (16 * (wave & 3) + fl) * PS + ks * 32 + fq * 8);
    const int t = t0 + 16 * (wave & 3) + fl, b = t >> 12, sq = t & (NS - 1);
    const bool first = sq == 0;
    const bf16_t* zc = p.Z + (size_t)t * DINP + ZC_RW;
    const bf16_t* WupT = p.lora; const bf16_t* AupT = p.lora + 384 * 64; const bf16_t* GupT = p.lora + 2 * 384 * 64;
    const int hd0 = (wave >> 2) * 3;
#pragma unroll
    for (int hi = 0; hi < 3; ++hi) {
        const int hd = hd0 + hi;
        f32x4 aw[4], aa[4], ag[4];
#pragma unroll
        for (int n = 0; n < 4; ++n) {
            const int cr = hd * 64 + 16 * n + fl;
            f32x4 w4 = (f32x4){0.f, 0.f, 0.f, 0.f}, a4 = w4, g4 = w4;
#pragma unroll
            for (int ks = 0; ks < 2; ++ks) {
                w4 = __builtin_amdgcn_mfma_f32_16x16x32_bf16(*(const bf16x8*)(WupT + cr * 64 + ks * 32 + fq * 8), xb[ks], w4, 0, 0, 0);
                a4 = __builtin_amdgcn_mfma_f32_16x16x32_bf16(*(const bf16x8*)(AupT + cr * 64 + ks * 32 + fq * 8), xb[2 + ks], a4, 0, 0, 0);
            }
#pragma unroll
            for (int ks = 0; ks < 4; ++ks) g4 = __builtin_amdgcn_mfma_f32_16x16x32_bf16(*(const bf16x8*)(GupT + cr * 128 + ks * 32 + fq * 8), xb[4 + ks], g4, 0, 0, 0);
            aw[n] = w4; aa[n] = a4; ag[n] = g4;
        }
        f32x4 kx[4], av[4], kkv[4];
        float ss = 0.f;
        const size_t hrow = ((size_t)(b * 6 + hd) * NS + sq) * 64;
#pragma unroll
        for (int n = 0; n < 4; ++n) {
            const int cl = 16 * n + 4 * fq, c = hd * 64 + cl;
            f32x4 rr = bf4(*(const u32x2*)(zc + c)), kk = bf4(*(const u32x2*)(zc + 384 + c)), vv = bf4(*(const u32x2*)(zc + 768 + c));
            f32x4 rp = (f32x4){0.f, 0.f, 0.f, 0.f}, kp = rp, vp = rp;
            if (!first) { rp = bf4(*(const u32x2*)(zc - DINP + c)); kp = bf4(*(const u32x2*)(zc - DINP + 384 + c)); vp = bf4(*(const u32x2*)(zc - DINP + 768 + c)); }
            rr = rr + (rp - rr) * *(const f32x4*)(p.mu + c); kk = kk + (kp - kk) * *(const f32x4*)(p.mu + 384 + c); vv = vv + (vp - vv) * *(const f32x4*)(p.mu + 768 + c);
            const f32x4 wb = *(const f32x4*)(p.w_bias + c), ab = *(const f32x4*)(p.a_bias + c), kkc = *(const f32x4*)(p.k_k + c), kac = *(const f32x4*)(p.k_a + c);
            f32x4 dec, a;
            {
                const f32x4 xw = wb + aw[n], xa = ab + aa[n];
                dec.x = __expf(-__expf(-softplusf_(-xw.x) - 0.5f)); dec.y = __expf(-__expf(-softplusf_(-xw.y) - 0.5f));
                dec.z = __expf(-__expf(-softplusf_(-xw.z) - 0.5f)); dec.w = __expf(-__expf(-softplusf_(-xw.w) - 0.5f));
                a.x = sigmoidf_(xa.x); a.y = sigmoidf_(xa.y); a.z = sigmoidf_(xa.z); a.w = sigmoidf_(xa.w);
            }
            const f32x4 kr = kk * kkc;
            ss += kr.x * kr.x + kr.y * kr.y + kr.z * kr.z + kr.w * kr.w;
            kkv[n] = kr; av[n] = a; kx[n] = kk;
            const f32x4 kmod = kk * ((a - 1.f) * kac + 1.f);
            *(f32x4*)(Wd + hrow + cl) = dec;
            u32x2 w;
            w.x = pk2(rr.x, rr.y); w.y = pk2(rr.z, rr.w); *(u32x2*)(Rd + hrow + cl) = w;
            w.x = pk2(kmod.x, kmod.y); w.y = pk2(kmod.z, kmod.w); *(u32x2*)(Kd + hrow + cl) = w;
            w.x = pk2(vv.x, vv.y); w.y = pk2(vv.z, vv.w); *(u32x2*)(Vd + hrow + cl) = w;
            w.x = pk2(ag[n].x, ag[n].y); w.y = pk2(ag[n].z, ag[n].w); *(u32x2*)(Gd + (size_t)t * 384 + c) = w;
        }
        ss = xor32_sum(xor16_sum(ss));
        const float rn = rsqrtf(fmaxf(ss, 1e-24f));
#pragma unroll
        for (int n = 0; n < 4; ++n) {
            const int cl = 16 * n + 4 * fq;
            const f32x4 kn = kkv[n] * rn;
            *(f32x4*)(KKd + hrow + cl) = kn;
            *(f32x4*)(KKAd + hrow + cl) = kn * av[n];
        }
    }
}

constexpr int SC_STEPS = 16;
constexpr int SEG_BEG[4] = {0, 1376, 2736, 4096};
constexpr size_t MX_SE0 = MX_END;
constexpr size_t MX_XE  = MX_SE0 + 24ull * 3 * 4096 * 4;
constexpr size_t MX_SST = MX_XE + 24ull * 3 * 4096 * 4;
static_assert(MX_SST + 24ull * 3 * 4096 * 2 <= 128 * MiB, "mix region");
__device__ __forceinline__ float row8_sum(float v) { v += dpp_f<0xB1>(v); v += dpp_f<0x4E>(v); v += dpp_f<0x141>(v); return v; }
__device__ void rwkv_scan_task(const RwP& p, char* smem, int bh, int seg, int grp, const CvP cvp, bool cv, int cvrow0, int cvstride) {
    float* buf = (float*)smem;
    float* obuf = buf + 2 * 6 * SC_STEPS * 64;
    const int tid = otid(), lane = tid & 63, wave = tid >> 6;
    const bool act = __builtin_amdgcn_readfirstlane(wave) < 4;
    const int rloc = (wave & 3) * 8 + (lane >> 3);
    const bool ident = grp >= 2;
    const int row = (grp & 1) * 32 + rloc;
    int cvrow = cvrow0 + (__builtin_amdgcn_readfirstlane(wave) - 4);
    const int c8 = (lane & 7) * 8;
    const int s_beg = seg == 0 ? SEG_BEG[0] : (seg == 1 ? SEG_BEG[1] : SEG_BEG[2]);
    const int s_end = seg == 0 ? SEG_BEG[1] : (seg == 1 ? SEG_BEG[2] : SEG_BEG[3]);
    const int NCH = (s_end - s_beg) / SC_STEPS;
    const size_t hb = ((size_t)bh * NS + s_beg) * 64;
    const float* Wd = (const float*)(p.mix + MX_W) + hb;
    const float* KKd = (const float*)(p.mix + MX_KK) + hb;
    const float* KKAd = (const float*)(p.mix + MX_KKA) + hb;
    const bf16_t* Rd = (const bf16_t*)(p.mix + MX_R) + hb;
    const bf16_t* Kd = (const bf16_t*)(p.mix + MX_K) + hb;
    const bf16_t* Vd = (const bf16_t*)(p.mix + MX_V) + hb;
    float* orow = p.oraw + hb;
    bf16_t* yrow = p.Y + hb;
    f32x4 Sa, Sb;
    Sa.x = (ident && c8 + 0 == row) ? 1.f : 0.f; Sa.y = (ident && c8 + 1 == row) ? 1.f : 0.f; Sa.z = (ident && c8 + 2 == row) ? 1.f : 0.f; Sa.w = (ident && c8 + 3 == row) ? 1.f : 0.f;
    Sb.x = (ident && c8 + 4 == row) ? 1.f : 0.f; Sb.y = (ident && c8 + 5 == row) ? 1.f : 0.f; Sb.z = (ident && c8 + 6 == row) ? 1.f : 0.f; Sb.w = (ident && c8 + 7 == row) ? 1.f : 0.f;
    struct Stg { f32x4 w, kk, ka; u32x2 r, k, v; };
    Stg sA;
    auto gload = [&](Stg& g, int ch) {
        if (tid >= 256) return;
        const size_t e = (size_t)ch * SC_STEPS * 64 + tid * 4;
        g.w = *(const f32x4*)(Wd + e); g.kk = *(const f32x4*)(KKd + e); g.ka = *(const f32x4*)(KKAd + e);
        g.r = *(const u32x2*)(Rd + e); g.k = *(const u32x2*)(Kd + e); g.v = *(const u32x2*)(Vd + e);
    };
    auto lstore = [&](const Stg& g, int bsel) {
        if (tid >= 256) return;
        float* bb = buf + bsel * 6 * SC_STEPS * 64 + tid * 4;
        *(f32x4*)(bb + 0 * SC_STEPS * 64) = g.w; *(f32x4*)(bb + 1 * SC_STEPS * 64) = g.kk; *(f32x4*)(bb + 2 * SC_STEPS * 64) = g.ka;
        *(f32x4*)(bb + 3 * SC_STEPS * 64) = (f32x4){lo_bf(g.r.x), hi_bf(g.r.x), lo_bf(g.r.y), hi_bf(g.r.y)};
        *(f32x4*)(bb + 4 * SC_STEPS * 64) = (f32x4){lo_bf(g.k.x), hi_bf(g.k.x), lo_bf(g.k.y), hi_bf(g.k.y)};
        *(f32x4*)(bb + 5 * SC_STEPS * 64) = (f32x4){lo_bf(g.v.x), hi_bf(g.v.x), lo_bf(g.v.y), hi_bf(g.v.y)};
    };
    __syncthreads();
    gload(sA, 0); lstore(sA, 0);
    __syncthreads();
    const float vmask = ident ? 0.f : 1.f;
    struct Ops { f32x4 w0, w1, kk0, kk1, ka0, ka1, r0, r1, k0, k1; float v; };
    auto ldops = [&](Ops& o, const float* bb, int st) {
        const float* q = bb + st * 64 + c8;
        o.w0 = *(const f32x4*)(q); o.w1 = *(const f32x4*)(q + 4);
        o.kk0 = *(const f32x4*)(q + 1 * SC_STEPS * 64); o.kk1 = *(const f32x4*)(q + 1 * SC_STEPS * 64 + 4);
        o.ka0 = *(const f32x4*)(q + 2 * SC_STEPS * 64); o.ka1 = *(const f32x4*)(q + 2 * SC_STEPS * 64 + 4);
        o.r0 = *(const f32x4*)(q + 3 * SC_STEPS * 64); o.r1 = *(const f32x4*)(q + 3 * SC_STEPS * 64 + 4);
        o.k0 = *(const f32x4*)(q + 4 * SC_STEPS * 64); o.k1 = *(const f32x4*)(q + 4 * SC_STEPS * 64 + 4);
        o.v = bb[5 * SC_STEPS * 64 + st * 64 + row];
    };
    auto chunk = [&](int ch, Stg& cur  ) {
        if (ch + 1 < NCH) gload(cur, ch + 1);
        const float* bb = buf + (ch & 1) * 6 * SC_STEPS * 64;
        if (!act) {
            if (cv && cvrow < 4 * NEXP) { convert_uv_row(cvp, cvrow, lane); cvrow += cvstride; }
        } else {
        Ops o; ldops(o, bb, 0);
#pragma unroll
        for (int st = 0; st < SC_STEPS; ++st) {
            Ops n; ldops(n, bb, (st + 1 < SC_STEPS) ? st + 1 : st);
            const float vx = o.v * vmask;
            const f32x4 pa = Sa * o.kk0 + Sb * o.kk1;
            const float sa = -row8_sum((pa.x + pa.y) + (pa.z + pa.w));
            Sa = Sa * o.w0 + o.k0 * vx + o.ka0 * sa;
            Sb = Sb * o.w1 + o.k1 * vx + o.ka1 * sa;
            const f32x4 qa = Sa * o.r0 + Sb * o.r1;
            obuf[st * 32 + rloc] = row8_sum((qa.x + qa.y) + (qa.z + qa.w));
            o = n;
        }
        }
        __syncthreads();
        {
            const int idx = tid, st = idx >> 5, rr = idx & 31;
            const size_t oi = ((size_t)ch * SC_STEPS + st) * 64 + (grp & 1) * 32 + rr;
            if (ident) yrow[oi] = f2bf(obuf[idx]); else orow[oi] = obuf[idx];
        }
        if (ch + 1 < NCH) lstore(cur, (ch + 1) & 1);
        __syncthreads();
    };
    for (int ch = 0; ch < NCH; ++ch) chunk(ch, sA);
    float* fin = (float*)(p.mix + (ident ? MX_XE : MX_SE0)) + ((size_t)(bh * 3 + seg) * 64 + row) * 64 + c8;
    if (act) { *(f32x4*)fin = Sa; *(f32x4*)(fin + 4) = Sb; }
}

__device__ void phase_rwkv_chain(const RwP& p, int bid, int nblk) {
    const int lane = otid() & 63, wave = otid() >> 6;
    const float* SE0 = (const float*)(p.mix + MX_SE0); const float* XE = (const float*)(p.mix + MX_XE);
    bf16_t* SST = (bf16_t*)(p.mix + MX_SST);
    for (int x = bid * NW + wave; x < 24 * 4; x += nblk * NW) {
        const int bh = x >> 2, cg = (x & 3) * 16;
        const float* s1 = SE0 + ((size_t)(bh * 3 + 0) * 64 + lane) * 64;
        const float* e1 = SE0 + ((size_t)(bh * 3 + 1) * 64 + lane) * 64 + cg;
        const float* X1 = XE + (size_t)(bh * 3 + 1) * 4096 + cg;
        float o[16];
#pragma unroll
        for (int k = 0; k < 16; ++k) o[k] = e1[k];
        for (int i = 0; i < 64; ++i) {
            const float si = s1[i];
#pragma unroll
            for (int k = 0; k < 16; ++k) o[k] += si * X1[i * 64 + k];
        }
        bf16_t* d1 = SST + ((size_t)(bh * 3 + 1) * 64 + lane) * 64 + cg;
        bf16_t* d2 = SST + ((size_t)(bh * 3 + 2) * 64 + lane) * 64 + cg;
#pragma unroll
        for (int k = 0; k < 16; ++k) { d1[k] = f2bf(s1[cg + k]); d2[k] = f2bf(o[k]); }
    }
}

__device__ void phase_rwkv_post(const RwP& p, int bid, int nblk) {
    const int lane = otid() & 63, wave = otid() >> 6;
    const int fl = lane & 15, fq = lane >> 4;
    const bf16_t* Rd = (const bf16_t*)(p.mix + MX_R); const bf16_t* Kd = (const bf16_t*)(p.mix + MX_K); const bf16_t* Vd = (const bf16_t*)(p.mix + MX_V);
    const bf16_t* Gd = (const bf16_t*)(p.mix + MX_G); const bf16_t* SST = (const bf16_t*)(p.mix + MX_SST);
    for (int x = bid * NW + wave; x < 24 * (NS / 16); x += nblk * NW) {
        const int bh = x / (NS / 16), s0 = (x % (NS / 16)) * 16;
        const int b = bh / 6, hd = bh % 6;
        const int seg = s0 < SEG_BEG[1] ? 0 : (s0 < SEG_BEG[2] ? 1 : 2);
        const size_t hrow = ((size_t)bh * NS + s0 + fl) * 64;
        f32x4 acc[4];
#pragma unroll
        for (int n = 0; n < 4; ++n) acc[n] = *(const f32x4*)(p.oraw + hrow + 16 * n + 4 * fq);
        if (seg > 0) {
            const bf16_t* ss = SST + (size_t)(bh * 3 + seg) * 4096;
#pragma unroll
            for (int ks = 0; ks < 2; ++ks) {
                const bf16x8 yb = *(const bf16x8*)(p.Y + hrow + ks * 32 + fq * 8);
#pragma unroll
                for (int n = 0; n < 4; ++n) {
                    const bf16x8 sa = *(const bf16x8*)(ss + (size_t)(16 * n + fl) * 64 + ks * 32 + fq * 8);
                    acc[n] = __builtin_amdgcn_mfma_f32_16x16x32_bf16(sa, yb, acc[n], 0, 0, 0);
                }
            }
        }
        float sm = 0.f;
#pragma unroll
        for (int n = 0; n < 4; ++n) sm += acc[n].x + acc[n].y + acc[n].z + acc[n].w;
        const float mean = xor32_sum(xor16_sum(sm)) * (1.f / 64.f);
        float sv = 0.f;
#pragma unroll
        for (int n = 0; n < 4; ++n) { acc[n] = acc[n] - mean; sv += acc[n].x * acc[n].x + acc[n].y * acc[n].y + acc[n].z * acc[n].z + acc[n].w * acc[n].w; }
        const float rstd = rsqrtf(xor32_sum(xor16_sum(sv)) * (1.f / 64.f) + 64e-5f);
        float rk = 0.f; f32x4 vv[4];
#pragma unroll
        for (int n = 0; n < 4; ++n) {
            const int c = 16 * n + 4 * fq;
            const u32x2 r2 = *(const u32x2*)(Rd + hrow + c), k2 = *(const u32x2*)(Kd + hrow + c), v2 = *(const u32x2*)(Vd + hrow + c);
            const f32x4 rkw = *(const f32x4*)(p.r_k + hd * 64 + c);
            rk += lo_bf(r2.x) * lo_bf(k2.x) * rkw.x + hi_bf(r2.x) * hi_bf(k2.x) * rkw.y + lo_bf(r2.y) * lo_bf(k2.y) * rkw.z + hi_bf(r2.y) * hi_bf(k2.y) * rkw.w;
            vv[n] = (f32x4){lo_bf(v2.x), hi_bf(v2.x), lo_bf(v2.y), hi_bf(v2.y)};
        }
        rk = xor32_sum(xor16_sum(rk));
        const size_t t = (size_t)b * NS + s0 + fl;
#pragma unroll
        for (int n = 0; n < 4; ++n) {
            const int c = 16 * n + 4 * fq;
            const f32x4 lw = *(const f32x4*)(p.ln_w + hd * 64 + c), lb = *(const f32x4*)(p.ln_b + hd * 64 + c);
            const u32x2 g2 = *(const u32x2*)(Gd + t * 384 + hd * 64 + c);
            const f32x4 gg = (f32x4){lo_bf(g2.x), hi_bf(g2.x), lo_bf(g2.y), hi_bf(g2.y)};
            const f32x4 o = (acc[n] * rstd * lw + lb + vv[n] * rk) * gg;
            u32x2 w; w.x = pk2(o.x, o.y); w.y = pk2(o.z, o.w);
            *(u32x2*)(p.O + t * D + 256 + hd * 64 + c) = w;
        }
    }
}

__device__ __forceinline__ unsigned ordkey(float f) { const unsigned u = __float_as_uint(f); return (u & 0x80000000u) ? ~u : (u | 0x80000000u); }
__device__ __forceinline__ float unordkey(unsigned k) { return __uint_as_float((k & 0x80000000u) ? (k & 0x7FFFFFFFu) : ~k); }
__device__ __forceinline__ void ins16(unsigned (&L)[16], unsigned x) {
#pragma unroll
    for (int i = 0; i < 16; ++i) { const unsigned hi = L[i] > x ? L[i] : x; x = L[i] > x ? x : L[i]; L[i] = hi; }
}
__device__ __forceinline__ void top16_col(const float* col  , unsigned (&L)[16]) {
#pragma unroll
    for (int i = 0; i < 16; ++i) L[i] = 0u;
#pragma unroll 1
    for (int n0 = 0; n0 < 128; n0 += 16) {
        float x[16];
#pragma unroll
        for (int j = 0; j < 16; ++j) x[j] = col[(size_t)(n0 + j) * NT];
#pragma unroll
        for (int j = 0; j < 16; ++j) ins16(L, (ordkey(x[j]) & 0xFFFFFF80u) | (unsigned)(127 - (n0 + j)));
    }
}
__device__ void phase_topk(const float* SCT, int* EIDX, float* GATE, char* smem, int bid, int nblk) {
    const int tid = otid(), lane = tid & 63, wave = tid >> 6;
    unsigned char* itab = (unsigned char*)smem + tid * 32;
    unsigned char* ctab = (unsigned char*)smem + NTHREADS * 32;
    __syncthreads();
    if (tid < 64) {
        const int c = tid; int ci, cj;
        if (c < 16) { ci = 0; cj = c; } else if (c < 24) { ci = 1; cj = c - 16; } else if (c < 29) { ci = 2; cj = c - 24; } else if (c < 33) { ci = 3; cj = c - 29; }
        else if (c < 36) { ci = 4; cj = c - 33; } else if (c < 38) { ci = 5; cj = c - 36; } else if (c < 40) { ci = 6; cj = c - 38; } else if (c < 42) { ci = 7; cj = c - 40; }
        else if (c < 50) { ci = c - 34; cj = 0; } else { ci = 0; cj = 0; }
        ctab[c] = (unsigned char)(ci | (cj << 4));
    }
    __syncthreads();
    for (int x = bid * NW + wave; x < (NT / 64) * 8; x += nblk * NW) {
        const int tb = x >> 3, hd = x & 7;
        const int t = tb * 64 + lane;
        unsigned L1[16], L2[16];
        top16_col(SCT + (size_t)(hd * 256) * NT + t, L1);
        top16_col(SCT + (size_t)(hd * 256 + 128) * NT + t, L2);
        float s1[16], s2[16];
#pragma unroll
        for (int i = 0; i < 16; ++i) {
            s1[i] = unordkey(L1[i] & 0xFFFFFF80u); s2[i] = unordkey(L2[i] & 0xFFFFFF80u);
            itab[i] = (unsigned char)(127u - (L1[i] & 127u)); itab[16 + i] = (unsigned char)(127u - (L2[i] & 127u));
        }
        unsigned M[16];
#pragma unroll
        for (int i = 0; i < 16; ++i) M[i] = 0u;
        int c = 0;
#pragma unroll
        for (int ci = 0; ci < 16; ++ci) {
#pragma unroll
            for (int cj = 0; cj < 16; ++cj) {
                if ((ci + 1) * (cj + 1) <= 16) {
                    const int cid = (ci == 0) ? cj : (ci == 1) ? 16 + cj : (ci == 2) ? 24 + cj : (ci == 3) ? 29 + cj : (ci == 4) ? 33 + cj : (ci == 5) ? 36 + cj : (ci == 6) ? 38 + cj : (ci == 7) ? 40 + cj : 34 + ci;
                    ins16(M, (ordkey(s1[ci] + s2[cj]) & 0xFFFFFFC0u) | (unsigned)(63 - cid));
                    ++c;
                }
            }
        }
        float ev[16]; int ee[16];
        const float mx = unordkey(M[0] & 0xFFFFFFC0u);
        float sum = 0.f;
#pragma unroll
        for (int i = 0; i < 16; ++i) {
            const int cid = 63 - (int)(M[i] & 63u);
            const unsigned cc = ctab[cid];
            ee[i] = (int)itab[cc & 15u] * 128 + (int)itab[16 + (cc >> 4)];
            ev[i] = __expf(unordkey(M[i] & 0xFFFFFFC0u) - mx);
            sum += ev[i];
        }
        const float inv = 1.f / sum;
        int* eo = EIDX + (size_t)t * 128 + hd * 16; float* go = GATE + (size_t)t * 128 + hd * 16;
#pragma unroll
        for (int i = 0; i < 4; ++i) {
            *(int4*)(eo + 4 * i) = make_int4(ee[4 * i], ee[4 * i + 1], ee[4 * i + 2], ee[4 * i + 3]);
            *(f32x4*)(go + 4 * i) = (f32x4){ev[4 * i] * inv, ev[4 * i + 1] * inv, ev[4 * i + 2] * inv, ev[4 * i + 3] * inv};
        }
    }
    __syncthreads();
}

typedef float f32x2 __attribute__((ext_vector_type(2)));
__device__ __forceinline__ float gelu_erf(float d) { return 0.5f * d * (1.f + erff(d * 0.7071067811865476f)); }
template <int NMODE>
__device__ void phase_expert(const bf16_t* H, const unsigned char* U4, const unsigned char* V4, const float* SU, const float* SV, const int* EIDX, const float* GATE,
                             const float* X, float* Xo, const float* gn, bf16_t* Hn, int bid, int nblk) {
    const int lane = otid() & 63, wave = otid() >> 6;
    for (int t = bid * NW + wave; t < NT; t += nblk * NW) {
        f32x2 xf[8], acc[8];
        {
            const u32x4 a = *(const u32x4*)(H + (size_t)t * D + lane * 16), b = *(const u32x4*)(H + (size_t)t * D + lane * 16 + 8);
            xf[0] = (f32x2){lo_bf(a.x), hi_bf(a.x)}; xf[1] = (f32x2){lo_bf(a.y), hi_bf(a.y)}; xf[2] = (f32x2){lo_bf(a.z), hi_bf(a.z)}; xf[3] = (f32x2){lo_bf(a.w), hi_bf(a.w)};
            xf[4] = (f32x2){lo_bf(b.x), hi_bf(b.x)}; xf[5] = (f32x2){lo_bf(b.y), hi_bf(b.y)}; xf[6] = (f32x2){lo_bf(b.z), hi_bf(b.z)}; xf[7] = (f32x2){lo_bf(b.w), hi_bf(b.w)};
        }
#pragma unroll
        for (int i = 0; i < 8; ++i) acc[i] = (f32x2){0.f, 0.f};
        const int e_lo = EIDX[(size_t)t * 128 + lane], e_hi = EIDX[(size_t)t * 128 + 64 + lane];
        const float g_lo = GATE[(size_t)t * 128 + lane] * SV[e_lo], g_hi = GATE[(size_t)t * 128 + 64 + lane] * SV[e_hi];
        const float su_lo = SU[e_lo], su_hi = SU[e_hi];
#pragma unroll 1
        for (int e0 = 0; e0 < 128; e0 += 16) {
            const int esrc = (e0 < 64) ? e_lo : e_hi;
            int ei[16]; u32x2 ur[16];
#pragma unroll
            for (int j = 0; j < 16; ++j) { ei[j] = __builtin_amdgcn_readlane(esrc, (e0 & 63) + j); ur[j] = *(const u32x2*)(U4 + (size_t)ei[j] * 512 + lane * 8); }
            float dmine = 0.f;
#pragma unroll
            for (int j = 0; j < 16; ++j) {
                f32x2 d2 = (f32x2){0.f, 0.f};
                d2 = __builtin_elementwise_fma(xf[0], __builtin_amdgcn_cvt_scalef32_pk_f32_fp4(ur[j].x, 1.0f, 0), d2);
                d2 = __builtin_elementwise_fma(xf[1], __builtin_amdgcn_cvt_scalef32_pk_f32_fp4(ur[j].x, 1.0f, 1), d2);
                d2 = __builtin_elementwise_fma(xf[2], __builtin_amdgcn_cvt_scalef32_pk_f32_fp4(ur[j].x, 1.0f, 2), d2);
                d2 = __builtin_elementwise_fma(xf[3], __builtin_amdgcn_cvt_scalef32_pk_f32_fp4(ur[j].x, 1.0f, 3), d2);
                d2 = __builtin_elementwise_fma(xf[4], __builtin_amdgcn_cvt_scalef32_pk_f32_fp4(ur[j].y, 1.0f, 0), d2);
                d2 = __builtin_elementwise_fma(xf[5], __builtin_amdgcn_cvt_scalef32_pk_f32_fp4(ur[j].y, 1.0f, 1), d2);
                d2 = __builtin_elementwise_fma(xf[6], __builtin_amdgcn_cvt_scalef32_pk_f32_fp4(ur[j].y, 1.0f, 2), d2);
                d2 = __builtin_elementwise_fma(xf[7], __builtin_amdgcn_cvt_scalef32_pk_f32_fp4(ur[j].y, 1.0f, 3), d2);
                const float d = wave_sum(d2.x + d2.y);
                if (lane == (e0 & 63) + j) dmine = d;
            }
            const float amine = gelu_erf(dmine * ((e0 < 64) ? su_lo : su_hi)) * ((e0 < 64) ? g_lo : g_hi);
#pragma unroll
            for (int j = 0; j < 16; ++j) ur[j] = *(const u32x2*)(V4 + (size_t)ei[j] * 512 + lane * 8);
#pragma unroll
            for (int j = 0; j < 16; ++j) {
                const float a = __int_as_float(__builtin_amdgcn_readlane(__float_as_int(amine), (e0 & 63) + j));
                const f32x2 a2 = (f32x2){a, a};
                acc[0] = __builtin_elementwise_fma(a2, __builtin_amdgcn_cvt_scalef32_pk_f32_fp4(ur[j].x, 1.0f, 0), acc[0]);
                acc[1] = __builtin_elementwise_fma(a2, __builtin_amdgcn_cvt_scalef32_pk_f32_fp4(ur[j].x, 1.0f, 1), acc[1]);
                acc[2] = __builtin_elementwise_fma(a2, __builtin_amdgcn_cvt_scalef32_pk_f32_fp4(ur[j].x, 1.0f, 2), acc[2]);
                acc[3] = __builtin_elementwise_fma(a2, __builtin_amdgcn_cvt_scalef32_pk_f32_fp4(ur[j].x, 1.0f, 3), acc[3]);
                acc[4] = __builtin_elementwise_fma(a2, __builtin_amdgcn_cvt_scalef32_pk_f32_fp4(ur[j].y, 1.0f, 0), acc[4]);
                acc[5] = __builtin_elementwise_fma(a2, __builtin_amdgcn_cvt_scalef32_pk_f32_fp4(ur[j].y, 1.0f, 1), acc[5]);
                acc[6] = __builtin_elementwise_fma(a2, __builtin_amdgcn_cvt_scalef32_pk_f32_fp4(ur[j].y, 1.0f, 2), acc[6]);
                acc[7] = __builtin_elementwise_fma(a2, __builtin_amdgcn_cvt_scalef32_pk_f32_fp4(ur[j].y, 1.0f, 3), acc[7]);
            }
        }
        const f32x4* xr = (const f32x4*)(X + (size_t)t * D) + lane * 4;
        f32x4* xo = (f32x4*)(Xo + (size_t)t * D) + lane * 4;
        f32x4 o[4]; float ss = 0.f;
#pragma unroll
        for (int i = 0; i < 4; ++i) { o[i] = xr[i]; o[i] += (f32x4){acc[2 * i].x, acc[2 * i].y, acc[2 * i + 1].x, acc[2 * i + 1].y}; ss += o[i].x * o[i].x + o[i].y * o[i].y + o[i].z * o[i].z + o[i].w * o[i].w; }
        const float rs = rsqrtf(wave_sum(ss) * (1.f / D) + 1e-6f);
        const f32x4* gp = (const f32x4*)gn + lane * 4;
        if (NMODE == 1) {
#pragma unroll
            for (int i = 0; i < 4; ++i) xo[i] = o[i] * rs * gp[i];
        } else {
            u32x4 h0, h1;
            { const f32x4 y0 = o[0] * rs * gp[0], y1 = o[1] * rs * gp[1], y2 = o[2] * rs * gp[2], y3 = o[3] * rs * gp[3];
              h0 = (u32x4){pk2(y0.x, y0.y), pk2(y0.z, y0.w), pk2(y1.x, y1.y), pk2(y1.z, y1.w)}; h1 = (u32x4){pk2(y2.x, y2.y), pk2(y2.z, y2.w), pk2(y3.x, y3.y), pk2(y3.z, y3.w)}; }
#pragma unroll
            for (int i = 0; i < 4; ++i) xo[i] = o[i];
            *(u32x4*)(Hn + (size_t)t * D + lane * 16) = h0; *(u32x4*)(Hn + (size_t)t * D + lane * 16 + 8) = h1;
        }
    }
}

#define XB_TMO      128
#define XB_XCNT(j)  (256  + 64 * (j))
#define XB_XSUB(j)  (1280 + 64 * (j))
#define XB_XGEN(j)  (2304 + 64 * (j))
#define XB_TOP      3328
#define XB_TOPGEN   3392
#define XCD_BAR_WORDS 3456
#define XB_SPIN_CAP (1u << 22)
#define LAS __attribute__((address_space(3)))
__device__ __forceinline__ unsigned xb_ld(unsigned* p)              { return __hip_atomic_load(p, __ATOMIC_RELAXED, __HIP_MEMORY_SCOPE_AGENT); }
__device__ __forceinline__ unsigned xb_add(unsigned* p, unsigned v) { return __hip_atomic_fetch_add(p, v, __ATOMIC_RELAXED, __HIP_MEMORY_SCOPE_AGENT); }
__device__ __forceinline__ unsigned xb_xcc_id() { return (unsigned)__builtin_amdgcn_s_getreg((3 << 11) | 20) & 0xFu; }
#define XB_SPIN(cond, bar) do { unsigned _sp = 0; while (cond) { __builtin_amdgcn_s_sleep(1); \
    if ((++_sp & 255u) == 0u) { if (xb_ld(&(bar)[XB_TMO])) break; if (_sp > XB_SPIN_CAP) { atomicAdd(&(bar)[XB_TMO], 1u); break; } } } } while (0)
struct XcdBarrier { unsigned* bar; unsigned x; volatile LAS unsigned* st; };
__device__ __forceinline__ XcdBarrier xcd_barrier_post(unsigned* bar, volatile LAS unsigned* st) {
    XcdBarrier b; b.bar = bar; b.x = xb_xcc_id(); b.st = st;
    if (threadIdx.x == 0) (void)xb_add(&bar[XB_XCNT(b.x)], 1u);
    return b;
}
__device__ __forceinline__ void xcd_barrier_complete(unsigned* bar, unsigned x, unsigned& nloc, unsigned& nx) {
    const unsigned G = gridDim.x * gridDim.y * gridDim.z;
    unsigned sum, cnt, mine, sp = 0u;
    for (;;) {
        sum = 0u; cnt = 0u; mine = 0u;
#pragma unroll
        for (unsigned j = 0; j < 16; ++j) { const unsigned c = xb_ld(&bar[XB_XCNT(j)]); sum += c; cnt += (c > 0u) ? 1u : 0u; mine = (j == x) ? c : mine; }
        if (sum == G) break;
        __builtin_amdgcn_s_sleep(1);
        if ((++sp & 255u) == 0u) { if (xb_ld(&bar[XB_TMO])) break; if (sp > XB_SPIN_CAP) { atomicAdd(&bar[XB_TMO], 1u); break; } }
    }
    nloc = mine > 0u ? mine : 1u; nx = cnt > 0u ? cnt : 1u;
}
__device__ __forceinline__ void xcd_barrier(const XcdBarrier& b0) {
    asm volatile("s_waitcnt vmcnt(0)" ::: "memory");
    __syncthreads();
    if (threadIdx.x == 0) {
        XcdBarrier b = b0;
        { unsigned x = __builtin_amdgcn_readfirstlane(b0.x); asm volatile("" : "+s"(x)); b.x = x; }
        unsigned* bar = b.bar;
        __builtin_amdgcn_s_waitcnt(0);
        unsigned nloc = b.st[0], nx = b.st[1];
        if (nloc == 0u) { xcd_barrier_complete(bar, b.x, nloc, nx); b.st[0] = nloc; b.st[1] = nx; }
        const unsigned old = xb_add(&bar[XB_XSUB(b.x)], 1u);
        const unsigned gen = old / nloc;
        if (old + 1u == (gen + 1u) * nloc) {
            __builtin_amdgcn_fence(__ATOMIC_RELEASE, "agent");
            asm volatile("s_waitcnt vmcnt(0)" ::: "memory");
            const unsigned og = xb_add(&bar[XB_TOP], 1u);
            const unsigned tg = og / nx;
            if (og + 1u == (tg + 1u) * nx) xb_add(&bar[XB_TOPGEN], 1u);
            else XB_SPIN(xb_ld(&bar[XB_TOPGEN]) == tg, bar);
            __builtin_amdgcn_fence(__ATOMIC_ACQUIRE, "agent");
            xb_add(&bar[XB_XGEN(b.x)], 1u);
            asm volatile("s_waitcnt vmcnt(0)" ::: "memory");
        } else {
            XB_SPIN(xb_ld(&bar[XB_XGEN(b.x)]) == gen, bar);
            __builtin_amdgcn_fence(__ATOMIC_ACQUIRE, "agent");
            asm volatile("s_waitcnt vmcnt(0)" ::: "memory");
        }
    }
    __syncthreads();
}

struct Params {
    const float* in[24];
    float* out; unsigned char* ws;
};
constexpr int LDS_BYTES = 147456;

typedef volatile LAS unsigned long long* ptab_t;
__device__ __forceinline__ const float* pin(ptab_t t, int i) {
    const unsigned long long v = t[i];
    const unsigned lo = __builtin_amdgcn_readfirstlane((unsigned)v), hi = __builtin_amdgcn_readfirstlane((unsigned)(v >> 32));
    return (const float*)(((unsigned long long)hi << 32) | lo);
}
__device__ __forceinline__ RwP make_rwp(const Params& P, ptab_t PT, int l) {
    RwP r;
    r.Z = (const bf16_t*)(P.ws + WS_Z); r.mix = P.ws + WS_MIX;
    r.mu = pin(PT, 6) + l * RW_F; r.w_up = pin(PT, 7) + (size_t)l * 64 * 384; r.w_bias = pin(PT, 8) + l * 384; r.a_up = pin(PT, 9) + (size_t)l * 64 * 384; r.a_bias = pin(PT, 10) + l * 384;
    r.g_up = pin(PT, 11) + (size_t)l * 128 * 384; r.k_k = pin(PT, 12) + l * 384; r.k_a = pin(PT, 13) + l * 384; r.r_k = pin(PT, 14) + l * 384; r.ln_w = pin(PT, 15) + l * 384; r.ln_b = pin(PT, 16) + l * 384;
    r.oraw = (float*)(P.ws + WS_H); r.O = (bf16_t*)(P.ws + WS_O); r.Y = (bf16_t*)(P.ws + WS_EIDX); r.lora = (const bf16_t*)(P.ws + WS_LORA + l * LORA_L);
    return r;
}

__global__ void __launch_bounds__(NTHREADS, 2) mega_fwd(Params P) {
    extern __shared__ __attribute__((aligned(16))) char smem[];
    const int bid = blockIdx.x, nblk = gridDim.x;
    volatile LAS unsigned* st = (volatile LAS unsigned*)(smem + LDS_BYTES - 16);
    ptab_t PT = (ptab_t)(smem + LDS_BYTES - 512);
    if (threadIdx.x == 0) {
        st[0] = 0u; st[1] = 0u; st[2] = 0u; st[3] = 0u;
        PT[0] = (unsigned long long)P.in[0]; PT[1] = (unsigned long long)P.in[1]; PT[2] = (unsigned long long)P.in[2]; PT[3] = (unsigned long long)P.in[3];
        PT[4] = (unsigned long long)P.in[4]; PT[5] = (unsigned long long)P.in[5]; PT[6] = (unsigned long long)P.in[6]; PT[7] = (unsigned long long)P.in[7];
        PT[8] = (unsigned long long)P.in[8]; PT[9] = (unsigned long long)P.in[9]; PT[10] = (unsigned long long)P.in[10]; PT[11] = (unsigned long long)P.in[11];
        PT[12] = (unsigned long long)P.in[12]; PT[13] = (unsigned long long)P.in[13]; PT[14] = (unsigned long long)P.in[14]; PT[15] = (unsigned long long)P.in[15];
        PT[16] = (unsigned long long)P.in[16]; PT[17] = (unsigned long long)P.in[17]; PT[18] = (unsigned long long)P.in[18]; PT[19] = (unsigned long long)P.in[19];
        PT[20] = (unsigned long long)P.in[20]; PT[21] = (unsigned long long)P.in[21]; PT[22] = (unsigned long long)P.in[22]; PT[23] = (unsigned long long)P.in[23];
    }
    __syncthreads();
    XcdBarrier bar = xcd_barrier_post((unsigned*)(P.ws + WS_CTL), st);
#define GSYNC() xcd_barrier(bar)
    constexpr int NSCAN = 240;

    {
        ConvP c{pin(PT, 4), pin(PT, 5), pin(PT, 20), pin(PT, 21), pin(PT, 22), pin(PT, 23), pin(PT, 7), pin(PT, 9), pin(PT, 11), P.ws};
        phase_convert_weights(c, smem, bid, nblk);
        phase_rmsnorm<false>(pin(PT, 0), pin(PT, 1), P.ws + WS_H, bid, nblk);
    }
    GSYNC();
#pragma unroll 1
    for (int l = 0; l < 2; ++l) {
        int bidl = bid; asm volatile("" : "+s"(bidl));
        const float* xin = (l == 0) ? pin(PT, 0) : P.out;
        {
            pg8::Gemm g{(const bf16_t*)(P.ws + WS_H), (const bf16_t*)(P.ws + WS_WTIN) + (size_t)l * DINP * D, NT, DINP, D};
            pg8::StaticOrder S; S.init(NT, DINP, nblk, bidl);
            pg8::Epi<0> E{P.ws + WS_Z, DINP, nullptr};
            pg8::gemm_phase<pg8::Epi<0>, pg8::StaticOrder, true, true>((PG8_LAS unsigned char*)smem, g, S, E);
        }
        GSYNC();
        if (l == 0) {
            const int vb = bidl - (nblk - 64);
            const int l2 = (vb >= 32) ? 1 : 0;
            pg8::Gemm ge{(const bf16_t*)(P.ws + WS_SKBD) + (size_t)l2 * 2048 * 2048, (const bf16_t*)(P.ws + WS_WTQ) + (size_t)l2 * D * 2048, 2048, D, 2048};
            pg8::StaticOrder S; S.init(2048, D, 32, vb < 0 ? -1 : (vb & 31));
            pg8::Epi<0> E{(bf16_t*)(P.ws + WS_WEFF) + (size_t)l2 * 2048 * D, D, nullptr};
            pg8::gemm_phase<pg8::Epi<0>, pg8::StaticOrder, false, true>((PG8_LAS unsigned char*)smem, ge, S, E);
        }
        RwP rw = make_rwp(P, PT, l);
        LinP lp{(const bf16_t*)(P.ws + WS_Z), (bf16_t*)(P.ws + WS_O), pin(PT, 17) + (size_t)l * 16 * 192, pin(PT, 18) + l * 192, pin(PT, 19) + l * 384, (const float*)(P.ws + WS_ROPE), P.ws + WS_LIN};
        for (int task = bidl; task < 256 + 1024; task += nblk) {
            if (task < 256) rwkv_prep_task(rw, smem, task);
            else lin_kv_dispatch(lp, smem, task - 256);
        }
        GSYNC();
        {
            CvP cvp{pin(PT, 22), pin(PT, 23), P.ws};
            const int nsb = nblk < NSCAN ? nblk : NSCAN;
            for (int task = bidl; task < NSCAN; task += nblk) {
                const int bh = task / 10, r = task % 10;
                const int seg = r < 2 ? 0 : (r < 6 ? 1 : 2), grp = r < 2 ? r : (r < 6 ? r - 2 : r - 6);
                rwkv_scan_task(rw, smem, bh, seg, grp, cvp, l == 0 && task == bidl, bidl * 4, nsb * 4);
            }
            if (l == 0) {
                const int lane = otid() & 63, gw = bidl * NW + (otid() >> 6), ngw = nblk * NW;
                for (int r = 85 * 4 * nsb + gw; r < 4 * NEXP; r += ngw) convert_uv_row(cvp, r, lane);
            }
            unsigned* lflags = (unsigned*)(P.ws + WS_FLAGS) + l * 32;
            if (nblk > NSCAN) { if (bidl >= NSCAN) lin_scan_phase(lp, bidl - NSCAN, nblk - NSCAN, lflags); }
            else lin_scan_phase(lp, bidl, nblk, lflags);
        }
        GSYNC();
        phase_rwkv_chain(rw, bidl, nblk);
        GSYNC();
        phase_rwkv_post(rw, bidl, nblk);
        for (int pair = bidl; pair < 1024; pair += nblk) lin_out_dispatch(lp, smem, pair, nullptr);
        GSYNC();
        {
            pg8::Gemm g{(const bf16_t*)(P.ws + WS_O), (const bf16_t*)(P.ws + WS_WTOUT) + (size_t)l * D * D, NT, D, D};
            pg8::StaticOrder S; S.init(NT, D, nblk, bidl);
            pg8::Epi<2> E{P.out, D, xin};
            pg8::gemm_phase<pg8::Epi<2>, pg8::StaticOrder, false, true>((PG8_LAS unsigned char*)smem, g, S, E);
        }
        GSYNC();
        phase_rmsnorm<false>(P.out, pin(PT, 2) + l * D, P.ws + WS_H, bidl, nblk);
        GSYNC();
        {
            pg8::Gemm g{(const bf16_t*)(P.ws + WS_WEFF) + (size_t)l * 2048 * D, (const bf16_t*)(P.ws + WS_H), 2048, NT, D};
            pg8::StaticOrder S; S.init(2048, NT, nblk, bidl);
            pg8::Epi<1> E{P.ws + WS_MIX, NT, nullptr};
            pg8::gemm_phase<pg8::Epi<1>, pg8::StaticOrder, true, true>((PG8_LAS unsigned char*)smem, g, S, E);
        }
        GSYNC();
        phase_topk((const float*)(P.ws + WS_MIX), (int*)(P.ws + WS_EIDX), (float*)(P.ws + WS_GATE), smem, bidl, nblk);
        GSYNC();
        if (l == 0) phase_expert<0>((const bf16_t*)(P.ws + WS_H), P.ws + WS_UB + (size_t)l * NEXP * 512, P.ws + WS_VB + (size_t)l * NEXP * 512,
                     (const float*)(P.ws + WS_ESC) + l * NEXP, (const float*)(P.ws + WS_ESC) + (2 + l) * NEXP,
                     (const int*)(P.ws + WS_EIDX), (const float*)(P.ws + WS_GATE), P.out, P.out, pin(PT, 1) + D, (bf16_t*)(P.ws + WS_H), bidl, nblk);
        else phase_expert<1>((const bf16_t*)(P.ws + WS_H), P.ws + WS_UB + (size_t)l * NEXP * 512, P.ws + WS_VB + (size_t)l * NEXP * 512,
                     (const float*)(P.ws + WS_ESC) + l * NEXP, (const float*)(P.ws + WS_ESC) + (2 + l) * NEXP,
                     (const int*)(P.ws + WS_EIDX), (const float*)(P.ws + WS_GATE), P.out, P.out, pin(PT, 3), nullptr, bidl, nblk);
        if (l == 0) GSYNC();
    }
}

extern "C" void kernel_launch(void* const* d_in, const int* in_sizes, int n_in, void* d_out, int out_size, void* d_ws, size_t ws_size, hipStream_t stream) {
    static int grid = 0;
    if (grid == 0) {
        if (n_in != 24 || ws_size < WS_END) { fprintf(stderr, "kernel_launch: bad args n_in=%d ws=%zu need=%zu\n", n_in, ws_size, (size_t)WS_END); grid = -1; return; }
        int dev = 0, cus = 0, per_cu = 0;
        hipGetDevice(&dev);
        hipDeviceGetAttribute(&cus, hipDeviceAttributeMultiprocessorCount, dev);
        hipFuncSetAttribute((const void*)mega_fwd, hipFuncAttributeMaxDynamicSharedMemorySize, LDS_BYTES);
        hipOccupancyMaxActiveBlocksPerMultiprocessor(&per_cu, (const void*)mega_fwd, NTHREADS, LDS_BYTES);
        if (per_cu < 1) { fprintf(stderr, "kernel_launch: occupancy query says %d\n", per_cu); grid = -1; return; }
        if (per_cu > 1) per_cu = 1;
        grid = cus * per_cu;
        fprintf(stderr, "kernel_launch: grid %d (%d CUs x %d)\n", grid, cus, per_cu);
    }
    if (grid < 0) return;
    hipMemsetAsync((char*)d_ws + WS_CTL, 0, 32768, stream);
    Params P{};
    for (int i = 0; i < 24; ++i) P.in[i] = (const float*)d_in[i];
    P.out = (float*)d_out; P.ws = (unsigned char*)d_ws;
    void* args[] = {&P};
    hipError_t e = hipLaunchCooperativeKernel((const void*)mega_fwd, dim3(grid), dim3(NTHREADS), args, LDS_BYTES, stream);
    if (e != hipSuccess) fprintf(stderr, "cooperative launch failed: %s (grid %d)\n", hipGetErrorString(e), grid);
}
```

```cpp
#include <hip/hip_runtime.h>
#include <stdint.h>
#include <stdio.h>

typedef unsigned short bf16_t;
typedef short bf16x8 __attribute__((ext_vector_type(8)));
typedef float f32x4 __attribute__((ext_vector_type(4)));
typedef unsigned u32x4 __attribute__((ext_vector_type(4)));
typedef unsigned u32x2 __attribute__((ext_vector_type(2)));

constexpr int NB = 4, NS = 4096, NT = NB * NS, D = 1024, DIN = 3600, DINP = 3840;
constexpr int ZC_RET = 0, ZC_RW = 1024, ZC_GLA = 2432;
constexpr int RW_F = 1408;
constexpr int NEXP = 16384;
constexpr int NTHREADS = 512;
constexpr int NW = NTHREADS / 64;

constexpr size_t MiB = 1024ull * 1024ull;
constexpr size_t WS_CTL   = 0;
constexpr size_t WS_LORA  = 65536;
constexpr size_t LORA_L   = 384ull * 256 * 2;
constexpr size_t WS_ESC   = 524288;
constexpr size_t WS_WTIN  = 1 * MiB;
constexpr size_t WS_WTOUT = WS_WTIN + 2ull * DINP * D * 2;
constexpr size_t WS_WTQ   = WS_WTOUT + 2ull * D * D * 2;
constexpr size_t WS_SK    = WS_WTQ + 2ull * 2048 * D * 2;
constexpr size_t WS_UB    = WS_SK + 2ull * 16 * 128 * 128 * 2;
constexpr size_t WS_VB    = WS_UB + 2ull * NEXP * D;
constexpr size_t WS_LIN   = WS_VB + 2ull * NEXP * D;
constexpr size_t WS_H     = WS_LIN + 64 * MiB;
constexpr size_t WS_Z     = WS_H + (size_t)NT * D * 2;
constexpr size_t WS_O     = WS_Z + (size_t)NT * DINP * 2;
constexpr size_t WS_MIX   = WS_O + (size_t)NT * D * 2;
constexpr size_t WS_EIDX  = WS_MIX + 128 * MiB;
constexpr size_t WS_GATE  = WS_EIDX + (size_t)NT * 128 * 4;
constexpr size_t WS_ROPE  = WS_GATE + (size_t)NT * 128 * 4;
constexpr size_t WS_WEFF  = WS_ROPE + 1 * MiB;
constexpr size_t WS_SKBD  = WS_WEFF + 2ull * 2048 * D * 2;
constexpr size_t WS_END   = WS_SKBD + 2ull * 8 * 256 * 256 * 2;
constexpr size_t RWA = (size_t)NT * 384;
constexpr size_t MX_W   = 0;
constexpr size_t MX_KK  = MX_W + RWA * 4;
constexpr size_t MX_KKA = MX_KK + RWA * 4;
constexpr size_t MX_R   = MX_KKA + RWA * 4;
constexpr size_t MX_K   = MX_R + RWA * 2;
constexpr size_t MX_V   = MX_K + RWA * 2;
constexpr size_t MX_G   = MX_V + RWA * 2;
constexpr size_t MX_END = MX_G + RWA * 2;
static_assert(MX_END <= 128 * MiB, "mix region");

__device__ __forceinline__ float bf2f(bf16_t v) { return __uint_as_float(((unsigned)v) << 16); }
__device__ __forceinline__ bf16_t f2bf(float f) { unsigned u = __float_as_uint(f); u += 0x7FFFu + ((u >> 16) & 1u); return (bf16_t)(u >> 16); }
__device__ __forceinline__ unsigned pk2(float lo, float hi) { return (unsigned)f2bf(lo) | ((unsigned)f2bf(hi) << 16); }
__device__ __forceinline__ float lo_bf(unsigned u) { return __uint_as_float(u << 16); }
__device__ __forceinline__ float hi_bf(unsigned u) { return __uint_as_float(u & 0xFFFF0000u); }
template <int CTRL> __device__ __forceinline__ float dpp_f(float v) { return __int_as_float(__builtin_amdgcn_update_dpp(0, __float_as_int(v), CTRL, 0xF, 0xF, true)); }
template <int CTRL> __device__ __forceinline__ unsigned dpp_u(unsigned v) { return (unsigned)__builtin_amdgcn_update_dpp(0, (int)v, CTRL, 0xF, 0xF, true); }
__device__ __forceinline__ float row16_sum(float v) { v += dpp_f<0x128>(v); v += dpp_f<0x124>(v); v += dpp_f<0x122>(v); v += dpp_f<0x121>(v); return v; }
__device__ __forceinline__ float xor16_sum(float v) { auto r = __builtin_amdgcn_permlane16_swap(__float_as_uint(v), __float_as_uint(v), false, false); return __uint_as_float(r[0]) + __uint_as_float(r[1]); }
__device__ __forceinline__ float xor32_sum(float v) { auto r = __builtin_amdgcn_permlane32_swap(__float_as_uint(v), __float_as_uint(v), false, false); return __uint_as_float(r[0]) + __uint_as_float(r[1]); }
__device__ __forceinline__ float wave_sum(float v) { return xor32_sum(xor16_sum(row16_sum(v))); }
__device__ __forceinline__ unsigned umax_(unsigned a, unsigned b) { return a > b ? a : b; }
__device__ __forceinline__ unsigned wave_max_u32(unsigned v) {
    v = umax_(v, dpp_u<0x128>(v)); v = umax_(v, dpp_u<0x124>(v)); v = umax_(v, dpp_u<0x122>(v)); v = umax_(v, dpp_u<0x121>(v));
    { auto r = __builtin_amdgcn_permlane16_swap(v, v, false, false); v = umax_(r[0], r[1]); }
    { auto r = __builtin_amdgcn_permlane32_swap(v, v, false, false); v = umax_(r[0], r[1]); }
    return v;
}
__device__ __forceinline__ float sigmoidf_(float x) { return 1.f / (1.f + __expf(-x)); }
__device__ __forceinline__ float softplusf_(float x) { return fmaxf(x, 0.f) + __logf(1.f + __expf(-fabsf(x))); }
__device__ __forceinline__ float tanhf_(float x) { const float e = __expf(2.f * fminf(fmaxf(x, -15.f), 15.f)); return (e - 1.f) / (e + 1.f); }

__device__ __forceinline__ int otid() { int t = threadIdx.x; asm volatile("" : "+v"(t)); return t; }

constexpr size_t WS_FLAGS = 16384;
__device__ __forceinline__ void flag_signal(unsigned* f, unsigned inc = 1u) {
    asm volatile("s_waitcnt vmcnt(0)" ::: "memory");
    __syncthreads();
    if (threadIdx.x == 0) {
        __builtin_amdgcn_fence(__ATOMIC_RELEASE, "agent");
        asm volatile("s_waitcnt vmcnt(0)" ::: "memory");
        __hip_atomic_fetch_add(f, inc, __ATOMIC_RELAXED, __HIP_MEMORY_SCOPE_AGENT);
    }
}
__device__ __forceinline__ void flag_wait(unsigned* f, unsigned need) {
    if (threadIdx.x == 0) {
        unsigned sp = 0;
        while (__hip_atomic_load(f, __ATOMIC_RELAXED, __HIP_MEMORY_SCOPE_AGENT) < need) { __builtin_amdgcn_s_sleep(4); if (++sp > (1u << 22)) break; }
        __builtin_amdgcn_fence(__ATOMIC_ACQUIRE, "agent");
        asm volatile("s_waitcnt vmcnt(0)" ::: "memory");
    }
    __syncthreads();
}

__device__ void transpose_tile(const float* __restrict__ W, int K, int N, bf16_t* __restrict__ Wt, int kt, int nt, float* tile  ) {
    const int tid = otid();
    const int k0 = kt * 64, n0 = nt * 64;
    if (tid < 256)
#pragma unroll
    for (int i = 0; i < 4; ++i) {
        const int k = i * 16 + (tid >> 4), n4 = (tid & 15) * 4;
        f32x4 v = (f32x4){0.f, 0.f, 0.f, 0.f};
        if (n0 + n4 < N) v = *(const f32x4*)(W + (size_t)(k0 + k) * N + n0 + n4);
        tile[k * 65 + n4] = v.x; tile[k * 65 + n4 + 1] = v.y; tile[k * 65 + n4 + 2] = v.z; tile[k * 65 + n4 + 3] = v.w;
    }
    __syncthreads();
    if (tid < 256) {
        const int n = tid >> 2, kc = (tid & 3) * 16;
        unsigned w[8];
#pragma unroll
        for (int j = 0; j < 8; ++j) w[j] = pk2(tile[(kc + 2 * j) * 65 + n], tile[(kc + 2 * j + 1) * 65 + n]);
        u32x4* dst = (u32x4*)(Wt + (size_t)(n0 + n) * K + k0 + kc);
        dst[0] = (u32x4){w[0], w[1], w[2], w[3]}; dst[1] = (u32x4){w[4], w[5], w[6], w[7]};
    }
    __syncthreads();
}

struct ConvP {
    const float* w_in; const float* w_out; const float* w_q; const float* sk; const float* u; const float* v;
    const float* w_up; const float* a_up; const float* g_up;
    unsigned char* ws;
};

__device__ void phase_convert_weights(const ConvP& p, char* smem, int bid, int nblk) {
    float* tile = (float*)smem;
    constexpr int T_IN = 16 * 60, T_OUT = 16 * 16, T_L = T_IN + T_OUT;
    for (int it = bid; it < 2 * T_L; it += nblk) {
        const int l = it / T_L; int r = it % T_L;
        if (r < T_IN) { transpose_tile(p.w_in + (size_t)l * D * DIN, D, DIN, (bf16_t*)(p.ws + WS_WTIN) + (size_t)l * DINP * D, r / 60, r % 60, tile); continue; }
        r -= T_IN;
        transpose_tile(p.w_out + (size_t)l * D * D, D, D, (bf16_t*)(p.ws + WS_WTOUT) + (size_t)l * D * D, r / 16, r % 16, tile);
    }
    const size_t gtid = (size_t)bid * NTHREADS + otid(), gn = (size_t)nblk * NTHREADS;
    {
        u32x4* d = (u32x4*)(p.ws + WS_SKBD);
        for (size_t i = gtid; i < 2ull * 8 * 256 * 256 / 8; i += gn) {
            const size_t lp = i / (256 * 32), r = (i / 32) % 256, c8 = (i % 32) * 8;
            u32x4 o = (u32x4){0u, 0u, 0u, 0u};
            if ((c8 >> 7) == (r >> 7)) {
                const f32x4* sp = (const f32x4*)(p.sk + ((lp * 256 + r) * 128 + (c8 & 127)));
                const f32x4 a = sp[0], b = sp[1];
                o.x = pk2(a.x, a.y); o.y = pk2(a.z, a.w); o.z = pk2(b.x, b.y); o.w = pk2(b.z, b.w);
            }
            d[i] = o;
        }
    }
    {
        for (size_t i = gtid; i < 2ull * 384 * 256; i += gn) {
            const int l = (int)(i / (384 * 256)), r = (int)(i % (384 * 256)), c = r >> 8, k = r & 255;
            bf16_t* base = (bf16_t*)(p.ws + WS_LORA + l * LORA_L);
            if (k < 64) base[c * 64 + k] = f2bf(p.w_up[(size_t)l * 64 * 384 + k * 384 + c]);
            else if (k < 128) base[384 * 64 + c * 64 + (k - 64)] = f2bf(p.a_up[(size_t)l * 64 * 384 + (k - 64) * 384 + c]);
            else base[2 * 384 * 64 + c * 128 + (k - 128)] = f2bf(p.g_up[(size_t)l * 128 * 384 + (k - 128) * 384 + c]);
        }
    }
    {
        float* ct = (float*)(p.ws + WS_ROPE); float* stb = ct + NS * 32;
        for (size_t i = gtid; i < (size_t)NS * 32; i += gn) {
            const int pos = (int)(i >> 5), fi = (int)(i & 31);
            const float inv = exp2f(-(float)fi * (13.287712379549449f / 32.f));
            float sn, cs; sincosf((float)pos * inv, &sn, &cs);
            ct[i] = cs; stb[i] = sn;
        }
    }
    {
        const size_t n8 = (2ull * D * 2048) / 8;
        const f32x4* s = (const f32x4*)p.w_q; u32x4* d = (u32x4*)(p.ws + WS_WTQ);
        for (size_t i = gtid; i < n8; i += gn) {
            f32x4 a = s[2 * i], b = s[2 * i + 1]; u32x4 o; o.x = pk2(a.x, a.y); o.y = pk2(a.z, a.w); o.z = pk2(b.x, b.y); o.w = pk2(b.z, b.w);
            const size_t e = i * 8, l = e / ((size_t)D * 2048), k = (e / 2048) % D, n = e % 2048;
            d[(((l * 8 + (n >> 8)) * D + k) * 256 + (n & 255)) / 8] = o;
        }
    }
    {
        const size_t n8 = (2ull * 16 * 128 * 128) / 8;
        const f32x4* s = (const f32x4*)p.sk; u32x4* d = (u32x4*)(p.ws + WS_SK);
        for (size_t i = gtid; i < n8; i += gn) { f32x4 a = s[2 * i], b = s[2 * i + 1]; u32x4 o; o.x = pk2(a.x, a.y); o.y = pk2(a.z, a.w); o.z = pk2(b.x, b.y); o.w = pk2(b.z, b.w); d[i] = o; }
    }
}

struct CvP { const float* u; const float* v; unsigned char* ws; };
__device__ __forceinline__ void convert_uv_row(const CvP& p, int r, int lane) {
    {
        {
            const bool isv = r >= 2 * NEXP; const int rr = isv ? r - 2 * NEXP : r;
            const f32x4* src = (const f32x4*)((isv ? p.v : p.u) + (size_t)rr * D) + lane * 4;
            f32x4 x[4]; float mx = 0.f;
#pragma unroll
            for (int i = 0; i < 4; ++i) { x[i] = src[i]; mx = fmaxf(mx, fmaxf(fmaxf(fabsf(x[i].x), fabsf(x[i].y)), fmaxf(fabsf(x[i].z), fabsf(x[i].w)))); }
            mx = __uint_as_float(wave_max_u32(__float_as_uint(mx)));
            const float sc = mx > 0.f ? 6.f / mx : 0.f;
            unsigned w0 = 0u, w1 = 0u;
            w0 = __builtin_amdgcn_cvt_scalef32_pk_fp4_f32(w0, x[0].x * sc, x[0].y * sc, 1.0f, 0); w0 = __builtin_amdgcn_cvt_scalef32_pk_fp4_f32(w0, x[0].z * sc, x[0].w * sc, 1.0f, 1);
            w0 = __builtin_amdgcn_cvt_scalef32_pk_fp4_f32(w0, x[1].x * sc, x[1].y * sc, 1.0f, 2); w0 = __builtin_amdgcn_cvt_scalef32_pk_fp4_f32(w0, x[1].z * sc, x[1].w * sc, 1.0f, 3);
            w1 = __builtin_amdgcn_cvt_scalef32_pk_fp4_f32(w1, x[2].x * sc, x[2].y * sc, 1.0f, 0); w1 = __builtin_amdgcn_cvt_scalef32_pk_fp4_f32(w1, x[2].z * sc, x[2].w * sc, 1.0f, 1);
            w1 = __builtin_amdgcn_cvt_scalef32_pk_fp4_f32(w1, x[3].x * sc, x[3].y * sc, 1.0f, 2); w1 = __builtin_amdgcn_cvt_scalef32_pk_fp4_f32(w1, x[3].z * sc, x[3].w * sc, 1.0f, 3);
            *(u32x2*)(p.ws + WS_UB + (size_t)rr * 1024 + (isv ? 512 : 0) + lane * 8) = (u32x2){w0, w1};
            if (lane == 0) ((float*)(p.ws + WS_ESC))[r] = mx * (1.f / 6.f);
        }
    }
}
__device__ void phase_convert_uv(const ConvP& p, int bid, int nblk) {
    const int lane = otid() & 63, gw = bid * NW + (otid() >> 6), ngw = nblk * NW;
    const CvP c{p.u, p.v, p.ws};
    for (int r = gw; r < 4 * NEXP; r += ngw) convert_uv_row(c, r, lane);
}

template <bool OUT_F32>
__device__ void phase_rmsnorm(const float* x, const float* __restrict__ g, void* out, int bid, int nblk) {
    const int lane = otid() & 63, wave = otid() >> 6;
    const int gw = bid * NW + wave, ngw = nblk * NW;
    f32x4 gv[4];
#pragma unroll
    for (int j = 0; j < 4; ++j) gv[j] = ((const f32x4*)g)[lane + 64 * j];
    for (int row = gw; row < NT; row += ngw) {
        const f32x4* xr = (const f32x4*)(x + (size_t)row * D) + lane;
        f32x4 v[4]; float s = 0.f;
#pragma unroll
        for (int j = 0; j < 4; ++j) { v[j] = xr[64 * j]; s += v[j].x * v[j].x + v[j].y * v[j].y + v[j].z * v[j].z + v[j].w * v[j].w; }
        s = wave_sum(s);
        const float rs = rsqrtf(s * (1.f / D) + 1e-6f);
        if (OUT_F32) {
            f32x4* o = (f32x4*)((float*)out + (size_t)row * D) + lane;
#pragma unroll
            for (int j = 0; j < 4; ++j) o[64 * j] = v[j] * rs * gv[j];
        } else {
            u32x2* o = (u32x2*)((bf16_t*)out + (size_t)row * D) + lane;
#pragma unroll
            for (int j = 0; j < 4; ++j) { f32x4 y = v[j] * rs * gv[j]; u32x2 w; w.x = pk2(y.x, y.y); w.y = pk2(y.z, y.w); o[64 * j] = w; }
        }
    }
}

struct GemmP {
    const bf16_t* A; int lda; int a_koff;
    int b_koff;
    const bf16_t* Bt; int ldb; int K;
    int MT, NTl;
    void* C; int ldc; const float* R;
};
constexpr int GS = 72;
template <int MODE, bool NARROW = false>
__device__ void phase_gemm(const GemmP& p, char* smem, int bid, int nblk, int tile0 = 0) {
    bf16_t* As = (bf16_t*)smem;
    bf16_t* Bs = As + 128 * GS;
    const int tid = otid(), lane = tid & 63, wave = tid >> 6;
    const int wr = wave >> 1, wc = wave & 1;
    const int lr = tid >> 3, lc = (tid & 7) * 8;
    const int fl = lane & 15, fq = lane >> 4;
    const int ntiles = NARROW ? p.MT : p.MT * p.NTl;
    const bool act = !NARROW || (__builtin_amdgcn_readfirstlane(wc) == 0);
    for (int tile = bid - tile0 + ((bid < tile0) ? nblk * ((tile0 - bid + nblk - 1) / nblk) : 0); tile < ntiles; tile += nblk) {
        const int mt = NARROW ? tile : tile / p.NTl, nt = NARROW ? p.NTl : tile % p.NTl;
        const bf16_t* Ag = p.A + (size_t)mt * 128 * p.lda + (size_t)nt * p.a_koff + (size_t)lr * p.lda + lc;
        const bf16_t* Bg = p.Bt + (size_t)nt * 128 * p.ldb + (size_t)mt * p.b_koff + (size_t)lr * p.ldb + lc;
        f32x4 acc[4][4];
#pragma unroll
        for (int m = 0; m < 4; ++m)
#pragma unroll
            for (int n = 0; n < 4; ++n) acc[m][n] = (f32x4){0.f, 0.f, 0.f, 0.f};
        u32x4 ra[4], rb[4];
        const int nk = p.K >> 6;
#pragma unroll
        for (int i = 0; i < 4; ++i) { ra[i] = *(const u32x4*)(Ag + (size_t)(32 * i) * p.lda); rb[i] = *(const u32x4*)(Bg + (size_t)(32 * i) * p.ldb); }
        __syncthreads();
#pragma unroll
        for (int i = 0; i < 4; ++i) { *(u32x4*)(As + (lr + 32 * i) * GS + lc) = ra[i]; *(u32x4*)(Bs + (lr + 32 * i) * GS + lc) = rb[i]; }
        if (nk > 1) {
#pragma unroll
            for (int i = 0; i < 4; ++i) { ra[i] = *(const u32x4*)(Ag + (size_t)(32 * i) * p.lda + 64); rb[i] = *(const u32x4*)(Bg + (size_t)(32 * i) * p.ldb + 64); }
        }
        __syncthreads();
        for (int kt = 0; kt < nk; ++kt) {
            const bf16_t* Ac = As + (kt & 1) * (256 * GS); const bf16_t* Bc = Ac + 128 * GS;
            bf16_t* An = As + ((kt & 1) ^ 1) * (256 * GS); bf16_t* Bn = An + 128 * GS;
            if (kt + 1 < nk) {
#pragma unroll
                for (int i = 0; i < 4; ++i) { *(u32x4*)(An + (lr + 32 * i) * GS + lc) = ra[i]; *(u32x4*)(Bn + (lr + 32 * i) * GS + lc) = rb[i]; }
                if (kt + 2 < nk) {
#pragma unroll
                    for (int i = 0; i < 4; ++i) { ra[i] = *(const u32x4*)(Ag + (size_t)(32 * i) * p.lda + (kt + 2) * 64); rb[i] = *(const u32x4*)(Bg + (size_t)(32 * i) * p.ldb + (kt + 2) * 64); }
                }
            }
#pragma unroll
            for (int ks = 0; ks < 2; ++ks) {
                bf16x8 xa[4], wb[4];
                if (act) {
#pragma unroll
                for (int m = 0; m < 4; ++m) xa[m] = *(const bf16x8*)(Ac + (wr * 64 + m * 16 + fl) * GS + ks * 32 + fq * 8);
#pragma unroll
                for (int n = 0; n < (NARROW ? 1 : 4); ++n) wb[n] = *(const bf16x8*)(Bc + (wc * 64 + n * 16 + fl) * GS + ks * 32 + fq * 8);
#pragma unroll
                for (int m = 0; m < 4; ++m)
#pragma unroll
                    for (int n = 0; n < (NARROW ? 1 : 4); ++n) acc[m][n] = (MODE == 3) ? __builtin_amdgcn_mfma_f32_16x16x32_bf16(xa[m], wb[n], acc[m][n], 0, 0, 0)
                                                                                    : __builtin_amdgcn_mfma_f32_16x16x32_bf16(wb[n], xa[m], acc[m][n], 0, 0, 0);
                }
            }
            __syncthreads();
        }
        if (act)
#pragma unroll
        for (int m = 0; m < 4; ++m) {
#pragma unroll
            for (int n = 0; n < (NARROW ? 1 : 4); ++n) {
                const f32x4 a = acc[m][n];
                if (MODE == 3) {
                    const size_t row = (size_t)mt * 128 + wr * 64 + m * 16 + fq * 4;
                    const size_t col = (size_t)nt * 128 + wc * 64 + n * 16 + fl;
                    *(f32x4*)((float*)p.C + col * p.ldc + row) = a;
                } else {
                    const size_t row = (size_t)mt * 128 + wr * 64 + m * 16 + fl;
                    const int col = nt * 128 + wc * 64 + n * 16 + fq * 4;
                    if (MODE == 0) { u32x2 w; w.x = pk2(a.x, a.y); w.y = pk2(a.z, a.w); *(u32x2*)((bf16_t*)p.C + row * p.ldc + col) = w; }
                    else if (MODE == 1) { *(f32x4*)((float*)p.C + row * p.ldc + col) = a; }
                    else { const f32x4 r = *(const f32x4*)(p.R + row * p.ldc + col); *(f32x4*)((float*)p.C + row * p.ldc + col) = r + a; }
                }
            }
        }
    }
}

__device__ __forceinline__ int lds_byte(int r, int c) {
    const int st = (r >> 4) * 2 + (c >> 5), rr = r & 15, cc = c & 31, ob = rr * 64 + cc * 2;
    return st * 1024 + (ob ^ (((ob >> 9) & 1) << 5));
}
__device__ __forceinline__ void stage_rc(int b, int& R, int& C) {
    const int st = b / 1024, sb = b % 1024, swz = sb ^ (((sb >> 9) & 1) << 5);
    R = (st >> 1) * 16 + swz / 64; C = (st & 1) * 32 + (swz % 64) / 2;
}
#define GL_WAIT_V(n) asm volatile("s_waitcnt vmcnt(" #n ")" ::: "memory")
#define GL_BAR() do { asm volatile("s_waitcnt lgkmcnt(0)" ::: "memory"); __builtin_amdgcn_s_barrier(); } while (0)
template <int MODE>
__device__ void phase_gemm_glds(const GemmP& p, char* smem, int bid, int nblk) {
    const int tid = otid(), lane = tid & 63, wave = tid >> 6;
    const int wr = wave >> 1, wc = wave & 1;
    const int fl = lane & 15, fq = lane >> 4;
    const int ntiles = p.MT * p.NTl, nk = p.K >> 6;
    int sr[4], sc[4];
#pragma unroll
    for (int i = 0; i < 4; ++i) stage_rc(tid * 16 + i * 4096, sr[i], sc[i]);
    for (int tile = bid; tile < ntiles; tile += nblk) {
        const int mt = tile / p.NTl, nt = tile % p.NTl;
        const bf16_t* Ag = p.A + (size_t)mt * 128 * p.lda;
        const bf16_t* Bg = p.Bt + (size_t)nt * 128 * p.ldb;
        f32x4 acc[4][4];
#pragma unroll
        for (int m = 0; m < 4; ++m)
#pragma unroll
            for (int n = 0; n < 4; ++n) acc[m][n] = (f32x4){0.f, 0.f, 0.f, 0.f};
        auto stage = [&](int kt, int buf) {
            char* sa = smem + buf * 32768; char* sb = sa + 16384;
#pragma unroll
            for (int i = 0; i < 4; ++i) {
                __builtin_amdgcn_global_load_lds((const unsigned*)(Ag + (size_t)sr[i] * p.lda + kt * 64 + sc[i]), (__attribute__((address_space(3))) unsigned*)(sa + tid * 16 + i * 4096), 16, 0, 0);
                __builtin_amdgcn_global_load_lds((const unsigned*)(Bg + (size_t)sr[i] * p.ldb + kt * 64 + sc[i]), (__attribute__((address_space(3))) unsigned*)(sb + tid * 16 + i * 4096), 16, 0, 0);
            }
        };
        GL_BAR();
        stage(0, 0);
        for (int kt = 0; kt < nk; ++kt) {
            if (kt + 1 < nk) { stage(kt + 1, (kt + 1) & 1); GL_WAIT_V(8); } else { GL_WAIT_V(0); }
            GL_BAR();
            const char* Ac = smem + (kt & 1) * 32768; const char* Bc = Ac + 16384;
#pragma unroll
            for (int ks = 0; ks < 2; ++ks) {
                bf16x8 xa[4], wb[4];
#pragma unroll
                for (int m = 0; m < 4; ++m) xa[m] = *(const bf16x8*)(Ac + lds_byte(wr * 64 + m * 16 + fl, ks * 32 + fq * 8));
#pragma unroll
                for (int n = 0; n < 4; ++n) wb[n] = *(const bf16x8*)(Bc + lds_byte(wc * 64 + n * 16 + fl, ks * 32 + fq * 8));
#pragma unroll
                for (int m = 0; m < 4; ++m)
#pragma unroll
                    for (int n = 0; n < 4; ++n) acc[m][n] = (MODE == 3) ? __builtin_amdgcn_mfma_f32_16x16x32_bf16(xa[m], wb[n], acc[m][n], 0, 0, 0)
                                                                     : __builtin_amdgcn_mfma_f32_16x16x32_bf16(wb[n], xa[m], acc[m][n], 0, 0, 0);
            }
            GL_BAR();
        }
#pragma unroll
        for (int m = 0; m < 4; ++m) {
#pragma unroll
            for (int n = 0; n < 4; ++n) {
                const f32x4 a = acc[m][n];
                if (MODE == 3) {
                    const size_t row = (size_t)mt * 128 + wr * 64 + m * 16 + fq * 4;
                    const size_t col = (size_t)nt * 128 + wc * 64 + n * 16 + fl;
                    *(f32x4*)((float*)p.C + col * p.ldc + row) = a;
                } else {
                    const size_t row = (size_t)mt * 128 + wr * 64 + m * 16 + fl;
                    const int col = nt * 128 + wc * 64 + n * 16 + fq * 4;
                    if (MODE == 0) { u32x2 w; w.x = pk2(a.x, a.y); w.y = pk2(a.z, a.w); *(u32x2*)((bf16_t*)p.C + row * p.ldc + col) = w; }
                    else if (MODE == 1) { *(f32x4*)((float*)p.C + row * p.ldc + col) = a; }
                    else { const f32x4 r = *(const f32x4*)(p.R + row * p.ldc + col); *(f32x4*)((float*)p.C + row * p.ldc + col) = r + a; }
                }
            }
        }
    }
    __syncthreads();
}

template <int MODE>
__device__ void phase_gemm8(const GemmP& p, char* smem, int bid, int nblk, int tile0 = 0) {
    const int tid = otid(), lane = tid & 63, wave = tid >> 6;
    const int wr = wave >> 2, wc = wave & 3;
    const int fl = lane & 15, fq = lane >> 4;
    const int ntiles = p.MT * p.NTl, nk = p.K >> 6;
    int sr[2], sc[2];
#pragma unroll
    for (int i = 0; i < 2; ++i) stage_rc(tid * 16 + i * 8192, sr[i], sc[i]);
    for (int tile = bid - tile0 + ((bid < tile0) ? nblk * ((tile0 - bid + nblk - 1) / nblk) : 0); tile < ntiles; tile += nblk) {
        const int mt = tile / p.NTl, nt = tile % p.NTl;
        const bf16_t* Ag = p.A + (size_t)mt * 128 * p.lda;
        const bf16_t* Bg = p.Bt + (size_t)nt * 256 * p.ldb;
        f32x4 acc[4][4];
#pragma unroll
        for (int m = 0; m < 4; ++m)
#pragma unroll
            for (int n = 0; n < 4; ++n) acc[m][n] = (f32x4){0.f, 0.f, 0.f, 0.f};
        auto stage = [&](int kt, int buf) {
            char* sa = smem + buf * 49152;
#pragma unroll
            for (int i = 0; i < 2; ++i) {
                __builtin_amdgcn_global_load_lds((const unsigned*)(Ag + (size_t)sr[i] * p.lda + kt * 64 + sc[i]), (__attribute__((address_space(3))) unsigned*)(sa + tid * 16 + i * 8192), 16, 0, 0);
                __builtin_amdgcn_global_load_lds((const unsigned*)(Bg + (size_t)sr[i] * p.ldb + kt * 64 + sc[i]), (__attribute__((address_space(3))) unsigned*)(sa + 16384 + tid * 16 + i * 8192), 16, 0, 0);
                __builtin_amdgcn_global_load_lds((const unsigned*)(Bg + (size_t)(128 + sr[i]) * p.ldb + kt * 64 + sc[i]), (__attribute__((address_space(3))) unsigned*)(sa + 32768 + tid * 16 + i * 8192), 16, 0, 0);
            }
        };
        GL_BAR();
        stage(0, 0);
        for (int kt = 0; kt < nk; ++kt) {
            if (kt + 1 < nk) { stage(kt + 1, (kt + 1) & 1); GL_WAIT_V(6); } else { GL_WAIT_V(0); }
            GL_BAR();
            const char* Ac = smem + (kt & 1) * 49152; const char* Bc = Ac + 16384 + (wc >> 1) * 16384;
#pragma unroll
            for (int ks = 0; ks < 2; ++ks) {
                bf16x8 xa[4], wb[4];
#pragma unroll
                for (int m = 0; m < 4; ++m) xa[m] = *(const bf16x8*)(Ac + lds_byte(wr * 64 + m * 16 + fl, ks * 32 + fq * 8));
#pragma unroll
                for (int n = 0; n < 4; ++n) wb[n] = *(const bf16x8*)(Bc + lds_byte((wc & 1) * 64 + n * 16 + fl, ks * 32 + fq * 8));
#pragma unroll
                for (int m = 0; m < 4; ++m)
#pragma unroll
                    for (int n = 0; n < 4; ++n) acc[m][n] = __builtin_amdgcn_mfma_f32_16x16x32_bf16(wb[n], xa[m], acc[m][n], 0, 0, 0);
            }
            GL_BAR();
        }
#pragma unroll
        for (int m = 0; m < 4; ++m) {
#pragma unroll
            for (int n = 0; n < 4; ++n) {
                const f32x4 a = acc[m][n];
                const size_t row = (size_t)mt * 128 + wr * 64 + m * 16 + fl;
                const int col = nt * 256 + wc * 64 + n * 16 + fq * 4;
                if (MODE == 0) { u32x2 w; w.x = pk2(a.x, a.y); w.y = pk2(a.z, a.w); *(u32x2*)((bf16_t*)p.C + row * p.ldc + col) = w; }
                else if (MODE == 1) { *(f32x4*)((float*)p.C + row * p.ldc + col) = a; }
                else { const f32x4 r = *(const f32x4*)(p.R + row * p.ldc + col); *(f32x4*)((float*)p.C + row * p.ldc + col) = r + a; }
            }
        }
    }
    __syncthreads();
}

namespace pg8 {
#define PG8_LAS __attribute__((address_space(3)))
constexpr int BM = 256, BK = 64, HALF = 128, HTB = HALF * BK * 2  , STAGE_BYTES = 8 * HTB, NXCD = 8, WGM = 8;
__device__ __forceinline__ int perm32(int rho) { const int n = rho >> 4, i = rho & 15; return 8 * (i >> 2) + 4 * n + (i & 3); }
struct Unit { int pm, pn; };
struct Gemm { const bf16_t* A; const bf16_t* Bt; int M, N, K; };
struct StaticOrder {
    int nM, nN, nwg, G, c;
    __device__ void init(int M, int N, int G_, int c_) { nM = M / BM; nN = N / BM; nwg = nM * nN; G = G_; c = c_; }
    __device__ bool next(int i, Unit& u) const {
        if (c < 0) return false;
        const long L = (long)i * G + c; if (L >= nwg) return false;
        int wgid = (int)L; { const int q = nwg / NXCD, r = nwg % NXCD, xcd = wgid % NXCD, off = wgid / NXCD; wgid = (xcd < r ? xcd * (q + 1) : r * (q + 1) + (xcd - r) * q) + off; }
        const int nig = WGM * nN, gid = wgid / nig, fm = gid * WGM, gsz = (nM - fm) < WGM ? (nM - fm) : WGM;
        u.pm = fm + ((wgid % nig) % gsz); u.pn = (wgid % nig) / gsz; return true;
    }
    __device__ __forceinline__ void a_ready(const Unit&) const {}
    __device__ __forceinline__ void done(const Unit&) const {}
};
template <int MODE  > struct Epi {
    static constexpr bool PERM = false, AFTER_DRAIN = false;
    void* C; int ldc; const float* R;
    __device__ __forceinline__ void operator()(const f32x4 (&acc)[2][2][4][2], const Unit& u, int wr, int wc, int fr, int fq) const {
#pragma unroll
        for (int ai = 0; ai < 2; ++ai)
#pragma unroll
            for (int m = 0; m < 4; ++m) {
                const size_t row = (size_t)u.pm * BM + ai * HALF + wr * 64 + m * 16 + fr;
#pragma unroll
                for (int bj = 0; bj < 2; ++bj)
#pragma unroll
                    for (int n = 0; n < 2; ++n) {
                        const int col = u.pn * BM + bj * HALF + wc * 32 + n * 16 + fq * 4;
                        const f32x4 a = acc[ai][bj][m][n];
                        if (MODE == 0) { u32x2 w; w.x = pk2(a.x, a.y); w.y = pk2(a.z, a.w); *(u32x2*)((bf16_t*)C + row * ldc + col) = w; }
                        else if (MODE == 1) { *(f32x4*)((float*)C + row * ldc + col) = a; }
                        else { const f32x4 r = *(const f32x4*)(R + row * ldc + col); *(f32x4*)((float*)C + row * ldc + col) = r + a; }
                    }
            }
    }
};
template <class Epi, class Sched, bool ALIGN_EPI = false, bool SP2 = false>
__device__ __forceinline__ void gemm_phase(PG8_LAS unsigned char* lds, const Gemm g, const Sched& S, const Epi& E) {
    const int tid = otid(), wid = __builtin_amdgcn_readfirstlane(tid >> 6), lane = tid & 63, wr = wid >> 2, wc = wid & 3, fr = lane & 15, fq = lane >> 4;
    const int K = g.K, nt = K / BK;
    unsigned voffA[2], voffB[2];
#pragma unroll
    for (int i = 0; i < 2; ++i) { int R, C; stage_rc(tid * 16 + i * 8192, R, C); const int Rb = Epi::PERM ? ((R & ~31) + perm32(R & 31)) : R;
        voffA[i] = (unsigned)(R * K + C) * 2u; voffB[i] = (unsigned)(Rb * K + C) * 2u; }
    const size_t kstep = (size_t)(BK * 2);
    const size_t hstep = (size_t)HALF * K * 2;
    const size_t tstep = 2 * hstep;
    const unsigned ldsw = (unsigned)wid * 1024u;
    const int aoff = lds_byte(wr * 64 + fr, fq * 8), boff = lds_byte(wc * 32 + fr, fq * 8);
#define PG8_SA(b, h) (((b) * 2 + (h)) * HTB)
#define PG8_SB(b, h) ((4 + (b) * 2 + (h)) * HTB)
#define PG8_STAGE(bufoff, gbase, voff) do { _Pragma("unroll") for (int _i = 0; _i < 2; ++_i) \
        __builtin_amdgcn_global_load_lds((const unsigned*)((const char*)(gbase) + (voff)[_i]), (PG8_LAS unsigned*)(lds + (bufoff) + ldsw + _i * 8192), 16, 0, 0); } while (0)
#define PG8_LDA(dst, b, h) do { _Pragma("unroll") for (int m = 0; m < 4; ++m) _Pragma("unroll") for (int k = 0; k < 2; ++k) dst[m][k] = *(const PG8_LAS bf16x8*)(lds + PG8_SA(b, h) + aoff + m * 2048 + k * 1024); } while (0)
#define PG8_LDB(dst, b, h) do { _Pragma("unroll") for (int n = 0; n < 2; ++n) _Pragma("unroll") for (int k = 0; k < 2; ++k) dst[n][k] = *(const PG8_LAS bf16x8*)(lds + PG8_SB(b, h) + boff + n * 2048 + k * 1024); } while (0)
#define PG8_MMA(ai, bj, At, Bt) do { __builtin_amdgcn_s_setprio(1); _Pragma("unroll") for (int m = 0; m < 4; ++m) _Pragma("unroll") for (int n = 0; n < 2; ++n) _Pragma("unroll") for (int k = 0; k < 2; ++k) \
        acc[ai][bj][m][n] = __builtin_amdgcn_mfma_f32_16x16x32_bf16(Bt[n][k], At[m][k], acc[ai][bj][m][n], 0, 0, 0); __builtin_amdgcn_s_setprio(0); } while (0)
#define PG8_WAIT_V(n) asm volatile("s_waitcnt vmcnt(" #n ")" ::: "memory")
#define PG8_WAIT_L(n) asm volatile("s_waitcnt lgkmcnt(" #n ")" ::: "memory")
#define PG8_BAR __builtin_amdgcn_s_barrier()
#define PG8_SCHED __builtin_amdgcn_sched_barrier(0)
    Unit cur, nxt; int ui = 0;
    if (!S.next(0, cur)) return;
    f32x4 acc[2][2][4][2];
#pragma unroll
    for (int a = 0; a < 2; ++a)
#pragma unroll
        for (int b = 0; b < 2; ++b)
#pragma unroll
            for (int m = 0; m < 4; ++m)
#pragma unroll
                for (int n = 0; n < 2; ++n) acc[a][b][m][n] = (f32x4){0.f, 0.f, 0.f, 0.f};
    bf16x8 At[4][2], B0[2][2], B1[2][2];
    const char* cA = (const char*)g.A + (size_t)cur.pm * tstep; const char* cB = (const char*)g.Bt + (size_t)cur.pn * tstep;
    S.a_ready(cur);
    if constexpr (SP2) {
        PG8_STAGE(PG8_SB(0, 0), cB, voffB); PG8_STAGE(PG8_SB(0, 1), cB + hstep, voffB); PG8_STAGE(PG8_SA(0, 0), cA, voffA); PG8_STAGE(PG8_SA(0, 1), cA + hstep, voffA);
        if (wr == 1) PG8_BAR;
        PG8_WAIT_V(2); PG8_BAR;
        PG8_STAGE(PG8_SB(1, 0), cB + kstep, voffB); PG8_STAGE(PG8_SA(1, 0), cA + kstep, voffA); PG8_STAGE(PG8_SB(1, 1), cB + hstep + kstep, voffB);
        PG8_WAIT_V(6); PG8_BAR;
    } else {
        PG8_STAGE(PG8_SB(0, 0), cB, voffB); PG8_STAGE(PG8_SA(0, 0), cA, voffA); PG8_STAGE(PG8_SB(0, 1), cB + hstep, voffB); PG8_STAGE(PG8_SA(0, 1), cA + hstep, voffA);
        if (wr == 1) PG8_BAR;
        PG8_WAIT_V(4); PG8_BAR;
        PG8_STAGE(PG8_SB(1, 0), cB + kstep, voffB); PG8_STAGE(PG8_SA(1, 0), cA + kstep, voffA); PG8_STAGE(PG8_SB(1, 1), cB + hstep + kstep, voffB);
        PG8_WAIT_V(6); PG8_BAR;
    }
    for (;;) {
        const bool has_next = S.next(ui + 1, nxt);
        const char* nA = has_next ? (const char*)g.A + (size_t)nxt.pm * tstep : cA; const char* nB = has_next ? (const char*)g.Bt + (size_t)nxt.pn * tstep : cB;
        for (int t = 0; t < nt; t += 2) {
            const bool last = (t == nt - 2);
            const char* a1 = cA + (size_t)(t + 1) * kstep;
            const char* a2 = last ? nA : cA + (size_t)(t + 2) * kstep; const char* b2 = last ? nB : cB + (size_t)(t + 2) * kstep;
            const char* a3 = a2 + kstep; const char* b3 = b2 + kstep;
            if (last && has_next) S.a_ready(nxt);
            if constexpr (SP2) {
            PG8_LDB(B0, 0, 0); PG8_LDB(B1, 0, 1); PG8_SCHED; PG8_LDA(At, 0, 0); PG8_STAGE(PG8_SA(1, 1), a1 + hstep, voffA);
            PG8_WAIT_V(8); PG8_WAIT_L(0); PG8_BAR; PG8_MMA(0, 0, At, B0); PG8_MMA(0, 1, At, B1); PG8_BAR; PG8_SCHED;
            PG8_LDA(At, 0, 1); PG8_STAGE(PG8_SB(0, 0), b2, voffB); PG8_STAGE(PG8_SB(0, 1), b2 + hstep, voffB); PG8_STAGE(PG8_SA(0, 0), a2, voffA);
            PG8_WAIT_V(8); PG8_WAIT_L(0); PG8_BAR; PG8_MMA(1, 0, At, B0); PG8_MMA(1, 1, At, B1); PG8_BAR; PG8_SCHED;
            PG8_LDB(B0, 1, 0); PG8_LDB(B1, 1, 1); PG8_SCHED; PG8_LDA(At, 1, 0); PG8_STAGE(PG8_SA(0, 1), a2 + hstep, voffA);
            PG8_WAIT_V(8); PG8_WAIT_L(0); PG8_BAR; PG8_MMA(0, 0, At, B0); PG8_MMA(0, 1, At, B1); PG8_BAR; PG8_SCHED;
            PG8_LDA(At, 1, 1); PG8_STAGE(PG8_SB(1, 0), b3, voffB); PG8_STAGE(PG8_SB(1, 1), b3 + hstep, voffB); PG8_STAGE(PG8_SA(1, 0), a3, voffA);
            PG8_WAIT_V(8); PG8_WAIT_L(0); PG8_BAR; PG8_MMA(1, 0, At, B0); PG8_MMA(1, 1, At, B1); PG8_BAR; PG8_SCHED;
            } else {
            PG8_LDB(B0, 0, 0); PG8_SCHED; PG8_LDA(At, 0, 0); PG8_STAGE(PG8_SA(1, 1), a1 + hstep, voffA);
            PG8_WAIT_L(8); PG8_BAR; PG8_WAIT_L(0); PG8_MMA(0, 0, At, B0); PG8_BAR; PG8_SCHED;
            PG8_LDB(B1, 0, 1); PG8_STAGE(PG8_SB(0, 0), b2, voffB);
            PG8_BAR; PG8_WAIT_L(0); PG8_MMA(0, 1, At, B1); PG8_BAR;
            PG8_LDA(At, 0, 1); PG8_STAGE(PG8_SA(0, 0), a2, voffA);
            PG8_BAR; PG8_WAIT_L(0); PG8_MMA(1, 0, At, B0); PG8_BAR; PG8_SCHED;
            PG8_STAGE(PG8_SB(0, 1), b2 + hstep, voffB);
            PG8_WAIT_V(6); PG8_BAR; PG8_MMA(1, 1, At, B1); PG8_BAR;
            PG8_LDB(B0, 1, 0); PG8_SCHED; PG8_LDA(At, 1, 0); PG8_STAGE(PG8_SA(0, 1), a2 + hstep, voffA);
            PG8_WAIT_L(8); PG8_BAR; PG8_WAIT_L(0); PG8_MMA(0, 0, At, B0); PG8_BAR; PG8_SCHED;
            PG8_LDB(B1, 1, 1); PG8_STAGE(PG8_SB(1, 0), b3, voffB);
            PG8_BAR; PG8_WAIT_L(0); PG8_MMA(0, 1, At, B1); PG8_BAR;
            PG8_LDA(At, 1, 1); PG8_STAGE(PG8_SA(1, 0), a3, voffA);
            PG8_BAR; PG8_WAIT_L(0); PG8_MMA(1, 0, At, B0); PG8_BAR; PG8_SCHED;
            PG8_STAGE(PG8_SB(1, 1), b3 + hstep, voffB);
            PG8_WAIT_V(6); PG8_BAR; PG8_MMA(1, 1, At, B1); PG8_BAR;
            }
        }
        if constexpr (ALIGN_EPI) { if (wr == 0) PG8_BAR; }
        if constexpr (!Epi::AFTER_DRAIN) { E(acc, cur, wr, wc, fr, fq); S.done(cur); }
        if (!has_next) break;
#pragma unroll
        for (int a = 0; a < 2; ++a)
#pragma unroll
            for (int b = 0; b < 2; ++b)
#pragma unroll
                for (int m = 0; m < 4; ++m)
#pragma unroll
                    for (int n = 0; n < 2; ++n) acc[a][b][m][n] = (f32x4){0.f, 0.f, 0.f, 0.f};
        cur = nxt; cA = nA; cB = nB; ++ui;
        if constexpr (ALIGN_EPI) { if (wr == 1) PG8_BAR; }
    }
    PG8_WAIT_V(0);
    if constexpr (!ALIGN_EPI) { if (wr == 0) PG8_BAR; }
    PG8_BAR;
    if constexpr (Epi::AFTER_DRAIN) { E.fused(acc, cur, wr, wc, fr, fq, lds, wid, lane); S.done(cur); }
#undef PG8_SA
#undef PG8_SB
#undef PG8_STAGE
#undef PG8_LDA
#undef PG8_LDB
#undef PG8_MMA
#undef PG8_WAIT_V
#undef PG8_WAIT_L
#undef PG8_BAR
#undef PG8_SCHED
}
}

constexpr int LS = 72;
struct LinP {
    const bf16_t* Z; bf16_t* O;
    const float* gk_up;
    const float* gk_bias;
    const float* norm_w;
    const float* rope;
    unsigned char* lin;
};
__device__ __forceinline__ bf16x8 ldfrag(const bf16_t* base, int row, int kofs) { return *(const bf16x8*)(base + row * LS + kofs); }

constexpr size_t LN_KV_RET = 0;
constexpr size_t LN_KV_GLA = LN_KV_RET + 1024ull * 64 * 64 * 4;
constexpr size_t LN_S_RET  = LN_KV_GLA + 1024ull * 96 * 64 * 4;
constexpr size_t LN_S_GLA  = LN_S_RET + 1024ull * 64 * 64 * 2;
constexpr size_t LN_DEC    = LN_S_GLA + 1024ull * 96 * 64 * 2;
static_assert(LN_DEC + 2048ull * 64 * 4 <= 64 * MiB, "lin region");

__device__ __forceinline__ float wave_incl_scan(float v) {
    v += dpp_f<0x111>(v); v += dpp_f<0x112>(v); v += dpp_f<0x114>(v); v += dpp_f<0x118>(v);
    v += __int_as_float(__builtin_amdgcn_update_dpp(0, __float_as_int(v), 0x142, 0xA, 0xF, false));
    v += __int_as_float(__builtin_amdgcn_update_dpp(0, __float_as_int(v), 0x143, 0xC, 0xF, false));
    return v;
}
__device__ __forceinline__ float readlane_f(float v, int l) { return __int_as_float(__builtin_amdgcn_readlane(__float_as_int(v), l)); }

__device__ __forceinline__ void rot8(const bf16_t* src, const float* rope, int spos, int cq, unsigned (&o1)[4], unsigned (&o2)[4]) {
    const u32x4 q1 = *(const u32x4*)(src + cq * 8), q2 = *(const u32x4*)(src + 32 + cq * 8);
    const unsigned q1w[4] = {q1.x, q1.y, q1.z, q1.w}, q2w[4] = {q2.x, q2.y, q2.z, q2.w};
    const f32x4 c0 = *(const f32x4*)(rope + spos * 32 + cq * 8), c1 = *(const f32x4*)(rope + spos * 32 + cq * 8 + 4);
    const f32x4 s0 = *(const f32x4*)(rope + NS * 32 + spos * 32 + cq * 8), s1 = *(const f32x4*)(rope + NS * 32 + spos * 32 + cq * 8 + 4);
    const float csv[8] = {c0.x, c0.y, c0.z, c0.w, c1.x, c1.y, c1.z, c1.w}, snv[8] = {s0.x, s0.y, s0.z, s0.w, s1.x, s1.y, s1.z, s1.w};
#pragma unroll
    for (int e = 0; e < 4; ++e) {
        const float a1l = lo_bf(q1w[e]), a1h = hi_bf(q1w[e]), a2l = lo_bf(q2w[e]), a2h = hi_bf(q2w[e]);
        o1[e] = pk2(a1l * csv[2 * e] - a2l * snv[2 * e], a1h * csv[2 * e + 1] - a2h * snv[2 * e + 1]);
        o2[e] = pk2(a1l * snv[2 * e] + a2l * csv[2 * e], a1h * snv[2 * e + 1] + a2h * csv[2 * e + 1]);
    }
}
__device__ __forceinline__ void load_vts(const bf16_t* Z, size_t t0, int voff, int nch, bf16_t* Vts, int tid) {
    for (int x = tid; x < 64 * nch; x += 256) {
        const int tok = x / nch, ch = x % nch;
        const u32x4 vv = *(const u32x4*)(Z + (t0 + tok) * DINP + voff + ch * 8);
        const unsigned w[4] = {vv.x, vv.y, vv.z, vv.w};
#pragma unroll
        for (int e = 0; e < 4; ++e) { Vts[(ch * 8 + 2 * e) * LS + tok] = (bf16_t)(w[e] & 0xFFFFu); Vts[(ch * 8 + 2 * e + 1) * LS + tok] = (bf16_t)(w[e] >> 16); }
    }
}
__device__ __forceinline__ void load_gd(const bf16_t* zr, float (&gd)[16]) {
    const u32x4 g0 = *(const u32x4*)zr, g1 = *(const u32x4*)(zr + 8);
    gd[0] = lo_bf(g0.x); gd[1] = hi_bf(g0.x); gd[2] = lo_bf(g0.y); gd[3] = hi_bf(g0.y); gd[4] = lo_bf(g0.z); gd[5] = hi_bf(g0.z); gd[6] = lo_bf(g0.w); gd[7] = hi_bf(g0.w);
    gd[8] = lo_bf(g1.x); gd[9] = hi_bf(g1.x); gd[10] = lo_bf(g1.y); gd[11] = hi_bf(g1.y); gd[12] = lo_bf(g1.z); gd[13] = hi_bf(g1.z); gd[14] = lo_bf(g1.w); gd[15] = hi_bf(g1.w);
}
__device__ __forceinline__ float gla_gk(const LinP& p, const float (&gd)[16], int h, int d) {
    float x = p.gk_bias[h * 48 + d];
#pragma unroll
    for (int i = 0; i < 16; ++i) x += gd[i] * p.gk_up[i * 192 + h * 48 + d];
    return (fminf(x, 0.f) - __logf(1.f + __expf(-fabsf(x)))) * (1.f / 16.f);
}
__device__ __forceinline__ float ret_lg(int h) { const float e = exp2f(-5.f - (float)h * (4.f / 3.f)); return log1pf(-e); }

constexpr int LIN_HALF_LDS = 57344;
template <bool IS_GLA>
__device__ void lin_kv_task(const LinP& p, char* smem, int b, int h, int c) {
    constexpr int DV = IS_GLA ? 96 : 64, NVB = DV / 16;
    { const int half = otid() >> 8; c += half; smem += half * LIN_HALF_LDS; }
    const int koff = IS_GLA ? (ZC_GLA + 192 + h * 48) : (ZC_RET + 256 + h * 64);
    const int voff = IS_GLA ? (ZC_GLA + 384 + h * 96) : (ZC_RET + 512 + h * 64);
    const int gkdoff = ZC_GLA + 768;
    bf16_t* Ks = (bf16_t*)smem;
    bf16_t* Kts = Ks + 64 * LS;
    bf16_t* Vts = Kts + 64 * LS;
    float* decs = (float*)(Vts + 96 * LS);
    const int tid = otid() & 255, lane = tid & 63, wave = tid >> 6;
    const int fl = lane & 15, fq = lane >> 4;
    const size_t t0 = (size_t)b * NS + (size_t)c * 64;
    const int task = (b * 4 + h) * 64 + c;
    __syncthreads();
    if (IS_GLA) {
        for (int x = tid; x < 64 * 6; x += 256) {
            const int tok = x / 6, ch = x % 6;
            *(u32x4*)(Ks + tok * LS + ch * 8) = *(const u32x4*)(p.Z + (t0 + tok) * DINP + koff + ch * 8);
        }
        for (int x = tid; x < 16 * LS / 2; x += 256) ((unsigned*)(Kts + 48 * LS))[x] = 0u;
        if (tid < 16) decs[48 + tid] = 1.f;
        load_vts(p.Z, t0, voff, 12, Vts, tid);
    } else {
        const int tok = tid >> 2, cq = tid & 3;
        unsigned k1[4], k2[4];
        rot8(p.Z + (t0 + tok) * DINP + koff, p.rope, c * 64 + tok, cq, k1, k2);
        const float fk2 = 0.125f * __expf(ret_lg(h) * (float)(63 - tok));
#pragma unroll
        for (int e = 0; e < 4; ++e) {
            Kts[(cq * 8 + 2 * e) * LS + tok] = f2bf(lo_bf(k1[e]) * fk2); Kts[(cq * 8 + 2 * e + 1) * LS + tok] = f2bf(hi_bf(k1[e]) * fk2);
            Kts[(32 + cq * 8 + 2 * e) * LS + tok] = f2bf(lo_bf(k2[e]) * fk2); Kts[(32 + cq * 8 + 2 * e + 1) * LS + tok] = f2bf(hi_bf(k2[e]) * fk2);
        }
        if (tid < 64) decs[tid] = __expf(ret_lg(h) * 64.f);
        load_vts(p.Z, t0, voff, 8, Vts, tid);
    }
    __syncthreads();
    if (IS_GLA) {
        float gd[16];
        load_gd(p.Z + (t0 + lane) * DINP + gkdoff, gd);
#pragma unroll 1
        for (int dd = 0; dd < 12; ++dd) {
            const int d = wave * 12 + dd;
            const float bc = wave_incl_scan(gla_gk(p, gd, h, d));
            const float bl = readlane_f(bc, 63);
            Kts[d * LS + lane] = f2bf(bf2f(Ks[lane * LS + d]) * __expf(bl - bc));
            if (lane == 0) decs[d] = __expf(bl);
        }
        __syncthreads();
    }
    float* KV = (float*)(p.lin + (IS_GLA ? LN_KV_GLA : LN_KV_RET)) + (size_t)task * DV * 64;
#pragma unroll
    for (int vb = 0; vb < NVB; ++vb) {
        f32x4 a4 = (f32x4){0.f, 0.f, 0.f, 0.f};
#pragma unroll
        for (int ks = 0; ks < 2; ++ks) {
            const bf16x8 a = ldfrag(Kts, 16 * wave + fl, ks * 32 + fq * 8);
            const bf16x8 bv = ldfrag(Vts, 16 * vb + fl, ks * 32 + fq * 8);
            a4 = __builtin_amdgcn_mfma_f32_16x16x32_bf16(a, bv, a4, 0, 0, 0);
        }
        *(f32x4*)(KV + (size_t)(16 * vb + fl) * 64 + 16 * wave + 4 * fq) = a4;
    }
    if (tid < 64) ((float*)(p.lin + LN_DEC))[(size_t)((IS_GLA ? 1024 : 0) + task) * 64 + tid] = decs[tid];
}

__device__ void lin_scan_phase(const LinP& p, int vbid, int nvblk, unsigned* flags) {
    const int tid = otid() & 255, half = otid() >> 8;
    for (int it2 = vbid; it2 < 80; it2 += nvblk) {
        const int it = 2 * it2 + half;
        const bool gla = it >= 64;
        const int r = gla ? it - 64 : it;
        const int per = gla ? 6 : 4, DVx = gla ? 96 : 64;
        const int bh = r / per, e = (r % per) * 1024 + tid;
        const float* KV = (const float*)(p.lin + (gla ? LN_KV_GLA : LN_KV_RET)) + (size_t)bh * 64 * DVx * 64 + e;
        bf16_t* Sb = (bf16_t*)(p.lin + (gla ? LN_S_GLA : LN_S_RET)) + (size_t)bh * 64 * DVx * 64 + e;
        const float* DEC = (const float*)(p.lin + LN_DEC) + (size_t)((gla ? 1024 : 0) + bh * 64) * 64 + (e & 63);
        float S0 = 0.f, S1 = 0.f, S2 = 0.f, S3 = 0.f;
#pragma unroll 8
        for (int c = 0; c < 64; ++c) {
            const size_t o = (size_t)c * DVx * 64;
            const float k0 = KV[o], k1 = KV[o + 256], k2 = KV[o + 512], k3 = KV[o + 768], dc = DEC[c * 64];
            Sb[o] = f2bf(S0); Sb[o + 256] = f2bf(S1); Sb[o + 512] = f2bf(S2); Sb[o + 768] = f2bf(S3);
            S0 = S0 * dc + k0; S1 = S1 * dc + k1; S2 = S2 * dc + k2; S3 = S3 * dc + k3;
        }
        flag_signal(flags + (gla ? 16 : 0) + bh, 2u);
    }
}

template <bool IS_GLA>
__device__ void lin_out_task(const LinP& p, char* smem, int b, int h, int c) {
    constexpr int DV = IS_GLA ? 96 : 64, NVB = DV / 16;
    { const int half = otid() >> 8; c += half; smem += half * LIN_HALF_LDS; }
    const int qoff = IS_GLA ? (ZC_GLA + 0 + h * 48) : (ZC_RET + 0 + h * 64);
    const int koff = IS_GLA ? (ZC_GLA + 192 + h * 48) : (ZC_RET + 256 + h * 64);
    const int voff = IS_GLA ? (ZC_GLA + 384 + h * 96) : (ZC_RET + 512 + h * 64);
    const int goff = IS_GLA ? (ZC_GLA + 784 + h * 96) : (ZC_RET + 768 + h * 64);
    const int gkdoff = ZC_GLA + 768;
    const int ooff = IS_GLA ? (640 + h * 96) : (h * 64);
    bf16_t* Qs = (bf16_t*)smem;
    bf16_t* Ks = Qs + 64 * LS;
    bf16_t* Ps = Ks + 64 * LS;
    bf16_t* Vts = Ps + 64 * LS;
    bf16_t* Sts = Vts + 96 * LS;
    const int tid = otid() & 255, lane = tid & 63, wave = tid >> 6;
    const int fl = lane & 15, fq = lane >> 4;
    const size_t t0 = (size_t)b * NS + (size_t)c * 64;
    const int task = (b * 4 + h) * 64 + c;
    __syncthreads();
    {
        const bf16_t* Sb = (const bf16_t*)(p.lin + (IS_GLA ? LN_S_GLA : LN_S_RET)) + (size_t)task * DV * 64;
        for (int x = tid; x < DV * 8; x += 256) { const int v = x >> 3, ch = x & 7; *(u32x4*)(Sts + v * LS + ch * 8) = *(const u32x4*)(Sb + v * 64 + ch * 8); }
    }
    if (IS_GLA) {
        for (int x = tid; x < 64 * 6; x += 256) {
            const int tok = x / 6, ch = x % 6;
            const bf16_t* zr = p.Z + (t0 + tok) * DINP;
            *(u32x4*)(Qs + tok * LS + ch * 8) = *(const u32x4*)(zr + qoff + ch * 8);
            *(u32x4*)(Ks + tok * LS + ch * 8) = *(const u32x4*)(zr + koff + ch * 8);
        }
        for (int x = tid; x < 64 * 2; x += 256) {
            const int tok = x >> 1, ch = 6 + (x & 1);
            *(u32x4*)(Qs + tok * LS + ch * 8) = (u32x4){0u, 0u, 0u, 0u};
            *(u32x4*)(Ks + tok * LS + ch * 8) = (u32x4){0u, 0u, 0u, 0u};
        }
        load_vts(p.Z, t0, voff, 12, Vts, tid);
    } else {
        const int tok = tid >> 2, cq = tid & 3;
        const bf16_t* zr = p.Z + (t0 + tok) * DINP;
        unsigned q1[4], q2[4], k1[4], k2[4];
        rot8(zr + qoff, p.rope, c * 64 + tok, cq, q1, q2);
        rot8(zr + koff, p.rope, c * 64 + tok, cq, k1, k2);
        const float lg = ret_lg(h);
        const float fqd = __expf(lg * (float)(tok + 1)), fk = 0.125f * __expf(-lg * (float)(tok + 1));
#pragma unroll
        for (int e = 0; e < 4; ++e) {
            q1[e] = pk2(lo_bf(q1[e]) * fqd, hi_bf(q1[e]) * fqd); q2[e] = pk2(lo_bf(q2[e]) * fqd, hi_bf(q2[e]) * fqd);
            k1[e] = pk2(lo_bf(k1[e]) * fk, hi_bf(k1[e]) * fk); k2[e] = pk2(lo_bf(k2[e]) * fk, hi_bf(k2[e]) * fk);
        }
        *(u32x4*)(Qs + tok * LS + cq * 8) = (u32x4){q1[0], q1[1], q1[2], q1[3]};
        *(u32x4*)(Qs + tok * LS + 32 + cq * 8) = (u32x4){q2[0], q2[1], q2[2], q2[3]};
        *(u32x4*)(Ks + tok * LS + cq * 8) = (u32x4){k1[0], k1[1], k1[2], k1[3]};
        *(u32x4*)(Ks + tok * LS + 32 + cq * 8) = (u32x4){k2[0], k2[1], k2[2], k2[3]};
        load_vts(p.Z, t0, voff, 8, Vts, tid);
    }
    __syncthreads();
    if (IS_GLA) {
        float gd[16];
        load_gd(p.Z + (t0 + lane) * DINP + gkdoff, gd);
#pragma unroll 1
        for (int dd = 0; dd < 12; ++dd) {
            const int d = wave * 12 + dd;
            const float bc = wave_incl_scan(gla_gk(p, gd, h, d));
            const float eq = __expf(bc) * 0.14433756729740643f  , ek = __expf(-bc);
            Qs[lane * LS + d] = f2bf(bf2f(Qs[lane * LS + d]) * eq);
            Ks[lane * LS + d] = f2bf(bf2f(Ks[lane * LS + d]) * ek);
        }
        __syncthreads();
    }
#pragma unroll
    for (int jb = 0; jb < 4; ++jb) {
        f32x4 ap = (f32x4){0.f, 0.f, 0.f, 0.f};
#pragma unroll
        for (int ks = 0; ks < 2; ++ks) {
            const bf16x8 a = ldfrag(Ks, 16 * jb + fl, ks * 32 + fq * 8);
            const bf16x8 bq = ldfrag(Qs, 16 * wave + fl, ks * 32 + fq * 8);
            ap = __builtin_amdgcn_mfma_f32_16x16x32_bf16(a, bq, ap, 0, 0, 0);
        }
        const int i = 16 * wave + fl, j0 = 16 * jb + 4 * fq;
        u32x2 w;
        w.x = pk2(j0 + 0 <= i ? ap.x : 0.f, j0 + 1 <= i ? ap.y : 0.f);
        w.y = pk2(j0 + 2 <= i ? ap.z : 0.f, j0 + 3 <= i ? ap.w : 0.f);
        *(u32x2*)(Ps + i * LS + j0) = w;
    }
    __syncthreads();
    {
        f32x4 ao[NVB];
        float ss = 0.f;
#pragma unroll
        for (int vb = 0; vb < NVB; ++vb) {
            f32x4 a4 = (f32x4){0.f, 0.f, 0.f, 0.f};
#pragma unroll
            for (int ks = 0; ks < 2; ++ks) {
                const bf16x8 a = ldfrag(Vts, 16 * vb + fl, ks * 32 + fq * 8);
                const bf16x8 bp = ldfrag(Ps, 16 * wave + fl, ks * 32 + fq * 8);
                a4 = __builtin_amdgcn_mfma_f32_16x16x32_bf16(a, bp, a4, 0, 0, 0);
            }
#pragma unroll
            for (int ks = 0; ks < 2; ++ks) {
                const bf16x8 a = ldfrag(Sts, 16 * vb + fl, ks * 32 + fq * 8);
                const bf16x8 bq = ldfrag(Qs, 16 * wave + fl, ks * 32 + fq * 8);
                a4 = __builtin_amdgcn_mfma_f32_16x16x32_bf16(a, bq, a4, 0, 0, 0);
            }
            ao[vb] = a4;
            ss += a4.x * a4.x + a4.y * a4.y + a4.z * a4.z + a4.w * a4.w;
        }
        ss = xor32_sum(xor16_sum(ss));
        const float inv = rsqrtf(ss * (1.f / DV) + 1e-5f);
        const size_t t = t0 + 16 * wave + fl;
#pragma unroll
        for (int vb = 0; vb < NVB; ++vb) {
            const int v0 = 16 * vb + 4 * fq;
            const u32x2 gg = *(const u32x2*)(p.Z + t * DINP + goff + v0);
            float g4[4] = {lo_bf(gg.x), hi_bf(gg.x), lo_bf(gg.y), hi_bf(gg.y)};
            float o4[4] = {ao[vb].x, ao[vb].y, ao[vb].z, ao[vb].w};
#pragma unroll
            for (int e = 0; e < 4; ++e) {
                float y = o4[e] * inv;
                if (IS_GLA) y *= p.norm_w[h * 96 + v0 + e];
                const float g = g4[e];
                o4[e] = y * (g / (1.f + __expf(-g)));
            }
            u32x2 w; w.x = pk2(o4[0], o4[1]); w.y = pk2(o4[2], o4[3]);
            *(u32x2*)(p.O + t * D + ooff + v0) = w;
        }
    }
}
__device__ __forceinline__ void lin_kv_dispatch(const LinP& p, char* smem, int pair) {
    const int task = 2 * pair;
    const int r = task & 1023, bh = r >> 6, c = r & 63;
    if (task < 1024) lin_kv_task<false>(p, smem, bh >> 2, bh & 3, c); else lin_kv_task<true>(p, smem, bh >> 2, bh & 3, c);
}
__device__ __forceinline__ void lin_out_dispatch(const LinP& p, char* smem, int pair, unsigned* flags) {
    const int task = 2 * pair;
    const int r = task & 1023, bh = r >> 6, c = r & 63;
    if (flags) flag_wait(flags + (task < 1024 ? 0 : 16) + bh, task < 1024 ? 4u : 6u);
    if (task < 1024) lin_out_task<false>(p, smem, bh >> 2, bh & 3, c); else lin_out_task<true>(p, smem, bh >> 2, bh & 3, c);
}

struct RwP {
    const bf16_t* Z; unsigned char* mix;
    const float* mu; const float* w_up; const float* w_bias; const float* a_up; const float* a_bias; const float* g_up;
    const float* k_k; const float* k_a; const float* r_k; const float* ln_w; const float* ln_b;
    float* oraw; bf16_t* O; bf16_t* Y; const bf16_t* lora;
};
constexpr int PS = 264;
__device__ __forceinline__ f32x4 bf4(u32x2 w) { return (f32x4){lo_bf(w.x), hi_bf(w.x), lo_bf(w.y), hi_bf(w.y)}; }
__device__ void rwkv_prep_task(const RwP& p, char* smem, int tile) {
    bf16_t* At = (bf16_t*)smem;
    const int tid = otid(), lane = tid & 63, wave = tid >> 6;
    const int fl = lane & 15, fq = lane >> 4;
    const int t0 = tile * 64;
    float* Wd = (float*)(p.mix + MX_W); float* KKd = (float*)(p.mix + MX_KK); float* KKAd = (float*)(p.mix + MX_KKA);
    bf16_t* Rd = (bf16_t*)(p.mix + MX_R); bf16_t* Kd = (bf16_t*)(p.mix + MX_K); bf16_t* Vd = (bf16_t*)(p.mix + MX_V); bf16_t* Gd = (bf16_t*)(p.mix + MX_G);
    __syncthreads();
    {
        const int tok = tid >> 3, t = t0 + tok;
        const bool first = (t & (NS - 1)) == 0;
        const bf16_t* zr = p.Z + (size_t)t * DINP + ZC_RW + 1152;
#pragma unroll
        for (int i = 0; i < 4; ++i) {
            const int ch = (tid & 7) + 8 * i;
            const u32x4 cur = *(const u32x4*)(zr + ch * 8);
            const u32x4 prv = first ? (u32x4){0u, 0u, 0u, 0u} : *(const u32x4*)(zr - DINP + ch * 8);
            const f32x4 m0 = *(const f32x4*)(p.mu + 1152 + ch * 8), m1 = *(const f32x4*)(p.mu + 1152 + ch * 8 + 4);
            const unsigned cw[4] = {cur.x, cur.y, cur.z, cur.w}, pw[4] = {prv.x, prv.y, prv.z, prv.w};
            const float mm[8] = {m0.x, m0.y, m0.z, m0.w, m1.x, m1.y, m1.z, m1.w};
            float o[8];
#pragma unroll
            for (int e = 0; e < 4; ++e) {
                const float f0 = lo_bf(cw[e]), f1 = hi_bf(cw[e]), g0 = lo_bf(pw[e]), g1 = hi_bf(pw[e]);
                o[2 * e] = f0 + (g0 - f0) * mm[2 * e]; o[2 * e + 1] = f1 + (g1 - f1) * mm[2 * e + 1];
            }
            if (ch < 8) {
#pragma unroll
                for (int e = 0; e < 8; ++e) o[e] = tanhf_(o[e]);
            } else if (ch >= 16) {
#pragma unroll
                for (int e = 0; e < 8; ++e) o[e] = sigmoidf_(o[e]);
            }
            *(u32x4*)(At + tok * PS + ch * 8) = (u32x4){pk2(o[0], o[1]), pk2(o[2], o[3]), pk2(o[4], o[5]), pk2(o[6], o[7])};
        }
    }
    __syncthreads();
    bf16x8 xb[8];
#pragma unroll
    for (int ks = 0; ks < 8; ++ks) xb[ks] = *(const bf16x8*)(At + (16 * (wave & 3) + fl) * PS + ks * 32 + fq * 8);
    const int t = t0 + 16 * (wave & 3) + fl, b = t >> 12, sq = t & (NS - 1);
    const bool first = sq == 0;
    const bf16_t* zc = p.Z + (size_t)t * DINP + ZC_RW;
    const bf16_t* WupT = p.lora; const bf16_t* AupT = p.lora + 384 * 64; const bf16_t* GupT = p.lora + 2 * 384 * 64;
    const int hd0 = (wave >> 2) * 3;
#pragma unroll
    for (int hi = 0; hi < 3; ++hi) {
        const int hd = hd0 + hi;
        f32x4 aw[4], aa[4], ag[4];
#pragma unroll
        for (int n = 0; n < 4; ++n) {
            const int cr = hd * 64 + 16 * n + fl;
            f32x4 w4 = (f32x4){0.f, 0.f, 0.f, 0.f}, a4 = w4, g4 = w4;
#pragma unroll
            for (int ks = 0; ks < 2; ++ks) {
                w4 = __builtin_amdgcn_mfma_f32_16x16x32_bf16(*(const bf16x8*)(WupT + cr * 64 + ks * 32 + fq * 8), xb[ks], w4, 0, 0, 0);
                a4 = __builtin_amdgcn_mfma_f32_16x16x32_bf16(*(const bf16x8*)(AupT + cr * 64 + ks * 32 + fq * 8), xb[2 + ks], a4, 0, 0, 0);
            }
#pragma unroll
            for (int ks = 0; ks < 4; ++ks) g4 = __builtin_amdgcn_mfma_f32_16x16x32_bf16(*(const bf16x8*)(GupT + cr * 128 + ks * 32 + fq * 8), xb[4 + ks], g4, 0, 0, 0);
            aw[n] = w4; aa[n] = a4; ag[n] = g4;
        }
        f32x4 kx[4], av[4], kkv[4];
        float ss = 0.f;
        const size_t hrow = ((size_t)(b * 6 + hd) * NS + sq) * 64;
#pragma unroll
        for (int n = 0; n < 4; ++n) {
            const int cl = 16 * n + 4 * fq, c = hd * 64 + cl;
            f32x4 rr = bf4(*(const u32x2*)(zc + c)), kk = bf4(*(const u32x2*)(zc + 384 + c)), vv = bf4(*(const u32x2*)(zc + 768 + c));
            f32x4 rp = (f32x4){0.f, 0.f, 0.f, 0.f}, kp = rp, vp = rp;
            if (!first) { rp = bf4(*(const u32x2*)(zc - DINP + c)); kp = bf4(*(const u32x2*)(zc - DINP + 384 + c)); vp = bf4(*(const u32x2*)(zc - DINP + 768 + c)); }
            rr = rr + (rp - rr) * *(const f32x4*)(p.mu + c); kk = kk + (kp - kk) * *(const f32x4*)(p.mu + 384 + c); vv = vv + (vp - vv) * *(const f32x4*)(p.mu + 768 + c);
            const f32x4 wb = *(const f32x4*)(p.w_bias + c), ab = *(const f32x4*)(p.a_bias + c), kkc = *(const f32x4*)(p.k_k + c), kac = *(const f32x4*)(p.k_a + c);
            f32x4 dec, a;
            {
                const f32x4 xw = wb + aw[n], xa = ab + aa[n];
                dec.x = __expf(-__expf(-softplusf_(-xw.x) - 0.5f)); dec.y = __expf(-__expf(-softplusf_(-xw.y) - 0.5f));
                dec.z = __expf(-__expf(-softplusf_(-xw.z) - 0.5f)); dec.w = __expf(-__expf(-softplusf_(-xw.w) - 0.5f));
                a.x = sigmoidf_(xa.x); a.y = sigmoidf_(xa.y); a.z = sigmoidf_(xa.z); a.w = sigmoidf_(xa.w);
            }
            const f32x4 kr = kk * kkc;
            ss += kr.x * kr.x + kr.y * kr.y + kr.z * kr.z + kr.w * kr.w;
            kkv[n] = kr; av[n] = a; kx[n] = kk;
            const f32x4 kmod = kk * ((a - 1.f) * kac + 1.f);
            *(f32x4*)(Wd + hrow + cl) = dec;
            u32x2 w;
            w.x = pk2(rr.x, rr.y); w.y = pk2(rr.z, rr.w); *(u32x2*)(Rd + hrow + cl) = w;
            w.x = pk2(kmod.x, kmod.y); w.y = pk2(kmod.z, kmod.w); *(u32x2*)(Kd + hrow + cl) = w;
            w.x = pk2(vv.x, vv.y); w.y = pk2(vv.z, vv.w); *(u32x2*)(Vd + hrow + cl) = w;
            w.x = pk2(ag[n].x, ag[n].y); w.y = pk2(ag[n].z, ag[n].w); *(u32x2*)(Gd + (size_t)t * 384 + c) = w;
        }
        ss = xor32_sum(xor16_sum(ss));
        const float rn = rsqrtf(fmaxf(ss, 1e-24f));
#pragma unroll
        for (int n = 0; n < 4; ++n) {
            const int cl = 16 * n + 4 * fq;
            const f32x4 kn = kkv[n] * rn;
            *(f32x4*)(KKd + hrow + cl) = kn;
            *(f32x4*)(KKAd + hrow + cl) = kn * av[n];
        }
    }
}

constexpr int SC_STEPS = 16;
constexpr int SEG_BEG[4] = {0, 1376, 2736, 4096};
constexpr size_t MX_SE0 = MX_END;
constexpr size_t MX_XE  = MX_SE0 + 24ull * 3 * 4096 * 4;
constexpr size_t MX_SST = MX_XE + 24ull * 3 * 4096 * 4;
static_assert(MX_SST + 24ull * 3 * 4096 * 2 <= 128 * MiB, "mix region");
__device__ __forceinline__ float row8_sum(float v) { v += dpp_f<0xB1>(v); v += dpp_f<0x4E>(v); v += dpp_f<0x141>(v); return v; }
__device__ void rwkv_scan_task(const RwP& p, char* smem, int bh, int seg, int grp, const CvP cvp, bool cv, int cvrow0, int cvstride) {
    float* buf = (float*)smem;
    float* obuf = buf + 2 * 6 * SC_STEPS * 64;
    const int tid = otid(), lane = tid & 63, wave = tid >> 6;
    const bool act = __builtin_amdgcn_readfirstlane(wave) < 4;
    const int rloc = (wave & 3) * 8 + (lane >> 3);
    const bool ident = grp >= 2;
    const int row = (grp & 1) * 32 + rloc;
    int cvrow = cvrow0 + (__builtin_amdgcn_readfirstlane(wave) - 4);
    const int c8 = (lane & 7) * 8;
    const int s_beg = seg == 0 ? SEG_BEG[0] : (seg == 1 ? SEG_BEG[1] : SEG_BEG[2]);
    const int s_end = seg == 0 ? SEG_BEG[1] : (seg == 1 ? SEG_BEG[2] : SEG_BEG[3]);
    const int NCH = (s_end - s_beg) / SC_STEPS;
    const size_t hb = ((size_t)bh * NS + s_beg) * 64;
    const float* Wd = (const float*)(p.mix + MX_W) + hb;
    const float* KKd = (const float*)(p.mix + MX_KK) + hb;
    const float* KKAd = (const float*)(p.mix + MX_KKA) + hb;
    const bf16_t* Rd = (const bf16_t*)(p.mix + MX_R) + hb;
    const bf16_t* Kd = (const bf16_t*)(p.mix + MX_K) + hb;
    const bf16_t* Vd = (const bf16_t*)(p.mix + MX_V) + hb;
    float* orow = p.oraw + hb;
    bf16_t* yrow = p.Y + hb;
    f32x4 Sa, Sb;
    Sa.x = (ident && c8 + 0 == row) ? 1.f : 0.f; Sa.y = (ident && c8 + 1 == row) ? 1.f : 0.f; Sa.z = (ident && c8 + 2 == row) ? 1.f : 0.f; Sa.w = (ident && c8 + 3 == row) ? 1.f : 0.f;
    Sb.x = (ident && c8 + 4 == row) ? 1.f : 0.f; Sb.y = (ident && c8 + 5 == row) ? 1.f : 0.f; Sb.z = (ident && c8 + 6 == row) ? 1.f : 0.f; Sb.w = (ident && c8 + 7 == row) ? 1.f : 0.f;
    struct Stg { f32x4 w, kk, ka; u32x2 r, k, v; };
    Stg sA;
    auto gload = [&](Stg& g, int ch) {
        if (tid >= 256) return;
        const size_t e = (size_t)ch * SC_STEPS * 64 + tid * 4;
        g.w = *(const f32x4*)(Wd + e); g.kk = *(const f32x4*)(KKd + e); g.ka = *(const f32x4*)(KKAd + e);
        g.r = *(const u32x2*)(Rd + e); g.k = *(const u32x2*)(Kd + e); g.v = *(const u32x2*)(Vd + e);
    };
    auto lstore = [&](const Stg& g, int bsel) {
        if (tid >= 256) return;
        float* bb = buf + bsel * 6 * SC_STEPS * 64 + tid * 4;
        *(f32x4*)(bb + 0 * SC_STEPS * 64) = g.w; *(f32x4*)(bb + 1 * SC_STEPS * 64) = g.kk; *(f32x4*)(bb + 2 * SC_STEPS * 64) = g.ka;
        *(f32x4*)(bb + 3 * SC_STEPS * 64) = (f32x4){lo_bf(g.r.x), hi_bf(g.r.x), lo_bf(g.r.y), hi_bf(g.r.y)};
        *(f32x4*)(bb + 4 * SC_STEPS * 64) = (f32x4){lo_bf(g.k.x), hi_bf(g.k.x), lo_bf(g.k.y), hi_bf(g.k.y)};
        *(f32x4*)(bb + 5 * SC_STEPS * 64) = (f32x4){lo_bf(g.v.x), hi_bf(g.v.x), lo_bf(g.v.y), hi_bf(g.v.y)};
    };
    __syncthreads();
    gload(sA, 0); lstore(sA, 0);
    __syncthreads();
    const float vmask = ident ? 0.f : 1.f;
    struct Ops { f32x4 w0, w1, kk0, kk1, ka0, ka1, r0, r1, k0, k1; float v; };
    auto ldops = [&](Ops& o, const float* bb, int st) {
        const float* q = bb + st * 64 + c8;
        o.w0 = *(const f32x4*)(q); o.w1 = *(const f32x4*)(q + 4);
        o.kk0 = *(const f32x4*)(q + 1 * SC_STEPS * 64); o.kk1 = *(const f32x4*)(q + 1 * SC_STEPS * 64 + 4);
        o.ka0 = *(const f32x4*)(q + 2 * SC_STEPS * 64); o.ka1 = *(const f32x4*)(q + 2 * SC_STEPS * 64 + 4);
        o.r0 = *(const f32x4*)(q + 3 * SC_STEPS * 64); o.r1 = *(const f32x4*)(q + 3 * SC_STEPS * 64 + 4);
        o.k0 = *(const f32x4*)(q + 4 * SC_STEPS * 64); o.k1 = *(const f32x4*)(q + 4 * SC_STEPS * 64 + 4);
        o.v = bb[5 * SC_STEPS * 64 + st * 64 + row];
    };
    auto chunk = [&](int ch, Stg& cur  ) {
        if (ch + 1 < NCH) gload(cur, ch + 1);
        const float* bb = buf + (ch & 1) * 6 * SC_STEPS * 64;
        if (!act) {
            if (cv && cvrow < 4 * NEXP) { convert_uv_row(cvp, cvrow, lane); cvrow += cvstride; }
        } else {
        Ops o; ldops(o, bb, 0);
#pragma unroll
        for (int st = 0; st < SC_STEPS; ++st) {
            Ops n; ldops(n, bb, (st + 1 < SC_STEPS) ? st + 1 : st);
            const float vx = o.v * vmask;
            const f32x4 pa = Sa * o.kk0 + Sb * o.kk1;
            const float sa = -row8_sum((pa.x + pa.y) + (pa.z + pa.w));
            Sa = Sa * o.w0 + o.k0 * vx + o.ka0 * sa;
            Sb = Sb * o.w1 + o.k1 * vx + o.ka1 * sa;
            const f32x4 qa = Sa * o.r0 + Sb * o.r1;
            obuf[st * 32 + rloc] = row8_sum((qa.x + qa.y) + (qa.z + qa.w));
            o = n;
        }
        }
        __syncthreads();
        {
            const int idx = tid, st = idx >> 5, rr = idx & 31;
            const size_t oi = ((size_t)ch * SC_STEPS + st) * 64 + (grp & 1) * 32 + rr;
            if (ident) yrow[oi] = f2bf(obuf[idx]); else orow[oi] = obuf[idx];
        }
        if (ch + 1 < NCH) lstore(cur, (ch + 1) & 1);
        __syncthreads();
    };
    for (int ch = 0; ch < NCH; ++ch) chunk(ch, sA);
    float* fin = (float*)(p.mix + (ident ? MX_XE : MX_SE0)) + ((size_t)(bh * 3 + seg) * 64 + row) * 64 + c8;
    if (act) { *(f32x4*)fin = Sa; *(f32x4*)(fin + 4) = Sb; }
}

__device__ void phase_rwkv_chain(const RwP& p, int bid, int nblk) {
    const int lane = otid() & 63, wave = otid() >> 6;
    const float* SE0 = (const float*)(p.mix + MX_SE0); const float* XE = (const float*)(p.mix + MX_XE);
    bf16_t* SST = (bf16_t*)(p.mix + MX_SST);
    for (int x = bid * NW + wave; x < 24 * 4; x += nblk * NW) {
        const int bh = x >> 2, cg = (x & 3) * 16;
        const float* s1 = SE0 + ((size_t)(bh * 3 + 0) * 64 + lane) * 64;
        const float* e1 = SE0 + ((size_t)(bh * 3 + 1) * 64 + lane) * 64 + cg;
        const float* X1 = XE + (size_t)(bh * 3 + 1) * 4096 + cg;
        float o[16];
#pragma unroll
        for (int k = 0; k < 16; ++k) o[k] = e1[k];
        for (int i = 0; i < 64; ++i) {
            const float si = s1[i];
#pragma unroll
            for (int k = 0; k < 16; ++k) o[k] += si * X1[i * 64 + k];
        }
        bf16_t* d1 = SST + ((size_t)(bh * 3 + 1) * 64 + lane) * 64 + cg;
        bf16_t* d2 = SST + ((size_t)(bh * 3 + 2) * 64 + lane) * 64 + cg;
#pragma unroll
        for (int k = 0; k < 16; ++k) { d1[k] = f2bf(s1[cg + k]); d2[k] = f2bf(o[k]); }
    }
}

__device__ void phase_rwkv_post(const RwP& p, int bid, int nblk) {
    const int lane = otid() & 63, wave = otid() >> 6;
    const int fl = lane & 15, fq = lane >> 4;
    const bf16_t* Rd = (const bf16_t*)(p.mix + MX_R); const bf16_t* Kd = (const bf16_t*)(p.mix + MX_K); const bf16_t* Vd = (const bf16_t*)(p.mix + MX_V);
    const bf16_t* Gd = (const bf16_t*)(p.mix + MX_G); const bf16_t* SST = (const bf16_t*)(p.mix + MX_SST);
    for (int x = bid * NW + wave; x < 24 * (NS / 16); x += nblk * NW) {
        const int bh = x / (NS / 16), s0 = (x % (NS / 16)) * 16;
        const int b = bh / 6, hd = bh % 6;
        const int seg = s0 < SEG_BEG[1] ? 0 : (s0 < SEG_BEG[2] ? 1 : 2);
        const size_t hrow = ((size_t)bh * NS + s0 + fl) * 64;
        f32x4 acc[4];
#pragma unroll
        for (int n = 0; n < 4; ++n) acc[n] = *(const f32x4*)(p.oraw + hrow + 16 * n + 4 * fq);
        if (seg > 0) {
            const bf16_t* ss = SST + (size_t)(bh * 3 + seg) * 4096;
#pragma unroll
            for (int ks = 0; ks < 2; ++ks) {
                const bf16x8 yb = *(const bf16x8*)(p.Y + hrow + ks * 32 + fq * 8);
#pragma unroll
                for (int n = 0; n < 4; ++n) {
                    const bf16x8 sa = *(const bf16x8*)(ss + (size_t)(16 * n + fl) * 64 + ks * 32 + fq * 8);
                    acc[n] = __builtin_amdgcn_mfma_f32_16x16x32_bf16(sa, yb, acc[n], 0, 0, 0);
                }
            }
        }
        float sm = 0.f;
#pragma unroll
        for (int n = 0; n < 4; ++n) sm += acc[n].x + acc[n].y + acc[n].z + acc[n].w;
        const float mean = xor32_sum(xor16_sum(sm)) * (1.f / 64.f);
        float sv = 0.f;
#pragma unroll
        for (int n = 0; n < 4; ++n) { acc[n] = acc[n] - mean; sv += acc[n].x * acc[n].x + acc[n].y * acc[n].y + acc[n].z * acc[n].z + acc[n].w * acc[n].w; }
        const float rstd = rsqrtf(xor32_sum(xor16_sum(sv)) * (1.f / 64.f) + 64e-5f);
        float rk = 0.f; f32x4 vv[4];
#pragma unroll
        for (int n = 0; n < 4; ++n) {
            const int c = 16 * n + 4 * fq;
            const u32x2 r2 = *(const u32x2*)(Rd + hrow + c), k2 = *(const u32x2*)(Kd + hrow + c), v2 = *(const u32x2*)(Vd + hrow + c);
            const f32x4 rkw = *(const f32x4*)(p.r_k + hd * 64 + c);
            rk += lo_bf(r2.x) * lo_bf(k2.x) * rkw.x + hi_bf(r2.x) * hi_bf(k2.x) * rkw.y + lo_bf(r2.y) * lo_bf(k2.y) * rkw.z + hi_bf(r2.y) * hi_bf(k2.y) * rkw.w;
            vv[n] = (f32x4){lo_bf(v2.x), hi_bf(v2.x), lo_bf(v2.y), hi_bf(v2.y)};
        }
        rk = xor32_sum(xor16_sum(rk));
        const size_t t = (size_t)b * NS + s0 + fl;
#pragma unroll
        for (int n = 0; n < 4; ++n) {
            const int c = 16 * n + 4 * fq;
            const f32x4 lw = *(const f32x4*)(p.ln_w + hd * 64 + c), lb = *(const f32x4*)(p.ln_b + hd * 64 + c);
            const u32x2 g2 = *(const u32x2*)(Gd + t * 384 + hd * 64 + c);
            const f32x4 gg = (f32x4){lo_bf(g2.x), hi_bf(g2.x), lo_bf(g2.y), hi_bf(g2.y)};
            const f32x4 o = (acc[n] * rstd * lw + lb + vv[n] * rk) * gg;
            u32x2 w; w.x = pk2(o.x, o.y); w.y = pk2(o.z, o.w);
            *(u32x2*)(p.O + t * D + 256 + hd * 64 + c) = w;
        }
    }
}

__device__ __forceinline__ unsigned ordkey(float f) { const unsigned u = __float_as_uint(f); return (u & 0x80000000u) ? ~u : (u | 0x80000000u); }
__device__ __forceinline__ float unordkey(unsigned k) { return __uint_as_float((k & 0x80000000u) ? (k & 0x7FFFFFFFu) : ~k); }
__device__ __forceinline__ void ins16(unsigned (&L)[16], unsigned x) {
#pragma unroll
    for (int i = 0; i < 16; ++i) { const unsigned hi = L[i] > x ? L[i] : x; x = L[i] > x ? x : L[i]; L[i] = hi; }
}
__device__ __forceinline__ void top16_col(const float* col  , unsigned (&L)[16]) {
#pragma unroll
    for (int i = 0; i < 16; ++i) L[i] = 0u;
#pragma unroll 1
    for (int n0 = 0; n0 < 128; n0 += 16) {
        float x[16];
#pragma unroll
        for (int j = 0; j < 16; ++j) x[j] = col[(size_t)(n0 + j) * NT];
#pragma unroll
        for (int j = 0; j < 16; ++j) ins16(L, (ordkey(x[j]) & 0xFFFFFF80u) | (unsigned)(127 - (n0 + j)));
    }
}
__device__ void phase_topk(const float* SCT, int* EIDX, float* GATE, char* smem, int bid, int nblk) {
    const int tid = otid(), lane = tid & 63, wave = tid >> 6;
    unsigned char* itab = (unsigned char*)smem + tid * 32;
    unsigned char* ctab = (unsigned char*)smem + NTHREADS * 32;
    __syncthreads();
    if (tid < 64) {
        const int c = tid; int ci, cj;
        if (c < 16) { ci = 0; cj = c; } else if (c < 24) { ci = 1; cj = c - 16; } else if (c < 29) { ci = 2; cj = c - 24; } else if (c < 33) { ci = 3; cj = c - 29; }
        else if (c < 36) { ci = 4; cj = c - 33; } else if (c < 38) { ci = 5; cj = c - 36; } else if (c < 40) { ci = 6; cj = c - 38; } else if (c < 42) { ci = 7; cj = c - 40; }
        else if (c < 50) { ci = c - 34; cj = 0; } else { ci = 0; cj = 0; }
        ctab[c] = (unsigned char)(ci | (cj << 4));
    }
    __syncthreads();
    for (int x = bid * NW + wave; x < (NT / 64) * 8; x += nblk * NW) {
        const int tb = x >> 3, hd = x & 7;
        const int t = tb * 64 + lane;
        unsigned L1[16], L2[16];
        top16_col(SCT + (size_t)(hd * 256) * NT + t, L1);
        top16_col(SCT + (size_t)(hd * 256 + 128) * NT + t, L2);
        float s1[16], s2[16];
#pragma unroll
        for (int i = 0; i < 16; ++i) {
            s1[i] = unordkey(L1[i] & 0xFFFFFF80u); s2[i] = unordkey(L2[i] & 0xFFFFFF80u);
            itab[i] = (unsigned char)(127u - (L1[i] & 127u)); itab[16 + i] = (unsigned char)(127u - (L2[i] & 127u));
        }
        unsigned M[16];
#pragma unroll
        for (int i = 0; i < 16; ++i) M[i] = 0u;
        int c = 0;
#pragma unroll
        for (int ci = 0; ci < 16; ++ci) {
#pragma unroll
            for (int cj = 0; cj < 16; ++cj) {
                if ((ci + 1) * (cj + 1) <= 16) {
                    const int cid = (ci == 0) ? cj : (ci == 1) ? 16 + cj : (ci == 2) ? 24 + cj : (ci == 3) ? 29 + cj : (ci == 4) ? 33 + cj : (ci == 5) ? 36 + cj : (ci == 6) ? 38 + cj : (ci == 7) ? 40 + cj : 34 + ci;
                    ins16(M, (ordkey(s1[ci] + s2[cj]) & 0xFFFFFFC0u) | (unsigned)(63 - cid));
                    ++c;
                }
            }
        }
        float ev[16]; int ee[16];
        const float mx = unordkey(M[0] & 0xFFFFFFC0u);
        float sum = 0.f;
#pragma unroll
        for (int i = 0; i < 16; ++i) {
            const int cid = 63 - (int)(M[i] & 63u);
            const unsigned cc = ctab[cid];
            ee[i] = (int)itab[cc & 15u] * 128 + (int)itab[16 + (cc >> 4)];
            ev[i] = __expf(unordkey(M[i] & 0xFFFFFFC0u) - mx);
            sum += ev[i];
        }
        const float inv = 1.f / sum;
        int* eo = EIDX + (size_t)t * 128 + hd * 16; float* go = GATE + (size_t)t * 128 + hd * 16;
#pragma unroll
        for (int i = 0; i < 4; ++i) {
            *(int4*)(eo + 4 * i) = make_int4(ee[4 * i], ee[4 * i + 1], ee[4 * i + 2], ee[4 * i + 3]);
            *(f32x4*)(go + 4 * i) = (f32x4){ev[4 * i] * inv, ev[4 * i + 1] * inv, ev[4 * i + 2] * inv, ev[4 * i + 3] * inv};
        }
    }
    __syncthreads();
}

typedef float f32x2 __attribute__((ext_vector_type(2)));
__device__ __forceinline__ float gelu_erf(float d) { return 0.5f * d * (1.f + erff(d * 0.7071067811865476f)); }
template <int NMODE>
__device__ void phase_expert(const bf16_t* H, const unsigned char* U4, const unsigned char* V4, const float* SU, const float* SV, const int* EIDX, const float* GATE,
                             const float* X, float* Xo, const float* gn, bf16_t* Hn, int bid, int nblk) {
    const int lane = otid() & 63, wave = otid() >> 6;
    for (int t = bid * NW + wave; t < NT; t += nblk * NW) {
        f32x2 xf[8], acc[8];
        {
            const u32x4 a = *(const u32x4*)(H + (size_t)t * D + lane * 16), b = *(const u32x4*)(H + (size_t)t * D + lane * 16 + 8);
            xf[0] = (f32x2){lo_bf(a.x), hi_bf(a.x)}; xf[1] = (f32x2){lo_bf(a.y), hi_bf(a.y)}; xf[2] = (f32x2){lo_bf(a.z), hi_bf(a.z)}; xf[3] = (f32x2){lo_bf(a.w), hi_bf(a.w)};
            xf[4] = (f32x2){lo_bf(b.x), hi_bf(b.x)}; xf[5] = (f32x2){lo_bf(b.y), hi_bf(b.y)}; xf[6] = (f32x2){lo_bf(b.z), hi_bf(b.z)}; xf[7] = (f32x2){lo_bf(b.w), hi_bf(b.w)};
        }
#pragma unroll
        for (int i = 0; i < 8; ++i) acc[i] = (f32x2){0.f, 0.f};
        const int e_lo = EIDX[(size_t)t * 128 + lane], e_hi = EIDX[(size_t)t * 128 + 64 + lane];
        const float g_lo = GATE[(size_t)t * 128 + lane] * SV[e_lo], g_hi = GATE[(size_t)t * 128 + 64 + lane] * SV[e_hi];
        const float su_lo = SU[e_lo], su_hi = SU[e_hi];
#pragma unroll 1
        for (int e0 = 0; e0 < 128; e0 += 16) {
            const int esrc = (e0 < 64) ? e_lo : e_hi;
            int ei[16]; u32x2 ur[16];
#pragma unroll
            for (int j = 0; j < 16; ++j) { ei[j] = __builtin_amdgcn_readlane(esrc, (e0 & 63) + j); ur[j] = *(const u32x2*)(U4 + (size_t)ei[j] * 1024 + lane * 8); }
            float dmine = 0.f;
#pragma unroll
            for (int j = 0; j < 16; ++j) {
                f32x2 d2 = (f32x2){0.f, 0.f};
                d2 = __builtin_elementwise_fma(xf[0], __builtin_amdgcn_cvt_scalef32_pk_f32_fp4(ur[j].x, 1.0f, 0), d2);
                d2 = __builtin_elementwise_fma(xf[1], __builtin_amdgcn_cvt_scalef32_pk_f32_fp4(ur[j].x, 1.0f, 1), d2);
                d2 = __builtin_elementwise_fma(xf[2], __builtin_amdgcn_cvt_scalef32_pk_f32_fp4(ur[j].x, 1.0f, 2), d2);
                d2 = __builtin_elementwise_fma(xf[3], __builtin_amdgcn_cvt_scalef32_pk_f32_fp4(ur[j].x, 1.0f, 3), d2);
                d2 = __builtin_elementwise_fma(xf[4], __builtin_amdgcn_cvt_scalef32_pk_f32_fp4(ur[j].y, 1.0f, 0), d2);
                d2 = __builtin_elementwise_fma(xf[5], __builtin_amdgcn_cvt_scalef32_pk_f32_fp4(ur[j].y, 1.0f, 1), d2);
                d2 = __builtin_elementwise_fma(xf[6], __builtin_amdgcn_cvt_scalef32_pk_f32_fp4(ur[j].y, 1.0f, 2), d2);
                d2 = __builtin_elementwise_fma(xf[7], __builtin_amdgcn_cvt_scalef32_pk_f32_fp4(ur[j].y, 1.0f, 3), d2);
                const float d = wave_sum(d2.x + d2.y);
                if (lane == (e0 & 63) + j) dmine = d;
            }
            const float amine = gelu_erf(dmine * ((e0 < 64) ? su_lo : su_hi)) * ((e0 < 64) ? g_lo : g_hi);
#pragma unroll
            for (int j = 0; j < 16; ++j) ur[j] = *(const u32x2*)(V4 + (size_t)ei[j] * 1024 + lane * 8);
#pragma unroll
            for (int j = 0; j < 16; ++j) {
                const float a = __int_as_float(__builtin_amdgcn_readlane(__float_as_int(amine), (e0 & 63) + j));
                const f32x2 a2 = (f32x2){a, a};
                acc[0] = __builtin_elementwise_fma(a2, __builtin_amdgcn_cvt_scalef32_pk_f32_fp4(ur[j].x, 1.0f, 0), acc[0]);
                acc[1] = __builtin_elementwise_fma(a2, __builtin_amdgcn_cvt_scalef32_pk_f32_fp4(ur[j].x, 1.0f, 1), acc[1]);
                acc[2] = __builtin_elementwise_fma(a2, __builtin_amdgcn_cvt_scalef32_pk_f32_fp4(ur[j].x, 1.0f, 2), acc[2]);
                acc[3] = __builtin_elementwise_fma(a2, __builtin_amdgcn_cvt_scalef32_pk_f32_fp4(ur[j].x, 1.0f, 3), acc[3]);
                acc[4] = __builtin_elementwise_fma(a2, __builtin_amdgcn_cvt_scalef32_pk_f32_fp4(ur[j].y, 1.0f, 0), acc[4]);
                acc[5] = __builtin_elementwise_fma(a2, __builtin_amdgcn_cvt_scalef32_pk_f32_fp4(ur[j].y, 1.0f, 1), acc[5]);
                acc[6] = __builtin_elementwise_fma(a2, __builtin_amdgcn_cvt_scalef32_pk_f32_fp4(ur[j].y, 1.0f, 2), acc[6]);
                acc[7] = __builtin_elementwise_fma(a2, __builtin_amdgcn_cvt_scalef32_pk_f32_fp4(ur[j].y, 1.0f, 3), acc[7]);
            }
        }
        const f32x4* xr = (const f32x4*)(X + (size_t)t * D) + lane * 4;
        f32x4* xo = (f32x4*)(Xo + (size_t)t * D) + lane * 4;
        f32x4 o[4]; float ss = 0.f;
#pragma unroll
        for (int i = 0; i < 4; ++i) { o[i] = xr[i]; o[i] += (f32x4){acc[2 * i].x, acc[2 * i].y, acc[2 * i + 1].x, acc[2 * i + 1].y}; ss += o[i].x * o[i].x + o[i].y * o[i].y + o[i].z * o[i].z + o[i].w * o[i].w; }
        const float rs = rsqrtf(wave_sum(ss) * (1.f / D) + 1e-6f);
        const f32x4* gp = (const f32x4*)gn + lane * 4;
        if (NMODE == 1) {
#pragma unroll
            for (int i = 0; i < 4; ++i) xo[i] = o[i] * rs * gp[i];
        } else {
            u32x4 h0, h1;
            { const f32x4 y0 = o[0] * rs * gp[0], y1 = o[1] * rs * gp[1], y2 = o[2] * rs * gp[2], y3 = o[3] * rs * gp[3];
              h0 = (u32x4){pk2(y0.x, y0.y), pk2(y0.z, y0.w), pk2(y1.x, y1.y), pk2(y1.z, y1.w)}; h1 = (u32x4){pk2(y2.x, y2.y), pk2(y2.z, y2.w), pk2(y3.x, y3.y), pk2(y3.z, y3.w)}; }
#pragma unroll
            for (int i = 0; i < 4; ++i) xo[i] = o[i];
            *(u32x4*)(Hn + (size_t)t * D + lane * 16) = h0; *(u32x4*)(Hn + (size_t)t * D + lane * 16 + 8) = h1;
        }
    }
}

#define XB_TMO      128
#define XB_XCNT(j)  (256  + 64 * (j))
#define XB_XSUB(j)  (1280 + 64 * (j))
#define XB_XGEN(j)  (2304 + 64 * (j))
#define XB_TOP      3328
#define XB_TOPGEN   3392
#define XCD_BAR_WORDS 3456
#define XB_SPIN_CAP (1u << 22)
#define LAS __attribute__((address_space(3)))
__device__ __forceinline__ unsigned xb_ld(unsigned* p)              { return __hip_atomic_load(p, __ATOMIC_RELAXED, __HIP_MEMORY_SCOPE_AGENT); }
__device__ __forceinline__ unsigned xb_add(unsigned* p, unsigned v) { return __hip_atomic_fetch_add(p, v, __ATOMIC_RELAXED, __HIP_MEMORY_SCOPE_AGENT); }
__device__ __forceinline__ unsigned xb_xcc_id() { return (unsigned)__builtin_amdgcn_s_getreg((3 << 11) | 20) & 0xFu; }
#define XB_SPIN(cond, bar) do { unsigned _sp = 0; while (cond) { __builtin_amdgcn_s_sleep(1); \
    if ((++_sp & 255u) == 0u) { if (xb_ld(&(bar)[XB_TMO])) break; if (_sp > XB_SPIN_CAP) { atomicAdd(&(bar)[XB_TMO], 1u); break; } } } } while (0)
struct XcdBarrier { unsigned* bar; unsigned x; volatile LAS unsigned* st; };
__device__ __forceinline__ XcdBarrier xcd_barrier_post(unsigned* bar, volatile LAS unsigned* st) {
    XcdBarrier b; b.bar = bar; b.x = xb_xcc_id(); b.st = st;
    if (threadIdx.x == 0) (void)xb_add(&bar[XB_XCNT(b.x)], 1u);
    return b;
}
__device__ __forceinline__ void xcd_barrier_complete(unsigned* bar, unsigned x, unsigned& nloc, unsigned& nx) {
    const unsigned G = gridDim.x * gridDim.y * gridDim.z;
    unsigned sum, cnt, mine, sp = 0u;
    for (;;) {
        sum = 0u; cnt = 0u; mine = 0u;
#pragma unroll
        for (unsigned j = 0; j < 16; ++j) { const unsigned c = xb_ld(&bar[XB_XCNT(j)]); sum += c; cnt += (c > 0u) ? 1u : 0u; mine = (j == x) ? c : mine; }
        if (sum == G) break;
        __builtin_amdgcn_s_sleep(1);
        if ((++sp & 255u) == 0u) { if (xb_ld(&bar[XB_TMO])) break; if (sp > XB_SPIN_CAP) { atomicAdd(&bar[XB_TMO], 1u); break; } }
    }
    nloc = mine > 0u ? mine : 1u; nx = cnt > 0u ? cnt : 1u;
}
__device__ __forceinline__ void xcd_barrier(const XcdBarrier& b0) {
    asm volatile("s_waitcnt vmcnt(0)" ::: "memory");
    __syncthreads();
    if (threadIdx.x == 0) {
        XcdBarrier b = b0;
        { unsigned x = __builtin_amdgcn_readfirstlane(b0.x); asm volatile("" : "+s"(x)); b.x = x; }
        unsigned* bar = b.bar;
        __builtin_amdgcn_s_waitcnt(0);
        unsigned nloc = b.st[0], nx = b.st[1];
        if (nloc == 0u) { xcd_barrier_complete(bar, b.x, nloc, nx); b.st[0] = nloc; b.st[1] = nx; }
        const unsigned old = xb_add(&bar[XB_XSUB(b.x)], 1u);
        const unsigned gen = old / nloc;
        if (old + 1u == (gen + 1u) * nloc) {
            __builtin_amdgcn_fence(__ATOMIC_RELEASE, "agent");
            asm volatile("s_waitcnt vmcnt(0)" ::: "memory");
            const unsigned og = xb_add(&bar[XB_TOP], 1u);
            const unsigned tg = og / nx;
            if (og + 1u == (tg + 1u) * nx) xb_add(&bar[XB_TOPGEN], 1u);
            else XB_SPIN(xb_ld(&bar[XB_TOPGEN]) == tg, bar);
            __builtin_amdgcn_fence(__ATOMIC_ACQUIRE, "agent");
            xb_add(&bar[XB_XGEN(b.x)], 1u);
            asm volatile("s_waitcnt vmcnt(0)" ::: "memory");
        } else {
            XB_SPIN(xb_ld(&bar[XB_XGEN(b.x)]) == gen, bar);
            __builtin_amdgcn_fence(__ATOMIC_ACQUIRE, "agent");
            asm volatile("s_waitcnt vmcnt(0)" ::: "memory");
        }
    }
    __syncthreads();
}

struct Params {
    const float* in[24];
    float* out; unsigned char* ws;
};
constexpr int LDS_BYTES = 147456;

typedef volatile LAS unsigned long long* ptab_t;
__device__ __forceinline__ const float* pin(ptab_t t, int i) {
    const unsigned long long v = t[i];
    const unsigned lo = __builtin_amdgcn_readfirstlane((unsigned)v), hi = __builtin_amdgcn_readfirstlane((unsigned)(v >> 32));
    return (const float*)(((unsigned long long)hi << 32) | lo);
}
__device__ __forceinline__ RwP make_rwp(const Params& P, ptab_t PT, int l) {
    RwP r;
    r.Z = (const bf16_t*)(P.ws + WS_Z); r.mix = P.ws + WS_MIX;
    r.mu = pin(PT, 6) + l * RW_F; r.w_up = pin(PT, 7) + (size_t)l * 64 * 384; r.w_bias = pin(PT, 8) + l * 384; r.a_up = pin(PT, 9) + (size_t)l * 64 * 384; r.a_bias = pin(PT, 10) + l * 384;
    r.g_up = pin(PT, 11) + (size_t)l * 128 * 384; r.k_k = pin(PT, 12) + l * 384; r.k_a = pin(PT, 13) + l * 384; r.r_k = pin(PT, 14) + l * 384; r.ln_w = pin(PT, 15) + l * 384; r.ln_b = pin(PT, 16) + l * 384;
    r.oraw = (float*)(P.ws + WS_H); r.O = (bf16_t*)(P.ws + WS_O); r.Y = (bf16_t*)(P.ws + WS_EIDX); r.lora = (const bf16_t*)(P.ws + WS_LORA + l * LORA_L);
    return r;
}

__global__ void __launch_bounds__(NTHREADS, 2) mega_fwd(Params P) {
    extern __shared__ __attribute__((aligned(16))) char smem[];
    const int bid = blockIdx.x, nblk = gridDim.x;
    volatile LAS unsigned* st = (volatile LAS unsigned*)(smem + LDS_BYTES - 16);
    ptab_t PT = (ptab_t)(smem + LDS_BYTES - 512);
    if (threadIdx.x == 0) {
        st[0] = 0u; st[1] = 0u; st[2] = 0u; st[3] = 0u;
        PT[0] = (unsigned long long)P.in[0]; PT[1] = (unsigned long long)P.in[1]; PT[2] = (unsigned long long)P.in[2]; PT[3] = (unsigned long long)P.in[3];
        PT[4] = (unsigned long long)P.in[4]; PT[5] = (unsigned long long)P.in[5]; PT[6] = (unsigned long long)P.in[6]; PT[7] = (unsigned long long)P.in[7];
        PT[8] = (unsigned long long)P.in[8]; PT[9] = (unsigned long long)P.in[9]; PT[10] = (unsigned long long)P.in[10]; PT[11] = (unsigned long long)P.in[11];
        PT[12] = (unsigned long long)P.in[12]; PT[13] = (unsigned long long)P.in[13]; PT[14] = (unsigned long long)P.in[14]; PT[15] = (unsigned long long)P.in[15];
        PT[16] = (unsigned long long)P.in[16]; PT[17] = (unsigned long long)P.in[17]; PT[18] = (unsigned long long)P.in[18]; PT[19] = (unsigned long long)P.in[19];
        PT[20] = (unsigned long long)P.in[20]; PT[21] = (unsigned long long)P.in[21]; PT[22] = (unsigned long long)P.in[22]; PT[23] = (unsigned long long)P.in[23];
    }
    __syncthreads();
    XcdBarrier bar = xcd_barrier_post((unsigned*)(P.ws + WS_CTL), st);
#define GSYNC() xcd_barrier(bar)
    constexpr int NSCAN = 240;

    {
        ConvP c{pin(PT, 4), pin(PT, 5), pin(PT, 20), pin(PT, 21), pin(PT, 22), pin(PT, 23), pin(PT, 7), pin(PT, 9), pin(PT, 11), P.ws};
        phase_convert_weights(c, smem, bid, nblk);
        phase_rmsnorm<false>(pin(PT, 0), pin(PT, 1), P.ws + WS_H, bid, nblk);
    }
    GSYNC();
#pragma unroll 1
    for (int l = 0; l < 2; ++l) {
        int bidl = bid; asm volatile("" : "+s"(bidl));
        const float* xin = (l == 0) ? pin(PT, 0) : P.out;
        {
            pg8::Gemm g{(const bf16_t*)(P.ws + WS_H), (const bf16_t*)(P.ws + WS_WTIN) + (size_t)l * DINP * D, NT, DINP, D};
            pg8::StaticOrder S; S.init(NT, DINP, nblk, bidl);
            pg8::Epi<0> E{P.ws + WS_Z, DINP, nullptr};
            pg8::gemm_phase<pg8::Epi<0>, pg8::StaticOrder, true, true>((PG8_LAS unsigned char*)smem, g, S, E);
        }
        GSYNC();
        if (l == 0) {
            const int vb = bidl - (nblk - 64);
            const int lpm = vb < 0 ? 0 : (vb >> 2);
            pg8::Gemm ge{(const bf16_t*)(P.ws + WS_SKBD) + (size_t)lpm * 256 * 256, (const bf16_t*)(P.ws + WS_WTQ) + (size_t)lpm * D * 256, 256, D, 256};
            pg8::StaticOrder S; S.init(256, D, 4, vb < 0 ? -1 : (vb & 3));
            pg8::Epi<0> E{(bf16_t*)(P.ws + WS_WEFF) + (size_t)lpm * 256 * D, D, nullptr};
            pg8::gemm_phase<pg8::Epi<0>, pg8::StaticOrder, false, true>((PG8_LAS unsigned char*)smem, ge, S, E);
        }
        RwP rw = make_rwp(P, PT, l);
        LinP lp{(const bf16_t*)(P.ws + WS_Z), (bf16_t*)(P.ws + WS_O), pin(PT, 17) + (size_t)l * 16 * 192, pin(PT, 18) + l * 192, pin(PT, 19) + l * 384, (const float*)(P.ws + WS_ROPE), P.ws + WS_LIN};
        for (int task = bidl; task < 256 + 1024; task += nblk) {
            if (task < 256) rwkv_prep_task(rw, smem, task);
            else lin_kv_dispatch(lp, smem, task - 256);
        }
        GSYNC();
        {
            CvP cvp{pin(PT, 22), pin(PT, 23), P.ws};
            const int nsb = nblk < NSCAN ? nblk : NSCAN;
            for (int task = bidl; task < NSCAN; task += nblk) {
                const int bh = task / 10, r = task % 10;
                const int seg = r < 2 ? 0 : (r < 6 ? 1 : 2), grp = r < 2 ? r : (r < 6 ? r - 2 : r - 6);
                rwkv_scan_task(rw, smem, bh, seg, grp, cvp, l == 0 && task == bidl, bidl * 4, nsb * 4);
            }
            if (l == 0) {
                const int lane = otid() & 63, gw = bidl * NW + (otid() >> 6), ngw = nblk * NW;
                for (int r = 85 * 4 * nsb + gw; r < 4 * NEXP; r += ngw) convert_uv_row(cvp, r, lane);
            }
            unsigned* lflags = (unsigned*)(P.ws + WS_FLAGS) + l * 32;
            if (nblk > NSCAN) { if (bidl >= NSCAN) lin_scan_phase(lp, bidl - NSCAN, nblk - NSCAN, lflags); }
            else lin_scan_phase(lp, bidl, nblk, lflags);
        }
        GSYNC();
        phase_rwkv_chain(rw, bidl, nblk);
        GSYNC();
        phase_rwkv_post(rw, bidl, nblk);
        for (int pair = bidl; pair < 1024; pair += nblk) lin_out_dispatch(lp, smem, pair, nullptr);
        GSYNC();
        {
            pg8::Gemm g{(const bf16_t*)(P.ws + WS_O), (const bf16_t*)(P.ws + WS_WTOUT) + (size_t)l * D * D, NT, D, D};
            pg8::StaticOrder S; S.init(NT, D, nblk, bidl);
            pg8::Epi<2> E{P.out, D, xin};
            pg8::gemm_phase<pg8::Epi<2>, pg8::StaticOrder, false, true>((PG8_LAS unsigned char*)smem, g, S, E);
        }
        GSYNC();
        phase_rmsnorm<false>(P.out, pin(PT, 2) + l * D, P.ws + WS_H, bidl, nblk);
        GSYNC();
        {
            pg8::Gemm g{(const bf16_t*)(P.ws + WS_WEFF) + (size_t)l * 2048 * D, (const bf16_t*)(P.ws + WS_H), 2048, NT, D};
            pg8::StaticOrder S; S.init(2048, NT, nblk, bidl);
            pg8::Epi<1> E{P.ws + WS_MIX, NT, nullptr};
            pg8::gemm_phase<pg8::Epi<1>, pg8::StaticOrder, true, true>((PG8_LAS unsigned char*)smem, g, S, E);
        }
        GSYNC();
        phase_topk((const float*)(P.ws + WS_MIX), (int*)(P.ws + WS_EIDX), (float*)(P.ws + WS_GATE), smem, bidl, nblk);
        GSYNC();
        if (l == 0) phase_expert<0>((const bf16_t*)(P.ws + WS_H), P.ws + WS_UB + (size_t)l * NEXP * 1024, P.ws + WS_UB + (size_t)l * NEXP * 1024 + 512,
                     (const float*)(P.ws + WS_ESC) + l * NEXP, (const float*)(P.ws + WS_ESC) + (2 + l) * NEXP,
                     (const int*)(P.ws + WS_EIDX), (const float*)(P.ws + WS_GATE), P.out, P.out, pin(PT, 1) + D, (bf16_t*)(P.ws + WS_H), bidl, nblk);
        else phase_expert<1>((const bf16_t*)(P.ws + WS_H), P.ws + WS_UB + (size_t)l * NEXP * 1024, P.ws + WS_UB + (size_t)l * NEXP * 1024 + 512,
                     (const float*)(P.ws + WS_ESC) + l * NEXP, (const float*)(P.ws + WS_ESC) + (2 + l) * NEXP,
                     (const int*)(P.ws + WS_EIDX), (const float*)(P.ws + WS_GATE), P.out, P.out, pin(PT, 3), nullptr, bidl, nblk);
        if (l == 0) GSYNC();
    }
}

extern "C" void kernel_launch(void* const* d_in, const int* in_sizes, int n_in, void* d_out, int out_size, void* d_ws, size_t ws_size, hipStream_t stream) {
    static int grid = 0;
    if (grid == 0) {
        if (n_in != 24 || ws_size < WS_END) { fprintf(stderr, "kernel_launch: bad args n_in=%d ws=%zu need=%zu\n", n_in, ws_size, (size_t)WS_END); grid = -1; return; }
        int dev = 0, cus = 0, per_cu = 0;
        hipGetDevice(&dev);
        hipDeviceGetAttribute(&cus, hipDeviceAttributeMultiprocessorCount, dev);
        hipFuncSetAttribute((const void*)mega_fwd, hipFuncAttributeMaxDynamicSharedMemorySize, LDS_BYTES);
        hipOccupancyMaxActiveBlocksPerMultiprocessor(&per_cu, (const void*)mega_fwd, NTHREADS, LDS_BYTES);
        if (per_cu < 1) { fprintf(stderr, "kernel_launch: occupancy query says %d\n", per_cu); grid = -1; return; }
        if (per_cu > 1) per_cu = 1;
        grid = cus * per_cu;
        fprintf(stderr, "kernel_launch: grid %d (%d CUs x %d)\n", grid, cus, per_cu);
    }
    if (grid < 0) return;
    hipMemsetAsync((char*)d_ws + WS_CTL, 0, 32768, stream);
    Params P{};
    for (int i = 0; i < 24; ++i) P.in[i] = (const float*)d_in[i];
    P.out = (float*)d_out; P.ws = (unsigned char*)d_ws;
    void* args[] = {&P};
    hipError_t e = hipLaunchCooperativeKernel((const void*)mega_fwd, dim3(grid), dim3(NTHREADS), args, LDS_BYTES, stream);
    if (e != hipSuccess) fprintf(stderr, "cooperative launch failed: %s (grid %d)\n", hipGetErrorString(e), grid);
}
```
